# Optimizing an MI355X kernel written in HIP

```python
import jax, jax.numpy as jnp
from jax import lax
import numpy as np

D_MODEL = 1024
BATCH = 16
SEQ = 4096
DEPTH = 1

MLSTM_HEADS = 4
MLSTM_HEAD_DIM = 256
MLSTM_WIDTH = MLSTM_HEADS * MLSTM_HEAD_DIM
MLSTM_CHUNK = 64
CONV_WIDTH = 4
ATTN_GROUPS = ((128, 1), (512, 4), (2048, 16))
N_GROUPS = len(ATTN_GROUPS)
HEADS_PER_GROUP = 4
ATTN_HEAD_DIM = 128
ATTN_HEADS = N_GROUPS * HEADS_PER_GROUP
ATTN_QKV_WIDTH = ATTN_HEADS * ATTN_HEAD_DIM
ATTN_OUT_WIDTH = HEADS_PER_GROUP * ATTN_HEAD_DIM
ROPE_DIM = ATTN_HEAD_DIM // 4
ROPE_THETA = 500000.0
EPS = 1e-6
IN_SPLITS = (MLSTM_WIDTH, MLSTM_WIDTH, MLSTM_WIDTH, MLSTM_WIDTH, MLSTM_HEADS, MLSTM_HEADS,
             ATTN_QKV_WIDTH, ATTN_QKV_WIDTH, ATTN_QKV_WIDTH, ATTN_OUT_WIDTH, D_MODEL, D_MODEL)
IN_WIDTH = sum(IN_SPLITS)

kernel_name = 'hybrid_mlstm_dilated_attn_block'


def rms_norm(x, gain):
    xf = x.astype(jnp.float32)
    y = xf * lax.rsqrt(jnp.mean(xf * xf, axis=-1, keepdims=True) + EPS)
    return (y * gain.astype(jnp.float32)).astype(x.dtype)


def causal_depthwise_conv(x, w, b):
    y = lax.conv_general_dilated(x, w[:, None, :], window_strides=(1,),
                                 padding=((CONV_WIDTH - 1, 0),),
                                 dimension_numbers=('NWC', 'WIO', 'NWC'),
                                 feature_group_count=x.shape[-1])
    return y + b


def partial_rotary(t, positions):
    half = ROPE_DIM // 2
    inv_freq = ROPE_THETA ** (-jnp.arange(half, dtype=jnp.float32) / half)
    ang = positions.astype(jnp.float32)[..., None] * inv_freq
    cos = jnp.cos(ang)[:, :, None, :]
    sin = jnp.sin(ang)[:, :, None, :]
    tr = t[..., :ROPE_DIM].astype(jnp.float32)
    x1, x2 = tr[..., :half], tr[..., half:]
    rot = jnp.concatenate([x1 * cos - x2 * sin, x2 * cos + x1 * sin], axis=-1)
    return jnp.concatenate([rot.astype(t.dtype), t[..., ROPE_DIM:]], axis=-1)


def mlstm_chunkwise(q, k, v, i_pre, f_pre):
    B, S, H, Dh = q.shape
    L = MLSTM_CHUNK
    NC = S // L
    f32 = jnp.float32

    def to_chunks(t):
        t = t.reshape((B, NC, L, H) + t.shape[3:])
        return jnp.moveaxis(t, (1, 3), (0, 2))

    qc = to_chunks(q.astype(f32))
    kc = to_chunks(k.astype(f32))
    vc = to_chunks(v.astype(f32))
    igc = to_chunks(i_pre.astype(f32))
    ac = jnp.cumsum(to_chunks(jax.nn.log_sigmoid(f_pre.astype(f32))), axis=-1)
    causal = jnp.tril(jnp.ones((L, L), dtype=bool))

    def step(carry, inp):
        C, n, m = carry
        qj, kj, vj, aj, ij = inp
        g = aj[..., -1]
        dmat = aj[..., :, None] - aj[..., None, :] + ij[..., None, :]
        dmat = jnp.where(causal, dmat, -jnp.inf)
        inter = aj + m[..., None]
        m_row = jnp.maximum(inter, jnp.max(dmat, axis=-1))
        w_intra = jnp.exp(dmat - m_row[..., None])
        w_inter = jnp.exp(inter - m_row)
        s = jnp.einsum('bhld,bhsd->bhls', qj, kj) * w_intra
        num = jnp.einsum('bhls,bhse->bhle', s, vj) + w_inter[..., None] * jnp.einsum('bhld,bhde->bhle', qj, C)
        den = jnp.sum(s, axis=-1) + w_inter * jnp.einsum('bhld,bhd->bhl', qj, n)
        h = num / jnp.maximum(jnp.abs(den), jnp.exp(-m_row))[..., None]
        w_state = g[..., None] - aj + ij
        m_new = jnp.maximum(g + m, jnp.max(w_state, axis=-1))
        decay = jnp.exp(g + m - m_new)
        kw = jnp.exp(w_state - m_new[..., None])[..., None] * kj
        C_new = decay[..., None, None] * C + jnp.einsum('bhld,bhle->bhde', kw, vj)
        n_new = decay[..., None] * n + jnp.sum(kw, axis=2)
        return (C_new, n_new, m_new), h

    init = (jnp.zeros((B, H, Dh, Dh), f32), jnp.zeros((B, H, Dh), f32), jnp.zeros((B, H), f32))
    _, hs = lax.scan(step, init, (qc, kc, vc, ac, igc))
    return hs.transpose(1, 0, 3, 2, 4).reshape(B, S, H, Dh)


def dilated_window_attention(q, k, v, window, dilation):
    B, S, H, Dh = q.shape
    span = window // dilation
    blk = span
    U = S // dilation
    nb = -(-U // blk)
    Up = nb * blk

    def strided(t):
        t = t.reshape(B, U, dilation, H, Dh).transpose(0, 3, 2, 1, 4)
        t = jnp.pad(t, ((0, 0), (0, 0), (0, 0), (0, Up - U), (0, 0)))
        return t.reshape(B, H, dilation, nb, blk, Dh)

    def with_prev(t):
        prev = jnp.pad(t, ((0, 0), (0, 0), (0, 0), (1, 0), (0, 0), (0, 0)))[:, :, :, :nb]
        return jnp.concatenate([prev, t], axis=4)

    qb = strided(q)
    kb = with_prev(strided(k))
    vb = with_prev(strided(v))
    scores = jnp.einsum('bhrnqd,bhrnkd->bhrnqk', qb, kb,
                        preferred_element_type=jnp.float32) * (Dh ** -0.5)
    p = jnp.arange(blk)[:, None]
    sk = jnp.arange(2 * blk)[None, :]
    delta = p + blk - sk
    band = (delta >= 0) & (delta <= span)
    key_u = jnp.arange(nb)[:, None, None] * blk - blk + sk[None]
    valid = band[None] & (key_u >= 0)
    scores = jnp.where(valid, scores, -jnp.inf)
    mx = jnp.max(scores, axis=-1, keepdims=True)
    e = jnp.exp(scores - mx)
    den = jnp.sum(e, axis=-1)
    out = jnp.einsum('bhrnqk,bhrnkd->bhrnqd', e, vb.astype(jnp.float32)) / den[..., None]
    lse = mx[..., 0] + jnp.log(den)
    out = out.reshape(B, H, dilation, Up, Dh)[:, :, :, :U].transpose(0, 3, 2, 1, 4).reshape(B, S, H, Dh)
    lse = lse.reshape(B, H, dilation, Up)[:, :, :, :U].transpose(0, 3, 2, 1).reshape(B, S, H)
    return out, lse


def setup_inputs(seed: int = 0) -> dict:
    key = jax.random.key(seed)
    ks = jax.random.split(key, 20)
    f32 = jnp.float32

    def nrm(k, shape, s):
        return jax.random.normal(k, shape, f32) * s

    x = nrm(ks[0], (BATCH, SEQ, D_MODEL), 1.0)
    c = nrm(ks[1], (BATCH, D_MODEL), 1.0)
    positions = (jax.random.randint(ks[2], (BATCH, 1), 0, 1024) + jnp.arange(SEQ)[None, :]).astype(jnp.int32)
    w_ada = nrm(ks[3], (DEPTH, D_MODEL, 3 * D_MODEL), D_MODEL ** -0.5)
    b_ada = nrm(ks[4], (DEPTH, 3 * D_MODEL), 0.02)
    g_norm = 1.0 + nrm(ks[5], (DEPTH, D_MODEL), 0.02)
    w_in = nrm(ks[6], (DEPTH, D_MODEL, IN_WIDTH), D_MODEL ** -0.5)
    b_igate = nrm(ks[7], (DEPTH, MLSTM_HEADS), 0.1)
    b_fgate = 3.0 + 3.0 * jax.random.uniform(ks[8], (DEPTH, MLSTM_HEADS), f32)
    w_conv = nrm(ks[9], (DEPTH, CONV_WIDTH, MLSTM_WIDTH), CONV_WIDTH ** -0.5)
    b_conv = nrm(ks[10], (DEPTH, MLSTM_WIDTH), 0.02)
    w_q_mlstm = nrm(ks[11], (DEPTH, MLSTM_HEADS, MLSTM_HEAD_DIM, MLSTM_HEAD_DIM), MLSTM_HEAD_DIM ** -0.5)
    w_k_mlstm = nrm(ks[12], (DEPTH, MLSTM_HEADS, MLSTM_HEAD_DIM, MLSTM_HEAD_DIM), MLSTM_HEAD_DIM ** -0.5)
    g_mlstm_head = 1.0 + nrm(ks[13], (DEPTH, MLSTM_HEADS, MLSTM_HEAD_DIM), 0.02)
    skip_mlstm = 1.0 + nrm(ks[14], (DEPTH, MLSTM_WIDTH), 0.02)
    w_out_mlstm = nrm(ks[15], (DEPTH, MLSTM_WIDTH, D_MODEL), MLSTM_WIDTH ** -0.5)
    w_out_attn = nrm(ks[16], (DEPTH, ATTN_OUT_WIDTH, D_MODEL), ATTN_OUT_WIDTH ** -0.5)
    w_out = nrm(ks[17], (DEPTH, D_MODEL, D_MODEL), D_MODEL ** -0.5)
    g_final = 1.0 + nrm(ks[18], (D_MODEL,), 0.02)
    return {'x': x, 'c': c, 'positions': positions, 'w_ada': w_ada, 'b_ada': b_ada,
            'g_norm': g_norm, 'w_in': w_in, 'b_igate': b_igate, 'b_fgate': b_fgate,
            'w_conv': w_conv, 'b_conv': b_conv, 'w_q_mlstm': w_q_mlstm, 'w_k_mlstm': w_k_mlstm,
            'g_mlstm_head': g_mlstm_head, 'skip_mlstm': skip_mlstm, 'w_out_mlstm': w_out_mlstm,
            'w_out_attn': w_out_attn, 'w_out': w_out, 'g_final': g_final}


def reference(x, c, positions, w_ada, b_ada, g_norm, w_in, b_igate, b_fgate, w_conv, b_conv,
              w_q_mlstm, w_k_mlstm, g_mlstm_head, skip_mlstm, w_out_mlstm, w_out_attn, w_out, g_final):
    B, S, _ = x.shape
    f32 = jnp.float32
    split_at = np.cumsum(IN_SPLITS)[:-1].tolist()
    for l in range(DEPTH):
        mod = jax.nn.silu(c) @ w_ada[l] + b_ada[l]
        shift, scale, gate = jnp.split(mod[:, None, :], 3, axis=-1)
        h = rms_norm(x, g_norm[l]) * (1.0 + scale) + shift
        proj = h @ w_in[l]
        xa, va, oa, za, ia, fa, qa, ka, vat, zb, ga, gb = jnp.split(proj, split_at, axis=-1)

        xc = jax.nn.silu(causal_depthwise_conv(xa, w_conv[l], b_conv[l]))
        xc_h = xc.reshape(B, S, MLSTM_HEADS, MLSTM_HEAD_DIM)
        q_m = jnp.einsum('bshd,hde->bshe', xc_h, w_q_mlstm[l])
        k_m = jnp.einsum('bshd,hde->bshe', xc_h, w_k_mlstm[l]) * (MLSTM_HEAD_DIM ** -0.5)
        v_m = va.reshape(B, S, MLSTM_HEADS, MLSTM_HEAD_DIM)
        h_m = mlstm_chunkwise(q_m, k_m, v_m, ia + b_igate[l], fa + b_fgate[l])
        h_m = jax.nn.sigmoid(oa.reshape(B, S, MLSTM_HEADS, MLSTM_HEAD_DIM).astype(f32)) * h_m
        h_m = rms_norm(h_m, g_mlstm_head[l]).reshape(B, S, MLSTM_WIDTH).astype(x.dtype)
        h_m = h_m + skip_mlstm[l] * xc
        y_m = (h_m * jax.nn.silu(za)) @ w_out_mlstm[l]

        qh = partial_rotary(qa.reshape(B, S, ATTN_HEADS, ATTN_HEAD_DIM), positions)
        kh = partial_rotary(ka.reshape(B, S, ATTN_HEADS, ATTN_HEAD_DIM), positions)
        vh = vat.reshape(B, S, ATTN_HEADS, ATTN_HEAD_DIM)
        outs = []
        lses = []
        for gi, (window, dilation) in enumerate(ATTN_GROUPS):
            sl = slice(gi * HEADS_PER_GROUP, (gi + 1) * HEADS_PER_GROUP)
            o_g, lse_g = dilated_window_attention(qh[:, :, sl], kh[:, :, sl], vh[:, :, sl], window, dilation)
            outs.append(o_g)
            lses.append(lse_g)
        wts = jax.nn.softmax(jnp.stack(lses, axis=0), axis=0)
        o_a = jnp.sum(wts[..., None] * jnp.stack(outs, axis=0), axis=0)
        o_a = o_a.reshape(B, S, ATTN_OUT_WIDTH).astype(x.dtype)
        y_a = (o_a * jax.nn.silu(zb)) @ w_out_attn[l]

        merged = jax.nn.sigmoid(ga) * y_m + jax.nn.sigmoid(gb) * y_a
        x = x + gate * (merged @ w_out[l])
    return rms_norm(x, g_final)
```

```cpp
#include <hip/hip_runtime.h>
#include <hip/hip_cooperative_groups.h>
#include <cstdio>
#include <cstdint>
namespace cg = cooperative_groups;

#ifndef MK_ONE_LAUNCH
#define MK_ONE_LAUNCH 0
#endif

namespace pg8 {
#define PG8_LAS __attribute__((address_space(3)))
typedef unsigned short bf16_t;
typedef short bf16x8 __attribute__((ext_vector_type(8)));
typedef float f32x4 __attribute__((ext_vector_type(4)));
typedef unsigned u32x4 __attribute__((ext_vector_type(4)));
constexpr int BM = 256, BK = 64, HALF = 128, HTB = HALF * BK * 2, STAGE_BYTES = 8 * HTB, NXCD = 8, WGM = 8;

__host__ __device__ __forceinline__ int lds_byte(int r, int c) { const int st = (r >> 4) * 2 + (c >> 5), rr = r & 15, cc = c & 31, ob = rr * 64 + cc * 2; return st * 1024 + (ob ^ (((ob >> 9) & 1) << 5)); }
__host__ __device__ __forceinline__ void stage_rc(int b, int& R, int& C) { const int st = b / 1024, sb = b % 1024, swz = sb ^ (((sb >> 9) & 1) << 5); R = (st >> 1) * 16 + swz / 64; C = (st & 1) * 32 + (swz % 64) / 2; }
__host__ __device__ __forceinline__ int perm32(int rho) { const int n = rho >> 4, i = rho & 15; return 8 * (i >> 2) + 4 * n + (i & 3); }

struct Unit { int pm, pn, g; };
template <int LDA, int LDB, int KK, int AGS = 0, int BGS = 0> struct Gemm {
    const bf16_t* A; const bf16_t* Bt;
    static constexpr int lda = LDA, ldb = LDB, K = KK;
    __device__ __forceinline__ const char* abase(const Unit& u) const { return (const char*)A + (size_t)(u.g * AGS) + (size_t)u.pm * (size_t)(BM * 2 * LDA); }
    __device__ __forceinline__ const char* bbase(const Unit& u) const { return (const char*)Bt + (size_t)(u.g * BGS) + (size_t)u.pn * (size_t)(BM * 2 * LDB); }
};

struct StaticOrder {
    int nM, nN, nwg, G, c;
    __host__ __device__ void init(int M, int N, int G_, int c_) { nM = M / BM; nN = N / BM; nwg = nM * nN; G = G_; c = c_; }
    __host__ __device__ bool next(int i, Unit& u) const {
        const long L = (long)i * G + c; if (L >= nwg) return false;
        int wgid = (int)L; { const int q = nwg / NXCD, r = nwg % NXCD, xcd = wgid % NXCD, off = wgid / NXCD; wgid = (xcd < r ? xcd * (q + 1) : r * (q + 1) + (xcd - r) * q) + off; }
        const int nig = WGM * nN, gid = wgid / nig, fm = gid * WGM, gsz = (nM - fm) < WGM ? (nM - fm) : WGM;
        u.pm = fm + ((wgid % nig) % gsz); u.pn = (wgid % nig) / gsz; u.g = 0; return true;
    }
    __device__ __forceinline__ void a_ready(const Unit&) const {}
    __device__ __forceinline__ void done(const Unit&) const {}
};
struct GroupOrder {
    int nunits, G, c;
    __host__ __device__ void init(int M, int G_, int c_) { nunits = (M / BM) * 8; G = G_; c = c_; }
    __host__ __device__ bool next(int i, Unit& u) const {
        const long L = (long)i * G + c; if (L >= nunits) return false;
        u.pm = (int)(L >> 3); u.g = (int)((L & 7) >> 1); u.pn = (int)(L & 1); return true;
    }
    __device__ __forceinline__ void a_ready(const Unit&) const {}
    __device__ __forceinline__ void done(const Unit&) const {}
};

__device__ __forceinline__ unsigned cvt_pk_bf16(float lo, float hi) { unsigned r; asm volatile("v_cvt_pk_bf16_f32 %0, %1, %2" : "=v"(r) : "v"(lo), "v"(hi)); return r; }

template <class Epi, class Sched, bool ALIGN_EPI, bool SP2, class GemmT>
__device__ __forceinline__ void gemm_phase(PG8_LAS unsigned char* lds, const GemmT g, const Sched& S, const Epi& E) {
    const int tid = threadIdx.x, wid = __builtin_amdgcn_readfirstlane(tid >> 6), lane = tid & 63, wr = wid >> 2, wc = wid & 3, fr = lane & 15, fq = lane >> 4;
    constexpr int K = GemmT::K, nt = K / BK;
    unsigned voffA[2], voffB[2];
#pragma unroll
    for (int i = 0; i < 2; ++i) { int R, C; stage_rc(tid * 16 + i * 8192, R, C); const int Rb = Epi::PERM ? ((R & ~31) + perm32(R & 31)) : R;
        voffA[i] = (unsigned)(R * g.lda + C) * 2u; voffB[i] = (unsigned)(Rb * g.ldb + C) * 2u; }
    const size_t kstep = (size_t)(BK * 2);
    const size_t hstepA = (size_t)HALF * g.lda * 2, hstepB = (size_t)HALF * g.ldb * 2;
    const unsigned ldsw = (unsigned)wid * 1024u;
    const int aoff = lds_byte(wr * 64 + fr, fq * 8), boff = lds_byte(wc * 32 + fr, fq * 8);
#define PG8_SA(b, h) (((b) * 2 + (h)) * HTB)
#define PG8_SB(b, h) ((4 + (b) * 2 + (h)) * HTB)
#define PG8_STAGE(bufoff, gbase, voff) do { _Pragma("unroll") for (int _i = 0; _i < 2; ++_i) \
        __builtin_amdgcn_global_load_lds((const unsigned*)((const char*)(gbase) + (voff)[_i]), (PG8_LAS unsigned*)(lds + (bufoff) + ldsw + _i * 8192), 16, 0, 0); } while (0)
#define PG8_LDA(dst, b, h) do { _Pragma("unroll") for (int m = 0; m < 4; ++m) _Pragma("unroll") for (int k = 0; k < 2; ++k) dst[m][k] = *(const PG8_LAS bf16x8*)(lds + PG8_SA(b, h) + aoff + m * 2048 + k * 1024); } while (0)
#define PG8_LDB(dst, b, h) do { _Pragma("unroll") for (int n = 0; n < 2; ++n) _Pragma("unroll") for (int k = 0; k < 2; ++k) dst[n][k] = *(const PG8_LAS bf16x8*)(lds + PG8_SB(b, h) + boff + n * 2048 + k * 1024); } while (0)
#define PG8_MMA(ai, bj, At, Bt) do { __builtin_amdgcn_s_setprio(1); _Pragma("unroll") for (int m = 0; m < 4; ++m) _Pragma("unroll") for (int n = 0; n < 2; ++n) _Pragma("unroll") for (int k = 0; k < 2; ++k) \
        acc[ai][bj][m][n] = __builtin_amdgcn_mfma_f32_16x16x32_bf16(Bt[n][k], At[m][k], acc[ai][bj][m][n], 0, 0, 0); __builtin_amdgcn_s_setprio(0); } while (0)
#define PG8_WAIT_V(n) asm volatile("s_waitcnt vmcnt(" #n ")" ::: "memory")
#define PG8_WAIT_L(n) asm volatile("s_waitcnt lgkmcnt(" #n ")" ::: "memory")
#define PG8_BAR __builtin_amdgcn_s_barrier()
#define PG8_SCHED __builtin_amdgcn_sched_barrier(0)
    Unit cur, nxt; int ui = 0;
    if (!S.next(0, cur)) return;
    f32x4 acc[2][2][4][2];
#pragma unroll
    for (int a = 0; a < 2; ++a)
#pragma unroll
        for (int b = 0; b < 2; ++b)
#pragma unroll
            for (int m = 0; m < 4; ++m)
#pragma unroll
                for (int n = 0; n < 2; ++n) acc[a][b][m][n] = (f32x4){0.f, 0.f, 0.f, 0.f};
    bf16x8 At[4][2], B0[2][2], B1[2][2];
    const char* cA = g.abase(cur); const char* cB = g.bbase(cur);
    S.a_ready(cur);
    if constexpr (SP2) {
        PG8_STAGE(PG8_SB(0, 0), cB, voffB); PG8_STAGE(PG8_SB(0, 1), cB + hstepB, voffB); PG8_STAGE(PG8_SA(0, 0), cA, voffA); PG8_STAGE(PG8_SA(0, 1), cA + hstepA, voffA);
        if (wr == 1) PG8_BAR;
        PG8_WAIT_V(2); PG8_BAR;
        PG8_STAGE(PG8_SB(1, 0), cB + kstep, voffB); PG8_STAGE(PG8_SA(1, 0), cA + kstep, voffA); PG8_STAGE(PG8_SB(1, 1), cB + hstepB + kstep, voffB);
        PG8_WAIT_V(6); PG8_BAR;
    } else {
        PG8_STAGE(PG8_SB(0, 0), cB, voffB); PG8_STAGE(PG8_SA(0, 0), cA, voffA); PG8_STAGE(PG8_SB(0, 1), cB + hstepB, voffB); PG8_STAGE(PG8_SA(0, 1), cA + hstepA, voffA);
        if (wr == 1) PG8_BAR;
        PG8_WAIT_V(4); PG8_BAR;
        PG8_STAGE(PG8_SB(1, 0), cB + kstep, voffB); PG8_STAGE(PG8_SA(1, 0), cA + kstep, voffA); PG8_STAGE(PG8_SB(1, 1), cB + hstepB + kstep, voffB);
        PG8_WAIT_V(6); PG8_BAR;
    }
    for (;;) {
        const bool has_next = S.next(ui + 1, nxt);
        const char* nA = has_next ? g.abase(nxt) : cA; const char* nB = has_next ? g.bbase(nxt) : cB;
#pragma nounroll
        for (int t = 0; t < nt; t += 2) {
            const bool last = (t == nt - 2);
            const char* a1 = cA + (size_t)(t + 1) * kstep;
            const char* a2 = last ? nA : cA + (size_t)(t + 2) * kstep; const char* b2 = last ? nB : cB + (size_t)(t + 2) * kstep;
            const char* a3 = a2 + kstep; const char* b3 = b2 + kstep;
            if (last && has_next) S.a_ready(nxt);
            if constexpr (SP2) {
            PG8_LDB(B0, 0, 0); PG8_LDB(B1, 0, 1); PG8_SCHED; PG8_LDA(At, 0, 0); PG8_STAGE(PG8_SA(1, 1), a1 + hstepA, voffA);
            PG8_WAIT_V(8); PG8_WAIT_L(0); PG8_BAR; PG8_MMA(0, 0, At, B0); PG8_MMA(0, 1, At, B1); PG8_BAR; PG8_SCHED;
            PG8_LDA(At, 0, 1); PG8_STAGE(PG8_SB(0, 0), b2, voffB); PG8_STAGE(PG8_SB(0, 1), b2 + hstepB, voffB); PG8_STAGE(PG8_SA(0, 0), a2, voffA);
            PG8_WAIT_V(8); PG8_WAIT_L(0); PG8_BAR; PG8_MMA(1, 0, At, B0); PG8_MMA(1, 1, At, B1); PG8_BAR; PG8_SCHED;
            PG8_LDB(B0, 1, 0); PG8_LDB(B1, 1, 1); PG8_SCHED; PG8_LDA(At, 1, 0); PG8_STAGE(PG8_SA(0, 1), a2 + hstepA, voffA);
            PG8_WAIT_V(8); PG8_WAIT_L(0); PG8_BAR; PG8_MMA(0, 0, At, B0); PG8_MMA(0, 1, At, B1); PG8_BAR; PG8_SCHED;
            PG8_LDA(At, 1, 1); PG8_STAGE(PG8_SB(1, 0), b3, voffB); PG8_STAGE(PG8_SB(1, 1), b3 + hstepB, voffB); PG8_STAGE(PG8_SA(1, 0), a3, voffA);
            PG8_WAIT_V(8); PG8_WAIT_L(0); PG8_BAR; PG8_MMA(1, 0, At, B0); PG8_MMA(1, 1, At, B1); PG8_BAR; PG8_SCHED;
            } else {
            PG8_LDB(B0, 0, 0); PG8_SCHED; PG8_LDA(At, 0, 0); PG8_STAGE(PG8_SA(1, 1), a1 + hstepA, voffA);
            PG8_WAIT_L(8); PG8_BAR; PG8_WAIT_L(0); PG8_MMA(0, 0, At, B0); PG8_BAR; PG8_SCHED;
            PG8_LDB(B1, 0, 1); PG8_STAGE(PG8_SB(0, 0), b2, voffB);
            PG8_BAR; PG8_WAIT_L(0); PG8_MMA(0, 1, At, B1); PG8_BAR;
            PG8_LDA(At, 0, 1); PG8_STAGE(PG8_SA(0, 0), a2, voffA);
            PG8_BAR; PG8_WAIT_L(0); PG8_MMA(1, 0, At, B0); PG8_BAR; PG8_SCHED;
            PG8_STAGE(PG8_SB(0, 1), b2 + hstepB, voffB);
            PG8_WAIT_V(6); PG8_BAR; PG8_MMA(1, 1, At, B1); PG8_BAR;
            PG8_LDB(B0, 1, 0); PG8_SCHED; PG8_LDA(At, 1, 0); PG8_STAGE(PG8_SA(0, 1), a2 + hstepA, voffA);
            PG8_WAIT_L(8); PG8_BAR; PG8_WAIT_L(0); PG8_MMA(0, 0, At, B0); PG8_BAR; PG8_SCHED;
            PG8_LDB(B1, 1, 1); PG8_STAGE(PG8_SB(1, 0), b3, voffB);
            PG8_BAR; PG8_WAIT_L(0); PG8_MMA(0, 1, At, B1); PG8_BAR;
            PG8_LDA(At, 1, 1); PG8_STAGE(PG8_SA(1, 0), a3, voffA);
            PG8_BAR; PG8_WAIT_L(0); PG8_MMA(1, 0, At, B0); PG8_BAR; PG8_SCHED;
            PG8_STAGE(PG8_SB(1, 1), b3 + hstepB, voffB);
            PG8_WAIT_V(6); PG8_BAR; PG8_MMA(1, 1, At, B1); PG8_BAR;
            }
        }
        if constexpr (ALIGN_EPI) { if (wr == 0) PG8_BAR; }
        E(acc, cur, wr, wc, fr, fq); S.done(cur);
        if (!has_next) break;
#pragma unroll
        for (int a = 0; a < 2; ++a)
#pragma unroll
            for (int b = 0; b < 2; ++b)
#pragma unroll
                for (int m = 0; m < 4; ++m)
#pragma unroll
                    for (int n = 0; n < 2; ++n) acc[a][b][m][n] = (f32x4){0.f, 0.f, 0.f, 0.f};
        cur = nxt; cA = nA; cB = nB; ++ui;
        if constexpr (ALIGN_EPI) { if (wr == 1) PG8_BAR; }
    }
    PG8_WAIT_V(0);
    if constexpr (!ALIGN_EPI) { if (wr == 0) PG8_BAR; }
    PG8_BAR;
#undef PG8_SA
#undef PG8_SB
#undef PG8_STAGE
#undef PG8_LDA
#undef PG8_LDB
#undef PG8_MMA
#undef PG8_WAIT_V
#undef PG8_WAIT_L
#undef PG8_BAR
#undef PG8_SCHED
}
}

constexpr int NWAVES = 8, NTHR = 512;
constexpr int DM = 1024, NBATCH = 16, SEQ = 4096, MALL = NBATCH * SEQ;
constexpr int NB_PASS = 4, MS = NB_PASS * SEQ, NPASS = NBATCH / NB_PASS;
constexpr int INW_SRC = 11272, INW = 11264;
constexpr int C_XA = 0, C_VA = 1024, C_OA = 2048, C_ZA = 3072, C_QA = 4096, C_KA = 5632, C_VT = 7168, C_ZB = 8704, C_GA = 9216, C_GB = 10240;
constexpr float EPS = 1e-6f;

constexpr size_t MiB = 1u << 20;
constexpr size_t WS_CTL = 0, CTL_ZERO_BYTES = 1 * MiB;
constexpr size_t WS_MOD = 1 * MiB;
constexpr size_t WS_WG = 1 * MiB + 256 * 1024;
constexpr size_t WS_WIN = 2 * MiB;
constexpr size_t WS_WQK = 24 * MiB;
constexpr size_t WS_WOM = 25 * MiB, WS_WOA = 27 * MiB, WS_WO = 28 * MiB;
constexpr size_t WS_IG = 30 * MiB, WS_FG = 31 * MiB;
constexpr size_t WS_GSC = 32 * MiB;
constexpr size_t WS_LSE = 34 * MiB;
constexpr size_t WS_H = 36 * MiB;
constexpr size_t WS_P = 164 * MiB;
constexpr size_t WS_XC = 516 * MiB;
constexpr size_t WS_QM = 548 * MiB, WS_KM = 580 * MiB;
constexpr size_t WS_HR = 612 * MiB;
constexpr size_t WS_AO = 644 * MiB;
constexpr size_t WS_UA = 692 * MiB;
constexpr size_t WS_T = 708 * MiB;
constexpr size_t WS_MG = 772 * MiB;
constexpr size_t WS_END = 804 * MiB;
constexpr int CW_QCTR = 1024;
constexpr int CW_ROWSS = 65536;
static_assert((CW_ROWSS + MALL) * 4 <= (int)CTL_ZERO_BYTES, "ctl");

constexpr int LDS_BYTES = 147456;

typedef unsigned short bf16;
typedef float f32x4 __attribute__((ext_vector_type(4)));
typedef float f32x2 __attribute__((ext_vector_type(2)));
typedef short bf16x8 __attribute__((ext_vector_type(8)));
typedef unsigned u32x4 __attribute__((ext_vector_type(4)));
typedef unsigned u32x2 __attribute__((ext_vector_type(2)));

__device__ __forceinline__ unsigned f2bf(float f) { unsigned u = __builtin_bit_cast(unsigned, f); return (u + 0x7fffu + ((u >> 16) & 1u)) >> 16; }
__device__ __forceinline__ unsigned pk2(float lo, float hi) { return f2bf(lo) | (f2bf(hi) << 16); }
__device__ __forceinline__ float bflo(unsigned w) { return __builtin_bit_cast(float, w << 16); }
__device__ __forceinline__ float bfhi(unsigned w) { return __builtin_bit_cast(float, w & 0xffff0000u); }
__device__ __forceinline__ float bf1(bf16 v) { return __builtin_bit_cast(float, (unsigned)v << 16); }
__device__ __forceinline__ float sigmoidf_(float x) { return 1.f / (1.f + __expf(-x)); }
__device__ __forceinline__ float siluf_(float x) { return x / (1.f + __expf(-x)); }
__device__ __forceinline__ float wave_sum(float v) {
#pragma unroll
    for (int o = 1; o < 64; o <<= 1) v += __shfl_xor(v, o);
    return v;
}
__device__ __forceinline__ void unpack8(const u32x4 w, float* f) {
    f[0] = bflo(w.x); f[1] = bfhi(w.x); f[2] = bflo(w.y); f[3] = bfhi(w.y); f[4] = bflo(w.z); f[5] = bfhi(w.z); f[6] = bflo(w.w); f[7] = bfhi(w.w);
}

struct Args {
    const float* x; const float* c; const int* pos; const float* w_ada; const float* b_ada; const float* g_norm; const float* w_in;
    const float* b_ig; const float* b_fg; const float* w_conv; const float* b_conv; const float* w_q; const float* w_k; const float* g_head;
    const float* skip; const float* w_om; const float* w_oa; const float* w_o; const float* g_final;
    float* out; unsigned char* ws; int ph_lo, ph_hi;
};

__device__ __forceinline__ void transpose_item(const float* W, int K, int Nsrc, int nblk, int src_col_off, bf16* WT, int ldt, int row_off, float scale, float* scr, int item, int lane) {
    const int kb = item / nblk, nb = item % nblk, k0 = 64 * kb, n0 = 32 * nb;
#pragma unroll 8
    for (int i = 0; i < 32; ++i) { const int kk = 2 * i + (lane >> 5); scr[kk * 33 + (lane & 31)] = W[(size_t)(k0 + kk) * Nsrc + src_col_off + n0 + (lane & 31)]; }
    __builtin_amdgcn_wave_barrier();
    asm volatile("s_waitcnt lgkmcnt(0)" ::: "memory");
    const int cc = lane & 7;
#pragma unroll
    for (int j = 0; j < 4; ++j) { const int n = (lane >> 3) + 8 * j; const float* s = scr + (8 * cc) * 33 + n;
        u32x4 o; o.x = pk2(s[0 * 33] * scale, s[1 * 33] * scale); o.y = pk2(s[2 * 33] * scale, s[3 * 33] * scale); o.z = pk2(s[4 * 33] * scale, s[5 * 33] * scale); o.w = pk2(s[6 * 33] * scale, s[7 * 33] * scale);
        *(u32x4*)(WT + (size_t)(row_off + n0 + n) * ldt + k0 + 8 * cc) = o; }
    asm volatile("s_waitcnt lgkmcnt(0)" ::: "memory");
    __builtin_amdgcn_wave_barrier();
}

__device__ __forceinline__ void phase_prologue(const Args& a, unsigned char* lds, int vcu, int G) {
    const int tid = threadIdx.x, lane = tid & 63, wave = tid >> 6;
    unsigned char* ws = a.ws;
    if (vcu < 48) {
        float* sc = (float*)lds;
        float* red = (float*)(lds + 65536);
        for (int i = tid; i < 16 * 1024; i += NTHR) sc[i] = siluf_(a.c[i]);
        __syncthreads();
        const int n = vcu * 64 + lane;
        float acc[16];
#pragma unroll
        for (int b = 0; b < 16; ++b) acc[b] = 0.f;
        const int k0 = wave * 128;
#pragma unroll 4
        for (int k = k0; k < k0 + 128; ++k) { const float w = a.w_ada[(size_t)k * 3072 + n];
#pragma unroll
            for (int b = 0; b < 16; ++b) acc[b] += sc[b * 1024 + k] * w; }
#pragma unroll
        for (int b = 0; b < 16; ++b) red[(wave * 16 + b) * 64 + lane] = acc[b];
        __syncthreads();
        float* mod = (float*)(ws + WS_MOD);
        for (int i = tid; i < 16 * 64; i += NTHR) { const int b = i >> 6, l = i & 63, nn = vcu * 64 + l; float s = 0.f;
#pragma unroll
            for (int w = 0; w < 8; ++w) s += red[(w * 16 + b) * 64 + l];
            s += a.b_ada[nn];
            const int part = nn >> 10, col = nn & 1023;
            if (part == 1) s = a.g_norm[col] * (1.f + s);
            mod[b * 3072 + nn] = s; }
        __syncthreads();
    }
    {
        float* scr = (float*)lds + wave * (64 * 33);
        const int gw = vcu * NWAVES + wave, NGW = G * NWAVES;
        constexpr int I_IN = (1024 / 64) * (INW / 32);
        constexpr int I_QK = 8 * (256 / 64) * (256 / 32);
        constexpr int I_OM = 16 * 32, I_OA = 8 * 32, I_O = 16 * 32;
        constexpr int NITEMS = I_IN + I_QK + I_OM + I_OA + I_O;
        for (int it = gw; it < NITEMS; it += NGW) {
            int r = it;
            if (r < I_IN) { const int nb = r % (INW / 32); const int off = (nb * 32 >= 4096) ? 8 : 0;
                transpose_item(a.w_in, 1024, INW_SRC, INW / 32, off, (bf16*)(ws + WS_WIN), 1024, 0, 1.f, scr, r, lane); continue; } r -= I_IN;
            if (r < I_QK) { const int mtx = r >> 5, rr = r & 31, h = mtx >> 1, isk = mtx & 1;
                const float* W = (isk ? a.w_k : a.w_q) + (size_t)h * 65536;
                transpose_item(W, 256, 256, 8, 0, (bf16*)(ws + WS_WQK) + (size_t)h * 512 * 256, 256, isk * 256, isk ? 0.0625f : 1.f, scr, rr, lane); continue; } r -= I_QK;
            if (r < I_OM) { transpose_item(a.w_om, 1024, 1024, 32, 0, (bf16*)(ws + WS_WOM), 1024, 0, 1.f, scr, r, lane); continue; } r -= I_OM;
            if (r < I_OA) { transpose_item(a.w_oa, 512, 1024, 32, 0, (bf16*)(ws + WS_WOA), 512, 0, 1.f, scr, r, lane); continue; } r -= I_OA;
            transpose_item(a.w_o, 1024, 1024, 32, 0, (bf16*)(ws + WS_WO), 1024, 0, 1.f, scr, r, lane);
        }
        float* wg = (float*)(ws + WS_WG);
        for (int i = (vcu * NTHR + tid); i < 8 * 1024; i += G * NTHR) { const int j = i >> 10, k = i & 1023; wg[i] = a.w_in[(size_t)k * INW_SRC + 4096 + j]; }
    }
}

__device__ __forceinline__ void phase_h(const Args& a, unsigned char* lds, int vcu, int G) {
    const int tid = threadIdx.x, lane = tid & 63, wave = tid >> 6;
    unsigned char* ws = a.ws;
    float* wg = (float*)lds;
    { const float* src = (const float*)(ws + WS_WG); for (int i = tid; i < 8192; i += NTHR) wg[i] = src[i]; }
    __syncthreads();
    const float* mod = (const float*)(ws + WS_MOD);
    bf16* H = (bf16*)(ws + WS_H);
    float* IG = (float*)(ws + WS_IG); float* FG = (float*)(ws + WS_FG);
    const int gw = vcu * NWAVES + wave, NGW = G * NWAVES;
    for (int row = gw; row < MALL; row += NGW) {
        const int b = row >> 12;
        const f32x4* xr = (const f32x4*)(a.x + (size_t)row * DM) + lane;
        f32x4 v[4]; float ss = 0.f;
#pragma unroll
        for (int j = 0; j < 4; ++j) { v[j] = xr[64 * j]; ss += (v[j].x * v[j].x + v[j].y * v[j].y) + (v[j].z * v[j].z + v[j].w * v[j].w); }
        ss = wave_sum(ss);
        const float rinv = 1.f / sqrtf(ss * (1.f / DM) + EPS);
        float pg[8];
#pragma unroll
        for (int g = 0; g < 8; ++g) pg[g] = 0.f;
        u32x2* ho = (u32x2*)(H + (size_t)row * DM) + lane;
#pragma unroll
        for (int j = 0; j < 4; ++j) {
            const int col = 4 * lane + 256 * j;
            const f32x4 sh = *(const f32x4*)(mod + b * 3072 + col), gs = *(const f32x4*)(mod + b * 3072 + 1024 + col);
            f32x4 h = v[j] * rinv * gs + sh;
#pragma unroll
            for (int g = 0; g < 8; ++g) { const f32x4 w = *(const f32x4*)(wg + g * 1024 + col); pg[g] += (h.x * w.x + h.y * w.y) + (h.z * w.z + h.w * w.w); }
            u32x2 o; o.x = pk2(h.x, h.y); o.y = pk2(h.z, h.w); ho[64 * j] = o;
        }
#pragma unroll
        for (int g = 0; g < 8; ++g) pg[g] = wave_sum(pg[g]);
        if (lane == 0) {
            f32x4 ig = {pg[0] + a.b_ig[0], pg[1] + a.b_ig[1], pg[2] + a.b_ig[2], pg[3] + a.b_ig[3]};
            f32x4 fg = {pg[4] + a.b_fg[0], pg[5] + a.b_fg[1], pg[6] + a.b_fg[2], pg[7] + a.b_fg[3]};
            *(f32x4*)(IG + (size_t)row * 4) = ig; *(f32x4*)(FG + (size_t)row * 4) = fg;
        }
    }
}

struct EpiProj {
    static constexpr bool PERM = true;
    bf16* P;
    __device__ __forceinline__ void operator()(const f32x4 (&acc)[2][2][4][2], const pg8::Unit& u, int wr, int wc, int fr, int fq) const {
        const int row0 = u.pm * 256 + wr * 64 + fr, col0 = u.pn * 256 + wc * 32 + 8 * fq;
#pragma unroll
        for (int ai = 0; ai < 2; ++ai)
#pragma unroll
            for (int m = 0; m < 4; ++m) { bf16* rowp = P + (size_t)(row0 + ai * 128 + m * 16) * INW + col0;
#pragma unroll
                for (int bj = 0; bj < 2; ++bj) { const f32x4 v0 = acc[ai][bj][m][0], v1 = acc[ai][bj][m][1];
                    u32x4 w; w.x = pg8::cvt_pk_bf16(v0[0], v0[1]); w.y = pg8::cvt_pk_bf16(v0[2], v0[3]); w.z = pg8::cvt_pk_bf16(v1[0], v1[1]); w.w = pg8::cvt_pk_bf16(v1[2], v1[3]);
                    *(u32x4*)(rowp + bj * 128) = w; } }
    }
};
struct EpiQK {
    static constexpr bool PERM = true;
    bf16* QM; bf16* KM;
    __device__ __forceinline__ void operator()(const f32x4 (&acc)[2][2][4][2], const pg8::Unit& u, int wr, int wc, int fr, int fq) const {
        const int row0 = u.pm * 256 + wr * 64 + fr, col0 = u.g * 256 + wc * 32 + 8 * fq;
        bf16* base = u.pn ? KM : QM;
#pragma unroll
        for (int ai = 0; ai < 2; ++ai)
#pragma unroll
            for (int m = 0; m < 4; ++m) { bf16* rowp = base + (size_t)(row0 + ai * 128 + m * 16) * 1024 + col0;
#pragma unroll
                for (int bj = 0; bj < 2; ++bj) { const f32x4 v0 = acc[ai][bj][m][0], v1 = acc[ai][bj][m][1];
                    u32x4 w; w.x = pg8::cvt_pk_bf16(v0[0], v0[1]); w.y = pg8::cvt_pk_bf16(v0[2], v0[3]); w.z = pg8::cvt_pk_bf16(v1[0], v1[1]); w.w = pg8::cvt_pk_bf16(v1[2], v1[3]);
                    *(u32x4*)(rowp + bj * 128) = w; } }
    }
};
template <int MODE> struct EpiMerge {
    static constexpr bool PERM = true;
    const bf16* P; float* T; bf16* MG;
    __device__ __forceinline__ void operator()(const f32x4 (&acc)[2][2][4][2], const pg8::Unit& u, int wr, int wc, int fr, int fq) const {
        const int row0 = u.pm * 256 + wr * 64 + fr, col0 = u.pn * 256 + wc * 32 + 8 * fq;
#pragma unroll
        for (int ai = 0; ai < 2; ++ai)
#pragma unroll
            for (int m = 0; m < 4; ++m) { const size_t r = (size_t)(row0 + ai * 128 + m * 16);
#pragma unroll
                for (int bj = 0; bj < 2; ++bj) { const int c = col0 + bj * 128;
                    const u32x4 gw = *(const u32x4*)(P + r * INW + (MODE == 0 ? C_GA : C_GB) + c); float gg[8]; unpack8(gw, gg);
                    const f32x4 v0 = acc[ai][bj][m][0], v1 = acc[ai][bj][m][1];
                    float o[8];
#pragma unroll
                    for (int e = 0; e < 4; ++e) { o[e] = sigmoidf_(gg[e]) * v0[e]; o[4 + e] = sigmoidf_(gg[4 + e]) * v1[e]; }
                    float* tp = T + r * 1024 + c;
                    if (MODE == 0) { *(f32x4*)tp = (f32x4){o[0], o[1], o[2], o[3]}; *(f32x4*)(tp + 4) = (f32x4){o[4], o[5], o[6], o[7]}; }
                    else { const f32x4 t0 = *(const f32x4*)tp, t1 = *(const f32x4*)(tp + 4);
                        u32x4 w; w.x = pg8::cvt_pk_bf16(t0[0] + o[0], t0[1] + o[1]); w.y = pg8::cvt_pk_bf16(t0[2] + o[2], t0[3] + o[3]);
                        w.z = pg8::cvt_pk_bf16(t1[0] + o[4], t1[1] + o[5]); w.w = pg8::cvt_pk_bf16(t1[2] + o[6], t1[3] + o[7]);
                        *(u32x4*)(MG + r * 1024 + c) = w; } } }
    }
};
struct EpiOut {
    static constexpr bool PERM = true;
    const float* x; float* out; const float* gate; float* rowss; int grow0;
    __device__ __forceinline__ void operator()(const f32x4 (&acc)[2][2][4][2], const pg8::Unit& u, int wr, int wc, int fr, int fq) const {
        const int row0 = grow0 + u.pm * 256 + wr * 64 + fr, col0 = u.pn * 256 + wc * 32 + 8 * fq;
#pragma unroll
        for (int ai = 0; ai < 2; ++ai)
#pragma unroll
            for (int m = 0; m < 4; ++m) { const int r = row0 + ai * 128 + m * 16; const int b = r >> 12; float ss = 0.f;
#pragma unroll
                for (int bj = 0; bj < 2; ++bj) { const int c = col0 + bj * 128;
                    const float* gp = gate + b * 3072 + c; const f32x4 g0 = *(const f32x4*)gp, g1 = *(const f32x4*)(gp + 4);
                    const float* xp = x + (size_t)r * 1024 + c; const f32x4 x0 = *(const f32x4*)xp, x1 = *(const f32x4*)(xp + 4);
                    const f32x4 o0 = x0 + g0 * acc[ai][bj][m][0], o1 = x1 + g1 * acc[ai][bj][m][1];
                    ss += (o0[0] * o0[0] + o0[1] * o0[1]) + (o0[2] * o0[2] + o0[3] * o0[3]) + (o1[0] * o1[0] + o1[1] * o1[1]) + (o1[2] * o1[2] + o1[3] * o1[3]);
                    float* op = out + (size_t)r * 1024 + c; *(f32x4*)op = o0; *(f32x4*)(op + 4) = o1; }
                ss += __shfl_xor(ss, 16); ss += __shfl_xor(ss, 32);
                if (fq == 0) atomicAdd(rowss + r, ss); }
    }
};

__constant__ double c_inv_freq[16] = {1.0, 0.44036660267178046, 0.19392274474868576, 0.08539710028576561, 0.03760603093086393, 0.016560440080994446, 0.007292664737217109, 0.003211445994752591,
    0.001414213562373095, 0.000622772421914596, 0.0002742481756762073, 0.00012076973741146504, 5.318295896944988e-05, 2.341999896140934e-05, 1.031338537721246e-05, 4.5416704806078695e-06};

__device__ __forceinline__ void phase_prep(const Args& a, unsigned char* lds, int vcu, int G, int pass) {
    const int tid = threadIdx.x, lane = tid & 63, wave = tid >> 6;
    unsigned char* ws = a.ws;
    bf16* P = (bf16*)(ws + WS_P);
    {
        const int gw = vcu * NWAVES + wave;
        if (gw < NB_PASS * 4) {
            const int bl = gw >> 2, h = gw & 3;
            const float* IG = (const float*)(ws + WS_IG); const float* FG = (const float*)(ws + WS_FG);
            float* gsc = (float*)(ws + WS_GSC);
            float* A1 = gsc, *B1 = gsc + MS * 4, *WI = gsc + 2 * MS * 4, *EF = gsc + 3 * MS * 4, *WK = gsc + 4 * MS * 4, *DEC = gsc + 5 * MS * 4;
            float m_prev = 0.f;
            for (int j = 0; j < 64; ++j) {
                const int lrow = bl * SEQ + j * 64 + lane; const size_t grow = (size_t)pass * MS + lrow;
                const float f = FG[grow * 4 + h], ii = IG[grow * 4 + h];
                const float ls = fminf(f, 0.f) - log1pf(expf(-fabsf(f)));
                float acs = ls;
#pragma unroll
                for (int o = 1; o < 64; o <<= 1) { const float t = __shfl_up(acs, o); if (lane >= o) acs += t; }
                const float b1 = ii - acs;
                float pm = b1;
#pragma unroll
                for (int o = 1; o < 64; o <<= 1) { const float t = __shfl_up(pm, o); if (lane >= o) pm = fmaxf(pm, t); }
                const float g = __shfl(acs, 63), pm63 = __shfl(pm, 63);
                const float mx = fmaxf(m_prev, pm);
                const float Ms = fmaxf(m_prev, pm63);
                A1[lrow * 4 + h] = -mx; B1[lrow * 4 + h] = b1; WI[lrow * 4 + h] = expf(m_prev - mx); EF[lrow * 4 + h] = expf(-(acs + mx)); WK[lrow * 4 + h] = expf(b1 - Ms);
                if (lane == 0) DEC[(bl * 64 + j) * 4 + h] = expf(m_prev - Ms);
                m_prev = g + Ms;
            }
        }
    }
    {
        bf16* XC = (bf16*)(ws + WS_XC);
        const int cg8 = (tid & 127) * 8, rq = tid >> 7;
        float wc[4][8], bc[8];
#pragma unroll
        for (int j = 0; j < 4; ++j)
#pragma unroll
            for (int e = 0; e < 8; ++e) wc[j][e] = a.w_conv[j * 1024 + cg8 + e];
#pragma unroll
        for (int e = 0; e < 8; ++e) bc[e] = a.b_conv[cg8 + e];
        for (int it = vcu; it < MS / 64; it += G) {
            const int r0 = it * 64 + rq * 16;
            float h0[8], h1[8], h2[8];
#pragma unroll
            for (int e = 0; e < 8; ++e) { h0[e] = 0.f; h1[e] = 0.f; h2[e] = 0.f; }
            const int t0 = r0 & (SEQ - 1);
            if (t0 >= 3) { u32x4 w;
                w = *(const u32x4*)(P + (size_t)(r0 - 3) * INW + C_XA + cg8); unpack8(w, h0);
                w = *(const u32x4*)(P + (size_t)(r0 - 2) * INW + C_XA + cg8); unpack8(w, h1);
                w = *(const u32x4*)(P + (size_t)(r0 - 1) * INW + C_XA + cg8); unpack8(w, h2); }
            for (int rr = 0; rr < 16; ++rr) {
                const int r = r0 + rr; float cur[8];
                const u32x4 w = *(const u32x4*)(P + (size_t)r * INW + C_XA + cg8); unpack8(w, cur);
                float o[8];
#pragma unroll
                for (int e = 0; e < 8; ++e) { const float y = bc[e] + wc[0][e] * h0[e] + wc[1][e] * h1[e] + wc[2][e] * h2[e] + wc[3][e] * cur[e]; o[e] = siluf_(y); h0[e] = h1[e]; h1[e] = h2[e]; h2[e] = cur[e]; }
                u32x4 ov; ov.x = pk2(o[0], o[1]); ov.y = pk2(o[2], o[3]); ov.z = pk2(o[4], o[5]); ov.w = pk2(o[6], o[7]);
                *(u32x4*)(XC + (size_t)r * 1024 + cg8) = ov;
            }
        }
    }
    {
        for (int r = vcu * NWAVES + wave; r < MS; r += G * NWAVES) {
            if (lane < 48) {
                const int hd = lane >> 1, half = lane & 1;
                const size_t grow = (size_t)pass * MS + r;
                const int pos = a.pos[grow];
                bf16* base = P + (size_t)r * INW + (hd < 12 ? C_QA + hd * 128 : C_KA + (hd - 12) * 128) + 8 * half;
                u32x4 w1 = *(const u32x4*)base, w2 = *(const u32x4*)(base + 16);
                float x1[8], x2[8]; unpack8(w1, x1); unpack8(w2, x2);
                float o1[8], o2[8];
#pragma unroll
                for (int e = 0; e < 8; ++e) {
                    const double rev = (double)pos * c_inv_freq[8 * half + e] * 0.15915494309189535;
                    const float fr = (float)(rev - rint(rev));
                    const float cs = __builtin_amdgcn_cosf(fr), sn = __builtin_amdgcn_sinf(fr);
                    o1[e] = x1[e] * cs - x2[e] * sn; o2[e] = x2[e] * cs + x1[e] * sn;
                }
                u32x4 v1, v2; v1.x = pk2(o1[0], o1[1]); v1.y = pk2(o1[2], o1[3]); v1.z = pk2(o1[4], o1[5]); v1.w = pk2(o1[6], o1[7]);
                v2.x = pk2(o2[0], o2[1]); v2.y = pk2(o2[2], o2[3]); v2.z = pk2(o2[4], o2[5]); v2.w = pk2(o2[6], o2[7]);
                *(u32x4*)base = v1; *(u32x4*)(base + 16) = v2;
            }
        }
    }
}

__device__ __forceinline__ f32x4 mfma16(bf16x8 a, bf16x8 b, f32x4 c) { return __builtin_amdgcn_mfma_f32_16x16x32_bf16(a, b, c, 0, 0, 0); }

constexpr int CBS = 264, VTS = 72, KTS = 72, SBS = 72;
constexpr int L_CB = 0;
constexpr int L_VT = L_CB + 64 * CBS * 2;
constexpr int L_KT = L_VT + 64 * VTS * 2;
constexpr int L_SB = L_KT + 256 * KTS * 2;
constexpr int L_NV = L_SB + 64 * SBS * 2;
constexpr int L_DEN = L_NV + 1024;
constexpr int L_DENF = L_DEN + 256;
constexpr int L_SC = L_DENF + 256;
constexpr int L_SCAN_END = L_SC + 5 * 256;
static_assert(L_SCAN_END <= 131072, "scan lds");

__device__ __forceinline__ void scan_item(const Args& a, unsigned char* lds, int item) {
    const int tid = threadIdx.x, lane = tid & 63, wave = __builtin_amdgcn_readfirstlane(tid >> 6);
    const int fr = lane & 15, fq = lane >> 4;
    unsigned char* ws = a.ws;
    const int bl = item >> 4, h = (item >> 2) & 3, es = item & 3;
    const bf16* P = (const bf16*)(ws + WS_P); const bf16* QM = (const bf16*)(ws + WS_QM); const bf16* KM = (const bf16*)(ws + WS_KM);
    bf16* HR = (bf16*)(ws + WS_HR);
    const float* gsc = (const float*)(ws + WS_GSC);
    const float* gA1 = gsc, *gB1 = gsc + MS * 4, *gWI = gsc + 2 * MS * 4, *gEF = gsc + 3 * MS * 4, *gWK = gsc + 4 * MS * 4, *gDEC = gsc + 5 * MS * 4;
    bf16* Cb = (bf16*)(lds + L_CB); bf16* VT = (bf16*)(lds + L_VT); bf16* KT = (bf16*)(lds + L_KT); bf16* Sb = (bf16*)(lds + L_SB);
    float* NV = (float*)(lds + L_NV); float* DEN = (float*)(lds + L_DEN); float* DENF = (float*)(lds + L_DENF); float* SC = (float*)(lds + L_SC);
    for (int i = tid; i < 64 * CBS / 2; i += NTHR) ((unsigned*)Cb)[i] = 0u;
    if (tid < 256) NV[tid] = 0.f;
    f32x4 Cacc[2][4];
#pragma unroll
    for (int x = 0; x < 2; ++x)
#pragma unroll
        for (int y = 0; y < 4; ++y) Cacc[x][y] = (f32x4){0.f, 0.f, 0.f, 0.f};
    const int ti = wave >> 1, tj0 = 2 * (wave & 1);
    for (int j = 0; j < 64; ++j) {
        const int t0 = bl * SEQ + j * 64;
        const float decay = gDEC[(bl * 64 + j) * 4 + h];
        __syncthreads();
        if (tid < 320) { const int which = tid >> 6, l = tid & 63; const float* src = which == 0 ? gA1 : which == 1 ? gB1 : which == 2 ? gWI : which == 3 ? gEF : gWK; SC[which * 64 + l] = src[(t0 + l) * 4 + h]; }
        if (tid < 64) DEN[tid] = 0.f;
        { const int l = tid & 63, ec = tid >> 6;
          const u32x4 w = *(const u32x4*)(P + (size_t)(t0 + l) * INW + C_VA + h * 256 + es * 64 + 8 * ec);
          bf16* d = VT + (8 * ec) * VTS + l;
          d[0 * VTS] = (bf16)(w.x & 0xffff); d[1 * VTS] = (bf16)(w.x >> 16); d[2 * VTS] = (bf16)(w.y & 0xffff); d[3 * VTS] = (bf16)(w.y >> 16);
          d[4 * VTS] = (bf16)(w.z & 0xffff); d[5 * VTS] = (bf16)(w.z >> 16); d[6 * VTS] = (bf16)(w.w & 0xffff); d[7 * VTS] = (bf16)(w.w >> 16); }
#pragma unroll
        for (int i = 0; i < 4; ++i) { const int c = tid + NTHR * i, l = c & 63, dc = c >> 6;
          const u32x4 w = *(const u32x4*)(KM + (size_t)(t0 + l) * 1024 + h * 256 + 8 * dc); float kv[8]; unpack8(w, kv);
          const float wk = gWK[(t0 + l) * 4 + h];
          bf16* d = KT + (8 * dc) * KTS + l;
#pragma unroll
          for (int e = 0; e < 8; ++e) d[e * KTS] = (bf16)f2bf(kv[e] * wk); }
        bf16x8 qf[8];
#pragma unroll
        for (int ks = 0; ks < 8; ++ks) qf[ks] = *(const bf16x8*)(QM + (size_t)(t0 + 16 * ti + fr) * 1024 + h * 256 + 32 * ks + 8 * fq);
        __syncthreads();
#pragma unroll
        for (int tt = 0; tt < 2; ++tt) {
            const int tj = tj0 + tt;
            f32x4 sacc = {0.f, 0.f, 0.f, 0.f};
            if (tj <= ti) {
#pragma unroll
                for (int ks = 0; ks < 8; ++ks) { const bf16x8 kf = *(const bf16x8*)(KM + (size_t)(t0 + 16 * tj + fr) * 1024 + h * 256 + 32 * ks + 8 * fq); sacc = mfma16(qf[ks], kf, sacc); }
            }
            const int s = 16 * tj + fr; const float b1s = SC[64 + s];
#pragma unroll
            for (int i = 0; i < 4; ++i) { const int l = 16 * ti + 4 * fq + i;
                float v = 0.f;
                if (s <= l) v = sacc[i] * __expf(SC[l] + b1s);
                Sb[l * SBS + s] = (bf16)f2bf(v);
                float rs = v; rs += __shfl_xor(rs, 1); rs += __shfl_xor(rs, 2); rs += __shfl_xor(rs, 4); rs += __shfl_xor(rs, 8);
                if (fr == 0 && tj <= ti) atomicAdd(&DEN[l], rs); }
        }
        __syncthreads();
        {
#pragma unroll
            for (int rr = 0; rr < 8; ++rr) { const int l = 8 * wave + rr;
                const u32x2 qw = *(const u32x2*)(QM + (size_t)(t0 + l) * 1024 + h * 256 + 4 * lane);
                const f32x4 nv = *(const f32x4*)(NV + 4 * lane);
                float p = bflo(qw.x) * nv.x + bfhi(qw.x) * nv.y + bflo(qw.y) * nv.z + bfhi(qw.y) * nv.w;
                p = wave_sum(p);
                if (lane == 0) DENF[l] = DEN[l] + SC[128 + l] * p; }
        }
        __syncthreads();
#pragma unroll
        for (int tt = 0; tt < 2; ++tt) {
            const int ej = tj0 + tt;
            f32x4 a1 = {0.f, 0.f, 0.f, 0.f}, a2 = {0.f, 0.f, 0.f, 0.f};
#pragma unroll
            for (int k2 = 0; k2 < 2; ++k2) { const bf16x8 sa = *(const bf16x8*)(Sb + (16 * ti + fr) * SBS + 32 * k2 + 8 * fq); const bf16x8 vb = *(const bf16x8*)(VT + (16 * ej + fr) * VTS + 32 * k2 + 8 * fq); a1 = mfma16(sa, vb, a1); }
#pragma unroll
            for (int ks = 0; ks < 8; ++ks) { const bf16x8 cb = *(const bf16x8*)(Cb + (16 * ej + fr) * CBS + 32 * ks + 8 * fq); a2 = mfma16(qf[ks], cb, a2); }
#pragma unroll
            for (int i = 0; i < 4; ++i) { const int l = 16 * ti + 4 * fq + i;
                const float num = a1[i] + SC[128 + l] * a2[i];
                const float den = fmaxf(fabsf(DENF[l]), SC[192 + l]);
                HR[(size_t)(t0 + l) * 1024 + h * 256 + es * 64 + 16 * ej + fr] = (bf16)f2bf(num / den); }
        }
        __syncthreads();
#pragma unroll
        for (int dt = 0; dt < 2; ++dt)
#pragma unroll
            for (int et = 0; et < 4; ++et) {
                f32x4 c = Cacc[dt][et] * decay;
#pragma unroll
                for (int k2 = 0; k2 < 2; ++k2) { const bf16x8 ka = *(const bf16x8*)(KT + (32 * wave + 16 * dt + fr) * KTS + 32 * k2 + 8 * fq); const bf16x8 vb = *(const bf16x8*)(VT + (16 * et + fr) * VTS + 32 * k2 + 8 * fq); c = mfma16(ka, vb, c); }
                Cacc[dt][et] = c;
                u32x2 o; o.x = pk2(c[0], c[1]); o.y = pk2(c[2], c[3]);
                *(u32x2*)(Cb + (16 * et + fr) * CBS + 32 * wave + 16 * dt + 4 * fq) = o;
            }
        if (tid < 256) { float s = 0.f; const bf16* kr = KT + tid * KTS;
#pragma unroll 8
            for (int l = 0; l < 64; ++l) s += bf1(kr[l]);
            NV[tid] = decay * NV[tid] + s; }
    }
    __syncthreads();
}

constexpr int AKS = 136;
constexpr int L_AK = 0, L_AV = L_AK + 128 * AKS * 2, L_AP = L_AV + 128 * AKS * 2, L_ATT_END = L_AP + 8 * 16 * AKS * 2;
static_assert(L_ATT_END <= 131072, "attn lds");

__device__ __forceinline__ void attn_item(const Args& a, unsigned char* lds, int item) {
    const int tid = threadIdx.x, lane = tid & 63, wave = __builtin_amdgcn_readfirstlane(tid >> 6);
    const int fr = lane & 15, fq = lane >> 4;
    unsigned char* ws = a.ws;
    const int blk = item & 31, hh = (item >> 5) & 3, bl = (item >> 7) & 3, g = item >> 9;
    const int dil = g == 0 ? 1 : g == 1 ? 4 : 16, nb = 32 / dil;
    const int r = blk / nb, n = blk % nb;
    const bf16* P = (const bf16*)(ws + WS_P);
    const int H = 4 * g + hh;
    const bf16* Qb = P + C_QA + H * 128; const bf16* Kb = P + C_KA + H * 128; const bf16* Vb = P + C_VT + H * 128;
    bf16* Ks = (bf16*)(lds + L_AK); bf16* VTs = (bf16*)(lds + L_AV); bf16* Pw = (bf16*)(lds + L_AP) + wave * 16 * AKS;
    const int rowbase = bl * SEQ + r;
    bf16x8 qf[4];
    { const size_t qrow = (size_t)(rowbase + (128 * n + 16 * wave + fr) * dil);
#pragma unroll
      for (int ks = 0; ks < 4; ++ks) qf[ks] = *(const bf16x8*)(Qb + qrow * INW + 32 * ks + 8 * fq); }
    f32x4 O[8];
#pragma unroll
    for (int i = 0; i < 8; ++i) O[i] = (f32x4){0.f, 0.f, 0.f, 0.f};
    float mrow[4], lrow[4];
#pragma unroll
    for (int i = 0; i < 4; ++i) { mrow[i] = -INFINITY; lrow[i] = 0.f; }
    const float scale = 0.08838834764831845f;
    for (int half = (n == 0 ? 1 : 0); half < 2; ++half) {
        const int ku0 = 128 * (n - 1 + half);
        __syncthreads();
#pragma unroll
        for (int i = 0; i < 4; ++i) { const int c = tid + NTHR * i, key = c & 127, dc = c >> 7;
            const size_t krow = (size_t)(rowbase + (ku0 + key) * dil);
            const u32x4 kw = *(const u32x4*)(Kb + krow * INW + 8 * dc);
            *(u32x4*)(Ks + key * AKS + 8 * dc) = kw;
            const u32x4 w = *(const u32x4*)(Vb + krow * INW + 8 * dc);
            bf16* d = VTs + (8 * dc) * AKS + key;
            d[0 * AKS] = (bf16)(w.x & 0xffff); d[1 * AKS] = (bf16)(w.x >> 16); d[2 * AKS] = (bf16)(w.y & 0xffff); d[3 * AKS] = (bf16)(w.y >> 16);
            d[4 * AKS] = (bf16)(w.z & 0xffff); d[5 * AKS] = (bf16)(w.z >> 16); d[6 * AKS] = (bf16)(w.w & 0xffff); d[7 * AKS] = (bf16)(w.w >> 16); }
        __syncthreads();
        f32x4 S[8];
#pragma unroll
        for (int kt = 0; kt < 8; ++kt) { f32x4 s = {0.f, 0.f, 0.f, 0.f};
#pragma unroll
            for (int ks = 0; ks < 4; ++ks) { const bf16x8 kf = *(const bf16x8*)(Ks + (16 * kt + fr) * AKS + 32 * ks + 8 * fq); s = mfma16(qf[ks], kf, s); }
            S[kt] = s; }
        float mx[4];
#pragma unroll
        for (int i = 0; i < 4; ++i) mx[i] = -INFINITY;
#pragma unroll
        for (int kt = 0; kt < 8; ++kt)
#pragma unroll
            for (int i = 0; i < 4; ++i) { const int p = 16 * wave + 4 * fq + i, kk = 16 * kt + fr;
                const bool ok = half == 0 ? (kk >= p) : (kk <= p);
                const float v = ok ? S[kt][i] * scale : -INFINITY; S[kt][i] = v; mx[i] = fmaxf(mx[i], v); }
        float alpha[4], rs[4];
#pragma unroll
        for (int i = 0; i < 4; ++i) { float m = mx[i]; m = fmaxf(m, __shfl_xor(m, 1)); m = fmaxf(m, __shfl_xor(m, 2)); m = fmaxf(m, __shfl_xor(m, 4)); m = fmaxf(m, __shfl_xor(m, 8));
            const float mn = fmaxf(mrow[i], m); alpha[i] = __expf(mrow[i] - mn); mrow[i] = mn; rs[i] = 0.f; }
#pragma unroll
        for (int kt = 0; kt < 8; ++kt)
#pragma unroll
            for (int i = 0; i < 4; ++i) { const float p = __expf(S[kt][i] - mrow[i]); rs[i] += p; Pw[(4 * fq + i) * AKS + 16 * kt + fr] = (bf16)f2bf(p); }
#pragma unroll
        for (int i = 0; i < 4; ++i) { float s = rs[i]; s += __shfl_xor(s, 1); s += __shfl_xor(s, 2); s += __shfl_xor(s, 4); s += __shfl_xor(s, 8); lrow[i] = lrow[i] * alpha[i] + s; }
#pragma unroll
        for (int dtile = 0; dtile < 8; ++dtile)
#pragma unroll
            for (int i = 0; i < 4; ++i) O[dtile][i] *= alpha[i];
        __builtin_amdgcn_wave_barrier();
        asm volatile("s_waitcnt lgkmcnt(0)" ::: "memory");
#pragma unroll
        for (int ks = 0; ks < 4; ++ks) { const bf16x8 pa = *(const bf16x8*)(Pw + fr * AKS + 32 * ks + 8 * fq);
#pragma unroll
            for (int dtile = 0; dtile < 8; ++dtile) { const bf16x8 vb = *(const bf16x8*)(VTs + (16 * dtile + fr) * AKS + 32 * ks + 8 * fq); O[dtile] = mfma16(pa, vb, O[dtile]); } }
    }
    bf16* AO = (bf16*)(ws + WS_AO) + (size_t)g * MS * 512; float* LSE = (float*)(ws + WS_LSE) + (size_t)g * MS * 4;
#pragma unroll
    for (int i = 0; i < 4; ++i) { const size_t row = (size_t)(rowbase + (128 * n + 16 * wave + 4 * fq + i) * dil); const float inv = 1.f / lrow[i];
#pragma unroll
        for (int dtile = 0; dtile < 8; ++dtile) AO[row * 512 + hh * 128 + 16 * dtile + fr] = (bf16)f2bf(O[dtile][i] * inv);
        if (fr == 0) LSE[row * 4 + hh] = mrow[i] + logf(lrow[i]); }
    __syncthreads();
}

constexpr int N_SCAN_ITEMS = NB_PASS * 16, N_ATT_ITEMS = 3 * NB_PASS * 4 * 32;
__device__ __forceinline__ void phase_mix(const Args& a, unsigned char* lds, int pass) {
    unsigned* qctr = (unsigned*)(a.ws + WS_CTL) + CW_QCTR + 64 * pass;
    volatile int* slot = (volatile int*)(lds + 131072 + 1024);
    for (;;) {
        __syncthreads();
        if (threadIdx.x == 0) *slot = (int)atomicAdd(qctr, 1u);
        __syncthreads();
        const int item = *slot;
        if (item >= N_SCAN_ITEMS + N_ATT_ITEMS) break;
        if (item < N_SCAN_ITEMS) scan_item(a, lds, item); else attn_item(a, lds, item - N_SCAN_ITEMS);
    }
}

__device__ __forceinline__ void phase_post(const Args& a, int vcu, int G) {
    const int tid = threadIdx.x, lane = tid & 63, wave = tid >> 6;
    unsigned char* ws = a.ws;
    const bf16* P = (const bf16*)(ws + WS_P); const bf16* XC = (const bf16*)(ws + WS_XC); bf16* HR = (bf16*)(ws + WS_HR);
    const bf16* AO = (const bf16*)(ws + WS_AO); const float* LSE = (const float*)(ws + WS_LSE); bf16* UA = (bf16*)(ws + WS_UA);
    for (int r = vcu * NWAVES + wave; r < MS; r += G * NWAVES) {
#pragma unroll
        for (int h = 0; h < 4; ++h) {
            const int c = h * 256 + 4 * lane;
            const u32x2 hw = *(const u32x2*)(HR + (size_t)r * 1024 + c), ow = *(const u32x2*)(P + (size_t)r * INW + C_OA + c), zw = *(const u32x2*)(P + (size_t)r * INW + C_ZA + c), xw = *(const u32x2*)(XC + (size_t)r * 1024 + c);
            float hm[4] = {sigmoidf_(bflo(ow.x)) * bflo(hw.x), sigmoidf_(bfhi(ow.x)) * bfhi(hw.x), sigmoidf_(bflo(ow.y)) * bflo(hw.y), sigmoidf_(bfhi(ow.y)) * bfhi(hw.y)};
            float ss = (hm[0] * hm[0] + hm[1] * hm[1]) + (hm[2] * hm[2] + hm[3] * hm[3]);
            ss = wave_sum(ss);
            const float rinv = 1.f / sqrtf(ss * (1.f / 256.f) + EPS);
            const f32x4 gh = *(const f32x4*)(a.g_head + c), sk = *(const f32x4*)(a.skip + c);
            const float xc[4] = {bflo(xw.x), bfhi(xw.x), bflo(xw.y), bfhi(xw.y)}, za[4] = {bflo(zw.x), bfhi(zw.x), bflo(zw.y), bfhi(zw.y)};
            float o[4];
#pragma unroll
            for (int e = 0; e < 4; ++e) o[e] = (hm[e] * rinv * gh[e] + sk[e] * xc[e]) * siluf_(za[e]);
            u32x2 ov; ov.x = pk2(o[0], o[1]); ov.y = pk2(o[2], o[3]);
            *(u32x2*)(HR + (size_t)r * 1024 + c) = ov;
        }
#pragma unroll
        for (int hh = 0; hh < 4; ++hh) {
            const float l0 = LSE[(size_t)r * 4 + hh], l1 = LSE[(size_t)(MS + r) * 4 + hh], l2 = LSE[(size_t)(2 * MS + r) * 4 + hh];
            const float mx = fmaxf(l0, fmaxf(l1, l2));
            float w0 = __expf(l0 - mx), w1 = __expf(l1 - mx), w2 = __expf(l2 - mx); const float inv = 1.f / (w0 + w1 + w2); w0 *= inv; w1 *= inv; w2 *= inv;
            const int c = hh * 128 + 2 * lane;
            const unsigned o0 = *(const unsigned*)(AO + (size_t)r * 512 + c), o1 = *(const unsigned*)(AO + ((size_t)MS + r) * 512 + c), o2 = *(const unsigned*)(AO + ((size_t)2 * MS + r) * 512 + c);
            const unsigned zb = *(const unsigned*)(P + (size_t)r * INW + C_ZB + c);
            const float va = (w0 * bflo(o0) + w1 * bflo(o1) + w2 * bflo(o2)) * siluf_(bflo(zb));
            const float vb = (w0 * bfhi(o0) + w1 * bfhi(o1) + w2 * bfhi(o2)) * siluf_(bfhi(zb));
            *(unsigned*)(UA + (size_t)r * 512 + c) = pk2(va, vb);
        }
    }
}

__device__ __forceinline__ void phase_norm(const Args& a, int vcu, int G) {
    const int tid = threadIdx.x, lane = tid & 63, wave = tid >> 6;
    const float* rowss = (const float*)(a.ws + WS_CTL) + CW_ROWSS;
    for (int r = vcu * NWAVES + wave; r < MALL; r += G * NWAVES) {
        const float rinv = 1.f / sqrtf(rowss[r] * (1.f / DM) + EPS);
        f32x4* o = (f32x4*)(a.out + (size_t)r * DM) + lane;
#pragma unroll
        for (int j = 0; j < 4; ++j) { const f32x4 gf = *((const f32x4*)a.g_final + lane + 64 * j); o[64 * j] = o[64 * j] * rinv * gf; }
    }
}

constexpr int PH_PER_PASS = 7, PH_TOTAL = 2 + PH_PER_PASS * NPASS + 1;
enum { K_PROLOGUE = 0, K_H = 1, K_INPROJ = 2, K_PREP = 3, K_QK = 4, K_MIX = 5, K_POST = 6, K_OUT1 = 7, K_OUT2 = 8, K_NORM = 9 };

template <int KIND>
__device__ __forceinline__ void run_phase(const Args& args, unsigned char* lds, int pass) {
    const int G = gridDim.x; const int bx = blockIdx.x;
    const int vcu = (G % 8 == 0) ? (bx % 8) * (G / 8) + bx / 8 : bx;
    unsigned char* ws = args.ws;
    PG8_LAS unsigned char* lds3 = (PG8_LAS unsigned char*)lds;
    if constexpr (KIND == K_PROLOGUE) phase_prologue(args, lds, vcu, G);
    else if constexpr (KIND == K_H) phase_h(args, lds, vcu, G);
    else if constexpr (KIND == K_NORM) phase_norm(args, vcu, G);
    else if constexpr (KIND == K_INPROJ) {
        pg8::Gemm<1024, 1024, 1024> g{(const bf16*)(ws + WS_H) + (size_t)pass * MS * 1024, (const bf16*)(ws + WS_WIN)};
        pg8::StaticOrder S; S.init(MS, INW, G, bx);
        EpiProj E{(bf16*)(ws + WS_P)};
        pg8::gemm_phase<EpiProj, pg8::StaticOrder, true, true>(lds3, g, S, E);
    } else if constexpr (KIND == K_PREP) phase_prep(args, lds, vcu, G, pass);
    else if constexpr (KIND == K_QK) {
        pg8::Gemm<1024, 256, 256, 512, 512 * 256 * 2> g{(const bf16*)(ws + WS_XC), (const bf16*)(ws + WS_WQK)};
        pg8::GroupOrder S; S.init(MS, G, bx);
        EpiQK E{(bf16*)(ws + WS_QM), (bf16*)(ws + WS_KM)};
        pg8::gemm_phase<EpiQK, pg8::GroupOrder, true, true>(lds3, g, S, E);
    } else if constexpr (KIND == K_MIX) phase_mix(args, lds, pass);
    else if constexpr (KIND == K_POST) phase_post(args, vcu, G);
    else if constexpr (KIND == K_OUT1) {
        { pg8::Gemm<1024, 1024, 1024> g{(const bf16*)(ws + WS_HR), (const bf16*)(ws + WS_WOM)};
          pg8::StaticOrder S; S.init(MS, 1024, G, bx);
          EpiMerge<0> E{(const bf16*)(ws + WS_P), (float*)(ws + WS_T), (bf16*)(ws + WS_MG)};
          pg8::gemm_phase<EpiMerge<0>, pg8::StaticOrder, true, true>(lds3, g, S, E); }
        { pg8::Gemm<512, 512, 512> g{(const bf16*)(ws + WS_UA), (const bf16*)(ws + WS_WOA)};
          pg8::StaticOrder S; S.init(MS, 1024, G, bx);
          EpiMerge<1> E{(const bf16*)(ws + WS_P), (float*)(ws + WS_T), (bf16*)(ws + WS_MG)};
          pg8::gemm_phase<EpiMerge<1>, pg8::StaticOrder, true, true>(lds3, g, S, E); }
    } else if constexpr (KIND == K_OUT2) {
        pg8::Gemm<1024, 1024, 1024> g{(const bf16*)(ws + WS_MG), (const bf16*)(ws + WS_WO)};
        pg8::StaticOrder S; S.init(MS, 1024, G, bx);
        EpiOut E{args.x, args.out, (const float*)(ws + WS_MOD) + 2048, (float*)(ws + WS_CTL) + CW_ROWSS, pass * MS};
        pg8::gemm_phase<EpiOut, pg8::StaticOrder, true, true>(lds3, g, S, E);
    }
}

#if !MK_ONE_LAUNCH
template <int KIND>
__global__ void __launch_bounds__(NTHR, 2) k_phase(Args args) {
    extern __shared__ __attribute__((aligned(16))) unsigned char lds[];
    run_phase<KIND>(args, lds, args.ph_lo);
}
#else
__global__ void __launch_bounds__(NTHR, 2) mk_fwd(Args args) {
    extern __shared__ __attribute__((aligned(16))) unsigned char lds[];
    for (int gp = args.ph_lo; gp < args.ph_hi; ++gp) {
        if (gp == 0) run_phase<K_PROLOGUE>(args, lds, 0);
        else if (gp == 1) run_phase<K_H>(args, lds, 0);
        else if (gp == PH_TOTAL - 1) run_phase<K_NORM>(args, lds, 0);
        else {
            const int pass = (gp - 2) / PH_PER_PASS, k = (gp - 2) % PH_PER_PASS;
            if (k == 0) run_phase<K_INPROJ>(args, lds, pass);
            else if (k == 1) run_phase<K_PREP>(args, lds, pass);
            else if (k == 2) run_phase<K_QK>(args, lds, pass);
            else if (k == 3) run_phase<K_MIX>(args, lds, pass);
            else if (k == 4) run_phase<K_POST>(args, lds, pass);
            else if (k == 5) run_phase<K_OUT1>(args, lds, pass);
            else run_phase<K_OUT2>(args, lds, pass);
        }
        if (gp + 1 < args.ph_hi) { __threadfence(); cg::this_grid().sync(); }
    }
}
#endif

extern "C" void kernel_launch(void* const* d_in, const int* in_sizes, int n_in, void* d_out, int out_size, void* d_ws, size_t ws_size, hipStream_t stream) {
    static int grid = 0;
    if (grid == 0) {
        if (n_in != 19 || in_sizes[0] != MALL * DM || out_size != MALL * DM || ws_size < WS_END) { fprintf(stderr, "kernel_launch: unexpected shapes (n_in %d, ws %zu)\n", n_in, ws_size); grid = -1; return; }
        int dev = 0, cus = 0, per_cu = 0;
        (void)hipGetDevice(&dev); (void)hipDeviceGetAttribute(&cus, hipDeviceAttributeMultiprocessorCount, dev);
#if MK_ONE_LAUNCH
        (void)hipFuncSetAttribute((const void*)mk_fwd, hipFuncAttributeMaxDynamicSharedMemorySize, LDS_BYTES);
        (void)hipOccupancyMaxActiveBlocksPerMultiprocessor(&per_cu, (const void*)mk_fwd, NTHR, LDS_BYTES);
        if (per_cu < 1) { fprintf(stderr, "kernel_launch: occupancy query says %d\n", per_cu); per_cu = 1; }
#else
#define SETATTR(KIND) (void)hipFuncSetAttribute((const void*)k_phase<KIND>, hipFuncAttributeMaxDynamicSharedMemorySize, LDS_BYTES)
        SETATTR(K_PROLOGUE); SETATTR(K_H); SETATTR(K_INPROJ); SETATTR(K_PREP); SETATTR(K_QK); SETATTR(K_MIX); SETATTR(K_POST); SETATTR(K_OUT1); SETATTR(K_OUT2); SETATTR(K_NORM);
        (void)per_cu;
#endif
        (void)hipGetLastError();
        grid = cus;
    }
    if (grid < 0) return;
    (void)hipMemsetAsync((char*)d_ws + WS_CTL, 0, CTL_ZERO_BYTES, stream);
    Args a{};
    a.x = (const float*)d_in[0]; a.c = (const float*)d_in[1]; a.pos = (const int*)d_in[2]; a.w_ada = (const float*)d_in[3]; a.b_ada = (const float*)d_in[4];
    a.g_norm = (const float*)d_in[5]; a.w_in = (const float*)d_in[6]; a.b_ig = (const float*)d_in[7]; a.b_fg = (const float*)d_in[8]; a.w_conv = (const float*)d_in[9];
    a.b_conv = (const float*)d_in[10]; a.w_q = (const float*)d_in[11]; a.w_k = (const float*)d_in[12]; a.g_head = (const float*)d_in[13]; a.skip = (const float*)d_in[14];
    a.w_om = (const float*)d_in[15]; a.w_oa = (const float*)d_in[16]; a.w_o = (const float*)d_in[17]; a.g_final = (const float*)d_in[18];
    a.out = (float*)d_out; a.ws = (unsigned char*)d_ws;
#if MK_ONE_LAUNCH
    a.ph_lo = 0; a.ph_hi = PH_TOTAL;
    void* params[] = {&a};
    hipError_t e = hipLaunchCooperativeKernel((const void*)mk_fwd, dim3(grid), dim3(NTHR), params, LDS_BYTES, stream);
    if (e != hipSuccess) fprintf(stderr, "cooperative launch failed: %s\n", hipGetErrorString(e));
#else
#define LAUNCH(KIND, PASS) do { a.ph_lo = (PASS); a.ph_hi = 0; hipLaunchKernelGGL(k_phase<KIND>, dim3(grid), dim3(NTHR), LDS_BYTES, stream, a); } while (0)
    LAUNCH(K_PROLOGUE, 0); LAUNCH(K_H, 0);
    for (int p = 0; p < NPASS; ++p) { LAUNCH(K_INPROJ, p); LAUNCH(K_PREP, p); LAUNCH(K_QK, p); LAUNCH(K_MIX, p); LAUNCH(K_POST, p); LAUNCH(K_OUT1, p); LAUNCH(K_OUT2, p); }
    LAUNCH(K_NORM, 0);
#endif
}
```

```cpp
#include <hip/hip_runtime.h>
#include <hip/hip_cooperative_groups.h>
#include <cstdio>
#include <cstdint>
namespace cg = cooperative_groups;

#ifndef MK_ONE_LAUNCH
#define MK_ONE_LAUNCH 1
#endif

__device__ __forceinline__ int opaque_tid() { int t = threadIdx.x; asm volatile("" : "+v"(t)); return t; }
namespace pg8 {
#define PG8_LAS __attribute__((address_space(3)))
typedef unsigned short bf16_t;
typedef short bf16x8 __attribute__((ext_vector_type(8)));
typedef float f32x4 __attribute__((ext_vector_type(4)));
typedef unsigned u32x4 __attribute__((ext_vector_type(4)));
constexpr int BM = 256, BK = 64, HALF = 128, HTB = HALF * BK * 2, STAGE_BYTES = 8 * HTB, NXCD = 8, WGM = 8;

__host__ __device__ __forceinline__ int lds_byte(int r, int c) { const int st = (r >> 4) * 2 + (c >> 5), rr = r & 15, cc = c & 31, ob = rr * 64 + cc * 2; return st * 1024 + (ob ^ (((ob >> 9) & 1) << 5)); }
__host__ __device__ __forceinline__ void stage_rc(int b, int& R, int& C) { const int st = b / 1024, sb = b % 1024, swz = sb ^ (((sb >> 9) & 1) << 5); R = (st >> 1) * 16 + swz / 64; C = (st & 1) * 32 + (swz % 64) / 2; }
__host__ __device__ __forceinline__ int perm32(int rho) { const int n = rho >> 4, i = rho & 15; return 8 * (i >> 2) + 4 * n + (i & 3); }

struct Unit { int pm, pn, g; };
template <int LDA, int LDB, int KK, int AGS = 0, int BGS = 0> struct Gemm {
    const bf16_t* A; const bf16_t* Bt;
    static constexpr int lda = LDA, ldb = LDB, K = KK;
    __device__ __forceinline__ const char* abase(const Unit& u) const { return (const char*)A + (size_t)(u.g * AGS) + (size_t)u.pm * (size_t)(BM * 2 * LDA); }
    __device__ __forceinline__ const char* bbase(const Unit& u) const { return (const char*)Bt + (size_t)(u.g * BGS) + (size_t)u.pn * (size_t)(BM * 2 * LDB); }
};

struct StaticOrder {
    int nM, nN, nwg, G, c;
    __host__ __device__ void init(int M, int N, int G_, int c_) { nM = M / BM; nN = N / BM; nwg = nM * nN; G = G_; c = c_; }
    __host__ __device__ bool next(int i, Unit& u) const {
        const long L = (long)i * G + c; if (L >= nwg) return false;
        int wgid = (int)L; { const int q = nwg / NXCD, r = nwg % NXCD, xcd = wgid % NXCD, off = wgid / NXCD; wgid = (xcd < r ? xcd * (q + 1) : r * (q + 1) + (xcd - r) * q) + off; }
        const int nig = WGM * nN, gid = wgid / nig, fm = gid * WGM, gsz = (nM - fm) < WGM ? (nM - fm) : WGM;
        u.pm = fm + ((wgid % nig) % gsz); u.pn = (wgid % nig) / gsz; u.g = 0; return true;
    }
    __device__ __forceinline__ void a_ready(const Unit&) const {}
    __device__ __forceinline__ void done(const Unit&) const {}
};
struct GroupOrder {
    int nunits, G, c;
    __host__ __device__ void init(int M, int G_, int c_) { nunits = (M / BM) * 8; G = G_; c = c_; }
    __host__ __device__ bool next(int i, Unit& u) const {
        const long L = (long)i * G + c; if (L >= nunits) return false;
        u.pm = (int)(L >> 3); u.g = (int)((L & 7) >> 1); u.pn = (int)(L & 1); return true;
    }
    __device__ __forceinline__ void a_ready(const Unit&) const {}
    __device__ __forceinline__ void done(const Unit&) const {}
};

__device__ __forceinline__ unsigned cvt_pk_bf16(float lo, float hi) { unsigned r; asm volatile("v_cvt_pk_bf16_f32 %0, %1, %2" : "=v"(r) : "v"(lo), "v"(hi)); return r; }

template <class Epi, class Sched, bool ALIGN_EPI, bool SP2, class GemmT>
__device__ __forceinline__ void gemm_phase(PG8_LAS unsigned char* lds, const GemmT g, const Sched& S, const Epi& E) {
    const int tid = opaque_tid(), wid = __builtin_amdgcn_readfirstlane(tid >> 6), lane = tid & 63, wr = wid >> 2, wc = wid & 3, fr = lane & 15, fq = lane >> 4;
    constexpr int K = GemmT::K, nt = K / BK;
    unsigned voffA[2], voffB[2];
#pragma unroll
    for (int i = 0; i < 2; ++i) { int R, C; stage_rc(tid * 16 + i * 8192, R, C); const int Rb = Epi::PERM ? ((R & ~31) + perm32(R & 31)) : R;
        voffA[i] = (unsigned)(R * g.lda + C) * 2u; voffB[i] = (unsigned)(Rb * g.ldb + C) * 2u; }
    const size_t kstep = (size_t)(BK * 2);
    const size_t hstepA = (size_t)HALF * g.lda * 2, hstepB = (size_t)HALF * g.ldb * 2;
    const unsigned ldsw = (unsigned)wid * 1024u;
    const int aoff = lds_byte(wr * 64 + fr, fq * 8), boff = lds_byte(wc * 32 + fr, fq * 8);
#define PG8_SA(b, h) (((b) * 2 + (h)) * HTB)
#define PG8_SB(b, h) ((4 + (b) * 2 + (h)) * HTB)
#define PG8_STAGE(bufoff, gbase, voff) do { _Pragma("unroll") for (int _i = 0; _i < 2; ++_i) \
        __builtin_amdgcn_global_load_lds((const unsigned*)((const char*)(gbase) + (voff)[_i]), (PG8_LAS unsigned*)(lds + (bufoff) + ldsw + _i * 8192), 16, 0, 0); } while (0)
#define PG8_LDA(dst, b, h) do { _Pragma("unroll") for (int m = 0; m < 4; ++m) _Pragma("unroll") for (int k = 0; k < 2; ++k) dst[m][k] = *(const PG8_LAS bf16x8*)(lds + PG8_SA(b, h) + aoff + m * 2048 + k * 1024); } while (0)
#define PG8_LDB(dst, b, h) do { _Pragma("unroll") for (int n = 0; n < 2; ++n) _Pragma("unroll") for (int k = 0; k < 2; ++k) dst[n][k] = *(const PG8_LAS bf16x8*)(lds + PG8_SB(b, h) + boff + n * 2048 + k * 1024); } while (0)
#define PG8_MMA(ai, bj, At, Bt) do { __builtin_amdgcn_s_setprio(1); _Pragma("unroll") for (int m = 0; m < 4; ++m) _Pragma("unroll") for (int n = 0; n < 2; ++n) _Pragma("unroll") for (int k = 0; k < 2; ++k) \
        acc[ai][bj][m][n] = __builtin_amdgcn_mfma_f32_16x16x32_bf16(Bt[n][k], At[m][k], acc[ai][bj][m][n], 0, 0, 0); __builtin_amdgcn_s_setprio(0); } while (0)
#define PG8_WAIT_V(n) asm volatile("s_waitcnt vmcnt(" #n ")" ::: "memory")
#define PG8_WAIT_L(n) asm volatile("s_waitcnt lgkmcnt(" #n ")" ::: "memory")
#define PG8_BAR __builtin_amdgcn_s_barrier()
#define PG8_SCHED __builtin_amdgcn_sched_barrier(0)
    Unit cur, nxt; int ui = 0;
    if (!S.next(0, cur)) return;
    f32x4 acc[2][2][4][2];
#pragma unroll
    for (int a = 0; a < 2; ++a)
#pragma unroll
        for (int b = 0; b < 2; ++b)
#pragma unroll
            for (int m = 0; m < 4; ++m)
#pragma unroll
                for (int n = 0; n < 2; ++n) acc[a][b][m][n] = (f32x4){0.f, 0.f, 0.f, 0.f};
    bf16x8 At[4][2], B0[2][2], B1[2][2];
    const char* cA = g.abase(cur); const char* cB = g.bbase(cur);
    S.a_ready(cur);
    if constexpr (SP2) {
        PG8_STAGE(PG8_SB(0, 0), cB, voffB); PG8_STAGE(PG8_SB(0, 1), cB + hstepB, voffB); PG8_STAGE(PG8_SA(0, 0), cA, voffA); PG8_STAGE(PG8_SA(0, 1), cA + hstepA, voffA);
        if (wr == 1) PG8_BAR;
        PG8_WAIT_V(2); PG8_BAR;
        PG8_STAGE(PG8_SB(1, 0), cB + kstep, voffB); PG8_STAGE(PG8_SA(1, 0), cA + kstep, voffA); PG8_STAGE(PG8_SB(1, 1), cB + hstepB + kstep, voffB);
        PG8_WAIT_V(6); PG8_BAR;
    } else {
        PG8_STAGE(PG8_SB(0, 0), cB, voffB); PG8_STAGE(PG8_SA(0, 0), cA, voffA); PG8_STAGE(PG8_SB(0, 1), cB + hstepB, voffB); PG8_STAGE(PG8_SA(0, 1), cA + hstepA, voffA);
        if (wr == 1) PG8_BAR;
        PG8_WAIT_V(4); PG8_BAR;
        PG8_STAGE(PG8_SB(1, 0), cB + kstep, voffB); PG8_STAGE(PG8_SA(1, 0), cA + kstep, voffA); PG8_STAGE(PG8_SB(1, 1), cB + hstepB + kstep, voffB);
        PG8_WAIT_V(6); PG8_BAR;
    }
    for (;;) {
        const bool has_next = S.next(ui + 1, nxt);
        const char* nA = has_next ? g.abase(nxt) : cA; const char* nB = has_next ? g.bbase(nxt) : cB;
#pragma nounroll
        for (int t = 0; t < nt; t += 2) {
            const bool last = (t == nt - 2);
            const char* a1 = cA + (size_t)(t + 1) * kstep;
            const char* a2 = last ? nA : cA + (size_t)(t + 2) * kstep; const char* b2 = last ? nB : cB + (size_t)(t + 2) * kstep;
            const char* a3 = a2 + kstep; const char* b3 = b2 + kstep;
            if (last && has_next) S.a_ready(nxt);
            if constexpr (SP2) {
            PG8_LDB(B0, 0, 0); PG8_LDB(B1, 0, 1); PG8_SCHED; PG8_LDA(At, 0, 0); PG8_STAGE(PG8_SA(1, 1), a1 + hstepA, voffA);
            PG8_WAIT_V(8); PG8_WAIT_L(0); PG8_BAR; PG8_MMA(0, 0, At, B0); PG8_MMA(0, 1, At, B1); PG8_BAR; PG8_SCHED;
            PG8_LDA(At, 0, 1); PG8_STAGE(PG8_SB(0, 0), b2, voffB); PG8_STAGE(PG8_SB(0, 1), b2 + hstepB, voffB); PG8_STAGE(PG8_SA(0, 0), a2, voffA);
            PG8_WAIT_V(8); PG8_WAIT_L(0); PG8_BAR; PG8_MMA(1, 0, At, B0); PG8_MMA(1, 1, At, B1); PG8_BAR; PG8_SCHED;
            PG8_LDB(B0, 1, 0); PG8_LDB(B1, 1, 1); PG8_SCHED; PG8_LDA(At, 1, 0); PG8_STAGE(PG8_SA(0, 1), a2 + hstepA, voffA);
            PG8_WAIT_V(8); PG8_WAIT_L(0); PG8_BAR; PG8_MMA(0, 0, At, B0); PG8_MMA(0, 1, At, B1); PG8_BAR; PG8_SCHED;
            PG8_LDA(At, 1, 1); PG8_STAGE(PG8_SB(1, 0), b3, voffB); PG8_STAGE(PG8_SB(1, 1), b3 + hstepB, voffB); PG8_STAGE(PG8_SA(1, 0), a3, voffA);
            PG8_WAIT_V(8); PG8_WAIT_L(0); PG8_BAR; PG8_MMA(1, 0, At, B0); PG8_MMA(1, 1, At, B1); PG8_BAR; PG8_SCHED;
            } else {
            PG8_LDB(B0, 0, 0); PG8_SCHED; PG8_LDA(At, 0, 0); PG8_STAGE(PG8_SA(1, 1), a1 + hstepA, voffA);
            PG8_WAIT_L(8); PG8_BAR; PG8_WAIT_L(0); PG8_MMA(0, 0, At, B0); PG8_BAR; PG8_SCHED;
            PG8_LDB(B1, 0, 1); PG8_STAGE(PG8_SB(0, 0), b2, voffB);
            PG8_BAR; PG8_WAIT_L(0); PG8_MMA(0, 1, At, B1); PG8_BAR;
            PG8_LDA(At, 0, 1); PG8_STAGE(PG8_SA(0, 0), a2, voffA);
            PG8_BAR; PG8_WAIT_L(0); PG8_MMA(1, 0, At, B0); PG8_BAR; PG8_SCHED;
            PG8_STAGE(PG8_SB(0, 1), b2 + hstepB, voffB);
            PG8_WAIT_V(6); PG8_BAR; PG8_MMA(1, 1, At, B1); PG8_BAR;
            PG8_LDB(B0, 1, 0); PG8_SCHED; PG8_LDA(At, 1, 0); PG8_STAGE(PG8_SA(0, 1), a2 + hstepA, voffA);
            PG8_WAIT_L(8); PG8_BAR; PG8_WAIT_L(0); PG8_MMA(0, 0, At, B0); PG8_BAR; PG8_SCHED;
            PG8_LDB(B1, 1, 1); PG8_STAGE(PG8_SB(1, 0), b3, voffB);
            PG8_BAR; PG8_WAIT_L(0); PG8_MMA(0, 1, At, B1); PG8_BAR;
            PG8_LDA(At, 1, 1); PG8_STAGE(PG8_SA(1, 0), a3, voffA);
            PG8_BAR; PG8_WAIT_L(0); PG8_MMA(1, 0, At, B0); PG8_BAR; PG8_SCHED;
            PG8_STAGE(PG8_SB(1, 1), b3 + hstepB, voffB);
            PG8_WAIT_V(6); PG8_BAR; PG8_MMA(1, 1, At, B1); PG8_BAR;
            }
        }
        if constexpr (ALIGN_EPI) { if (wr == 0) PG8_BAR; }
        E(acc, cur, wr, wc, fr, fq); S.done(cur);
        if (!has_next) break;
#pragma unroll
        for (int a = 0; a < 2; ++a)
#pragma unroll
            for (int b = 0; b < 2; ++b)
#pragma unroll
                for (int m = 0; m < 4; ++m)
#pragma unroll
                    for (int n = 0; n < 2; ++n) acc[a][b][m][n] = (f32x4){0.f, 0.f, 0.f, 0.f};
        cur = nxt; cA = nA; cB = nB; ++ui;
        if constexpr (ALIGN_EPI) { if (wr == 1) PG8_BAR; }
    }
    PG8_WAIT_V(0);
    if constexpr (!ALIGN_EPI) { if (wr == 0) PG8_BAR; }
    PG8_BAR;
#undef PG8_SA
#undef PG8_SB
#undef PG8_STAGE
#undef PG8_LDA
#undef PG8_LDB
#undef PG8_MMA
#undef PG8_WAIT_V
#undef PG8_WAIT_L
#undef PG8_BAR
#undef PG8_SCHED
}
}

constexpr int NWAVES = 8, NTHR = 512;
constexpr int DM = 1024, NBATCH = 16, SEQ = 4096, MALL = NBATCH * SEQ;
constexpr int NB_PASS = 4, MS = NB_PASS * SEQ, NPASS = NBATCH / NB_PASS;
constexpr int INW_SRC = 11272, INW = 11264;
constexpr int C_XA = 0, C_VA = 1024, C_OA = 2048, C_ZA = 3072, C_QA = 4096, C_KA = 5632, C_VT = 7168, C_ZB = 8704, C_GA = 9216, C_GB = 10240;
constexpr float EPS = 1e-6f;

constexpr size_t MiB = 1u << 20;
constexpr size_t WS_CTL = 0, CTL_ZERO_BYTES = 1 * MiB;
constexpr size_t WS_MOD = 1 * MiB;
constexpr size_t WS_WG = 1 * MiB + 256 * 1024;
constexpr size_t WS_WIN = 2 * MiB;
constexpr size_t WS_WQK = 24 * MiB;
constexpr size_t WS_WOM = 25 * MiB, WS_WOA = 27 * MiB, WS_WO = 28 * MiB;
constexpr size_t WS_IG = 30 * MiB, WS_FG = 31 * MiB;
constexpr size_t WS_GSC = 32 * MiB;
constexpr size_t WS_LSE = 34 * MiB;
constexpr size_t WS_H = 36 * MiB;
constexpr size_t WS_P = 164 * MiB;
constexpr size_t WS_XC = 516 * MiB;
constexpr size_t WS_QM = 548 * MiB, WS_KM = 580 * MiB;
constexpr size_t WS_HR = 612 * MiB;
constexpr size_t WS_AO = 644 * MiB;
constexpr size_t WS_UA = 692 * MiB;
constexpr size_t WS_T = 708 * MiB;
constexpr size_t WS_MG = 772 * MiB;
constexpr size_t WS_END = 804 * MiB;
constexpr int CW_QCTR = 1024;
constexpr int CW_ROWSS = 65536;
static_assert((CW_ROWSS + MALL) * 4 <= (int)CTL_ZERO_BYTES, "ctl");

constexpr int LDS_BYTES = 147456;

typedef unsigned short bf16;
typedef float f32x4 __attribute__((ext_vector_type(4)));
typedef float f32x2 __attribute__((ext_vector_type(2)));
typedef short bf16x8 __attribute__((ext_vector_type(8)));
typedef unsigned u32x4 __attribute__((ext_vector_type(4)));
typedef unsigned u32x2 __attribute__((ext_vector_type(2)));

__device__ __forceinline__ unsigned f2bf(float f) { unsigned u = __builtin_bit_cast(unsigned, f); return (u + 0x7fffu + ((u >> 16) & 1u)) >> 16; }
__device__ __forceinline__ unsigned pk2(float lo, float hi) { return f2bf(lo) | (f2bf(hi) << 16); }
__device__ __forceinline__ float bflo(unsigned w) { return __builtin_bit_cast(float, w << 16); }
__device__ __forceinline__ float bfhi(unsigned w) { return __builtin_bit_cast(float, w & 0xffff0000u); }
__device__ __forceinline__ float bf1(bf16 v) { return __builtin_bit_cast(float, (unsigned)v << 16); }
__device__ __forceinline__ float sigmoidf_(float x) { return 1.f / (1.f + __expf(-x)); }
__device__ __forceinline__ float siluf_(float x) { return x / (1.f + __expf(-x)); }
__device__ __forceinline__ float wave_sum(float v) {
#pragma unroll
    for (int o = 1; o < 64; o <<= 1) v += __shfl_xor(v, o);
    return v;
}
__device__ __forceinline__ void unpack8(const u32x4 w, float* f) {
    f[0] = bflo(w.x); f[1] = bfhi(w.x); f[2] = bflo(w.y); f[3] = bfhi(w.y); f[4] = bflo(w.z); f[5] = bfhi(w.z); f[6] = bflo(w.w); f[7] = bfhi(w.w);
}

struct Args {
    const float* x; const float* c; const int* pos; const float* w_ada; const float* b_ada; const float* g_norm; const float* w_in;
    const float* b_ig; const float* b_fg; const float* w_conv; const float* b_conv; const float* w_q; const float* w_k; const float* g_head;
    const float* skip; const float* w_om; const float* w_oa; const float* w_o; const float* g_final;
    float* out; unsigned char* ws; int ph_lo, ph_hi;
};

__device__ __forceinline__ void transpose_item(const float* W, int K, int Nsrc, int nblk, int src_col_off, bf16* WT, int ldt, int row_off, float scale, float* scr, int item, int lane) {
    const int kb = item / nblk, nb = item % nblk, k0 = 64 * kb, n0 = 32 * nb;
#pragma unroll 8
    for (int i = 0; i < 32; ++i) { const int kk = 2 * i + (lane >> 5); scr[kk * 33 + (lane & 31)] = W[(size_t)(k0 + kk) * Nsrc + src_col_off + n0 + (lane & 31)]; }
    __builtin_amdgcn_wave_barrier();
    asm volatile("s_waitcnt lgkmcnt(0)" ::: "memory");
    const int cc = lane & 7;
#pragma unroll
    for (int j = 0; j < 4; ++j) { const int n = (lane >> 3) + 8 * j; const float* s = scr + (8 * cc) * 33 + n;
        u32x4 o; o.x = pk2(s[0 * 33] * scale, s[1 * 33] * scale); o.y = pk2(s[2 * 33] * scale, s[3 * 33] * scale); o.z = pk2(s[4 * 33] * scale, s[5 * 33] * scale); o.w = pk2(s[6 * 33] * scale, s[7 * 33] * scale);
        *(u32x4*)(WT + (size_t)(row_off + n0 + n) * ldt + k0 + 8 * cc) = o; }
    asm volatile("s_waitcnt lgkmcnt(0)" ::: "memory");
    __builtin_amdgcn_wave_barrier();
}

__device__ __forceinline__ void phase_prologue(const Args& a, unsigned char* lds, int vcu, int G) {
    const int tid = opaque_tid(), lane = tid & 63, wave = tid >> 6;
    unsigned char* ws = a.ws;
    if (vcu < 48) {
        float* sc = (float*)lds;
        float* red = (float*)(lds + 65536);
        for (int i = tid; i < 16 * 1024; i += NTHR) sc[i] = siluf_(a.c[i]);
        __syncthreads();
        const int n = vcu * 64 + lane;
        float acc[16];
#pragma unroll
        for (int b = 0; b < 16; ++b) acc[b] = 0.f;
        const int k0 = wave * 128;
#pragma unroll 4
        for (int k = k0; k < k0 + 128; ++k) { const float w = a.w_ada[(size_t)k * 3072 + n];
#pragma unroll
            for (int b = 0; b < 16; ++b) acc[b] += sc[b * 1024 + k] * w; }
#pragma unroll
        for (int b = 0; b < 16; ++b) red[(wave * 16 + b) * 64 + lane] = acc[b];
        __syncthreads();
        float* mod = (float*)(ws + WS_MOD);
        for (int i = tid; i < 16 * 64; i += NTHR) { const int b = i >> 6, l = i & 63, nn = vcu * 64 + l; float s = 0.f;
#pragma unroll
            for (int w = 0; w < 8; ++w) s += red[(w * 16 + b) * 64 + l];
            s += a.b_ada[nn];
            const int part = nn >> 10, col = nn & 1023;
            if (part == 1) s = a.g_norm[col] * (1.f + s);
            mod[b * 3072 + nn] = s; }
        __syncthreads();
    }
    {
        float* scr = (float*)lds + wave * (64 * 33);
        const int gw = vcu * NWAVES + wave, NGW = G * NWAVES;
        constexpr int I_IN = (1024 / 64) * (INW / 32);
        constexpr int I_QK = 8 * (256 / 64) * (256 / 32);
        constexpr int I_OM = 16 * 32, I_OA = 8 * 32, I_O = 16 * 32;
        constexpr int NITEMS = I_IN + I_QK + I_OM + I_OA + I_O;
        for (int it = gw; it < NITEMS; it += NGW) {
            int r = it;
            if (r < I_IN) { const int nb = r % (INW / 32); const int off = (nb * 32 >= 4096) ? 8 : 0;
                transpose_item(a.w_in, 1024, INW_SRC, INW / 32, off, (bf16*)(ws + WS_WIN), 1024, 0, 1.f, scr, r, lane); continue; } r -= I_IN;
            if (r < I_QK) { const int mtx = r >> 5, rr = r & 31, h = mtx >> 1, isk = mtx & 1;
                const float* W = (isk ? a.w_k : a.w_q) + (size_t)h * 65536;
                transpose_item(W, 256, 256, 8, 0, (bf16*)(ws + WS_WQK) + (size_t)h * 512 * 256, 256, isk * 256, isk ? 0.0625f : 1.f, scr, rr, lane); continue; } r -= I_QK;
            if (r < I_OM) { transpose_item(a.w_om, 1024, 1024, 32, 0, (bf16*)(ws + WS_WOM), 1024, 0, 1.f, scr, r, lane); continue; } r -= I_OM;
            if (r < I_OA) { transpose_item(a.w_oa, 512, 1024, 32, 0, (bf16*)(ws + WS_WOA), 512, 0, 1.f, scr, r, lane); continue; } r -= I_OA;
            transpose_item(a.w_o, 1024, 1024, 32, 0, (bf16*)(ws + WS_WO), 1024, 0, 1.f, scr, r, lane);
        }
        float* wg = (float*)(ws + WS_WG);
        for (int i = (vcu * NTHR + tid); i < 8 * 1024; i += G * NTHR) { const int j = i >> 10, k = i & 1023; wg[i] = a.w_in[(size_t)k * INW_SRC + 4096 + j]; }
    }
}

__device__ __forceinline__ void phase_h(const Args& a, unsigned char* lds, int vcu, int G) {
    const int tid = opaque_tid(), lane = tid & 63, wave = tid >> 6;
    unsigned char* ws = a.ws;
    float* wg = (float*)lds;
    { const float* src = (const float*)(ws + WS_WG); for (int i = tid; i < 8192; i += NTHR) wg[i] = src[i]; }
    __syncthreads();
    const float* mod = (const float*)(ws + WS_MOD);
    bf16* H = (bf16*)(ws + WS_H);
    float* IG = (float*)(ws + WS_IG); float* FG = (float*)(ws + WS_FG);
    const int gw = vcu * NWAVES + wave, NGW = G * NWAVES;
    for (int row = gw; row < MALL; row += NGW) {
        const int b = row >> 12;
        const f32x4* xr = (const f32x4*)(a.x + (size_t)row * DM) + lane;
        f32x4 v[4]; float ss = 0.f;
#pragma unroll
        for (int j = 0; j < 4; ++j) { v[j] = xr[64 * j]; ss += (v[j].x * v[j].x + v[j].y * v[j].y) + (v[j].z * v[j].z + v[j].w * v[j].w); }
        ss = wave_sum(ss);
        const float rinv = 1.f / sqrtf(ss * (1.f / DM) + EPS);
        float pg[8];
#pragma unroll
        for (int g = 0; g < 8; ++g) pg[g] = 0.f;
        u32x2* ho = (u32x2*)(H + (size_t)row * DM) + lane;
#pragma unroll
        for (int j = 0; j < 4; ++j) {
            const int col = 4 * lane + 256 * j;
            const f32x4 sh = *(const f32x4*)(mod + b * 3072 + col), gs = *(const f32x4*)(mod + b * 3072 + 1024 + col);
            f32x4 h = v[j] * rinv * gs + sh;
#pragma unroll
            for (int g = 0; g < 8; ++g) { const f32x4 w = *(const f32x4*)(wg + g * 1024 + col); pg[g] += (h.x * w.x + h.y * w.y) + (h.z * w.z + h.w * w.w); }
            u32x2 o; o.x = pk2(h.x, h.y); o.y = pk2(h.z, h.w); ho[64 * j] = o;
        }
#pragma unroll
        for (int g = 0; g < 8; ++g) pg[g] = wave_sum(pg[g]);
        if (lane == 0) {
            f32x4 ig = {pg[0] + a.b_ig[0], pg[1] + a.b_ig[1], pg[2] + a.b_ig[2], pg[3] + a.b_ig[3]};
            f32x4 fg = {pg[4] + a.b_fg[0], pg[5] + a.b_fg[1], pg[6] + a.b_fg[2], pg[7] + a.b_fg[3]};
            *(f32x4*)(IG + (size_t)row * 4) = ig; *(f32x4*)(FG + (size_t)row * 4) = fg;
        }
    }
}

struct EpiProj {
    static constexpr bool PERM = true;
    bf16* P;
    __device__ __forceinline__ void operator()(const f32x4 (&acc)[2][2][4][2], const pg8::Unit& u, int wr, int wc, int fr, int fq) const {
        const int row0 = u.pm * 256 + wr * 64 + fr, col0 = u.pn * 256 + wc * 32 + 8 * fq;
#pragma unroll
        for (int ai = 0; ai < 2; ++ai)
#pragma unroll
            for (int m = 0; m < 4; ++m) { bf16* rowp = P + (size_t)(row0 + ai * 128 + m * 16) * INW + col0;
#pragma unroll
                for (int bj = 0; bj < 2; ++bj) { const f32x4 v0 = acc[ai][bj][m][0], v1 = acc[ai][bj][m][1];
                    u32x4 w; w.x = pg8::cvt_pk_bf16(v0[0], v0[1]); w.y = pg8::cvt_pk_bf16(v0[2], v0[3]); w.z = pg8::cvt_pk_bf16(v1[0], v1[1]); w.w = pg8::cvt_pk_bf16(v1[2], v1[3]);
                    *(u32x4*)(rowp + bj * 128) = w; } }
    }
};
struct EpiQK {
    static constexpr bool PERM = true;
    bf16* QM; bf16* KM;
    __device__ __forceinline__ void operator()(const f32x4 (&acc)[2][2][4][2], const pg8::Unit& u, int wr, int wc, int fr, int fq) const {
        const int row0 = u.pm * 256 + wr * 64 + fr, col0 = u.g * 256 + wc * 32 + 8 * fq;
        bf16* base = u.pn ? KM : QM;
#pragma unroll
        for (int ai = 0; ai < 2; ++ai)
#pragma unroll
            for (int m = 0; m < 4; ++m) { bf16* rowp = base + (size_t)(row0 + ai * 128 + m * 16) * 1024 + col0;
#pragma unroll
                for (int bj = 0; bj < 2; ++bj) { const f32x4 v0 = acc[ai][bj][m][0], v1 = acc[ai][bj][m][1];
                    u32x4 w; w.x = pg8::cvt_pk_bf16(v0[0], v0[1]); w.y = pg8::cvt_pk_bf16(v0[2], v0[3]); w.z = pg8::cvt_pk_bf16(v1[0], v1[1]); w.w = pg8::cvt_pk_bf16(v1[2], v1[3]);
                    *(u32x4*)(rowp + bj * 128) = w; } }
    }
};
template <int MODE> struct EpiMerge {
    static constexpr bool PERM = true;
    const bf16* P; float* T; bf16* MG;
    __device__ __forceinline__ void operator()(const f32x4 (&acc)[2][2][4][2], const pg8::Unit& u, int wr, int wc, int fr, int fq) const {
        const int row0 = u.pm * 256 + wr * 64 + fr, col0 = u.pn * 256 + wc * 32 + 8 * fq;
#pragma unroll
        for (int ai = 0; ai < 2; ++ai)
#pragma unroll
            for (int m = 0; m < 4; ++m) { const size_t r = (size_t)(row0 + ai * 128 + m * 16);
#pragma unroll
                for (int bj = 0; bj < 2; ++bj) { const int c = col0 + bj * 128;
                    const u32x4 gw = *(const u32x4*)(P + r * INW + (MODE == 0 ? C_GA : C_GB) + c); float gg[8]; unpack8(gw, gg);
                    const f32x4 v0 = acc[ai][bj][m][0], v1 = acc[ai][bj][m][1];
                    float o[8];
#pragma unroll
                    for (int e = 0; e < 4; ++e) { o[e] = sigmoidf_(gg[e]) * v0[e]; o[4 + e] = sigmoidf_(gg[4 + e]) * v1[e]; }
                    float* tp = T + r * 1024 + c;
                    if (MODE == 0) { *(f32x4*)tp = (f32x4){o[0], o[1], o[2], o[3]}; *(f32x4*)(tp + 4) = (f32x4){o[4], o[5], o[6], o[7]}; }
                    else { const f32x4 t0 = *(const f32x4*)tp, t1 = *(const f32x4*)(tp + 4);
                        u32x4 w; w.x = pg8::cvt_pk_bf16(t0[0] + o[0], t0[1] + o[1]); w.y = pg8::cvt_pk_bf16(t0[2] + o[2], t0[3] + o[3]);
                        w.z = pg8::cvt_pk_bf16(t1[0] + o[4], t1[1] + o[5]); w.w = pg8::cvt_pk_bf16(t1[2] + o[6], t1[3] + o[7]);
                        *(u32x4*)(MG + r * 1024 + c) = w; } } }
    }
};
struct EpiOut {
    static constexpr bool PERM = true;
    const float* x; float* out; const float* gate; float* rowss; int grow0;
    __device__ __forceinline__ void operator()(const f32x4 (&acc)[2][2][4][2], const pg8::Unit& u, int wr, int wc, int fr, int fq) const {
        const int row0 = grow0 + u.pm * 256 + wr * 64 + fr, col0 = u.pn * 256 + wc * 32 + 8 * fq;
#pragma unroll
        for (int ai = 0; ai < 2; ++ai)
#pragma unroll
            for (int m = 0; m < 4; ++m) { const int r = row0 + ai * 128 + m * 16; const int b = r >> 12; float ss = 0.f;
#pragma unroll
                for (int bj = 0; bj < 2; ++bj) { const int c = col0 + bj * 128;
                    const float* gp = gate + b * 3072 + c; const f32x4 g0 = *(const f32x4*)gp, g1 = *(const f32x4*)(gp + 4);
                    const float* xp = x + (size_t)r * 1024 + c; const f32x4 x0 = *(const f32x4*)xp, x1 = *(const f32x4*)(xp + 4);
                    const f32x4 o0 = x0 + g0 * acc[ai][bj][m][0], o1 = x1 + g1 * acc[ai][bj][m][1];
                    ss += (o0[0] * o0[0] + o0[1] * o0[1]) + (o0[2] * o0[2] + o0[3] * o0[3]) + (o1[0] * o1[0] + o1[1] * o1[1]) + (o1[2] * o1[2] + o1[3] * o1[3]);
                    float* op = out + (size_t)r * 1024 + c; *(f32x4*)op = o0; *(f32x4*)(op + 4) = o1; }
                ss += __shfl_xor(ss, 16); ss += __shfl_xor(ss, 32);
                if (fq == 0) atomicAdd(rowss + r, ss); }
    }
};

__constant__ double c_inv_freq[16] = {1.0, 0.44036660267178046, 0.19392274474868576, 0.08539710028576561, 0.03760603093086393, 0.016560440080994446, 0.007292664737217109, 0.003211445994752591,
    0.001414213562373095, 0.000622772421914596, 0.0002742481756762073, 0.00012076973741146504, 5.318295896944988e-05, 2.341999896140934e-05, 1.031338537721246e-05, 4.5416704806078695e-06};

__device__ __forceinline__ void phase_prep(const Args& a, unsigned char* lds, int vcu, int G, int pass) {
    const int tid = opaque_tid(), lane = tid & 63, wave = tid >> 6;
    unsigned char* ws = a.ws;
    bf16* P = (bf16*)(ws + WS_P);
    {
        const int gw = vcu * NWAVES + wave;
        if (gw < NB_PASS * 4) {
            const int bl = gw >> 2, h = gw & 3;
            const float* IG = (const float*)(ws + WS_IG); const float* FG = (const float*)(ws + WS_FG);
            float* gsc = (float*)(ws + WS_GSC);
            float* A1 = gsc, *B1 = gsc + MS * 4, *WI = gsc + 2 * MS * 4, *EF = gsc + 3 * MS * 4, *WK = gsc + 4 * MS * 4, *DEC = gsc + 5 * MS * 4;
            float m_prev = 0.f;
            for (int j = 0; j < 64; ++j) {
                const int lrow = bl * SEQ + j * 64 + lane; const size_t grow = (size_t)pass * MS + lrow;
                const float f = FG[grow * 4 + h], ii = IG[grow * 4 + h];
                const float ls = fminf(f, 0.f) - log1pf(expf(-fabsf(f)));
                float acs = ls;
#pragma unroll
                for (int o = 1; o < 64; o <<= 1) { const float t = __shfl_up(acs, o); if (lane >= o) acs += t; }
                const float b1 = ii - acs;
                float pm = b1;
#pragma unroll
                for (int o = 1; o < 64; o <<= 1) { const float t = __shfl_up(pm, o); if (lane >= o) pm = fmaxf(pm, t); }
                const float g = __shfl(acs, 63), pm63 = __shfl(pm, 63);
                const float mx = fmaxf(m_prev, pm);
                const float Ms = fmaxf(m_prev, pm63);
                A1[lrow * 4 + h] = -mx; B1[lrow * 4 + h] = b1; WI[lrow * 4 + h] = expf(m_prev - mx); EF[lrow * 4 + h] = expf(-(acs + mx)); WK[lrow * 4 + h] = expf(b1 - Ms);
                if (lane == 0) DEC[(bl * 64 + j) * 4 + h] = expf(m_prev - Ms);
                m_prev = g + Ms;
            }
        }
    }
    {
        bf16* XC = (bf16*)(ws + WS_XC);
        const int cg8 = (tid & 127) * 8, rq = tid >> 7;
        float wc[4][8], bc[8];
#pragma unroll
        for (int j = 0; j < 4; ++j)
#pragma unroll
            for (int e = 0; e < 8; ++e) wc[j][e] = a.w_conv[j * 1024 + cg8 + e];
#pragma unroll
        for (int e = 0; e < 8; ++e) bc[e] = a.b_conv[cg8 + e];
        for (int it = vcu; it < MS / 64; it += G) {
            const int r0 = it * 64 + rq * 16;
            float h0[8], h1[8], h2[8];
#pragma unroll
            for (int e = 0; e < 8; ++e) { h0[e] = 0.f; h1[e] = 0.f; h2[e] = 0.f; }
            const int t0 = r0 & (SEQ - 1);
            if (t0 >= 3) { u32x4 w;
                w = *(const u32x4*)(P + (size_t)(r0 - 3) * INW + C_XA + cg8); unpack8(w, h0);
                w = *(const u32x4*)(P + (size_t)(r0 - 2) * INW + C_XA + cg8); unpack8(w, h1);
                w = *(const u32x4*)(P + (size_t)(r0 - 1) * INW + C_XA + cg8); unpack8(w, h2); }
            for (int rr = 0; rr < 16; ++rr) {
                const int r = r0 + rr; float cur[8];
                const u32x4 w = *(const u32x4*)(P + (size_t)r * INW + C_XA + cg8); unpack8(w, cur);
                float o[8];
#pragma unroll
                for (int e = 0; e < 8; ++e) { const float y = bc[e] + wc[0][e] * h0[e] + wc[1][e] * h1[e] + wc[2][e] * h2[e] + wc[3][e] * cur[e]; o[e] = siluf_(y); h0[e] = h1[e]; h1[e] = h2[e]; h2[e] = cur[e]; }
                u32x4 ov; ov.x = pk2(o[0], o[1]); ov.y = pk2(o[2], o[3]); ov.z = pk2(o[4], o[5]); ov.w = pk2(o[6], o[7]);
                *(u32x4*)(XC + (size_t)r * 1024 + cg8) = ov;
            }
        }
    }
    {
        for (int r = vcu * NWAVES + wave; r < MS; r += G * NWAVES) {
            if (lane < 48) {
                const int hd = lane >> 1, half = lane & 1;
                const size_t grow = (size_t)pass * MS + r;
                const int pos = a.pos[grow];
                bf16* base = P + (size_t)r * INW + (hd < 12 ? C_QA + hd * 128 : C_KA + (hd - 12) * 128) + 8 * half;
                u32x4 w1 = *(const u32x4*)base, w2 = *(const u32x4*)(base + 16);
                float x1[8], x2[8]; unpack8(w1, x1); unpack8(w2, x2);
                float o1[8], o2[8];
#pragma unroll
                for (int e = 0; e < 8; ++e) {
                    const double rev = (double)pos * c_inv_freq[8 * half + e] * 0.15915494309189535;
                    const float fr = (float)(rev - rint(rev));
                    const float cs = __builtin_amdgcn_cosf(fr), sn = __builtin_amdgcn_sinf(fr);
                    o1[e] = x1[e] * cs - x2[e] * sn; o2[e] = x2[e] * cs + x1[e] * sn;
                }
                u32x4 v1, v2; v1.x = pk2(o1[0], o1[1]); v1.y = pk2(o1[2], o1[3]); v1.z = pk2(o1[4], o1[5]); v1.w = pk2(o1[6], o1[7]);
                v2.x = pk2(o2[0], o2[1]); v2.y = pk2(o2[2], o2[3]); v2.z = pk2(o2[4], o2[5]); v2.w = pk2(o2[6], o2[7]);
                *(u32x4*)base = v1; *(u32x4*)(base + 16) = v2;
            }
        }
    }
}

__device__ __forceinline__ f32x4 mfma16(bf16x8 a, bf16x8 b, f32x4 c) { return __builtin_amdgcn_mfma_f32_16x16x32_bf16(a, b, c, 0, 0, 0); }

constexpr int CBS = 264, VTS = 72, KTS = 72, SBS = 72;
constexpr int L_CB = 0;
constexpr int L_VT = L_CB + 64 * CBS * 2;
constexpr int L_KT = L_VT + 64 * VTS * 2;
constexpr int L_SB = L_KT + 256 * KTS * 2;
constexpr int L_NV = L_SB + 64 * SBS * 2;
constexpr int L_DEN = L_NV + 1024;
constexpr int L_DENF = L_DEN + 256;
constexpr int L_SC = L_DENF + 256;
constexpr int L_SCAN_END = L_SC + 5 * 256;
static_assert(L_SCAN_END <= 131072, "scan lds");

__device__ __forceinline__ void scan_item(const Args& a, unsigned char* lds, int item) {
    const int tid = opaque_tid(), lane = tid & 63, wave = __builtin_amdgcn_readfirstlane(tid >> 6);
    const int fr = lane & 15, fq = lane >> 4;
    unsigned char* ws = a.ws;
    const int bl = item >> 4, h = (item >> 2) & 3, es = item & 3;
    const bf16* P = (const bf16*)(ws + WS_P); const bf16* QM = (const bf16*)(ws + WS_QM); const bf16* KM = (const bf16*)(ws + WS_KM);
    bf16* HR = (bf16*)(ws + WS_HR);
    const float* gsc = (const float*)(ws + WS_GSC);
    const float* gA1 = gsc, *gB1 = gsc + MS * 4, *gWI = gsc + 2 * MS * 4, *gEF = gsc + 3 * MS * 4, *gWK = gsc + 4 * MS * 4, *gDEC = gsc + 5 * MS * 4;
    bf16* Cb = (bf16*)(lds + L_CB); bf16* VT = (bf16*)(lds + L_VT); bf16* KT = (bf16*)(lds + L_KT); bf16* Sb = (bf16*)(lds + L_SB);
    float* NV = (float*)(lds + L_NV); float* DEN = (float*)(lds + L_DEN); float* DENF = (float*)(lds + L_DENF); float* SC = (float*)(lds + L_SC);
    for (int i = tid; i < 64 * CBS / 2; i += NTHR) ((unsigned*)Cb)[i] = 0u;
    if (tid < 256) NV[tid] = 0.f;
    f32x4 Cacc[2][4];
#pragma unroll
    for (int x = 0; x < 2; ++x)
#pragma unroll
        for (int y = 0; y < 4; ++y) Cacc[x][y] = (f32x4){0.f, 0.f, 0.f, 0.f};
    const int ti = wave >> 1, tj0 = 2 * (wave & 1);
    for (int j = 0; j < 64; ++j) {
        const int t0 = bl * SEQ + j * 64;
        const float decay = gDEC[(bl * 64 + j) * 4 + h];
        __syncthreads();
        if (tid < 320) { const int which = tid >> 6, l = tid & 63; const float* src = which == 0 ? gA1 : which == 1 ? gB1 : which == 2 ? gWI : which == 3 ? gEF : gWK; SC[which * 64 + l] = src[(t0 + l) * 4 + h]; }
        if (tid < 64) DEN[tid] = 0.f;
        { const int l = tid & 63, ec = tid >> 6;
          const u32x4 w = *(const u32x4*)(P + (size_t)(t0 + l) * INW + C_VA + h * 256 + es * 64 + 8 * ec);
          bf16* d = VT + (8 * ec) * VTS + l;
          d[0 * VTS] = (bf16)(w.x & 0xffff); d[1 * VTS] = (bf16)(w.x >> 16); d[2 * VTS] = (bf16)(w.y & 0xffff); d[3 * VTS] = (bf16)(w.y >> 16);
          d[4 * VTS] = (bf16)(w.z & 0xffff); d[5 * VTS] = (bf16)(w.z >> 16); d[6 * VTS] = (bf16)(w.w & 0xffff); d[7 * VTS] = (bf16)(w.w >> 16); }
#pragma unroll
        for (int i = 0; i < 4; ++i) { const int c = tid + NTHR * i, l = c & 63, dc = c >> 6;
          const u32x4 w = *(const u32x4*)(KM + (size_t)(t0 + l) * 1024 + h * 256 + 8 * dc); float kv[8]; unpack8(w, kv);
          const float wk = gWK[(t0 + l) * 4 + h];
          bf16* d = KT + (8 * dc) * KTS + l;
#pragma unroll
          for (int e = 0; e < 8; ++e) d[e * KTS] = (bf16)f2bf(kv[e] * wk); }
        bf16x8 qf[8];
#pragma unroll
        for (int ks = 0; ks < 8; ++ks) qf[ks] = *(const bf16x8*)(QM + (size_t)(t0 + 16 * ti + fr) * 1024 + h * 256 + 32 * ks + 8 * fq);
        __syncthreads();
#pragma unroll
        for (int tt = 0; tt < 2; ++tt) {
            const int tj = tj0 + tt;
            f32x4 sacc = {0.f, 0.f, 0.f, 0.f};
            if (tj <= ti) {
#pragma unroll
                for (int ks = 0; ks < 8; ++ks) { const bf16x8 kf = *(const bf16x8*)(KM + (size_t)(t0 + 16 * tj + fr) * 1024 + h * 256 + 32 * ks + 8 * fq); sacc = mfma16(qf[ks], kf, sacc); }
            }
            const int s = 16 * tj + fr; const float b1s = SC[64 + s];
#pragma unroll
            for (int i = 0; i < 4; ++i) { const int l = 16 * ti + 4 * fq + i;
                float v = 0.f;
                if (s <= l) v = sacc[i] * __expf(SC[l] + b1s);
                Sb[l * SBS + s] = (bf16)f2bf(v);
                float rs = v; rs += __shfl_xor(rs, 1); rs += __shfl_xor(rs, 2); rs += __shfl_xor(rs, 4); rs += __shfl_xor(rs, 8);
                if (fr == 0 && tj <= ti) atomicAdd(&DEN[l], rs); }
        }
        __syncthreads();
        {
#pragma unroll
            for (int rr = 0; rr < 8; ++rr) { const int l = 8 * wave + rr;
                const u32x2 qw = *(const u32x2*)(QM + (size_t)(t0 + l) * 1024 + h * 256 + 4 * lane);
                const f32x4 nv = *(const f32x4*)(NV + 4 * lane);
                float p = bflo(qw.x) * nv.x + bfhi(qw.x) * nv.y + bflo(qw.y) * nv.z + bfhi(qw.y) * nv.w;
                p = wave_sum(p);
                if (lane == 0) DENF[l] = DEN[l] + SC[128 + l] * p; }
        }
        __syncthreads();
#pragma unroll
        for (int tt = 0; tt < 2; ++tt) {
            const int ej = tj0 + tt;
            f32x4 a1 = {0.f, 0.f, 0.f, 0.f}, a2 = {0.f, 0.f, 0.f, 0.f};
#pragma unroll
            for (int k2 = 0; k2 < 2; ++k2) { const bf16x8 sa = *(const bf16x8*)(Sb + (16 * ti + fr) * SBS + 32 * k2 + 8 * fq); const bf16x8 vb = *(const bf16x8*)(VT + (16 * ej + fr) * VTS + 32 * k2 + 8 * fq); a1 = mfma16(sa, vb, a1); }
#pragma unroll
            for (int ks = 0; ks < 8; ++ks) { const bf16x8 cb = *(const bf16x8*)(Cb + (16 * ej + fr) * CBS + 32 * ks + 8 * fq); a2 = mfma16(qf[ks], cb, a2); }
#pragma unroll
            for (int i = 0; i < 4; ++i) { const int l = 16 * ti + 4 * fq + i;
                const float num = a1[i] + SC[128 + l] * a2[i];
                const float den = fmaxf(fabsf(DENF[l]), SC[192 + l]);
                HR[(size_t)(t0 + l) * 1024 + h * 256 + es * 64 + 16 * ej + fr] = (bf16)f2bf(num / den); }
        }
        __syncthreads();
#pragma unroll
        for (int dt = 0; dt < 2; ++dt)
#pragma unroll
            for (int et = 0; et < 4; ++et) {
                f32x4 c = Cacc[dt][et] * decay;
#pragma unroll
                for (int k2 = 0; k2 < 2; ++k2) { const bf16x8 ka = *(const bf16x8*)(KT + (32 * wave + 16 * dt + fr) * KTS + 32 * k2 + 8 * fq); const bf16x8 vb = *(const bf16x8*)(VT + (16 * et + fr) * VTS + 32 * k2 + 8 * fq); c = mfma16(ka, vb, c); }
                Cacc[dt][et] = c;
                u32x2 o; o.x = pk2(c[0], c[1]); o.y = pk2(c[2], c[3]);
                *(u32x2*)(Cb + (16 * et + fr) * CBS + 32 * wave + 16 * dt + 4 * fq) = o;
            }
        if (tid < 256) { float s = 0.f; const bf16* kr = KT + tid * KTS;
#pragma unroll 8
            for (int l = 0; l < 64; ++l) s += bf1(kr[l]);
            NV[tid] = decay * NV[tid] + s; }
    }
    __syncthreads();
}

constexpr int AKS = 136;
constexpr int L_AK = 0, L_AV = L_AK + 128 * AKS * 2, L_AP = L_AV + 128 * AKS * 2, L_ATT_END = L_AP + 8 * 16 * AKS * 2;
static_assert(L_ATT_END <= 131072, "attn lds");

__device__ __forceinline__ void attn_item(const Args& a, unsigned char* lds, int item) {
    const int tid = opaque_tid(), lane = tid & 63, wave = __builtin_amdgcn_readfirstlane(tid >> 6);
    const int fr = lane & 15, fq = lane >> 4;
    unsigned char* ws = a.ws;
    const int blk = item & 31, hh = (item >> 5) & 3, bl = (item >> 7) & 3, g = item >> 9;
    const int dil = g == 0 ? 1 : g == 1 ? 4 : 16, nb = 32 / dil;
    const int r = blk / nb, n = blk % nb;
    const bf16* P = (const bf16*)(ws + WS_P);
    const int H = 4 * g + hh;
    const bf16* Qb = P + C_QA + H * 128; const bf16* Kb = P + C_KA + H * 128; const bf16* Vb = P + C_VT + H * 128;
    bf16* Ks = (bf16*)(lds + L_AK); bf16* VTs = (bf16*)(lds + L_AV); bf16* Pw = (bf16*)(lds + L_AP) + wave * 16 * AKS;
    const int rowbase = bl * SEQ + r;
    bf16x8 qf[4];
    { const size_t qrow = (size_t)(rowbase + (128 * n + 16 * wave + fr) * dil);
#pragma unroll
      for (int ks = 0; ks < 4; ++ks) qf[ks] = *(const bf16x8*)(Qb + qrow * INW + 32 * ks + 8 * fq); }
    f32x4 O[8];
#pragma unroll
    for (int i = 0; i < 8; ++i) O[i] = (f32x4){0.f, 0.f, 0.f, 0.f};
    float mrow[4], lrow[4];
#pragma unroll
    for (int i = 0; i < 4; ++i) { mrow[i] = -INFINITY; lrow[i] = 0.f; }
    const float scale = 0.08838834764831845f;
    for (int half = (n == 0 ? 1 : 0); half < 2; ++half) {
        const int ku0 = 128 * (n - 1 + half);
        __syncthreads();
#pragma unroll
        for (int i = 0; i < 4; ++i) { const int c = tid + NTHR * i, key = c & 127, dc = c >> 7;
            const size_t krow = (size_t)(rowbase + (ku0 + key) * dil);
            const u32x4 kw = *(const u32x4*)(Kb + krow * INW + 8 * dc);
            *(u32x4*)(Ks + key * AKS + 8 * dc) = kw;
            const u32x4 w = *(const u32x4*)(Vb + krow * INW + 8 * dc);
            bf16* d = VTs + (8 * dc) * AKS + key;
            d[0 * AKS] = (bf16)(w.x & 0xffff); d[1 * AKS] = (bf16)(w.x >> 16); d[2 * AKS] = (bf16)(w.y & 0xffff); d[3 * AKS] = (bf16)(w.y >> 16);
            d[4 * AKS] = (bf16)(w.z & 0xffff); d[5 * AKS] = (bf16)(w.z >> 16); d[6 * AKS] = (bf16)(w.w & 0xffff); d[7 * AKS] = (bf16)(w.w >> 16); }
        __syncthreads();
        f32x4 S[8];
#pragma unroll
        for (int kt = 0; kt < 8; ++kt) { f32x4 s = {0.f, 0.f, 0.f, 0.f};
#pragma unroll
            for (int ks = 0; ks < 4; ++ks) { const bf16x8 kf = *(const bf16x8*)(Ks + (16 * kt + fr) * AKS + 32 * ks + 8 * fq); s = mfma16(qf[ks], kf, s); }
            S[kt] = s; }
        float mx[4];
#pragma unroll
        for (int i = 0; i < 4; ++i) mx[i] = -INFINITY;
#pragma unroll
        for (int kt = 0; kt < 8; ++kt)
#pragma unroll
            for (int i = 0; i < 4; ++i) { const int p = 16 * wave + 4 * fq + i, kk = 16 * kt + fr;
                const bool ok = half == 0 ? (kk >= p) : (kk <= p);
                const float v = ok ? S[kt][i] * scale : -INFINITY; S[kt][i] = v; mx[i] = fmaxf(mx[i], v); }
        float alpha[4], rs[4];
#pragma unroll
        for (int i = 0; i < 4; ++i) { float m = mx[i]; m = fmaxf(m, __shfl_xor(m, 1)); m = fmaxf(m, __shfl_xor(m, 2)); m = fmaxf(m, __shfl_xor(m, 4)); m = fmaxf(m, __shfl_xor(m, 8));
            const float mn = fmaxf(mrow[i], m); alpha[i] = __expf(mrow[i] - mn); mrow[i] = mn; rs[i] = 0.f; }
#pragma unroll
        for (int kt = 0; kt < 8; ++kt)
#pragma unroll
            for (int i = 0; i < 4; ++i) { const float p = __expf(S[kt][i] - mrow[i]); rs[i] += p; Pw[(4 * fq + i) * AKS + 16 * kt + fr] = (bf16)f2bf(p); }
#pragma unroll
        for (int i = 0; i < 4; ++i) { float s = rs[i]; s += __shfl_xor(s, 1); s += __shfl_xor(s, 2); s += __shfl_xor(s, 4); s += __shfl_xor(s, 8); lrow[i] = lrow[i] * alpha[i] + s; }
#pragma unroll
        for (int dtile = 0; dtile < 8; ++dtile)
#pragma unroll
            for (int i = 0; i < 4; ++i) O[dtile][i] *= alpha[i];
        __builtin_amdgcn_wave_barrier();
        asm volatile("s_waitcnt lgkmcnt(0)" ::: "memory");
#pragma unroll
        for (int ks = 0; ks < 4; ++ks) { const bf16x8 pa = *(const bf16x8*)(Pw + fr * AKS + 32 * ks + 8 * fq);
#pragma unroll
            for (int dtile = 0; dtile < 8; ++dtile) { const bf16x8 vb = *(const bf16x8*)(VTs + (16 * dtile + fr) * AKS + 32 * ks + 8 * fq); O[dtile] = mfma16(pa, vb, O[dtile]); } }
    }
    bf16* AO = (bf16*)(ws + WS_AO) + (size_t)g * MS * 512; float* LSE = (float*)(ws + WS_LSE) + (size_t)g * MS * 4;
#pragma unroll
    for (int i = 0; i < 4; ++i) { const size_t row = (size_t)(rowbase + (128 * n + 16 * wave + 4 * fq + i) * dil); const float inv = 1.f / lrow[i];
#pragma unroll
        for (int dtile = 0; dtile < 8; ++dtile) AO[row * 512 + hh * 128 + 16 * dtile + fr] = (bf16)f2bf(O[dtile][i] * inv);
        if (fr == 0) LSE[row * 4 + hh] = mrow[i] + logf(lrow[i]); }
    __syncthreads();
}

constexpr int N_SCAN_ITEMS = NB_PASS * 16, N_ATT_ITEMS = 3 * NB_PASS * 4 * 32;
__device__ __forceinline__ void phase_mix(const Args& a, unsigned char* lds, int pass) {
    unsigned* qctr = (unsigned*)(a.ws + WS_CTL) + CW_QCTR + 64 * pass;
    volatile int* slot = (volatile int*)(lds + 131072 + 1024);
    for (;;) {
        __syncthreads();
        if (opaque_tid() == 0) *slot = (int)atomicAdd(qctr, 1u);
        __syncthreads();
        const int item = *slot;
        if (item >= N_SCAN_ITEMS + N_ATT_ITEMS) break;
        if (item < N_SCAN_ITEMS) scan_item(a, lds, item); else attn_item(a, lds, item - N_SCAN_ITEMS);
    }
}

__device__ __forceinline__ void phase_post(const Args& a, int vcu, int G) {
    const int tid = opaque_tid(), lane = tid & 63, wave = tid >> 6;
    unsigned char* ws = a.ws;
    const bf16* P = (const bf16*)(ws + WS_P); const bf16* XC = (const bf16*)(ws + WS_XC); bf16* HR = (bf16*)(ws + WS_HR);
    const bf16* AO = (const bf16*)(ws + WS_AO); const float* LSE = (const float*)(ws + WS_LSE); bf16* UA = (bf16*)(ws + WS_UA);
    for (int r = vcu * NWAVES + wave; r < MS; r += G * NWAVES) {
#pragma unroll
        for (int h = 0; h < 4; ++h) {
            const int c = h * 256 + 4 * lane;
            const u32x2 hw = *(const u32x2*)(HR + (size_t)r * 1024 + c), ow = *(const u32x2*)(P + (size_t)r * INW + C_OA + c), zw = *(const u32x2*)(P + (size_t)r * INW + C_ZA + c), xw = *(const u32x2*)(XC + (size_t)r * 1024 + c);
            float hm[4] = {sigmoidf_(bflo(ow.x)) * bflo(hw.x), sigmoidf_(bfhi(ow.x)) * bfhi(hw.x), sigmoidf_(bflo(ow.y)) * bflo(hw.y), sigmoidf_(bfhi(ow.y)) * bfhi(hw.y)};
            float ss = (hm[0] * hm[0] + hm[1] * hm[1]) + (hm[2] * hm[2] + hm[3] * hm[3]);
            ss = wave_sum(ss);
            const float rinv = 1.f / sqrtf(ss * (1.f / 256.f) + EPS);
            const f32x4 gh = *(const f32x4*)(a.g_head + c), sk = *(const f32x4*)(a.skip + c);
            const float xc[4] = {bflo(xw.x), bfhi(xw.x), bflo(xw.y), bfhi(xw.y)}, za[4] = {bflo(zw.x), bfhi(zw.x), bflo(zw.y), bfhi(zw.y)};
            float o[4];
#pragma unroll
            for (int e = 0; e < 4; ++e) o[e] = (hm[e] * rinv * gh[e] + sk[e] * xc[e]) * siluf_(za[e]);
            u32x2 ov; ov.x = pk2(o[0], o[1]); ov.y = pk2(o[2], o[3]);
            *(u32x2*)(HR + (size_t)r * 1024 + c) = ov;
        }
#pragma unroll
        for (int hh = 0; hh < 4; ++hh) {
            const float l0 = LSE[(size_t)r * 4 + hh], l1 = LSE[(size_t)(MS + r) * 4 + hh], l2 = LSE[(size_t)(2 * MS + r) * 4 + hh];
            const float mx = fmaxf(l0, fmaxf(l1, l2));
            float w0 = __expf(l0 - mx), w1 = __expf(l1 - mx), w2 = __expf(l2 - mx); const float inv = 1.f / (w0 + w1 + w2); w0 *= inv; w1 *= inv; w2 *= inv;
            const int c = hh * 128 + 2 * lane;
            const unsigned o0 = *(const unsigned*)(AO + (size_t)r * 512 + c), o1 = *(const unsigned*)(AO + ((size_t)MS + r) * 512 + c), o2 = *(const unsigned*)(AO + ((size_t)2 * MS + r) * 512 + c);
            const unsigned zb = *(const unsigned*)(P + (size_t)r * INW + C_ZB + c);
            const float va = (w0 * bflo(o0) + w1 * bflo(o1) + w2 * bflo(o2)) * siluf_(bflo(zb));
            const float vb = (w0 * bfhi(o0) + w1 * bfhi(o1) + w2 * bfhi(o2)) * siluf_(bfhi(zb));
            *(unsigned*)(UA + (size_t)r * 512 + c) = pk2(va, vb);
        }
    }
}

__device__ __forceinline__ void phase_norm(const Args& a, int vcu, int G) {
    const int tid = opaque_tid(), lane = tid & 63, wave = tid >> 6;
    const float* rowss = (const float*)(a.ws + WS_CTL) + CW_ROWSS;
    for (int r = vcu * NWAVES + wave; r < MALL; r += G * NWAVES) {
        const float rinv = 1.f / sqrtf(rowss[r] * (1.f / DM) + EPS);
        f32x4* o = (f32x4*)(a.out + (size_t)r * DM) + lane;
#pragma unroll
        for (int j = 0; j < 4; ++j) { const f32x4 gf = *((const f32x4*)a.g_final + lane + 64 * j); o[64 * j] = o[64 * j] * rinv * gf; }
    }
}

constexpr int PH_PER_PASS = 7, PH_TOTAL = 2 + PH_PER_PASS * NPASS + 1;
enum { K_PROLOGUE = 0, K_H = 1, K_INPROJ = 2, K_PREP = 3, K_QK = 4, K_MIX = 5, K_POST = 6, K_OUT1 = 7, K_OUT2 = 8, K_NORM = 9 };

template <int KIND>
__device__ __forceinline__ void run_phase(const Args& args, unsigned char* lds, int pass) {
    const int G = gridDim.x; const int bx = blockIdx.x;
    const int vcu = (G % 8 == 0) ? (bx % 8) * (G / 8) + bx / 8 : bx;
    unsigned char* ws = args.ws;
    PG8_LAS unsigned char* lds3 = (PG8_LAS unsigned char*)lds;
    if constexpr (KIND == K_PROLOGUE) phase_prologue(args, lds, vcu, G);
    else if constexpr (KIND == K_H) phase_h(args, lds, vcu, G);
    else if constexpr (KIND == K_NORM) phase_norm(args, vcu, G);
    else if constexpr (KIND == K_INPROJ) {
        pg8::Gemm<1024, 1024, 1024> g{(const bf16*)(ws + WS_H) + (size_t)pass * MS * 1024, (const bf16*)(ws + WS_WIN)};
        pg8::StaticOrder S; S.init(MS, INW, G, bx);
        EpiProj E{(bf16*)(ws + WS_P)};
        pg8::gemm_phase<EpiProj, pg8::StaticOrder, true, true>(lds3, g, S, E);
    } else if constexpr (KIND == K_PREP) phase_prep(args, lds, vcu, G, pass);
    else if constexpr (KIND == K_QK) {
        pg8::Gemm<1024, 256, 256, 512, 512 * 256 * 2> g{(const bf16*)(ws + WS_XC), (const bf16*)(ws + WS_WQK)};
        pg8::GroupOrder S; S.init(MS, G, bx);
        EpiQK E{(bf16*)(ws + WS_QM), (bf16*)(ws + WS_KM)};
        pg8::gemm_phase<EpiQK, pg8::GroupOrder, true, true>(lds3, g, S, E);
    } else if constexpr (KIND == K_MIX) phase_mix(args, lds, pass);
    else if constexpr (KIND == K_POST) phase_post(args, vcu, G);
    else if constexpr (KIND == K_OUT1) {
        { pg8::Gemm<1024, 1024, 1024> g{(const bf16*)(ws + WS_HR), (const bf16*)(ws + WS_WOM)};
          pg8::StaticOrder S; S.init(MS, 1024, G, bx);
          EpiMerge<0> E{(const bf16*)(ws + WS_P), (float*)(ws + WS_T), (bf16*)(ws + WS_MG)};
          pg8::gemm_phase<EpiMerge<0>, pg8::StaticOrder, true, true>(lds3, g, S, E); }
        { pg8::Gemm<512, 512, 512> g{(const bf16*)(ws + WS_UA), (const bf16*)(ws + WS_WOA)};
          pg8::StaticOrder S; S.init(MS, 1024, G, bx);
          EpiMerge<1> E{(const bf16*)(ws + WS_P), (float*)(ws + WS_T), (bf16*)(ws + WS_MG)};
          pg8::gemm_phase<EpiMerge<1>, pg8::StaticOrder, true, true>(lds3, g, S, E); }
    } else if constexpr (KIND == K_OUT2) {
        pg8::Gemm<1024, 1024, 1024> g{(const bf16*)(ws + WS_MG), (const bf16*)(ws + WS_WO)};
        pg8::StaticOrder S; S.init(MS, 1024, G, bx);
        EpiOut E{args.x, args.out, (const float*)(ws + WS_MOD) + 2048, (float*)(ws + WS_CTL) + CW_ROWSS, pass * MS};
        pg8::gemm_phase<EpiOut, pg8::StaticOrder, true, true>(lds3, g, S, E);
    }
}

#if !MK_ONE_LAUNCH
template <int KIND>
__global__ void __launch_bounds__(NTHR, 2) k_phase(Args args) {
    extern __shared__ __attribute__((aligned(16))) unsigned char lds[];
    run_phase<KIND>(args, lds, args.ph_lo);
}
#else
__global__ void __launch_bounds__(NTHR, 2) mk_fwd(Args args) {
    extern __shared__ __attribute__((aligned(16))) unsigned char lds[];
    for (int gp = args.ph_lo; gp < args.ph_hi; ++gp) {
        if (gp == 0) run_phase<K_PROLOGUE>(args, lds, 0);
        else if (gp == 1) run_phase<K_H>(args, lds, 0);
        else if (gp == PH_TOTAL - 1) run_phase<K_NORM>(args, lds, 0);
        else {
            const int pass = (gp - 2) / PH_PER_PASS, k = (gp - 2) % PH_PER_PASS;
            if (k == 0) run_phase<K_INPROJ>(args, lds, pass);
            else if (k == 1) run_phase<K_PREP>(args, lds, pass);
            else if (k == 2) run_phase<K_QK>(args, lds, pass);
            else if (k == 3) run_phase<K_MIX>(args, lds, pass);
            else if (k == 4) run_phase<K_POST>(args, lds, pass);
            else if (k == 5) run_phase<K_OUT1>(args, lds, pass);
            else run_phase<K_OUT2>(args, lds, pass);
        }
        if (gp + 1 < args.ph_hi) { __threadfence(); cg::this_grid().sync(); }
    }
}
#endif

extern "C" void kernel_launch(void* const* d_in, const int* in_sizes, int n_in, void* d_out, int out_size, void* d_ws, size_t ws_size, hipStream_t stream) {
    static int grid = 0;
    if (grid == 0) {
        if (n_in != 19 || in_sizes[0] != MALL * DM || out_size != MALL * DM || ws_size < WS_END) { fprintf(stderr, "kernel_launch: unexpected shapes (n_in %d, ws %zu)\n", n_in, ws_size); grid = -1; return; }
        int dev = 0, cus = 0, per_cu = 0;
        (void)hipGetDevice(&dev); (void)hipDeviceGetAttribute(&cus, hipDeviceAttributeMultiprocessorCount, dev);
#if MK_ONE_LAUNCH
        (void)hipFuncSetAttribute((const void*)mk_fwd, hipFuncAttributeMaxDynamicSharedMemorySize, LDS_BYTES);
        (void)hipOccupancyMaxActiveBlocksPerMultiprocessor(&per_cu, (const void*)mk_fwd, NTHR, LDS_BYTES);
        if (per_cu < 1) { fprintf(stderr, "kernel_launch: occupancy query says %d\n", per_cu); per_cu = 1; }
#else
#define SETATTR(KIND) (void)hipFuncSetAttribute((const void*)k_phase<KIND>, hipFuncAttributeMaxDynamicSharedMemorySize, LDS_BYTES)
        SETATTR(K_PROLOGUE); SETATTR(K_H); SETATTR(K_INPROJ); SETATTR(K_PREP); SETATTR(K_QK); SETATTR(K_MIX); SETATTR(K_POST); SETATTR(K_OUT1); SETATTR(K_OUT2); SETATTR(K_NORM);
        (void)per_cu;
#endif
        (void)hipGetLastError();
        grid = cus;
    }
    if (grid < 0) return;
    (void)hipMemsetAsync((char*)d_ws + WS_CTL, 0, CTL_ZERO_BYTES, stream);
    Args a{};
    a.x = (const float*)d_in[0]; a.c = (const float*)d_in[1]; a.pos = (const int*)d_in[2]; a.w_ada = (const float*)d_in[3]; a.b_ada = (const float*)d_in[4];
    a.g_norm = (const float*)d_in[5]; a.w_in = (const float*)d_in[6]; a.b_ig = (const float*)d_in[7]; a.b_fg = (const float*)d_in[8]; a.w_conv = (const float*)d_in[9];
    a.b_conv = (const float*)d_in[10]; a.w_q = (const float*)d_in[11]; a.w_k = (const float*)d_in[12]; a.g_head = (const float*)d_in[13]; a.skip = (const float*)d_in[14];
    a.w_om = (const float*)d_in[15]; a.w_oa = (const float*)d_in[16]; a.w_o = (const float*)d_in[17]; a.g_final = (const float*)d_in[18];
    a.out = (float*)d_out; a.ws = (unsigned char*)d_ws;
#if MK_ONE_LAUNCH
    a.ph_lo = 0; a.ph_hi = PH_TOTAL;
    void* params[] = {&a};
    hipError_t e = hipLaunchCooperativeKernel((const void*)mk_fwd, dim3(grid), dim3(NTHR), params, LDS_BYTES, stream);
    if (e != hipSuccess) fprintf(stderr, "cooperative launch failed: %s\n", hipGetErrorString(e));
#else
#define LAUNCH(KIND, PASS) do { a.ph_lo = (PASS); a.ph_hi = 0; hipLaunchKernelGGL(k_phase<KIND>, dim3(grid), dim3(NTHR), LDS_BYTES, stream, a); } while (0)
    LAUNCH(K_PROLOGUE, 0); LAUNCH(K_H, 0);
    for (int p = 0; p < NPASS; ++p) { LAUNCH(K_INPROJ, p); LAUNCH(K_PREP, p); LAUNCH(K_QK, p); LAUNCH(K_MIX, p); LAUNCH(K_POST, p); LAUNCH(K_OUT1, p); LAUNCH(K_OUT2, p); }
    LAUNCH(K_NORM, 0);
#endif
}
```

```cpp
#include <hip/hip_runtime.h>
#include <hip/hip_cooperative_groups.h>
#include <cstdio>
#include <cstdint>
namespace cg = cooperative_groups;

#ifndef MK_ONE_LAUNCH
#define MK_ONE_LAUNCH 1
#endif

__device__ __forceinline__ int opaque_tid() { int t = threadIdx.x; asm volatile("" : "+v"(t)); return t; }
namespace pg8 {
#define PG8_LAS __attribute__((address_space(3)))
typedef unsigned short bf16_t;
typedef short bf16x8 __attribute__((ext_vector_type(8)));
typedef float f32x4 __attribute__((ext_vector_type(4)));
typedef unsigned u32x4 __attribute__((ext_vector_type(4)));
constexpr int BM = 256, BK = 64, HALF = 128, HTB = HALF * BK * 2, STAGE_BYTES = 8 * HTB, NXCD = 8, WGM = 8;

__host__ __device__ __forceinline__ int lds_byte(int r, int c) { const int st = (r >> 4) * 2 + (c >> 5), rr = r & 15, cc = c & 31, ob = rr * 64 + cc * 2; return st * 1024 + (ob ^ (((ob >> 9) & 1) << 5)); }
__host__ __device__ __forceinline__ void stage_rc(int b, int& R, int& C) { const int st = b / 1024, sb = b % 1024, swz = sb ^ (((sb >> 9) & 1) << 5); R = (st >> 1) * 16 + swz / 64; C = (st & 1) * 32 + (swz % 64) / 2; }
__host__ __device__ __forceinline__ int perm32(int rho) { const int n = rho >> 4, i = rho & 15; return 8 * (i >> 2) + 4 * n + (i & 3); }

struct Unit { int pm, pn, g; };
template <int LDA, int LDB, int KK, int AGS = 0, int BGS = 0> struct Gemm {
    const bf16_t* A; const bf16_t* Bt;
    static constexpr int lda = LDA, ldb = LDB, K = KK;
    __device__ __forceinline__ const char* abase(const Unit& u) const { return (const char*)A + (size_t)(u.g * AGS) + (size_t)u.pm * (size_t)(BM * 2 * LDA); }
    __device__ __forceinline__ const char* bbase(const Unit& u) const { return (const char*)Bt + (size_t)(u.g * BGS) + (size_t)u.pn * (size_t)(BM * 2 * LDB); }
};

struct StaticOrder {
    int nM, nN, nwg, G, c;
    __host__ __device__ void init(int M, int N, int G_, int c_) { nM = M / BM; nN = N / BM; nwg = nM * nN; G = G_; c = c_; }
    __host__ __device__ bool next(int i, Unit& u) const {
        const long L = (long)i * G + c; if (L >= nwg) return false;
        int wgid = (int)L; { const int q = nwg / NXCD, r = nwg % NXCD, xcd = wgid % NXCD, off = wgid / NXCD; wgid = (xcd < r ? xcd * (q + 1) : r * (q + 1) + (xcd - r) * q) + off; }
        const int nig = WGM * nN, gid = wgid / nig, fm = gid * WGM, gsz = (nM - fm) < WGM ? (nM - fm) : WGM;
        u.pm = fm + ((wgid % nig) % gsz); u.pn = (wgid % nig) / gsz; u.g = 0; return true;
    }
    __device__ __forceinline__ void a_ready(const Unit&) const {}
    __device__ __forceinline__ void done(const Unit&) const {}
};
struct GroupOrder {
    int nunits, G, c;
    __host__ __device__ void init(int M, int G_, int c_) { nunits = (M / BM) * 8; G = G_; c = c_; }
    __host__ __device__ bool next(int i, Unit& u) const {
        const long L = (long)i * G + c; if (L >= nunits) return false;
        u.pm = (int)(L >> 3); u.g = (int)((L & 7) >> 1); u.pn = (int)(L & 1); return true;
    }
    __device__ __forceinline__ void a_ready(const Unit&) const {}
    __device__ __forceinline__ void done(const Unit&) const {}
};

__device__ __forceinline__ unsigned cvt_pk_bf16(float lo, float hi) { unsigned r; asm volatile("v_cvt_pk_bf16_f32 %0, %1, %2" : "=v"(r) : "v"(lo), "v"(hi)); return r; }

template <class Epi, class Sched, bool ALIGN_EPI, bool SP2, class GemmT>
__device__ __forceinline__ void gemm_phase(PG8_LAS unsigned char* lds, const GemmT g, const Sched& S, const Epi& E) {
    const int tid = opaque_tid(), wid = __builtin_amdgcn_readfirstlane(tid >> 6), lane = tid & 63, wr = wid >> 2, wc = wid & 3, fr = lane & 15, fq = lane >> 4;
    constexpr int K = GemmT::K, nt = K / BK;
    unsigned voffA[2], voffB[2];
#pragma unroll
    for (int i = 0; i < 2; ++i) { int R, C; stage_rc(tid * 16 + i * 8192, R, C); const int Rb = Epi::PERM ? ((R & ~31) + perm32(R & 31)) : R;
        voffA[i] = (unsigned)(R * g.lda + C) * 2u; voffB[i] = (unsigned)(Rb * g.ldb + C) * 2u; }
    const size_t kstep = (size_t)(BK * 2);
    const size_t hstepA = (size_t)HALF * g.lda * 2, hstepB = (size_t)HALF * g.ldb * 2;
    const unsigned ldsw = (unsigned)wid * 1024u;
    const int aoff = lds_byte(wr * 64 + fr, fq * 8), boff = lds_byte(wc * 32 + fr, fq * 8);
#define PG8_SA(b, h) (((b) * 2 + (h)) * HTB)
#define PG8_SB(b, h) ((4 + (b) * 2 + (h)) * HTB)
#define PG8_STAGE(bufoff, gbase, voff) do { _Pragma("unroll") for (int _i = 0; _i < 2; ++_i) \
        __builtin_amdgcn_global_load_lds((const unsigned*)((const char*)(gbase) + (voff)[_i]), (PG8_LAS unsigned*)(lds + (bufoff) + ldsw + _i * 8192), 16, 0, 0); } while (0)
#define PG8_LDA(dst, b, h) do { _Pragma("unroll") for (int m = 0; m < 4; ++m) _Pragma("unroll") for (int k = 0; k < 2; ++k) dst[m][k] = *(const PG8_LAS bf16x8*)(lds + PG8_SA(b, h) + aoff + m * 2048 + k * 1024); } while (0)
#define PG8_LDB(dst, b, h) do { _Pragma("unroll") for (int n = 0; n < 2; ++n) _Pragma("unroll") for (int k = 0; k < 2; ++k) dst[n][k] = *(const PG8_LAS bf16x8*)(lds + PG8_SB(b, h) + boff + n * 2048 + k * 1024); } while (0)
#define PG8_MMA(ai, bj, At, Bt) do { __builtin_amdgcn_s_setprio(1); _Pragma("unroll") for (int m = 0; m < 4; ++m) _Pragma("unroll") for (int n = 0; n < 2; ++n) _Pragma("unroll") for (int k = 0; k < 2; ++k) \
        acc[ai][bj][m][n] = __builtin_amdgcn_mfma_f32_16x16x32_bf16(Bt[n][k], At[m][k], acc[ai][bj][m][n], 0, 0, 0); __builtin_amdgcn_s_setprio(0); } while (0)
#define PG8_WAIT_V(n) asm volatile("s_waitcnt vmcnt(" #n ")" ::: "memory")
#define PG8_WAIT_L(n) asm volatile("s_waitcnt lgkmcnt(" #n ")" ::: "memory")
#define PG8_BAR __builtin_amdgcn_s_barrier()
#define PG8_SCHED __builtin_amdgcn_sched_barrier(0)
    Unit cur, nxt; int ui = 0;
    if (!S.next(0, cur)) return;
    f32x4 acc[2][2][4][2];
#pragma unroll
    for (int a = 0; a < 2; ++a)
#pragma unroll
        for (int b = 0; b < 2; ++b)
#pragma unroll
            for (int m = 0; m < 4; ++m)
#pragma unroll
                for (int n = 0; n < 2; ++n) acc[a][b][m][n] = (f32x4){0.f, 0.f, 0.f, 0.f};
    bf16x8 At[4][2], B0[2][2], B1[2][2];
    const char* cA = g.abase(cur); const char* cB = g.bbase(cur);
    S.a_ready(cur);
    if constexpr (SP2) {
        PG8_STAGE(PG8_SB(0, 0), cB, voffB); PG8_STAGE(PG8_SB(0, 1), cB + hstepB, voffB); PG8_STAGE(PG8_SA(0, 0), cA, voffA); PG8_STAGE(PG8_SA(0, 1), cA + hstepA, voffA);
        if (wr == 1) PG8_BAR;
        PG8_WAIT_V(2); PG8_BAR;
        PG8_STAGE(PG8_SB(1, 0), cB + kstep, voffB); PG8_STAGE(PG8_SA(1, 0), cA + kstep, voffA); PG8_STAGE(PG8_SB(1, 1), cB + hstepB + kstep, voffB);
        PG8_WAIT_V(6); PG8_BAR;
    } else {
        PG8_STAGE(PG8_SB(0, 0), cB, voffB); PG8_STAGE(PG8_SA(0, 0), cA, voffA); PG8_STAGE(PG8_SB(0, 1), cB + hstepB, voffB); PG8_STAGE(PG8_SA(0, 1), cA + hstepA, voffA);
        if (wr == 1) PG8_BAR;
        PG8_WAIT_V(4); PG8_BAR;
        PG8_STAGE(PG8_SB(1, 0), cB + kstep, voffB); PG8_STAGE(PG8_SA(1, 0), cA + kstep, voffA); PG8_STAGE(PG8_SB(1, 1), cB + hstepB + kstep, voffB);
        PG8_WAIT_V(6); PG8_BAR;
    }
    for (;;) {
        const bool has_next = S.next(ui + 1, nxt);
        const char* nA = has_next ? g.abase(nxt) : cA; const char* nB = has_next ? g.bbase(nxt) : cB;
#pragma nounroll
        for (int t = 0; t < nt; t += 2) {
            const bool last = (t == nt - 2);
            const char* a1 = cA + (size_t)(t + 1) * kstep;
            const char* a2 = last ? nA : cA + (size_t)(t + 2) * kstep; const char* b2 = last ? nB : cB + (size_t)(t + 2) * kstep;
            const char* a3 = a2 + kstep; const char* b3 = b2 + kstep;
            if (last && has_next) S.a_ready(nxt);
            if constexpr (SP2) {
            PG8_LDB(B0, 0, 0); PG8_LDB(B1, 0, 1); PG8_SCHED; PG8_LDA(At, 0, 0); PG8_STAGE(PG8_SA(1, 1), a1 + hstepA, voffA);
            PG8_WAIT_V(8); PG8_WAIT_L(0); PG8_BAR; PG8_MMA(0, 0, At, B0); PG8_MMA(0, 1, At, B1); PG8_BAR; PG8_SCHED;
            PG8_LDA(At, 0, 1); PG8_STAGE(PG8_SB(0, 0), b2, voffB); PG8_STAGE(PG8_SB(0, 1), b2 + hstepB, voffB); PG8_STAGE(PG8_SA(0, 0), a2, voffA);
            PG8_WAIT_V(8); PG8_WAIT_L(0); PG8_BAR; PG8_MMA(1, 0, At, B0); PG8_MMA(1, 1, At, B1); PG8_BAR; PG8_SCHED;
            PG8_LDB(B0, 1, 0); PG8_LDB(B1, 1, 1); PG8_SCHED; PG8_LDA(At, 1, 0); PG8_STAGE(PG8_SA(0, 1), a2 + hstepA, voffA);
            PG8_WAIT_V(8); PG8_WAIT_L(0); PG8_BAR; PG8_MMA(0, 0, At, B0); PG8_MMA(0, 1, At, B1); PG8_BAR; PG8_SCHED;
            PG8_LDA(At, 1, 1); PG8_STAGE(PG8_SB(1, 0), b3, voffB); PG8_STAGE(PG8_SB(1, 1), b3 + hstepB, voffB); PG8_STAGE(PG8_SA(1, 0), a3, voffA);
            PG8_WAIT_V(8); PG8_WAIT_L(0); PG8_BAR; PG8_MMA(1, 0, At, B0); PG8_MMA(1, 1, At, B1); PG8_BAR; PG8_SCHED;
            } else {
            PG8_LDB(B0, 0, 0); PG8_SCHED; PG8_LDA(At, 0, 0); PG8_STAGE(PG8_SA(1, 1), a1 + hstepA, voffA);
            PG8_WAIT_L(8); PG8_BAR; PG8_WAIT_L(0); PG8_MMA(0, 0, At, B0); PG8_BAR; PG8_SCHED;
            PG8_LDB(B1, 0, 1); PG8_STAGE(PG8_SB(0, 0), b2, voffB);
            PG8_BAR; PG8_WAIT_L(0); PG8_MMA(0, 1, At, B1); PG8_BAR;
            PG8_LDA(At, 0, 1); PG8_STAGE(PG8_SA(0, 0), a2, voffA);
            PG8_BAR; PG8_WAIT_L(0); PG8_MMA(1, 0, At, B0); PG8_BAR; PG8_SCHED;
            PG8_STAGE(PG8_SB(0, 1), b2 + hstepB, voffB);
            PG8_WAIT_V(6); PG8_BAR; PG8_MMA(1, 1, At, B1); PG8_BAR;
            PG8_LDB(B0, 1, 0); PG8_SCHED; PG8_LDA(At, 1, 0); PG8_STAGE(PG8_SA(0, 1), a2 + hstepA, voffA);
            PG8_WAIT_L(8); PG8_BAR; PG8_WAIT_L(0); PG8_MMA(0, 0, At, B0); PG8_BAR; PG8_SCHED;
            PG8_LDB(B1, 1, 1); PG8_STAGE(PG8_SB(1, 0), b3, voffB);
            PG8_BAR; PG8_WAIT_L(0); PG8_MMA(0, 1, At, B1); PG8_BAR;
            PG8_LDA(At, 1, 1); PG8_STAGE(PG8_SA(1, 0), a3, voffA);
            PG8_BAR; PG8_WAIT_L(0); PG8_MMA(1, 0, At, B0); PG8_BAR; PG8_SCHED;
            PG8_STAGE(PG8_SB(1, 1), b3 + hstepB, voffB);
            PG8_WAIT_V(6); PG8_BAR; PG8_MMA(1, 1, At, B1); PG8_BAR;
            }
        }
        if constexpr (ALIGN_EPI) { if (wr == 0) PG8_BAR; }
        E(acc, cur, wr, wc, fr, fq); S.done(cur);
        if (!has_next) break;
#pragma unroll
        for (int a = 0; a < 2; ++a)
#pragma unroll
            for (int b = 0; b < 2; ++b)
#pragma unroll
                for (int m = 0; m < 4; ++m)
#pragma unroll
                    for (int n = 0; n < 2; ++n) acc[a][b][m][n] = (f32x4){0.f, 0.f, 0.f, 0.f};
        cur = nxt; cA = nA; cB = nB; ++ui;
        if constexpr (ALIGN_EPI) { if (wr == 1) PG8_BAR; }
    }
    PG8_WAIT_V(0);
    if constexpr (!ALIGN_EPI) { if (wr == 0) PG8_BAR; }
    PG8_BAR;
#undef PG8_SA
#undef PG8_SB
#undef PG8_STAGE
#undef PG8_LDA
#undef PG8_LDB
#undef PG8_MMA
#undef PG8_WAIT_V
#undef PG8_WAIT_L
#undef PG8_BAR
#undef PG8_SCHED
}
}

constexpr int NWAVES = 8, NTHR = 512;
constexpr int DM = 1024, NBATCH = 16, SEQ = 4096, MALL = NBATCH * SEQ;
constexpr int NB_PASS = 4, MS = NB_PASS * SEQ, NPASS = NBATCH / NB_PASS;
constexpr int INW_SRC = 11272, INW = 11264;
constexpr int C_XA = 0, C_VA = 1024, C_OA = 2048, C_ZA = 3072, C_QA = 4096, C_KA = 5632, C_VT = 7168, C_ZB = 8704, C_GA = 9216, C_GB = 10240;
constexpr float EPS = 1e-6f;

constexpr size_t MiB = 1u << 20;
constexpr size_t WS_CTL = 0, CTL_ZERO_BYTES = 1 * MiB;
constexpr size_t WS_MOD = 1 * MiB;
constexpr size_t WS_WG = 1 * MiB + 256 * 1024;
constexpr size_t WS_WIN = 2 * MiB;
constexpr size_t WS_WQK = 24 * MiB;
constexpr size_t WS_WOM = 25 * MiB, WS_WOA = 27 * MiB, WS_WO = 28 * MiB;
constexpr size_t WS_IG = 30 * MiB, WS_FG = 31 * MiB;
constexpr size_t WS_GSC = 32 * MiB;
constexpr size_t WS_LSE = 34 * MiB;
constexpr size_t WS_DEN = 35 * MiB;
constexpr size_t WS_H = 36 * MiB;
constexpr size_t WS_P = 164 * MiB;
constexpr size_t WS_XC = 516 * MiB;
constexpr size_t WS_QM = 548 * MiB, WS_KM = 580 * MiB;
constexpr size_t WS_HR = 612 * MiB;
constexpr size_t WS_AO = 644 * MiB;
constexpr size_t WS_UA = 692 * MiB;
constexpr size_t WS_T = 708 * MiB;
constexpr size_t WS_MG = 772 * MiB;
constexpr size_t WS_SG = 804 * MiB;
constexpr size_t WS_KTG = 812 * MiB;
constexpr size_t WS_VTG = 844 * MiB;
constexpr size_t WS_END = 876 * MiB;
constexpr int CW_QCTR = 1024;
constexpr int CW_ROWSS = 65536;
static_assert((CW_ROWSS + MALL) * 4 <= (int)CTL_ZERO_BYTES, "ctl");

constexpr int LDS_BYTES = 147456;

typedef unsigned short bf16;
typedef float f32x4 __attribute__((ext_vector_type(4)));
typedef float f32x2 __attribute__((ext_vector_type(2)));
typedef short bf16x8 __attribute__((ext_vector_type(8)));
typedef unsigned u32x4 __attribute__((ext_vector_type(4)));
typedef unsigned u32x2 __attribute__((ext_vector_type(2)));

__device__ __forceinline__ unsigned f2bf(float f) { unsigned u = __builtin_bit_cast(unsigned, f); return (u + 0x7fffu + ((u >> 16) & 1u)) >> 16; }
__device__ __forceinline__ unsigned pk2(float lo, float hi) { return f2bf(lo) | (f2bf(hi) << 16); }
__device__ __forceinline__ float bflo(unsigned w) { return __builtin_bit_cast(float, w << 16); }
__device__ __forceinline__ float bfhi(unsigned w) { return __builtin_bit_cast(float, w & 0xffff0000u); }
__device__ __forceinline__ float bf1(bf16 v) { return __builtin_bit_cast(float, (unsigned)v << 16); }
__device__ __forceinline__ float sigmoidf_(float x) { return 1.f / (1.f + __expf(-x)); }
__device__ __forceinline__ float siluf_(float x) { return x / (1.f + __expf(-x)); }
__device__ __forceinline__ float wave_sum(float v) {
#pragma unroll
    for (int o = 1; o < 64; o <<= 1) v += __shfl_xor(v, o);
    return v;
}
__device__ __forceinline__ void unpack8(const u32x4 w, float* f) {
    f[0] = bflo(w.x); f[1] = bfhi(w.x); f[2] = bflo(w.y); f[3] = bfhi(w.y); f[4] = bflo(w.z); f[5] = bfhi(w.z); f[6] = bflo(w.w); f[7] = bfhi(w.w);
}

struct Args {
    const float* x; const float* c; const int* pos; const float* w_ada; const float* b_ada; const float* g_norm; const float* w_in;
    const float* b_ig; const float* b_fg; const float* w_conv; const float* b_conv; const float* w_q; const float* w_k; const float* g_head;
    const float* skip; const float* w_om; const float* w_oa; const float* w_o; const float* g_final;
    float* out; unsigned char* ws; int ph_lo, ph_hi;
};

__device__ __forceinline__ void transpose_item(const float* W, int K, int Nsrc, int nblk, int src_col_off, bf16* WT, int ldt, int row_off, float scale, float* scr, int item, int lane) {
    const int kb = item / nblk, nb = item % nblk, k0 = 64 * kb, n0 = 32 * nb;
#pragma unroll 8
    for (int i = 0; i < 32; ++i) { const int kk = 2 * i + (lane >> 5); scr[kk * 33 + (lane & 31)] = W[(size_t)(k0 + kk) * Nsrc + src_col_off + n0 + (lane & 31)]; }
    __builtin_amdgcn_wave_barrier();
    asm volatile("s_waitcnt lgkmcnt(0)" ::: "memory");
    const int cc = lane & 7;
#pragma unroll
    for (int j = 0; j < 4; ++j) { const int n = (lane >> 3) + 8 * j; const float* s = scr + (8 * cc) * 33 + n;
        u32x4 o; o.x = pk2(s[0 * 33] * scale, s[1 * 33] * scale); o.y = pk2(s[2 * 33] * scale, s[3 * 33] * scale); o.z = pk2(s[4 * 33] * scale, s[5 * 33] * scale); o.w = pk2(s[6 * 33] * scale, s[7 * 33] * scale);
        *(u32x4*)(WT + (size_t)(row_off + n0 + n) * ldt + k0 + 8 * cc) = o; }
    asm volatile("s_waitcnt lgkmcnt(0)" ::: "memory");
    __builtin_amdgcn_wave_barrier();
}

__device__ __forceinline__ void phase_prologue(const Args& a, unsigned char* lds, int vcu, int G) {
    const int tid = opaque_tid(), lane = tid & 63, wave = tid >> 6;
    unsigned char* ws = a.ws;
    if (vcu < 48) {
        float* sc = (float*)lds;
        float* red = (float*)(lds + 65536);
        for (int i = tid; i < 16 * 1024; i += NTHR) sc[i] = siluf_(a.c[i]);
        __syncthreads();
        const int n = vcu * 64 + lane;
        float acc[16];
#pragma unroll
        for (int b = 0; b < 16; ++b) acc[b] = 0.f;
        const int k0 = wave * 128;
#pragma unroll 4
        for (int k = k0; k < k0 + 128; ++k) { const float w = a.w_ada[(size_t)k * 3072 + n];
#pragma unroll
            for (int b = 0; b < 16; ++b) acc[b] += sc[b * 1024 + k] * w; }
#pragma unroll
        for (int b = 0; b < 16; ++b) red[(wave * 16 + b) * 64 + lane] = acc[b];
        __syncthreads();
        float* mod = (float*)(ws + WS_MOD);
        for (int i = tid; i < 16 * 64; i += NTHR) { const int b = i >> 6, l = i & 63, nn = vcu * 64 + l; float s = 0.f;
#pragma unroll
            for (int w = 0; w < 8; ++w) s += red[(w * 16 + b) * 64 + l];
            s += a.b_ada[nn];
            const int part = nn >> 10, col = nn & 1023;
            if (part == 1) s = a.g_norm[col] * (1.f + s);
            mod[b * 3072 + nn] = s; }
        __syncthreads();
    }
    {
        float* scr = (float*)lds + wave * (64 * 33);
        const int gw = vcu * NWAVES + wave, NGW = G * NWAVES;
        constexpr int I_IN = (1024 / 64) * (INW / 32);
        constexpr int I_QK = 8 * (256 / 64) * (256 / 32);
        constexpr int I_OM = 16 * 32, I_OA = 8 * 32, I_O = 16 * 32;
        constexpr int NITEMS = I_IN + I_QK + I_OM + I_OA + I_O;
        for (int it = gw; it < NITEMS; it += NGW) {
            int r = it;
            if (r < I_IN) { const int nb = r % (INW / 32); const int off = (nb * 32 >= 4096) ? 8 : 0;
                transpose_item(a.w_in, 1024, INW_SRC, INW / 32, off, (bf16*)(ws + WS_WIN), 1024, 0, 1.f, scr, r, lane); continue; } r -= I_IN;
            if (r < I_QK) { const int mtx = r >> 5, rr = r & 31, h = mtx >> 1, isk = mtx & 1;
                const float* W = (isk ? a.w_k : a.w_q) + (size_t)h * 65536;
                transpose_item(W, 256, 256, 8, 0, (bf16*)(ws + WS_WQK) + (size_t)h * 512 * 256, 256, isk * 256, isk ? 0.0625f : 1.f, scr, rr, lane); continue; } r -= I_QK;
            if (r < I_OM) { transpose_item(a.w_om, 1024, 1024, 32, 0, (bf16*)(ws + WS_WOM), 1024, 0, 1.f, scr, r, lane); continue; } r -= I_OM;
            if (r < I_OA) { transpose_item(a.w_oa, 512, 1024, 32, 0, (bf16*)(ws + WS_WOA), 512, 0, 1.f, scr, r, lane); continue; } r -= I_OA;
            transpose_item(a.w_o, 1024, 1024, 32, 0, (bf16*)(ws + WS_WO), 1024, 0, 1.f, scr, r, lane);
        }
        float* wg = (float*)(ws + WS_WG);
        for (int i = (vcu * NTHR + tid); i < 8 * 1024; i += G * NTHR) { const int j = i >> 10, k = i & 1023; wg[i] = a.w_in[(size_t)k * INW_SRC + 4096 + j]; }
    }
}

__device__ __forceinline__ void phase_h(const Args& a, unsigned char* lds, int vcu, int G) {
    const int tid = opaque_tid(), lane = tid & 63, wave = tid >> 6;
    unsigned char* ws = a.ws;
    float* wg = (float*)lds;
    { const float* src = (const float*)(ws + WS_WG); for (int i = tid; i < 8192; i += NTHR) wg[i] = src[i]; }
    __syncthreads();
    const float* mod = (const float*)(ws + WS_MOD);
    bf16* H = (bf16*)(ws + WS_H);
    float* IG = (float*)(ws + WS_IG); float* FG = (float*)(ws + WS_FG);
    const int gw = vcu * NWAVES + wave, NGW = G * NWAVES;
    for (int row = gw; row < MALL; row += NGW) {
        const int b = row >> 12;
        const f32x4* xr = (const f32x4*)(a.x + (size_t)row * DM) + lane;
        f32x4 v[4]; float ss = 0.f;
#pragma unroll
        for (int j = 0; j < 4; ++j) { v[j] = xr[64 * j]; ss += (v[j].x * v[j].x + v[j].y * v[j].y) + (v[j].z * v[j].z + v[j].w * v[j].w); }
        ss = wave_sum(ss);
        const float rinv = 1.f / sqrtf(ss * (1.f / DM) + EPS);
        float pg[8];
#pragma unroll
        for (int g = 0; g < 8; ++g) pg[g] = 0.f;
        u32x2* ho = (u32x2*)(H + (size_t)row * DM) + lane;
#pragma unroll
        for (int j = 0; j < 4; ++j) {
            const int col = 4 * lane + 256 * j;
            const f32x4 sh = *(const f32x4*)(mod + b * 3072 + col), gs = *(const f32x4*)(mod + b * 3072 + 1024 + col);
            f32x4 h = v[j] * rinv * gs + sh;
#pragma unroll
            for (int g = 0; g < 8; ++g) { const f32x4 w = *(const f32x4*)(wg + g * 1024 + col); pg[g] += (h.x * w.x + h.y * w.y) + (h.z * w.z + h.w * w.w); }
            u32x2 o; o.x = pk2(h.x, h.y); o.y = pk2(h.z, h.w); ho[64 * j] = o;
        }
#pragma unroll
        for (int g = 0; g < 8; ++g) pg[g] = wave_sum(pg[g]);
        if (lane == 0) {
            f32x4 ig = {pg[0] + a.b_ig[0], pg[1] + a.b_ig[1], pg[2] + a.b_ig[2], pg[3] + a.b_ig[3]};
            f32x4 fg = {pg[4] + a.b_fg[0], pg[5] + a.b_fg[1], pg[6] + a.b_fg[2], pg[7] + a.b_fg[3]};
            *(f32x4*)(IG + (size_t)row * 4) = ig; *(f32x4*)(FG + (size_t)row * 4) = fg;
        }
    }
}

struct EpiProj {
    static constexpr bool PERM = true;
    bf16* P;
    __device__ __forceinline__ void operator()(const f32x4 (&acc)[2][2][4][2], const pg8::Unit& u, int wr, int wc, int fr, int fq) const {
        const int row0 = u.pm * 256 + wr * 64 + fr, col0 = u.pn * 256 + wc * 32 + 8 * fq;
#pragma unroll
        for (int ai = 0; ai < 2; ++ai)
#pragma unroll
            for (int m = 0; m < 4; ++m) { bf16* rowp = P + (size_t)(row0 + ai * 128 + m * 16) * INW + col0;
#pragma unroll
                for (int bj = 0; bj < 2; ++bj) { const f32x4 v0 = acc[ai][bj][m][0], v1 = acc[ai][bj][m][1];
                    u32x4 w; w.x = pg8::cvt_pk_bf16(v0[0], v0[1]); w.y = pg8::cvt_pk_bf16(v0[2], v0[3]); w.z = pg8::cvt_pk_bf16(v1[0], v1[1]); w.w = pg8::cvt_pk_bf16(v1[2], v1[3]);
                    *(u32x4*)(rowp + bj * 128) = w; } }
    }
};
struct EpiQK {
    static constexpr bool PERM = true;
    bf16* QM; bf16* KM;
    __device__ __forceinline__ void operator()(const f32x4 (&acc)[2][2][4][2], const pg8::Unit& u, int wr, int wc, int fr, int fq) const {
        const int row0 = u.pm * 256 + wr * 64 + fr, col0 = u.g * 256 + wc * 32 + 8 * fq;
        bf16* base = u.pn ? KM : QM;
#pragma unroll
        for (int ai = 0; ai < 2; ++ai)
#pragma unroll
            for (int m = 0; m < 4; ++m) { bf16* rowp = base + (size_t)(row0 + ai * 128 + m * 16) * 1024 + col0;
#pragma unroll
                for (int bj = 0; bj < 2; ++bj) { const f32x4 v0 = acc[ai][bj][m][0], v1 = acc[ai][bj][m][1];
                    u32x4 w; w.x = pg8::cvt_pk_bf16(v0[0], v0[1]); w.y = pg8::cvt_pk_bf16(v0[2], v0[3]); w.z = pg8::cvt_pk_bf16(v1[0], v1[1]); w.w = pg8::cvt_pk_bf16(v1[2], v1[3]);
                    *(u32x4*)(rowp + bj * 128) = w; } }
    }
};
template <int MODE> struct EpiMerge {
    static constexpr bool PERM = true;
    const bf16* P; float* T; bf16* MG;
    __device__ __forceinline__ void operator()(const f32x4 (&acc)[2][2][4][2], const pg8::Unit& u, int wr, int wc, int fr, int fq) const {
        const int row0 = u.pm * 256 + wr * 64 + fr, col0 = u.pn * 256 + wc * 32 + 8 * fq;
#pragma unroll
        for (int ai = 0; ai < 2; ++ai)
#pragma unroll
            for (int m = 0; m < 4; ++m) { const size_t r = (size_t)(row0 + ai * 128 + m * 16);
#pragma unroll
                for (int bj = 0; bj < 2; ++bj) { const int c = col0 + bj * 128;
                    const u32x4 gw = *(const u32x4*)(P + r * INW + (MODE == 0 ? C_GA : C_GB) + c); float gg[8]; unpack8(gw, gg);
                    const f32x4 v0 = acc[ai][bj][m][0], v1 = acc[ai][bj][m][1];
                    float o[8];
#pragma unroll
                    for (int e = 0; e < 4; ++e) { o[e] = sigmoidf_(gg[e]) * v0[e]; o[4 + e] = sigmoidf_(gg[4 + e]) * v1[e]; }
                    float* tp = T + r * 1024 + c;
                    if (MODE == 0) { *(f32x4*)tp = (f32x4){o[0], o[1], o[2], o[3]}; *(f32x4*)(tp + 4) = (f32x4){o[4], o[5], o[6], o[7]}; }
                    else { const f32x4 t0 = *(const f32x4*)tp, t1 = *(const f32x4*)(tp + 4);
                        u32x4 w; w.x = pg8::cvt_pk_bf16(t0[0] + o[0], t0[1] + o[1]); w.y = pg8::cvt_pk_bf16(t0[2] + o[2], t0[3] + o[3]);
                        w.z = pg8::cvt_pk_bf16(t1[0] + o[4], t1[1] + o[5]); w.w = pg8::cvt_pk_bf16(t1[2] + o[6], t1[3] + o[7]);
                        *(u32x4*)(MG + r * 1024 + c) = w; } } }
    }
};
struct EpiOut {
    static constexpr bool PERM = true;
    const float* x; float* out; const float* gate; float* rowss; int grow0;
    __device__ __forceinline__ void operator()(const f32x4 (&acc)[2][2][4][2], const pg8::Unit& u, int wr, int wc, int fr, int fq) const {
        const int row0 = grow0 + u.pm * 256 + wr * 64 + fr, col0 = u.pn * 256 + wc * 32 + 8 * fq;
#pragma unroll
        for (int ai = 0; ai < 2; ++ai)
#pragma unroll
            for (int m = 0; m < 4; ++m) { const int r = row0 + ai * 128 + m * 16; const int b = r >> 12; float ss = 0.f;
#pragma unroll
                for (int bj = 0; bj < 2; ++bj) { const int c = col0 + bj * 128;
                    const float* gp = gate + b * 3072 + c; const f32x4 g0 = *(const f32x4*)gp, g1 = *(const f32x4*)(gp + 4);
                    const float* xp = x + (size_t)r * 1024 + c; const f32x4 x0 = *(const f32x4*)xp, x1 = *(const f32x4*)(xp + 4);
                    const f32x4 o0 = x0 + g0 * acc[ai][bj][m][0], o1 = x1 + g1 * acc[ai][bj][m][1];
                    ss += (o0[0] * o0[0] + o0[1] * o0[1]) + (o0[2] * o0[2] + o0[3] * o0[3]) + (o1[0] * o1[0] + o1[1] * o1[1]) + (o1[2] * o1[2] + o1[3] * o1[3]);
                    float* op = out + (size_t)r * 1024 + c; *(f32x4*)op = o0; *(f32x4*)(op + 4) = o1; }
                ss += __shfl_xor(ss, 16); ss += __shfl_xor(ss, 32);
                if (fq == 0) atomicAdd(rowss + r, ss); }
    }
};

__constant__ double c_inv_freq[16] = {1.0, 0.44036660267178046, 0.19392274474868576, 0.08539710028576561, 0.03760603093086393, 0.016560440080994446, 0.007292664737217109, 0.003211445994752591,
    0.001414213562373095, 0.000622772421914596, 0.0002742481756762073, 0.00012076973741146504, 5.318295896944988e-05, 2.341999896140934e-05, 1.031338537721246e-05, 4.5416704806078695e-06};

__device__ __forceinline__ void phase_prep(const Args& a, unsigned char* lds, int vcu, int G, int pass) {
    const int tid = opaque_tid(), lane = tid & 63, wave = tid >> 6;
    unsigned char* ws = a.ws;
    bf16* P = (bf16*)(ws + WS_P);
    {
        const int gw = vcu * NWAVES + wave;
        if (gw < NB_PASS * 4) {
            const int bl = gw >> 2, h = gw & 3;
            const float* IG = (const float*)(ws + WS_IG); const float* FG = (const float*)(ws + WS_FG);
            float* gsc = (float*)(ws + WS_GSC);
            float* A1 = gsc, *B1 = gsc + MS * 4, *WI = gsc + 2 * MS * 4, *EF = gsc + 3 * MS * 4, *WK = gsc + 4 * MS * 4, *DEC = gsc + 5 * MS * 4;
            float m_prev = 0.f;
            for (int j = 0; j < 64; ++j) {
                const int lrow = bl * SEQ + j * 64 + lane; const size_t grow = (size_t)pass * MS + lrow;
                const float f = FG[grow * 4 + h], ii = IG[grow * 4 + h];
                const float ls = fminf(f, 0.f) - log1pf(expf(-fabsf(f)));
                float acs = ls;
#pragma unroll
                for (int o = 1; o < 64; o <<= 1) { const float t = __shfl_up(acs, o); if (lane >= o) acs += t; }
                const float b1 = ii - acs;
                float pm = b1;
#pragma unroll
                for (int o = 1; o < 64; o <<= 1) { const float t = __shfl_up(pm, o); if (lane >= o) pm = fmaxf(pm, t); }
                const float g = __shfl(acs, 63), pm63 = __shfl(pm, 63);
                const float mx = fmaxf(m_prev, pm);
                const float Ms = fmaxf(m_prev, pm63);
                A1[lrow * 4 + h] = -mx; B1[lrow * 4 + h] = b1; WI[lrow * 4 + h] = expf(m_prev - mx); EF[lrow * 4 + h] = expf(-(acs + mx)); WK[lrow * 4 + h] = expf(b1 - Ms);
                if (lane == 0) DEC[(bl * 64 + j) * 4 + h] = expf(m_prev - Ms);
                m_prev = g + Ms;
            }
        }
    }
    {
        bf16* XC = (bf16*)(ws + WS_XC);
        const int cg8 = (tid & 127) * 8, rq = tid >> 7;
        float wc[4][8], bc[8];
#pragma unroll
        for (int j = 0; j < 4; ++j)
#pragma unroll
            for (int e = 0; e < 8; ++e) wc[j][e] = a.w_conv[j * 1024 + cg8 + e];
#pragma unroll
        for (int e = 0; e < 8; ++e) bc[e] = a.b_conv[cg8 + e];
        for (int it = vcu; it < MS / 64; it += G) {
            const int r0 = it * 64 + rq * 16;
            float h0[8], h1[8], h2[8];
#pragma unroll
            for (int e = 0; e < 8; ++e) { h0[e] = 0.f; h1[e] = 0.f; h2[e] = 0.f; }
            const int t0 = r0 & (SEQ - 1);
            if (t0 >= 3) { u32x4 w;
                w = *(const u32x4*)(P + (size_t)(r0 - 3) * INW + C_XA + cg8); unpack8(w, h0);
                w = *(const u32x4*)(P + (size_t)(r0 - 2) * INW + C_XA + cg8); unpack8(w, h1);
                w = *(const u32x4*)(P + (size_t)(r0 - 1) * INW + C_XA + cg8); unpack8(w, h2); }
            for (int rr = 0; rr < 16; ++rr) {
                const int r = r0 + rr; float cur[8];
                const u32x4 w = *(const u32x4*)(P + (size_t)r * INW + C_XA + cg8); unpack8(w, cur);
                float o[8];
#pragma unroll
                for (int e = 0; e < 8; ++e) { const float y = bc[e] + wc[0][e] * h0[e] + wc[1][e] * h1[e] + wc[2][e] * h2[e] + wc[3][e] * cur[e]; o[e] = siluf_(y); h0[e] = h1[e]; h1[e] = h2[e]; h2[e] = cur[e]; }
                u32x4 ov; ov.x = pk2(o[0], o[1]); ov.y = pk2(o[2], o[3]); ov.z = pk2(o[4], o[5]); ov.w = pk2(o[6], o[7]);
                *(u32x4*)(XC + (size_t)r * 1024 + cg8) = ov;
            }
        }
    }
    {
        for (int r = vcu * NWAVES + wave; r < MS; r += G * NWAVES) {
            if (lane < 48) {
                const int hd = lane >> 1, half = lane & 1;
                const size_t grow = (size_t)pass * MS + r;
                const int pos = a.pos[grow];
                bf16* base = P + (size_t)r * INW + (hd < 12 ? C_QA + hd * 128 : C_KA + (hd - 12) * 128) + 8 * half;
                u32x4 w1 = *(const u32x4*)base, w2 = *(const u32x4*)(base + 16);
                float x1[8], x2[8]; unpack8(w1, x1); unpack8(w2, x2);
                float o1[8], o2[8];
#pragma unroll
                for (int e = 0; e < 8; ++e) {
                    const double rev = (double)pos * c_inv_freq[8 * half + e] * 0.15915494309189535;
                    const float fr = (float)(rev - rint(rev));
                    const float cs = __builtin_amdgcn_cosf(fr), sn = __builtin_amdgcn_sinf(fr);
                    o1[e] = x1[e] * cs - x2[e] * sn; o2[e] = x2[e] * cs + x1[e] * sn;
                }
                u32x4 v1, v2; v1.x = pk2(o1[0], o1[1]); v1.y = pk2(o1[2], o1[3]); v1.z = pk2(o1[4], o1[5]); v1.w = pk2(o1[6], o1[7]);
                v2.x = pk2(o2[0], o2[1]); v2.y = pk2(o2[2], o2[3]); v2.z = pk2(o2[4], o2[5]); v2.w = pk2(o2[6], o2[7]);
                *(u32x4*)base = v1; *(u32x4*)(base + 16) = v2;
            }
        }
    }
}

__device__ __forceinline__ f32x4 mfma16(bf16x8 a, bf16x8 b, f32x4 c) { return __builtin_amdgcn_mfma_f32_16x16x32_bf16(a, b, c, 0, 0, 0); }

constexpr int TPS = 72;
__device__ __forceinline__ void phase_cprep(const Args& a, unsigned char* lds, int vcu, int G) {
    const int tid = opaque_tid(), lane = tid & 63, wave = __builtin_amdgcn_readfirstlane(tid >> 6);
    const int fr = lane & 15, fq = lane >> 4;
    unsigned char* ws = a.ws;
    const bf16* P = (const bf16*)(ws + WS_P); const bf16* QM = (const bf16*)(ws + WS_QM); const bf16* KM = (const bf16*)(ws + WS_KM);
    const float* gsc = (const float*)(ws + WS_GSC);
    const float* gA1 = gsc, *gB1 = gsc + MS * 4, *gWK = gsc + 4 * MS * 4;
    bf16* SG = (bf16*)(ws + WS_SG); bf16* KTG = (bf16*)(ws + WS_KTG); bf16* VTG = (bf16*)(ws + WS_VTG);
    bf16* KT = (bf16*)lds; bf16* VT = (bf16*)(lds + 256 * TPS * 2);
    const int ti = wave >> 1, tj0 = 2 * (wave & 1);
    for (int ci = vcu; ci < (MS / 64) * 4; ci += G) {
        const int h = ci & 3, t0 = (ci >> 2) * 64;
        __syncthreads();
#pragma unroll
        for (int i = 0; i < 4; ++i) { const int c = tid + NTHR * i, l = c & 63, dc = c >> 6;
            const u32x4 kw = *(const u32x4*)(KM + (size_t)(t0 + l) * 1024 + h * 256 + 8 * dc); float kv[8]; unpack8(kw, kv);
            const float wk = gWK[(t0 + l) * 4 + h];
            bf16* d = KT + (8 * dc) * TPS + l;
#pragma unroll
            for (int e = 0; e < 8; ++e) d[e * TPS] = (bf16)f2bf(kv[e] * wk);
            const u32x4 w = *(const u32x4*)(P + (size_t)(t0 + l) * INW + C_VA + h * 256 + 8 * dc);
            bf16* dv = VT + (8 * dc) * TPS + l;
            dv[0 * TPS] = (bf16)(w.x & 0xffff); dv[1 * TPS] = (bf16)(w.x >> 16); dv[2 * TPS] = (bf16)(w.y & 0xffff); dv[3 * TPS] = (bf16)(w.y >> 16);
            dv[4 * TPS] = (bf16)(w.z & 0xffff); dv[5 * TPS] = (bf16)(w.z >> 16); dv[6 * TPS] = (bf16)(w.w & 0xffff); dv[7 * TPS] = (bf16)(w.w >> 16); }
        {
            bf16x8 qf[8];
#pragma unroll
            for (int ks = 0; ks < 8; ++ks) qf[ks] = *(const bf16x8*)(QM + (size_t)(t0 + 16 * ti + fr) * 1024 + h * 256 + 32 * ks + 8 * fq);
            float a1l[4];
#pragma unroll
            for (int i = 0; i < 4; ++i) a1l[i] = gA1[(t0 + 16 * ti + 4 * fq + i) * 4 + h];
#pragma unroll
            for (int tt = 0; tt < 2; ++tt) {
                const int tj = tj0 + tt;
                f32x4 sacc = {0.f, 0.f, 0.f, 0.f};
                if (tj <= ti) {
#pragma unroll
                    for (int ks = 0; ks < 8; ++ks) { const bf16x8 kf = *(const bf16x8*)(KM + (size_t)(t0 + 16 * tj + fr) * 1024 + h * 256 + 32 * ks + 8 * fq); sacc = mfma16(qf[ks], kf, sacc); }
                }
                const int sidx = 16 * tj + fr; const float b1s = gB1[(t0 + sidx) * 4 + h];
#pragma unroll
                for (int i = 0; i < 4; ++i) { const int l = 16 * ti + 4 * fq + i;
                    float v = 0.f;
                    if (sidx <= l) v = sacc[i] * __expf(a1l[i] + b1s);
                    SG[(size_t)ci * 4096 + l * 64 + sidx] = (bf16)f2bf(v); }
            }
        }
        __syncthreads();
#pragma unroll
        for (int i = 0; i < 4; ++i) { const int c = tid + NTHR * i, row = c >> 3, ch = c & 7;
            *(u32x4*)(KTG + (size_t)ci * 16384 + row * 64 + 8 * ch) = *(const u32x4*)(KT + row * TPS + 8 * ch);
            *(u32x4*)(VTG + (size_t)ci * 16384 + row * 64 + 8 * ch) = *(const u32x4*)(VT + row * TPS + 8 * ch); }
    }
}

constexpr int CBS = 264, CB_ROWS = 80, CB_BYTES = CB_ROWS * CBS * 2;
static_assert(2 * CB_BYTES <= 131072, "scan lds");

__device__ __forceinline__ void scan_item(const Args& a, unsigned char* lds, int item) {
    const int tid = opaque_tid(), lane = tid & 63, wave = __builtin_amdgcn_readfirstlane(tid >> 6);
    const int fr = lane & 15, fq = lane >> 4;
    unsigned char* ws = a.ws;
    const int bl = item >> 4, h = (item >> 2) & 3, es = item & 3;
    const bf16* QM = (const bf16*)(ws + WS_QM);
    const bf16* SG = (const bf16*)(ws + WS_SG); const bf16* KTG = (const bf16*)(ws + WS_KTG); const bf16* VTG = (const bf16*)(ws + WS_VTG);
    bf16* HR = (bf16*)(ws + WS_HR); float* DENO = (float*)(ws + WS_DEN);
    const float* gsc = (const float*)(ws + WS_GSC);
    const float* gWI = gsc + 2 * MS * 4, *gDEC = gsc + 5 * MS * 4;
    const bool do_den = (es == 0);
    for (int i = tid; i < 2 * CB_BYTES / 4; i += NTHR) ((unsigned*)lds)[i] = 0u;
    f32x4 Cacc[2][4], Nacc[2];
#pragma unroll
    for (int x = 0; x < 2; ++x) { Nacc[x] = (f32x4){0.f, 0.f, 0.f, 0.f};
#pragma unroll
        for (int y = 0; y < 4; ++y) Cacc[x][y] = (f32x4){0.f, 0.f, 0.f, 0.f}; }
    const int ti = wave >> 1, tj0 = 2 * (wave & 1);
    bf16x8 ones;
    { const short ov = (fr == 0) ? (short)0x3F80 : (short)0;
#pragma unroll
      for (int e = 0; e < 8; ++e) ones[e] = ov; }
    bf16x8 qf[8], sf[2], ktf[2][2], vtf[4][2], vy[2][2]; float wi[4]; float decay;
    {
        const int ci = (bl * 64) * 4 + h, t0 = bl * SEQ;
#pragma unroll
        for (int ks = 0; ks < 8; ++ks) qf[ks] = *(const bf16x8*)(QM + (size_t)(t0 + 16 * ti + fr) * 1024 + h * 256 + 32 * ks + 8 * fq);
#pragma unroll
        for (int k2 = 0; k2 < 2; ++k2) sf[k2] = *(const bf16x8*)(SG + (size_t)ci * 4096 + (16 * ti + fr) * 64 + 32 * k2 + 8 * fq);
#pragma unroll
        for (int i = 0; i < 4; ++i) wi[i] = gWI[(t0 + 16 * ti + 4 * fq + i) * 4 + h];
#pragma unroll
        for (int dt = 0; dt < 2; ++dt)
#pragma unroll
            for (int k2 = 0; k2 < 2; ++k2) ktf[dt][k2] = *(const bf16x8*)(KTG + (size_t)ci * 16384 + (32 * wave + 16 * dt + fr) * 64 + 32 * k2 + 8 * fq);
#pragma unroll
        for (int et = 0; et < 4; ++et)
#pragma unroll
            for (int k2 = 0; k2 < 2; ++k2) vtf[et][k2] = *(const bf16x8*)(VTG + (size_t)ci * 16384 + (es * 64 + 16 * et + fr) * 64 + 32 * k2 + 8 * fq);
#pragma unroll
        for (int tt = 0; tt < 2; ++tt)
#pragma unroll
            for (int k2 = 0; k2 < 2; ++k2) vy[tt][k2] = *(const bf16x8*)(VTG + (size_t)ci * 16384 + (es * 64 + 16 * (tj0 + tt) + fr) * 64 + 32 * k2 + 8 * fq);
        decay = gDEC[(bl * 64) * 4 + h];
    }
    __syncthreads();
    for (int j = 0; j < 64; ++j) {
        const int t0 = bl * SEQ + j * 64;
        const int jn = j < 63 ? j + 1 : 63;
        const int cin = (bl * 64 + jn) * 4 + h, t0n = bl * SEQ + jn * 64;
        const bf16* Cprev = (const bf16*)(lds + ((j & 1) ^ 1) * CB_BYTES); bf16* Ccur = (bf16*)(lds + (j & 1) * CB_BYTES);
#pragma unroll
        for (int tt = 0; tt < 2; ++tt) {
            const int ej = tj0 + tt;
            f32x4 a1 = {0.f, 0.f, 0.f, 0.f}, a2 = {0.f, 0.f, 0.f, 0.f};
#pragma unroll
            for (int k2 = 0; k2 < 2; ++k2) a1 = mfma16(sf[k2], vy[tt][k2], a1);
#pragma unroll
            for (int ks = 0; ks < 8; ++ks) { const bf16x8 cb = *(const bf16x8*)(Cprev + (16 * ej + fr) * CBS + 32 * ks + 8 * fq); a2 = mfma16(qf[ks], cb, a2); }
#pragma unroll
            for (int i = 0; i < 4; ++i) { const int l = 16 * ti + 4 * fq + i;
                HR[(size_t)(t0 + l) * 1024 + h * 256 + es * 64 + 16 * ej + fr] = (bf16)f2bf(a1[i] + wi[i] * a2[i]); }
        }
        if (do_den && (wave & 1) == 0) {
            f32x4 a1 = {0.f, 0.f, 0.f, 0.f}, a2 = {0.f, 0.f, 0.f, 0.f};
#pragma unroll
            for (int k2 = 0; k2 < 2; ++k2) a1 = mfma16(sf[k2], ones, a1);
#pragma unroll
            for (int ks = 0; ks < 8; ++ks) { const bf16x8 cb = *(const bf16x8*)(Cprev + (64 + fr) * CBS + 32 * ks + 8 * fq); a2 = mfma16(qf[ks], cb, a2); }
            if (fr == 0) {
#pragma unroll
                for (int i = 0; i < 4; ++i) DENO[(size_t)(t0 + 16 * ti + 4 * fq + i) * 4 + h] = a1[i] + wi[i] * a2[i]; }
        }
#pragma unroll
        for (int ks = 0; ks < 8; ++ks) qf[ks] = *(const bf16x8*)(QM + (size_t)(t0n + 16 * ti + fr) * 1024 + h * 256 + 32 * ks + 8 * fq);
#pragma unroll
        for (int k2 = 0; k2 < 2; ++k2) sf[k2] = *(const bf16x8*)(SG + (size_t)cin * 4096 + (16 * ti + fr) * 64 + 32 * k2 + 8 * fq);
#pragma unroll
        for (int i = 0; i < 4; ++i) wi[i] = gWI[(t0n + 16 * ti + 4 * fq + i) * 4 + h];
#pragma unroll
        for (int tt = 0; tt < 2; ++tt)
#pragma unroll
            for (int k2 = 0; k2 < 2; ++k2) vy[tt][k2] = *(const bf16x8*)(VTG + (size_t)cin * 16384 + (es * 64 + 16 * (tj0 + tt) + fr) * 64 + 32 * k2 + 8 * fq);
#pragma unroll
        for (int dt = 0; dt < 2; ++dt) {
#pragma unroll
            for (int et = 0; et < 4; ++et) {
                f32x4 c = Cacc[dt][et] * decay;
#pragma unroll
                for (int k2 = 0; k2 < 2; ++k2) c = mfma16(ktf[dt][k2], vtf[et][k2], c);
                Cacc[dt][et] = c;
                u32x2 o; o.x = pk2(c[0], c[1]); o.y = pk2(c[2], c[3]);
                *(u32x2*)(Ccur + (16 * et + fr) * CBS + 32 * wave + 16 * dt + 4 * fq) = o;
            }
            if (do_den) {
                f32x4 c = Nacc[dt] * decay;
#pragma unroll
                for (int k2 = 0; k2 < 2; ++k2) c = mfma16(ktf[dt][k2], ones, c);
                Nacc[dt] = c;
                u32x2 o; o.x = pk2(c[0], c[1]); o.y = pk2(c[2], c[3]);
                *(u32x2*)(Ccur + (64 + fr) * CBS + 32 * wave + 16 * dt + 4 * fq) = o;
            }
        }
#pragma unroll
        for (int dt = 0; dt < 2; ++dt)
#pragma unroll
            for (int k2 = 0; k2 < 2; ++k2) ktf[dt][k2] = *(const bf16x8*)(KTG + (size_t)cin * 16384 + (32 * wave + 16 * dt + fr) * 64 + 32 * k2 + 8 * fq);
#pragma unroll
        for (int et = 0; et < 4; ++et)
#pragma unroll
            for (int k2 = 0; k2 < 2; ++k2) vtf[et][k2] = *(const bf16x8*)(VTG + (size_t)cin * 16384 + (es * 64 + 16 * et + fr) * 64 + 32 * k2 + 8 * fq);
        decay = gDEC[(bl * 64 + jn) * 4 + h];
        asm volatile("s_waitcnt lgkmcnt(0)" ::: "memory"); __builtin_amdgcn_s_barrier(); asm volatile("" ::: "memory");
    }
    asm volatile("s_waitcnt vmcnt(0)" ::: "memory"); __syncthreads();
}

constexpr int AKS = 136;
constexpr int L_AK = 0, L_AV = L_AK + 128 * AKS * 2, L_AP = L_AV + 128 * AKS * 2, L_ATT_END = L_AP + 8 * 16 * AKS * 2;
static_assert(L_ATT_END <= 131072, "attn lds");

__device__ __forceinline__ void attn_item(const Args& a, unsigned char* lds, int item) {
    const int tid = opaque_tid(), lane = tid & 63, wave = __builtin_amdgcn_readfirstlane(tid >> 6);
    const int fr = lane & 15, fq = lane >> 4;
    unsigned char* ws = a.ws;
    const int blk = item & 31, hh = (item >> 5) & 3, bl = (item >> 7) & 3, g = item >> 9;
    const int dil = g == 0 ? 1 : g == 1 ? 4 : 16, nb = 32 / dil;
    const int r = blk / nb, n = blk % nb;
    const bf16* P = (const bf16*)(ws + WS_P);
    const int H = 4 * g + hh;
    const bf16* Qb = P + C_QA + H * 128; const bf16* Kb = P + C_KA + H * 128; const bf16* Vb = P + C_VT + H * 128;
    bf16* Ks = (bf16*)(lds + L_AK); bf16* VTs = (bf16*)(lds + L_AV); bf16* Pw = (bf16*)(lds + L_AP) + wave * 16 * AKS;
    const int rowbase = bl * SEQ + r;
    bf16x8 qf[4];
    { const size_t qrow = (size_t)(rowbase + (128 * n + 16 * wave + fr) * dil);
#pragma unroll
      for (int ks = 0; ks < 4; ++ks) qf[ks] = *(const bf16x8*)(Qb + qrow * INW + 32 * ks + 8 * fq); }
    f32x4 O[8];
#pragma unroll
    for (int i = 0; i < 8; ++i) O[i] = (f32x4){0.f, 0.f, 0.f, 0.f};
    float mrow[4], lrow[4];
#pragma unroll
    for (int i = 0; i < 4; ++i) { mrow[i] = -INFINITY; lrow[i] = 0.f; }
    const float scale = 0.08838834764831845f;
    for (int half = (n == 0 ? 1 : 0); half < 2; ++half) {
        const int ku0 = 128 * (n - 1 + half);
        __syncthreads();
#pragma unroll
        for (int i = 0; i < 4; ++i) { const int c = tid + NTHR * i, key = c & 127, dc = c >> 7;
            const size_t krow = (size_t)(rowbase + (ku0 + key) * dil);
            const u32x4 kw = *(const u32x4*)(Kb + krow * INW + 8 * dc);
            *(u32x4*)(Ks + key * AKS + 8 * dc) = kw;
            const u32x4 w = *(const u32x4*)(Vb + krow * INW + 8 * dc);
            bf16* d = VTs + (8 * dc) * AKS + key;
            d[0 * AKS] = (bf16)(w.x & 0xffff); d[1 * AKS] = (bf16)(w.x >> 16); d[2 * AKS] = (bf16)(w.y & 0xffff); d[3 * AKS] = (bf16)(w.y >> 16);
            d[4 * AKS] = (bf16)(w.z & 0xffff); d[5 * AKS] = (bf16)(w.z >> 16); d[6 * AKS] = (bf16)(w.w & 0xffff); d[7 * AKS] = (bf16)(w.w >> 16); }
        __syncthreads();
        f32x4 S[8];
#pragma unroll
        for (int kt = 0; kt < 8; ++kt) { f32x4 s = {0.f, 0.f, 0.f, 0.f};
#pragma unroll
            for (int ks = 0; ks < 4; ++ks) { const bf16x8 kf = *(const bf16x8*)(Ks + (16 * kt + fr) * AKS + 32 * ks + 8 * fq); s = mfma16(qf[ks], kf, s); }
            S[kt] = s; }
        float mx[4];
#pragma unroll
        for (int i = 0; i < 4; ++i) mx[i] = -INFINITY;
#pragma unroll
        for (int kt = 0; kt < 8; ++kt)
#pragma unroll
            for (int i = 0; i < 4; ++i) { const int p = 16 * wave + 4 * fq + i, kk = 16 * kt + fr;
                const bool ok = half == 0 ? (kk >= p) : (kk <= p);
                const float v = ok ? S[kt][i] * scale : -INFINITY; S[kt][i] = v; mx[i] = fmaxf(mx[i], v); }
        float alpha[4], rs[4];
#pragma unroll
        for (int i = 0; i < 4; ++i) { float m = mx[i]; m = fmaxf(m, __shfl_xor(m, 1)); m = fmaxf(m, __shfl_xor(m, 2)); m = fmaxf(m, __shfl_xor(m, 4)); m = fmaxf(m, __shfl_xor(m, 8));
            const float mn = fmaxf(mrow[i], m); alpha[i] = __expf(mrow[i] - mn); mrow[i] = mn; rs[i] = 0.f; }
#pragma unroll
        for (int kt = 0; kt < 8; ++kt)
#pragma unroll
            for (int i = 0; i < 4; ++i) { const float p = __expf(S[kt][i] - mrow[i]); rs[i] += p; Pw[(4 * fq + i) * AKS + 16 * kt + fr] = (bf16)f2bf(p); }
#pragma unroll
        for (int i = 0; i < 4; ++i) { float s = rs[i]; s += __shfl_xor(s, 1); s += __shfl_xor(s, 2); s += __shfl_xor(s, 4); s += __shfl_xor(s, 8); lrow[i] = lrow[i] * alpha[i] + s; }
#pragma unroll
        for (int dtile = 0; dtile < 8; ++dtile)
#pragma unroll
            for (int i = 0; i < 4; ++i) O[dtile][i] *= alpha[i];
        __builtin_amdgcn_wave_barrier();
        asm volatile("s_waitcnt lgkmcnt(0)" ::: "memory");
#pragma unroll
        for (int ks = 0; ks < 4; ++ks) { const bf16x8 pa = *(const bf16x8*)(Pw + fr * AKS + 32 * ks + 8 * fq);
#pragma unroll
            for (int dtile = 0; dtile < 8; ++dtile) { const bf16x8 vb = *(const bf16x8*)(VTs + (16 * dtile + fr) * AKS + 32 * ks + 8 * fq); O[dtile] = mfma16(pa, vb, O[dtile]); } }
    }
    bf16* AO = (bf16*)(ws + WS_AO) + (size_t)g * MS * 512; float* LSE = (float*)(ws + WS_LSE) + (size_t)g * MS * 4;
#pragma unroll
    for (int i = 0; i < 4; ++i) { const size_t row = (size_t)(rowbase + (128 * n + 16 * wave + 4 * fq + i) * dil); const float inv = 1.f / lrow[i];
#pragma unroll
        for (int dtile = 0; dtile < 8; ++dtile) AO[row * 512 + hh * 128 + 16 * dtile + fr] = (bf16)f2bf(O[dtile][i] * inv);
        if (fr == 0) LSE[row * 4 + hh] = mrow[i] + logf(lrow[i]); }
    __syncthreads();
}

constexpr int N_SCAN_ITEMS = NB_PASS * 16, N_ATT_ITEMS = 3 * NB_PASS * 4 * 32;
__device__ __forceinline__ void phase_mix(const Args& a, unsigned char* lds, int pass) {
    unsigned* qctr = (unsigned*)(a.ws + WS_CTL) + CW_QCTR + 64 * pass;
    volatile int* slot = (volatile int*)(lds + 131072 + 1024);
    for (;;) {
        __syncthreads();
        if (opaque_tid() == 0) *slot = (int)atomicAdd(qctr, 1u);
        __syncthreads();
        const int item = *slot;
        if (item >= N_SCAN_ITEMS + N_ATT_ITEMS) break;
        if (item < N_SCAN_ITEMS) scan_item(a, lds, item); else attn_item(a, lds, item - N_SCAN_ITEMS);
    }
}

__device__ __forceinline__ void phase_post(const Args& a, int vcu, int G) {
    const int tid = opaque_tid(), lane = tid & 63, wave = tid >> 6;
    unsigned char* ws = a.ws;
    const bf16* P = (const bf16*)(ws + WS_P); const bf16* XC = (const bf16*)(ws + WS_XC); bf16* HR = (bf16*)(ws + WS_HR);
    const bf16* AO = (const bf16*)(ws + WS_AO); const float* LSE = (const float*)(ws + WS_LSE); bf16* UA = (bf16*)(ws + WS_UA);
    const float* DENO = (const float*)(ws + WS_DEN); const float* gEF = (const float*)(ws + WS_GSC) + 3 * MS * 4;
    for (int r = vcu * NWAVES + wave; r < MS; r += G * NWAVES) {
#pragma unroll
        for (int h = 0; h < 4; ++h) {
            const int c = h * 256 + 4 * lane;
            const float rd = 1.f / fmaxf(fabsf(DENO[(size_t)r * 4 + h]), gEF[(size_t)r * 4 + h]);
            const u32x2 hw = *(const u32x2*)(HR + (size_t)r * 1024 + c), ow = *(const u32x2*)(P + (size_t)r * INW + C_OA + c), zw = *(const u32x2*)(P + (size_t)r * INW + C_ZA + c), xw = *(const u32x2*)(XC + (size_t)r * 1024 + c);
            float hm[4] = {sigmoidf_(bflo(ow.x)) * bflo(hw.x) * rd, sigmoidf_(bfhi(ow.x)) * bfhi(hw.x) * rd, sigmoidf_(bflo(ow.y)) * bflo(hw.y) * rd, sigmoidf_(bfhi(ow.y)) * bfhi(hw.y) * rd};
            float ss = (hm[0] * hm[0] + hm[1] * hm[1]) + (hm[2] * hm[2] + hm[3] * hm[3]);
            ss = wave_sum(ss);
            const float rinv = 1.f / sqrtf(ss * (1.f / 256.f) + EPS);
            const f32x4 gh = *(const f32x4*)(a.g_head + c), sk = *(const f32x4*)(a.skip + c);
            const float xc[4] = {bflo(xw.x), bfhi(xw.x), bflo(xw.y), bfhi(xw.y)}, za[4] = {bflo(zw.x), bfhi(zw.x), bflo(zw.y), bfhi(zw.y)};
            float o[4];
#pragma unroll
            for (int e = 0; e < 4; ++e) o[e] = (hm[e] * rinv * gh[e] + sk[e] * xc[e]) * siluf_(za[e]);
            u32x2 ov; ov.x = pk2(o[0], o[1]); ov.y = pk2(o[2], o[3]);
            *(u32x2*)(HR + (size_t)r * 1024 + c) = ov;
        }
#pragma unroll
        for (int hh = 0; hh < 4; ++hh) {
            const float l0 = LSE[(size_t)r * 4 + hh], l1 = LSE[(size_t)(MS + r) * 4 + hh], l2 = LSE[(size_t)(2 * MS + r) * 4 + hh];
            const float mx = fmaxf(l0, fmaxf(l1, l2));
            float w0 = __expf(l0 - mx), w1 = __expf(l1 - mx), w2 = __expf(l2 - mx); const float inv = 1.f / (w0 + w1 + w2); w0 *= inv; w1 *= inv; w2 *= inv;
            const int c = hh * 128 + 2 * lane;
            const unsigned o0 = *(const unsigned*)(AO + (size_t)r * 512 + c), o1 = *(const unsigned*)(AO + ((size_t)MS + r) * 512 + c), o2 = *(const unsigned*)(AO + ((size_t)2 * MS + r) * 512 + c);
            const unsigned zb = *(const unsigned*)(P + (size_t)r * INW + C_ZB + c);
            const float va = (w0 * bflo(o0) + w1 * bflo(o1) + w2 * bflo(o2)) * siluf_(bflo(zb));
            const float vb = (w0 * bfhi(o0) + w1 * bfhi(o1) + w2 * bfhi(o2)) * siluf_(bfhi(zb));
            *(unsigned*)(UA + (size_t)r * 512 + c) = pk2(va, vb);
        }
    }
}

__device__ __forceinline__ void phase_norm(const Args& a, int vcu, int G) {
    const int tid = opaque_tid(), lane = tid & 63, wave = tid >> 6;
    const float* rowss = (const float*)(a.ws + WS_CTL) + CW_ROWSS;
    for (int r = vcu * NWAVES + wave; r < MALL; r += G * NWAVES) {
        const float rinv = 1.f / sqrtf(rowss[r] * (1.f / DM) + EPS);
        f32x4* o = (f32x4*)(a.out + (size_t)r * DM) + lane;
#pragma unroll
        for (int j = 0; j < 4; ++j) { const f32x4 gf = *((const f32x4*)a.g_final + lane + 64 * j); o[64 * j] = o[64 * j] * rinv * gf; }
    }
}


#define LAS __attribute__((address_space(3)))
#define XB_TMO      128
#define XB_XCNT(j)  (256  + 64 * (j))
#define XB_XSUB(j)  (1280 + 64 * (j))
#define XB_XGEN(j)  (2304 + 64 * (j))
#define XB_TOP      3328
#define XB_TOPGEN   3392
#define XCD_BAR_WORDS 3456
#define XB_SPIN_CAP (1u << 22)
constexpr int CW_BAR = 4096;
__device__ __forceinline__ unsigned xb_ld(unsigned* p)              { return __hip_atomic_load(p, __ATOMIC_RELAXED, __HIP_MEMORY_SCOPE_AGENT); }
__device__ __forceinline__ unsigned xb_add(unsigned* p, unsigned v) { return __hip_atomic_fetch_add(p, v, __ATOMIC_RELAXED, __HIP_MEMORY_SCOPE_AGENT); }
__device__ __forceinline__ unsigned xb_xcc_id() { return (unsigned)__builtin_amdgcn_s_getreg((3 << 11) | 20) & 0xFu; }
#define XB_SPIN(cond, bar) do { unsigned _sp = 0; while (cond) { __builtin_amdgcn_s_sleep(1); \
    if ((++_sp & 255u) == 0u) { if (xb_ld(&(bar)[XB_TMO])) break; if (_sp > XB_SPIN_CAP) { atomicAdd(&(bar)[XB_TMO], 1u); break; } } } } while (0)
struct XcdBarrier { unsigned* bar; unsigned x; volatile LAS unsigned* st; };
__device__ __forceinline__ XcdBarrier xcd_barrier_post(unsigned* bar, volatile LAS unsigned* st) {
    XcdBarrier b; b.bar = bar; b.x = xb_xcc_id(); b.st = st;
    if (threadIdx.x == 0) (void)xb_add(&bar[XB_XCNT(b.x)], 1u);
    return b;
}
__device__ __forceinline__ void xcd_barrier_complete(unsigned* bar, unsigned x, unsigned& nloc, unsigned& nx) {
    const unsigned G = gridDim.x * gridDim.y * gridDim.z;
    unsigned sum, cnt, mine, sp = 0u;
    for (;;) {
        sum = 0u; cnt = 0u; mine = 0u;
#pragma unroll
        for (unsigned j = 0; j < 16; ++j) { const unsigned c = xb_ld(&bar[XB_XCNT(j)]); sum += c; cnt += (c > 0u) ? 1u : 0u; mine = (j == x) ? c : mine; }
        if (sum == G) break;
        __builtin_amdgcn_s_sleep(1);
        if ((++sp & 255u) == 0u) { if (xb_ld(&bar[XB_TMO])) break; if (sp > XB_SPIN_CAP) { atomicAdd(&bar[XB_TMO], 1u); break; } }
    }
    nloc = mine > 0u ? mine : 1u; nx = cnt > 0u ? cnt : 1u;
}
__device__ __forceinline__ void xcd_barrier(const XcdBarrier& b) {
    asm volatile("s_waitcnt vmcnt(0)" ::: "memory");
    __syncthreads();
    if (threadIdx.x == 0) {
        unsigned* bar = b.bar;
        __builtin_amdgcn_s_waitcnt(0);
        unsigned nloc = b.st[0], nx = b.st[1];
        if (nloc == 0u) { xcd_barrier_complete(bar, b.x, nloc, nx); b.st[0] = nloc; b.st[1] = nx; }
        const unsigned old = xb_add(&bar[XB_XSUB(b.x)], 1u);
        const unsigned gen = old / nloc;
        if (old + 1u == (gen + 1u) * nloc) {
            __builtin_amdgcn_fence(__ATOMIC_RELEASE, "agent");
            asm volatile("s_waitcnt vmcnt(0)" ::: "memory");
            const unsigned og = xb_add(&bar[XB_TOP], 1u);
            const unsigned tg = og / nx;
            if (og + 1u == (tg + 1u) * nx) xb_add(&bar[XB_TOPGEN], 1u);
            else XB_SPIN(xb_ld(&bar[XB_TOPGEN]) == tg, bar);
            __builtin_amdgcn_fence(__ATOMIC_ACQUIRE, "agent");
            xb_add(&bar[XB_XGEN(b.x)], 1u);
            asm volatile("s_waitcnt vmcnt(0)" ::: "memory");
        } else {
            XB_SPIN(xb_ld(&bar[XB_XGEN(b.x)]) == gen, bar);
            __builtin_amdgcn_fence(__ATOMIC_ACQUIRE, "agent");
            asm volatile("s_waitcnt vmcnt(0)" ::: "memory");
        }
    }
    __syncthreads();
}

constexpr int PH_PER_PASS = 8, PH_TOTAL = 2 + PH_PER_PASS * NPASS + 1;
enum { K_PROLOGUE = 0, K_H = 1, K_INPROJ = 2, K_PREP = 3, K_QK = 4, K_MIX = 5, K_POST = 6, K_OUT1 = 7, K_OUT2 = 8, K_NORM = 9, K_CPREP = 10 };

template <int KIND>
__device__ __forceinline__ void run_phase(const Args& args, unsigned char* lds, int pass) {
    const int G = gridDim.x; const int bx = blockIdx.x;
    const int vcu = (G % 8 == 0) ? (bx % 8) * (G / 8) + bx / 8 : bx;
    unsigned char* ws = args.ws;
    PG8_LAS unsigned char* lds3 = (PG8_LAS unsigned char*)lds;
    if constexpr (KIND == K_PROLOGUE) phase_prologue(args, lds, vcu, G);
    else if constexpr (KIND == K_H) phase_h(args, lds, vcu, G);
    else if constexpr (KIND == K_NORM) phase_norm(args, vcu, G);
    else if constexpr (KIND == K_INPROJ) {
        pg8::Gemm<1024, 1024, 1024> g{(const bf16*)(ws + WS_H) + (size_t)pass * MS * 1024, (const bf16*)(ws + WS_WIN)};
        pg8::StaticOrder S; S.init(MS, INW, G, bx);
        EpiProj E{(bf16*)(ws + WS_P)};
        pg8::gemm_phase<EpiProj, pg8::StaticOrder, true, true>(lds3, g, S, E);
    } else if constexpr (KIND == K_PREP) phase_prep(args, lds, vcu, G, pass);
    else if constexpr (KIND == K_QK) {
        pg8::Gemm<1024, 256, 256, 512, 512 * 256 * 2> g{(const bf16*)(ws + WS_XC), (const bf16*)(ws + WS_WQK)};
        pg8::GroupOrder S; S.init(MS, G, bx);
        EpiQK E{(bf16*)(ws + WS_QM), (bf16*)(ws + WS_KM)};
        pg8::gemm_phase<EpiQK, pg8::GroupOrder, true, true>(lds3, g, S, E);
    } else if constexpr (KIND == K_CPREP) phase_cprep(args, lds, vcu, G);
    else if constexpr (KIND == K_MIX) phase_mix(args, lds, pass);
    else if constexpr (KIND == K_POST) phase_post(args, vcu, G);
    else if constexpr (KIND == K_OUT1) {
        { pg8::Gemm<1024, 1024, 1024> g{(const bf16*)(ws + WS_HR), (const bf16*)(ws + WS_WOM)};
          pg8::StaticOrder S; S.init(MS, 1024, G, bx);
          EpiMerge<0> E{(const bf16*)(ws + WS_P), (float*)(ws + WS_T), (bf16*)(ws + WS_MG)};
          pg8::gemm_phase<EpiMerge<0>, pg8::StaticOrder, true, true>(lds3, g, S, E); }
        { pg8::Gemm<512, 512, 512> g{(const bf16*)(ws + WS_UA), (const bf16*)(ws + WS_WOA)};
          pg8::StaticOrder S; S.init(MS, 1024, G, bx);
          EpiMerge<1> E{(const bf16*)(ws + WS_P), (float*)(ws + WS_T), (bf16*)(ws + WS_MG)};
          pg8::gemm_phase<EpiMerge<1>, pg8::StaticOrder, true, true>(lds3, g, S, E); }
    } else if constexpr (KIND == K_OUT2) {
        pg8::Gemm<1024, 1024, 1024> g{(const bf16*)(ws + WS_MG), (const bf16*)(ws + WS_WO)};
        pg8::StaticOrder S; S.init(MS, 1024, G, bx);
        EpiOut E{args.x, args.out, (const float*)(ws + WS_MOD) + 2048, (float*)(ws + WS_CTL) + CW_ROWSS, pass * MS};
        pg8::gemm_phase<EpiOut, pg8::StaticOrder, true, true>(lds3, g, S, E);
    }
}

#if !MK_ONE_LAUNCH
template <int KIND>
__global__ void __launch_bounds__(NTHR, 2) k_phase(Args args) {
    extern __shared__ __attribute__((aligned(16))) unsigned char lds[];
    run_phase<KIND>(args, lds, args.ph_lo);
}
#else
__global__ void __launch_bounds__(NTHR, 2) mk_fwd(Args args) {
    extern __shared__ __attribute__((aligned(16))) unsigned char lds[];
    volatile LAS unsigned* misc = (volatile LAS unsigned*)((LAS unsigned char*)lds + 131072 + 2048);
    if (threadIdx.x < 16) misc[threadIdx.x] = 0u;
    __syncthreads();
    XcdBarrier bar = xcd_barrier_post((unsigned*)(args.ws + WS_CTL) + CW_BAR, misc + 8);
    for (int gp = args.ph_lo; gp < args.ph_hi; ++gp) {
        if (gp == 0) run_phase<K_PROLOGUE>(args, lds, 0);
        else if (gp == 1) run_phase<K_H>(args, lds, 0);
        else if (gp == PH_TOTAL - 1) run_phase<K_NORM>(args, lds, 0);
        else {
            const int pass = (gp - 2) / PH_PER_PASS, k = (gp - 2) % PH_PER_PASS;
            if (k == 0) run_phase<K_INPROJ>(args, lds, pass);
            else if (k == 1) run_phase<K_PREP>(args, lds, pass);
            else if (k == 2) run_phase<K_QK>(args, lds, pass);
            else if (k == 3) run_phase<K_CPREP>(args, lds, pass);
            else if (k == 4) run_phase<K_MIX>(args, lds, pass);
            else if (k == 5) run_phase<K_POST>(args, lds, pass);
            else if (k == 6) run_phase<K_OUT1>(args, lds, pass);
            else run_phase<K_OUT2>(args, lds, pass);
        }
        if (gp + 1 < args.ph_hi) { if (gp == 0) { __threadfence(); cg::this_grid().sync(); } else xcd_barrier(bar); }
    }
}
#endif

extern "C" void kernel_launch(void* const* d_in, const int* in_sizes, int n_in, void* d_out, int out_size, void* d_ws, size_t ws_size, hipStream_t stream) {
    static int grid = 0;
    if (grid == 0) {
        if (n_in != 19 || in_sizes[0] != MALL * DM || out_size != MALL * DM || ws_size < WS_END) { fprintf(stderr, "kernel_launch: unexpected shapes (n_in %d, ws %zu)\n", n_in, ws_size); grid = -1; return; }
        int dev = 0, cus = 0, per_cu = 0;
        (void)hipGetDevice(&dev); (void)hipDeviceGetAttribute(&cus, hipDeviceAttributeMultiprocessorCount, dev);
#if MK_ONE_LAUNCH
        (void)hipFuncSetAttribute((const void*)mk_fwd, hipFuncAttributeMaxDynamicSharedMemorySize, LDS_BYTES);
        (void)hipOccupancyMaxActiveBlocksPerMultiprocessor(&per_cu, (const void*)mk_fwd, NTHR, LDS_BYTES);
        if (per_cu < 1) { fprintf(stderr, "kernel_launch: occupancy query says %d\n", per_cu); per_cu = 1; }
#else
#define SETATTR(KIND) (void)hipFuncSetAttribute((const void*)k_phase<KIND>, hipFuncAttributeMaxDynamicSharedMemorySize, LDS_BYTES)
        SETATTR(K_PROLOGUE); SETATTR(K_H); SETATTR(K_INPROJ); SETATTR(K_PREP); SETATTR(K_QK); SETATTR(K_MIX); SETATTR(K_POST); SETATTR(K_OUT1); SETATTR(K_OUT2); SETATTR(K_NORM); SETATTR(K_CPREP);
        (void)per_cu;
#endif
        (void)hipGetLastError();
        grid = cus;
    }
    if (grid < 0) return;
    (void)hipMemsetAsync((char*)d_ws + WS_CTL, 0, CTL_ZERO_BYTES, stream);
    Args a{};
    a.x = (const float*)d_in[0]; a.c = (const float*)d_in[1]; a.pos = (const int*)d_in[2]; a.w_ada = (const float*)d_in[3]; a.b_ada = (const float*)d_in[4];
    a.g_norm = (const float*)d_in[5]; a.w_in = (const float*)d_in[6]; a.b_ig = (const float*)d_in[7]; a.b_fg = (const float*)d_in[8]; a.w_conv = (const float*)d_in[9];
    a.b_conv = (const float*)d_in[10]; a.w_q = (const float*)d_in[11]; a.w_k = (const float*)d_in[12]; a.g_head = (const float*)d_in[13]; a.skip = (const float*)d_in[14];
    a.w_om = (const float*)d_in[15]; a.w_oa = (const float*)d_in[16]; a.w_o = (const float*)d_in[17]; a.g_final = (const float*)d_in[18];
    a.out = (float*)d_out; a.ws = (unsigned char*)d_ws;
#if MK_ONE_LAUNCH
    a.ph_lo = 0; a.ph_hi = PH_TOTAL;
    void* params[] = {&a};
    hipError_t e = hipLaunchCooperativeKernel((const void*)mk_fwd, dim3(grid), dim3(NTHR), params, LDS_BYTES, stream);
    if (e != hipSuccess) fprintf(stderr, "cooperative launch failed: %s\n", hipGetErrorString(e));
#else
#define LAUNCH(KIND, PASS) do { a.ph_lo = (PASS); a.ph_hi = 0; hipLaunchKernelGGL(k_phase<KIND>, dim3(grid), dim3(NTHR), LDS_BYTES, stream, a); } while (0)
    LAUNCH(K_PROLOGUE, 0); LAUNCH(K_H, 0);
    for (int p = 0; p < NPASS; ++p) { LAUNCH(K_INPROJ, p); LAUNCH(K_PREP, p); LAUNCH(K_QK, p); LAUNCH(K_CPREP, p); LAUNCH(K_MIX, p); LAUNCH(K_POST, p); LAUNCH(K_OUT1, p); LAUNCH(K_OUT2, p); }
    LAUNCH(K_NORM, 0);
#endif
}
```

```cpp
#include <hip/hip_runtime.h>
#include <hip/hip_cooperative_groups.h>
#include <cstdio>
#include <cstdint>
namespace cg = cooperative_groups;

#ifndef MK_ONE_LAUNCH
#define MK_ONE_LAUNCH 1
#endif

__device__ __forceinline__ int opaque_tid() { int t = threadIdx.x; asm volatile("" : "+v"(t)); return t; }
namespace pg8 {
#define PG8_LAS __attribute__((address_space(3)))
typedef unsigned short bf16_t;
typedef short bf16x8 __attribute__((ext_vector_type(8)));
typedef float f32x4 __attribute__((ext_vector_type(4)));
typedef unsigned u32x4 __attribute__((ext_vector_type(4)));
constexpr int BM = 256, BK = 64, HALF = 128, HTB = HALF * BK * 2, STAGE_BYTES = 8 * HTB, NXCD = 8, WGM = 8;

__host__ __device__ __forceinline__ int lds_byte(int r, int c) { const int st = (r >> 4) * 2 + (c >> 5), rr = r & 15, cc = c & 31, ob = rr * 64 + cc * 2; return st * 1024 + (ob ^ (((ob >> 9) & 1) << 5)); }
__host__ __device__ __forceinline__ void stage_rc(int b, int& R, int& C) { const int st = b / 1024, sb = b % 1024, swz = sb ^ (((sb >> 9) & 1) << 5); R = (st >> 1) * 16 + swz / 64; C = (st & 1) * 32 + (swz % 64) / 2; }
__host__ __device__ __forceinline__ int perm32(int rho) { const int n = rho >> 4, i = rho & 15; return 8 * (i >> 2) + 4 * n + (i & 3); }

struct Unit { int pm, pn, g; };
template <int LDA, int LDB, int KK, int AGS = 0, int BGS = 0> struct Gemm {
    const bf16_t* A; const bf16_t* Bt;
    static constexpr int lda = LDA, ldb = LDB, K = KK;
    __device__ __forceinline__ const char* abase(const Unit& u) const { return (const char*)A + (size_t)(u.g * AGS) + (size_t)u.pm * (size_t)(BM * 2 * LDA); }
    __device__ __forceinline__ const char* bbase(const Unit& u) const { return (const char*)Bt + (size_t)(u.g * BGS) + (size_t)u.pn * (size_t)(BM * 2 * LDB); }
};

struct StaticOrder {
    int nM, nN, nwg, G, c;
    __host__ __device__ void init(int M, int N, int G_, int c_) { nM = M / BM; nN = N / BM; nwg = nM * nN; G = G_; c = c_; }
    __host__ __device__ bool next(int i, Unit& u) const {
        const long L = (long)i * G + c; if (L >= nwg) return false;
        int wgid = (int)L; { const int q = nwg / NXCD, r = nwg % NXCD, xcd = wgid % NXCD, off = wgid / NXCD; wgid = (xcd < r ? xcd * (q + 1) : r * (q + 1) + (xcd - r) * q) + off; }
        const int nig = WGM * nN, gid = wgid / nig, fm = gid * WGM, gsz = (nM - fm) < WGM ? (nM - fm) : WGM;
        u.pm = fm + ((wgid % nig) % gsz); u.pn = (wgid % nig) / gsz; u.g = 0; return true;
    }
    __device__ __forceinline__ void a_ready(const Unit&) const {}
    __device__ __forceinline__ void done(const Unit&) const {}
};
struct GroupOrder {
    int nunits, G, c;
    __host__ __device__ void init(int M, int G_, int c_) { nunits = (M / BM) * 8; G = G_; c = c_; }
    __host__ __device__ bool next(int i, Unit& u) const {
        const long L = (long)i * G + c; if (L >= nunits) return false;
        u.pm = (int)(L >> 3); u.g = (int)((L & 7) >> 1); u.pn = (int)(L & 1); return true;
    }
    __device__ __forceinline__ void a_ready(const Unit&) const {}
    __device__ __forceinline__ void done(const Unit&) const {}
};

__device__ __forceinline__ unsigned cvt_pk_bf16(float lo, float hi) { unsigned r; asm volatile("v_cvt_pk_bf16_f32 %0, %1, %2" : "=v"(r) : "v"(lo), "v"(hi)); return r; }

template <class Epi, class Sched, bool ALIGN_EPI, bool SP2, class GemmT>
__device__ __forceinline__ void gemm_phase(PG8_LAS unsigned char* lds, const GemmT g, const Sched& S, const Epi& E) {
    const int tid = opaque_tid(), wid = __builtin_amdgcn_readfirstlane(tid >> 6), lane = tid & 63, wr = wid >> 2, wc = wid & 3, fr = lane & 15, fq = lane >> 4;
    constexpr int K = GemmT::K, nt = K / BK;
    unsigned voffA[2], voffB[2];
#pragma unroll
    for (int i = 0; i < 2; ++i) { int R, C; stage_rc(tid * 16 + i * 8192, R, C); const int Rb = Epi::PERM ? ((R & ~31) + perm32(R & 31)) : R;
        voffA[i] = (unsigned)(R * g.lda + C) * 2u; voffB[i] = (unsigned)(Rb * g.ldb + C) * 2u; }
    const size_t kstep = (size_t)(BK * 2);
    const size_t hstepA = (size_t)HALF * g.lda * 2, hstepB = (size_t)HALF * g.ldb * 2;
    const unsigned ldsw = (unsigned)wid * 1024u;
    const int aoff = lds_byte(wr * 64 + fr, fq * 8), boff = lds_byte(wc * 32 + fr, fq * 8);
#define PG8_SA(b, h) (((b) * 2 + (h)) * HTB)
#define PG8_SB(b, h) ((4 + (b) * 2 + (h)) * HTB)
#define PG8_STAGE(bufoff, gbase, voff) do { _Pragma("unroll") for (int _i = 0; _i < 2; ++_i) \
        __builtin_amdgcn_global_load_lds((const unsigned*)((const char*)(gbase) + (voff)[_i]), (PG8_LAS unsigned*)(lds + (bufoff) + ldsw + _i * 8192), 16, 0, 0); } while (0)
#define PG8_LDA(dst, b, h) do { _Pragma("unroll") for (int m = 0; m < 4; ++m) _Pragma("unroll") for (int k = 0; k < 2; ++k) dst[m][k] = *(const PG8_LAS bf16x8*)(lds + PG8_SA(b, h) + aoff + m * 2048 + k * 1024); } while (0)
#define PG8_LDB(dst, b, h) do { _Pragma("unroll") for (int n = 0; n < 2; ++n) _Pragma("unroll") for (int k = 0; k < 2; ++k) dst[n][k] = *(const PG8_LAS bf16x8*)(lds + PG8_SB(b, h) + boff + n * 2048 + k * 1024); } while (0)
#define PG8_MMA(ai, bj, At, Bt) do { __builtin_amdgcn_s_setprio(1); _Pragma("unroll") for (int m = 0; m < 4; ++m) _Pragma("unroll") for (int n = 0; n < 2; ++n) _Pragma("unroll") for (int k = 0; k < 2; ++k) \
        acc[ai][bj][m][n] = __builtin_amdgcn_mfma_f32_16x16x32_bf16(Bt[n][k], At[m][k], acc[ai][bj][m][n], 0, 0, 0); __builtin_amdgcn_s_setprio(0); } while (0)
#define PG8_WAIT_V(n) asm volatile("s_waitcnt vmcnt(" #n ")" ::: "memory")
#define PG8_WAIT_L(n) asm volatile("s_waitcnt lgkmcnt(" #n ")" ::: "memory")
#define PG8_BAR __builtin_amdgcn_s_barrier()
#define PG8_SCHED __builtin_amdgcn_sched_barrier(0)
    Unit cur, nxt; int ui = 0;
    if (!S.next(0, cur)) return;
    f32x4 acc[2][2][4][2];
#pragma unroll
    for (int a = 0; a < 2; ++a)
#pragma unroll
        for (int b = 0; b < 2; ++b)
#pragma unroll
            for (int m = 0; m < 4; ++m)
#pragma unroll
                for (int n = 0; n < 2; ++n) acc[a][b][m][n] = (f32x4){0.f, 0.f, 0.f, 0.f};
    bf16x8 At[4][2], B0[2][2], B1[2][2];
    const char* cA = g.abase(cur); const char* cB = g.bbase(cur);
    S.a_ready(cur);
    if constexpr (SP2) {
        PG8_STAGE(PG8_SB(0, 0), cB, voffB); PG8_STAGE(PG8_SB(0, 1), cB + hstepB, voffB); PG8_STAGE(PG8_SA(0, 0), cA, voffA); PG8_STAGE(PG8_SA(0, 1), cA + hstepA, voffA);
        if (wr == 1) PG8_BAR;
        PG8_WAIT_V(2); PG8_BAR;
        PG8_STAGE(PG8_SB(1, 0), cB + kstep, voffB); PG8_STAGE(PG8_SA(1, 0), cA + kstep, voffA); PG8_STAGE(PG8_SB(1, 1), cB + hstepB + kstep, voffB);
        PG8_WAIT_V(6); PG8_BAR;
    } else {
        PG8_STAGE(PG8_SB(0, 0), cB, voffB); PG8_STAGE(PG8_SA(0, 0), cA, voffA); PG8_STAGE(PG8_SB(0, 1), cB + hstepB, voffB); PG8_STAGE(PG8_SA(0, 1), cA + hstepA, voffA);
        if (wr == 1) PG8_BAR;
        PG8_WAIT_V(4); PG8_BAR;
        PG8_STAGE(PG8_SB(1, 0), cB + kstep, voffB); PG8_STAGE(PG8_SA(1, 0), cA + kstep, voffA); PG8_STAGE(PG8_SB(1, 1), cB + hstepB + kstep, voffB);
        PG8_WAIT_V(6); PG8_BAR;
    }
    for (;;) {
        const bool has_next = S.next(ui + 1, nxt);
        const char* nA = has_next ? g.abase(nxt) : cA; const char* nB = has_next ? g.bbase(nxt) : cB;
#pragma nounroll
        for (int t = 0; t < nt; t += 2) {
            const bool last = (t == nt - 2);
            const char* a1 = cA + (size_t)(t + 1) * kstep;
            const char* a2 = last ? nA : cA + (size_t)(t + 2) * kstep; const char* b2 = last ? nB : cB + (size_t)(t + 2) * kstep;
            const char* a3 = a2 + kstep; const char* b3 = b2 + kstep;
            if (last && has_next) S.a_ready(nxt);
            if constexpr (SP2) {
            PG8_LDB(B0, 0, 0); PG8_LDB(B1, 0, 1); PG8_SCHED; PG8_LDA(At, 0, 0); PG8_STAGE(PG8_SA(1, 1), a1 + hstepA, voffA);
            PG8_WAIT_V(8); PG8_WAIT_L(0); PG8_BAR; PG8_MMA(0, 0, At, B0); PG8_MMA(0, 1, At, B1); PG8_BAR; PG8_SCHED;
            PG8_LDA(At, 0, 1); PG8_STAGE(PG8_SB(0, 0), b2, voffB); PG8_STAGE(PG8_SB(0, 1), b2 + hstepB, voffB); PG8_STAGE(PG8_SA(0, 0), a2, voffA);
            PG8_WAIT_V(8); PG8_WAIT_L(0); PG8_BAR; PG8_MMA(1, 0, At, B0); PG8_MMA(1, 1, At, B1); PG8_BAR; PG8_SCHED;
            PG8_LDB(B0, 1, 0); PG8_LDB(B1, 1, 1); PG8_SCHED; PG8_LDA(At, 1, 0); PG8_STAGE(PG8_SA(0, 1), a2 + hstepA, voffA);
            PG8_WAIT_V(8); PG8_WAIT_L(0); PG8_BAR; PG8_MMA(0, 0, At, B0); PG8_MMA(0, 1, At, B1); PG8_BAR; PG8_SCHED;
            PG8_LDA(At, 1, 1); PG8_STAGE(PG8_SB(1, 0), b3, voffB); PG8_STAGE(PG8_SB(1, 1), b3 + hstepB, voffB); PG8_STAGE(PG8_SA(1, 0), a3, voffA);
            PG8_WAIT_V(8); PG8_WAIT_L(0); PG8_BAR; PG8_MMA(1, 0, At, B0); PG8_MMA(1, 1, At, B1); PG8_BAR; PG8_SCHED;
            } else {
            PG8_LDB(B0, 0, 0); PG8_SCHED; PG8_LDA(At, 0, 0); PG8_STAGE(PG8_SA(1, 1), a1 + hstepA, voffA);
            PG8_WAIT_L(8); PG8_BAR; PG8_WAIT_L(0); PG8_MMA(0, 0, At, B0); PG8_BAR; PG8_SCHED;
            PG8_LDB(B1, 0, 1); PG8_STAGE(PG8_SB(0, 0), b2, voffB);
            PG8_BAR; PG8_WAIT_L(0); PG8_MMA(0, 1, At, B1); PG8_BAR;
            PG8_LDA(At, 0, 1); PG8_STAGE(PG8_SA(0, 0), a2, voffA);
            PG8_BAR; PG8_WAIT_L(0); PG8_MMA(1, 0, At, B0); PG8_BAR; PG8_SCHED;
            PG8_STAGE(PG8_SB(0, 1), b2 + hstepB, voffB);
            PG8_WAIT_V(6); PG8_BAR; PG8_MMA(1, 1, At, B1); PG8_BAR;
            PG8_LDB(B0, 1, 0); PG8_SCHED; PG8_LDA(At, 1, 0); PG8_STAGE(PG8_SA(0, 1), a2 + hstepA, voffA);
            PG8_WAIT_L(8); PG8_BAR; PG8_WAIT_L(0); PG8_MMA(0, 0, At, B0); PG8_BAR; PG8_SCHED;
            PG8_LDB(B1, 1, 1); PG8_STAGE(PG8_SB(1, 0), b3, voffB);
            PG8_BAR; PG8_WAIT_L(0); PG8_MMA(0, 1, At, B1); PG8_BAR;
            PG8_LDA(At, 1, 1); PG8_STAGE(PG8_SA(1, 0), a3, voffA);
            PG8_BAR; PG8_WAIT_L(0); PG8_MMA(1, 0, At, B0); PG8_BAR; PG8_SCHED;
            PG8_STAGE(PG8_SB(1, 1), b3 + hstepB, voffB);
            PG8_WAIT_V(6); PG8_BAR; PG8_MMA(1, 1, At, B1); PG8_BAR;
            }
        }
        if constexpr (ALIGN_EPI) { if (wr == 0) PG8_BAR; }
        E(acc, cur, wr, wc, fr, fq); S.done(cur);
        if (!has_next) break;
#pragma unroll
        for (int a = 0; a < 2; ++a)
#pragma unroll
            for (int b = 0; b < 2; ++b)
#pragma unroll
                for (int m = 0; m < 4; ++m)
#pragma unroll
                    for (int n = 0; n < 2; ++n) acc[a][b][m][n] = (f32x4){0.f, 0.f, 0.f, 0.f};
        cur = nxt; cA = nA; cB = nB; ++ui;
        if constexpr (ALIGN_EPI) { if (wr == 1) PG8_BAR; }
    }
    PG8_WAIT_V(0);
    if constexpr (!ALIGN_EPI) { if (wr == 0) PG8_BAR; }
    PG8_BAR;
#undef PG8_SA
#undef PG8_SB
#undef PG8_STAGE
#undef PG8_LDA
#undef PG8_LDB
#undef PG8_MMA
#undef PG8_WAIT_V
#undef PG8_WAIT_L
#undef PG8_BAR
#undef PG8_SCHED
}
}

constexpr int NWAVES = 8, NTHR = 512;
constexpr int DM = 1024, NBATCH = 16, SEQ = 4096, MALL = NBATCH * SEQ;
constexpr int NB_PASS = 4, MS = NB_PASS * SEQ, NPASS = NBATCH / NB_PASS;
constexpr int INW_SRC = 11272, INW = 11264;
constexpr int C_XA = 0, C_VA = 1024, C_OA = 2048, C_ZA = 3072, C_QA = 4096, C_KA = 5632, C_VT = 7168, C_ZB = 8704, C_GA = 9216, C_GB = 10240;
constexpr float EPS = 1e-6f;

constexpr size_t MiB = 1u << 20;
constexpr size_t WS_CTL = 0, CTL_ZERO_BYTES = 1 * MiB;
constexpr size_t WS_MOD = 1 * MiB;
constexpr size_t WS_WG = 1 * MiB + 256 * 1024;
constexpr size_t WS_WIN = 2 * MiB;
constexpr size_t WS_WQK = 24 * MiB;
constexpr size_t WS_WOM = 25 * MiB, WS_WOA = 27 * MiB, WS_WO = 28 * MiB;
constexpr size_t WS_IG = 30 * MiB, WS_FG = 31 * MiB;
constexpr size_t WS_GSC = 32 * MiB;
constexpr size_t WS_LSE = 34 * MiB;
constexpr size_t WS_DEN = 35 * MiB;
constexpr size_t WS_H = 36 * MiB;
constexpr size_t WS_P = 164 * MiB;
constexpr size_t WS_XC = 516 * MiB;
constexpr size_t WS_QM = 548 * MiB, WS_KM = 580 * MiB;
constexpr size_t WS_HR = 612 * MiB;
constexpr size_t WS_AO = 644 * MiB;
constexpr size_t WS_UA = 692 * MiB;
constexpr size_t WS_T = 708 * MiB;
constexpr size_t WS_MG = 772 * MiB;
constexpr size_t WS_SG = 804 * MiB;
constexpr size_t WS_KTG = 812 * MiB;
constexpr size_t WS_VTG = 844 * MiB;
constexpr size_t WS_CS = 876 * MiB;
constexpr size_t WS_NS = 1004 * MiB;
constexpr size_t WS_ROPE = 1005 * MiB;
constexpr size_t WS_END = 1013 * MiB;
constexpr int CW_QCTR = 1024;
constexpr int CW_ROWSS = 65536;
static_assert((CW_ROWSS + MALL) * 4 <= (int)CTL_ZERO_BYTES, "ctl");

constexpr int LDS_BYTES = 147456;

typedef unsigned short bf16;
typedef float f32x4 __attribute__((ext_vector_type(4)));
typedef float f32x2 __attribute__((ext_vector_type(2)));
typedef short bf16x8 __attribute__((ext_vector_type(8)));
typedef unsigned u32x4 __attribute__((ext_vector_type(4)));
typedef unsigned u32x2 __attribute__((ext_vector_type(2)));

__device__ __forceinline__ unsigned f2bf(float f) { unsigned u = __builtin_bit_cast(unsigned, f); return (u + 0x7fffu + ((u >> 16) & 1u)) >> 16; }
__device__ __forceinline__ unsigned pk2(float lo, float hi) { return f2bf(lo) | (f2bf(hi) << 16); }
__device__ __forceinline__ float bflo(unsigned w) { return __builtin_bit_cast(float, w << 16); }
__device__ __forceinline__ float bfhi(unsigned w) { return __builtin_bit_cast(float, w & 0xffff0000u); }
__device__ __forceinline__ float bf1(bf16 v) { return __builtin_bit_cast(float, (unsigned)v << 16); }
__device__ __forceinline__ float sigmoidf_(float x) { return 1.f / (1.f + __expf(-x)); }
__device__ __forceinline__ float siluf_(float x) { return x / (1.f + __expf(-x)); }
__device__ __forceinline__ float wave_sum(float v) {
#pragma unroll
    for (int o = 1; o < 64; o <<= 1) v += __shfl_xor(v, o);
    return v;
}
__device__ __forceinline__ void unpack8(const u32x4 w, float* f) {
    f[0] = bflo(w.x); f[1] = bfhi(w.x); f[2] = bflo(w.y); f[3] = bfhi(w.y); f[4] = bflo(w.z); f[5] = bfhi(w.z); f[6] = bflo(w.w); f[7] = bfhi(w.w);
}

struct Args {
    const float* x; const float* c; const int* pos; const float* w_ada; const float* b_ada; const float* g_norm; const float* w_in;
    const float* b_ig; const float* b_fg; const float* w_conv; const float* b_conv; const float* w_q; const float* w_k; const float* g_head;
    const float* skip; const float* w_om; const float* w_oa; const float* w_o; const float* g_final;
    float* out; unsigned char* ws; int ph_lo, ph_hi;
};

__device__ __forceinline__ void transpose_item(const float* W, int K, int Nsrc, int nblk, int src_col_off, bf16* WT, int ldt, int row_off, float scale, float* scr, int item, int lane) {
    const int kb = item / nblk, nb = item % nblk, k0 = 64 * kb, n0 = 32 * nb;
#pragma unroll 8
    for (int i = 0; i < 32; ++i) { const int kk = 2 * i + (lane >> 5); scr[kk * 33 + (lane & 31)] = W[(size_t)(k0 + kk) * Nsrc + src_col_off + n0 + (lane & 31)]; }
    __builtin_amdgcn_wave_barrier();
    asm volatile("s_waitcnt lgkmcnt(0)" ::: "memory");
    const int cc = lane & 7;
#pragma unroll
    for (int j = 0; j < 4; ++j) { const int n = (lane >> 3) + 8 * j; const float* s = scr + (8 * cc) * 33 + n;
        u32x4 o; o.x = pk2(s[0 * 33] * scale, s[1 * 33] * scale); o.y = pk2(s[2 * 33] * scale, s[3 * 33] * scale); o.z = pk2(s[4 * 33] * scale, s[5 * 33] * scale); o.w = pk2(s[6 * 33] * scale, s[7 * 33] * scale);
        *(u32x4*)(WT + (size_t)(row_off + n0 + n) * ldt + k0 + 8 * cc) = o; }
    asm volatile("s_waitcnt lgkmcnt(0)" ::: "memory");
    __builtin_amdgcn_wave_barrier();
}

__device__ __forceinline__ void phase_prologue(const Args& a, unsigned char* lds, int vcu, int G) {
    const int tid = opaque_tid(), lane = tid & 63, wave = tid >> 6;
    unsigned char* ws = a.ws;
    if (vcu < 48) {
        float* sc = (float*)lds;
        float* red = (float*)(lds + 65536);
        for (int i = tid; i < 16 * 1024; i += NTHR) sc[i] = siluf_(a.c[i]);
        __syncthreads();
        const int n = vcu * 64 + lane;
        float acc[16];
#pragma unroll
        for (int b = 0; b < 16; ++b) acc[b] = 0.f;
        const int k0 = wave * 128;
#pragma unroll 16
        for (int k = k0; k < k0 + 128; ++k) { const float w = a.w_ada[(size_t)k * 3072 + n];
#pragma unroll
            for (int b = 0; b < 16; ++b) acc[b] += sc[b * 1024 + k] * w; }
#pragma unroll
        for (int b = 0; b < 16; ++b) red[(wave * 16 + b) * 64 + lane] = acc[b];
        __syncthreads();
        float* mod = (float*)(ws + WS_MOD);
        for (int i = tid; i < 16 * 64; i += NTHR) { const int b = i >> 6, l = i & 63, nn = vcu * 64 + l; float s = 0.f;
#pragma unroll
            for (int w = 0; w < 8; ++w) s += red[(w * 16 + b) * 64 + l];
            s += a.b_ada[nn];
            const int part = nn >> 10, col = nn & 1023;
            if (part == 1) s = a.g_norm[col] * (1.f + s);
            mod[b * 3072 + nn] = s; }
        __syncthreads();
    }
    {
        float* scr = (float*)lds + wave * (64 * 33);
        const int gw = vcu * NWAVES + wave, NGW = G * NWAVES;
        constexpr int I_IN = (1024 / 64) * (INW / 32);
        constexpr int I_QK = 8 * (256 / 64) * (256 / 32);
        constexpr int I_OM = 16 * 32, I_OA = 8 * 32, I_O = 16 * 32;
        constexpr int NITEMS = I_IN + I_QK + I_OM + I_OA + I_O;
        for (int it = gw; it < NITEMS; it += NGW) {
            int r = it;
            if (r < I_IN) { const int nb = r % (INW / 32); const int off = (nb * 32 >= 4096) ? 8 : 0;
                transpose_item(a.w_in, 1024, INW_SRC, INW / 32, off, (bf16*)(ws + WS_WIN), 1024, 0, 1.f, scr, r, lane); continue; } r -= I_IN;
            if (r < I_QK) { const int mtx = r >> 5, rr = r & 31, h = mtx >> 1, isk = mtx & 1;
                const float* W = (isk ? a.w_k : a.w_q) + (size_t)h * 65536;
                transpose_item(W, 256, 256, 8, 0, (bf16*)(ws + WS_WQK) + (size_t)h * 512 * 256, 256, isk * 256, isk ? 0.0625f : 1.f, scr, rr, lane); continue; } r -= I_QK;
            if (r < I_OM) { transpose_item(a.w_om, 1024, 1024, 32, 0, (bf16*)(ws + WS_WOM), 1024, 0, 1.f, scr, r, lane); continue; } r -= I_OM;
            if (r < I_OA) { transpose_item(a.w_oa, 512, 1024, 32, 0, (bf16*)(ws + WS_WOA), 512, 0, 1.f, scr, r, lane); continue; } r -= I_OA;
            transpose_item(a.w_o, 1024, 1024, 32, 0, (bf16*)(ws + WS_WO), 1024, 0, 1.f, scr, r, lane);
        }
        float* wg = (float*)(ws + WS_WG);
        for (int i = (vcu * NTHR + tid); i < 8 * 1024; i += G * NTHR) { const int j = i >> 10, k = i & 1023; wg[i] = a.w_in[(size_t)k * INW_SRC + 4096 + j]; }
    }
}

__constant__ double c_inv_freq[16] = {1.0, 0.44036660267178046, 0.19392274474868576, 0.08539710028576561, 0.03760603093086393, 0.016560440080994446, 0.007292664737217109, 0.003211445994752591,
    0.001414213562373095, 0.000622772421914596, 0.0002742481756762073, 0.00012076973741146504, 5.318295896944988e-05, 2.341999896140934e-05, 1.031338537721246e-05, 4.5416704806078695e-06};

__device__ __forceinline__ void phase_h(const Args& a, unsigned char* lds, int vcu, int G) {
    const int tid = opaque_tid(), lane = tid & 63, wave = tid >> 6;
    unsigned char* ws = a.ws;
    float* wg = (float*)lds;
    { const float* src = (const float*)(ws + WS_WG); for (int i = tid; i < 8192; i += NTHR) wg[i] = src[i]; }
    __syncthreads();
    const float* mod = (const float*)(ws + WS_MOD);
    bf16* H = (bf16*)(ws + WS_H);
    float* IG = (float*)(ws + WS_IG); float* FG = (float*)(ws + WS_FG); float* ROPE = (float*)(ws + WS_ROPE);
    const int gw = vcu * NWAVES + wave, NGW = G * NWAVES;
    for (int row0 = 2 * gw; row0 < MALL; row0 += 2 * NGW) {
        f32x4 v[2][4]; float ss[2] = {0.f, 0.f};
#pragma unroll
        for (int rr = 0; rr < 2; ++rr) { const f32x4* xr = (const f32x4*)(a.x + (size_t)(row0 + rr) * DM) + lane;
#pragma unroll
            for (int j = 0; j < 4; ++j) v[rr][j] = xr[64 * j]; }
        if (lane < 32) { const int rr = lane >> 4, fi = lane & 15; const int pos = a.pos[row0 + rr];
            const double rev = (double)pos * c_inv_freq[fi] * 0.15915494309189535; const float fr_ = (float)(rev - rint(rev));
            ROPE[(size_t)(row0 + rr) * 32 + fi] = __builtin_amdgcn_cosf(fr_); ROPE[(size_t)(row0 + rr) * 32 + 16 + fi] = __builtin_amdgcn_sinf(fr_); }
#pragma unroll
        for (int rr = 0; rr < 2; ++rr) {
#pragma unroll
            for (int j = 0; j < 4; ++j) ss[rr] += (v[rr][j].x * v[rr][j].x + v[rr][j].y * v[rr][j].y) + (v[rr][j].z * v[rr][j].z + v[rr][j].w * v[rr][j].w);
        }
#pragma unroll
        for (int o = 1; o < 64; o <<= 1) { ss[0] += __shfl_xor(ss[0], o); ss[1] += __shfl_xor(ss[1], o); }
        const int b = row0 >> 12;
        float pg[2][8];
#pragma unroll
        for (int rr = 0; rr < 2; ++rr)
#pragma unroll
            for (int g = 0; g < 8; ++g) pg[rr][g] = 0.f;
        const float rinv[2] = {1.f / sqrtf(ss[0] * (1.f / DM) + EPS), 1.f / sqrtf(ss[1] * (1.f / DM) + EPS)};
#pragma unroll
        for (int j = 0; j < 4; ++j) {
            const int col = 4 * lane + 256 * j;
            const f32x4 sh = *(const f32x4*)(mod + b * 3072 + col), gs = *(const f32x4*)(mod + b * 3072 + 1024 + col);
            f32x4 h[2];
#pragma unroll
            for (int rr = 0; rr < 2; ++rr) { h[rr] = v[rr][j] * rinv[rr] * gs + sh;
                u32x2 o; o.x = pk2(h[rr].x, h[rr].y); o.y = pk2(h[rr].z, h[rr].w); *((u32x2*)(H + (size_t)(row0 + rr) * DM) + lane + 64 * j) = o; }
#pragma unroll
            for (int g = 0; g < 8; ++g) { const f32x4 w = *(const f32x4*)(wg + g * 1024 + col);
                pg[0][g] += (h[0].x * w.x + h[0].y * w.y) + (h[0].z * w.z + h[0].w * w.w); pg[1][g] += (h[1].x * w.x + h[1].y * w.y) + (h[1].z * w.z + h[1].w * w.w); }
            __builtin_amdgcn_sched_barrier(0);
        }
#pragma unroll
        for (int o = 1; o < 64; o <<= 1)
#pragma unroll
            for (int g = 0; g < 8; ++g) { pg[0][g] += __shfl_xor(pg[0][g], o); pg[1][g] += __shfl_xor(pg[1][g], o); }
        if (lane < 2) { const int rr = lane; const float* p = rr ? pg[1] : pg[0];
            f32x4 ig = {p[0] + a.b_ig[0], p[1] + a.b_ig[1], p[2] + a.b_ig[2], p[3] + a.b_ig[3]};
            f32x4 fg = {p[4] + a.b_fg[0], p[5] + a.b_fg[1], p[6] + a.b_fg[2], p[7] + a.b_fg[3]};
            *(f32x4*)(IG + (size_t)(row0 + rr) * 4) = ig; *(f32x4*)(FG + (size_t)(row0 + rr) * 4) = fg; }
    }
}

struct EpiProj {
    static constexpr bool PERM = true;
    bf16* P;
    __device__ __forceinline__ void operator()(const f32x4 (&acc)[2][2][4][2], const pg8::Unit& u, int wr, int wc, int fr, int fq) const {
        const int row0 = u.pm * 256 + wr * 64 + fr, col0 = u.pn * 256 + wc * 32 + 8 * fq;
#pragma unroll
        for (int ai = 0; ai < 2; ++ai)
#pragma unroll
            for (int m = 0; m < 4; ++m) { bf16* rowp = P + (size_t)(row0 + ai * 128 + m * 16) * INW + col0;
#pragma unroll
                for (int bj = 0; bj < 2; ++bj) { const f32x4 v0 = acc[ai][bj][m][0], v1 = acc[ai][bj][m][1];
                    u32x4 w; w.x = pg8::cvt_pk_bf16(v0[0], v0[1]); w.y = pg8::cvt_pk_bf16(v0[2], v0[3]); w.z = pg8::cvt_pk_bf16(v1[0], v1[1]); w.w = pg8::cvt_pk_bf16(v1[2], v1[3]);
                    *(u32x4*)(rowp + bj * 128) = w; } }
    }
};
struct EpiQK {
    static constexpr bool PERM = true;
    bf16* QM; bf16* KM;
    __device__ __forceinline__ void operator()(const f32x4 (&acc)[2][2][4][2], const pg8::Unit& u, int wr, int wc, int fr, int fq) const {
        const int row0 = u.pm * 256 + wr * 64 + fr, col0 = u.g * 256 + wc * 32 + 8 * fq;
        bf16* base = u.pn ? KM : QM;
#pragma unroll
        for (int ai = 0; ai < 2; ++ai)
#pragma unroll
            for (int m = 0; m < 4; ++m) { bf16* rowp = base + (size_t)(row0 + ai * 128 + m * 16) * 1024 + col0;
#pragma unroll
                for (int bj = 0; bj < 2; ++bj) { const f32x4 v0 = acc[ai][bj][m][0], v1 = acc[ai][bj][m][1];
                    u32x4 w; w.x = pg8::cvt_pk_bf16(v0[0], v0[1]); w.y = pg8::cvt_pk_bf16(v0[2], v0[3]); w.z = pg8::cvt_pk_bf16(v1[0], v1[1]); w.w = pg8::cvt_pk_bf16(v1[2], v1[3]);
                    *(u32x4*)(rowp + bj * 128) = w; } }
    }
};
template <int MODE> struct EpiMerge {
    static constexpr bool PERM = true;
    const bf16* P; float* T; bf16* MG;
    __device__ __forceinline__ void operator()(const f32x4 (&acc)[2][2][4][2], const pg8::Unit& u, int wr, int wc, int fr, int fq) const {
        const int row0 = u.pm * 256 + wr * 64 + fr, col0 = u.pn * 256 + wc * 32 + 8 * fq;
#pragma unroll
        for (int ai = 0; ai < 2; ++ai)
#pragma unroll
            for (int m = 0; m < 4; ++m) { const size_t r = (size_t)(row0 + ai * 128 + m * 16);
#pragma unroll
                for (int bj = 0; bj < 2; ++bj) { const int c = col0 + bj * 128;
                    const u32x4 gw = *(const u32x4*)(P + r * INW + (MODE == 0 ? C_GA : C_GB) + c); float gg[8]; unpack8(gw, gg);
                    const f32x4 v0 = acc[ai][bj][m][0], v1 = acc[ai][bj][m][1];
                    float o[8];
#pragma unroll
                    for (int e = 0; e < 4; ++e) { o[e] = sigmoidf_(gg[e]) * v0[e]; o[4 + e] = sigmoidf_(gg[4 + e]) * v1[e]; }
                    float* tp = T + r * 1024 + c;
                    if (MODE == 0) { *(f32x4*)tp = (f32x4){o[0], o[1], o[2], o[3]}; *(f32x4*)(tp + 4) = (f32x4){o[4], o[5], o[6], o[7]}; }
                    else { const f32x4 t0 = *(const f32x4*)tp, t1 = *(const f32x4*)(tp + 4);
                        u32x4 w; w.x = pg8::cvt_pk_bf16(t0[0] + o[0], t0[1] + o[1]); w.y = pg8::cvt_pk_bf16(t0[2] + o[2], t0[3] + o[3]);
                        w.z = pg8::cvt_pk_bf16(t1[0] + o[4], t1[1] + o[5]); w.w = pg8::cvt_pk_bf16(t1[2] + o[6], t1[3] + o[7]);
                        *(u32x4*)(MG + r * 1024 + c) = w; } } }
    }
};
struct EpiOut {
    static constexpr bool PERM = true;
    const float* x; float* out; const float* gate; float* rowss; int grow0;
    __device__ __forceinline__ void operator()(const f32x4 (&acc)[2][2][4][2], const pg8::Unit& u, int wr, int wc, int fr, int fq) const {
        const int row0 = grow0 + u.pm * 256 + wr * 64 + fr, col0 = u.pn * 256 + wc * 32 + 8 * fq;
#pragma unroll
        for (int ai = 0; ai < 2; ++ai)
#pragma unroll
            for (int m = 0; m < 4; ++m) { const int r = row0 + ai * 128 + m * 16; const int b = r >> 12; float ss = 0.f;
#pragma unroll
                for (int bj = 0; bj < 2; ++bj) { const int c = col0 + bj * 128;
                    const float* gp = gate + b * 3072 + c; const f32x4 g0 = *(const f32x4*)gp, g1 = *(const f32x4*)(gp + 4);
                    const float* xp = x + (size_t)r * 1024 + c; const f32x4 x0 = *(const f32x4*)xp, x1 = *(const f32x4*)(xp + 4);
                    const f32x4 o0 = x0 + g0 * acc[ai][bj][m][0], o1 = x1 + g1 * acc[ai][bj][m][1];
                    ss += (o0[0] * o0[0] + o0[1] * o0[1]) + (o0[2] * o0[2] + o0[3] * o0[3]) + (o1[0] * o1[0] + o1[1] * o1[1]) + (o1[2] * o1[2] + o1[3] * o1[3]);
                    float* op = out + (size_t)r * 1024 + c; *(f32x4*)op = o0; *(f32x4*)(op + 4) = o1; }
                ss += __shfl_xor(ss, 16); ss += __shfl_xor(ss, 32);
                if (fq == 0) atomicAdd(rowss + r, ss); }
    }
};

__device__ __forceinline__ void phase_prep(const Args& a, unsigned char* lds, int vcu, int G, int pass) {
    const int tid = opaque_tid(), lane = tid & 63, wave = tid >> 6;
    unsigned char* ws = a.ws;
    bf16* P = (bf16*)(ws + WS_P);
    if (vcu < NB_PASS * 4) {
        const int bl = vcu >> 2, h = vcu & 3;
        const float* IG = (const float*)(ws + WS_IG); const float* FG = (const float*)(ws + WS_FG);
        float* gsc = (float*)(ws + WS_GSC);
        float* A1 = gsc, *B1 = gsc + MS * 4, *WI = gsc + 2 * MS * 4, *EF = gsc + 3 * MS * 4, *WK = gsc + 4 * MS * 4, *DEC = gsc + 5 * MS * 4;
        float* cg = (float*)lds; float* cp = cg + 64;
        float f[8], ii[8];
#pragma unroll
        for (int q = 0; q < 8; ++q) { const size_t grow = (size_t)pass * MS + bl * SEQ + (wave * 8 + q) * 64 + lane; f[q] = FG[grow * 4 + h]; ii[q] = IG[grow * 4 + h]; }
        float acs[8], b1[8], pm[8];
#pragma unroll
        for (int q = 0; q < 8; ++q) {
            float x = fminf(f[q], 0.f) - log1pf(expf(-fabsf(f[q])));
#pragma unroll
            for (int o = 1; o < 64; o <<= 1) { const float t = __shfl_up(x, o); if (lane >= o) x += t; }
            acs[q] = x; b1[q] = ii[q] - x;
            float m = b1[q];
#pragma unroll
            for (int o = 1; o < 64; o <<= 1) { const float t = __shfl_up(m, o); if (lane >= o) m = fmaxf(m, t); }
            pm[q] = m;
            if (lane == 63) { cg[wave * 8 + q] = x; cp[wave * 8 + q] = m; }
        }
        __syncthreads();
        float m_prev = 0.f, mp[8], Ms8[8];
        for (int j = 0; j < 64; ++j) { const float Ms = fmaxf(m_prev, cp[j]);
#pragma unroll
            for (int q = 0; q < 8; ++q) if (j == wave * 8 + q) { mp[q] = m_prev; Ms8[q] = Ms; }
            m_prev = cg[j] + Ms; }
#pragma unroll
        for (int q = 0; q < 8; ++q) {
            const int j = wave * 8 + q, lrow = bl * SEQ + j * 64 + lane;
            const float mx = fmaxf(mp[q], pm[q]);
            A1[lrow * 4 + h] = -mx; B1[lrow * 4 + h] = b1[q]; WI[lrow * 4 + h] = expf(mp[q] - mx); EF[lrow * 4 + h] = expf(-(acs[q] + mx)); WK[lrow * 4 + h] = expf(b1[q] - Ms8[q]);
            if (lane == 0) DEC[(bl * 64 + j) * 4 + h] = expf(mp[q] - Ms8[q]);
        }
    }
    {
        bf16* XC = (bf16*)(ws + WS_XC);
        const int cg8 = (tid & 127) * 8, rq = tid >> 7;
        float wc[4][8], bc[8];
#pragma unroll
        for (int j = 0; j < 4; ++j)
#pragma unroll
            for (int e = 0; e < 8; ++e) wc[j][e] = a.w_conv[j * 1024 + cg8 + e];
#pragma unroll
        for (int e = 0; e < 8; ++e) bc[e] = a.b_conv[cg8 + e];
        for (int it = vcu; it < MS / 32; it += G) {
            const int r0 = it * 32 + rq * 8, t0 = r0 & (SEQ - 1);
            u32x4 w[11];
#pragma unroll
            for (int k = 0; k < 11; ++k) { const int rr = r0 - 3 + k; w[k] = (k >= 3 || t0 >= 3) ? *(const u32x4*)(P + (size_t)rr * INW + C_XA + cg8) : (u32x4){0u, 0u, 0u, 0u}; }
            float xin[11][8];
#pragma unroll
            for (int k = 0; k < 11; ++k) unpack8(w[k], xin[k]);
#pragma unroll
            for (int k = 0; k < 8; ++k) { float o[8];
#pragma unroll
                for (int e = 0; e < 8; ++e) o[e] = siluf_(bc[e] + wc[0][e] * xin[k][e] + wc[1][e] * xin[k + 1][e] + wc[2][e] * xin[k + 2][e] + wc[3][e] * xin[k + 3][e]);
                u32x4 ov; ov.x = pk2(o[0], o[1]); ov.y = pk2(o[2], o[3]); ov.z = pk2(o[4], o[5]); ov.w = pk2(o[6], o[7]);
                *(u32x4*)(XC + (size_t)(r0 + k) * 1024 + cg8) = ov; }
        }
    }
    {
        const float* ROPE = (const float*)(ws + WS_ROPE) + (size_t)pass * MS * 32;
        const int NU = MS * 48;
        for (int u0 = (vcu * NTHR + tid) * 2; u0 < NU; u0 += G * NTHR * 2) {
            u32x4 w1[2], w2[2]; f32x4 cs[2][2], sn[2][2]; bf16* base[2];
#pragma unroll
            for (int q = 0; q < 2; ++q) { const int u = u0 + q, r = u / 48, k = u - r * 48, hd = k >> 1, half = k & 1;
                base[q] = P + (size_t)r * INW + (hd < 12 ? C_QA + hd * 128 : C_KA + (hd - 12) * 128) + 8 * half;
                w1[q] = *(const u32x4*)base[q]; w2[q] = *(const u32x4*)(base[q] + 16);
                const float* tp = ROPE + (size_t)r * 32 + 8 * half;
                cs[q][0] = *(const f32x4*)tp; cs[q][1] = *(const f32x4*)(tp + 4); sn[q][0] = *(const f32x4*)(tp + 16); sn[q][1] = *(const f32x4*)(tp + 20); }
#pragma unroll
            for (int q = 0; q < 2; ++q) { float x1[8], x2[8], o1[8], o2[8]; unpack8(w1[q], x1); unpack8(w2[q], x2);
#pragma unroll
                for (int e = 0; e < 8; ++e) { const float c_ = cs[q][e >> 2][e & 3], s_ = sn[q][e >> 2][e & 3]; o1[e] = x1[e] * c_ - x2[e] * s_; o2[e] = x2[e] * c_ + x1[e] * s_; }
                u32x4 v1, v2; v1.x = pk2(o1[0], o1[1]); v1.y = pk2(o1[2], o1[3]); v1.z = pk2(o1[4], o1[5]); v1.w = pk2(o1[6], o1[7]);
                v2.x = pk2(o2[0], o2[1]); v2.y = pk2(o2[2], o2[3]); v2.z = pk2(o2[4], o2[5]); v2.w = pk2(o2[6], o2[7]);
                *(u32x4*)base[q] = v1; *(u32x4*)(base[q] + 16) = v2; }
        }
    }
}

__device__ __forceinline__ f32x4 mfma16(bf16x8 a, bf16x8 b, f32x4 c) { return __builtin_amdgcn_mfma_f32_16x16x32_bf16(a, b, c, 0, 0, 0); }

constexpr int TPS = 72;
__device__ __forceinline__ void phase_cprep(const Args& a, unsigned char* lds, int vcu, int G) {
    const int tid = opaque_tid(), lane = tid & 63, wave = __builtin_amdgcn_readfirstlane(tid >> 6);
    const int fr = lane & 15, fq = lane >> 4;
    unsigned char* ws = a.ws;
    const bf16* P = (const bf16*)(ws + WS_P); const bf16* QM = (const bf16*)(ws + WS_QM); const bf16* KM = (const bf16*)(ws + WS_KM);
    const float* gsc = (const float*)(ws + WS_GSC);
    const float* gA1 = gsc, *gB1 = gsc + MS * 4, *gWK = gsc + 4 * MS * 4;
    bf16* SG = (bf16*)(ws + WS_SG); bf16* KTG = (bf16*)(ws + WS_KTG); bf16* VTG = (bf16*)(ws + WS_VTG);
    bf16* KT = (bf16*)lds; bf16* VT = (bf16*)(lds + 256 * TPS * 2);
    bf16* sp = (bf16*)(lds + 2 * 256 * TPS * 2) + wave * 16 * 40;
    const int ti = wave >> 1, tj0 = 2 * (wave & 1);
    for (int ci = vcu; ci < (MS / 64) * 4; ci += G) {
        const int h = ci & 3, t0 = (ci >> 2) * 64;
        bf16x8 qf[8], kf[2][8]; float a1l[4], b1s[2];
#pragma unroll
        for (int ks = 0; ks < 8; ++ks) qf[ks] = *(const bf16x8*)(QM + (size_t)(t0 + 16 * ti + fr) * 1024 + h * 256 + 32 * ks + 8 * fq);
#pragma unroll
        for (int tt = 0; tt < 2; ++tt) {
            if (tj0 + tt <= ti) {
#pragma unroll
                for (int ks = 0; ks < 8; ++ks) kf[tt][ks] = *(const bf16x8*)(KM + (size_t)(t0 + 16 * (tj0 + tt) + fr) * 1024 + h * 256 + 32 * ks + 8 * fq);
            }
            b1s[tt] = gB1[(t0 + 16 * (tj0 + tt) + fr) * 4 + h];
        }
#pragma unroll
        for (int i = 0; i < 4; ++i) a1l[i] = gA1[(t0 + 16 * ti + 4 * fq + i) * 4 + h];
        u32x4 kw[4], vw[4]; float wk[4];
#pragma unroll
        for (int i = 0; i < 4; ++i) { const int c = tid + NTHR * i, l = c & 63, dc = c >> 6;
            kw[i] = *(const u32x4*)(KM + (size_t)(t0 + l) * 1024 + h * 256 + 8 * dc); vw[i] = *(const u32x4*)(P + (size_t)(t0 + l) * INW + C_VA + h * 256 + 8 * dc); wk[i] = gWK[(t0 + l) * 4 + h]; }
        __syncthreads();
#pragma unroll
        for (int i = 0; i < 4; ++i) { const int c = tid + NTHR * i, l = c & 63, dc = c >> 6;
            float kv[8]; unpack8(kw[i], kv);
            bf16* d = KT + (8 * dc) * TPS + l;
#pragma unroll
            for (int e = 0; e < 8; ++e) d[e * TPS] = (bf16)f2bf(kv[e] * wk[i]);
            const u32x4 w = vw[i]; bf16* dv = VT + (8 * dc) * TPS + l;
            dv[0 * TPS] = (bf16)(w.x & 0xffff); dv[1 * TPS] = (bf16)(w.x >> 16); dv[2 * TPS] = (bf16)(w.y & 0xffff); dv[3 * TPS] = (bf16)(w.y >> 16);
            dv[4 * TPS] = (bf16)(w.z & 0xffff); dv[5 * TPS] = (bf16)(w.z >> 16); dv[6 * TPS] = (bf16)(w.w & 0xffff); dv[7 * TPS] = (bf16)(w.w >> 16); }
#pragma unroll
        for (int tt = 0; tt < 2; ++tt) {
            const int tj = tj0 + tt;
            f32x4 sacc = {0.f, 0.f, 0.f, 0.f};
            if (tj <= ti) {
#pragma unroll
                for (int ks = 0; ks < 8; ++ks) sacc = mfma16(qf[ks], kf[tt][ks], sacc);
            }
            const int sidx = 16 * tj + fr;
#pragma unroll
            for (int i = 0; i < 4; ++i) { const int l = 16 * ti + 4 * fq + i;
                float v = 0.f;
                if (sidx <= l) v = sacc[i] * __expf(a1l[i] + b1s[tt]);
                sp[(4 * fq + i) * 40 + 16 * tt + fr] = (bf16)f2bf(v); }
        }
        { const int row = lane >> 2, ch = lane & 3;
          *(u32x4*)(SG + (size_t)ci * 4096 + (16 * ti + row) * 64 + 16 * tj0 + 8 * ch) = *(const u32x4*)(sp + row * 40 + 8 * ch); }
        __syncthreads();
#pragma unroll
        for (int i = 0; i < 4; ++i) { const int c = tid + NTHR * i, row = c >> 3, ch = c & 7;
            *(u32x4*)(KTG + (size_t)ci * 16384 + row * 64 + 8 * ch) = *(const u32x4*)(KT + row * TPS + 8 * ch);
            *(u32x4*)(VTG + (size_t)ci * 16384 + row * 64 + 8 * ch) = *(const u32x4*)(VT + row * TPS + 8 * ch); }
    }
}

constexpr int SA_DEPTH = 5, SA_PATCH = 32 * 32 * 2 + 128;
struct ScanA { const bf16* KTG; const bf16* VTG; const float* gDEC; bf16* CS; float* NS; int bl, h, dblk, eblk, wave, fr, fq; unsigned koff, voff; bool do_den; };
struct ScanAOps { bf16x8 k[2][2], v[2][2]; float decay; };
__device__ __forceinline__ void scana_load(const ScanA& c, int j, ScanAOps& o) {
    const int ci = (c.bl * 64 + j) * 4 + c.h;
    const bf16* kb = c.KTG + (size_t)ci * 16384; const bf16* vb = c.VTG + (size_t)ci * 16384;
#pragma unroll
    for (int dt = 0; dt < 2; ++dt)
#pragma unroll
        for (int k2 = 0; k2 < 2; ++k2) o.k[dt][k2] = *(const bf16x8*)(kb + (c.koff + (unsigned)(dt * 1024 + k2 * 32)));
#pragma unroll
    for (int et = 0; et < 2; ++et)
#pragma unroll
        for (int k2 = 0; k2 < 2; ++k2) o.v[et][k2] = *(const bf16x8*)(vb + (c.voff + (unsigned)(et * 1024 + k2 * 32)));
    o.decay = c.gDEC[(c.bl * 64 + j) * 4 + c.h];
}
__device__ __forceinline__ void scana_step(const ScanA& c, unsigned char* lds, int j, f32x4 (&Cacc)[2][2], f32x4 (&Nacc)[2], const ScanAOps& o, const bf16x8 ones) {
    const int ci = (c.bl * 64 + j) * 4 + c.h;
    unsigned char* patch = lds + c.wave * SA_PATCH;
    const int lane = c.fq * 16 + c.fr;
#pragma unroll
    for (int dt = 0; dt < 2; ++dt) {
#pragma unroll
        for (int et = 0; et < 2; ++et) { const f32x4 cc = Cacc[dt][et]; u32x2 w; w.x = pk2(cc[0], cc[1]); w.y = pk2(cc[2], cc[3]);
            *(u32x2*)(patch + (16 * et + c.fr) * 64 + (16 * dt + 4 * c.fq) * 2) = w; }
        if (c.do_den && c.fr == 0) *(f32x4*)(patch + 2048 + (16 * dt + 4 * c.fq) * 4) = Nacc[dt];
    }
    { bf16* cs = c.CS + (size_t)ci * 65536 + (c.eblk * 8 + c.dblk) * 1024;
#pragma unroll
      for (int k = 0; k < 2; ++k) *(u32x4*)(cs + k * 512 + lane * 8) = *(const u32x4*)(patch + k * 1024 + lane * 16);
      if (c.do_den && lane < 8) *(f32x4*)(c.NS + (size_t)ci * 256 + c.dblk * 32 + lane * 4) = *(const f32x4*)(patch + 2048 + lane * 16); }
#pragma unroll
    for (int dt = 0; dt < 2; ++dt) {
#pragma unroll
        for (int et = 0; et < 2; ++et) {
            f32x4 cc = Cacc[dt][et] * o.decay;
#pragma unroll
            for (int k2 = 0; k2 < 2; ++k2) cc = mfma16(o.k[dt][k2], o.v[et][k2], cc);
            Cacc[dt][et] = cc;
        }
        if (c.do_den) {
            f32x4 cc = Nacc[dt] * o.decay;
#pragma unroll
            for (int k2 = 0; k2 < 2; ++k2) cc = mfma16(o.k[dt][k2], ones, cc);
            Nacc[dt] = cc;
        }
    }
}
__device__ __forceinline__ void scana_item(const Args& a, unsigned char* lds, int item) {
    const int tid = opaque_tid(), lane = tid & 63;
    unsigned char* ws = a.ws;
    ScanA c;
    c.wave = __builtin_amdgcn_readfirstlane(tid >> 6); c.fr = lane & 15; c.fq = lane >> 4;
    item = __builtin_amdgcn_readfirstlane(item);
    c.bl = item >> 5; c.h = (item >> 3) & 3; c.dblk = 2 * ((item >> 1) & 3) + (c.wave >> 2); c.eblk = 4 * (item & 1) + (c.wave & 3); c.do_den = (c.eblk == 0);
    c.koff = (unsigned)((32 * c.dblk + c.fr) * 64 + 8 * c.fq); c.voff = (unsigned)((32 * c.eblk + c.fr) * 64 + 8 * c.fq);
    c.KTG = (const bf16*)(ws + WS_KTG); c.VTG = (const bf16*)(ws + WS_VTG); c.gDEC = (const float*)(ws + WS_GSC) + 5 * MS * 4;
    c.CS = (bf16*)(ws + WS_CS); c.NS = (float*)(ws + WS_NS);
    f32x4 Cacc[2][2], Nacc[2];
#pragma unroll
    for (int x = 0; x < 2; ++x) { Nacc[x] = (f32x4){0.f, 0.f, 0.f, 0.f};
#pragma unroll
        for (int y = 0; y < 2; ++y) Cacc[x][y] = (f32x4){0.f, 0.f, 0.f, 0.f}; }
    bf16x8 ones;
    { const short ov = (c.fr == 0) ? (short)0x3F80 : (short)0;
#pragma unroll
      for (int e = 0; e < 8; ++e) ones[e] = ov; }
    ScanAOps o0, o1, o2, o3, o4;
    scana_load(c, 0, o0); scana_load(c, 1, o1); scana_load(c, 2, o2); scana_load(c, 3, o3); scana_load(c, 4, o4);
#define SA_STEP(jj, ob) do { scana_step(c, lds, (jj), Cacc, Nacc, ob, ones); __builtin_amdgcn_sched_barrier(0); scana_load(c, (jj) + SA_DEPTH < 64 ? (jj) + SA_DEPTH : 63, ob); __builtin_amdgcn_sched_barrier(0); } while (0)
#pragma nounroll
    for (int j = 0; j < 60; j += 5) { SA_STEP(j, o0); SA_STEP(j + 1, o1); SA_STEP(j + 2, o2); SA_STEP(j + 3, o3); SA_STEP(j + 4, o4); }
    SA_STEP(60, o0); SA_STEP(61, o1); SA_STEP(62, o2); SA_STEP(63, o3);
#undef SA_STEP
    asm volatile("s_waitcnt vmcnt(0)" ::: "memory");
}

constexpr int AKS = 136;
constexpr int L_AK = 0, L_AV = L_AK + 128 * AKS * 2, L_AP = L_AV + 128 * AKS * 2, L_ATT_END = L_AP + 8 * 16 * AKS * 2;
static_assert(L_ATT_END <= 131072, "attn lds");

__device__ __forceinline__ void attn_item(const Args& a, unsigned char* lds, int item) {
    const int tid = opaque_tid(), lane = tid & 63, wave = __builtin_amdgcn_readfirstlane(tid >> 6);
    const int fr = lane & 15, fq = lane >> 4;
    unsigned char* ws = a.ws;
    const int blk = item & 31, hh = (item >> 5) & 3, bl = (item >> 7) & 3, g = item >> 9;
    const int dil = g == 0 ? 1 : g == 1 ? 4 : 16, nb = 32 / dil;
    const int r = blk / nb, n = blk % nb;
    const bf16* P = (const bf16*)(ws + WS_P);
    const int H = 4 * g + hh;
    const bf16* Qb = P + C_QA + H * 128; const bf16* Kb = P + C_KA + H * 128; const bf16* Vb = P + C_VT + H * 128;
    bf16* Ks = (bf16*)(lds + L_AK); bf16* VTs = (bf16*)(lds + L_AV); bf16* Pw = (bf16*)(lds + L_AP) + wave * 16 * AKS;
    const int rowbase = bl * SEQ + r;
    bf16x8 qf[4];
    { const size_t qrow = (size_t)(rowbase + (128 * n + 16 * wave + fr) * dil);
#pragma unroll
      for (int ks = 0; ks < 4; ++ks) qf[ks] = *(const bf16x8*)(Qb + qrow * INW + 32 * ks + 8 * fq); }
    f32x4 O[8];
#pragma unroll
    for (int i = 0; i < 8; ++i) O[i] = (f32x4){0.f, 0.f, 0.f, 0.f};
    float mrow[4], lrow[4];
#pragma unroll
    for (int i = 0; i < 4; ++i) { mrow[i] = -INFINITY; lrow[i] = 0.f; }
    const float scale = 0.08838834764831845f;
    for (int half = (n == 0 ? 1 : 0); half < 2; ++half) {
        const int ku0 = 128 * (n - 1 + half);
        __syncthreads();
#pragma unroll
        for (int i = 0; i < 4; ++i) { const int c = tid + NTHR * i, key = c & 127, dc = c >> 7;
            const size_t krow = (size_t)(rowbase + (ku0 + key) * dil);
            const u32x4 kw = *(const u32x4*)(Kb + krow * INW + 8 * dc);
            *(u32x4*)(Ks + key * AKS + 8 * dc) = kw;
            const u32x4 w = *(const u32x4*)(Vb + krow * INW + 8 * dc);
            bf16* d = VTs + (8 * dc) * AKS + key;
            d[0 * AKS] = (bf16)(w.x & 0xffff); d[1 * AKS] = (bf16)(w.x >> 16); d[2 * AKS] = (bf16)(w.y & 0xffff); d[3 * AKS] = (bf16)(w.y >> 16);
            d[4 * AKS] = (bf16)(w.z & 0xffff); d[5 * AKS] = (bf16)(w.z >> 16); d[6 * AKS] = (bf16)(w.w & 0xffff); d[7 * AKS] = (bf16)(w.w >> 16); }
        __syncthreads();
        f32x4 S[8];
#pragma unroll
        for (int kt = 0; kt < 8; ++kt) { f32x4 s = {0.f, 0.f, 0.f, 0.f};
#pragma unroll
            for (int ks = 0; ks < 4; ++ks) { const bf16x8 kf = *(const bf16x8*)(Ks + (16 * kt + fr) * AKS + 32 * ks + 8 * fq); s = mfma16(qf[ks], kf, s); }
            S[kt] = s; }
        float mx[4];
#pragma unroll
        for (int i = 0; i < 4; ++i) mx[i] = -INFINITY;
#pragma unroll
        for (int kt = 0; kt < 8; ++kt)
#pragma unroll
            for (int i = 0; i < 4; ++i) { const int p = 16 * wave + 4 * fq + i, kk = 16 * kt + fr;
                const bool ok = half == 0 ? (kk >= p) : (kk <= p);
                const float v = ok ? S[kt][i] * scale : -INFINITY; S[kt][i] = v; mx[i] = fmaxf(mx[i], v); }
        float alpha[4], rs[4];
#pragma unroll
        for (int i = 0; i < 4; ++i) { float m = mx[i]; m = fmaxf(m, __shfl_xor(m, 1)); m = fmaxf(m, __shfl_xor(m, 2)); m = fmaxf(m, __shfl_xor(m, 4)); m = fmaxf(m, __shfl_xor(m, 8));
            const float mn = fmaxf(mrow[i], m); alpha[i] = __expf(mrow[i] - mn); mrow[i] = mn; rs[i] = 0.f; }
#pragma unroll
        for (int kt = 0; kt < 8; ++kt)
#pragma unroll
            for (int i = 0; i < 4; ++i) { const float p = __expf(S[kt][i] - mrow[i]); rs[i] += p; Pw[(4 * fq + i) * AKS + 16 * kt + fr] = (bf16)f2bf(p); }
#pragma unroll
        for (int i = 0; i < 4; ++i) { float s = rs[i]; s += __shfl_xor(s, 1); s += __shfl_xor(s, 2); s += __shfl_xor(s, 4); s += __shfl_xor(s, 8); lrow[i] = lrow[i] * alpha[i] + s; }
#pragma unroll
        for (int dtile = 0; dtile < 8; ++dtile)
#pragma unroll
            for (int i = 0; i < 4; ++i) O[dtile][i] *= alpha[i];
        __builtin_amdgcn_wave_barrier();
        asm volatile("s_waitcnt lgkmcnt(0)" ::: "memory");
#pragma unroll
        for (int ks = 0; ks < 4; ++ks) { const bf16x8 pa = *(const bf16x8*)(Pw + fr * AKS + 32 * ks + 8 * fq);
#pragma unroll
            for (int dtile = 0; dtile < 8; ++dtile) { const bf16x8 vb = *(const bf16x8*)(VTs + (16 * dtile + fr) * AKS + 32 * ks + 8 * fq); O[dtile] = mfma16(pa, vb, O[dtile]); } }
    }
    bf16* AO = (bf16*)(ws + WS_AO) + (size_t)g * MS * 512; float* LSE = (float*)(ws + WS_LSE) + (size_t)g * MS * 4;
#pragma unroll
    for (int i = 0; i < 4; ++i) { const size_t row = (size_t)(rowbase + (128 * n + 16 * wave + 4 * fq + i) * dil); const float inv = 1.f / lrow[i];
#pragma unroll
        for (int dtile = 0; dtile < 8; ++dtile) AO[row * 512 + hh * 128 + 16 * dtile + fr] = (bf16)f2bf(O[dtile][i] * inv);
        if (fr == 0) LSE[row * 4 + hh] = mrow[i] + logf(lrow[i]); }
    __syncthreads();
}

constexpr int N_SCAN_ITEMS = NB_PASS * 32, N_ATT_ITEMS = 3 * NB_PASS * 4 * 32;
#ifndef PROBE_ATT_REP
#define PROBE_ATT_REP 1
#endif
struct XcdBarrier;
__device__ __forceinline__ void xcd_barrier(const XcdBarrier& b);
__device__ __forceinline__ void phase_mix(const Args& a, unsigned char* lds, int pass, const XcdBarrier* pbar) {
    unsigned* qctr = (unsigned*)(a.ws + WS_CTL) + CW_QCTR + 64 * pass;
    volatile int* slot = (volatile int*)(lds + 131072 + 1024);
#ifdef PROBE_SPLIT
    for (int it = blockIdx.x; it < N_SCAN_ITEMS; it += gridDim.x) scana_item(a, lds, it);
    xcd_barrier(*pbar);
    for (int rep = 0; rep < PROBE_ATT_REP; ++rep)
    for (int it = blockIdx.x; it < N_ATT_ITEMS; it += gridDim.x) attn_item(a, lds, it);
#else
    for (;;) {
        __syncthreads();
        if (opaque_tid() == 0) *slot = (int)atomicAdd(qctr, 1u);
        __syncthreads();
        const int item = *slot;
        if (item >= N_SCAN_ITEMS + N_ATT_ITEMS) break;
        if (item < N_SCAN_ITEMS) scana_item(a, lds, item); else attn_item(a, lds, item - N_SCAN_ITEMS);
    }
#endif
}

constexpr int QS_STRIDE = 264, SS_STRIDE = 72;
constexpr int L_QS = 0, L_SS = L_QS + 64 * QS_STRIDE * 2, L_DENL = L_SS + 64 * SS_STRIDE * 2, L_SB_END = L_DENL + 256;
static_assert(L_SB_END <= 131072, "scan-B lds");
__device__ __forceinline__ void scanb_item(const Args& a, unsigned char* lds, int ch) {
    const int tid = opaque_tid(), lane = tid & 63, wave = __builtin_amdgcn_readfirstlane(tid >> 6), fr = lane & 15, fq = lane >> 4;
    unsigned char* ws = a.ws;
    const int h = ch & 3, t0 = (ch >> 2) * 64;
    const bf16* P = (const bf16*)(ws + WS_P); const bf16* XC = (const bf16*)(ws + WS_XC); const bf16* QM = (const bf16*)(ws + WS_QM);
    const bf16* SG = (const bf16*)(ws + WS_SG); const bf16* VTG = (const bf16*)(ws + WS_VTG); const bf16* CS = (const bf16*)(ws + WS_CS); const float* NS = (const float*)(ws + WS_NS);
    const float* gWI = (const float*)(ws + WS_GSC) + 2 * MS * 4; const float* gEF = (const float*)(ws + WS_GSC) + 3 * MS * 4;
    bf16* UM = (bf16*)(ws + WS_HR);
    bf16* QS = (bf16*)(lds + L_QS); bf16* SS = (bf16*)(lds + L_SS); float* DENL = (float*)(lds + L_DENL);
    __syncthreads();
#pragma unroll
    for (int i = 0; i < 4; ++i) { const int c = tid + NTHR * i, row = c >> 5, cc = c & 31;
        *(u32x4*)(QS + row * QS_STRIDE + 8 * cc) = *(const u32x4*)(QM + (size_t)(t0 + row) * 1024 + h * 256 + 8 * cc); }
    { const int row = tid >> 3, cc = tid & 7; *(u32x4*)(SS + row * SS_STRIDE + 8 * cc) = *(const u32x4*)(SG + (size_t)ch * 4096 + row * 64 + 8 * cc); }
    bf16x8 cb[2][8], vt[2][2];
#pragma unroll
    for (int t = 0; t < 2; ++t) {
#pragma unroll
        for (int ks = 0; ks < 8; ++ks) cb[t][ks] = *(const bf16x8*)(CS + (size_t)ch * 65536 + (wave * 8 + ks) * 1024 + (16 * t + fr) * 32 + 8 * fq);
#pragma unroll
        for (int k2 = 0; k2 < 2; ++k2) vt[t][k2] = *(const bf16x8*)(VTG + (size_t)ch * 16384 + (32 * wave + 16 * t + fr) * 64 + 32 * k2 + 8 * fq);
    }
    float wi[4][4];
#pragma unroll
    for (int lt = 0; lt < 4; ++lt)
#pragma unroll
        for (int i = 0; i < 4; ++i) wi[lt][i] = gWI[(t0 + 16 * lt + 4 * fq + i) * 4 + h];
    __syncthreads();
    f32x4 num[4][2];
#pragma unroll
    for (int lt = 0; lt < 4; ++lt) {
        bf16x8 qf[8], sf[2];
#pragma unroll
        for (int ks = 0; ks < 8; ++ks) qf[ks] = *(const bf16x8*)(QS + (16 * lt + fr) * QS_STRIDE + 32 * ks + 8 * fq);
#pragma unroll
        for (int k2 = 0; k2 < 2; ++k2) sf[k2] = *(const bf16x8*)(SS + (16 * lt + fr) * SS_STRIDE + 32 * k2 + 8 * fq);
#pragma unroll
        for (int t = 0; t < 2; ++t) {
            f32x4 a1 = {0.f, 0.f, 0.f, 0.f}, a2 = {0.f, 0.f, 0.f, 0.f}, a3 = {0.f, 0.f, 0.f, 0.f};
#pragma unroll
            for (int k2 = 0; k2 < 2; ++k2) a1 = mfma16(sf[k2], vt[t][k2], a1);
#pragma unroll
            for (int ks = 0; ks < 8; ks += 2) { a2 = mfma16(qf[ks], cb[t][ks], a2); a3 = mfma16(qf[ks + 1], cb[t][ks + 1], a3); }
#pragma unroll
            for (int i = 0; i < 4; ++i) num[lt][t][i] = a1[i] + wi[lt][i] * (a2[i] + a3[i]);
        }
    }
    if (wave == 0) {
        bf16x8 nb[8], ones;
        { const short ov = (fr == 0) ? (short)0x3F80 : (short)0;
#pragma unroll
          for (int e = 0; e < 8; ++e) ones[e] = ov; }
#pragma unroll
        for (int ks = 0; ks < 8; ++ks) { const f32x4 n0 = *(const f32x4*)(NS + (size_t)ch * 256 + 32 * ks + 8 * fq), n1 = *(const f32x4*)(NS + (size_t)ch * 256 + 32 * ks + 8 * fq + 4);
            u32x4 w; w.x = pk2(n0[0], n0[1]); w.y = pk2(n0[2], n0[3]); w.z = pk2(n1[0], n1[1]); w.w = pk2(n1[2], n1[3]);
            if (fr != 0) w = (u32x4){0u, 0u, 0u, 0u};
            nb[ks] = __builtin_bit_cast(bf16x8, w); }
#pragma unroll
        for (int lt = 0; lt < 4; ++lt) {
            f32x4 a1 = {0.f, 0.f, 0.f, 0.f}, a2 = {0.f, 0.f, 0.f, 0.f};
#pragma unroll
            for (int k2 = 0; k2 < 2; ++k2) { const bf16x8 sf = *(const bf16x8*)(SS + (16 * lt + fr) * SS_STRIDE + 32 * k2 + 8 * fq); a1 = mfma16(sf, ones, a1); }
#pragma unroll
            for (int ks = 0; ks < 8; ++ks) { const bf16x8 qf = *(const bf16x8*)(QS + (16 * lt + fr) * QS_STRIDE + 32 * ks + 8 * fq); a2 = mfma16(qf, nb[ks], a2); }
            if (fr == 0) {
#pragma unroll
                for (int i = 0; i < 4; ++i) { const int l = 16 * lt + 4 * fq + i; const float den = a1[i] + wi[lt][i] * a2[i]; DENL[l] = 1.f / fmaxf(fabsf(den), gEF[(t0 + l) * 4 + h]); } }
        }
    }
    __syncthreads();
#pragma unroll
    for (int lt = 0; lt < 4; ++lt)
#pragma unroll
        for (int t = 0; t < 2; ++t)
#pragma unroll
            for (int i = 0; i < 4; ++i) QS[(16 * lt + 4 * fq + i) * QS_STRIDE + 32 * wave + 16 * t + fr] = (bf16)f2bf(num[lt][t][i]);
    __syncthreads();
    const int c = h * 256 + 4 * lane;
    const f32x4 gh = *(const f32x4*)(a.g_head + c), sk = *(const f32x4*)(a.skip + c);
#pragma unroll 2
    for (int rr = 0; rr < 8; ++rr) {
        const int l = 8 * wave + rr; const size_t r = (size_t)(t0 + l);
        const u32x2 hw = *(const u32x2*)(QS + l * QS_STRIDE + 4 * lane);
        const u32x2 ow = *(const u32x2*)(P + r * INW + C_OA + c), zw = *(const u32x2*)(P + r * INW + C_ZA + c), xw = *(const u32x2*)(XC + r * 1024 + c);
        const float rd = DENL[l];
        float hm[4] = {sigmoidf_(bflo(ow.x)) * bflo(hw.x) * rd, sigmoidf_(bfhi(ow.x)) * bfhi(hw.x) * rd, sigmoidf_(bflo(ow.y)) * bflo(hw.y) * rd, sigmoidf_(bfhi(ow.y)) * bfhi(hw.y) * rd};
        float ss = (hm[0] * hm[0] + hm[1] * hm[1]) + (hm[2] * hm[2] + hm[3] * hm[3]);
        ss = wave_sum(ss);
        const float rinv = 1.f / sqrtf(ss * (1.f / 256.f) + EPS);
        const float xc[4] = {bflo(xw.x), bfhi(xw.x), bflo(xw.y), bfhi(xw.y)}, za[4] = {bflo(zw.x), bfhi(zw.x), bflo(zw.y), bfhi(zw.y)};
        float o[4];
#pragma unroll
        for (int e = 0; e < 4; ++e) o[e] = (hm[e] * rinv * gh[e] + sk[e] * xc[e]) * siluf_(za[e]);
        u32x2 ov; ov.x = pk2(o[0], o[1]); ov.y = pk2(o[2], o[3]);
        *(u32x2*)(UM + r * 1024 + c) = ov;
    }
}

__device__ __forceinline__ void phase_post(const Args& a, unsigned char* lds, int vcu, int G) {
    for (int ch = vcu; ch < (MS / 64) * 4; ch += G) scanb_item(a, lds, ch);
    const int tid = opaque_tid(), lane = tid & 63, wave = tid >> 6;
    unsigned char* ws = a.ws;
    const bf16* P = (const bf16*)(ws + WS_P);
    const bf16* AO = (const bf16*)(ws + WS_AO); const float* LSE = (const float*)(ws + WS_LSE); bf16* UA = (bf16*)(ws + WS_UA);
    const int hh = lane >> 4, c = hh * 128 + 8 * (lane & 15);
    for (int r0 = 2 * (vcu * NWAVES + wave); r0 < MS; r0 += 2 * G * NWAVES) {
        u32x4 o0[2], o1[2], o2[2], zb[2]; float l0[2], l1[2], l2[2];
#pragma unroll
        for (int q = 0; q < 2; ++q) { const size_t r = (size_t)(r0 + q);
            o0[q] = *(const u32x4*)(AO + r * 512 + c); o1[q] = *(const u32x4*)(AO + ((size_t)MS + r) * 512 + c); o2[q] = *(const u32x4*)(AO + ((size_t)2 * MS + r) * 512 + c);
            zb[q] = *(const u32x4*)(P + r * INW + C_ZB + c);
            l0[q] = LSE[r * 4 + hh]; l1[q] = LSE[((size_t)MS + r) * 4 + hh]; l2[q] = LSE[((size_t)2 * MS + r) * 4 + hh]; }
#pragma unroll
        for (int q = 0; q < 2; ++q) {
            const float mx = fmaxf(l0[q], fmaxf(l1[q], l2[q]));
            float w0 = __expf(l0[q] - mx), w1 = __expf(l1[q] - mx), w2 = __expf(l2[q] - mx); const float inv = 1.f / (w0 + w1 + w2); w0 *= inv; w1 *= inv; w2 *= inv;
            float f0[8], f1[8], f2[8], z[8], o[8]; unpack8(o0[q], f0); unpack8(o1[q], f1); unpack8(o2[q], f2); unpack8(zb[q], z);
#pragma unroll
            for (int e = 0; e < 8; ++e) o[e] = (w0 * f0[e] + w1 * f1[e] + w2 * f2[e]) * siluf_(z[e]);
            u32x4 ov; ov.x = pk2(o[0], o[1]); ov.y = pk2(o[2], o[3]); ov.z = pk2(o[4], o[5]); ov.w = pk2(o[6], o[7]);
            *(u32x4*)(UA + (size_t)(r0 + q) * 512 + c) = ov;
        }
    }
}

__device__ __forceinline__ void phase_norm(const Args& a, int vcu, int G) {
    const int tid = opaque_tid(), lane = tid & 63, wave = tid >> 6;
    const float* rowss = (const float*)(a.ws + WS_CTL) + CW_ROWSS;
    for (int r = vcu * NWAVES + wave; r < MALL; r += G * NWAVES) {
        const float rinv = 1.f / sqrtf(rowss[r] * (1.f / DM) + EPS);
        f32x4* o = (f32x4*)(a.out + (size_t)r * DM) + lane;
#pragma unroll
        for (int j = 0; j < 4; ++j) { const f32x4 gf = *((const f32x4*)a.g_final + lane + 64 * j); o[64 * j] = o[64 * j] * rinv * gf; }
    }
}


#define LAS __attribute__((address_space(3)))
#define XB_TMO      128
#define XB_XCNT(j)  (256  + 64 * (j))
#define XB_XSUB(j)  (1280 + 64 * (j))
#define XB_XGEN(j)  (2304 + 64 * (j))
#define XB_TOP      3328
#define XB_TOPGEN   3392
#define XCD_BAR_WORDS 3456
#define XB_SPIN_CAP (1u << 22)
constexpr int CW_BAR = 4096;
__device__ __forceinline__ unsigned xb_ld(unsigned* p)              { return __hip_atomic_load(p, __ATOMIC_RELAXED, __HIP_MEMORY_SCOPE_AGENT); }
__device__ __forceinline__ unsigned xb_add(unsigned* p, unsigned v) { return __hip_atomic_fetch_add(p, v, __ATOMIC_RELAXED, __HIP_MEMORY_SCOPE_AGENT); }
__device__ __forceinline__ unsigned xb_xcc_id() { return (unsigned)__builtin_amdgcn_s_getreg((3 << 11) | 20) & 0xFu; }
#define XB_SPIN(cond, bar) do { unsigned _sp = 0; while (cond) { __builtin_amdgcn_s_sleep(1); \
    if ((++_sp & 255u) == 0u) { if (xb_ld(&(bar)[XB_TMO])) break; if (_sp > XB_SPIN_CAP) { atomicAdd(&(bar)[XB_TMO], 1u); break; } } } } while (0)
struct XcdBarrier { unsigned* bar; unsigned x; volatile LAS unsigned* st; };
__device__ __forceinline__ XcdBarrier xcd_barrier_post(unsigned* bar, volatile LAS unsigned* st) {
    XcdBarrier b; b.bar = bar; b.x = xb_xcc_id(); b.st = st;
    if (threadIdx.x == 0) (void)xb_add(&bar[XB_XCNT(b.x)], 1u);
    return b;
}
__device__ __forceinline__ void xcd_barrier_complete(unsigned* bar, unsigned x, unsigned& nloc, unsigned& nx) {
    const unsigned G = gridDim.x * gridDim.y * gridDim.z;
    unsigned sum, cnt, mine, sp = 0u;
    for (;;) {
        sum = 0u; cnt = 0u; mine = 0u;
#pragma unroll
        for (unsigned j = 0; j < 16; ++j) { const unsigned c = xb_ld(&bar[XB_XCNT(j)]); sum += c; cnt += (c > 0u) ? 1u : 0u; mine = (j == x) ? c : mine; }
        if (sum == G) break;
        __builtin_amdgcn_s_sleep(1);
        if ((++sp & 255u) == 0u) { if (xb_ld(&bar[XB_TMO])) break; if (sp > XB_SPIN_CAP) { atomicAdd(&bar[XB_TMO], 1u); break; } }
    }
    nloc = mine > 0u ? mine : 1u; nx = cnt > 0u ? cnt : 1u;
}
__device__ __forceinline__ void xcd_barrier(const XcdBarrier& b) {
    asm volatile("s_waitcnt vmcnt(0)" ::: "memory");
    __syncthreads();
    if (threadIdx.x == 0) {
        unsigned* bar = b.bar;
        __builtin_amdgcn_s_waitcnt(0);
        unsigned nloc = b.st[0], nx = b.st[1];
        if (nloc == 0u) { xcd_barrier_complete(bar, b.x, nloc, nx); b.st[0] = nloc; b.st[1] = nx; }
        const unsigned old = xb_add(&bar[XB_XSUB(b.x)], 1u);
        const unsigned gen = old / nloc;
        if (old + 1u == (gen + 1u) * nloc) {
            __builtin_amdgcn_fence(__ATOMIC_RELEASE, "agent");
            asm volatile("s_waitcnt vmcnt(0)" ::: "memory");
            const unsigned og = xb_add(&bar[XB_TOP], 1u);
            const unsigned tg = og / nx;
            if (og + 1u == (tg + 1u) * nx) xb_add(&bar[XB_TOPGEN], 1u);
            else XB_SPIN(xb_ld(&bar[XB_TOPGEN]) == tg, bar);
            __builtin_amdgcn_fence(__ATOMIC_ACQUIRE, "agent");
            xb_add(&bar[XB_XGEN(b.x)], 1u);
            asm volatile("s_waitcnt vmcnt(0)" ::: "memory");
        } else {
            XB_SPIN(xb_ld(&bar[XB_XGEN(b.x)]) == gen, bar);
            __builtin_amdgcn_fence(__ATOMIC_ACQUIRE, "agent");
            asm volatile("s_waitcnt vmcnt(0)" ::: "memory");
        }
    }
    __syncthreads();
}

constexpr int PH_PER_PASS = 8, PH_TOTAL = 2 + PH_PER_PASS * NPASS + 1;
#define PROBE_KIND_OF(k) ((k) == 0 ? K_INPROJ : (k) == 1 ? K_PREP : (k) == 2 ? K_QK : (k) == 3 ? K_CPREP : (k) == 4 ? K_MIX : (k) == 5 ? K_POST : (k) == 6 ? K_OUT1 : K_OUT2)
enum { K_PROLOGUE = 0, K_H = 1, K_INPROJ = 2, K_PREP = 3, K_QK = 4, K_MIX = 5, K_POST = 6, K_OUT1 = 7, K_OUT2 = 8, K_NORM = 9, K_CPREP = 10 };

template <int KIND>
__device__ __forceinline__ void run_phase(const Args& args, unsigned char* lds, int pass, const XcdBarrier* pbar = nullptr) {
    const int G = gridDim.x; const int bx = blockIdx.x;
    const int vcu = (G % 8 == 0) ? (bx % 8) * (G / 8) + bx / 8 : bx;
    unsigned char* ws = args.ws;
    PG8_LAS unsigned char* lds3 = (PG8_LAS unsigned char*)lds;
    if constexpr (KIND == K_PROLOGUE) phase_prologue(args, lds, vcu, G);
    else if constexpr (KIND == K_H) phase_h(args, lds, vcu, G);
    else if constexpr (KIND == K_NORM) phase_norm(args, vcu, G);
    else if constexpr (KIND == K_INPROJ) {
        pg8::Gemm<1024, 1024, 1024> g{(const bf16*)(ws + WS_H) + (size_t)pass * MS * 1024, (const bf16*)(ws + WS_WIN)};
        pg8::StaticOrder S; S.init(MS, INW, G, bx);
        EpiProj E{(bf16*)(ws + WS_P)};
        pg8::gemm_phase<EpiProj, pg8::StaticOrder, true, true>(lds3, g, S, E);
    } else if constexpr (KIND == K_PREP) phase_prep(args, lds, vcu, G, pass);
    else if constexpr (KIND == K_QK) {
        pg8::Gemm<1024, 256, 256, 512, 512 * 256 * 2> g{(const bf16*)(ws + WS_XC), (const bf16*)(ws + WS_WQK)};
        pg8::GroupOrder S; S.init(MS, G, bx);
        EpiQK E{(bf16*)(ws + WS_QM), (bf16*)(ws + WS_KM)};
        pg8::gemm_phase<EpiQK, pg8::GroupOrder, true, true>(lds3, g, S, E);
    } else if constexpr (KIND == K_CPREP) phase_cprep(args, lds, vcu, G);
    else if constexpr (KIND == K_MIX) phase_mix(args, lds, pass, pbar);
    else if constexpr (KIND == K_POST) phase_post(args, lds, vcu, G);
    else if constexpr (KIND == K_OUT1) {
        { pg8::Gemm<1024, 1024, 1024> g{(const bf16*)(ws + WS_HR), (const bf16*)(ws + WS_WOM)};
          pg8::StaticOrder S; S.init(MS, 1024, G, bx);
          EpiMerge<0> E{(const bf16*)(ws + WS_P), (float*)(ws + WS_T), (bf16*)(ws + WS_MG)};
          pg8::gemm_phase<EpiMerge<0>, pg8::StaticOrder, true, true>(lds3, g, S, E); }
        { pg8::Gemm<512, 512, 512> g{(const bf16*)(ws + WS_UA), (const bf16*)(ws + WS_WOA)};
          pg8::StaticOrder S; S.init(MS, 1024, G, bx);
          EpiMerge<1> E{(const bf16*)(ws + WS_P), (float*)(ws + WS_T), (bf16*)(ws + WS_MG)};
          pg8::gemm_phase<EpiMerge<1>, pg8::StaticOrder, true, true>(lds3, g, S, E); }
    } else if constexpr (KIND == K_OUT2) {
        pg8::Gemm<1024, 1024, 1024> g{(const bf16*)(ws + WS_MG), (const bf16*)(ws + WS_WO)};
        pg8::StaticOrder S; S.init(MS, 1024, G, bx);
        EpiOut E{args.x, args.out, (const float*)(ws + WS_MOD) + 2048, (float*)(ws + WS_CTL) + CW_ROWSS, pass * MS};
        pg8::gemm_phase<EpiOut, pg8::StaticOrder, true, true>(lds3, g, S, E);
    }
}

#if !MK_ONE_LAUNCH
template <int KIND>
__global__ void __launch_bounds__(NTHR, 2) k_phase(Args args) {
    extern __shared__ __attribute__((aligned(16))) unsigned char lds[];
    run_phase<KIND>(args, lds, args.ph_lo);
}
#else
__global__ void __launch_bounds__(NTHR, 2) mk_fwd(Args args) {
    extern __shared__ __attribute__((aligned(16))) unsigned char lds[];
    volatile LAS unsigned* misc = (volatile LAS unsigned*)((LAS unsigned char*)lds + 131072 + 2048);
    if (threadIdx.x < 16) misc[threadIdx.x] = 0u;
    __syncthreads();
    XcdBarrier bar = xcd_barrier_post((unsigned*)(args.ws + WS_CTL) + CW_BAR, misc + 8);
#ifdef PROBE_TMASK
    unsigned long long pr_acc = 0ull;
#endif
    for (int gp = args.ph_lo; gp < args.ph_hi; ++gp) {
#ifdef PROBE_TMASK
        const unsigned long long pr_t0 = __builtin_amdgcn_s_memrealtime();
        int pr_kind;
        if (gp == 0) pr_kind = K_PROLOGUE; else if (gp == 1) pr_kind = K_H; else if (gp == PH_TOTAL - 1) pr_kind = K_NORM;
        else { const int k = (gp - 2) % PH_PER_PASS; pr_kind = k == 0 ? K_INPROJ : k == 1 ? K_PREP : k == 2 ? K_QK : k == 3 ? K_CPREP : k == 4 ? K_MIX : k == 5 ? K_POST : k == 6 ? K_OUT1 : K_OUT2; }
#endif
        if (gp == 0) run_phase<K_PROLOGUE>(args, lds, 0);
        else if (gp == 1) run_phase<K_H>(args, lds, 0);
        else if (gp == PH_TOTAL - 1) run_phase<K_NORM>(args, lds, 0);
        else {
            const int pass = (gp - 2) / PH_PER_PASS, k = (gp - 2) % PH_PER_PASS;
            if (k == 0) run_phase<K_INPROJ>(args, lds, pass);
            else if (k == 1) run_phase<K_PREP>(args, lds, pass);
            else if (k == 2) run_phase<K_QK>(args, lds, pass);
            else if (k == 3) run_phase<K_CPREP>(args, lds, pass);
            else if (k == 4) run_phase<K_MIX>(args, lds, pass, &bar);
            else if (k == 5) run_phase<K_POST>(args, lds, pass);
            else if (k == 6) run_phase<K_OUT1>(args, lds, pass);
            else run_phase<K_OUT2>(args, lds, pass);
        }
        if (gp + 1 < args.ph_hi) xcd_barrier(bar);
#ifdef PROBE_TMASK
        else __syncthreads();
        if ((PROBE_TMASK >> pr_kind) & 1) pr_acc += __builtin_amdgcn_s_memrealtime() - pr_t0;
#endif
    }
#ifdef PROBE_TMASK
    if (blockIdx.x == 0) { const unsigned long long t1 = __builtin_amdgcn_s_memrealtime(); while (__builtin_amdgcn_s_memrealtime() - t1 < 4ull * pr_acc) __builtin_amdgcn_s_sleep(8); }
#endif
}
#endif

extern "C" void kernel_launch(void* const* d_in, const int* in_sizes, int n_in, void* d_out, int out_size, void* d_ws, size_t ws_size, hipStream_t stream) {
    static int grid = 0;
    if (grid == 0) {
        if (n_in != 19 || in_sizes[0] != MALL * DM || out_size != MALL * DM || ws_size < WS_END) { fprintf(stderr, "kernel_launch: unexpected shapes (n_in %d, ws %zu)\n", n_in, ws_size); grid = -1; return; }
        int dev = 0, cus = 0, per_cu = 0;
        (void)hipGetDevice(&dev); (void)hipDeviceGetAttribute(&cus, hipDeviceAttributeMultiprocessorCount, dev);
#if MK_ONE_LAUNCH
        (void)hipFuncSetAttribute((const void*)mk_fwd, hipFuncAttributeMaxDynamicSharedMemorySize, LDS_BYTES);
        (void)hipOccupancyMaxActiveBlocksPerMultiprocessor(&per_cu, (const void*)mk_fwd, NTHR, LDS_BYTES);
        if (per_cu < 1) { fprintf(stderr, "kernel_launch: occupancy query says %d\n", per_cu); per_cu = 1; }
#else
#define SETATTR(KIND) (void)hipFuncSetAttribute((const void*)k_phase<KIND>, hipFuncAttributeMaxDynamicSharedMemorySize, LDS_BYTES)
        SETATTR(K_PROLOGUE); SETATTR(K_H); SETATTR(K_INPROJ); SETATTR(K_PREP); SETATTR(K_QK); SETATTR(K_MIX); SETATTR(K_POST); SETATTR(K_OUT1); SETATTR(K_OUT2); SETATTR(K_NORM); SETATTR(K_CPREP);
        (void)per_cu;
#endif
        (void)hipGetLastError();
        grid = cus;
    }
    if (grid < 0) return;
    (void)hipMemsetAsync((char*)d_ws + WS_CTL, 0, CTL_ZERO_BYTES, stream);
    Args a{};
    a.x = (const float*)d_in[0]; a.c = (const float*)d_in[1]; a.pos = (const int*)d_in[2]; a.w_ada = (const float*)d_in[3]; a.b_ada = (const float*)d_in[4];
    a.g_norm = (const float*)d_in[5]; a.w_in = (const float*)d_in[6]; a.b_ig = (const float*)d_in[7]; a.b_fg = (const float*)d_in[8]; a.w_conv = (const float*)d_in[9];
    a.b_conv = (const float*)d_in[10]; a.w_q = (const float*)d_in[11]; a.w_k = (const float*)d_in[12]; a.g_head = (const float*)d_in[13]; a.skip = (const float*)d_in[14];
    a.w_om = (const float*)d_in[15]; a.w_oa = (const float*)d_in[16]; a.w_o = (const float*)d_in[17]; a.g_final = (const float*)d_in[18];
    a.out = (float*)d_out; a.ws = (unsigned char*)d_ws;
#if MK_ONE_LAUNCH
    a.ph_lo = 0; a.ph_hi = PH_TOTAL;
    void* params[] = {&a};
    hipError_t e = hipLaunchCooperativeKernel((const void*)mk_fwd, dim3(grid), dim3(NTHR), params, LDS_BYTES, stream);
    if (e != hipSuccess) fprintf(stderr, "cooperative launch failed: %s\n", hipGetErrorString(e));
#else
#define LAUNCH(KIND, PASS) do { a.ph_lo = (PASS); a.ph_hi = 0; hipLaunchKernelGGL(k_phase<KIND>, dim3(grid), dim3(NTHR), LDS_BYTES, stream, a); } while (0)
    LAUNCH(K_PROLOGUE, 0); LAUNCH(K_H, 0);
    for (int p = 0; p < NPASS; ++p) { LAUNCH(K_INPROJ, p); LAUNCH(K_PREP, p); LAUNCH(K_QK, p); LAUNCH(K_CPREP, p); LAUNCH(K_MIX, p); LAUNCH(K_POST, p); LAUNCH(K_OUT1, p); LAUNCH(K_OUT2, p); }
    LAUNCH(K_NORM, 0);
#endif
}
```

```cpp
#include <hip/hip_runtime.h>
#include <hip/hip_cooperative_groups.h>
#include <cstdio>
#include <cstdint>
namespace cg = cooperative_groups;

#ifndef MK_ONE_LAUNCH
#define MK_ONE_LAUNCH 1
#endif

__device__ __forceinline__ int opaque_tid() { int t = threadIdx.x; asm volatile("" : "+v"(t)); return t; }
namespace pg8 {
#define PG8_LAS __attribute__((address_space(3)))
typedef unsigned short bf16_t;
typedef short bf16x8 __attribute__((ext_vector_type(8)));
typedef float f32x4 __attribute__((ext_vector_type(4)));
typedef unsigned u32x4 __attribute__((ext_vector_type(4)));
constexpr int BM = 256, BK = 64, HALF = 128, HTB = HALF * BK * 2, STAGE_BYTES = 8 * HTB, NXCD = 8, WGM = 8;

__host__ __device__ __forceinline__ int lds_byte(int r, int c) { const int st = (r >> 4) * 2 + (c >> 5), rr = r & 15, cc = c & 31, ob = rr * 64 + cc * 2; return st * 1024 + (ob ^ (((ob >> 9) & 1) << 5)); }
__host__ __device__ __forceinline__ void stage_rc(int b, int& R, int& C) { const int st = b / 1024, sb = b % 1024, swz = sb ^ (((sb >> 9) & 1) << 5); R = (st >> 1) * 16 + swz / 64; C = (st & 1) * 32 + (swz % 64) / 2; }
__host__ __device__ __forceinline__ int perm32(int rho) { const int n = rho >> 4, i = rho & 15; return 8 * (i >> 2) + 4 * n + (i & 3); }

struct Unit { int pm, pn, g; };
template <int LDA, int LDB, int KK, int AGS = 0, int BGS = 0> struct Gemm {
    const bf16_t* A; const bf16_t* Bt;
    static constexpr int lda = LDA, ldb = LDB, K = KK;
    __device__ __forceinline__ const char* abase(const Unit& u) const { return (const char*)A + (size_t)(u.g * AGS) + (size_t)u.pm * (size_t)(BM * 2 * LDA); }
    __device__ __forceinline__ const char* bbase(const Unit& u) const { return (const char*)Bt + (size_t)(u.g * BGS) + (size_t)u.pn * (size_t)(BM * 2 * LDB); }
};

struct StaticOrder {
    int nM, nN, nwg, G, c;
    __host__ __device__ void init(int M, int N, int G_, int c_) { nM = M / BM; nN = N / BM; nwg = nM * nN; G = G_; c = c_; }
    __host__ __device__ bool next(int i, Unit& u) const {
        const long L = (long)i * G + c; if (L >= nwg) return false;
        int wgid = (int)L; { const int q = nwg / NXCD, r = nwg % NXCD, xcd = wgid % NXCD, off = wgid / NXCD; wgid = (xcd < r ? xcd * (q + 1) : r * (q + 1) + (xcd - r) * q) + off; }
        const int nig = WGM * nN, gid = wgid / nig, fm = gid * WGM, gsz = (nM - fm) < WGM ? (nM - fm) : WGM;
        u.pm = fm + ((wgid % nig) % gsz); u.pn = (wgid % nig) / gsz; u.g = 0; return true;
    }
    __device__ __forceinline__ void a_ready(const Unit&) const {}
    __device__ __forceinline__ void done(const Unit&) const {}
};
struct GroupOrder {
    int nunits, G, c;
    __host__ __device__ void init(int M, int G_, int c_) { nunits = (M / BM) * 8; G = G_; c = c_; }
    __host__ __device__ bool next(int i, Unit& u) const {
        const long L = (long)i * G + c; if (L >= nunits) return false;
        u.pm = (int)(L >> 3); u.g = (int)((L & 7) >> 1); u.pn = (int)(L & 1); return true;
    }
    __device__ __forceinline__ void a_ready(const Unit&) const {}
    __device__ __forceinline__ void done(const Unit&) const {}
};

__device__ __forceinline__ unsigned cvt_pk_bf16(float lo, float hi) { unsigned r; asm volatile("v_cvt_pk_bf16_f32 %0, %1, %2" : "=v"(r) : "v"(lo), "v"(hi)); return r; }

template <class Epi, class Sched, bool ALIGN_EPI, bool SP2, class GemmT>
__device__ __forceinline__ void gemm_phase(PG8_LAS unsigned char* lds, const GemmT g, const Sched& S, const Epi& E) {
    const int tid = opaque_tid(), wid = __builtin_amdgcn_readfirstlane(tid >> 6), lane = tid & 63, wr = wid >> 2, wc = wid & 3, fr = lane & 15, fq = lane >> 4;
    constexpr int K = GemmT::K, nt = K / BK;
    unsigned voffA[2], voffB[2];
#pragma unroll
    for (int i = 0; i < 2; ++i) { int R, C; stage_rc(tid * 16 + i * 8192, R, C); const int Rb = Epi::PERM ? (64 * (R >> 5) + perm32(R & 31)) : R;
        voffA[i] = (unsigned)(R * g.lda + C) * 2u; voffB[i] = (unsigned)(Rb * g.ldb + C) * 2u; }
    const size_t kstep = (size_t)(BK * 2);
    const size_t hstepA = (size_t)HALF * g.lda * 2, hstepB = (size_t)(Epi::PERM ? 32 : HALF) * g.ldb * 2;
    const unsigned ldsw = (unsigned)wid * 1024u;
    const int aoff = lds_byte(wr * 64 + fr, fq * 8), boff = lds_byte(wc * 32 + fr, fq * 8);
#define PG8_SA(b, h) (((b) * 2 + (h)) * HTB)
#define PG8_SB(b, h) ((4 + (b) * 2 + (h)) * HTB)
#define PG8_STAGE(bufoff, gbase, voff) do { _Pragma("unroll") for (int _i = 0; _i < 2; ++_i) \
        __builtin_amdgcn_global_load_lds((const unsigned*)((const char*)(gbase) + (voff)[_i]), (PG8_LAS unsigned*)(lds + (bufoff) + ldsw + _i * 8192), 16, 0, 0); } while (0)
#define PG8_LDA(dst, b, h) do { _Pragma("unroll") for (int m = 0; m < 4; ++m) _Pragma("unroll") for (int k = 0; k < 2; ++k) dst[m][k] = *(const PG8_LAS bf16x8*)(lds + PG8_SA(b, h) + aoff + m * 2048 + k * 1024); } while (0)
#define PG8_LDB(dst, b, h) do { _Pragma("unroll") for (int n = 0; n < 2; ++n) _Pragma("unroll") for (int k = 0; k < 2; ++k) dst[n][k] = *(const PG8_LAS bf16x8*)(lds + PG8_SB(b, h) + boff + n * 2048 + k * 1024); } while (0)
#define PG8_MMA(ai, bj, At, Bt) do { __builtin_amdgcn_s_setprio(1); _Pragma("unroll") for (int m = 0; m < 4; ++m) _Pragma("unroll") for (int n = 0; n < 2; ++n) _Pragma("unroll") for (int k = 0; k < 2; ++k) \
        acc[ai][bj][m][n] = __builtin_amdgcn_mfma_f32_16x16x32_bf16(Bt[n][k], At[m][k], acc[ai][bj][m][n], 0, 0, 0); __builtin_amdgcn_s_setprio(0); } while (0)
#define PG8_WAIT_V(n) asm volatile("s_waitcnt vmcnt(" #n ")" ::: "memory")
#define PG8_WAIT_L(n) asm volatile("s_waitcnt lgkmcnt(" #n ")" ::: "memory")
#define PG8_BAR __builtin_amdgcn_s_barrier()
#define PG8_SCHED __builtin_amdgcn_sched_barrier(0)
    Unit cur, nxt; int ui = 0;
    if (!S.next(0, cur)) return;
    f32x4 acc[2][2][4][2];
#pragma unroll
    for (int a = 0; a < 2; ++a)
#pragma unroll
        for (int b = 0; b < 2; ++b)
#pragma unroll
            for (int m = 0; m < 4; ++m)
#pragma unroll
                for (int n = 0; n < 2; ++n) acc[a][b][m][n] = (f32x4){0.f, 0.f, 0.f, 0.f};
    bf16x8 At[4][2], B0[2][2], B1[2][2];
    const char* cA = g.abase(cur); const char* cB = g.bbase(cur);
    S.a_ready(cur);
    if constexpr (SP2) {
        PG8_STAGE(PG8_SB(0, 0), cB, voffB); PG8_STAGE(PG8_SB(0, 1), cB + hstepB, voffB); PG8_STAGE(PG8_SA(0, 0), cA, voffA); PG8_STAGE(PG8_SA(0, 1), cA + hstepA, voffA);
        if (wr == 1) PG8_BAR;
        PG8_WAIT_V(2); PG8_BAR;
        PG8_STAGE(PG8_SB(1, 0), cB + kstep, voffB); PG8_STAGE(PG8_SA(1, 0), cA + kstep, voffA); PG8_STAGE(PG8_SB(1, 1), cB + hstepB + kstep, voffB);
        PG8_WAIT_V(6); PG8_BAR;
    } else {
        PG8_STAGE(PG8_SB(0, 0), cB, voffB); PG8_STAGE(PG8_SA(0, 0), cA, voffA); PG8_STAGE(PG8_SB(0, 1), cB + hstepB, voffB); PG8_STAGE(PG8_SA(0, 1), cA + hstepA, voffA);
        if (wr == 1) PG8_BAR;
        PG8_WAIT_V(4); PG8_BAR;
        PG8_STAGE(PG8_SB(1, 0), cB + kstep, voffB); PG8_STAGE(PG8_SA(1, 0), cA + kstep, voffA); PG8_STAGE(PG8_SB(1, 1), cB + hstepB + kstep, voffB);
        PG8_WAIT_V(6); PG8_BAR;
    }
    for (;;) {
        const bool has_next = S.next(ui + 1, nxt);
        const char* nA = has_next ? g.abase(nxt) : cA; const char* nB = has_next ? g.bbase(nxt) : cB;
#pragma nounroll
        for (int t = 0; t < nt; t += 2) {
            const bool last = (t == nt - 2);
            const char* a1 = cA + (size_t)(t + 1) * kstep;
            const char* a2 = last ? nA : cA + (size_t)(t + 2) * kstep; const char* b2 = last ? nB : cB + (size_t)(t + 2) * kstep;
            const char* a3 = a2 + kstep; const char* b3 = b2 + kstep;
            if (last && has_next) S.a_ready(nxt);
            if constexpr (Epi::HOOK_T >= 0) { if (t == Epi::HOOK_T) E.hook(acc, cur, wr, wc, fr, fq); }
            if constexpr (SP2) {
            PG8_LDB(B0, 0, 0); PG8_LDB(B1, 0, 1); PG8_SCHED; PG8_LDA(At, 0, 0); PG8_STAGE(PG8_SA(1, 1), a1 + hstepA, voffA);
            PG8_WAIT_V(8); PG8_WAIT_L(0); PG8_BAR; PG8_MMA(0, 0, At, B0); PG8_MMA(0, 1, At, B1); PG8_BAR; PG8_SCHED;
            PG8_LDA(At, 0, 1); PG8_STAGE(PG8_SB(0, 0), b2, voffB); PG8_STAGE(PG8_SB(0, 1), b2 + hstepB, voffB); PG8_STAGE(PG8_SA(0, 0), a2, voffA);
            PG8_WAIT_V(8); PG8_WAIT_L(0); PG8_BAR; PG8_MMA(1, 0, At, B0); PG8_MMA(1, 1, At, B1); PG8_BAR; PG8_SCHED;
            PG8_LDB(B0, 1, 0); PG8_LDB(B1, 1, 1); PG8_SCHED; PG8_LDA(At, 1, 0); PG8_STAGE(PG8_SA(0, 1), a2 + hstepA, voffA);
            PG8_WAIT_V(8); PG8_WAIT_L(0); PG8_BAR; PG8_MMA(0, 0, At, B0); PG8_MMA(0, 1, At, B1); PG8_BAR; PG8_SCHED;
            PG8_LDA(At, 1, 1); PG8_STAGE(PG8_SB(1, 0), b3, voffB); PG8_STAGE(PG8_SB(1, 1), b3 + hstepB, voffB); PG8_STAGE(PG8_SA(1, 0), a3, voffA);
            PG8_WAIT_V(8); PG8_WAIT_L(0); PG8_BAR; PG8_MMA(1, 0, At, B0); PG8_MMA(1, 1, At, B1); PG8_BAR; PG8_SCHED;
            } else {
            PG8_LDB(B0, 0, 0); PG8_SCHED; PG8_LDA(At, 0, 0); PG8_STAGE(PG8_SA(1, 1), a1 + hstepA, voffA);
            PG8_WAIT_L(8); PG8_BAR; PG8_WAIT_L(0); PG8_MMA(0, 0, At, B0); PG8_BAR; PG8_SCHED;
            PG8_LDB(B1, 0, 1); PG8_STAGE(PG8_SB(0, 0), b2, voffB);
            PG8_BAR; PG8_WAIT_L(0); PG8_MMA(0, 1, At, B1); PG8_BAR;
            PG8_LDA(At, 0, 1); PG8_STAGE(PG8_SA(0, 0), a2, voffA);
            PG8_BAR; PG8_WAIT_L(0); PG8_MMA(1, 0, At, B0); PG8_BAR; PG8_SCHED;
            PG8_STAGE(PG8_SB(0, 1), b2 + hstepB, voffB);
            PG8_WAIT_V(6); PG8_BAR; PG8_MMA(1, 1, At, B1); PG8_BAR;
            PG8_LDB(B0, 1, 0); PG8_SCHED; PG8_LDA(At, 1, 0); PG8_STAGE(PG8_SA(0, 1), a2 + hstepA, voffA);
            PG8_WAIT_L(8); PG8_BAR; PG8_WAIT_L(0); PG8_MMA(0, 0, At, B0); PG8_BAR; PG8_SCHED;
            PG8_LDB(B1, 1, 1); PG8_STAGE(PG8_SB(1, 0), b3, voffB);
            PG8_BAR; PG8_WAIT_L(0); PG8_MMA(0, 1, At, B1); PG8_BAR;
            PG8_LDA(At, 1, 1); PG8_STAGE(PG8_SA(1, 0), a3, voffA);
            PG8_BAR; PG8_WAIT_L(0); PG8_MMA(1, 0, At, B0); PG8_BAR; PG8_SCHED;
            PG8_STAGE(PG8_SB(1, 1), b3 + hstepB, voffB);
            PG8_WAIT_V(6); PG8_BAR; PG8_MMA(1, 1, At, B1); PG8_BAR;
            }
        }
        if constexpr (ALIGN_EPI) { if (wr == 0) PG8_BAR; }
        E(acc, cur, wr, wc, fr, fq); S.done(cur);
        if (!has_next) break;
#pragma unroll
        for (int a = 0; a < 2; ++a)
#pragma unroll
            for (int b = 0; b < 2; ++b)
#pragma unroll
                for (int m = 0; m < 4; ++m)
#pragma unroll
                    for (int n = 0; n < 2; ++n) acc[a][b][m][n] = (f32x4){0.f, 0.f, 0.f, 0.f};
        cur = nxt; cA = nA; cB = nB; ++ui;
        if constexpr (ALIGN_EPI) { if (wr == 1) PG8_BAR; }
    }
    PG8_WAIT_V(0);
    if constexpr (!ALIGN_EPI) { if (wr == 0) PG8_BAR; }
    PG8_BAR;
#undef PG8_SA
#undef PG8_SB
#undef PG8_STAGE
#undef PG8_LDA
#undef PG8_LDB
#undef PG8_MMA
#undef PG8_WAIT_V
#undef PG8_WAIT_L
#undef PG8_BAR
#undef PG8_SCHED
}
}

constexpr int NWAVES = 8, NTHR = 512;
constexpr int DM = 1024, NBATCH = 16, SEQ = 4096, MALL = NBATCH * SEQ;
constexpr int NB_PASS = 4, MS = NB_PASS * SEQ, NPASS = NBATCH / NB_PASS;
constexpr int INW_SRC = 11272, INW = 11264;
constexpr int C_XA = 0, C_VA = 1024, C_OA = 2048, C_ZA = 3072, C_QA = 4096, C_KA = 5632, C_VT = 7168, C_ZB = 8704, C_GA = 9216, C_GB = 10240;
constexpr float EPS = 1e-6f;

constexpr size_t MiB = 1u << 20;
constexpr size_t WS_CTL = 0, CTL_ZERO_BYTES = 1 * MiB;
constexpr size_t WS_MOD = 1 * MiB;
constexpr size_t WS_WG = 1 * MiB + 256 * 1024;
constexpr size_t WS_WIN = 2 * MiB;
constexpr size_t WS_WQK = 24 * MiB;
constexpr size_t WS_WOM = 25 * MiB, WS_WOA = 27 * MiB, WS_WO = 28 * MiB;
constexpr size_t WS_IG = 30 * MiB, WS_FG = 31 * MiB;
constexpr size_t WS_GSC = 32 * MiB;
constexpr size_t WS_LSE = 34 * MiB;
constexpr size_t WS_DEN = 35 * MiB;
constexpr size_t WS_H = 36 * MiB;
constexpr size_t WS_P = 164 * MiB;
constexpr size_t WS_XC = 516 * MiB;
constexpr size_t WS_QM = 548 * MiB, WS_KM = 580 * MiB;
constexpr size_t WS_HR = 612 * MiB;
constexpr size_t WS_AO = 644 * MiB;
constexpr size_t WS_UA = 692 * MiB;
constexpr size_t WS_ACAT = 708 * MiB;
constexpr size_t WS_MG = 772 * MiB;
constexpr size_t WS_SG = 804 * MiB;
constexpr size_t WS_KTG = 812 * MiB;
constexpr size_t WS_VTG = 844 * MiB;
constexpr size_t WS_CS = 876 * MiB;
constexpr size_t WS_NS = 1004 * MiB;
constexpr size_t WS_ROPE = 1005 * MiB;
constexpr size_t WS_END = 1013 * MiB;
constexpr int CW_QCTR = 1024;
constexpr int CW_ROWSS = 65536;
static_assert((CW_ROWSS + MALL) * 4 <= (int)CTL_ZERO_BYTES, "ctl");

constexpr int LDS_BYTES = 147456;

typedef unsigned short bf16;
typedef float f32x4 __attribute__((ext_vector_type(4)));
typedef float f32x2 __attribute__((ext_vector_type(2)));
typedef short bf16x8 __attribute__((ext_vector_type(8)));
typedef unsigned u32x4 __attribute__((ext_vector_type(4)));
typedef unsigned u32x2 __attribute__((ext_vector_type(2)));
typedef short s16x4 __attribute__((ext_vector_type(4)));

__device__ __forceinline__ unsigned f2bf(float f) { unsigned u = __builtin_bit_cast(unsigned, f); return (u + 0x7fffu + ((u >> 16) & 1u)) >> 16; }
__device__ __forceinline__ unsigned pk2(float lo, float hi) { return f2bf(lo) | (f2bf(hi) << 16); }
__device__ __forceinline__ float bflo(unsigned w) { return __builtin_bit_cast(float, w << 16); }
__device__ __forceinline__ float bfhi(unsigned w) { return __builtin_bit_cast(float, w & 0xffff0000u); }
__device__ __forceinline__ float bf1(bf16 v) { return __builtin_bit_cast(float, (unsigned)v << 16); }
__device__ __forceinline__ float sigmoidf_(float x) { return 1.f / (1.f + __expf(-x)); }
__device__ __forceinline__ float siluf_(float x) { return x / (1.f + __expf(-x)); }
__device__ __forceinline__ float wave_sum(float v) {
#pragma unroll
    for (int o = 1; o < 64; o <<= 1) v += __shfl_xor(v, o);
    return v;
}
__device__ __forceinline__ void unpack8(const u32x4 w, float* f) {
    f[0] = bflo(w.x); f[1] = bfhi(w.x); f[2] = bflo(w.y); f[3] = bfhi(w.y); f[4] = bflo(w.z); f[5] = bfhi(w.z); f[6] = bflo(w.w); f[7] = bfhi(w.w);
}

struct Args {
    const float* x; const float* c; const int* pos; const float* w_ada; const float* b_ada; const float* g_norm; const float* w_in;
    const float* b_ig; const float* b_fg; const float* w_conv; const float* b_conv; const float* w_q; const float* w_k; const float* g_head;
    const float* skip; const float* w_om; const float* w_oa; const float* w_o; const float* g_final;
    float* out; unsigned char* ws; int ph_lo, ph_hi;
};

__device__ __forceinline__ void transpose_item(const float* W, int K, int Nsrc, int nblk, int src_col_off, bf16* WT, int ldt, int row_off, float scale, float* scr, int item, int lane) {
    const int kb = item / nblk, nb = item % nblk, k0 = 64 * kb, n0 = 32 * nb;
#pragma unroll 8
    for (int i = 0; i < 32; ++i) { const int kk = 2 * i + (lane >> 5); scr[kk * 33 + (lane & 31)] = W[(size_t)(k0 + kk) * Nsrc + src_col_off + n0 + (lane & 31)]; }
    __builtin_amdgcn_wave_barrier();
    asm volatile("s_waitcnt lgkmcnt(0)" ::: "memory");
    const int cc = lane & 7;
#pragma unroll
    for (int j = 0; j < 4; ++j) { const int n = (lane >> 3) + 8 * j; const float* s = scr + (8 * cc) * 33 + n;
        u32x4 o; o.x = pk2(s[0 * 33] * scale, s[1 * 33] * scale); o.y = pk2(s[2 * 33] * scale, s[3 * 33] * scale); o.z = pk2(s[4 * 33] * scale, s[5 * 33] * scale); o.w = pk2(s[6 * 33] * scale, s[7 * 33] * scale);
        *(u32x4*)(WT + (size_t)(row_off + n0 + n) * ldt + k0 + 8 * cc) = o; }
    asm volatile("s_waitcnt lgkmcnt(0)" ::: "memory");
    __builtin_amdgcn_wave_barrier();
}

__device__ __forceinline__ void phase_prologue(const Args& a, unsigned char* lds, int vcu, int G) {
    const int tid = opaque_tid(), lane = tid & 63, wave = tid >> 6;
    unsigned char* ws = a.ws;
    if (vcu < 48) {
        float* sc = (float*)lds;
        float* red = (float*)(lds + 65536);
        for (int i = tid; i < 16 * 1024; i += NTHR) sc[i] = siluf_(a.c[i]);
        __syncthreads();
        const int n = vcu * 64 + lane;
        float acc[16];
#pragma unroll
        for (int b = 0; b < 16; ++b) acc[b] = 0.f;
        const int k0 = wave * 128;
#pragma unroll 16
        for (int k = k0; k < k0 + 128; ++k) { const float w = a.w_ada[(size_t)k * 3072 + n];
#pragma unroll
            for (int b = 0; b < 16; ++b) acc[b] += sc[b * 1024 + k] * w; }
#pragma unroll
        for (int b = 0; b < 16; ++b) red[(wave * 16 + b) * 64 + lane] = acc[b];
        __syncthreads();
        float* mod = (float*)(ws + WS_MOD);
        for (int i = tid; i < 16 * 64; i += NTHR) { const int b = i >> 6, l = i & 63, nn = vcu * 64 + l; float s = 0.f;
#pragma unroll
            for (int w = 0; w < 8; ++w) s += red[(w * 16 + b) * 64 + l];
            s += a.b_ada[nn];
            const int part = nn >> 10, col = nn & 1023;
            if (part == 1) s = a.g_norm[col] * (1.f + s);
            mod[b * 3072 + nn] = s; }
        __syncthreads();
    }
    {
        float* scr = (float*)lds + wave * (64 * 33);
        const int gw = vcu * NWAVES + wave, NGW = G * NWAVES;
        constexpr int I_IN = (1024 / 64) * (INW / 32);
        constexpr int I_QK = 8 * (256 / 64) * (256 / 32);
        constexpr int I_OM = 16 * 32, I_OA = 8 * 32, I_O = 16 * 32;
        constexpr int NITEMS = I_IN + I_QK + I_OM + I_OA + I_O;
        for (int it = gw; it < NITEMS; it += NGW) {
            int r = it;
            if (r < I_IN) { const int nb = r % (INW / 32); const int off = (nb * 32 >= 4096) ? 8 : 0;
                transpose_item(a.w_in, 1024, INW_SRC, INW / 32, off, (bf16*)(ws + WS_WIN), 1024, 0, 1.f, scr, r, lane); continue; } r -= I_IN;
            if (r < I_QK) { const int mtx = r >> 5, rr = r & 31, h = mtx >> 1, isk = mtx & 1;
                const float* W = (isk ? a.w_k : a.w_q) + (size_t)h * 65536;
                transpose_item(W, 256, 256, 8, 0, (bf16*)(ws + WS_WQK) + (size_t)h * 512 * 256, 256, isk * 256, isk ? 0.0625f : 1.f, scr, rr, lane); continue; } r -= I_QK;
            if (r < I_OM) { transpose_item(a.w_om, 1024, 1024, 32, 0, (bf16*)(ws + WS_WOM), 1536, 0, 1.f, scr, r, lane); continue; } r -= I_OM;
            if (r < I_OA) { transpose_item(a.w_oa, 512, 1024, 32, 0, (bf16*)(ws + WS_WOM) + 1024, 1536, 0, 1.f, scr, r, lane); continue; } r -= I_OA;
            transpose_item(a.w_o, 1024, 1024, 32, 0, (bf16*)(ws + WS_WO), 1024, 0, 1.f, scr, r, lane);
        }
        float* wg = (float*)(ws + WS_WG);
        for (int i = (vcu * NTHR + tid); i < 8 * 1024; i += G * NTHR) { const int j = i >> 10, k = i & 1023; wg[i] = a.w_in[(size_t)k * INW_SRC + 4096 + j]; }
    }
}

__constant__ double c_inv_freq[16] = {1.0, 0.44036660267178046, 0.19392274474868576, 0.08539710028576561, 0.03760603093086393, 0.016560440080994446, 0.007292664737217109, 0.003211445994752591,
    0.001414213562373095, 0.000622772421914596, 0.0002742481756762073, 0.00012076973741146504, 5.318295896944988e-05, 2.341999896140934e-05, 1.031338537721246e-05, 4.5416704806078695e-06};

__device__ __forceinline__ void phase_h(const Args& a, unsigned char* lds, int vcu, int G) {
    const int tid = opaque_tid(), lane = tid & 63, wave = tid >> 6;
    unsigned char* ws = a.ws;
    float* wg = (float*)lds;
    { const float* src = (const float*)(ws + WS_WG); for (int i = tid; i < 8192; i += NTHR) wg[i] = src[i]; }
    __syncthreads();
    const float* mod = (const float*)(ws + WS_MOD);
    bf16* H = (bf16*)(ws + WS_H);
    float* IG = (float*)(ws + WS_IG); float* FG = (float*)(ws + WS_FG); float* ROPE = (float*)(ws + WS_ROPE);
    const int gw = vcu * NWAVES + wave, NGW = G * NWAVES;
    for (int row0 = 2 * gw; row0 < MALL; row0 += 2 * NGW) {
        f32x4 v[2][4]; float ss[2] = {0.f, 0.f};
#pragma unroll
        for (int rr = 0; rr < 2; ++rr) { const f32x4* xr = (const f32x4*)(a.x + (size_t)(row0 + rr) * DM) + lane;
#pragma unroll
            for (int j = 0; j < 4; ++j) v[rr][j] = xr[64 * j]; }
        if (lane < 32) { const int rr = lane >> 4, fi = lane & 15; const int pos = a.pos[row0 + rr];
            const double rev = (double)pos * c_inv_freq[fi] * 0.15915494309189535; const float fr_ = (float)(rev - rint(rev));
            ROPE[(size_t)(row0 + rr) * 32 + fi] = __builtin_amdgcn_cosf(fr_); ROPE[(size_t)(row0 + rr) * 32 + 16 + fi] = __builtin_amdgcn_sinf(fr_); }
#pragma unroll
        for (int rr = 0; rr < 2; ++rr) {
#pragma unroll
            for (int j = 0; j < 4; ++j) ss[rr] += (v[rr][j].x * v[rr][j].x + v[rr][j].y * v[rr][j].y) + (v[rr][j].z * v[rr][j].z + v[rr][j].w * v[rr][j].w);
        }
#pragma unroll
        for (int o = 1; o < 64; o <<= 1) { ss[0] += __shfl_xor(ss[0], o); ss[1] += __shfl_xor(ss[1], o); }
        const int b = row0 >> 12;
        float pg[2][8];
#pragma unroll
        for (int rr = 0; rr < 2; ++rr)
#pragma unroll
            for (int g = 0; g < 8; ++g) pg[rr][g] = 0.f;
        const float rinv[2] = {1.f / sqrtf(ss[0] * (1.f / DM) + EPS), 1.f / sqrtf(ss[1] * (1.f / DM) + EPS)};
#pragma unroll
        for (int j = 0; j < 4; ++j) {
            const int col = 4 * lane + 256 * j;
            const f32x4 sh = *(const f32x4*)(mod + b * 3072 + col), gs = *(const f32x4*)(mod + b * 3072 + 1024 + col);
            f32x4 h[2];
#pragma unroll
            for (int rr = 0; rr < 2; ++rr) { h[rr] = v[rr][j] * rinv[rr] * gs + sh;
                u32x2 o; o.x = pk2(h[rr].x, h[rr].y); o.y = pk2(h[rr].z, h[rr].w); *((u32x2*)(H + (size_t)(row0 + rr) * DM) + lane + 64 * j) = o; }
#pragma unroll
            for (int g = 0; g < 8; ++g) { const f32x4 w = *(const f32x4*)(wg + g * 1024 + col);
                pg[0][g] += (h[0].x * w.x + h[0].y * w.y) + (h[0].z * w.z + h[0].w * w.w); pg[1][g] += (h[1].x * w.x + h[1].y * w.y) + (h[1].z * w.z + h[1].w * w.w); }
            __builtin_amdgcn_sched_barrier(0);
        }
#pragma unroll
        for (int o = 1; o < 64; o <<= 1)
#pragma unroll
            for (int g = 0; g < 8; ++g) { pg[0][g] += __shfl_xor(pg[0][g], o); pg[1][g] += __shfl_xor(pg[1][g], o); }
        if (lane < 2) { const int rr = lane; const float* p = rr ? pg[1] : pg[0];
            f32x4 ig = {p[0] + a.b_ig[0], p[1] + a.b_ig[1], p[2] + a.b_ig[2], p[3] + a.b_ig[3]};
            f32x4 fg = {p[4] + a.b_fg[0], p[5] + a.b_fg[1], p[6] + a.b_fg[2], p[7] + a.b_fg[3]};
            *(f32x4*)(IG + (size_t)(row0 + rr) * 4) = ig; *(f32x4*)(FG + (size_t)(row0 + rr) * 4) = fg; }
    }
}

struct EpiProj {
    static constexpr bool PERM = true; static constexpr int HOOK_T = -1;
    bf16* P;
    __device__ __forceinline__ void operator()(const f32x4 (&acc)[2][2][4][2], const pg8::Unit& u, int wr, int wc, int fr, int fq) const {
        const int row0 = u.pm * 256 + wr * 64 + fr, col0 = u.pn * 256 + wc * 64 + 8 * fq;
#pragma unroll
        for (int ai = 0; ai < 2; ++ai)
#pragma unroll
            for (int m = 0; m < 4; ++m) { bf16* rowp = P + (size_t)(row0 + ai * 128 + m * 16) * INW + col0;
#pragma unroll
                for (int bj = 0; bj < 2; ++bj) { const f32x4 v0 = acc[ai][bj][m][0], v1 = acc[ai][bj][m][1];
                    u32x4 w; w.x = pg8::cvt_pk_bf16(v0[0], v0[1]); w.y = pg8::cvt_pk_bf16(v0[2], v0[3]); w.z = pg8::cvt_pk_bf16(v1[0], v1[1]); w.w = pg8::cvt_pk_bf16(v1[2], v1[3]);
                    *(u32x4*)(rowp + bj * 32) = w; } }
    }
};
struct EpiQK {
    static constexpr bool PERM = true; static constexpr int HOOK_T = -1;
    bf16* QM; bf16* KM;
    __device__ __forceinline__ void operator()(const f32x4 (&acc)[2][2][4][2], const pg8::Unit& u, int wr, int wc, int fr, int fq) const {
        const int row0 = u.pm * 256 + wr * 64 + fr, col0 = u.g * 256 + wc * 64 + 8 * fq;
        bf16* base = u.pn ? KM : QM;
#pragma unroll
        for (int ai = 0; ai < 2; ++ai)
#pragma unroll
            for (int m = 0; m < 4; ++m) { bf16* rowp = base + (size_t)(row0 + ai * 128 + m * 16) * 1024 + col0;
#pragma unroll
                for (int bj = 0; bj < 2; ++bj) { const f32x4 v0 = acc[ai][bj][m][0], v1 = acc[ai][bj][m][1];
                    u32x4 w; w.x = pg8::cvt_pk_bf16(v0[0], v0[1]); w.y = pg8::cvt_pk_bf16(v0[2], v0[3]); w.z = pg8::cvt_pk_bf16(v1[0], v1[1]); w.w = pg8::cvt_pk_bf16(v1[2], v1[3]);
                    *(u32x4*)(rowp + bj * 32) = w; } }
    }
};
struct EpiMerge {
    static constexpr bool PERM = true; static constexpr int HOOK_T = 16;
    const bf16* P; bf16* MG;
    __device__ __forceinline__ void hook(f32x4 (&acc)[2][2][4][2], const pg8::Unit& u, int wr, int wc, int fr, int fq) const {
        int row0 = u.pm * 256 + wr * 64 + fr, col0 = u.pn * 256 + wc * 64 + 8 * fq;
        asm volatile("" : "+v"(row0), "+v"(col0));
#pragma unroll
        for (int ai = 0; ai < 2; ++ai)
#pragma unroll
            for (int m = 0; m < 4; ++m) { const size_t r = (size_t)(row0 + ai * 128 + m * 16);
#pragma unroll
                for (int bj = 0; bj < 2; ++bj) { const int c = col0 + bj * 32;
                    const u32x4 gaw = *(const u32x4*)(P + r * INW + C_GA + c), gbw = *(const u32x4*)(P + r * INW + C_GB + c);
                    float ga[8], gb[8]; unpack8(gaw, ga); unpack8(gbw, gb);
#pragma unroll
                    for (int e = 0; e < 4; ++e) {
                        acc[ai][bj][m][0][e] *= (1.f + __expf(-gb[e])) / (1.f + __expf(-ga[e]));
                        acc[ai][bj][m][1][e] *= (1.f + __expf(-gb[4 + e])) / (1.f + __expf(-ga[4 + e])); } }
                __builtin_amdgcn_sched_barrier(0); }
    }
    __device__ __forceinline__ void operator()(const f32x4 (&acc)[2][2][4][2], const pg8::Unit& u, int wr, int wc, int fr, int fq) const {
        const int row0 = u.pm * 256 + wr * 64 + fr, col0 = u.pn * 256 + wc * 64 + 8 * fq;
#pragma unroll
        for (int ai = 0; ai < 2; ++ai)
#pragma unroll
            for (int m = 0; m < 4; ++m) { const size_t r = (size_t)(row0 + ai * 128 + m * 16);
#pragma unroll
                for (int bj = 0; bj < 2; ++bj) { const int c = col0 + bj * 32;
                    const u32x4 gbw = *(const u32x4*)(P + r * INW + C_GB + c); float gb[8]; unpack8(gbw, gb);
                    const f32x4 v0 = acc[ai][bj][m][0], v1 = acc[ai][bj][m][1];
                    float o[8];
#pragma unroll
                    for (int e = 0; e < 4; ++e) { o[e] = sigmoidf_(gb[e]) * v0[e]; o[4 + e] = sigmoidf_(gb[4 + e]) * v1[e]; }
                    u32x4 w; w.x = pg8::cvt_pk_bf16(o[0], o[1]); w.y = pg8::cvt_pk_bf16(o[2], o[3]); w.z = pg8::cvt_pk_bf16(o[4], o[5]); w.w = pg8::cvt_pk_bf16(o[6], o[7]);
                    *(u32x4*)(MG + r * 1024 + c) = w; } }
    }
};
struct EpiOut {
    static constexpr bool PERM = true; static constexpr int HOOK_T = -1;
    const float* x; float* out; const float* gate; float* rowss; int grow0;
    __device__ __forceinline__ void operator()(const f32x4 (&acc)[2][2][4][2], const pg8::Unit& u, int wr, int wc, int fr, int fq) const {
        const int row0 = grow0 + u.pm * 256 + wr * 64 + fr, col0 = u.pn * 256 + wc * 64 + 8 * fq;
#pragma unroll
        for (int ai = 0; ai < 2; ++ai)
#pragma unroll
            for (int m = 0; m < 4; ++m) { const int r = row0 + ai * 128 + m * 16; const int b = r >> 12; float ss = 0.f;
#pragma unroll
                for (int bj = 0; bj < 2; ++bj) { const int c = col0 + bj * 32;
                    const float* gp = gate + b * 3072 + c; const f32x4 g0 = *(const f32x4*)gp, g1 = *(const f32x4*)(gp + 4);
                    const float* xp = x + (size_t)r * 1024 + c; const f32x4 x0 = *(const f32x4*)xp, x1 = *(const f32x4*)(xp + 4);
                    const f32x4 o0 = x0 + g0 * acc[ai][bj][m][0], o1 = x1 + g1 * acc[ai][bj][m][1];
                    ss += (o0[0] * o0[0] + o0[1] * o0[1]) + (o0[2] * o0[2] + o0[3] * o0[3]) + (o1[0] * o1[0] + o1[1] * o1[1]) + (o1[2] * o1[2] + o1[3] * o1[3]);
                    float* op = out + (size_t)r * 1024 + c; *(f32x4*)op = o0; *(f32x4*)(op + 4) = o1; }
                ss += __shfl_xor(ss, 16); ss += __shfl_xor(ss, 32);
                if (fq == 0) atomicAdd(rowss + r, ss); }
    }
};

__device__ __forceinline__ void phase_prep(const Args& a, unsigned char* lds, int vcu, int G, int pass) {
    const int tid = opaque_tid(), lane = tid & 63, wave = tid >> 6;
    unsigned char* ws = a.ws;
    bf16* P = (bf16*)(ws + WS_P);
    if (vcu < NB_PASS * 4) {
        const int bl = vcu >> 2, h = vcu & 3;
        const float* IG = (const float*)(ws + WS_IG); const float* FG = (const float*)(ws + WS_FG);
        float* gsc = (float*)(ws + WS_GSC);
        float* A1 = gsc, *B1 = gsc + MS * 4, *WI = gsc + 2 * MS * 4, *EF = gsc + 3 * MS * 4, *WK = gsc + 4 * MS * 4, *DEC = gsc + 5 * MS * 4;
        float* cg = (float*)lds; float* cp = cg + 64;
        float f[8], ii[8];
#pragma unroll
        for (int q = 0; q < 8; ++q) { const size_t grow = (size_t)pass * MS + bl * SEQ + (wave * 8 + q) * 64 + lane; f[q] = FG[grow * 4 + h]; ii[q] = IG[grow * 4 + h]; }
        float acs[8], b1[8], pm[8];
#pragma unroll
        for (int q = 0; q < 8; ++q) {
            float x = fminf(f[q], 0.f) - log1pf(expf(-fabsf(f[q])));
#pragma unroll
            for (int o = 1; o < 64; o <<= 1) { const float t = __shfl_up(x, o); if (lane >= o) x += t; }
            acs[q] = x; b1[q] = ii[q] - x;
            float m = b1[q];
#pragma unroll
            for (int o = 1; o < 64; o <<= 1) { const float t = __shfl_up(m, o); if (lane >= o) m = fmaxf(m, t); }
            pm[q] = m;
            if (lane == 63) { cg[wave * 8 + q] = x; cp[wave * 8 + q] = m; }
        }
        __syncthreads();
        float m_prev = 0.f, mp[8], Ms8[8];
        for (int j = 0; j < 64; ++j) { const float Ms = fmaxf(m_prev, cp[j]);
#pragma unroll
            for (int q = 0; q < 8; ++q) if (j == wave * 8 + q) { mp[q] = m_prev; Ms8[q] = Ms; }
            m_prev = cg[j] + Ms; }
#pragma unroll
        for (int q = 0; q < 8; ++q) {
            const int j = wave * 8 + q, lrow = bl * SEQ + j * 64 + lane;
            const float mx = fmaxf(mp[q], pm[q]);
            A1[lrow * 4 + h] = -mx; B1[lrow * 4 + h] = b1[q]; WI[lrow * 4 + h] = expf(mp[q] - mx); EF[lrow * 4 + h] = expf(-(acs[q] + mx)); WK[lrow * 4 + h] = expf(b1[q] - Ms8[q]);
            if (lane == 0) DEC[(bl * 64 + j) * 4 + h] = expf(mp[q] - Ms8[q]);
        }
    }
    {
        bf16* XC = (bf16*)(ws + WS_XC);
        const int cg8 = (tid & 127) * 8, rq = tid >> 7;
        float wc[4][8], bc[8];
#pragma unroll
        for (int j = 0; j < 4; ++j)
#pragma unroll
            for (int e = 0; e < 8; ++e) wc[j][e] = a.w_conv[j * 1024 + cg8 + e];
#pragma unroll
        for (int e = 0; e < 8; ++e) bc[e] = a.b_conv[cg8 + e];
        for (int it = vcu; it < MS / 32; it += G) {
            const int r0 = it * 32 + rq * 8, t0 = r0 & (SEQ - 1);
            u32x4 w[11];
#pragma unroll
            for (int k = 0; k < 11; ++k) { const int rr = r0 - 3 + k; w[k] = (k >= 3 || t0 >= 3) ? *(const u32x4*)(P + (size_t)rr * INW + C_XA + cg8) : (u32x4){0u, 0u, 0u, 0u}; }
            float xin[11][8];
#pragma unroll
            for (int k = 0; k < 11; ++k) unpack8(w[k], xin[k]);
#pragma unroll
            for (int k = 0; k < 8; ++k) { float o[8];
#pragma unroll
                for (int e = 0; e < 8; ++e) o[e] = siluf_(bc[e] + wc[0][e] * xin[k][e] + wc[1][e] * xin[k + 1][e] + wc[2][e] * xin[k + 2][e] + wc[3][e] * xin[k + 3][e]);
                u32x4 ov; ov.x = pk2(o[0], o[1]); ov.y = pk2(o[2], o[3]); ov.z = pk2(o[4], o[5]); ov.w = pk2(o[6], o[7]);
                *(u32x4*)(XC + (size_t)(r0 + k) * 1024 + cg8) = ov; }
        }
    }
    {
        const float* ROPE = (const float*)(ws + WS_ROPE) + (size_t)pass * MS * 32;
        const int NU = MS * 48;
        for (int u0 = (vcu * NTHR + tid) * 2; u0 < NU; u0 += G * NTHR * 2) {
            u32x4 w1[2], w2[2]; f32x4 cs[2][2], sn[2][2]; bf16* base[2];
#pragma unroll
            for (int q = 0; q < 2; ++q) { const int u = u0 + q, r = u / 48, k = u - r * 48, hd = k >> 1, half = k & 1;
                base[q] = P + (size_t)r * INW + (hd < 12 ? C_QA + hd * 128 : C_KA + (hd - 12) * 128) + 8 * half;
                w1[q] = *(const u32x4*)base[q]; w2[q] = *(const u32x4*)(base[q] + 16);
                const float* tp = ROPE + (size_t)r * 32 + 8 * half;
                cs[q][0] = *(const f32x4*)tp; cs[q][1] = *(const f32x4*)(tp + 4); sn[q][0] = *(const f32x4*)(tp + 16); sn[q][1] = *(const f32x4*)(tp + 20); }
#pragma unroll
            for (int q = 0; q < 2; ++q) { float x1[8], x2[8], o1[8], o2[8]; unpack8(w1[q], x1); unpack8(w2[q], x2);
#pragma unroll
                for (int e = 0; e < 8; ++e) { const float c_ = cs[q][e >> 2][e & 3], s_ = sn[q][e >> 2][e & 3]; o1[e] = x1[e] * c_ - x2[e] * s_; o2[e] = x2[e] * c_ + x1[e] * s_; }
                u32x4 v1, v2; v1.x = pk2(o1[0], o1[1]); v1.y = pk2(o1[2], o1[3]); v1.z = pk2(o1[4], o1[5]); v1.w = pk2(o1[6], o1[7]);
                v2.x = pk2(o2[0], o2[1]); v2.y = pk2(o2[2], o2[3]); v2.z = pk2(o2[4], o2[5]); v2.w = pk2(o2[6], o2[7]);
                *(u32x4*)base[q] = v1; *(u32x4*)(base[q] + 16) = v2; }
        }
    }
}

__device__ __forceinline__ f32x4 mfma16(bf16x8 a, bf16x8 b, f32x4 c) { return __builtin_amdgcn_mfma_f32_16x16x32_bf16(a, b, c, 0, 0, 0); }

constexpr int TPS = 72;
__device__ __forceinline__ void phase_cprep(const Args& a, unsigned char* lds, int vcu, int G) {
    const int tid = opaque_tid(), lane = tid & 63, wave = __builtin_amdgcn_readfirstlane(tid >> 6);
    const int fr = lane & 15, fq = lane >> 4;
    unsigned char* ws = a.ws;
    const bf16* P = (const bf16*)(ws + WS_P); const bf16* QM = (const bf16*)(ws + WS_QM); const bf16* KM = (const bf16*)(ws + WS_KM);
    const float* gsc = (const float*)(ws + WS_GSC);
    const float* gA1 = gsc, *gB1 = gsc + MS * 4, *gWK = gsc + 4 * MS * 4;
    bf16* SG = (bf16*)(ws + WS_SG); bf16* KTG = (bf16*)(ws + WS_KTG); bf16* VTG = (bf16*)(ws + WS_VTG);
    bf16* KT = (bf16*)lds; bf16* VT = (bf16*)(lds + 256 * TPS * 2);
    bf16* sp = (bf16*)(lds + 2 * 256 * TPS * 2) + wave * 16 * 40;
    const int ti = wave >> 1, tj0 = 2 * (wave & 1);
    for (int ci = vcu; ci < (MS / 64) * 4; ci += G) {
        const int h = ci & 3, t0 = (ci >> 2) * 64;
        bf16x8 qf[8], kf[2][8]; float a1l[4], b1s[2];
#pragma unroll
        for (int ks = 0; ks < 8; ++ks) qf[ks] = *(const bf16x8*)(QM + (size_t)(t0 + 16 * ti + fr) * 1024 + h * 256 + 32 * ks + 8 * fq);
#pragma unroll
        for (int tt = 0; tt < 2; ++tt) {
            if (tj0 + tt <= ti) {
#pragma unroll
                for (int ks = 0; ks < 8; ++ks) kf[tt][ks] = *(const bf16x8*)(KM + (size_t)(t0 + 16 * (tj0 + tt) + fr) * 1024 + h * 256 + 32 * ks + 8 * fq);
            }
            b1s[tt] = gB1[(t0 + 16 * (tj0 + tt) + fr) * 4 + h];
        }
#pragma unroll
        for (int i = 0; i < 4; ++i) a1l[i] = gA1[(t0 + 16 * ti + 4 * fq + i) * 4 + h];
        u32x4 kw[4], vw[4]; float wk[4];
#pragma unroll
        for (int i = 0; i < 4; ++i) { const int c = tid + NTHR * i, l = c & 63, dc = c >> 6;
            kw[i] = *(const u32x4*)(KM + (size_t)(t0 + l) * 1024 + h * 256 + 8 * dc); vw[i] = *(const u32x4*)(P + (size_t)(t0 + l) * INW + C_VA + h * 256 + 8 * dc); wk[i] = gWK[(t0 + l) * 4 + h]; }
        __syncthreads();
#pragma unroll
        for (int i = 0; i < 4; ++i) { const int c = tid + NTHR * i, l = c & 63, dc = c >> 6;
            float kv[8]; unpack8(kw[i], kv);
            bf16* d = KT + (8 * dc) * TPS + l;
#pragma unroll
            for (int e = 0; e < 8; ++e) d[e * TPS] = (bf16)f2bf(kv[e] * wk[i]);
            const u32x4 w = vw[i]; bf16* dv = VT + (8 * dc) * TPS + l;
            dv[0 * TPS] = (bf16)(w.x & 0xffff); dv[1 * TPS] = (bf16)(w.x >> 16); dv[2 * TPS] = (bf16)(w.y & 0xffff); dv[3 * TPS] = (bf16)(w.y >> 16);
            dv[4 * TPS] = (bf16)(w.z & 0xffff); dv[5 * TPS] = (bf16)(w.z >> 16); dv[6 * TPS] = (bf16)(w.w & 0xffff); dv[7 * TPS] = (bf16)(w.w >> 16); }
#pragma unroll
        for (int tt = 0; tt < 2; ++tt) {
            const int tj = tj0 + tt;
            f32x4 sacc = {0.f, 0.f, 0.f, 0.f};
            if (tj <= ti) {
#pragma unroll
                for (int ks = 0; ks < 8; ++ks) sacc = mfma16(qf[ks], kf[tt][ks], sacc);
            }
            const int sidx = 16 * tj + fr;
#pragma unroll
            for (int i = 0; i < 4; ++i) { const int l = 16 * ti + 4 * fq + i;
                float v = 0.f;
                if (sidx <= l) v = sacc[i] * __expf(a1l[i] + b1s[tt]);
                sp[(4 * fq + i) * 40 + 16 * tt + fr] = (bf16)f2bf(v); }
        }
        { const int row = lane >> 2, ch = lane & 3;
          *(u32x4*)(SG + (size_t)ci * 4096 + (16 * ti + row) * 64 + 16 * tj0 + 8 * ch) = *(const u32x4*)(sp + row * 40 + 8 * ch); }
        __syncthreads();
#pragma unroll
        for (int i = 0; i < 4; ++i) { const int p = tid + NTHR * i, blk = p >> 6, ln = p & 63, row = (blk >> 1) * 16 + (ln & 15), ch = (blk & 1) * 4 + (ln >> 4);
            *(u32x4*)(KTG + (size_t)ci * 16384 + p * 8) = *(const u32x4*)(KT + row * TPS + 8 * ch);
            *(u32x4*)(VTG + (size_t)ci * 16384 + p * 8) = *(const u32x4*)(VT + row * TPS + 8 * ch); }
    }
}

constexpr int SA_DEPTH = 5, SA_PATCH = 32 * 32 * 2 + 128;
struct ScanA { const bf16* KTG; const bf16* VTG; const float* gDEC; bf16* CS; float* NS; int bl, h, dblk, eblk, wave, fr, fq; unsigned koff, voff; bool do_den; };
struct ScanAOps { bf16x8 k[2][2], v[2][2]; float decay; };
__device__ __forceinline__ void scana_load(const ScanA& c, int j, ScanAOps& o) {
    const int ci = (c.bl * 64 + j) * 4 + c.h;
    const bf16* kb = c.KTG + (size_t)ci * 16384; const bf16* vb = c.VTG + (size_t)ci * 16384;
#pragma unroll
    for (int dt = 0; dt < 2; ++dt)
#pragma unroll
        for (int k2 = 0; k2 < 2; ++k2) o.k[dt][k2] = *(const bf16x8*)(kb + (c.koff + (unsigned)((dt * 2 + k2) * 512)));
#pragma unroll
    for (int et = 0; et < 2; ++et)
#pragma unroll
        for (int k2 = 0; k2 < 2; ++k2) o.v[et][k2] = *(const bf16x8*)(vb + (c.voff + (unsigned)((et * 2 + k2) * 512)));
    o.decay = c.gDEC[(c.bl * 64 + j) * 4 + c.h];
}
__device__ __forceinline__ void scana_step(const ScanA& c, unsigned char* lds, int j, f32x4 (&Cacc)[2][2], f32x4 (&Nacc)[2], const ScanAOps& o, const bf16x8 ones) {
    const int ci = (c.bl * 64 + j) * 4 + c.h;
    unsigned char* patch = lds + c.wave * SA_PATCH;
    const int lane = c.fq * 16 + c.fr;
#pragma unroll
    for (int dt = 0; dt < 2; ++dt) {
#pragma unroll
        for (int et = 0; et < 2; ++et) { const f32x4 cc = Cacc[dt][et]; u32x2 w; w.x = pk2(cc[0], cc[1]); w.y = pk2(cc[2], cc[3]);
            *(u32x2*)(patch + (16 * et + c.fr) * 64 + (16 * dt + 4 * c.fq) * 2) = w; }
        if (c.do_den && c.fr == 0) *(f32x4*)(patch + 2048 + (16 * dt + 4 * c.fq) * 4) = Nacc[dt];
    }
    { bf16* cs = c.CS + (size_t)ci * 65536 + (c.eblk * 8 + c.dblk) * 1024;
#pragma unroll
      for (int k = 0; k < 2; ++k) *(u32x4*)(cs + k * 512 + lane * 8) = *(const u32x4*)(patch + k * 1024 + lane * 16);
      if (c.do_den && lane < 8) *(f32x4*)(c.NS + (size_t)ci * 256 + c.dblk * 32 + lane * 4) = *(const f32x4*)(patch + 2048 + lane * 16); }
#pragma unroll
    for (int dt = 0; dt < 2; ++dt) {
#pragma unroll
        for (int et = 0; et < 2; ++et) {
            f32x4 cc = Cacc[dt][et] * o.decay;
#pragma unroll
            for (int k2 = 0; k2 < 2; ++k2) cc = mfma16(o.k[dt][k2], o.v[et][k2], cc);
            Cacc[dt][et] = cc;
        }
        if (c.do_den) {
            f32x4 cc = Nacc[dt] * o.decay;
#pragma unroll
            for (int k2 = 0; k2 < 2; ++k2) cc = mfma16(o.k[dt][k2], ones, cc);
            Nacc[dt] = cc;
        }
    }
}
__device__ __forceinline__ void scana_item(const Args& a, unsigned char* lds, int item) {
    const int tid = opaque_tid(), lane = tid & 63;
    unsigned char* ws = a.ws;
    ScanA c;
    c.wave = __builtin_amdgcn_readfirstlane(tid >> 6); c.fr = lane & 15; c.fq = lane >> 4;
    item = __builtin_amdgcn_readfirstlane(item);
    c.bl = item >> 5; c.h = (item >> 3) & 3; c.dblk = 2 * ((item >> 1) & 3) + (c.wave >> 2); c.eblk = 4 * (item & 1) + (c.wave & 3); c.do_den = (c.eblk == 0);
    c.koff = (unsigned)((4 * c.dblk) * 512 + lane * 8); c.voff = (unsigned)((4 * c.eblk) * 512 + lane * 8);
    c.KTG = (const bf16*)(ws + WS_KTG); c.VTG = (const bf16*)(ws + WS_VTG); c.gDEC = (const float*)(ws + WS_GSC) + 5 * MS * 4;
    c.CS = (bf16*)(ws + WS_CS); c.NS = (float*)(ws + WS_NS);
    f32x4 Cacc[2][2], Nacc[2];
#pragma unroll
    for (int x = 0; x < 2; ++x) { Nacc[x] = (f32x4){0.f, 0.f, 0.f, 0.f};
#pragma unroll
        for (int y = 0; y < 2; ++y) Cacc[x][y] = (f32x4){0.f, 0.f, 0.f, 0.f}; }
    bf16x8 ones;
    { const short ov = (c.fr == 0) ? (short)0x3F80 : (short)0;
#pragma unroll
      for (int e = 0; e < 8; ++e) ones[e] = ov; }
    ScanAOps o0, o1, o2, o3, o4;
    scana_load(c, 0, o0); scana_load(c, 1, o1); scana_load(c, 2, o2); scana_load(c, 3, o3); scana_load(c, 4, o4);
#define SA_STEP(jj, ob) do { scana_step(c, lds, (jj), Cacc, Nacc, ob, ones); __builtin_amdgcn_sched_barrier(0); scana_load(c, (jj) + SA_DEPTH < 64 ? (jj) + SA_DEPTH : 63, ob); __builtin_amdgcn_sched_barrier(0); } while (0)
#pragma nounroll
    for (int j = 0; j < 60; j += 5) { SA_STEP(j, o0); SA_STEP(j + 1, o1); SA_STEP(j + 2, o2); SA_STEP(j + 3, o3); SA_STEP(j + 4, o4); }
    SA_STEP(60, o0); SA_STEP(61, o1); SA_STEP(62, o2); SA_STEP(63, o3);
#undef SA_STEP
    asm volatile("s_waitcnt vmcnt(0)" ::: "memory");
}

constexpr int AKS = 136;
constexpr int L_AK = 0, L_AV = L_AK + 128 * AKS * 2, L_AP = L_AV + 128 * AKS * 2, L_ATT_END = L_AP + 8 * 16 * AKS * 2;
static_assert(L_ATT_END <= 131072, "attn lds");

__device__ __forceinline__ void attn_item(const Args& a, unsigned char* lds, int item) {
    const int tid = opaque_tid(), lane = tid & 63, wave = __builtin_amdgcn_readfirstlane(tid >> 6);
    const int fr = lane & 15, fq = lane >> 4;
    unsigned char* ws = a.ws;
    const int blk = item & 31, hh = (item >> 5) & 3, bl = (item >> 7) & 3, g = item >> 9;
    const int dil = g == 0 ? 1 : g == 1 ? 4 : 16, nb = 32 / dil;
    const int r = blk / nb, n = blk % nb;
    const bf16* P = (const bf16*)(ws + WS_P);
    const int H = 4 * g + hh;
    const bf16* Qb = P + C_QA + H * 128; const bf16* Kb = P + C_KA + H * 128; const bf16* Vb = P + C_VT + H * 128;
    bf16* Ks = (bf16*)(lds + L_AK); bf16* VTs = (bf16*)(lds + L_AV); bf16* Pw = (bf16*)(lds + L_AP) + wave * 16 * AKS;
    const int rowbase = bl * SEQ + r;
    bf16x8 qf[4];
    { const size_t qrow = (size_t)(rowbase + (128 * n + 16 * wave + fr) * dil);
#pragma unroll
      for (int ks = 0; ks < 4; ++ks) qf[ks] = *(const bf16x8*)(Qb + qrow * INW + 32 * ks + 8 * fq); }
    f32x4 O[8];
#pragma unroll
    for (int i = 0; i < 8; ++i) O[i] = (f32x4){0.f, 0.f, 0.f, 0.f};
    float mrow = -INFINITY, lrow = 0.f;
    const float scale = 0.08838834764831845f;
#define ATT_BAR() do { asm volatile("s_waitcnt lgkmcnt(0)" ::: "memory"); __builtin_amdgcn_s_barrier(); asm volatile("" ::: "memory"); } while (0)
    const int half0 = (n == 0 ? 1 : 0);
    u32x4 kreg[4], vreg[4];
#pragma unroll
    for (int i = 0; i < 4; ++i) { const int c = tid + NTHR * i, key = c >> 4, dc = c & 15;
        const size_t krow = (size_t)(rowbase + (128 * (n - 1 + half0) + key) * dil);
        kreg[i] = *(const u32x4*)(Kb + krow * INW + 8 * dc); vreg[i] = *(const u32x4*)(Vb + krow * INW + 8 * dc); }
    for (int half = half0; half < 2; ++half) {
        ATT_BAR();
#pragma unroll
        for (int i = 0; i < 4; ++i) { const int c = tid + NTHR * i, key = c >> 4, dc = c & 15;
            *(u32x4*)(Ks + key * AKS + 8 * dc) = kreg[i]; *(u32x4*)(VTs + key * AKS + 8 * dc) = vreg[i]; }
        if (half == 0) {
#pragma unroll
            for (int i = 0; i < 4; ++i) { const int c = tid + NTHR * i, key = c >> 4, dc = c & 15;
                const size_t krow = (size_t)(rowbase + (128 * n + key) * dil);
                kreg[i] = *(const u32x4*)(Kb + krow * INW + 8 * dc); vreg[i] = *(const u32x4*)(Vb + krow * INW + 8 * dc); }
        }
        ATT_BAR();
        f32x4 S[8];
        const int p = 16 * wave + fr;
        float mx = -INFINITY;
#pragma unroll
        for (int kt = 0; kt < 8; ++kt) {
            const bool act = half == 0 ? (kt >= wave) : (kt <= wave);
            f32x4 sacc = {0.f, 0.f, 0.f, 0.f};
            if (act) {
#pragma unroll
                for (int ks = 0; ks < 4; ++ks) { const bf16x8 kf = *(const bf16x8*)(Ks + (16 * kt + fr) * AKS + 32 * ks + 8 * fq); sacc = mfma16(kf, qf[ks], sacc); }
#pragma unroll
                for (int i = 0; i < 4; ++i) { const int kk = 16 * kt + 4 * fq + i; const bool ok = half == 0 ? (kk >= p) : (kk <= p);
                    const float v = ok ? sacc[i] * scale : -INFINITY; sacc[i] = v; mx = fmaxf(mx, v); }
            }
            S[kt] = sacc;
        }
        mx = fmaxf(mx, __shfl_xor(mx, 16)); mx = fmaxf(mx, __shfl_xor(mx, 32));
        const float mn = fmaxf(mrow, mx), alpha = __expf(mrow - mn); mrow = mn;
        float rs = 0.f;
        unsigned pk[8][2];
#pragma unroll
        for (int kt = 0; kt < 8; ++kt) {
            const bool act = half == 0 ? (kt >= wave) : (kt <= wave);
            if (act) { const float p0 = __expf(S[kt][0] - mn), p1 = __expf(S[kt][1] - mn), p2 = __expf(S[kt][2] - mn), p3 = __expf(S[kt][3] - mn);
                rs += (p0 + p1) + (p2 + p3); pk[kt][0] = pk2(p0, p1); pk[kt][1] = pk2(p2, p3); }
            else { pk[kt][0] = 0u; pk[kt][1] = 0u; }
        }
        rs += __shfl_xor(rs, 16); rs += __shfl_xor(rs, 32);
        lrow = lrow * alpha + rs;
        float al[4];
#pragma unroll
        for (int i = 0; i < 4; ++i) al[i] = __shfl(alpha, 4 * fq + i);
#pragma unroll
        for (int dtile = 0; dtile < 8; ++dtile)
#pragma unroll
            for (int i = 0; i < 4; ++i) O[dtile][i] *= al[i];
#pragma unroll
        for (int ks = 0; ks < 4; ++ks) {
            const bool act = half == 0 ? (2 * ks + 1 >= wave) : (2 * ks <= wave);
            if (act) {
                u32x4 pw; pw.x = pk[2 * ks][0]; pw.y = pk[2 * ks][1]; pw.z = pk[2 * ks + 1][0]; pw.w = pk[2 * ks + 1][1];
                const bf16x8 pa = __builtin_bit_cast(bf16x8, pw);
#pragma unroll
                for (int dtile = 0; dtile < 8; ++dtile) {
                    const bf16* vp = VTs + (32 * ks + 4 * fq + (fr >> 2)) * AKS + 16 * dtile + 4 * (fr & 3);
                    const s16x4 v0 = __builtin_amdgcn_ds_read_tr16_b64_v4i16((__attribute__((address_space(3))) s16x4*)(vp));
                    const s16x4 v1 = __builtin_amdgcn_ds_read_tr16_b64_v4i16((__attribute__((address_space(3))) s16x4*)(vp + 16 * AKS));
                    bf16x8 vb; vb[0] = v0[0]; vb[1] = v0[1]; vb[2] = v0[2]; vb[3] = v0[3]; vb[4] = v1[0]; vb[5] = v1[1]; vb[6] = v1[2]; vb[7] = v1[3];
                    O[dtile] = mfma16(pa, vb, O[dtile]); }
            }
        }
    }
    bf16* AO = (bf16*)(ws + WS_AO) + (size_t)g * MS * 512; float* LSE = (float*)(ws + WS_LSE) + (size_t)g * MS * 4;
    {
        const float inv_l = 1.f / lrow;
        float il[4];
#pragma unroll
        for (int i = 0; i < 4; ++i) il[i] = __shfl(inv_l, 4 * fq + i);
#pragma unroll
        for (int dtile = 0; dtile < 8; ++dtile)
#pragma unroll
            for (int i = 0; i < 4; ++i) Pw[(4 * fq + i) * AKS + 16 * dtile + fr] = (bf16)f2bf(O[dtile][i] * il[i]);
        if (fq == 0) { const size_t row = (size_t)(rowbase + (128 * n + 16 * wave + fr) * dil); LSE[row * 4 + hh] = mrow + logf(lrow); }
#pragma unroll
        for (int k = 0; k < 4; ++k) { const int c = lane + 64 * k, q = c >> 4, ch = c & 15;
            const size_t row = (size_t)(rowbase + (128 * n + 16 * wave + q) * dil);
            *(u32x4*)(AO + row * 512 + hh * 128 + 8 * ch) = *(const u32x4*)(Pw + q * AKS + 8 * ch); }
    }
    __syncthreads();
}

constexpr int N_SCAN_ITEMS = NB_PASS * 32, N_ATT_ITEMS = 3 * NB_PASS * 4 * 32;
#ifndef PROBE_ATT_REP
#define PROBE_ATT_REP 1
#endif
struct XcdBarrier;
__device__ __forceinline__ void xcd_barrier(const XcdBarrier& b);
__device__ __forceinline__ void phase_mix(const Args& a, unsigned char* lds, int pass, const XcdBarrier* pbar) {
    unsigned* qctr = (unsigned*)(a.ws + WS_CTL) + CW_QCTR + 64 * pass;
    volatile int* slot = (volatile int*)(lds + 131072 + 1024);
#ifdef PROBE_SPLIT
    for (int it = blockIdx.x; it < N_SCAN_ITEMS; it += gridDim.x) scana_item(a, lds, it);
    xcd_barrier(*pbar);
    for (int rep = 0; rep < PROBE_ATT_REP; ++rep)
    for (int it = blockIdx.x; it < N_ATT_ITEMS; it += gridDim.x) attn_item(a, lds, it);
#else
    for (;;) {
        __syncthreads();
        if (opaque_tid() == 0) *slot = (int)atomicAdd(qctr, 1u);
        __syncthreads();
        const int item = *slot;
        if (item >= N_SCAN_ITEMS + N_ATT_ITEMS) break;
        if (item < N_SCAN_ITEMS) scana_item(a, lds, item); else attn_item(a, lds, item - N_SCAN_ITEMS);
    }
#endif
}

constexpr int QS_STRIDE = 264, SS_STRIDE = 72;
constexpr int L_QS = 0, L_SS = L_QS + 64 * QS_STRIDE * 2, L_DENL = L_SS + 64 * SS_STRIDE * 2, L_WIL = L_DENL + 256, L_NUM = L_WIL + 256, L_SB_END = L_NUM + 64 * QS_STRIDE * 2;
static_assert(L_SB_END <= 131072, "scan-B lds");
__device__ __forceinline__ void scanb_item(const Args& a, unsigned char* lds, int ch) {
    const int tid = opaque_tid(), lane = tid & 63, wave = __builtin_amdgcn_readfirstlane(tid >> 6), fr = lane & 15, fq = lane >> 4;
    unsigned char* ws = a.ws;
    const int h = ch & 3, t0 = (ch >> 2) * 64;
    const bf16* P = (const bf16*)(ws + WS_P); const bf16* XC = (const bf16*)(ws + WS_XC); const bf16* QM = (const bf16*)(ws + WS_QM);
    const bf16* SG = (const bf16*)(ws + WS_SG); const bf16* VTG = (const bf16*)(ws + WS_VTG); const bf16* CS = (const bf16*)(ws + WS_CS); const float* NS = (const float*)(ws + WS_NS);
    const float* gWI = (const float*)(ws + WS_GSC) + 2 * MS * 4; const float* gEF = (const float*)(ws + WS_GSC) + 3 * MS * 4;
    bf16* UM = (bf16*)(ws + WS_ACAT);
    bf16* QS = (bf16*)(lds + L_QS); bf16* SS = (bf16*)(lds + L_SS); float* DENL = (float*)(lds + L_DENL); float* WIL = (float*)(lds + L_WIL); bf16* NUMS = (bf16*)(lds + L_NUM);
    const int c = h * 256 + 4 * lane;
    u32x2 owr[8], zwr[8], xwr[8];
#pragma unroll
    for (int rr = 0; rr < 8; ++rr) { const size_t r = (size_t)(t0 + 8 * wave + rr);
        owr[rr] = *(const u32x2*)(P + r * INW + C_OA + c); zwr[rr] = *(const u32x2*)(P + r * INW + C_ZA + c); xwr[rr] = *(const u32x2*)(XC + r * 1024 + c); }
    __syncthreads();
#pragma unroll
    for (int i = 0; i < 4; ++i) { const int c = tid + NTHR * i, row = c >> 5, cc = c & 31;
        *(u32x4*)(QS + row * QS_STRIDE + 8 * cc) = *(const u32x4*)(QM + (size_t)(t0 + row) * 1024 + h * 256 + 8 * cc); }
    { const int row = tid >> 3, cc = tid & 7; *(u32x4*)(SS + row * SS_STRIDE + 8 * cc) = *(const u32x4*)(SG + (size_t)ch * 4096 + row * 64 + 8 * cc); }
    if (tid < 64) WIL[tid] = gWI[(t0 + tid) * 4 + h];
    bf16x8 cb[2][8], vt[2][2];
#pragma unroll
    for (int t = 0; t < 2; ++t) {
#pragma unroll
        for (int ks = 0; ks < 8; ++ks) cb[t][ks] = *(const bf16x8*)(CS + (size_t)ch * 65536 + (wave * 8 + ks) * 1024 + (16 * t + fr) * 32 + 8 * fq);
#pragma unroll
        for (int k2 = 0; k2 < 2; ++k2) vt[t][k2] = *(const bf16x8*)(VTG + (size_t)ch * 16384 + (((2 * wave + t) * 2 + k2) * 64 + lane) * 8);
    }
    __syncthreads();
#pragma unroll
    for (int lt = 0; lt < 4; ++lt) {
        bf16x8 qf[8], sf[2];
#pragma unroll
        for (int ks = 0; ks < 8; ++ks) qf[ks] = *(const bf16x8*)(QS + (16 * lt + fr) * QS_STRIDE + 32 * ks + 8 * fq);
#pragma unroll
        for (int k2 = 0; k2 < 2; ++k2) sf[k2] = *(const bf16x8*)(SS + (16 * lt + fr) * SS_STRIDE + 32 * k2 + 8 * fq);
#pragma unroll
        for (int t = 0; t < 2; ++t) {
            f32x4 a1 = {0.f, 0.f, 0.f, 0.f}, a2 = {0.f, 0.f, 0.f, 0.f}, a3 = {0.f, 0.f, 0.f, 0.f};
#pragma unroll
            for (int k2 = 0; k2 < 2; ++k2) a1 = mfma16(sf[k2], vt[t][k2], a1);
#pragma unroll
            for (int ks = 0; ks < 8; ks += 2) { a2 = mfma16(qf[ks], cb[t][ks], a2); a3 = mfma16(qf[ks + 1], cb[t][ks + 1], a3); }
#pragma unroll
            for (int i = 0; i < 4; ++i) NUMS[(16 * lt + 4 * fq + i) * QS_STRIDE + 32 * wave + 16 * t + fr] = (bf16)f2bf(a1[i] + WIL[16 * lt + 4 * fq + i] * (a2[i] + a3[i]));
        }
    }
    if (wave == 0) {
        bf16x8 nb[8], ones;
        { const short ov = (fr == 0) ? (short)0x3F80 : (short)0;
#pragma unroll
          for (int e = 0; e < 8; ++e) ones[e] = ov; }
#pragma unroll
        for (int ks = 0; ks < 8; ++ks) { const f32x4 n0 = *(const f32x4*)(NS + (size_t)ch * 256 + 32 * ks + 8 * fq), n1 = *(const f32x4*)(NS + (size_t)ch * 256 + 32 * ks + 8 * fq + 4);
            u32x4 w; w.x = pk2(n0[0], n0[1]); w.y = pk2(n0[2], n0[3]); w.z = pk2(n1[0], n1[1]); w.w = pk2(n1[2], n1[3]);
            if (fr != 0) w = (u32x4){0u, 0u, 0u, 0u};
            nb[ks] = __builtin_bit_cast(bf16x8, w); }
#pragma unroll
        for (int lt = 0; lt < 4; ++lt) {
            f32x4 a1 = {0.f, 0.f, 0.f, 0.f}, a2 = {0.f, 0.f, 0.f, 0.f};
#pragma unroll
            for (int k2 = 0; k2 < 2; ++k2) { const bf16x8 sf = *(const bf16x8*)(SS + (16 * lt + fr) * SS_STRIDE + 32 * k2 + 8 * fq); a1 = mfma16(sf, ones, a1); }
#pragma unroll
            for (int ks = 0; ks < 8; ++ks) { const bf16x8 qf = *(const bf16x8*)(QS + (16 * lt + fr) * QS_STRIDE + 32 * ks + 8 * fq); a2 = mfma16(qf, nb[ks], a2); }
            if (fr == 0) {
#pragma unroll
                for (int i = 0; i < 4; ++i) { const int l = 16 * lt + 4 * fq + i; const float den = a1[i] + WIL[l] * a2[i]; DENL[l] = 1.f / fmaxf(fabsf(den), gEF[(t0 + l) * 4 + h]); } }
        }
    }
    __syncthreads();
    const f32x4 gh = *(const f32x4*)(a.g_head + c), sk = *(const f32x4*)(a.skip + c);
#pragma unroll
    for (int rr = 0; rr < 8; ++rr) {
        const int l = 8 * wave + rr; const size_t r = (size_t)(t0 + l);
        const u32x2 hw = *(const u32x2*)(NUMS + l * QS_STRIDE + 4 * lane);
        const u32x2 ow = owr[rr], zw = zwr[rr], xw = xwr[rr];
        const float rd = DENL[l];
        float hm[4] = {sigmoidf_(bflo(ow.x)) * bflo(hw.x) * rd, sigmoidf_(bfhi(ow.x)) * bfhi(hw.x) * rd, sigmoidf_(bflo(ow.y)) * bflo(hw.y) * rd, sigmoidf_(bfhi(ow.y)) * bfhi(hw.y) * rd};
        float ss = (hm[0] * hm[0] + hm[1] * hm[1]) + (hm[2] * hm[2] + hm[3] * hm[3]);
        ss = wave_sum(ss);
        const float rinv = 1.f / sqrtf(ss * (1.f / 256.f) + EPS);
        const float xc[4] = {bflo(xw.x), bfhi(xw.x), bflo(xw.y), bfhi(xw.y)}, za[4] = {bflo(zw.x), bfhi(zw.x), bflo(zw.y), bfhi(zw.y)};
        float o[4];
#pragma unroll
        for (int e = 0; e < 4; ++e) o[e] = (hm[e] * rinv * gh[e] + sk[e] * xc[e]) * siluf_(za[e]);
        u32x2 ov; ov.x = pk2(o[0], o[1]); ov.y = pk2(o[2], o[3]);
        *(u32x2*)(UM + r * 1536 + c) = ov;
    }
}

__device__ __forceinline__ void phase_post(const Args& a, unsigned char* lds, int vcu, int G) {
    for (int ch = vcu; ch < (MS / 64) * 4; ch += G) scanb_item(a, lds, ch);
    const int tid = opaque_tid(), lane = tid & 63, wave = tid >> 6;
    unsigned char* ws = a.ws;
    const bf16* P = (const bf16*)(ws + WS_P);
    const bf16* AO = (const bf16*)(ws + WS_AO); const float* LSE = (const float*)(ws + WS_LSE); bf16* UA = (bf16*)(ws + WS_ACAT) + 1024;
    const int hh = lane >> 4, c = hh * 128 + 8 * (lane & 15);
    for (int r0 = 2 * (vcu * NWAVES + wave); r0 < MS; r0 += 2 * G * NWAVES) {
        u32x4 o0[2], o1[2], o2[2], zb[2]; float l0[2], l1[2], l2[2];
#pragma unroll
        for (int q = 0; q < 2; ++q) { const size_t r = (size_t)(r0 + q);
            o0[q] = *(const u32x4*)(AO + r * 512 + c); o1[q] = *(const u32x4*)(AO + ((size_t)MS + r) * 512 + c); o2[q] = *(const u32x4*)(AO + ((size_t)2 * MS + r) * 512 + c);
            zb[q] = *(const u32x4*)(P + r * INW + C_ZB + c);
            l0[q] = LSE[r * 4 + hh]; l1[q] = LSE[((size_t)MS + r) * 4 + hh]; l2[q] = LSE[((size_t)2 * MS + r) * 4 + hh]; }
#pragma unroll
        for (int q = 0; q < 2; ++q) {
            const float mx = fmaxf(l0[q], fmaxf(l1[q], l2[q]));
            float w0 = __expf(l0[q] - mx), w1 = __expf(l1[q] - mx), w2 = __expf(l2[q] - mx); const float inv = 1.f / (w0 + w1 + w2); w0 *= inv; w1 *= inv; w2 *= inv;
            float f0[8], f1[8], f2[8], z[8], o[8]; unpack8(o0[q], f0); unpack8(o1[q], f1); unpack8(o2[q], f2); unpack8(zb[q], z);
#pragma unroll
            for (int e = 0; e < 8; ++e) o[e] = (w0 * f0[e] + w1 * f1[e] + w2 * f2[e]) * siluf_(z[e]);
            u32x4 ov; ov.x = pk2(o[0], o[1]); ov.y = pk2(o[2], o[3]); ov.z = pk2(o[4], o[5]); ov.w = pk2(o[6], o[7]);
            *(u32x4*)(UA + (size_t)(r0 + q) * 1536 + c) = ov;
        }
    }
}

__device__ __forceinline__ void phase_norm(const Args& a, int vcu, int G) {
    const int tid = opaque_tid(), lane = tid & 63, wave = tid >> 6;
    const float* rowss = (const float*)(a.ws + WS_CTL) + CW_ROWSS;
    for (int r = vcu * NWAVES + wave; r < MALL; r += G * NWAVES) {
        const float rinv = 1.f / sqrtf(rowss[r] * (1.f / DM) + EPS);
        f32x4* o = (f32x4*)(a.out + (size_t)r * DM) + lane;
#pragma unroll
        for (int j = 0; j < 4; ++j) { const f32x4 gf = *((const f32x4*)a.g_final + lane + 64 * j); o[64 * j] = o[64 * j] * rinv * gf; }
    }
}


#define LAS __attribute__((address_space(3)))
#define XB_TMO      128
#define XB_XCNT(j)  (256  + 64 * (j))
#define XB_XSUB(j)  (1280 + 64 * (j))
#define XB_XGEN(j)  (2304 + 64 * (j))
#define XB_TOP      3328
#define XB_TOPGEN   3392
#define XCD_BAR_WORDS 3456
#define XB_SPIN_CAP (1u << 22)
constexpr int CW_BAR = 4096;
__device__ __forceinline__ unsigned xb_ld(unsigned* p)              { return __hip_atomic_load(p, __ATOMIC_RELAXED, __HIP_MEMORY_SCOPE_AGENT); }
__device__ __forceinline__ unsigned xb_add(unsigned* p, unsigned v) { return __hip_atomic_fetch_add(p, v, __ATOMIC_RELAXED, __HIP_MEMORY_SCOPE_AGENT); }
__device__ __forceinline__ unsigned xb_xcc_id() { return (unsigned)__builtin_amdgcn_s_getreg((3 << 11) | 20) & 0xFu; }
#define XB_SPIN(cond, bar) do { unsigned _sp = 0; while (cond) { __builtin_amdgcn_s_sleep(1); \
    if ((++_sp & 255u) == 0u) { if (xb_ld(&(bar)[XB_TMO])) break; if (_sp > XB_SPIN_CAP) { atomicAdd(&(bar)[XB_TMO], 1u); break; } } } } while (0)
struct XcdBarrier { unsigned* bar; unsigned x; volatile LAS unsigned* st; };
__device__ __forceinline__ XcdBarrier xcd_barrier_post(unsigned* bar, volatile LAS unsigned* st) {
    XcdBarrier b; b.bar = bar; b.x = xb_xcc_id(); b.st = st;
    if (threadIdx.x == 0) (void)xb_add(&bar[XB_XCNT(b.x)], 1u);
    return b;
}
__device__ __forceinline__ void xcd_barrier_complete(unsigned* bar, unsigned x, unsigned& nloc, unsigned& nx) {
    const unsigned G = gridDim.x * gridDim.y * gridDim.z;
    unsigned sum, cnt, mine, sp = 0u;
    for (;;) {
        sum = 0u; cnt = 0u; mine = 0u;
#pragma unroll
        for (unsigned j = 0; j < 16; ++j) { const unsigned c = xb_ld(&bar[XB_XCNT(j)]); sum += c; cnt += (c > 0u) ? 1u : 0u; mine = (j == x) ? c : mine; }
        if (sum == G) break;
        __builtin_amdgcn_s_sleep(1);
        if ((++sp & 255u) == 0u) { if (xb_ld(&bar[XB_TMO])) break; if (sp > XB_SPIN_CAP) { atomicAdd(&bar[XB_TMO], 1u); break; } }
    }
    nloc = mine > 0u ? mine : 1u; nx = cnt > 0u ? cnt : 1u;
}
__device__ __forceinline__ void xcd_barrier(const XcdBarrier& b) {
    asm volatile("s_waitcnt vmcnt(0)" ::: "memory");
    __syncthreads();
    if (threadIdx.x == 0) {
        unsigned* bar = b.bar;
        __builtin_amdgcn_s_waitcnt(0);
        unsigned nloc = b.st[0], nx = b.st[1];
        if (nloc == 0u) { xcd_barrier_complete(bar, b.x, nloc, nx); b.st[0] = nloc; b.st[1] = nx; }
        const unsigned old = xb_add(&bar[XB_XSUB(b.x)], 1u);
        const unsigned gen = old / nloc;
        if (old + 1u == (gen + 1u) * nloc) {
            __builtin_amdgcn_fence(__ATOMIC_RELEASE, "agent");
            asm volatile("s_waitcnt vmcnt(0)" ::: "memory");
            const unsigned og = xb_add(&bar[XB_TOP], 1u);
            const unsigned tg = og / nx;
            if (og + 1u == (tg + 1u) * nx) xb_add(&bar[XB_TOPGEN], 1u);
            else XB_SPIN(xb_ld(&bar[XB_TOPGEN]) == tg, bar);
            __builtin_amdgcn_fence(__ATOMIC_ACQUIRE, "agent");
            xb_add(&bar[XB_XGEN(b.x)], 1u);
            asm volatile("s_waitcnt vmcnt(0)" ::: "memory");
        } else {
            XB_SPIN(xb_ld(&bar[XB_XGEN(b.x)]) == gen, bar);
            __builtin_amdgcn_fence(__ATOMIC_ACQUIRE, "agent");
            asm volatile("s_waitcnt vmcnt(0)" ::: "memory");
        }
    }
    __syncthreads();
}

constexpr int PH_PER_PASS = 8, PH_TOTAL = 2 + PH_PER_PASS * NPASS + 1;
#define PROBE_KIND_OF(k) ((k) == 0 ? K_INPROJ : (k) == 1 ? K_PREP : (k) == 2 ? K_QK : (k) == 3 ? K_CPREP : (k) == 4 ? K_MIX : (k) == 5 ? K_POST : (k) == 6 ? K_OUT1 : K_OUT2)
enum { K_PROLOGUE = 0, K_H = 1, K_INPROJ = 2, K_PREP = 3, K_QK = 4, K_MIX = 5, K_POST = 6, K_OUT1 = 7, K_OUT2 = 8, K_NORM = 9, K_CPREP = 10 };

__device__ __forceinline__ Args fresh_args() {
    Args a{};
#if defined(__HIP_DEVICE_COMPILE__)
    typedef const __attribute__((address_space(4))) unsigned long long* KP;
    KP q = (KP)__builtin_amdgcn_kernarg_segment_ptr(); asm volatile("" : "+s"(q));
    static_assert(sizeof(Args) == 22 * 8, "Args layout");
    unsigned long long w[22];
#pragma unroll
    for (int i = 0; i < 22; ++i) w[i] = q[i];
    __builtin_memcpy(&a, w, sizeof(Args));
#endif
    return a;
}
template <int KIND>
__device__ __forceinline__ void run_phase(const Args& args, unsigned char* lds, int pass, const XcdBarrier* pbar = nullptr) {
    const int G = gridDim.x; const int bx = blockIdx.x;
    const int vcu = (G % 8 == 0) ? (bx % 8) * (G / 8) + bx / 8 : bx;
    unsigned char* ws = args.ws;
    PG8_LAS unsigned char* lds3 = (PG8_LAS unsigned char*)lds;
    if constexpr (KIND == K_PROLOGUE) phase_prologue(args, lds, vcu, G);
    else if constexpr (KIND == K_H) phase_h(args, lds, vcu, G);
    else if constexpr (KIND == K_NORM) phase_norm(args, vcu, G);
    else if constexpr (KIND == K_INPROJ) {
        pg8::Gemm<1024, 1024, 1024> g{(const bf16*)(ws + WS_H) + (size_t)pass * MS * 1024, (const bf16*)(ws + WS_WIN)};
        pg8::StaticOrder S; S.init(MS, INW, G, bx);
        EpiProj E{(bf16*)(ws + WS_P)};
        pg8::gemm_phase<EpiProj, pg8::StaticOrder, true, true>(lds3, g, S, E);
    } else if constexpr (KIND == K_PREP) phase_prep(args, lds, vcu, G, pass);
    else if constexpr (KIND == K_QK) {
        pg8::Gemm<1024, 256, 256, 512, 512 * 256 * 2> g{(const bf16*)(ws + WS_XC), (const bf16*)(ws + WS_WQK)};
        pg8::GroupOrder S; S.init(MS, G, bx);
        EpiQK E{(bf16*)(ws + WS_QM), (bf16*)(ws + WS_KM)};
        pg8::gemm_phase<EpiQK, pg8::GroupOrder, true, true>(lds3, g, S, E);
    } else if constexpr (KIND == K_CPREP) phase_cprep(args, lds, vcu, G);
    else if constexpr (KIND == K_MIX) phase_mix(args, lds, pass, pbar);
    else if constexpr (KIND == K_POST) phase_post(args, lds, vcu, G);
    else if constexpr (KIND == K_OUT1) {
        pg8::Gemm<1536, 1536, 1536> g{(const bf16*)(ws + WS_ACAT), (const bf16*)(ws + WS_WOM)};
        pg8::StaticOrder S; S.init(MS, 1024, G, bx);
        EpiMerge E{(const bf16*)(ws + WS_P), (bf16*)(ws + WS_MG)};
        pg8::gemm_phase<EpiMerge, pg8::StaticOrder, true, true>(lds3, g, S, E);
    } else if constexpr (KIND == K_OUT2) {
        pg8::Gemm<1024, 1024, 1024> g{(const bf16*)(ws + WS_MG), (const bf16*)(ws + WS_WO)};
        pg8::StaticOrder S; S.init(MS, 1024, G, bx);
        EpiOut E{args.x, args.out, (const float*)(ws + WS_MOD) + 2048, (float*)(ws + WS_CTL) + CW_ROWSS, pass * MS};
        pg8::gemm_phase<EpiOut, pg8::StaticOrder, true, true>(lds3, g, S, E);
    }
}

#if !MK_ONE_LAUNCH
template <int KIND>
__global__ void __launch_bounds__(NTHR, 2) k_phase(Args args) {
    extern __shared__ __attribute__((aligned(16))) unsigned char lds[];
    run_phase<KIND>(args, lds, args.ph_lo);
}
#else
__global__ void __launch_bounds__(NTHR, 2) mk_fwd(Args args) {
    extern __shared__ __attribute__((aligned(16))) unsigned char lds[];
    volatile LAS unsigned* misc = (volatile LAS unsigned*)((LAS unsigned char*)lds + 131072 + 2048);
    if (threadIdx.x < 16) misc[threadIdx.x] = 0u;
    __syncthreads();
    XcdBarrier bar = xcd_barrier_post((unsigned*)(args.ws + WS_CTL) + CW_BAR, misc + 8);
#ifdef PROBE_TMASK
    unsigned long long pr_acc = 0ull;
#endif
    for (int gp = args.ph_lo; gp < args.ph_hi; ++gp) {
#ifdef PROBE_TMASK
        const unsigned long long pr_t0 = __builtin_amdgcn_s_memrealtime();
        int pr_kind;
        if (gp == 0) pr_kind = K_PROLOGUE; else if (gp == 1) pr_kind = K_H; else if (gp == PH_TOTAL - 1) pr_kind = K_NORM;
        else { const int k = (gp - 2) % PH_PER_PASS; pr_kind = k == 0 ? K_INPROJ : k == 1 ? K_PREP : k == 2 ? K_QK : k == 3 ? K_CPREP : k == 4 ? K_MIX : k == 5 ? K_POST : k == 6 ? K_OUT1 : K_OUT2; }
#endif
        if (gp == 0) run_phase<K_PROLOGUE>(args, lds, 0);
        else if (gp == 1) run_phase<K_H>(args, lds, 0);
        else if (gp == PH_TOTAL - 1) run_phase<K_NORM>(args, lds, 0);
        else {
            const int pass = (gp - 2) / PH_PER_PASS, k = (gp - 2) % PH_PER_PASS;
            if (k == 0) run_phase<K_INPROJ>(args, lds, pass);
            else if (k == 1) run_phase<K_PREP>(args, lds, pass);
            else if (k == 2) run_phase<K_QK>(args, lds, pass);
            else if (k == 3) run_phase<K_CPREP>(args, lds, pass);
            else if (k == 4) run_phase<K_MIX>(args, lds, pass, &bar);
            else if (k == 5) run_phase<K_POST>(args, lds, pass);
            else if (k == 6) run_phase<K_OUT1>(args, lds, pass);
            else run_phase<K_OUT2>(args, lds, pass);
        }
#ifdef PROBE_TMASK
        const unsigned long long pr_tb = __builtin_amdgcn_s_memrealtime();
#endif
        if (gp + 1 < args.ph_hi) xcd_barrier(bar);
#ifdef PROBE_TMASK
        else __syncthreads();
        if ((PROBE_TMASK >> 11) & 1) pr_acc += __builtin_amdgcn_s_memrealtime() - pr_tb;
        if ((PROBE_TMASK >> pr_kind) & 1) pr_acc += __builtin_amdgcn_s_memrealtime() - pr_t0;
#endif
    }
#ifdef PROBE_TMASK
    if (blockIdx.x == 0) { const unsigned long long t1 = __builtin_amdgcn_s_memrealtime(); while (__builtin_amdgcn_s_memrealtime() - t1 < 4ull * pr_acc) __builtin_amdgcn_s_sleep(8); }
#endif
}
#endif

extern "C" void kernel_launch(void* const* d_in, const int* in_sizes, int n_in, void* d_out, int out_size, void* d_ws, size_t ws_size, hipStream_t stream) {
    static int grid = 0;
    if (grid == 0) {
        if (n_in != 19 || in_sizes[0] != MALL * DM || out_size != MALL * DM || ws_size < WS_END) { fprintf(stderr, "kernel_launch: unexpected shapes (n_in %d, ws %zu)\n", n_in, ws_size); grid = -1; return; }
        int dev = 0, cus = 0, per_cu = 0;
        (void)hipGetDevice(&dev); (void)hipDeviceGetAttribute(&cus, hipDeviceAttributeMultiprocessorCount, dev);
#if MK_ONE_LAUNCH
        (void)hipFuncSetAttribute((const void*)mk_fwd, hipFuncAttributeMaxDynamicSharedMemorySize, LDS_BYTES);
        (void)hipOccupancyMaxActiveBlocksPerMultiprocessor(&per_cu, (const void*)mk_fwd, NTHR, LDS_BYTES);
        if (per_cu < 1) { fprintf(stderr, "kernel_launch: occupancy query says %d\n", per_cu); per_cu = 1; }
#else
#define SETATTR(KIND) (void)hipFuncSetAttribute((const void*)k_phase<KIND>, hipFuncAttributeMaxDynamicSharedMemorySize, LDS_BYTES)
        SETATTR(K_PROLOGUE); SETATTR(K_H); SETATTR(K_INPROJ); SETATTR(K_PREP); SETATTR(K_QK); SETATTR(K_MIX); SETATTR(K_POST); SETATTR(K_OUT1); SETATTR(K_OUT2); SETATTR(K_NORM); SETATTR(K_CPREP);
        (void)per_cu;
#endif
        (void)hipGetLastError();
        grid = cus;
    }
    if (grid < 0) return;
    (void)hipMemsetAsync((char*)d_ws + WS_CTL, 0, CTL_ZERO_BYTES, stream);
    Args a{};
    a.x = (const float*)d_in[0]; a.c = (const float*)d_in[1]; a.pos = (const int*)d_in[2]; a.w_ada = (const float*)d_in[3]; a.b_ada = (const float*)d_in[4];
    a.g_norm = (const float*)d_in[5]; a.w_in = (const float*)d_in[6]; a.b_ig = (const float*)d_in[7]; a.b_fg = (const float*)d_in[8]; a.w_conv = (const float*)d_in[9];
    a.b_conv = (const float*)d_in[10]; a.w_q = (const float*)d_in[11]; a.w_k = (const float*)d_in[12]; a.g_head = (const float*)d_in[13]; a.skip = (const float*)d_in[14];
    a.w_om = (const float*)d_in[15]; a.w_oa = (const float*)d_in[16]; a.w_o = (const float*)d_in[17]; a.g_final = (const float*)d_in[18];
    a.out = (float*)d_out; a.ws = (unsigned char*)d_ws;
#if MK_ONE_LAUNCH
    a.ph_lo = 0; a.ph_hi = PH_TOTAL;
    void* params[] = {&a};
    hipError_t e = hipLaunchCooperativeKernel((const void*)mk_fwd, dim3(grid), dim3(NTHR), params, LDS_BYTES, stream);
    if (e != hipSuccess) fprintf(stderr, "cooperative launch failed: %s\n", hipGetErrorString(e));
#else
#define LAUNCH(KIND, PASS) do { a.ph_lo = (PASS); a.ph_hi = 0; hipLaunchKernelGGL(k_phase<KIND>, dim3(grid), dim3(NTHR), LDS_BYTES, stream, a); } while (0)
    LAUNCH(K_PROLOGUE, 0); LAUNCH(K_H, 0);
    for (int p = 0; p < NPASS; ++p) { LAUNCH(K_INPROJ, p); LAUNCH(K_PREP, p); LAUNCH(K_QK, p); LAUNCH(K_CPREP, p); LAUNCH(K_MIX, p); LAUNCH(K_POST, p); LAUNCH(K_OUT1, p); LAUNCH(K_OUT2, p); }
    LAUNCH(K_NORM, 0);
#endif
}
```

```cpp
#include <hip/hip_runtime.h>
#include <hip/hip_cooperative_groups.h>
#include <cstdio>
#include <cstdint>
namespace cg = cooperative_groups;

#ifndef MK_ONE_LAUNCH
#define MK_ONE_LAUNCH 1
#endif

__device__ __forceinline__ int opaque_tid() { int t = threadIdx.x; asm volatile("" : "+v"(t)); return t; }
namespace pg8 {
#define PG8_LAS __attribute__((address_space(3)))
typedef unsigned short bf16_t;
typedef short bf16x8 __attribute__((ext_vector_type(8)));
typedef float f32x4 __attribute__((ext_vector_type(4)));
typedef unsigned u32x4 __attribute__((ext_vector_type(4)));
constexpr int BM = 256, BK = 64, HALF = 128, HTB = HALF * BK * 2, STAGE_BYTES = 8 * HTB, NXCD = 8, WGM = 8;

__host__ __device__ __forceinline__ int lds_byte(int r, int c) { const int st = (r >> 4) * 2 + (c >> 5), rr = r & 15, cc = c & 31, ob = rr * 64 + cc * 2; return st * 1024 + (ob ^ (((ob >> 9) & 1) << 5)); }
__host__ __device__ __forceinline__ void stage_rc(int b, int& R, int& C) { const int st = b / 1024, sb = b % 1024, swz = sb ^ (((sb >> 9) & 1) << 5); R = (st >> 1) * 16 + swz / 64; C = (st & 1) * 32 + (swz % 64) / 2; }
__host__ __device__ __forceinline__ int perm32(int rho) { const int n = rho >> 4, i = rho & 15; return 8 * (i >> 2) + 4 * n + (i & 3); }

struct Unit { int pm, pn, g; };
template <int LDA, int LDB, int KK, int AGS = 0, int BGS = 0> struct Gemm {
    const bf16_t* A; const bf16_t* Bt;
    static constexpr int lda = LDA, ldb = LDB, K = KK;
    __device__ __forceinline__ const char* abase(const Unit& u) const { return (const char*)A + (size_t)(u.g * AGS) + (size_t)u.pm * (size_t)(BM * 2 * LDA); }
    __device__ __forceinline__ const char* bbase(const Unit& u) const { return (const char*)Bt + (size_t)(u.g * BGS) + (size_t)u.pn * (size_t)(BM * 2 * LDB); }
};

struct StaticOrder {
    int nM, nN, nwg, G, c;
    __host__ __device__ void init(int M, int N, int G_, int c_) { nM = M / BM; nN = N / BM; nwg = nM * nN; G = G_; c = c_; }
    __host__ __device__ bool next(int i, Unit& u) const {
        const long L = (long)i * G + c; if (L >= nwg) return false;
        int wgid = (int)L; { const int q = nwg / NXCD, r = nwg % NXCD, xcd = wgid % NXCD, off = wgid / NXCD; wgid = (xcd < r ? xcd * (q + 1) : r * (q + 1) + (xcd - r) * q) + off; }
        const int nig = WGM * nN, gid = wgid / nig, fm = gid * WGM, gsz = (nM - fm) < WGM ? (nM - fm) : WGM;
        u.pm = fm + ((wgid % nig) % gsz); u.pn = (wgid % nig) / gsz; u.g = 0; return true;
    }
    __device__ __forceinline__ void a_ready(const Unit&) const {}
    __device__ __forceinline__ void done(const Unit&) const {}
};
struct GroupOrder {
    int nunits, G, c;
    __host__ __device__ void init(int M, int G_, int c_) { nunits = (M / BM) * 8; G = G_; c = c_; }
    __host__ __device__ bool next(int i, Unit& u) const {
        const long L = (long)i * G + c; if (L >= nunits) return false;
        u.pm = (int)(L >> 3); u.g = (int)((L & 7) >> 1); u.pn = (int)(L & 1); return true;
    }
    __device__ __forceinline__ void a_ready(const Unit&) const {}
    __device__ __forceinline__ void done(const Unit&) const {}
};

__device__ __forceinline__ unsigned cvt_pk_bf16(float lo, float hi) { unsigned r; asm volatile("v_cvt_pk_bf16_f32 %0, %1, %2" : "=v"(r) : "v"(lo), "v"(hi)); return r; }

template <class Epi, class Sched, bool ALIGN_EPI, bool SP2, class GemmT>
__device__ __forceinline__ void gemm_phase(PG8_LAS unsigned char* lds, const GemmT g, const Sched& S, const Epi& E) {
    const int tid = opaque_tid(), wid = __builtin_amdgcn_readfirstlane(tid >> 6), lane = tid & 63, wr = wid >> 2, wc = wid & 3, fr = lane & 15, fq = lane >> 4;
    constexpr int K = GemmT::K, nt = K / BK;
    unsigned voffA[2], voffB[2];
#pragma unroll
    for (int i = 0; i < 2; ++i) { int R, C; stage_rc(tid * 16 + i * 8192, R, C); const int Rb = Epi::PERM ? (64 * (R >> 5) + perm32(R & 31)) : R;
        voffA[i] = (unsigned)(R * g.lda + C) * 2u; voffB[i] = (unsigned)(Rb * g.ldb + C) * 2u; }
    const size_t kstep = (size_t)(BK * 2);
    const size_t hstepA = (size_t)HALF * g.lda * 2, hstepB = (size_t)(Epi::PERM ? 32 : HALF) * g.ldb * 2;
    const unsigned ldsw = (unsigned)wid * 1024u;
    const int aoff = lds_byte(wr * 64 + fr, fq * 8), boff = lds_byte(wc * 32 + fr, fq * 8);
#define PG8_SA(b, h) (((b) * 2 + (h)) * HTB)
#define PG8_SB(b, h) ((4 + (b) * 2 + (h)) * HTB)
#define PG8_STAGE(bufoff, gbase, voff) do { _Pragma("unroll") for (int _i = 0; _i < 2; ++_i) \
        __builtin_amdgcn_global_load_lds((const unsigned*)((const char*)(gbase) + (voff)[_i]), (PG8_LAS unsigned*)(lds + (bufoff) + ldsw + _i * 8192), 16, 0, 0); } while (0)
#define PG8_LDA(dst, b, h) do { _Pragma("unroll") for (int m = 0; m < 4; ++m) _Pragma("unroll") for (int k = 0; k < 2; ++k) dst[m][k] = *(const PG8_LAS bf16x8*)(lds + PG8_SA(b, h) + aoff + m * 2048 + k * 1024); } while (0)
#define PG8_LDB(dst, b, h) do { _Pragma("unroll") for (int n = 0; n < 2; ++n) _Pragma("unroll") for (int k = 0; k < 2; ++k) dst[n][k] = *(const PG8_LAS bf16x8*)(lds + PG8_SB(b, h) + boff + n * 2048 + k * 1024); } while (0)
#define PG8_MMA(ai, bj, At, Bt) do { __builtin_amdgcn_s_setprio(1); _Pragma("unroll") for (int m = 0; m < 4; ++m) _Pragma("unroll") for (int n = 0; n < 2; ++n) _Pragma("unroll") for (int k = 0; k < 2; ++k) \
        acc[ai][bj][m][n] = __builtin_amdgcn_mfma_f32_16x16x32_bf16(Bt[n][k], At[m][k], acc[ai][bj][m][n], 0, 0, 0); __builtin_amdgcn_s_setprio(0); } while (0)
#define PG8_WAIT_V(n) asm volatile("s_waitcnt vmcnt(" #n ")" ::: "memory")
#define PG8_WAIT_L(n) asm volatile("s_waitcnt lgkmcnt(" #n ")" ::: "memory")
#define PG8_BAR __builtin_amdgcn_s_barrier()
#define PG8_SCHED __builtin_amdgcn_sched_barrier(0)
    Unit cur, nxt; int ui = 0;
    if (!S.next(0, cur)) return;
    f32x4 acc[2][2][4][2];
#pragma unroll
    for (int a = 0; a < 2; ++a)
#pragma unroll
        for (int b = 0; b < 2; ++b)
#pragma unroll
            for (int m = 0; m < 4; ++m)
#pragma unroll
                for (int n = 0; n < 2; ++n) acc[a][b][m][n] = (f32x4){0.f, 0.f, 0.f, 0.f};
    bf16x8 At[4][2], B0[2][2], B1[2][2];
    const char* cA = g.abase(cur); const char* cB = g.bbase(cur);
    S.a_ready(cur);
    if constexpr (SP2) {
        PG8_STAGE(PG8_SB(0, 0), cB, voffB); PG8_STAGE(PG8_SB(0, 1), cB + hstepB, voffB); PG8_STAGE(PG8_SA(0, 0), cA, voffA); PG8_STAGE(PG8_SA(0, 1), cA + hstepA, voffA);
        if (wr == 1) PG8_BAR;
        PG8_WAIT_V(2); PG8_BAR;
        PG8_STAGE(PG8_SB(1, 0), cB + kstep, voffB); PG8_STAGE(PG8_SA(1, 0), cA + kstep, voffA); PG8_STAGE(PG8_SB(1, 1), cB + hstepB + kstep, voffB);
        PG8_WAIT_V(6); PG8_BAR;
    } else {
        PG8_STAGE(PG8_SB(0, 0), cB, voffB); PG8_STAGE(PG8_SA(0, 0), cA, voffA); PG8_STAGE(PG8_SB(0, 1), cB + hstepB, voffB); PG8_STAGE(PG8_SA(0, 1), cA + hstepA, voffA);
        if (wr == 1) PG8_BAR;
        PG8_WAIT_V(4); PG8_BAR;
        PG8_STAGE(PG8_SB(1, 0), cB + kstep, voffB); PG8_STAGE(PG8_SA(1, 0), cA + kstep, voffA); PG8_STAGE(PG8_SB(1, 1), cB + hstepB + kstep, voffB);
        PG8_WAIT_V(6); PG8_BAR;
    }
    for (;;) {
        const bool has_next = S.next(ui + 1, nxt);
        const char* nA = has_next ? g.abase(nxt) : cA; const char* nB = has_next ? g.bbase(nxt) : cB;
#pragma nounroll
        for (int t = 0; t < nt; t += 2) {
            const bool last = (t == nt - 2);
            const char* a1 = cA + (size_t)(t + 1) * kstep;
            const char* a2 = last ? nA : cA + (size_t)(t + 2) * kstep; const char* b2 = last ? nB : cB + (size_t)(t + 2) * kstep;
            const char* a3 = a2 + kstep; const char* b3 = b2 + kstep;
            if (last && has_next) S.a_ready(nxt);
            if constexpr (Epi::HOOK_T >= 0) { if (t == Epi::HOOK_T) E.hook(acc, cur, wr, wc, fr, fq); }
            if constexpr (SP2) {
            PG8_LDB(B0, 0, 0); PG8_LDB(B1, 0, 1); PG8_SCHED; PG8_LDA(At, 0, 0); PG8_STAGE(PG8_SA(1, 1), a1 + hstepA, voffA);
            PG8_WAIT_V(8); PG8_WAIT_L(0); PG8_BAR; PG8_MMA(0, 0, At, B0); PG8_MMA(0, 1, At, B1); PG8_BAR; PG8_SCHED;
            PG8_LDA(At, 0, 1); PG8_STAGE(PG8_SB(0, 0), b2, voffB); PG8_STAGE(PG8_SB(0, 1), b2 + hstepB, voffB); PG8_STAGE(PG8_SA(0, 0), a2, voffA);
            PG8_WAIT_V(8); PG8_WAIT_L(0); PG8_BAR; PG8_MMA(1, 0, At, B0); PG8_MMA(1, 1, At, B1); PG8_BAR; PG8_SCHED;
            PG8_LDB(B0, 1, 0); PG8_LDB(B1, 1, 1); PG8_SCHED; PG8_LDA(At, 1, 0); PG8_STAGE(PG8_SA(0, 1), a2 + hstepA, voffA);
            PG8_WAIT_V(8); PG8_WAIT_L(0); PG8_BAR; PG8_MMA(0, 0, At, B0); PG8_MMA(0, 1, At, B1); PG8_BAR; PG8_SCHED;
            PG8_LDA(At, 1, 1); PG8_STAGE(PG8_SB(1, 0), b3, voffB); PG8_STAGE(PG8_SB(1, 1), b3 + hstepB, voffB); PG8_STAGE(PG8_SA(1, 0), a3, voffA);
            PG8_WAIT_V(8); PG8_WAIT_L(0); PG8_BAR; PG8_MMA(1, 0, At, B0); PG8_MMA(1, 1, At, B1); PG8_BAR; PG8_SCHED;
            } else {
            PG8_LDB(B0, 0, 0); PG8_SCHED; PG8_LDA(At, 0, 0); PG8_STAGE(PG8_SA(1, 1), a1 + hstepA, voffA);
            PG8_WAIT_L(8); PG8_BAR; PG8_WAIT_L(0); PG8_MMA(0, 0, At, B0); PG8_BAR; PG8_SCHED;
            PG8_LDB(B1, 0, 1); PG8_STAGE(PG8_SB(0, 0), b2, voffB);
            PG8_BAR; PG8_WAIT_L(0); PG8_MMA(0, 1, At, B1); PG8_BAR;
            PG8_LDA(At, 0, 1); PG8_STAGE(PG8_SA(0, 0), a2, voffA);
            PG8_BAR; PG8_WAIT_L(0); PG8_MMA(1, 0, At, B0); PG8_BAR; PG8_SCHED;
            PG8_STAGE(PG8_SB(0, 1), b2 + hstepB, voffB);
            PG8_WAIT_V(6); PG8_BAR; PG8_MMA(1, 1, At, B1); PG8_BAR;
            PG8_LDB(B0, 1, 0); PG8_SCHED; PG8_LDA(At, 1, 0); PG8_STAGE(PG8_SA(0, 1), a2 + hstepA, voffA);
            PG8_WAIT_L(8); PG8_BAR; PG8_WAIT_L(0); PG8_MMA(0, 0, At, B0); PG8_BAR; PG8_SCHED;
            PG8_LDB(B1, 1, 1); PG8_STAGE(PG8_SB(1, 0), b3, voffB);
            PG8_BAR; PG8_WAIT_L(0); PG8_MMA(0, 1, At, B1); PG8_BAR;
            PG8_LDA(At, 1, 1); PG8_STAGE(PG8_SA(1, 0), a3, voffA);
            PG8_BAR; PG8_WAIT_L(0); PG8_MMA(1, 0, At, B0); PG8_BAR; PG8_SCHED;
            PG8_STAGE(PG8_SB(1, 1), b3 + hstepB, voffB);
            PG8_WAIT_V(6); PG8_BAR; PG8_MMA(1, 1, At, B1); PG8_BAR;
            }
        }
        if constexpr (ALIGN_EPI) { if (wr == 0) PG8_BAR; }
        E(acc, cur, wr, wc, fr, fq); S.done(cur);
        if (!has_next) break;
#pragma unroll
        for (int a = 0; a < 2; ++a)
#pragma unroll
            for (int b = 0; b < 2; ++b)
#pragma unroll
                for (int m = 0; m < 4; ++m)
#pragma unroll
                    for (int n = 0; n < 2; ++n) acc[a][b][m][n] = (f32x4){0.f, 0.f, 0.f, 0.f};
        cur = nxt; cA = nA; cB = nB; ++ui;
        if constexpr (ALIGN_EPI) { if (wr == 1) PG8_BAR; }
    }
    PG8_WAIT_V(0);
    if constexpr (!ALIGN_EPI) { if (wr == 0) PG8_BAR; }
    PG8_BAR;
#undef PG8_SA
#undef PG8_SB
#undef PG8_STAGE
#undef PG8_LDA
#undef PG8_LDB
#undef PG8_MMA
#undef PG8_WAIT_V
#undef PG8_WAIT_L
#undef PG8_BAR
#undef PG8_SCHED
}
}

constexpr int NWAVES = 8, NTHR = 512;
constexpr int DM = 1024, NBATCH = 16, SEQ = 4096, MALL = NBATCH * SEQ;
constexpr int NB_PASS = 4, MS = NB_PASS * SEQ, NPASS = NBATCH / NB_PASS;
constexpr int INW_SRC = 11272, INW = 11264;
constexpr int C_XA = 0, C_VA = 1024, C_OA = 2048, C_ZA = 3072, C_QA = 4096, C_KA = 5632, C_VT = 7168, C_ZB = 8704, C_GA = 9216, C_GB = 10240;
constexpr float EPS = 1e-6f;

constexpr size_t MiB = 1u << 20;
constexpr size_t WS_CTL = 0, CTL_ZERO_BYTES = 1 * MiB;
constexpr size_t WS_MOD = 1 * MiB;
constexpr size_t WS_WG = 1 * MiB + 256 * 1024;
constexpr size_t WS_WIN = 2 * MiB;
constexpr size_t WS_WQK = 24 * MiB;
constexpr size_t WS_WOM = 25 * MiB, WS_WOA = 27 * MiB, WS_WO = 28 * MiB;
constexpr size_t WS_IG = 30 * MiB, WS_FG = 31 * MiB;
constexpr size_t WS_GSC = 32 * MiB;
constexpr size_t WS_LSE = 34 * MiB;
constexpr size_t WS_DEN = 35 * MiB;
constexpr size_t WS_H = 36 * MiB;
constexpr size_t WS_P = 164 * MiB;
constexpr size_t WS_XC = 516 * MiB;
constexpr size_t WS_QM = 548 * MiB, WS_KM = 580 * MiB;
constexpr size_t WS_HR = 612 * MiB;
constexpr size_t WS_AO = 644 * MiB;
constexpr size_t WS_UA = 692 * MiB;
constexpr size_t WS_ACAT = 708 * MiB;
constexpr size_t WS_MG = 772 * MiB;
constexpr size_t WS_SG = 804 * MiB;
constexpr size_t WS_KTG = 812 * MiB;
constexpr size_t WS_VTG = 844 * MiB;
constexpr size_t WS_CS = 876 * MiB;
constexpr size_t WS_NS = 1004 * MiB;
constexpr size_t WS_ROPE = 1005 * MiB;
constexpr size_t WS_END = 1013 * MiB;
constexpr int CW_QCTR = 1024;
constexpr int CW_ROWSS = 65536;
static_assert((CW_ROWSS + MALL) * 4 <= (int)CTL_ZERO_BYTES, "ctl");

constexpr int LDS_BYTES = 147456;

typedef unsigned short bf16;
typedef float f32x4 __attribute__((ext_vector_type(4)));
typedef float f32x2 __attribute__((ext_vector_type(2)));
typedef short bf16x8 __attribute__((ext_vector_type(8)));
typedef unsigned u32x4 __attribute__((ext_vector_type(4)));
typedef unsigned u32x2 __attribute__((ext_vector_type(2)));
typedef short s16x4 __attribute__((ext_vector_type(4)));

__device__ __forceinline__ unsigned f2bf(float f) { unsigned u = __builtin_bit_cast(unsigned, f); return (u + 0x7fffu + ((u >> 16) & 1u)) >> 16; }
__device__ __forceinline__ unsigned pk2(float lo, float hi) { return f2bf(lo) | (f2bf(hi) << 16); }
__device__ __forceinline__ float bflo(unsigned w) { return __builtin_bit_cast(float, w << 16); }
__device__ __forceinline__ float bfhi(unsigned w) { return __builtin_bit_cast(float, w & 0xffff0000u); }
__device__ __forceinline__ float bf1(bf16 v) { return __builtin_bit_cast(float, (unsigned)v << 16); }
__device__ __forceinline__ float sigmoidf_(float x) { return 1.f / (1.f + __expf(-x)); }
__device__ __forceinline__ float siluf_(float x) { return x / (1.f + __expf(-x)); }
__device__ __forceinline__ float wave_sum(float v) {
#pragma unroll
    for (int o = 1; o < 64; o <<= 1) v += __shfl_xor(v, o);
    return v;
}
__device__ __forceinline__ void unpack8(const u32x4 w, float* f) {
    f[0] = bflo(w.x); f[1] = bfhi(w.x); f[2] = bflo(w.y); f[3] = bfhi(w.y); f[4] = bflo(w.z); f[5] = bfhi(w.z); f[6] = bflo(w.w); f[7] = bfhi(w.w);
}

struct Args {
    const float* x; const float* c; const int* pos; const float* w_ada; const float* b_ada; const float* g_norm; const float* w_in;
    const float* b_ig; const float* b_fg; const float* w_conv; const float* b_conv; const float* w_q; const float* w_k; const float* g_head;
    const float* skip; const float* w_om; const float* w_oa; const float* w_o; const float* g_final;
    float* out; unsigned char* ws; int ph_lo, ph_hi;
};

__device__ __forceinline__ void transpose_item(const float* W, int K, int Nsrc, int nblk, int src_col_off, bf16* WT, int ldt, int row_off, float scale, float* scr, int item, int lane) {
    const int kb = item / nblk, nb = item % nblk, k0 = 64 * kb, n0 = 32 * nb;
#pragma unroll 8
    for (int i = 0; i < 32; ++i) { const int kk = 2 * i + (lane >> 5); scr[kk * 33 + (lane & 31)] = W[(size_t)(k0 + kk) * Nsrc + src_col_off + n0 + (lane & 31)]; }
    __builtin_amdgcn_wave_barrier();
    asm volatile("s_waitcnt lgkmcnt(0)" ::: "memory");
    const int cc = lane & 7;
#pragma unroll
    for (int j = 0; j < 4; ++j) { const int n = (lane >> 3) + 8 * j; const float* s = scr + (8 * cc) * 33 + n;
        u32x4 o; o.x = pk2(s[0 * 33] * scale, s[1 * 33] * scale); o.y = pk2(s[2 * 33] * scale, s[3 * 33] * scale); o.z = pk2(s[4 * 33] * scale, s[5 * 33] * scale); o.w = pk2(s[6 * 33] * scale, s[7 * 33] * scale);
        *(u32x4*)(WT + (size_t)(row_off + n0 + n) * ldt + k0 + 8 * cc) = o; }
    asm volatile("s_waitcnt lgkmcnt(0)" ::: "memory");
    __builtin_amdgcn_wave_barrier();
}

__device__ __forceinline__ void phase_prologue(const Args& a, unsigned char* lds, int vcu, int G) {
    const int tid = opaque_tid(), lane = tid & 63, wave = tid >> 6;
    unsigned char* ws = a.ws;
    if (vcu < 48) {
        float* sc = (float*)lds;
        float* red = (float*)(lds + 65536);
        for (int i = tid; i < 16 * 1024; i += NTHR) sc[i] = siluf_(a.c[i]);
        __syncthreads();
        const int n = vcu * 64 + lane;
        float acc[16];
#pragma unroll
        for (int b = 0; b < 16; ++b) acc[b] = 0.f;
        const int k0 = wave * 128;
#pragma unroll 16
        for (int k = k0; k < k0 + 128; ++k) { const float w = a.w_ada[(size_t)k * 3072 + n];
#pragma unroll
            for (int b = 0; b < 16; ++b) acc[b] += sc[b * 1024 + k] * w; }
#pragma unroll
        for (int b = 0; b < 16; ++b) red[(wave * 16 + b) * 64 + lane] = acc[b];
        __syncthreads();
        float* mod = (float*)(ws + WS_MOD);
        for (int i = tid; i < 16 * 64; i += NTHR) { const int b = i >> 6, l = i & 63, nn = vcu * 64 + l; float s = 0.f;
#pragma unroll
            for (int w = 0; w < 8; ++w) s += red[(w * 16 + b) * 64 + l];
            s += a.b_ada[nn];
            const int part = nn >> 10, col = nn & 1023;
            if (part == 1) s = a.g_norm[col] * (1.f + s);
            mod[b * 3072 + nn] = s; }
        __syncthreads();
    }
    {
        float* scr = (float*)lds + wave * (64 * 33);
        const int gw = vcu * NWAVES + wave, NGW = G * NWAVES;
        constexpr int I_IN = (1024 / 64) * (INW / 32);
        constexpr int I_QK = 8 * (256 / 64) * (256 / 32);
        constexpr int I_OM = 16 * 32, I_OA = 8 * 32, I_O = 16 * 32;
        constexpr int NITEMS = I_IN + I_QK + I_OM + I_OA + I_O;
        for (int it = gw; it < NITEMS; it += NGW) {
            int r = it;
            if (r < I_IN) { const int nb = r % (INW / 32); const int off = (nb * 32 >= 4096) ? 8 : 0;
                transpose_item(a.w_in, 1024, INW_SRC, INW / 32, off, (bf16*)(ws + WS_WIN), 1024, 0, 1.f, scr, r, lane); continue; } r -= I_IN;
            if (r < I_QK) { const int mtx = r >> 5, rr = r & 31, h = mtx >> 1, isk = mtx & 1;
                const float* W = (isk ? a.w_k : a.w_q) + (size_t)h * 65536;
                transpose_item(W, 256, 256, 8, 0, (bf16*)(ws + WS_WQK) + (size_t)h * 512 * 256, 256, isk * 256, isk ? 0.0625f : 1.f, scr, rr, lane); continue; } r -= I_QK;
            if (r < I_OM) { transpose_item(a.w_om, 1024, 1024, 32, 0, (bf16*)(ws + WS_WOM), 1536, 0, 1.f, scr, r, lane); continue; } r -= I_OM;
            if (r < I_OA) { transpose_item(a.w_oa, 512, 1024, 32, 0, (bf16*)(ws + WS_WOM) + 1024, 1536, 0, 1.f, scr, r, lane); continue; } r -= I_OA;
            transpose_item(a.w_o, 1024, 1024, 32, 0, (bf16*)(ws + WS_WO), 1024, 0, 1.f, scr, r, lane);
        }
        float* wg = (float*)(ws + WS_WG);
        for (int i = (vcu * NTHR + tid); i < 8 * 1024; i += G * NTHR) { const int j = i >> 10, k = i & 1023; wg[i] = a.w_in[(size_t)k * INW_SRC + 4096 + j]; }
    }
}

__constant__ double c_inv_freq[16] = {1.0, 0.44036660267178046, 0.19392274474868576, 0.08539710028576561, 0.03760603093086393, 0.016560440080994446, 0.007292664737217109, 0.003211445994752591,
    0.001414213562373095, 0.000622772421914596, 0.0002742481756762073, 0.00012076973741146504, 5.318295896944988e-05, 2.341999896140934e-05, 1.031338537721246e-05, 4.5416704806078695e-06};

__device__ __forceinline__ void phase_h(const Args& a, unsigned char* lds, int vcu, int G) {
    const int tid = opaque_tid(), lane = tid & 63, wave = tid >> 6;
    unsigned char* ws = a.ws;
    float* wg = (float*)lds;
    { const float* src = (const float*)(ws + WS_WG); for (int i = tid; i < 8192; i += NTHR) wg[i] = src[i]; }
    __syncthreads();
    const float* mod = (const float*)(ws + WS_MOD);
    bf16* H = (bf16*)(ws + WS_H);
    float* IG = (float*)(ws + WS_IG); float* FG = (float*)(ws + WS_FG); float* ROPE = (float*)(ws + WS_ROPE);
    const int gw = vcu * NWAVES + wave, NGW = G * NWAVES;
    for (int row0 = 2 * gw; row0 < MALL; row0 += 2 * NGW) {
        f32x4 v[2][4]; float ss[2] = {0.f, 0.f};
#pragma unroll
        for (int rr = 0; rr < 2; ++rr) { const f32x4* xr = (const f32x4*)(a.x + (size_t)(row0 + rr) * DM) + lane;
#pragma unroll
            for (int j = 0; j < 4; ++j) v[rr][j] = xr[64 * j]; }
        if (lane < 32) { const int rr = lane >> 4, fi = lane & 15; const int pos = a.pos[row0 + rr];
            const double rev = (double)pos * c_inv_freq[fi] * 0.15915494309189535; const float fr_ = (float)(rev - rint(rev));
            ROPE[(size_t)(row0 + rr) * 32 + fi] = __builtin_amdgcn_cosf(fr_); ROPE[(size_t)(row0 + rr) * 32 + 16 + fi] = __builtin_amdgcn_sinf(fr_); }
#pragma unroll
        for (int rr = 0; rr < 2; ++rr) {
#pragma unroll
            for (int j = 0; j < 4; ++j) ss[rr] += (v[rr][j].x * v[rr][j].x + v[rr][j].y * v[rr][j].y) + (v[rr][j].z * v[rr][j].z + v[rr][j].w * v[rr][j].w);
        }
#pragma unroll
        for (int o = 1; o < 64; o <<= 1) { ss[0] += __shfl_xor(ss[0], o); ss[1] += __shfl_xor(ss[1], o); }
        const int b = row0 >> 12;
        float pg[2][8];
#pragma unroll
        for (int rr = 0; rr < 2; ++rr)
#pragma unroll
            for (int g = 0; g < 8; ++g) pg[rr][g] = 0.f;
        const float rinv[2] = {1.f / sqrtf(ss[0] * (1.f / DM) + EPS), 1.f / sqrtf(ss[1] * (1.f / DM) + EPS)};
#pragma unroll
        for (int j = 0; j < 4; ++j) {
            const int col = 4 * lane + 256 * j;
            const f32x4 sh = *(const f32x4*)(mod + b * 3072 + col), gs = *(const f32x4*)(mod + b * 3072 + 1024 + col);
            f32x4 h[2];
#pragma unroll
            for (int rr = 0; rr < 2; ++rr) { h[rr] = v[rr][j] * rinv[rr] * gs + sh;
                u32x2 o; o.x = pk2(h[rr].x, h[rr].y); o.y = pk2(h[rr].z, h[rr].w); *((u32x2*)(H + (size_t)(row0 + rr) * DM) + lane + 64 * j) = o; }
#pragma unroll
            for (int g = 0; g < 8; ++g) { const f32x4 w = *(const f32x4*)(wg + g * 1024 + col);
                pg[0][g] += (h[0].x * w.x + h[0].y * w.y) + (h[0].z * w.z + h[0].w * w.w); pg[1][g] += (h[1].x * w.x + h[1].y * w.y) + (h[1].z * w.z + h[1].w * w.w); }
            __builtin_amdgcn_sched_barrier(0);
        }
#pragma unroll
        for (int o = 1; o < 64; o <<= 1)
#pragma unroll
            for (int g = 0; g < 8; ++g) { pg[0][g] += __shfl_xor(pg[0][g], o); pg[1][g] += __shfl_xor(pg[1][g], o); }
        if (lane < 2) { const int rr = lane; const float* p = rr ? pg[1] : pg[0];
            f32x4 ig = {p[0] + a.b_ig[0], p[1] + a.b_ig[1], p[2] + a.b_ig[2], p[3] + a.b_ig[3]};
            f32x4 fg = {p[4] + a.b_fg[0], p[5] + a.b_fg[1], p[6] + a.b_fg[2], p[7] + a.b_fg[3]};
            *(f32x4*)(IG + (size_t)(row0 + rr) * 4) = ig; *(f32x4*)(FG + (size_t)(row0 + rr) * 4) = fg; }
    }
}

struct EpiProj {
    static constexpr bool PERM = true; static constexpr int HOOK_T = -1;
    bf16* P; const float* rope;
    __device__ __forceinline__ void operator()(const f32x4 (&acc)[2][2][4][2], const pg8::Unit& u, int wr, int wc, int fr, int fq) const {
        const int row0 = u.pm * 256 + wr * 64 + fr, col0 = u.pn * 256 + wc * 64 + 8 * fq;
        const bool rot = (u.pn >= 16) && (u.pn < 28) && ((wc & 1) == 0);
#pragma unroll
        for (int ai = 0; ai < 2; ++ai)
#pragma unroll
            for (int m = 0; m < 4; ++m) { const int r = row0 + ai * 128 + m * 16; bf16* rowp = P + (size_t)r * INW + col0;
#pragma unroll
                for (int bj = 0; bj < 2; ++bj) { f32x4 v0 = acc[ai][bj][m][0], v1 = acc[ai][bj][m][1];
                    if (bj == 0 && rot) {
                        const float* tp = rope + (size_t)r * 32 + 8 * (fq & 1);
                        const f32x4 c0 = *(const f32x4*)tp, c1 = *(const f32x4*)(tp + 4), s0 = *(const f32x4*)(tp + 16), s1 = *(const f32x4*)(tp + 20);
                        f32x4 p0, p1;
#pragma unroll
                        for (int e = 0; e < 4; ++e) { p0[e] = __shfl_xor(v0[e], 32); p1[e] = __shfl_xor(v1[e], 32); }
                        const float sg = (fq < 2) ? -1.f : 1.f;
                        v0 = v0 * c0 + p0 * s0 * sg; v1 = v1 * c1 + p1 * s1 * sg;
                    }
                    u32x4 w; w.x = pg8::cvt_pk_bf16(v0[0], v0[1]); w.y = pg8::cvt_pk_bf16(v0[2], v0[3]); w.z = pg8::cvt_pk_bf16(v1[0], v1[1]); w.w = pg8::cvt_pk_bf16(v1[2], v1[3]);
                    *(u32x4*)(rowp + bj * 32) = w; } }
    }
};
struct EpiQK {
    static constexpr bool PERM = true; static constexpr int HOOK_T = -1;
    bf16* QM; bf16* KM;
    __device__ __forceinline__ void operator()(const f32x4 (&acc)[2][2][4][2], const pg8::Unit& u, int wr, int wc, int fr, int fq) const {
        const int row0 = u.pm * 256 + wr * 64 + fr, col0 = u.g * 256 + wc * 64 + 8 * fq;
        bf16* base = u.pn ? KM : QM;
#pragma unroll
        for (int ai = 0; ai < 2; ++ai)
#pragma unroll
            for (int m = 0; m < 4; ++m) { bf16* rowp = base + (size_t)(row0 + ai * 128 + m * 16) * 1024 + col0;
#pragma unroll
                for (int bj = 0; bj < 2; ++bj) { const f32x4 v0 = acc[ai][bj][m][0], v1 = acc[ai][bj][m][1];
                    u32x4 w; w.x = pg8::cvt_pk_bf16(v0[0], v0[1]); w.y = pg8::cvt_pk_bf16(v0[2], v0[3]); w.z = pg8::cvt_pk_bf16(v1[0], v1[1]); w.w = pg8::cvt_pk_bf16(v1[2], v1[3]);
                    *(u32x4*)(rowp + bj * 32) = w; } }
    }
};
struct EpiMerge {
    static constexpr bool PERM = true; static constexpr int HOOK_T = 16;
    const bf16* P; bf16* MG;
    __device__ __forceinline__ void hook(f32x4 (&acc)[2][2][4][2], const pg8::Unit& u, int wr, int wc, int fr, int fq) const {
        int row0 = u.pm * 256 + wr * 64 + fr, col0 = u.pn * 256 + wc * 64 + 8 * fq;
        asm volatile("" : "+v"(row0), "+v"(col0));
#pragma unroll
        for (int ai = 0; ai < 2; ++ai)
#pragma unroll
            for (int m = 0; m < 4; ++m) { const size_t r = (size_t)(row0 + ai * 128 + m * 16);
#pragma unroll
                for (int bj = 0; bj < 2; ++bj) { const int c = col0 + bj * 32;
                    const u32x4 gaw = *(const u32x4*)(P + r * INW + C_GA + c), gbw = *(const u32x4*)(P + r * INW + C_GB + c);
                    float ga[8], gb[8]; unpack8(gaw, ga); unpack8(gbw, gb);
#pragma unroll
                    for (int e = 0; e < 4; ++e) {
                        acc[ai][bj][m][0][e] *= (1.f + __expf(-gb[e])) / (1.f + __expf(-ga[e]));
                        acc[ai][bj][m][1][e] *= (1.f + __expf(-gb[4 + e])) / (1.f + __expf(-ga[4 + e])); } }
                __builtin_amdgcn_sched_barrier(0); }
    }
    __device__ __forceinline__ void operator()(const f32x4 (&acc)[2][2][4][2], const pg8::Unit& u, int wr, int wc, int fr, int fq) const {
        const int row0 = u.pm * 256 + wr * 64 + fr, col0 = u.pn * 256 + wc * 64 + 8 * fq;
#pragma unroll
        for (int ai = 0; ai < 2; ++ai)
#pragma unroll
            for (int m = 0; m < 4; ++m) { const size_t r = (size_t)(row0 + ai * 128 + m * 16);
#pragma unroll
                for (int bj = 0; bj < 2; ++bj) { const int c = col0 + bj * 32;
                    const u32x4 gbw = *(const u32x4*)(P + r * INW + C_GB + c); float gb[8]; unpack8(gbw, gb);
                    const f32x4 v0 = acc[ai][bj][m][0], v1 = acc[ai][bj][m][1];
                    float o[8];
#pragma unroll
                    for (int e = 0; e < 4; ++e) { o[e] = sigmoidf_(gb[e]) * v0[e]; o[4 + e] = sigmoidf_(gb[4 + e]) * v1[e]; }
                    u32x4 w; w.x = pg8::cvt_pk_bf16(o[0], o[1]); w.y = pg8::cvt_pk_bf16(o[2], o[3]); w.z = pg8::cvt_pk_bf16(o[4], o[5]); w.w = pg8::cvt_pk_bf16(o[6], o[7]);
                    *(u32x4*)(MG + r * 1024 + c) = w; } }
    }
};
struct EpiOut {
    static constexpr bool PERM = true; static constexpr int HOOK_T = -1;
    const float* x; float* out; const float* gate; float* rowss; int grow0;
    __device__ __forceinline__ void operator()(const f32x4 (&acc)[2][2][4][2], const pg8::Unit& u, int wr, int wc, int fr, int fq) const {
        const int row0 = grow0 + u.pm * 256 + wr * 64 + fr, col0 = u.pn * 256 + wc * 64 + 8 * fq;
#pragma unroll
        for (int ai = 0; ai < 2; ++ai)
#pragma unroll
            for (int m = 0; m < 4; ++m) { const int r = row0 + ai * 128 + m * 16; const int b = r >> 12; float ss = 0.f;
#pragma unroll
                for (int bj = 0; bj < 2; ++bj) { const int c = col0 + bj * 32;
                    const float* gp = gate + b * 3072 + c; const f32x4 g0 = *(const f32x4*)gp, g1 = *(const f32x4*)(gp + 4);
                    const float* xp = x + (size_t)r * 1024 + c; const f32x4 x0 = *(const f32x4*)xp, x1 = *(const f32x4*)(xp + 4);
                    const f32x4 o0 = x0 + g0 * acc[ai][bj][m][0], o1 = x1 + g1 * acc[ai][bj][m][1];
                    ss += (o0[0] * o0[0] + o0[1] * o0[1]) + (o0[2] * o0[2] + o0[3] * o0[3]) + (o1[0] * o1[0] + o1[1] * o1[1]) + (o1[2] * o1[2] + o1[3] * o1[3]);
                    float* op = out + (size_t)r * 1024 + c; *(f32x4*)op = o0; *(f32x4*)(op + 4) = o1; }
                ss += __shfl_xor(ss, 16); ss += __shfl_xor(ss, 32);
                if (fq == 0) atomicAdd(rowss + r, ss); }
    }
};

__device__ __forceinline__ void phase_prep(const Args& a, unsigned char* lds, int vcu, int G, int pass) {
    const int tid = opaque_tid(), lane = tid & 63, wave = tid >> 6;
    unsigned char* ws = a.ws;
    bf16* P = (bf16*)(ws + WS_P);
    if (vcu < NB_PASS * 4) {
        const int bl = vcu >> 2, h = vcu & 3;
        const float* IG = (const float*)(ws + WS_IG); const float* FG = (const float*)(ws + WS_FG);
        float* gsc = (float*)(ws + WS_GSC);
        float* A1 = gsc, *B1 = gsc + MS * 4, *WI = gsc + 2 * MS * 4, *EF = gsc + 3 * MS * 4, *WK = gsc + 4 * MS * 4, *DEC = gsc + 5 * MS * 4;
        float* cg = (float*)lds; float* cp = cg + 64;
        float f[8], ii[8];
#pragma unroll
        for (int q = 0; q < 8; ++q) { const size_t grow = (size_t)pass * MS + bl * SEQ + (wave * 8 + q) * 64 + lane; f[q] = FG[grow * 4 + h]; ii[q] = IG[grow * 4 + h]; }
        float acs[8], b1[8], pm[8];
#pragma unroll
        for (int q = 0; q < 8; ++q) {
            float x = fminf(f[q], 0.f) - log1pf(expf(-fabsf(f[q])));
#pragma unroll
            for (int o = 1; o < 64; o <<= 1) { const float t = __shfl_up(x, o); if (lane >= o) x += t; }
            acs[q] = x; b1[q] = ii[q] - x;
            float m = b1[q];
#pragma unroll
            for (int o = 1; o < 64; o <<= 1) { const float t = __shfl_up(m, o); if (lane >= o) m = fmaxf(m, t); }
            pm[q] = m;
            if (lane == 63) { cg[wave * 8 + q] = x; cp[wave * 8 + q] = m; }
        }
        __syncthreads();
        float m_prev = 0.f, mp[8], Ms8[8];
        for (int j = 0; j < 64; ++j) { const float Ms = fmaxf(m_prev, cp[j]);
#pragma unroll
            for (int q = 0; q < 8; ++q) if (j == wave * 8 + q) { mp[q] = m_prev; Ms8[q] = Ms; }
            m_prev = cg[j] + Ms; }
#pragma unroll
        for (int q = 0; q < 8; ++q) {
            const int j = wave * 8 + q, lrow = bl * SEQ + j * 64 + lane;
            const float mx = fmaxf(mp[q], pm[q]);
            A1[lrow * 4 + h] = -mx; B1[lrow * 4 + h] = b1[q]; WI[lrow * 4 + h] = expf(mp[q] - mx); EF[lrow * 4 + h] = expf(-(acs[q] + mx)); WK[lrow * 4 + h] = expf(b1[q] - Ms8[q]);
            if (lane == 0) DEC[(bl * 64 + j) * 4 + h] = expf(mp[q] - Ms8[q]);
        }
    }
    {
        bf16* XC = (bf16*)(ws + WS_XC);
        const int cg8 = (tid & 127) * 8, rq = tid >> 7;
        float wc[4][8], bc[8];
#pragma unroll
        for (int j = 0; j < 4; ++j)
#pragma unroll
            for (int e = 0; e < 8; ++e) wc[j][e] = a.w_conv[j * 1024 + cg8 + e];
#pragma unroll
        for (int e = 0; e < 8; ++e) bc[e] = a.b_conv[cg8 + e];
        for (int it = vcu; it < MS / 32; it += G) {
            const int r0 = it * 32 + rq * 8, t0 = r0 & (SEQ - 1);
            u32x4 w[11];
#pragma unroll
            for (int k = 0; k < 11; ++k) { const int rr = r0 - 3 + k; w[k] = (k >= 3 || t0 >= 3) ? *(const u32x4*)(P + (size_t)rr * INW + C_XA + cg8) : (u32x4){0u, 0u, 0u, 0u}; }
            float xin[11][8];
#pragma unroll
            for (int k = 0; k < 11; ++k) unpack8(w[k], xin[k]);
#pragma unroll
            for (int k = 0; k < 8; ++k) { float o[8];
#pragma unroll
                for (int e = 0; e < 8; ++e) o[e] = siluf_(bc[e] + wc[0][e] * xin[k][e] + wc[1][e] * xin[k + 1][e] + wc[2][e] * xin[k + 2][e] + wc[3][e] * xin[k + 3][e]);
                u32x4 ov; ov.x = pk2(o[0], o[1]); ov.y = pk2(o[2], o[3]); ov.z = pk2(o[4], o[5]); ov.w = pk2(o[6], o[7]);
                *(u32x4*)(XC + (size_t)(r0 + k) * 1024 + cg8) = ov; }
        }
    }
}

__device__ __forceinline__ f32x4 mfma16(bf16x8 a, bf16x8 b, f32x4 c) { return __builtin_amdgcn_mfma_f32_16x16x32_bf16(a, b, c, 0, 0, 0); }

constexpr int TPS = 72;
__device__ __forceinline__ void phase_cprep(const Args& a, unsigned char* lds, int vcu, int G) {
    const int tid = opaque_tid(), lane = tid & 63, wave = __builtin_amdgcn_readfirstlane(tid >> 6);
    const int fr = lane & 15, fq = lane >> 4;
    unsigned char* ws = a.ws;
    const bf16* P = (const bf16*)(ws + WS_P); const bf16* QM = (const bf16*)(ws + WS_QM); const bf16* KM = (const bf16*)(ws + WS_KM);
    const float* gsc = (const float*)(ws + WS_GSC);
    const float* gA1 = gsc, *gB1 = gsc + MS * 4, *gWK = gsc + 4 * MS * 4;
    bf16* SG = (bf16*)(ws + WS_SG); bf16* KTG = (bf16*)(ws + WS_KTG); bf16* VTG = (bf16*)(ws + WS_VTG);
    bf16* KT = (bf16*)lds; bf16* VT = (bf16*)(lds + 256 * TPS * 2);
    bf16* sp = (bf16*)(lds + 2 * 256 * TPS * 2) + wave * 16 * 40;
    const int ti = wave >> 1, tj0 = 2 * (wave & 1);
    for (int ci = vcu; ci < (MS / 64) * 4; ci += G) {
        const int h = ci & 3, t0 = (ci >> 2) * 64;
        bf16x8 qf[8], kf[2][8]; float a1l[4], b1s[2];
#pragma unroll
        for (int ks = 0; ks < 8; ++ks) qf[ks] = *(const bf16x8*)(QM + (size_t)(t0 + 16 * ti + fr) * 1024 + h * 256 + 32 * ks + 8 * fq);
#pragma unroll
        for (int tt = 0; tt < 2; ++tt) {
            if (tj0 + tt <= ti) {
#pragma unroll
                for (int ks = 0; ks < 8; ++ks) kf[tt][ks] = *(const bf16x8*)(KM + (size_t)(t0 + 16 * (tj0 + tt) + fr) * 1024 + h * 256 + 32 * ks + 8 * fq);
            }
            b1s[tt] = gB1[(t0 + 16 * (tj0 + tt) + fr) * 4 + h];
        }
#pragma unroll
        for (int i = 0; i < 4; ++i) a1l[i] = gA1[(t0 + 16 * ti + 4 * fq + i) * 4 + h];
        u32x4 kw[4], vw[4]; float wk[4];
#pragma unroll
        for (int i = 0; i < 4; ++i) { const int c = tid + NTHR * i, l = c & 63, dc = c >> 6;
            kw[i] = *(const u32x4*)(KM + (size_t)(t0 + l) * 1024 + h * 256 + 8 * dc); vw[i] = *(const u32x4*)(P + (size_t)(t0 + l) * INW + C_VA + h * 256 + 8 * dc); wk[i] = gWK[(t0 + l) * 4 + h]; }
        __syncthreads();
#pragma unroll
        for (int i = 0; i < 4; ++i) { const int c = tid + NTHR * i, l = c & 63, dc = c >> 6;
            float kv[8]; unpack8(kw[i], kv);
            bf16* d = KT + (8 * dc) * TPS + l;
#pragma unroll
            for (int e = 0; e < 8; ++e) d[e * TPS] = (bf16)f2bf(kv[e] * wk[i]);
            const u32x4 w = vw[i]; bf16* dv = VT + (8 * dc) * TPS + l;
            dv[0 * TPS] = (bf16)(w.x & 0xffff); dv[1 * TPS] = (bf16)(w.x >> 16); dv[2 * TPS] = (bf16)(w.y & 0xffff); dv[3 * TPS] = (bf16)(w.y >> 16);
            dv[4 * TPS] = (bf16)(w.z & 0xffff); dv[5 * TPS] = (bf16)(w.z >> 16); dv[6 * TPS] = (bf16)(w.w & 0xffff); dv[7 * TPS] = (bf16)(w.w >> 16); }
#pragma unroll
        for (int tt = 0; tt < 2; ++tt) {
            const int tj = tj0 + tt;
            f32x4 sacc = {0.f, 0.f, 0.f, 0.f};
            if (tj <= ti) {
#pragma unroll
                for (int ks = 0; ks < 8; ++ks) sacc = mfma16(qf[ks], kf[tt][ks], sacc);
            }
            const int sidx = 16 * tj + fr;
#pragma unroll
            for (int i = 0; i < 4; ++i) { const int l = 16 * ti + 4 * fq + i;
                float v = 0.f;
                if (sidx <= l) v = sacc[i] * __expf(a1l[i] + b1s[tt]);
                sp[(4 * fq + i) * 40 + 16 * tt + fr] = (bf16)f2bf(v); }
        }
        { const int row = lane >> 2, ch = lane & 3;
          *(u32x4*)(SG + (size_t)ci * 4096 + (16 * ti + row) * 64 + 16 * tj0 + 8 * ch) = *(const u32x4*)(sp + row * 40 + 8 * ch); }
        __syncthreads();
#pragma unroll
        for (int i = 0; i < 4; ++i) { const int p = tid + NTHR * i, blk = p >> 6, ln = p & 63, row = (blk >> 1) * 16 + (ln & 15), ch = (blk & 1) * 4 + (ln >> 4);
            *(u32x4*)(KTG + (size_t)ci * 16384 + p * 8) = *(const u32x4*)(KT + row * TPS + 8 * ch);
            *(u32x4*)(VTG + (size_t)ci * 16384 + p * 8) = *(const u32x4*)(VT + row * TPS + 8 * ch); }
    }
}

constexpr int SA_DEPTH = 5, SA_PATCH = 32 * 32 * 2 + 128;
struct ScanA { const bf16* KTG; const bf16* VTG; const float* gDEC; bf16* CS; float* NS; int bl, h, dblk, eblk, wave, fr, fq; unsigned koff, voff; bool do_den; };
struct ScanAOps { bf16x8 k[2][2], v[2][2]; float decay; };
__device__ __forceinline__ void scana_load(const ScanA& c, int j, ScanAOps& o) {
    const int ci = (c.bl * 64 + j) * 4 + c.h;
    const bf16* kb = c.KTG + (size_t)ci * 16384; const bf16* vb = c.VTG + (size_t)ci * 16384;
#pragma unroll
    for (int dt = 0; dt < 2; ++dt)
#pragma unroll
        for (int k2 = 0; k2 < 2; ++k2) o.k[dt][k2] = *(const bf16x8*)(kb + (c.koff + (unsigned)((dt * 2 + k2) * 512)));
#pragma unroll
    for (int et = 0; et < 2; ++et)
#pragma unroll
        for (int k2 = 0; k2 < 2; ++k2) o.v[et][k2] = *(const bf16x8*)(vb + (c.voff + (unsigned)((et * 2 + k2) * 512)));
    o.decay = c.gDEC[(c.bl * 64 + j) * 4 + c.h];
}
__device__ __forceinline__ void scana_step(const ScanA& c, unsigned char* lds, int j, f32x4 (&Cacc)[2][2], f32x4 (&Nacc)[2], const ScanAOps& o, const bf16x8 ones) {
    const int ci = (c.bl * 64 + j) * 4 + c.h;
    unsigned char* patch = lds + c.wave * SA_PATCH;
    const int lane = c.fq * 16 + c.fr;
#pragma unroll
    for (int dt = 0; dt < 2; ++dt) {
#pragma unroll
        for (int et = 0; et < 2; ++et) { const f32x4 cc = Cacc[dt][et]; u32x2 w; w.x = pk2(cc[0], cc[1]); w.y = pk2(cc[2], cc[3]);
            *(u32x2*)(patch + (16 * et + c.fr) * 64 + (16 * dt + 4 * c.fq) * 2) = w; }
        if (c.do_den && c.fr == 0) *(f32x4*)(patch + 2048 + (16 * dt + 4 * c.fq) * 4) = Nacc[dt];
    }
    { bf16* cs = c.CS + (size_t)ci * 65536 + (c.eblk * 8 + c.dblk) * 1024;
#pragma unroll
      for (int k = 0; k < 2; ++k) *(u32x4*)(cs + k * 512 + lane * 8) = *(const u32x4*)(patch + k * 1024 + lane * 16);
      if (c.do_den && lane < 8) *(f32x4*)(c.NS + (size_t)ci * 256 + c.dblk * 32 + lane * 4) = *(const f32x4*)(patch + 2048 + lane * 16); }
#pragma unroll
    for (int dt = 0; dt < 2; ++dt) {
#pragma unroll
        for (int et = 0; et < 2; ++et) {
            f32x4 cc = Cacc[dt][et] * o.decay;
#pragma unroll
            for (int k2 = 0; k2 < 2; ++k2) cc = mfma16(o.k[dt][k2], o.v[et][k2], cc);
            Cacc[dt][et] = cc;
        }
        if (c.do_den) {
            f32x4 cc = Nacc[dt] * o.decay;
#pragma unroll
            for (int k2 = 0; k2 < 2; ++k2) cc = mfma16(o.k[dt][k2], ones, cc);
            Nacc[dt] = cc;
        }
    }
}
__device__ __forceinline__ void scana_item(const Args& a, unsigned char* lds, int item) {
    const int tid = opaque_tid(), lane = tid & 63;
    unsigned char* ws = a.ws;
    ScanA c;
    c.wave = __builtin_amdgcn_readfirstlane(tid >> 6); c.fr = lane & 15; c.fq = lane >> 4;
    item = __builtin_amdgcn_readfirstlane(item);
    c.bl = item >> 5; c.h = (item >> 3) & 3; c.dblk = 2 * ((item >> 1) & 3) + (c.wave >> 2); c.eblk = 4 * (item & 1) + (c.wave & 3); c.do_den = (c.eblk == 0);
    c.koff = (unsigned)((4 * c.dblk) * 512 + lane * 8); c.voff = (unsigned)((4 * c.eblk) * 512 + lane * 8);
    c.KTG = (const bf16*)(ws + WS_KTG); c.VTG = (const bf16*)(ws + WS_VTG); c.gDEC = (const float*)(ws + WS_GSC) + 5 * MS * 4;
    c.CS = (bf16*)(ws + WS_CS); c.NS = (float*)(ws + WS_NS);
    f32x4 Cacc[2][2], Nacc[2];
#pragma unroll
    for (int x = 0; x < 2; ++x) { Nacc[x] = (f32x4){0.f, 0.f, 0.f, 0.f};
#pragma unroll
        for (int y = 0; y < 2; ++y) Cacc[x][y] = (f32x4){0.f, 0.f, 0.f, 0.f}; }
    bf16x8 ones;
    { const short ov = (c.fr == 0) ? (short)0x3F80 : (short)0;
#pragma unroll
      for (int e = 0; e < 8; ++e) ones[e] = ov; }
    ScanAOps o0, o1, o2, o3, o4;
    scana_load(c, 0, o0); scana_load(c, 1, o1); scana_load(c, 2, o2); scana_load(c, 3, o3); scana_load(c, 4, o4);
#define SA_STEP(jj, ob) do { scana_step(c, lds, (jj), Cacc, Nacc, ob, ones); __builtin_amdgcn_sched_barrier(0); scana_load(c, (jj) + SA_DEPTH < 64 ? (jj) + SA_DEPTH : 63, ob); __builtin_amdgcn_sched_barrier(0); } while (0)
#pragma nounroll
    for (int j = 0; j < 60; j += 5) { SA_STEP(j, o0); SA_STEP(j + 1, o1); SA_STEP(j + 2, o2); SA_STEP(j + 3, o3); SA_STEP(j + 4, o4); }
    SA_STEP(60, o0); SA_STEP(61, o1); SA_STEP(62, o2); SA_STEP(63, o3);
#undef SA_STEP
    asm volatile("s_waitcnt vmcnt(0)" ::: "memory");
}

constexpr int AKS = 136;
constexpr int L_AK = 0, L_AV = L_AK + 128 * AKS * 2, L_AP = L_AV + 128 * AKS * 2, L_ATT_END = L_AP + 8 * 16 * AKS * 2;
static_assert(L_ATT_END <= 131072, "attn lds");

__device__ __forceinline__ void attn_item(const Args& a, unsigned char* lds, int item) {
    const int tid = opaque_tid(), lane = tid & 63, wave = __builtin_amdgcn_readfirstlane(tid >> 6);
    const int fr = lane & 15, fq = lane >> 4;
    unsigned char* ws = a.ws;
    const int blk = item & 31, hh = (item >> 5) & 3, bl = (item >> 7) & 3, g = item >> 9;
    const int dil = g == 0 ? 1 : g == 1 ? 4 : 16, nb = 32 / dil;
    const int r = blk / nb, n = blk % nb;
    const bf16* P = (const bf16*)(ws + WS_P);
    const int H = 4 * g + hh;
    const bf16* Qb = P + C_QA + H * 128; const bf16* Kb = P + C_KA + H * 128; const bf16* Vb = P + C_VT + H * 128;
    bf16* Ks = (bf16*)(lds + L_AK); bf16* VTs = (bf16*)(lds + L_AV); bf16* Pw = (bf16*)(lds + L_AP) + wave * 16 * AKS;
    const int rowbase = bl * SEQ + r;
    bf16x8 qf[4];
    { const size_t qrow = (size_t)(rowbase + (128 * n + 16 * wave + fr) * dil);
#pragma unroll
      for (int ks = 0; ks < 4; ++ks) qf[ks] = *(const bf16x8*)(Qb + qrow * INW + 32 * ks + 8 * fq); }
    f32x4 O[8];
#pragma unroll
    for (int i = 0; i < 8; ++i) O[i] = (f32x4){0.f, 0.f, 0.f, 0.f};
    float mrow = -INFINITY, lrow = 0.f;
    const float scale = 0.08838834764831845f;
#define ATT_BAR() do { asm volatile("s_waitcnt lgkmcnt(0)" ::: "memory"); __builtin_amdgcn_s_barrier(); asm volatile("" ::: "memory"); } while (0)
    const int half0 = (n == 0 ? 1 : 0);
    u32x4 kreg[4], vreg[4];
#pragma unroll
    for (int i = 0; i < 4; ++i) { const int c = tid + NTHR * i, key = c >> 4, dc = c & 15;
        const size_t krow = (size_t)(rowbase + (128 * (n - 1 + half0) + key) * dil);
        kreg[i] = *(const u32x4*)(Kb + krow * INW + 8 * dc); vreg[i] = *(const u32x4*)(Vb + krow * INW + 8 * dc); }
    for (int half = half0; half < 2; ++half) {
        ATT_BAR();
#pragma unroll
        for (int i = 0; i < 4; ++i) { const int c = tid + NTHR * i, key = c >> 4, dc = c & 15;
            *(u32x4*)(Ks + key * AKS + 8 * dc) = kreg[i]; *(u32x4*)(VTs + key * AKS + 8 * dc) = vreg[i]; }
        if (half == 0) {
#pragma unroll
            for (int i = 0; i < 4; ++i) { const int c = tid + NTHR * i, key = c >> 4, dc = c & 15;
                const size_t krow = (size_t)(rowbase + (128 * n + key) * dil);
                kreg[i] = *(const u32x4*)(Kb + krow * INW + 8 * dc); vreg[i] = *(const u32x4*)(Vb + krow * INW + 8 * dc); }
        }
        ATT_BAR();
        f32x4 S[8];
        const int p = 16 * wave + fr;
        float mx = -INFINITY;
#pragma unroll
        for (int kt = 0; kt < 8; ++kt) {
            const bool act = half == 0 ? (kt >= wave) : (kt <= wave);
            f32x4 sacc = {0.f, 0.f, 0.f, 0.f};
            if (act) {
#pragma unroll
                for (int ks = 0; ks < 4; ++ks) { const bf16x8 kf = *(const bf16x8*)(Ks + (16 * kt + fr) * AKS + 32 * ks + 8 * fq); sacc = mfma16(kf, qf[ks], sacc); }
#pragma unroll
                for (int i = 0; i < 4; ++i) { const int kk = 16 * kt + 4 * fq + i; const bool ok = half == 0 ? (kk >= p) : (kk <= p);
                    const float v = ok ? sacc[i] * scale : -INFINITY; sacc[i] = v; mx = fmaxf(mx, v); }
            }
            S[kt] = sacc;
        }
        mx = fmaxf(mx, __shfl_xor(mx, 16)); mx = fmaxf(mx, __shfl_xor(mx, 32));
        const float mn = fmaxf(mrow, mx), alpha = __expf(mrow - mn); mrow = mn;
        float rs = 0.f;
        unsigned pk[8][2];
#pragma unroll
        for (int kt = 0; kt < 8; ++kt) {
            const bool act = half == 0 ? (kt >= wave) : (kt <= wave);
            if (act) { const float p0 = __expf(S[kt][0] - mn), p1 = __expf(S[kt][1] - mn), p2 = __expf(S[kt][2] - mn), p3 = __expf(S[kt][3] - mn);
                rs += (p0 + p1) + (p2 + p3); pk[kt][0] = pk2(p0, p1); pk[kt][1] = pk2(p2, p3); }
            else { pk[kt][0] = 0u; pk[kt][1] = 0u; }
        }
        rs += __shfl_xor(rs, 16); rs += __shfl_xor(rs, 32);
        lrow = lrow * alpha + rs;
        float al[4];
#pragma unroll
        for (int i = 0; i < 4; ++i) al[i] = __shfl(alpha, 4 * fq + i);
#pragma unroll
        for (int dtile = 0; dtile < 8; ++dtile)
#pragma unroll
            for (int i = 0; i < 4; ++i) O[dtile][i] *= al[i];
#pragma unroll
        for (int ks = 0; ks < 4; ++ks) {
            const bool act = half == 0 ? (2 * ks + 1 >= wave) : (2 * ks <= wave);
            if (act) {
                u32x4 pw; pw.x = pk[2 * ks][0]; pw.y = pk[2 * ks][1]; pw.z = pk[2 * ks + 1][0]; pw.w = pk[2 * ks + 1][1];
                const bf16x8 pa = __builtin_bit_cast(bf16x8, pw);
#pragma unroll
                for (int dtile = 0; dtile < 8; ++dtile) {
                    const bf16* vp = VTs + (32 * ks + 4 * fq + (fr >> 2)) * AKS + 16 * dtile + 4 * (fr & 3);
                    const s16x4 v0 = __builtin_amdgcn_ds_read_tr16_b64_v4i16((__attribute__((address_space(3))) s16x4*)(vp));
                    const s16x4 v1 = __builtin_amdgcn_ds_read_tr16_b64_v4i16((__attribute__((address_space(3))) s16x4*)(vp + 16 * AKS));
                    bf16x8 vb; vb[0] = v0[0]; vb[1] = v0[1]; vb[2] = v0[2]; vb[3] = v0[3]; vb[4] = v1[0]; vb[5] = v1[1]; vb[6] = v1[2]; vb[7] = v1[3];
                    O[dtile] = mfma16(pa, vb, O[dtile]); }
            }
        }
    }
    bf16* AO = (bf16*)(ws + WS_AO) + (size_t)g * MS * 512; float* LSE = (float*)(ws + WS_LSE) + (size_t)g * MS * 4;
    {
        const float inv_l = 1.f / lrow;
        float il[4];
#pragma unroll
        for (int i = 0; i < 4; ++i) il[i] = __shfl(inv_l, 4 * fq + i);
#pragma unroll
        for (int dtile = 0; dtile < 8; ++dtile)
#pragma unroll
            for (int i = 0; i < 4; ++i) Pw[(4 * fq + i) * AKS + 16 * dtile + fr] = (bf16)f2bf(O[dtile][i] * il[i]);
        if (fq == 0) { const size_t row = (size_t)(rowbase + (128 * n + 16 * wave + fr) * dil); LSE[row * 4 + hh] = mrow + logf(lrow); }
#pragma unroll
        for (int k = 0; k < 4; ++k) { const int c = lane + 64 * k, q = c >> 4, ch = c & 15;
            const size_t row = (size_t)(rowbase + (128 * n + 16 * wave + q) * dil);
            *(u32x4*)(AO + row * 512 + hh * 128 + 8 * ch) = *(const u32x4*)(Pw + q * AKS + 8 * ch); }
    }
    __syncthreads();
}

constexpr int N_SCAN_ITEMS = NB_PASS * 32, N_ATT_ITEMS = 3 * NB_PASS * 4 * 32;
#ifndef PROBE_ATT_REP
#define PROBE_ATT_REP 1
#endif
struct XcdBarrier;
__device__ __forceinline__ void xcd_barrier(const XcdBarrier& b);
__device__ __forceinline__ void phase_mix(const Args& a, unsigned char* lds, int pass, const XcdBarrier* pbar) {
    volatile int* slot = (volatile int*)(lds + 131072 + 1024);
#ifdef PROBE_SPLIT
    for (int it = blockIdx.x; it < N_SCAN_ITEMS; it += gridDim.x) scana_item(a, lds, it);
    xcd_barrier(*pbar);
    for (int rep = 0; rep < PROBE_ATT_REP; ++rep)
    for (int it = blockIdx.x; it < N_ATT_ITEMS; it += gridDim.x) attn_item(a, lds, it);
#else
    if ((int)blockIdx.x < N_SCAN_ITEMS && gridDim.x >= (unsigned)N_SCAN_ITEMS) {
        const int x = blockIdx.x & 7, k = blockIdx.x >> 3, g = x + 8 * (k >> 3), m = k & 7;
        scana_item(a, lds, g * 8 + m);
    } else if (gridDim.x < (unsigned)N_SCAN_ITEMS) { for (int it = blockIdx.x; it < N_SCAN_ITEMS; it += gridDim.x) scana_item(a, lds, it); }
    constexpr int QN = N_ATT_ITEMS / 8;
    for (int qo = 0; qo < 8; ++qo) {
        const int qx = (int)((blockIdx.x + qo) & 7);
        unsigned* qc = (unsigned*)(a.ws + WS_CTL) + CW_QCTR + (pass * 8 + qx) * 64;
        for (;;) {
            __syncthreads();
            if (opaque_tid() == 0) *slot = (int)atomicAdd(qc, 1u);
            __syncthreads();
            const int L = *slot;
            if (L >= QN) break;
            attn_item(a, lds, ((L >> 3) * 8 + qx) * 8 + (L & 7));
        }
    }
#endif
}

constexpr int QS_STRIDE = 264, SS_STRIDE = 72;
constexpr int L_QS = 0, L_SS = L_QS + 64 * QS_STRIDE * 2, L_DENL = L_SS + 64 * SS_STRIDE * 2, L_WIL = L_DENL + 256, L_NUM = L_WIL + 256, L_SB_END = L_NUM + 64 * QS_STRIDE * 2;
static_assert(L_SB_END <= 131072, "scan-B lds");
__device__ __forceinline__ void scanb_item(const Args& a, unsigned char* lds, int ch) {
    const int tid = opaque_tid(), lane = tid & 63, wave = __builtin_amdgcn_readfirstlane(tid >> 6), fr = lane & 15, fq = lane >> 4;
    unsigned char* ws = a.ws;
    const int h = ch & 3, t0 = (ch >> 2) * 64;
    const bf16* P = (const bf16*)(ws + WS_P); const bf16* XC = (const bf16*)(ws + WS_XC); const bf16* QM = (const bf16*)(ws + WS_QM);
    const bf16* SG = (const bf16*)(ws + WS_SG); const bf16* VTG = (const bf16*)(ws + WS_VTG); const bf16* CS = (const bf16*)(ws + WS_CS); const float* NS = (const float*)(ws + WS_NS);
    const float* gWI = (const float*)(ws + WS_GSC) + 2 * MS * 4; const float* gEF = (const float*)(ws + WS_GSC) + 3 * MS * 4;
    bf16* UM = (bf16*)(ws + WS_ACAT);
    bf16* QS = (bf16*)(lds + L_QS); bf16* SS = (bf16*)(lds + L_SS); float* DENL = (float*)(lds + L_DENL); float* WIL = (float*)(lds + L_WIL); bf16* NUMS = (bf16*)(lds + L_NUM);
    const int c = h * 256 + 4 * lane;
    u32x2 owr[8], zwr[8], xwr[8];
#pragma unroll
    for (int rr = 0; rr < 8; ++rr) { const size_t r = (size_t)(t0 + 8 * wave + rr);
        owr[rr] = *(const u32x2*)(P + r * INW + C_OA + c); zwr[rr] = *(const u32x2*)(P + r * INW + C_ZA + c); xwr[rr] = *(const u32x2*)(XC + r * 1024 + c); }
    __syncthreads();
#pragma unroll
    for (int i = 0; i < 4; ++i) { const int c = tid + NTHR * i, row = c >> 5, cc = c & 31;
        *(u32x4*)(QS + row * QS_STRIDE + 8 * cc) = *(const u32x4*)(QM + (size_t)(t0 + row) * 1024 + h * 256 + 8 * cc); }
    { const int row = tid >> 3, cc = tid & 7; *(u32x4*)(SS + row * SS_STRIDE + 8 * cc) = *(const u32x4*)(SG + (size_t)ch * 4096 + row * 64 + 8 * cc); }
    if (tid < 64) WIL[tid] = gWI[(t0 + tid) * 4 + h];
    bf16x8 cb[2][8], vt[2][2];
#pragma unroll
    for (int t = 0; t < 2; ++t) {
#pragma unroll
        for (int ks = 0; ks < 8; ++ks) cb[t][ks] = *(const bf16x8*)(CS + (size_t)ch * 65536 + (wave * 8 + ks) * 1024 + (16 * t + fr) * 32 + 8 * fq);
#pragma unroll
        for (int k2 = 0; k2 < 2; ++k2) vt[t][k2] = *(const bf16x8*)(VTG + (size_t)ch * 16384 + (((2 * wave + t) * 2 + k2) * 64 + lane) * 8);
    }
    __syncthreads();
#pragma unroll
    for (int lt = 0; lt < 4; ++lt) {
        bf16x8 qf[8], sf[2];
#pragma unroll
        for (int ks = 0; ks < 8; ++ks) qf[ks] = *(const bf16x8*)(QS + (16 * lt + fr) * QS_STRIDE + 32 * ks + 8 * fq);
#pragma unroll
        for (int k2 = 0; k2 < 2; ++k2) sf[k2] = *(const bf16x8*)(SS + (16 * lt + fr) * SS_STRIDE + 32 * k2 + 8 * fq);
#pragma unroll
        for (int t = 0; t < 2; ++t) {
            f32x4 a1 = {0.f, 0.f, 0.f, 0.f}, a2 = {0.f, 0.f, 0.f, 0.f}, a3 = {0.f, 0.f, 0.f, 0.f};
#pragma unroll
            for (int k2 = 0; k2 < 2; ++k2) a1 = mfma16(sf[k2], vt[t][k2], a1);
#pragma unroll
            for (int ks = 0; ks < 8; ks += 2) { a2 = mfma16(qf[ks], cb[t][ks], a2); a3 = mfma16(qf[ks + 1], cb[t][ks + 1], a3); }
#pragma unroll
            for (int i = 0; i < 4; ++i) NUMS[(16 * lt + 4 * fq + i) * QS_STRIDE + 32 * wave + 16 * t + fr] = (bf16)f2bf(a1[i] + WIL[16 * lt + 4 * fq + i] * (a2[i] + a3[i]));
        }
    }
    if (wave == 0) {
        bf16x8 nb[8], ones;
        { const short ov = (fr == 0) ? (short)0x3F80 : (short)0;
#pragma unroll
          for (int e = 0; e < 8; ++e) ones[e] = ov; }
#pragma unroll
        for (int ks = 0; ks < 8; ++ks) { const f32x4 n0 = *(const f32x4*)(NS + (size_t)ch * 256 + 32 * ks + 8 * fq), n1 = *(const f32x4*)(NS + (size_t)ch * 256 + 32 * ks + 8 * fq + 4);
            u32x4 w; w.x = pk2(n0[0], n0[1]); w.y = pk2(n0[2], n0[3]); w.z = pk2(n1[0], n1[1]); w.w = pk2(n1[2], n1[3]);
            if (fr != 0) w = (u32x4){0u, 0u, 0u, 0u};
            nb[ks] = __builtin_bit_cast(bf16x8, w); }
#pragma unroll
        for (int lt = 0; lt < 4; ++lt) {
            f32x4 a1 = {0.f, 0.f, 0.f, 0.f}, a2 = {0.f, 0.f, 0.f, 0.f};
#pragma unroll
            for (int k2 = 0; k2 < 2; ++k2) { const bf16x8 sf = *(const bf16x8*)(SS + (16 * lt + fr) * SS_STRIDE + 32 * k2 + 8 * fq); a1 = mfma16(sf, ones, a1); }
#pragma unroll
            for (int ks = 0; ks < 8; ++ks) { const bf16x8 qf = *(const bf16x8*)(QS + (16 * lt + fr) * QS_STRIDE + 32 * ks + 8 * fq); a2 = mfma16(qf, nb[ks], a2); }
            if (fr == 0) {
#pragma unroll
                for (int i = 0; i < 4; ++i) { const int l = 16 * lt + 4 * fq + i; const float den = a1[i] + WIL[l] * a2[i]; DENL[l] = 1.f / fmaxf(fabsf(den), gEF[(t0 + l) * 4 + h]); } }
        }
    }
    __syncthreads();
    const f32x4 gh = *(const f32x4*)(a.g_head + c), sk = *(const f32x4*)(a.skip + c);
#pragma unroll
    for (int rr = 0; rr < 8; ++rr) {
        const int l = 8 * wave + rr; const size_t r = (size_t)(t0 + l);
        const u32x2 hw = *(const u32x2*)(NUMS + l * QS_STRIDE + 4 * lane);
        const u32x2 ow = owr[rr], zw = zwr[rr], xw = xwr[rr];
        const float rd = DENL[l];
        float hm[4] = {sigmoidf_(bflo(ow.x)) * bflo(hw.x) * rd, sigmoidf_(bfhi(ow.x)) * bfhi(hw.x) * rd, sigmoidf_(bflo(ow.y)) * bflo(hw.y) * rd, sigmoidf_(bfhi(ow.y)) * bfhi(hw.y) * rd};
        float ss = (hm[0] * hm[0] + hm[1] * hm[1]) + (hm[2] * hm[2] + hm[3] * hm[3]);
        ss = wave_sum(ss);
        const float rinv = 1.f / sqrtf(ss * (1.f / 256.f) + EPS);
        const float xc[4] = {bflo(xw.x), bfhi(xw.x), bflo(xw.y), bfhi(xw.y)}, za[4] = {bflo(zw.x), bfhi(zw.x), bflo(zw.y), bfhi(zw.y)};
        float o[4];
#pragma unroll
        for (int e = 0; e < 4; ++e) o[e] = (hm[e] * rinv * gh[e] + sk[e] * xc[e]) * siluf_(za[e]);
        u32x2 ov; ov.x = pk2(o[0], o[1]); ov.y = pk2(o[2], o[3]);
        *(u32x2*)(UM + r * 1536 + c) = ov;
    }
}

__device__ __forceinline__ void phase_post(const Args& a, unsigned char* lds, int vcu, int G) {
    for (int ch = vcu; ch < (MS / 64) * 4; ch += G) scanb_item(a, lds, ch);
    const int tid = opaque_tid(), lane = tid & 63, wave = tid >> 6;
    unsigned char* ws = a.ws;
    const bf16* P = (const bf16*)(ws + WS_P);
    const bf16* AO = (const bf16*)(ws + WS_AO); const float* LSE = (const float*)(ws + WS_LSE); bf16* UA = (bf16*)(ws + WS_ACAT) + 1024;
    const int hh = lane >> 4, c = hh * 128 + 8 * (lane & 15);
    for (int r0 = 2 * (vcu * NWAVES + wave); r0 < MS; r0 += 2 * G * NWAVES) {
        u32x4 o0[2], o1[2], o2[2], zb[2]; float l0[2], l1[2], l2[2];
#pragma unroll
        for (int q = 0; q < 2; ++q) { const size_t r = (size_t)(r0 + q);
            o0[q] = *(const u32x4*)(AO + r * 512 + c); o1[q] = *(const u32x4*)(AO + ((size_t)MS + r) * 512 + c); o2[q] = *(const u32x4*)(AO + ((size_t)2 * MS + r) * 512 + c);
            zb[q] = *(const u32x4*)(P + r * INW + C_ZB + c);
            l0[q] = LSE[r * 4 + hh]; l1[q] = LSE[((size_t)MS + r) * 4 + hh]; l2[q] = LSE[((size_t)2 * MS + r) * 4 + hh]; }
#pragma unroll
        for (int q = 0; q < 2; ++q) {
            const float mx = fmaxf(l0[q], fmaxf(l1[q], l2[q]));
            float w0 = __expf(l0[q] - mx), w1 = __expf(l1[q] - mx), w2 = __expf(l2[q] - mx); const float inv = 1.f / (w0 + w1 + w2); w0 *= inv; w1 *= inv; w2 *= inv;
            float f0[8], f1[8], f2[8], z[8], o[8]; unpack8(o0[q], f0); unpack8(o1[q], f1); unpack8(o2[q], f2); unpack8(zb[q], z);
#pragma unroll
            for (int e = 0; e < 8; ++e) o[e] = (w0 * f0[e] + w1 * f1[e] + w2 * f2[e]) * siluf_(z[e]);
            u32x4 ov; ov.x = pk2(o[0], o[1]); ov.y = pk2(o[2], o[3]); ov.z = pk2(o[4], o[5]); ov.w = pk2(o[6], o[7]);
            *(u32x4*)(UA + (size_t)(r0 + q) * 1536 + c) = ov;
        }
    }
}

__device__ __forceinline__ void phase_norm(const Args& a, int vcu, int G) {
    const int tid = opaque_tid(), lane = tid & 63, wave = tid >> 6;
    const float* rowss = (const float*)(a.ws + WS_CTL) + CW_ROWSS;
    for (int r = vcu * NWAVES + wave; r < MALL; r += G * NWAVES) {
        const float rinv = 1.f / sqrtf(rowss[r] * (1.f / DM) + EPS);
        f32x4* o = (f32x4*)(a.out + (size_t)r * DM) + lane;
#pragma unroll
        for (int j = 0; j < 4; ++j) { const f32x4 gf = *((const f32x4*)a.g_final + lane + 64 * j); o[64 * j] = o[64 * j] * rinv * gf; }
    }
}


#define LAS __attribute__((address_space(3)))
#define XB_TMO      128
#define XB_XCNT(j)  (256  + 64 * (j))
#define XB_XSUB(j)  (1280 + 64 * (j))
#define XB_XGEN(j)  (2304 + 64 * (j))
#define XB_TOP      3328
#define XB_TOPGEN   3392
#define XCD_BAR_WORDS 3456
#define XB_SPIN_CAP (1u << 22)
constexpr int CW_BAR = 4096;
__device__ __forceinline__ unsigned xb_ld(unsigned* p)              { return __hip_atomic_load(p, __ATOMIC_RELAXED, __HIP_MEMORY_SCOPE_AGENT); }
__device__ __forceinline__ unsigned xb_add(unsigned* p, unsigned v) { return __hip_atomic_fetch_add(p, v, __ATOMIC_RELAXED, __HIP_MEMORY_SCOPE_AGENT); }
__device__ __forceinline__ unsigned xb_xcc_id() { return (unsigned)__builtin_amdgcn_s_getreg((3 << 11) | 20) & 0xFu; }
#define XB_SPIN(cond, bar) do { unsigned _sp = 0; while (cond) { __builtin_amdgcn_s_sleep(1); \
    if ((++_sp & 255u) == 0u) { if (xb_ld(&(bar)[XB_TMO])) break; if (_sp > XB_SPIN_CAP) { atomicAdd(&(bar)[XB_TMO], 1u); break; } } } } while (0)
struct XcdBarrier { unsigned* bar; unsigned x; volatile LAS unsigned* st; };
__device__ __forceinline__ XcdBarrier xcd_barrier_post(unsigned* bar, volatile LAS unsigned* st) {
    XcdBarrier b; b.bar = bar; b.x = xb_xcc_id(); b.st = st;
    if (threadIdx.x == 0) (void)xb_add(&bar[XB_XCNT(b.x)], 1u);
    return b;
}
__device__ __forceinline__ void xcd_barrier_complete(unsigned* bar, unsigned x, unsigned& nloc, unsigned& nx) {
    const unsigned G = gridDim.x * gridDim.y * gridDim.z;
    unsigned sum, cnt, mine, sp = 0u;
    for (;;) {
        sum = 0u; cnt = 0u; mine = 0u;
#pragma unroll
        for (unsigned j = 0; j < 16; ++j) { const unsigned c = xb_ld(&bar[XB_XCNT(j)]); sum += c; cnt += (c > 0u) ? 1u : 0u; mine = (j == x) ? c : mine; }
        if (sum == G) break;
        __builtin_amdgcn_s_sleep(1);
        if ((++sp & 255u) == 0u) { if (xb_ld(&bar[XB_TMO])) break; if (sp > XB_SPIN_CAP) { atomicAdd(&bar[XB_TMO], 1u); break; } }
    }
    nloc = mine > 0u ? mine : 1u; nx = cnt > 0u ? cnt : 1u;
}
__device__ __forceinline__ void xcd_barrier(const XcdBarrier& b) {
    asm volatile("s_waitcnt vmcnt(0)" ::: "memory");
    __syncthreads();
    if (threadIdx.x == 0) {
        unsigned* bar = b.bar;
        __builtin_amdgcn_s_waitcnt(0);
        unsigned nloc = b.st[0], nx = b.st[1];
        if (nloc == 0u) { xcd_barrier_complete(bar, b.x, nloc, nx); b.st[0] = nloc; b.st[1] = nx; }
        const unsigned old = xb_add(&bar[XB_XSUB(b.x)], 1u);
        const unsigned gen = old / nloc;
        if (old + 1u == (gen + 1u) * nloc) {
            __builtin_amdgcn_fence(__ATOMIC_RELEASE, "agent");
            asm volatile("s_waitcnt vmcnt(0)" ::: "memory");
            const unsigned og = xb_add(&bar[XB_TOP], 1u);
            const unsigned tg = og / nx;
            if (og + 1u == (tg + 1u) * nx) xb_add(&bar[XB_TOPGEN], 1u);
            else XB_SPIN(xb_ld(&bar[XB_TOPGEN]) == tg, bar);
            __builtin_amdgcn_fence(__ATOMIC_ACQUIRE, "agent");
            xb_add(&bar[XB_XGEN(b.x)], 1u);
            asm volatile("s_waitcnt vmcnt(0)" ::: "memory");
        } else {
            XB_SPIN(xb_ld(&bar[XB_XGEN(b.x)]) == gen, bar);
            __builtin_amdgcn_fence(__ATOMIC_ACQUIRE, "agent");
            asm volatile("s_waitcnt vmcnt(0)" ::: "memory");
        }
    }
    __syncthreads();
}

constexpr int PH_PER_PASS = 8, PH_TOTAL = 2 + PH_PER_PASS * NPASS + 1;
#define PROBE_KIND_OF(k) ((k) == 0 ? K_INPROJ : (k) == 1 ? K_PREP : (k) == 2 ? K_QK : (k) == 3 ? K_CPREP : (k) == 4 ? K_MIX : (k) == 5 ? K_POST : (k) == 6 ? K_OUT1 : K_OUT2)
enum { K_PROLOGUE = 0, K_H = 1, K_INPROJ = 2, K_PREP = 3, K_QK = 4, K_MIX = 5, K_POST = 6, K_OUT1 = 7, K_OUT2 = 8, K_NORM = 9, K_CPREP = 10 };

__device__ __forceinline__ Args fresh_args() {
    Args a{};
#if defined(__HIP_DEVICE_COMPILE__)
    typedef const __attribute__((address_space(4))) unsigned long long* KP;
    KP q = (KP)__builtin_amdgcn_kernarg_segment_ptr(); asm volatile("" : "+s"(q));
    static_assert(sizeof(Args) == 22 * 8, "Args layout");
    unsigned long long w[22];
#pragma unroll
    for (int i = 0; i < 22; ++i) w[i] = q[i];
    __builtin_memcpy(&a, w, sizeof(Args));
#endif
    return a;
}
template <int KIND>
__device__ __forceinline__ void run_phase(const Args& args, unsigned char* lds, int pass, const XcdBarrier* pbar = nullptr) {
    const int G = gridDim.x; const int bx = blockIdx.x;
    const int vcu = (G % 8 == 0) ? (bx % 8) * (G / 8) + bx / 8 : bx;
    unsigned char* ws = args.ws;
    PG8_LAS unsigned char* lds3 = (PG8_LAS unsigned char*)lds;
    if constexpr (KIND == K_PROLOGUE) phase_prologue(args, lds, vcu, G);
    else if constexpr (KIND == K_H) phase_h(args, lds, vcu, G);
    else if constexpr (KIND == K_NORM) phase_norm(args, vcu, G);
    else if constexpr (KIND == K_INPROJ) {
        pg8::Gemm<1024, 1024, 1024> g{(const bf16*)(ws + WS_H) + (size_t)pass * MS * 1024, (const bf16*)(ws + WS_WIN)};
        pg8::StaticOrder S; S.init(MS, INW, G, bx);
        EpiProj E{(bf16*)(ws + WS_P), (const float*)(ws + WS_ROPE) + (size_t)pass * MS * 32};
        pg8::gemm_phase<EpiProj, pg8::StaticOrder, true, true>(lds3, g, S, E);
    } else if constexpr (KIND == K_PREP) phase_prep(args, lds, vcu, G, pass);
    else if constexpr (KIND == K_QK) {
        pg8::Gemm<1024, 256, 256, 512, 512 * 256 * 2> g{(const bf16*)(ws + WS_XC), (const bf16*)(ws + WS_WQK)};
        pg8::GroupOrder S; S.init(MS, G, bx);
        EpiQK E{(bf16*)(ws + WS_QM), (bf16*)(ws + WS_KM)};
        pg8::gemm_phase<EpiQK, pg8::GroupOrder, true, true>(lds3, g, S, E);
    } else if constexpr (KIND == K_CPREP) phase_cprep(args, lds, vcu, G);
    else if constexpr (KIND == K_MIX) phase_mix(args, lds, pass, pbar);
    else if constexpr (KIND == K_POST) phase_post(args, lds, vcu, G);
    else if constexpr (KIND == K_OUT1) {
        pg8::Gemm<1536, 1536, 1536> g{(const bf16*)(ws + WS_ACAT), (const bf16*)(ws + WS_WOM)};
        pg8::StaticOrder S; S.init(MS, 1024, G, bx);
        EpiMerge E{(const bf16*)(ws + WS_P), (bf16*)(ws + WS_MG)};
        pg8::gemm_phase<EpiMerge, pg8::StaticOrder, true, true>(lds3, g, S, E);
    } else if constexpr (KIND == K_OUT2) {
        pg8::Gemm<1024, 1024, 1024> g{(const bf16*)(ws + WS_MG), (const bf16*)(ws + WS_WO)};
        pg8::StaticOrder S; S.init(MS, 1024, G, bx);
        EpiOut E{args.x, args.out, (const float*)(ws + WS_MOD) + 2048, (float*)(ws + WS_CTL) + CW_ROWSS, pass * MS};
        pg8::gemm_phase<EpiOut, pg8::StaticOrder, true, true>(lds3, g, S, E);
    }
}

#if !MK_ONE_LAUNCH
template <int KIND>
__global__ void __launch_bounds__(NTHR, 2) k_phase(Args args) {
    extern __shared__ __attribute__((aligned(16))) unsigned char lds[];
    run_phase<KIND>(args, lds, args.ph_lo);
}
#else
__global__ void __launch_bounds__(NTHR, 2) mk_fwd(Args args) {
    extern __shared__ __attribute__((aligned(16))) unsigned char lds[];
    volatile LAS unsigned* misc = (volatile LAS unsigned*)((LAS unsigned char*)lds + 131072 + 2048);
    if (threadIdx.x < 16) misc[threadIdx.x] = 0u;
    __syncthreads();
    XcdBarrier bar = xcd_barrier_post((unsigned*)(args.ws + WS_CTL) + CW_BAR, misc + 8);
#ifdef PROBE_TMASK
    unsigned long long pr_acc = 0ull;
#endif
    for (int gp = args.ph_lo; gp < args.ph_hi; ++gp) {
#ifdef PROBE_TMASK
        const unsigned long long pr_t0 = __builtin_amdgcn_s_memrealtime();
        int pr_kind;
        if (gp == 0) pr_kind = K_PROLOGUE; else if (gp == 1) pr_kind = K_H; else if (gp == PH_TOTAL - 1) pr_kind = K_NORM;
        else { const int k = (gp - 2) % PH_PER_PASS; pr_kind = k == 0 ? K_INPROJ : k == 1 ? K_PREP : k == 2 ? K_QK : k == 3 ? K_CPREP : k == 4 ? K_MIX : k == 5 ? K_POST : k == 6 ? K_OUT1 : K_OUT2; }
#endif
        if (gp == 0) run_phase<K_PROLOGUE>(args, lds, 0);
        else if (gp == 1) run_phase<K_H>(args, lds, 0);
        else if (gp == PH_TOTAL - 1) run_phase<K_NORM>(args, lds, 0);
        else {
            const int pass = (gp - 2) / PH_PER_PASS, k = (gp - 2) % PH_PER_PASS;
            if (k == 0) run_phase<K_INPROJ>(args, lds, pass);
            else if (k == 1) run_phase<K_PREP>(args, lds, pass);
            else if (k == 2) run_phase<K_QK>(args, lds, pass);
            else if (k == 3) run_phase<K_CPREP>(args, lds, pass);
            else if (k == 4) run_phase<K_MIX>(args, lds, pass, &bar);
            else if (k == 5) run_phase<K_POST>(args, lds, pass);
            else if (k == 6) run_phase<K_OUT1>(args, lds, pass);
            else run_phase<K_OUT2>(args, lds, pass);
        }
#ifdef PROBE_TMASK
        const unsigned long long pr_tb = __builtin_amdgcn_s_memrealtime();
#endif
        if (gp + 1 < args.ph_hi) xcd_barrier(bar);
#ifdef PROBE_TMASK
        else __syncthreads();
        if ((PROBE_TMASK >> 11) & 1) pr_acc += __builtin_amdgcn_s_memrealtime() - pr_tb;
        if ((PROBE_TMASK >> pr_kind) & 1) pr_acc += __builtin_amdgcn_s_memrealtime() - pr_t0;
#endif
    }
#ifdef PROBE_TMASK
    if (blockIdx.x == 0) { const unsigned long long t1 = __builtin_amdgcn_s_memrealtime(); while (__builtin_amdgcn_s_memrealtime() - t1 < 4ull * pr_acc) __builtin_amdgcn_s_sleep(8); }
#endif
}
#endif

extern "C" void kernel_launch(void* const* d_in, const int* in_sizes, int n_in, void* d_out, int out_size, void* d_ws, size_t ws_size, hipStream_t stream) {
    static int grid = 0;
    if (grid == 0) {
        if (n_in != 19 || in_sizes[0] != MALL * DM || out_size != MALL * DM || ws_size < WS_END) { fprintf(stderr, "kernel_launch: unexpected shapes (n_in %d, ws %zu)\n", n_in, ws_size); grid = -1; return; }
        int dev = 0, cus = 0, per_cu = 0;
        (void)hipGetDevice(&dev); (void)hipDeviceGetAttribute(&cus, hipDeviceAttributeMultiprocessorCount, dev);
#if MK_ONE_LAUNCH
        (void)hipFuncSetAttribute((const void*)mk_fwd, hipFuncAttributeMaxDynamicSharedMemorySize, LDS_BYTES);
        (void)hipOccupancyMaxActiveBlocksPerMultiprocessor(&per_cu, (const void*)mk_fwd, NTHR, LDS_BYTES);
        if (per_cu < 1) { fprintf(stderr, "kernel_launch: occupancy query says %d\n", per_cu); per_cu = 1; }
#else
#define SETATTR(KIND) (void)hipFuncSetAttribute((const void*)k_phase<KIND>, hipFuncAttributeMaxDynamicSharedMemorySize, LDS_BYTES)
        SETATTR(K_PROLOGUE); SETATTR(K_H); SETATTR(K_INPROJ); SETATTR(K_PREP); SETATTR(K_QK); SETATTR(K_MIX); SETATTR(K_POST); SETATTR(K_OUT1); SETATTR(K_OUT2); SETATTR(K_NORM); SETATTR(K_CPREP);
        (void)per_cu;
#endif
        (void)hipGetLastError();
        grid = cus;
    }
    if (grid < 0) return;
    (void)hipMemsetAsync((char*)d_ws + WS_CTL, 0, CTL_ZERO_BYTES, stream);
    Args a{};
    a.x = (const float*)d_in[0]; a.c = (const float*)d_in[1]; a.pos = (const int*)d_in[2]; a.w_ada = (const float*)d_in[3]; a.b_ada = (const float*)d_in[4];
    a.g_norm = (const float*)d_in[5]; a.w_in = (const float*)d_in[6]; a.b_ig = (const float*)d_in[7]; a.b_fg = (const float*)d_in[8]; a.w_conv = (const float*)d_in[9];
    a.b_conv = (const float*)d_in[10]; a.w_q = (const float*)d_in[11]; a.w_k = (const float*)d_in[12]; a.g_head = (const float*)d_in[13]; a.skip = (const float*)d_in[14];
    a.w_om = (const float*)d_in[15]; a.w_oa = (const float*)d_in[16]; a.w_o = (const float*)d_in[17]; a.g_final = (const float*)d_in[18];
    a.out = (float*)d_out; a.ws = (unsigned char*)d_ws;
#if MK_ONE_LAUNCH
    a.ph_lo = 0; a.ph_hi = PH_TOTAL;
    void* params[] = {&a};
    hipError_t e = hipLaunchCooperativeKernel((const void*)mk_fwd, dim3(grid), dim3(NTHR), params, LDS_BYTES, stream);
    if (e != hipSuccess) fprintf(stderr, "cooperative launch failed: %s\n", hipGetErrorString(e));
#else
#define LAUNCH(KIND, PASS) do { a.ph_lo = (PASS); a.ph_hi = 0; hipLaunchKernelGGL(k_phase<KIND>, dim3(grid), dim3(NTHR), LDS_BYTES, stream, a); } while (0)
    LAUNCH(K_PROLOGUE, 0); LAUNCH(K_H, 0);
    for (int p = 0; p < NPASS; ++p) { LAUNCH(K_INPROJ, p); LAUNCH(K_PREP, p); LAUNCH(K_QK, p); LAUNCH(K_CPREP, p); LAUNCH(K_MIX, p); LAUNCH(K_POST, p); LAUNCH(K_OUT1, p); LAUNCH(K_OUT2, p); }
    LAUNCH(K_NORM, 0);
#endif
}
```

```cpp
#include <hip/hip_runtime.h>
#include <hip/hip_cooperative_groups.h>
#include <cstdio>
#include <cstdint>
namespace cg = cooperative_groups;

#ifndef MK_ONE_LAUNCH
#define MK_ONE_LAUNCH 1
#endif

__device__ __forceinline__ int opaque_tid() { int t = threadIdx.x; asm volatile("" : "+v"(t)); return t; }
namespace pg8 {
#define PG8_LAS __attribute__((address_space(3)))
typedef unsigned short bf16_t;
typedef short bf16x8 __attribute__((ext_vector_type(8)));
typedef float f32x4 __attribute__((ext_vector_type(4)));
typedef unsigned u32x4 __attribute__((ext_vector_type(4)));
constexpr int BM = 256, BK = 64, HALF = 128, HTB = HALF * BK * 2, STAGE_BYTES = 8 * HTB, NXCD = 8, WGM = 8;

__host__ __device__ __forceinline__ int lds_byte(int r, int c) { const int st = (r >> 4) * 2 + (c >> 5), rr = r & 15, cc = c & 31, ob = rr * 64 + cc * 2; return st * 1024 + (ob ^ (((ob >> 9) & 1) << 5)); }
__host__ __device__ __forceinline__ void stage_rc(int b, int& R, int& C) { const int st = b / 1024, sb = b % 1024, swz = sb ^ (((sb >> 9) & 1) << 5); R = (st >> 1) * 16 + swz / 64; C = (st & 1) * 32 + (swz % 64) / 2; }
__host__ __device__ __forceinline__ int perm32(int rho) { const int n = rho >> 4, i = rho & 15; return 8 * (i >> 2) + 4 * n + (i & 3); }

struct Unit { int pm, pn, g; };
template <int LDA, int LDB, int KK, int AGS = 0, int BGS = 0> struct Gemm {
    const bf16_t* A; const bf16_t* Bt;
    static constexpr int lda = LDA, ldb = LDB, K = KK;
    __device__ __forceinline__ const char* abase(const Unit& u) const { return (const char*)A + (size_t)(u.g * AGS) + (size_t)u.pm * (size_t)(BM * 2 * LDA); }
    __device__ __forceinline__ const char* bbase(const Unit& u) const { return (const char*)Bt + (size_t)(u.g * BGS) + (size_t)u.pn * (size_t)(BM * 2 * LDB); }
};

struct StaticOrder {
    int nM, nN, nwg, G, c;
    __host__ __device__ void init(int M, int N, int G_, int c_) { nM = M / BM; nN = N / BM; nwg = nM * nN; G = G_; c = c_; }
    __host__ __device__ bool next(int i, Unit& u) const {
        const long L = (long)i * G + c; if (L >= nwg) return false;
        int wgid = (int)L; { const int q = nwg / NXCD, r = nwg % NXCD, xcd = wgid % NXCD, off = wgid / NXCD; wgid = (xcd < r ? xcd * (q + 1) : r * (q + 1) + (xcd - r) * q) + off; }
        const int nig = WGM * nN, gid = wgid / nig, fm = gid * WGM, gsz = (nM - fm) < WGM ? (nM - fm) : WGM;
        u.pm = fm + ((wgid % nig) % gsz); u.pn = (wgid % nig) / gsz; u.g = 0; return true;
    }
    __device__ __forceinline__ void a_ready(const Unit&) const {}
    __device__ __forceinline__ void done(const Unit&) const {}
};
struct GroupOrder {
    int nunits, G, c;
    __host__ __device__ void init(int M, int G_, int c_) { nunits = (M / BM) * 8; G = G_; c = c_; }
    __host__ __device__ bool next(int i, Unit& u) const {
        const long L = (long)i * G + c; if (L >= nunits) return false;
        u.pm = (int)(L >> 3); u.g = (int)((L & 7) >> 1); u.pn = (int)(L & 1); return true;
    }
    __device__ __forceinline__ void a_ready(const Unit&) const {}
    __device__ __forceinline__ void done(const Unit&) const {}
};

__device__ __forceinline__ unsigned cvt_pk_bf16(float lo, float hi) { unsigned r; asm volatile("v_cvt_pk_bf16_f32 %0, %1, %2" : "=v"(r) : "v"(lo), "v"(hi)); return r; }

template <class Epi, class Sched, bool ALIGN_EPI, bool SP2, class GemmT>
__device__ __forceinline__ void gemm_phase(PG8_LAS unsigned char* lds, const GemmT g, const Sched& S, const Epi& E) {
    const int tid = opaque_tid(), wid = __builtin_amdgcn_readfirstlane(tid >> 6), lane = tid & 63, wr = wid >> 2, wc = wid & 3, fr = lane & 15, fq = lane >> 4;
    constexpr int K = GemmT::K, nt = K / BK;
    unsigned voffA[2], voffB[2];
#pragma unroll
    for (int i = 0; i < 2; ++i) { int R, C; stage_rc(tid * 16 + i * 8192, R, C); const int Rb = Epi::PERM ? (64 * (R >> 5) + perm32(R & 31)) : R;
        voffA[i] = (unsigned)(R * g.lda + C) * 2u; voffB[i] = (unsigned)(Rb * g.ldb + C) * 2u; }
    const size_t kstep = (size_t)(BK * 2);
    const size_t hstepA = (size_t)HALF * g.lda * 2, hstepB = (size_t)(Epi::PERM ? 32 : HALF) * g.ldb * 2;
    const unsigned ldsw = (unsigned)wid * 1024u;
    const int aoff = lds_byte(wr * 64 + fr, fq * 8), boff = lds_byte(wc * 32 + fr, fq * 8);
#define PG8_SA(b, h) (((b) * 2 + (h)) * HTB)
#define PG8_SB(b, h) ((4 + (b) * 2 + (h)) * HTB)
#define PG8_STAGE(bufoff, gbase, voff) do { _Pragma("unroll") for (int _i = 0; _i < 2; ++_i) \
        __builtin_amdgcn_global_load_lds((const unsigned*)((const char*)(gbase) + (voff)[_i]), (PG8_LAS unsigned*)(lds + (bufoff) + ldsw + _i * 8192), 16, 0, 0); } while (0)
#define PG8_LDA(dst, b, h) do { _Pragma("unroll") for (int m = 0; m < 4; ++m) _Pragma("unroll") for (int k = 0; k < 2; ++k) dst[m][k] = *(const PG8_LAS bf16x8*)(lds + PG8_SA(b, h) + aoff + m * 2048 + k * 1024); } while (0)
#define PG8_LDB(dst, b, h) do { _Pragma("unroll") for (int n = 0; n < 2; ++n) _Pragma("unroll") for (int k = 0; k < 2; ++k) dst[n][k] = *(const PG8_LAS bf16x8*)(lds + PG8_SB(b, h) + boff + n * 2048 + k * 1024); } while (0)
#define PG8_MMA(ai, bj, At, Bt) do { __builtin_amdgcn_s_setprio(1); _Pragma("unroll") for (int m = 0; m < 4; ++m) _Pragma("unroll") for (int n = 0; n < 2; ++n) _Pragma("unroll") for (int k = 0; k < 2; ++k) \
        acc[ai][bj][m][n] = __builtin_amdgcn_mfma_f32_16x16x32_bf16(Bt[n][k], At[m][k], acc[ai][bj][m][n], 0, 0, 0); __builtin_amdgcn_s_setprio(0); } while (0)
#define PG8_WAIT_V(n) asm volatile("s_waitcnt vmcnt(" #n ")" ::: "memory")
#define PG8_WAIT_L(n) asm volatile("s_waitcnt lgkmcnt(" #n ")" ::: "memory")
#define PG8_BAR __builtin_amdgcn_s_barrier()
#define PG8_SCHED __builtin_amdgcn_sched_barrier(0)
    Unit cur, nxt; int ui = 0;
    if (!S.next(0, cur)) return;
    f32x4 acc[2][2][4][2];
#pragma unroll
    for (int a = 0; a < 2; ++a)
#pragma unroll
        for (int b = 0; b < 2; ++b)
#pragma unroll
            for (int m = 0; m < 4; ++m)
#pragma unroll
                for (int n = 0; n < 2; ++n) acc[a][b][m][n] = (f32x4){0.f, 0.f, 0.f, 0.f};
    bf16x8 At[4][2], B0[2][2], B1[2][2];
    const char* cA = g.abase(cur); const char* cB = g.bbase(cur);
    S.a_ready(cur);
    if constexpr (SP2) {
        PG8_STAGE(PG8_SB(0, 0), cB, voffB); PG8_STAGE(PG8_SB(0, 1), cB + hstepB, voffB); PG8_STAGE(PG8_SA(0, 0), cA, voffA); PG8_STAGE(PG8_SA(0, 1), cA + hstepA, voffA);
        if (wr == 1) PG8_BAR;
        PG8_WAIT_V(2); PG8_BAR;
        PG8_STAGE(PG8_SB(1, 0), cB + kstep, voffB); PG8_STAGE(PG8_SA(1, 0), cA + kstep, voffA); PG8_STAGE(PG8_SB(1, 1), cB + hstepB + kstep, voffB);
        PG8_WAIT_V(6); PG8_BAR;
    } else {
        PG8_STAGE(PG8_SB(0, 0), cB, voffB); PG8_STAGE(PG8_SA(0, 0), cA, voffA); PG8_STAGE(PG8_SB(0, 1), cB + hstepB, voffB); PG8_STAGE(PG8_SA(0, 1), cA + hstepA, voffA);
        if (wr == 1) PG8_BAR;
        PG8_WAIT_V(4); PG8_BAR;
        PG8_STAGE(PG8_SB(1, 0), cB + kstep, voffB); PG8_STAGE(PG8_SA(1, 0), cA + kstep, voffA); PG8_STAGE(PG8_SB(1, 1), cB + hstepB + kstep, voffB);
        PG8_WAIT_V(6); PG8_BAR;
    }
    for (;;) {
        const bool has_next = S.next(ui + 1, nxt);
        const char* nA = has_next ? g.abase(nxt) : cA; const char* nB = has_next ? g.bbase(nxt) : cB;
#pragma nounroll
        for (int t = 0; t < nt; t += 2) {
            const bool last = (t == nt - 2);
            const char* a1 = cA + (size_t)(t + 1) * kstep;
            const char* a2 = last ? nA : cA + (size_t)(t + 2) * kstep; const char* b2 = last ? nB : cB + (size_t)(t + 2) * kstep;
            const char* a3 = a2 + kstep; const char* b3 = b2 + kstep;
            if (last && has_next) S.a_ready(nxt);
            if constexpr (Epi::HOOK_T >= 0) { if (t == Epi::HOOK_T) E.hook(acc, cur, wr, wc, fr, fq); }
            if constexpr (SP2) {
            PG8_LDB(B0, 0, 0); PG8_LDB(B1, 0, 1); PG8_SCHED; PG8_LDA(At, 0, 0); PG8_STAGE(PG8_SA(1, 1), a1 + hstepA, voffA);
            PG8_WAIT_V(8); PG8_WAIT_L(0); PG8_BAR; PG8_MMA(0, 0, At, B0); PG8_MMA(0, 1, At, B1); PG8_BAR; PG8_SCHED;
            PG8_LDA(At, 0, 1); PG8_STAGE(PG8_SB(0, 0), b2, voffB); PG8_STAGE(PG8_SB(0, 1), b2 + hstepB, voffB); PG8_STAGE(PG8_SA(0, 0), a2, voffA);
            PG8_WAIT_V(8); PG8_WAIT_L(0); PG8_BAR; PG8_MMA(1, 0, At, B0); PG8_MMA(1, 1, At, B1); PG8_BAR; PG8_SCHED;
            PG8_LDB(B0, 1, 0); PG8_LDB(B1, 1, 1); PG8_SCHED; PG8_LDA(At, 1, 0); PG8_STAGE(PG8_SA(0, 1), a2 + hstepA, voffA);
            PG8_WAIT_V(8); PG8_WAIT_L(0); PG8_BAR; PG8_MMA(0, 0, At, B0); PG8_MMA(0, 1, At, B1); PG8_BAR; PG8_SCHED;
            PG8_LDA(At, 1, 1); PG8_STAGE(PG8_SB(1, 0), b3, voffB); PG8_STAGE(PG8_SB(1, 1), b3 + hstepB, voffB); PG8_STAGE(PG8_SA(1, 0), a3, voffA);
            PG8_WAIT_V(8); PG8_WAIT_L(0); PG8_BAR; PG8_MMA(1, 0, At, B0); PG8_MMA(1, 1, At, B1); PG8_BAR; PG8_SCHED;
            } else {
            PG8_LDB(B0, 0, 0); PG8_SCHED; PG8_LDA(At, 0, 0); PG8_STAGE(PG8_SA(1, 1), a1 + hstepA, voffA);
            PG8_WAIT_L(8); PG8_BAR; PG8_WAIT_L(0); PG8_MMA(0, 0, At, B0); PG8_BAR; PG8_SCHED;
            PG8_LDB(B1, 0, 1); PG8_STAGE(PG8_SB(0, 0), b2, voffB);
            PG8_BAR; PG8_WAIT_L(0); PG8_MMA(0, 1, At, B1); PG8_BAR;
            PG8_LDA(At, 0, 1); PG8_STAGE(PG8_SA(0, 0), a2, voffA);
            PG8_BAR; PG8_WAIT_L(0); PG8_MMA(1, 0, At, B0); PG8_BAR; PG8_SCHED;
            PG8_STAGE(PG8_SB(0, 1), b2 + hstepB, voffB);
            PG8_WAIT_V(6); PG8_BAR; PG8_MMA(1, 1, At, B1); PG8_BAR;
            PG8_LDB(B0, 1, 0); PG8_SCHED; PG8_LDA(At, 1, 0); PG8_STAGE(PG8_SA(0, 1), a2 + hstepA, voffA);
            PG8_WAIT_L(8); PG8_BAR; PG8_WAIT_L(0); PG8_MMA(0, 0, At, B0); PG8_BAR; PG8_SCHED;
            PG8_LDB(B1, 1, 1); PG8_STAGE(PG8_SB(1, 0), b3, voffB);
            PG8_BAR; PG8_WAIT_L(0); PG8_MMA(0, 1, At, B1); PG8_BAR;
            PG8_LDA(At, 1, 1); PG8_STAGE(PG8_SA(1, 0), a3, voffA);
            PG8_BAR; PG8_WAIT_L(0); PG8_MMA(1, 0, At, B0); PG8_BAR; PG8_SCHED;
            PG8_STAGE(PG8_SB(1, 1), b3 + hstepB, voffB);
            PG8_WAIT_V(6); PG8_BAR; PG8_MMA(1, 1, At, B1); PG8_BAR;
            }
        }
        if constexpr (ALIGN_EPI) { if (wr == 0) PG8_BAR; }
        E(acc, cur, wr, wc, fr, fq); S.done(cur);
        if (!has_next) break;
#pragma unroll
        for (int a = 0; a < 2; ++a)
#pragma unroll
            for (int b = 0; b < 2; ++b)
#pragma unroll
                for (int m = 0; m < 4; ++m)
#pragma unroll
                    for (int n = 0; n < 2; ++n) acc[a][b][m][n] = (f32x4){0.f, 0.f, 0.f, 0.f};
        cur = nxt; cA = nA; cB = nB; ++ui;
        if constexpr (ALIGN_EPI) { if (wr == 1) PG8_BAR; }
    }
    PG8_WAIT_V(0);
    if constexpr (!ALIGN_EPI) { if (wr == 0) PG8_BAR; }
    PG8_BAR;
#undef PG8_SA
#undef PG8_SB
#undef PG8_STAGE
#undef PG8_LDA
#undef PG8_LDB
#undef PG8_MMA
#undef PG8_WAIT_V
#undef PG8_WAIT_L
#undef PG8_BAR
#undef PG8_SCHED
}
}

constexpr int NWAVES = 8, NTHR = 512;
constexpr int DM = 1024, NBATCH = 16, SEQ = 4096, MALL = NBATCH * SEQ;
constexpr int NB_PASS = 4, MS = NB_PASS * SEQ, NPASS = NBATCH / NB_PASS;
constexpr int INW_SRC = 11272, INW = 11264;
constexpr int C_XA = 0, C_VA = 1024, C_OA = 2048, C_ZA = 3072, C_QA = 4096, C_KA = 5632, C_VT = 7168, C_ZB = 8704, C_GA = 9216, C_GB = 10240;
constexpr float EPS = 1e-6f;

constexpr size_t MiB = 1u << 20;
constexpr size_t WS_CTL = 0, CTL_ZERO_BYTES = 1 * MiB;
constexpr size_t WS_MOD = 1 * MiB;
constexpr size_t WS_WG = 1 * MiB + 256 * 1024;
constexpr size_t WS_WIN = 2 * MiB;
constexpr size_t WS_WQK = 24 * MiB;
constexpr size_t WS_WOM = 25 * MiB, WS_WOA = 27 * MiB, WS_WO = 28 * MiB;
constexpr size_t WS_IG = 30 * MiB, WS_FG = 31 * MiB;
constexpr size_t WS_GSC = 32 * MiB;
constexpr size_t WS_LSE = 34 * MiB;
constexpr size_t WS_DEN = 35 * MiB;
constexpr size_t WS_H = 36 * MiB;
constexpr size_t WS_P = 164 * MiB;
constexpr size_t WS_XC = 516 * MiB;
constexpr size_t WS_QM = 548 * MiB, WS_KM = 580 * MiB;
constexpr size_t WS_HR = 612 * MiB;
constexpr size_t WS_AO = 644 * MiB;
constexpr size_t WS_UA = 692 * MiB;
constexpr size_t WS_ACAT = 708 * MiB;
constexpr size_t WS_MG = 772 * MiB;
constexpr size_t WS_SG = 804 * MiB;
constexpr size_t WS_KTG = 812 * MiB;
constexpr size_t WS_VTG = 844 * MiB;
constexpr size_t WS_CS = 876 * MiB;
constexpr size_t WS_NS = 1004 * MiB;
constexpr size_t WS_ROPE = 1005 * MiB;
constexpr size_t WS_END = 1013 * MiB;
constexpr int CW_QCTR = 1024;
constexpr int CW_ROWSS = 65536;
static_assert((CW_ROWSS + MALL) * 4 <= (int)CTL_ZERO_BYTES, "ctl");

constexpr int LDS_BYTES = 147456;

typedef unsigned short bf16;
typedef float f32x4 __attribute__((ext_vector_type(4)));
typedef float f32x2 __attribute__((ext_vector_type(2)));
typedef short bf16x8 __attribute__((ext_vector_type(8)));
typedef unsigned u32x4 __attribute__((ext_vector_type(4)));
typedef unsigned u32x2 __attribute__((ext_vector_type(2)));
typedef short s16x4 __attribute__((ext_vector_type(4)));

__device__ __forceinline__ unsigned f2bf(float f) { unsigned u = __builtin_bit_cast(unsigned, f); return (u + 0x7fffu + ((u >> 16) & 1u)) >> 16; }
__device__ __forceinline__ unsigned pk2(float lo, float hi) { return f2bf(lo) | (f2bf(hi) << 16); }
__device__ __forceinline__ float bflo(unsigned w) { return __builtin_bit_cast(float, w << 16); }
__device__ __forceinline__ float bfhi(unsigned w) { return __builtin_bit_cast(float, w & 0xffff0000u); }
__device__ __forceinline__ float bf1(bf16 v) { return __builtin_bit_cast(float, (unsigned)v << 16); }
__device__ __forceinline__ float sigmoidf_(float x) { return 1.f / (1.f + __expf(-x)); }
__device__ __forceinline__ float siluf_(float x) { return x / (1.f + __expf(-x)); }
__device__ __forceinline__ float wave_sum(float v) {
#pragma unroll
    for (int o = 1; o < 64; o <<= 1) v += __shfl_xor(v, o);
    return v;
}
__device__ __forceinline__ void unpack8(const u32x4 w, float* f) {
    f[0] = bflo(w.x); f[1] = bfhi(w.x); f[2] = bflo(w.y); f[3] = bfhi(w.y); f[4] = bflo(w.z); f[5] = bfhi(w.z); f[6] = bflo(w.w); f[7] = bfhi(w.w);
}

struct Args {
    const float* x; const float* c; const int* pos; const float* w_ada; const float* b_ada; const float* g_norm; const float* w_in;
    const float* b_ig; const float* b_fg; const float* w_conv; const float* b_conv; const float* w_q; const float* w_k; const float* g_head;
    const float* skip; const float* w_om; const float* w_oa; const float* w_o; const float* g_final;
    float* out; unsigned char* ws; int ph_lo, ph_hi;
};

__device__ __forceinline__ void transpose_item(const float* W, int K, int Nsrc, int nblk, int src_col_off, bf16* WT, int ldt, int row_off, float scale, float* scr, int item, int lane, bool frag = false) {
    const int kb = item / nblk, nb = item % nblk, k0 = 64 * kb, n0 = 32 * nb;
#pragma unroll 8
    for (int i = 0; i < 32; ++i) { const int kk = 2 * i + (lane >> 5); scr[kk * 33 + (lane & 31)] = W[(size_t)(k0 + kk) * Nsrc + src_col_off + n0 + (lane & 31)]; }
    __builtin_amdgcn_wave_barrier();
    asm volatile("s_waitcnt lgkmcnt(0)" ::: "memory");
    const int cc = lane & 7;
#pragma unroll
    for (int j = 0; j < 4; ++j) { const int n = (lane >> 3) + 8 * j; const float* s = scr + (8 * cc) * 33 + n;
        u32x4 o; o.x = pk2(s[0 * 33] * scale, s[1 * 33] * scale); o.y = pk2(s[2 * 33] * scale, s[3 * 33] * scale); o.z = pk2(s[4 * 33] * scale, s[5 * 33] * scale); o.w = pk2(s[6 * 33] * scale, s[7 * 33] * scale);
        if (frag) { const int nn = row_off + n0 + n, kc = (k0 >> 3) + cc; *(u32x4*)(WT + (size_t)((((nn >> 4) * (K >> 5) + (kc >> 2)) * 64 + (kc & 3) * 16 + (nn & 15)) * 8)) = o; }
        else *(u32x4*)(WT + (size_t)(row_off + n0 + n) * ldt + k0 + 8 * cc) = o; }
    asm volatile("s_waitcnt lgkmcnt(0)" ::: "memory");
    __builtin_amdgcn_wave_barrier();
}

__device__ __forceinline__ void phase_prologue(const Args& a, unsigned char* lds, int vcu, int G) {
    const int tid = opaque_tid(), lane = tid & 63, wave = tid >> 6;
    unsigned char* ws = a.ws;
    if (vcu < 48) {
        float* sc = (float*)lds;
        float* red = (float*)(lds + 65536);
        for (int i = tid; i < 16 * 1024; i += NTHR) sc[i] = siluf_(a.c[i]);
        __syncthreads();
        const int n = vcu * 64 + lane;
        float acc[16];
#pragma unroll
        for (int b = 0; b < 16; ++b) acc[b] = 0.f;
        const int k0 = wave * 128;
#pragma unroll 16
        for (int k = k0; k < k0 + 128; ++k) { const float w = a.w_ada[(size_t)k * 3072 + n];
#pragma unroll
            for (int b = 0; b < 16; ++b) acc[b] += sc[b * 1024 + k] * w; }
#pragma unroll
        for (int b = 0; b < 16; ++b) red[(wave * 16 + b) * 64 + lane] = acc[b];
        __syncthreads();
        float* mod = (float*)(ws + WS_MOD);
        for (int i = tid; i < 16 * 64; i += NTHR) { const int b = i >> 6, l = i & 63, nn = vcu * 64 + l; float s = 0.f;
#pragma unroll
            for (int w = 0; w < 8; ++w) s += red[(w * 16 + b) * 64 + l];
            s += a.b_ada[nn];
            const int part = nn >> 10, col = nn & 1023;
            if (part == 1) s = a.g_norm[col] * (1.f + s);
            mod[b * 3072 + nn] = s; }
        __syncthreads();
    }
    {
        float* scr = (float*)lds + wave * (64 * 33);
        const int gw = vcu * NWAVES + wave, NGW = G * NWAVES;
        constexpr int I_IN = (1024 / 64) * (INW / 32);
        constexpr int I_QK = 8 * (256 / 64) * (256 / 32);
        constexpr int I_OM = 16 * 32, I_OA = 8 * 32, I_O = 16 * 32;
        constexpr int NITEMS = I_IN + I_QK + I_OM + I_OA + I_O;
        for (int it = gw; it < NITEMS; it += NGW) {
            int r = it;
            if (r < I_IN) { const int nb = r % (INW / 32); const int off = (nb * 32 >= 4096) ? 8 : 0;
                transpose_item(a.w_in, 1024, INW_SRC, INW / 32, off, (bf16*)(ws + WS_WIN), 1024, 0, 1.f, scr, r, lane); continue; } r -= I_IN;
            if (r < I_QK) { const int mtx = r >> 5, rr = r & 31, h = mtx >> 1, isk = mtx & 1;
                const float* W = (isk ? a.w_k : a.w_q) + (size_t)h * 65536;
                transpose_item(W, 256, 256, 8, 0, (bf16*)(ws + WS_WQK) + (size_t)h * 512 * 256, 256, isk * 256, isk ? 0.0625f : 1.f, scr, rr, lane, true); continue; } r -= I_QK;
            if (r < I_OM) { transpose_item(a.w_om, 1024, 1024, 32, 0, (bf16*)(ws + WS_WOM), 1536, 0, 1.f, scr, r, lane); continue; } r -= I_OM;
            if (r < I_OA) { transpose_item(a.w_oa, 512, 1024, 32, 0, (bf16*)(ws + WS_WOM) + 1024, 1536, 0, 1.f, scr, r, lane); continue; } r -= I_OA;
            transpose_item(a.w_o, 1024, 1024, 32, 0, (bf16*)(ws + WS_WO), 1024, 0, 1.f, scr, r, lane);
        }
        float* wg = (float*)(ws + WS_WG);
        for (int i = (vcu * NTHR + tid); i < 8 * 1024; i += G * NTHR) { const int j = i >> 10, k = i & 1023; wg[i] = a.w_in[(size_t)k * INW_SRC + 4096 + j]; }
    }
}

__constant__ double c_inv_freq[16] = {1.0, 0.44036660267178046, 0.19392274474868576, 0.08539710028576561, 0.03760603093086393, 0.016560440080994446, 0.007292664737217109, 0.003211445994752591,
    0.001414213562373095, 0.000622772421914596, 0.0002742481756762073, 0.00012076973741146504, 5.318295896944988e-05, 2.341999896140934e-05, 1.031338537721246e-05, 4.5416704806078695e-06};

__device__ __forceinline__ void phase_h(const Args& a, unsigned char* lds, int vcu, int G) {
    const int tid = opaque_tid(), lane = tid & 63, wave = tid >> 6;
    unsigned char* ws = a.ws;
    float* wg = (float*)lds;
    { const float* src = (const float*)(ws + WS_WG); for (int i = tid; i < 8192; i += NTHR) wg[i] = src[i]; }
    __syncthreads();
    const float* mod = (const float*)(ws + WS_MOD);
    bf16* H = (bf16*)(ws + WS_H);
    float* IG = (float*)(ws + WS_IG); float* FG = (float*)(ws + WS_FG); float* ROPE = (float*)(ws + WS_ROPE);
    const int gw = vcu * NWAVES + wave, NGW = G * NWAVES;
    for (int row0 = 2 * gw; row0 < MALL; row0 += 2 * NGW) {
        f32x4 v[2][4]; float ss[2] = {0.f, 0.f};
#pragma unroll
        for (int rr = 0; rr < 2; ++rr) { const f32x4* xr = (const f32x4*)(a.x + (size_t)(row0 + rr) * DM) + lane;
#pragma unroll
            for (int j = 0; j < 4; ++j) v[rr][j] = xr[64 * j]; }
        { const int rr = lane >> 5, fi = lane & 15; const int pos = a.pos[row0 + rr];
            const double rev = (double)pos * c_inv_freq[fi] * 0.15915494309189535; const float fr_ = (float)(rev - rint(rev));
            ROPE[(size_t)row0 * 32 + lane] = (lane & 16) ? __builtin_amdgcn_sinf(fr_) : __builtin_amdgcn_cosf(fr_); }
#pragma unroll
        for (int rr = 0; rr < 2; ++rr) {
#pragma unroll
            for (int j = 0; j < 4; ++j) ss[rr] += (v[rr][j].x * v[rr][j].x + v[rr][j].y * v[rr][j].y) + (v[rr][j].z * v[rr][j].z + v[rr][j].w * v[rr][j].w);
        }
#pragma unroll
        for (int o = 1; o < 64; o <<= 1) { ss[0] += __shfl_xor(ss[0], o); ss[1] += __shfl_xor(ss[1], o); }
        const int b = row0 >> 12;
        float pg[2][8];
#pragma unroll
        for (int rr = 0; rr < 2; ++rr)
#pragma unroll
            for (int g = 0; g < 8; ++g) pg[rr][g] = 0.f;
        const float rinv[2] = {1.f / sqrtf(ss[0] * (1.f / DM) + EPS), 1.f / sqrtf(ss[1] * (1.f / DM) + EPS)};
#pragma unroll
        for (int j = 0; j < 4; ++j) {
            const int col = 4 * lane + 256 * j;
            const f32x4 sh = *(const f32x4*)(mod + b * 3072 + col), gs = *(const f32x4*)(mod + b * 3072 + 1024 + col);
            f32x4 h[2];
#pragma unroll
            for (int rr = 0; rr < 2; ++rr) { h[rr] = v[rr][j] * rinv[rr] * gs + sh;
                u32x2 o; o.x = pk2(h[rr].x, h[rr].y); o.y = pk2(h[rr].z, h[rr].w); *((u32x2*)(H + (size_t)(row0 + rr) * DM) + lane + 64 * j) = o; }
#pragma unroll
            for (int g = 0; g < 8; ++g) { const f32x4 w = *(const f32x4*)(wg + g * 1024 + col);
                pg[0][g] += (h[0].x * w.x + h[0].y * w.y) + (h[0].z * w.z + h[0].w * w.w); pg[1][g] += (h[1].x * w.x + h[1].y * w.y) + (h[1].z * w.z + h[1].w * w.w); }
            __builtin_amdgcn_sched_barrier(0);
        }
#pragma unroll
        for (int o = 1; o < 64; o <<= 1)
#pragma unroll
            for (int g = 0; g < 8; ++g) { pg[0][g] += __shfl_xor(pg[0][g], o); pg[1][g] += __shfl_xor(pg[1][g], o); }
        if (lane < 2) { const int rr = lane; const float* p = rr ? pg[1] : pg[0];
            f32x4 ig = {p[0] + a.b_ig[0], p[1] + a.b_ig[1], p[2] + a.b_ig[2], p[3] + a.b_ig[3]};
            f32x4 fg = {p[4] + a.b_fg[0], p[5] + a.b_fg[1], p[6] + a.b_fg[2], p[7] + a.b_fg[3]};
            *(f32x4*)(IG + (size_t)(row0 + rr) * 4) = ig; *(f32x4*)(FG + (size_t)(row0 + rr) * 4) = fg; }
    }
}

struct EpiProj {
    static constexpr bool PERM = true; static constexpr int HOOK_T = -1;
    bf16* P; const float* rope;
    __device__ __forceinline__ void operator()(const f32x4 (&acc)[2][2][4][2], const pg8::Unit& u, int wr, int wc, int fr, int fq) const {
        const int row0 = u.pm * 256 + wr * 64 + fr, col0 = u.pn * 256 + wc * 64 + 8 * fq;
        const bool rot = (u.pn >= 16) && (u.pn < 28) && ((wc & 1) == 0);
#pragma unroll
        for (int ai = 0; ai < 2; ++ai)
#pragma unroll
            for (int m = 0; m < 4; ++m) { const int r = row0 + ai * 128 + m * 16; bf16* rowp = P + (size_t)r * INW + col0;
#pragma unroll
                for (int bj = 0; bj < 2; ++bj) { f32x4 v0 = acc[ai][bj][m][0], v1 = acc[ai][bj][m][1];
                    if (bj == 0 && rot) {
                        const float* tp = rope + (size_t)r * 32 + 8 * (fq & 1);
                        const f32x4 c0 = *(const f32x4*)tp, c1 = *(const f32x4*)(tp + 4), s0 = *(const f32x4*)(tp + 16), s1 = *(const f32x4*)(tp + 20);
                        f32x4 p0, p1;
#pragma unroll
                        for (int e = 0; e < 4; ++e) { p0[e] = __shfl_xor(v0[e], 32); p1[e] = __shfl_xor(v1[e], 32); }
                        const float sg = (fq < 2) ? -1.f : 1.f;
                        v0 = v0 * c0 + p0 * s0 * sg; v1 = v1 * c1 + p1 * s1 * sg;
                    }
                    u32x4 w; w.x = pg8::cvt_pk_bf16(v0[0], v0[1]); w.y = pg8::cvt_pk_bf16(v0[2], v0[3]); w.z = pg8::cvt_pk_bf16(v1[0], v1[1]); w.w = pg8::cvt_pk_bf16(v1[2], v1[3]);
                    *(u32x4*)(rowp + bj * 32) = w; } }
    }
};
struct EpiQK {
    static constexpr bool PERM = true; static constexpr int HOOK_T = -1;
    bf16* QM; bf16* KM;
    __device__ __forceinline__ void operator()(const f32x4 (&acc)[2][2][4][2], const pg8::Unit& u, int wr, int wc, int fr, int fq) const {
        const int row0 = u.pm * 256 + wr * 64 + fr, col0 = u.g * 256 + wc * 64 + 8 * fq;
        bf16* base = u.pn ? KM : QM;
#pragma unroll
        for (int ai = 0; ai < 2; ++ai)
#pragma unroll
            for (int m = 0; m < 4; ++m) { bf16* rowp = base + (size_t)(row0 + ai * 128 + m * 16) * 1024 + col0;
#pragma unroll
                for (int bj = 0; bj < 2; ++bj) { const f32x4 v0 = acc[ai][bj][m][0], v1 = acc[ai][bj][m][1];
                    u32x4 w; w.x = pg8::cvt_pk_bf16(v0[0], v0[1]); w.y = pg8::cvt_pk_bf16(v0[2], v0[3]); w.z = pg8::cvt_pk_bf16(v1[0], v1[1]); w.w = pg8::cvt_pk_bf16(v1[2], v1[3]);
                    *(u32x4*)(rowp + bj * 32) = w; } }
    }
};
struct EpiMerge {
    static constexpr bool PERM = true; static constexpr int HOOK_T = 16;
    const bf16* P; bf16* MG;
    __device__ __forceinline__ void hook(f32x4 (&acc)[2][2][4][2], const pg8::Unit& u, int wr, int wc, int fr, int fq) const {
        int row0 = u.pm * 256 + wr * 64 + fr, col0 = u.pn * 256 + wc * 64 + 8 * fq;
        asm volatile("" : "+v"(row0), "+v"(col0));
#pragma unroll
        for (int ai = 0; ai < 2; ++ai)
#pragma unroll
            for (int m = 0; m < 4; ++m) { const size_t r = (size_t)(row0 + ai * 128 + m * 16);
#pragma unroll
                for (int bj = 0; bj < 2; ++bj) { const int c = col0 + bj * 32;
                    const u32x4 gaw = *(const u32x4*)(P + r * INW + C_GA + c), gbw = *(const u32x4*)(P + r * INW + C_GB + c);
                    float ga[8], gb[8]; unpack8(gaw, ga); unpack8(gbw, gb);
#pragma unroll
                    for (int e = 0; e < 4; ++e) {
                        acc[ai][bj][m][0][e] *= (1.f + __expf(-gb[e])) / (1.f + __expf(-ga[e]));
                        acc[ai][bj][m][1][e] *= (1.f + __expf(-gb[4 + e])) / (1.f + __expf(-ga[4 + e])); } }
                __builtin_amdgcn_sched_barrier(0); }
    }
    __device__ __forceinline__ void operator()(const f32x4 (&acc)[2][2][4][2], const pg8::Unit& u, int wr, int wc, int fr, int fq) const {
        const int row0 = u.pm * 256 + wr * 64 + fr, col0 = u.pn * 256 + wc * 64 + 8 * fq;
#pragma unroll
        for (int ai = 0; ai < 2; ++ai)
#pragma unroll
            for (int m = 0; m < 4; ++m) { const size_t r = (size_t)(row0 + ai * 128 + m * 16);
#pragma unroll
                for (int bj = 0; bj < 2; ++bj) { const int c = col0 + bj * 32;
                    const u32x4 gbw = *(const u32x4*)(P + r * INW + C_GB + c); float gb[8]; unpack8(gbw, gb);
                    const f32x4 v0 = acc[ai][bj][m][0], v1 = acc[ai][bj][m][1];
                    float o[8];
#pragma unroll
                    for (int e = 0; e < 4; ++e) { o[e] = sigmoidf_(gb[e]) * v0[e]; o[4 + e] = sigmoidf_(gb[4 + e]) * v1[e]; }
                    u32x4 w; w.x = pg8::cvt_pk_bf16(o[0], o[1]); w.y = pg8::cvt_pk_bf16(o[2], o[3]); w.z = pg8::cvt_pk_bf16(o[4], o[5]); w.w = pg8::cvt_pk_bf16(o[6], o[7]);
                    *(u32x4*)(MG + r * 1024 + c) = w; } }
    }
};
struct EpiOut {
    static constexpr bool PERM = true; static constexpr int HOOK_T = -1;
    const float* x; bf16* xn; const float* gate; float* rowss; int grow0;
    __device__ __forceinline__ void operator()(const f32x4 (&acc)[2][2][4][2], const pg8::Unit& u, int wr, int wc, int fr, int fq) const {
        const int row0 = grow0 + u.pm * 256 + wr * 64 + fr, col0 = u.pn * 256 + wc * 64 + 8 * fq;
#pragma unroll
        for (int ai = 0; ai < 2; ++ai)
#pragma unroll
            for (int m = 0; m < 4; ++m) { const int r = row0 + ai * 128 + m * 16; const int b = r >> 12; float ss = 0.f;
#pragma unroll
                for (int bj = 0; bj < 2; ++bj) { const int c = col0 + bj * 32;
                    const float* gp = gate + b * 3072 + c; const f32x4 g0 = *(const f32x4*)gp, g1 = *(const f32x4*)(gp + 4);
                    const float* xp = x + (size_t)r * 1024 + c; const f32x4 x0 = *(const f32x4*)xp, x1 = *(const f32x4*)(xp + 4);
                    const f32x4 o0 = x0 + g0 * acc[ai][bj][m][0], o1 = x1 + g1 * acc[ai][bj][m][1];
                    ss += (o0[0] * o0[0] + o0[1] * o0[1]) + (o0[2] * o0[2] + o0[3] * o0[3]) + (o1[0] * o1[0] + o1[1] * o1[1]) + (o1[2] * o1[2] + o1[3] * o1[3]);
                    u32x4 w; w.x = pg8::cvt_pk_bf16(o0[0], o0[1]); w.y = pg8::cvt_pk_bf16(o0[2], o0[3]); w.z = pg8::cvt_pk_bf16(o1[0], o1[1]); w.w = pg8::cvt_pk_bf16(o1[2], o1[3]);
                    *(u32x4*)(xn + (size_t)r * 1024 + c) = w; }
                ss += __shfl_xor(ss, 16); ss += __shfl_xor(ss, 32);
                if (fq == 0) atomicAdd(rowss + r, ss); }
    }
};

__device__ __forceinline__ void phase_prep(const Args& a, unsigned char* lds, int vcu, int G, int pass) {
    const int tid = opaque_tid(), lane = tid & 63, wave = tid >> 6;
    unsigned char* ws = a.ws;
    bf16* P = (bf16*)(ws + WS_P);
    if (vcu < NB_PASS * 4) {
        const int bl = vcu >> 2, h = vcu & 3;
        const float* IG = (const float*)(ws + WS_IG); const float* FG = (const float*)(ws + WS_FG);
        float* gsc = (float*)(ws + WS_GSC);
        float* A1 = gsc, *B1 = gsc + MS * 4, *WI = gsc + 2 * MS * 4, *EF = gsc + 3 * MS * 4, *WK = gsc + 4 * MS * 4, *DEC = gsc + 5 * MS * 4;
        float* cg = (float*)lds; float* cp = cg + 64;
        float f[8], ii[8];
#pragma unroll
        for (int q = 0; q < 8; ++q) { const size_t grow = (size_t)pass * MS + bl * SEQ + (wave * 8 + q) * 64 + lane; f[q] = FG[grow * 4 + h]; ii[q] = IG[grow * 4 + h]; }
        float acs[8], b1[8], pm[8];
#pragma unroll
        for (int q = 0; q < 8; ++q) {
            float x = fminf(f[q], 0.f) - log1pf(expf(-fabsf(f[q])));
#pragma unroll
            for (int o = 1; o < 64; o <<= 1) { const float t = __shfl_up(x, o); if (lane >= o) x += t; }
            acs[q] = x; b1[q] = ii[q] - x;
            float m = b1[q];
#pragma unroll
            for (int o = 1; o < 64; o <<= 1) { const float t = __shfl_up(m, o); if (lane >= o) m = fmaxf(m, t); }
            pm[q] = m;
            if (lane == 63) { cg[wave * 8 + q] = x; cp[wave * 8 + q] = m; }
        }
        __syncthreads();
        float m_prev = 0.f, mp[8], Ms8[8];
        for (int j = 0; j < 64; ++j) { const float Ms = fmaxf(m_prev, cp[j]);
#pragma unroll
            for (int q = 0; q < 8; ++q) if (j == wave * 8 + q) { mp[q] = m_prev; Ms8[q] = Ms; }
            m_prev = cg[j] + Ms; }
#pragma unroll
        for (int q = 0; q < 8; ++q) {
            const int j = wave * 8 + q, lrow = bl * SEQ + j * 64 + lane;
            const float mx = fmaxf(mp[q], pm[q]);
            A1[h * MS + lrow] = -mx; B1[h * MS + lrow] = b1[q]; WI[h * MS + lrow] = expf(mp[q] - mx); EF[h * MS + lrow] = expf(-(acs[q] + mx)); WK[h * MS + lrow] = expf(b1[q] - Ms8[q]);
            if (lane == 0) { DEC[h * (MS / 64) + bl * 64 + j] = expf(mp[q] - Ms8[q]); DEC[4 * (MS / 64) + h * (MS / 64) + bl * 64 + j] = Ms8[q]; }
        }
    }
    {
        bf16* XC = (bf16*)(ws + WS_XC);
        const int cg8 = (tid & 127) * 8, rq = tid >> 7;
        float wc[4][8], bc[8];
#pragma unroll
        for (int j = 0; j < 4; ++j)
#pragma unroll
            for (int e = 0; e < 8; ++e) wc[j][e] = a.w_conv[j * 1024 + cg8 + e];
#pragma unroll
        for (int e = 0; e < 8; ++e) bc[e] = a.b_conv[cg8 + e];
        for (int it = vcu; it < MS / 32; it += G) {
            const int r0 = it * 32 + rq * 8, t0 = r0 & (SEQ - 1);
            u32x4 w[11];
#pragma unroll
            for (int k = 0; k < 11; ++k) { const int rr = r0 - 3 + k; w[k] = (k >= 3 || t0 >= 3) ? *(const u32x4*)(P + (size_t)rr * INW + C_XA + cg8) : (u32x4){0u, 0u, 0u, 0u}; }
            float xin[11][8];
#pragma unroll
            for (int k = 0; k < 11; ++k) unpack8(w[k], xin[k]);
#pragma unroll
            for (int k = 0; k < 8; ++k) { float o[8];
#pragma unroll
                for (int e = 0; e < 8; ++e) o[e] = siluf_(bc[e] + wc[0][e] * xin[k][e] + wc[1][e] * xin[k + 1][e] + wc[2][e] * xin[k + 2][e] + wc[3][e] * xin[k + 3][e]);
                u32x4 ov; ov.x = pk2(o[0], o[1]); ov.y = pk2(o[2], o[3]); ov.z = pk2(o[4], o[5]); ov.w = pk2(o[6], o[7]);
                *(u32x4*)(XC + (size_t)(r0 + k) * 1024 + cg8) = ov; }
        }
    }
}

__device__ __forceinline__ f32x4 mfma16(bf16x8 a, bf16x8 b, f32x4 c) { return __builtin_amdgcn_mfma_f32_16x16x32_bf16(a, b, c, 0, 0, 0); }

constexpr int TPS = 72;
constexpr int XCS = 264;
constexpr int L_QC_X = 0, L_QC_Q = 36864, L_QC_KT = L_QC_Q + 64 * XCS * 2, L_QC_ST = L_QC_KT + 256 * TPS * 2, L_QC_END = L_QC_ST + 64 * TPS * 2;
static_assert(64 * XCS * 2 <= 36864 && 256 * TPS * 2 <= 36864 && L_QC_END <= 131072, "qkc lds");
__device__ __forceinline__ void phase_cprep(const Args& a, unsigned char* lds, int vcu, int G) {
    const int tid = opaque_tid(), lane = tid & 63, wave = __builtin_amdgcn_readfirstlane(tid >> 6);
    const int fr = lane & 15, fq = lane >> 4;
    unsigned char* ws = a.ws;
    const bf16* P = (const bf16*)(ws + WS_P); const bf16* XC = (const bf16*)(ws + WS_XC); bf16* QM = (bf16*)(ws + WS_QM);
    const bf16* WF = (const bf16*)(ws + WS_WQK);
    const float* gsc = (const float*)(ws + WS_GSC);
    const float* gA1 = gsc, *gWK = gsc + 4 * MS * 4, *gMS = gsc + 5 * MS * 4 + 4 * (MS / 64);
    bf16* SG = (bf16*)(ws + WS_SG); bf16* KTG = (bf16*)(ws + WS_KTG); bf16* VTG = (bf16*)(ws + WS_VTG);
    bf16* XS = (bf16*)(lds + L_QC_X); bf16* VT = (bf16*)(lds + L_QC_X); bf16* QL = (bf16*)(lds + L_QC_Q); bf16* KT = (bf16*)(lds + L_QC_KT); bf16* ST = (bf16*)(lds + L_QC_ST);
    const int ti = wave >> 1, tj0 = 2 * (wave & 1);
    for (int ci = vcu; ci < (MS / 64) * 4; ci += G) {
        const int h = ci & 3, t0 = (ci >> 2) * 64;
        u32x4 xw[4], vw[4];
#pragma unroll
        for (int i = 0; i < 4; ++i) { const int c = tid + NTHR * i, row = c >> 5, cc = c & 31;
            xw[i] = *(const u32x4*)(XC + (size_t)(t0 + row) * 1024 + h * 256 + 8 * cc); }
#pragma unroll
        for (int i = 0; i < 4; ++i) { const int c = tid + NTHR * i, l = c & 63, dc = c >> 6;
            vw[i] = *(const u32x4*)(P + (size_t)(t0 + l) * INW + C_VA + h * 256 + 8 * dc); }
        float wkr[4][4], a1l[4];
        if (wave >= 4) {
#pragma unroll
            for (int lt = 0; lt < 4; ++lt)
#pragma unroll
                for (int i = 0; i < 4; ++i) wkr[lt][i] = gWK[h * MS + t0 + 16 * lt + 4 * fq + i];
        }
#pragma unroll
        for (int i = 0; i < 4; ++i) a1l[i] = gA1[h * MS + t0 + 16 * ti + 4 * fq + i];
        const float msc = gMS[h * (MS / 64) + (ci >> 2)];
        __syncthreads();
#pragma unroll
        for (int i = 0; i < 4; ++i) { const int c = tid + NTHR * i, row = c >> 5, cc = c & 31; *(u32x4*)(XS + row * XCS + 8 * cc) = xw[i]; }
        __syncthreads();
        const bf16* wf = WF + (size_t)h * 512 * 256;
#pragma unroll 1
        for (int ct = 0; ct < 4; ++ct) {
            const int nt = 4 * wave + ct;
            bf16x8 bq[8];
#pragma unroll
            for (int ks = 0; ks < 8; ++ks) bq[ks] = *(const bf16x8*)(wf + (size_t)((nt * 8 + ks) * 64 + lane) * 8);
#pragma unroll
            for (int lt = 0; lt < 4; ++lt) {
                f32x4 acc = {0.f, 0.f, 0.f, 0.f};
#pragma unroll
                for (int ks = 0; ks < 8; ++ks) { const bf16x8 af = *(const bf16x8*)(XS + (16 * lt + fr) * XCS + 32 * ks + 8 * fq); acc = mfma16(af, bq[ks], acc); }
                if (wave < 4) {
#pragma unroll
                    for (int i = 0; i < 4; ++i) QL[(16 * lt + 4 * fq + i) * XCS + 64 * wave + 16 * ct + fr] = (bf16)f2bf(acc[i]);
                } else {
                    const int d = 64 * (wave - 4) + 16 * ct + fr;
                    u32x2 o; o.x = pk2(acc[0] * wkr[lt][0], acc[1] * wkr[lt][1]); o.y = pk2(acc[2] * wkr[lt][2], acc[3] * wkr[lt][3]);
                    *(u32x2*)(KT + d * TPS + 16 * lt + 4 * fq) = o;
                }
            }
        }
        __syncthreads();
#pragma unroll
        for (int i = 0; i < 4; ++i) { const int c = tid + NTHR * i, l = c & 63, dc = c >> 6;
            const u32x4 w = vw[i]; bf16* dv = VT + (8 * dc) * TPS + l;
            dv[0 * TPS] = (bf16)(w.x & 0xffff); dv[1 * TPS] = (bf16)(w.x >> 16); dv[2 * TPS] = (bf16)(w.y & 0xffff); dv[3 * TPS] = (bf16)(w.y >> 16);
            dv[4 * TPS] = (bf16)(w.z & 0xffff); dv[5 * TPS] = (bf16)(w.z >> 16); dv[6 * TPS] = (bf16)(w.w & 0xffff); dv[7 * TPS] = (bf16)(w.w >> 16); }
#pragma unroll
        for (int i = 0; i < 4; ++i) { const int c = tid + NTHR * i, row = c >> 5, cc = c & 31;
            *(u32x4*)(QM + (size_t)(t0 + row) * 1024 + h * 256 + 8 * cc) = *(const u32x4*)(QL + row * XCS + 8 * cc); }
#pragma unroll
        for (int tt = 0; tt < 2; ++tt) {
            const int tj = tj0 + tt;
            f32x4 sacc = {0.f, 0.f, 0.f, 0.f};
            if (tj <= ti) {
#pragma unroll
                for (int ks = 0; ks < 8; ++ks) {
                    const bf16x8 qf = *(const bf16x8*)(QL + (16 * ti + fr) * XCS + 32 * ks + 8 * fq);
                    const bf16* kp = KT + (32 * ks + 8 * fq + (fr >> 2)) * TPS + 16 * tj + 4 * (fr & 3);
                    const s16x4 k0 = __builtin_amdgcn_ds_read_tr16_b64_v4i16((__attribute__((address_space(3))) s16x4*)(kp));
                    const s16x4 k1 = __builtin_amdgcn_ds_read_tr16_b64_v4i16((__attribute__((address_space(3))) s16x4*)(kp + 4 * TPS));
                    bf16x8 kb; kb[0] = k0[0]; kb[1] = k0[1]; kb[2] = k0[2]; kb[3] = k0[3]; kb[4] = k1[0]; kb[5] = k1[1]; kb[6] = k1[2]; kb[7] = k1[3];
                    sacc = mfma16(qf, kb, sacc); }
            }
            const int sidx = 16 * tj + fr;
#pragma unroll
            for (int i = 0; i < 4; ++i) { const int l = 16 * ti + 4 * fq + i;
                float v = 0.f;
                if (sidx <= l) v = sacc[i] * __expf(a1l[i] + msc);
                ST[l * TPS + sidx] = (bf16)f2bf(v); }
        }
        __syncthreads();
        { const int row = tid >> 3, ch = tid & 7; *(u32x4*)(SG + (size_t)ci * 4096 + row * 64 + 8 * ch) = *(const u32x4*)(ST + row * TPS + 8 * ch); }
#pragma unroll
        for (int i = 0; i < 4; ++i) { const int p = tid + NTHR * i, blk = p >> 6, ln = p & 63, row = (blk >> 1) * 16 + (ln & 15), ch = (blk & 1) * 4 + (ln >> 4);
            *(u32x4*)(KTG + (size_t)ci * 16384 + p * 8) = *(const u32x4*)(KT + row * TPS + 8 * ch);
            *(u32x4*)(VTG + (size_t)ci * 16384 + p * 8) = *(const u32x4*)(VT + row * TPS + 8 * ch); }
    }
}

constexpr int SA_DEPTH = 5, SA_PATCH = 32 * 32 * 2 + 128;
struct ScanA { const bf16* KTG; const bf16* VTG; const float* gDEC; bf16* CS; float* NS; int bl, h, dblk, eblk, wave, fr, fq; unsigned koff, voff; bool do_den; };
struct ScanAOps { bf16x8 k[2][2], v[2][2]; float decay; };
__device__ __forceinline__ void scana_load(const ScanA& c, int j, ScanAOps& o) {
    const int ci = (c.bl * 64 + j) * 4 + c.h;
    const bf16* kb = c.KTG + (size_t)ci * 16384; const bf16* vb = c.VTG + (size_t)ci * 16384;
#pragma unroll
    for (int dt = 0; dt < 2; ++dt)
#pragma unroll
        for (int k2 = 0; k2 < 2; ++k2) o.k[dt][k2] = *(const bf16x8*)(kb + (c.koff + (unsigned)((dt * 2 + k2) * 512)));
#pragma unroll
    for (int et = 0; et < 2; ++et)
#pragma unroll
        for (int k2 = 0; k2 < 2; ++k2) o.v[et][k2] = *(const bf16x8*)(vb + (c.voff + (unsigned)((et * 2 + k2) * 512)));
    o.decay = c.gDEC[c.h * (MS / 64) + c.bl * 64 + j];
}
__device__ __forceinline__ void scana_step(const ScanA& c, unsigned char* lds, int j, f32x4 (&Cacc)[2][2], f32x4 (&Nacc)[2], const ScanAOps& o, const bf16x8 ones) {
    const int ci = (c.bl * 64 + j) * 4 + c.h;
    unsigned char* patch = lds + c.wave * SA_PATCH;
    const int lane = c.fq * 16 + c.fr;
#pragma unroll
    for (int dt = 0; dt < 2; ++dt) {
#pragma unroll
        for (int et = 0; et < 2; ++et) { const f32x4 cc = Cacc[dt][et]; u32x2 w; w.x = pk2(cc[0], cc[1]); w.y = pk2(cc[2], cc[3]);
            *(u32x2*)(patch + (16 * et + c.fr) * 64 + (16 * dt + 4 * c.fq) * 2) = w; }
        if (c.do_den && c.fr == 0) *(f32x4*)(patch + 2048 + (16 * dt + 4 * c.fq) * 4) = Nacc[dt];
    }
    { bf16* cs = c.CS + (size_t)ci * 65536 + (c.eblk * 8 + c.dblk) * 1024;
#pragma unroll
      for (int k = 0; k < 2; ++k) *(u32x4*)(cs + k * 512 + lane * 8) = *(const u32x4*)(patch + k * 1024 + lane * 16);
      if (c.do_den && lane < 8) *(f32x4*)(c.NS + (size_t)ci * 256 + c.dblk * 32 + lane * 4) = *(const f32x4*)(patch + 2048 + lane * 16); }
#pragma unroll
    for (int dt = 0; dt < 2; ++dt) {
#pragma unroll
        for (int et = 0; et < 2; ++et) {
            f32x4 cc = Cacc[dt][et] * o.decay;
#pragma unroll
            for (int k2 = 0; k2 < 2; ++k2) cc = mfma16(o.k[dt][k2], o.v[et][k2], cc);
            Cacc[dt][et] = cc;
        }
        if (c.do_den) {
            f32x4 cc = Nacc[dt] * o.decay;
#pragma unroll
            for (int k2 = 0; k2 < 2; ++k2) cc = mfma16(o.k[dt][k2], ones, cc);
            Nacc[dt] = cc;
        }
    }
}
__device__ __forceinline__ void scana_item(const Args& a, unsigned char* lds, int item) {
    const int tid = opaque_tid(), lane = tid & 63;
    unsigned char* ws = a.ws;
    ScanA c;
    c.wave = __builtin_amdgcn_readfirstlane(tid >> 6); c.fr = lane & 15; c.fq = lane >> 4;
    item = __builtin_amdgcn_readfirstlane(item);
    c.bl = item >> 5; c.h = (item >> 3) & 3; c.dblk = 2 * ((item >> 1) & 3) + (c.wave >> 2); c.eblk = 4 * (item & 1) + (c.wave & 3); c.do_den = (c.eblk == 0);
    c.koff = (unsigned)((4 * c.dblk) * 512 + lane * 8); c.voff = (unsigned)((4 * c.eblk) * 512 + lane * 8);
    c.KTG = (const bf16*)(ws + WS_KTG); c.VTG = (const bf16*)(ws + WS_VTG); c.gDEC = (const float*)(ws + WS_GSC) + 5 * MS * 4;
    c.CS = (bf16*)(ws + WS_CS); c.NS = (float*)(ws + WS_NS);
    f32x4 Cacc[2][2], Nacc[2];
#pragma unroll
    for (int x = 0; x < 2; ++x) { Nacc[x] = (f32x4){0.f, 0.f, 0.f, 0.f};
#pragma unroll
        for (int y = 0; y < 2; ++y) Cacc[x][y] = (f32x4){0.f, 0.f, 0.f, 0.f}; }
    bf16x8 ones;
    { const short ov = (c.fr == 0) ? (short)0x3F80 : (short)0;
#pragma unroll
      for (int e = 0; e < 8; ++e) ones[e] = ov; }
    ScanAOps o0, o1, o2, o3, o4;
    scana_load(c, 0, o0); scana_load(c, 1, o1); scana_load(c, 2, o2); scana_load(c, 3, o3); scana_load(c, 4, o4);
#define SA_STEP(jj, ob) do { scana_step(c, lds, (jj), Cacc, Nacc, ob, ones); __builtin_amdgcn_sched_barrier(0); scana_load(c, (jj) + SA_DEPTH < 64 ? (jj) + SA_DEPTH : 63, ob); __builtin_amdgcn_sched_barrier(0); } while (0)
#pragma nounroll
    for (int j = 0; j < 60; j += 5) { SA_STEP(j, o0); SA_STEP(j + 1, o1); SA_STEP(j + 2, o2); SA_STEP(j + 3, o3); SA_STEP(j + 4, o4); }
    SA_STEP(60, o0); SA_STEP(61, o1); SA_STEP(62, o2); SA_STEP(63, o3);
#undef SA_STEP
    asm volatile("s_waitcnt vmcnt(0)" ::: "memory");
}

constexpr int AKS = 136;
constexpr int L_AK = 0, L_AV = L_AK + 128 * AKS * 2, L_AP = L_AV + 128 * AKS * 2, L_ATT_END = L_AP + 8 * 16 * AKS * 2;
static_assert(L_ATT_END <= 131072, "attn lds");

__device__ __forceinline__ void attn_item(const Args& a, unsigned char* lds, int item) {
    const int tid = opaque_tid(), lane = tid & 63, wave = __builtin_amdgcn_readfirstlane(tid >> 6);
    const int fr = lane & 15, fq = lane >> 4;
    unsigned char* ws = a.ws;
    const int blk = item & 31, hh = (item >> 5) & 3, bl = (item >> 7) & 3, g = item >> 9;
    const int dil = g == 0 ? 1 : g == 1 ? 4 : 16, nb = 32 / dil;
    const int r = blk / nb, n = blk % nb;
    const bf16* P = (const bf16*)(ws + WS_P);
    const int H = 4 * g + hh;
    const bf16* Qb = P + C_QA + H * 128; const bf16* Kb = P + C_KA + H * 128; const bf16* Vb = P + C_VT + H * 128;
    bf16* Ks = (bf16*)(lds + L_AK); bf16* VTs = (bf16*)(lds + L_AV); bf16* Pw = (bf16*)(lds + L_AP) + wave * 16 * AKS;
    const int rowbase = bl * SEQ + r;
    bf16x8 qf[4];
    { const size_t qrow = (size_t)(rowbase + (128 * n + 16 * wave + fr) * dil);
#pragma unroll
      for (int ks = 0; ks < 4; ++ks) qf[ks] = *(const bf16x8*)(Qb + qrow * INW + 32 * ks + 8 * fq); }
    f32x4 O[8];
#pragma unroll
    for (int i = 0; i < 8; ++i) O[i] = (f32x4){0.f, 0.f, 0.f, 0.f};
    float mrow = -INFINITY, lrow = 0.f;
    const float scale = 0.08838834764831845f;
#define ATT_BAR() do { asm volatile("s_waitcnt lgkmcnt(0)" ::: "memory"); __builtin_amdgcn_s_barrier(); asm volatile("" ::: "memory"); } while (0)
    const int half0 = (n == 0 ? 1 : 0);
    u32x4 kreg[4], vreg[4];
#pragma unroll
    for (int i = 0; i < 4; ++i) { const int c = tid + NTHR * i, key = c >> 4, dc = c & 15;
        const size_t krow = (size_t)(rowbase + (128 * (n - 1 + half0) + key) * dil);
        kreg[i] = *(const u32x4*)(Kb + krow * INW + 8 * dc); vreg[i] = *(const u32x4*)(Vb + krow * INW + 8 * dc); }
    for (int half = half0; half < 2; ++half) {
        ATT_BAR();
#pragma unroll
        for (int i = 0; i < 4; ++i) { const int c = tid + NTHR * i, key = c >> 4, dc = c & 15;
            *(u32x4*)(Ks + key * AKS + 8 * dc) = kreg[i]; *(u32x4*)(VTs + key * AKS + 8 * dc) = vreg[i]; }
        if (half == 0) {
#pragma unroll
            for (int i = 0; i < 4; ++i) { const int c = tid + NTHR * i, key = c >> 4, dc = c & 15;
                const size_t krow = (size_t)(rowbase + (128 * n + key) * dil);
                kreg[i] = *(const u32x4*)(Kb + krow * INW + 8 * dc); vreg[i] = *(const u32x4*)(Vb + krow * INW + 8 * dc); }
        }
        ATT_BAR();
        f32x4 S[8];
        const int p = 16 * wave + fr;
        float mx = -INFINITY;
#pragma unroll
        for (int kt = 0; kt < 8; ++kt) {
            const bool act = half == 0 ? (kt >= wave) : (kt <= wave);
            f32x4 sacc = {0.f, 0.f, 0.f, 0.f};
            if (act) {
#pragma unroll
                for (int ks = 0; ks < 4; ++ks) { const bf16x8 kf = *(const bf16x8*)(Ks + (16 * kt + fr) * AKS + 32 * ks + 8 * fq); sacc = mfma16(kf, qf[ks], sacc); }
#pragma unroll
                for (int i = 0; i < 4; ++i) { const int kk = 16 * kt + 4 * fq + i; const bool ok = half == 0 ? (kk >= p) : (kk <= p);
                    const float v = ok ? sacc[i] * scale : -INFINITY; sacc[i] = v; mx = fmaxf(mx, v); }
            }
            S[kt] = sacc;
        }
        mx = fmaxf(mx, __shfl_xor(mx, 16)); mx = fmaxf(mx, __shfl_xor(mx, 32));
        const float mn = fmaxf(mrow, mx), alpha = __expf(mrow - mn); mrow = mn;
        float rs = 0.f;
        unsigned pk[8][2];
#pragma unroll
        for (int kt = 0; kt < 8; ++kt) {
            const bool act = half == 0 ? (kt >= wave) : (kt <= wave);
            if (act) { const float p0 = __expf(S[kt][0] - mn), p1 = __expf(S[kt][1] - mn), p2 = __expf(S[kt][2] - mn), p3 = __expf(S[kt][3] - mn);
                rs += (p0 + p1) + (p2 + p3); pk[kt][0] = pk2(p0, p1); pk[kt][1] = pk2(p2, p3); }
            else { pk[kt][0] = 0u; pk[kt][1] = 0u; }
        }
        rs += __shfl_xor(rs, 16); rs += __shfl_xor(rs, 32);
        lrow = lrow * alpha + rs;
        float al[4];
#pragma unroll
        for (int i = 0; i < 4; ++i) al[i] = __shfl(alpha, 4 * fq + i);
#pragma unroll
        for (int dtile = 0; dtile < 8; ++dtile)
#pragma unroll
            for (int i = 0; i < 4; ++i) O[dtile][i] *= al[i];
#pragma unroll
        for (int ks = 0; ks < 4; ++ks) {
            const bool act = half == 0 ? (2 * ks + 1 >= wave) : (2 * ks <= wave);
            if (act) {
                u32x4 pw; pw.x = pk[2 * ks][0]; pw.y = pk[2 * ks][1]; pw.z = pk[2 * ks + 1][0]; pw.w = pk[2 * ks + 1][1];
                const bf16x8 pa = __builtin_bit_cast(bf16x8, pw);
#pragma unroll
                for (int dtile = 0; dtile < 8; ++dtile) {
                    const bf16* vp = VTs + (32 * ks + 4 * fq + (fr >> 2)) * AKS + 16 * dtile + 4 * (fr & 3);
                    const s16x4 v0 = __builtin_amdgcn_ds_read_tr16_b64_v4i16((__attribute__((address_space(3))) s16x4*)(vp));
                    const s16x4 v1 = __builtin_amdgcn_ds_read_tr16_b64_v4i16((__attribute__((address_space(3))) s16x4*)(vp + 16 * AKS));
                    bf16x8 vb; vb[0] = v0[0]; vb[1] = v0[1]; vb[2] = v0[2]; vb[3] = v0[3]; vb[4] = v1[0]; vb[5] = v1[1]; vb[6] = v1[2]; vb[7] = v1[3];
                    O[dtile] = mfma16(pa, vb, O[dtile]); }
            }
        }
    }
    bf16* AO = (bf16*)(ws + WS_AO) + (size_t)g * MS * 512; float* LSE = (float*)(ws + WS_LSE) + (size_t)g * MS * 4;
    {
        const float inv_l = 1.f / lrow;
        float il[4];
#pragma unroll
        for (int i = 0; i < 4; ++i) il[i] = __shfl(inv_l, 4 * fq + i);
#pragma unroll
        for (int dtile = 0; dtile < 8; ++dtile)
#pragma unroll
            for (int i = 0; i < 4; ++i) Pw[(4 * fq + i) * AKS + 16 * dtile + fr] = (bf16)f2bf(O[dtile][i] * il[i]);
        if (fq == 0) { const size_t row = (size_t)(rowbase + (128 * n + 16 * wave + fr) * dil); LSE[(size_t)hh * MS + row] = mrow + logf(lrow); }
#pragma unroll
        for (int k = 0; k < 4; ++k) { const int c = lane + 64 * k, q = c >> 4, ch = c & 15;
            const size_t row = (size_t)(rowbase + (128 * n + 16 * wave + q) * dil);
            *(u32x4*)(AO + row * 512 + hh * 128 + 8 * ch) = *(const u32x4*)(Pw + q * AKS + 8 * ch); }
    }
    __syncthreads();
}

constexpr int N_SCAN_ITEMS = NB_PASS * 32, N_ATT_ITEMS = 3 * NB_PASS * 4 * 32;
#ifndef PROBE_ATT_REP
#define PROBE_ATT_REP 1
#endif
struct XcdBarrier;
__device__ __forceinline__ void xcd_barrier(const XcdBarrier& b);
__device__ __forceinline__ void phase_mix(const Args& a, unsigned char* lds, int pass, const XcdBarrier* pbar) {
    volatile int* slot = (volatile int*)(lds + 131072 + 1024);
#ifdef PROBE_SPLIT
    for (int it = blockIdx.x; it < N_SCAN_ITEMS; it += gridDim.x) scana_item(a, lds, it);
    xcd_barrier(*pbar);
    for (int rep = 0; rep < PROBE_ATT_REP; ++rep)
    for (int it = blockIdx.x; it < N_ATT_ITEMS; it += gridDim.x) attn_item(a, lds, it);
#else
    if ((int)blockIdx.x < N_SCAN_ITEMS && gridDim.x >= (unsigned)N_SCAN_ITEMS) {
        const int x = blockIdx.x & 7, k = blockIdx.x >> 3, g = x + 8 * (k >> 3), m = k & 7;
        scana_item(a, lds, g * 8 + m);
    } else if (gridDim.x < (unsigned)N_SCAN_ITEMS) { for (int it = blockIdx.x; it < N_SCAN_ITEMS; it += gridDim.x) scana_item(a, lds, it); }
    constexpr int QN = N_ATT_ITEMS / 8;
    for (int qo = 0; qo < 8; ++qo) {
        const int qx = (int)((blockIdx.x + qo) & 7);
        unsigned* qc = (unsigned*)(a.ws + WS_CTL) + CW_QCTR + (pass * 8 + qx) * 64;
        for (;;) {
            __syncthreads();
            if (opaque_tid() == 0) *slot = (int)atomicAdd(qc, 1u);
            __syncthreads();
            const int L = *slot;
            if (L >= QN) break;
            attn_item(a, lds, ((L >> 3) * 8 + qx) * 8 + (L & 7));
        }
    }
#endif
}

constexpr int QS_STRIDE = 264, SS_STRIDE = 72;
constexpr int L_QS = 0, L_SS = L_QS + 64 * QS_STRIDE * 2, L_DENL = L_SS + 64 * SS_STRIDE * 2, L_WIL = L_DENL + 256, L_NUM = L_WIL + 256, L_SB_END = L_NUM + 64 * QS_STRIDE * 2;
static_assert(L_SB_END <= 131072, "scan-B lds");
__device__ __forceinline__ void scanb_item(const Args& a, unsigned char* lds, int ch) {
    const int tid = opaque_tid(), lane = tid & 63, wave = __builtin_amdgcn_readfirstlane(tid >> 6), fr = lane & 15, fq = lane >> 4;
    unsigned char* ws = a.ws;
    const int h = ch & 3, t0 = (ch >> 2) * 64;
    const bf16* P = (const bf16*)(ws + WS_P); const bf16* XC = (const bf16*)(ws + WS_XC); const bf16* QM = (const bf16*)(ws + WS_QM);
    const bf16* SG = (const bf16*)(ws + WS_SG); const bf16* VTG = (const bf16*)(ws + WS_VTG); const bf16* CS = (const bf16*)(ws + WS_CS); const float* NS = (const float*)(ws + WS_NS);
    const float* gWI = (const float*)(ws + WS_GSC) + 2 * MS * 4; const float* gEF = (const float*)(ws + WS_GSC) + 3 * MS * 4;
    bf16* UM = (bf16*)(ws + WS_ACAT);
    bf16* QS = (bf16*)(lds + L_QS); bf16* SS = (bf16*)(lds + L_SS); float* DENL = (float*)(lds + L_DENL); float* WIL = (float*)(lds + L_WIL); bf16* NUMS = (bf16*)(lds + L_NUM);
    const int c = h * 256 + 4 * lane;
    u32x2 owr[8], zwr[8], xwr[8];
#pragma unroll
    for (int rr = 0; rr < 8; ++rr) { const size_t r = (size_t)(t0 + 8 * wave + rr);
        owr[rr] = *(const u32x2*)(P + r * INW + C_OA + c); zwr[rr] = *(const u32x2*)(P + r * INW + C_ZA + c); xwr[rr] = *(const u32x2*)(XC + r * 1024 + c); }
    __syncthreads();
#pragma unroll
    for (int i = 0; i < 4; ++i) { const int c = tid + NTHR * i, row = c >> 5, cc = c & 31;
        *(u32x4*)(QS + row * QS_STRIDE + 8 * cc) = *(const u32x4*)(QM + (size_t)(t0 + row) * 1024 + h * 256 + 8 * cc); }
    { const int row = tid >> 3, cc = tid & 7; *(u32x4*)(SS + row * SS_STRIDE + 8 * cc) = *(const u32x4*)(SG + (size_t)ch * 4096 + row * 64 + 8 * cc); }
    if (tid < 64) WIL[tid] = gWI[h * MS + t0 + tid];
    bf16x8 cb[2][8], vt[2][2];
#pragma unroll
    for (int t = 0; t < 2; ++t) {
#pragma unroll
        for (int ks = 0; ks < 8; ++ks) cb[t][ks] = *(const bf16x8*)(CS + (size_t)ch * 65536 + (wave * 8 + ks) * 1024 + (16 * t + fr) * 32 + 8 * fq);
#pragma unroll
        for (int k2 = 0; k2 < 2; ++k2) vt[t][k2] = *(const bf16x8*)(VTG + (size_t)ch * 16384 + (((2 * wave + t) * 2 + k2) * 64 + lane) * 8);
    }
    __syncthreads();
#pragma unroll
    for (int lt = 0; lt < 4; ++lt) {
        bf16x8 qf[8], sf[2];
#pragma unroll
        for (int ks = 0; ks < 8; ++ks) qf[ks] = *(const bf16x8*)(QS + (16 * lt + fr) * QS_STRIDE + 32 * ks + 8 * fq);
#pragma unroll
        for (int k2 = 0; k2 < 2; ++k2) sf[k2] = *(const bf16x8*)(SS + (16 * lt + fr) * SS_STRIDE + 32 * k2 + 8 * fq);
#pragma unroll
        for (int t = 0; t < 2; ++t) {
            f32x4 a1 = {0.f, 0.f, 0.f, 0.f}, a2 = {0.f, 0.f, 0.f, 0.f}, a3 = {0.f, 0.f, 0.f, 0.f};
#pragma unroll
            for (int k2 = 0; k2 < 2; ++k2) a1 = mfma16(sf[k2], vt[t][k2], a1);
#pragma unroll
            for (int ks = 0; ks < 8; ks += 2) { a2 = mfma16(qf[ks], cb[t][ks], a2); a3 = mfma16(qf[ks + 1], cb[t][ks + 1], a3); }
#pragma unroll
            for (int i = 0; i < 4; ++i) NUMS[(16 * lt + 4 * fq + i) * QS_STRIDE + 32 * wave + 16 * t + fr] = (bf16)f2bf(a1[i] + WIL[16 * lt + 4 * fq + i] * (a2[i] + a3[i]));
        }
    }
    if (wave == 0) {
        bf16x8 nb[8], ones;
        { const short ov = (fr == 0) ? (short)0x3F80 : (short)0;
#pragma unroll
          for (int e = 0; e < 8; ++e) ones[e] = ov; }
#pragma unroll
        for (int ks = 0; ks < 8; ++ks) { const f32x4 n0 = *(const f32x4*)(NS + (size_t)ch * 256 + 32 * ks + 8 * fq), n1 = *(const f32x4*)(NS + (size_t)ch * 256 + 32 * ks + 8 * fq + 4);
            u32x4 w; w.x = pk2(n0[0], n0[1]); w.y = pk2(n0[2], n0[3]); w.z = pk2(n1[0], n1[1]); w.w = pk2(n1[2], n1[3]);
            if (fr != 0) w = (u32x4){0u, 0u, 0u, 0u};
            nb[ks] = __builtin_bit_cast(bf16x8, w); }
#pragma unroll
        for (int lt = 0; lt < 4; ++lt) {
            f32x4 a1 = {0.f, 0.f, 0.f, 0.f}, a2 = {0.f, 0.f, 0.f, 0.f};
#pragma unroll
            for (int k2 = 0; k2 < 2; ++k2) { const bf16x8 sf = *(const bf16x8*)(SS + (16 * lt + fr) * SS_STRIDE + 32 * k2 + 8 * fq); a1 = mfma16(sf, ones, a1); }
#pragma unroll
            for (int ks = 0; ks < 8; ++ks) { const bf16x8 qf = *(const bf16x8*)(QS + (16 * lt + fr) * QS_STRIDE + 32 * ks + 8 * fq); a2 = mfma16(qf, nb[ks], a2); }
            if (fr == 0) {
#pragma unroll
                for (int i = 0; i < 4; ++i) { const int l = 16 * lt + 4 * fq + i; const float den = a1[i] + WIL[l] * a2[i]; DENL[l] = 1.f / fmaxf(fabsf(den), gEF[h * MS + t0 + l]); } }
        }
    }
    __syncthreads();
    const f32x4 gh = *(const f32x4*)(a.g_head + c), sk = *(const f32x4*)(a.skip + c);
#pragma unroll
    for (int rr = 0; rr < 8; ++rr) {
        const int l = 8 * wave + rr; const size_t r = (size_t)(t0 + l);
        const u32x2 hw = *(const u32x2*)(NUMS + l * QS_STRIDE + 4 * lane);
        const u32x2 ow = owr[rr], zw = zwr[rr], xw = xwr[rr];
        const float rd = DENL[l];
        float hm[4] = {sigmoidf_(bflo(ow.x)) * bflo(hw.x) * rd, sigmoidf_(bfhi(ow.x)) * bfhi(hw.x) * rd, sigmoidf_(bflo(ow.y)) * bflo(hw.y) * rd, sigmoidf_(bfhi(ow.y)) * bfhi(hw.y) * rd};
        float ss = (hm[0] * hm[0] + hm[1] * hm[1]) + (hm[2] * hm[2] + hm[3] * hm[3]);
        ss = wave_sum(ss);
        const float rinv = 1.f / sqrtf(ss * (1.f / 256.f) + EPS);
        const float xc[4] = {bflo(xw.x), bfhi(xw.x), bflo(xw.y), bfhi(xw.y)}, za[4] = {bflo(zw.x), bfhi(zw.x), bflo(zw.y), bfhi(zw.y)};
        float o[4];
#pragma unroll
        for (int e = 0; e < 4; ++e) o[e] = (hm[e] * rinv * gh[e] + sk[e] * xc[e]) * siluf_(za[e]);
        u32x2 ov; ov.x = pk2(o[0], o[1]); ov.y = pk2(o[2], o[3]);
        *(u32x2*)(UM + r * 1536 + c) = ov;
    }
}

__device__ __forceinline__ void phase_post(const Args& a, unsigned char* lds, int vcu, int G) {
    for (int ch = vcu; ch < (MS / 64) * 4; ch += G) scanb_item(a, lds, ch);
    const int tid = opaque_tid(), lane = tid & 63, wave = tid >> 6;
    unsigned char* ws = a.ws;
    const bf16* P = (const bf16*)(ws + WS_P);
    const bf16* AO = (const bf16*)(ws + WS_AO); const float* LSE = (const float*)(ws + WS_LSE); bf16* UA = (bf16*)(ws + WS_ACAT) + 1024;
    const int hh = lane >> 4, c = hh * 128 + 8 * (lane & 15);
    for (int r0 = 2 * (vcu * NWAVES + wave); r0 < MS; r0 += 2 * G * NWAVES) {
        u32x4 o0[2], o1[2], o2[2], zb[2]; float l0[2], l1[2], l2[2];
#pragma unroll
        for (int q = 0; q < 2; ++q) { const size_t r = (size_t)(r0 + q);
            o0[q] = *(const u32x4*)(AO + r * 512 + c); o1[q] = *(const u32x4*)(AO + ((size_t)MS + r) * 512 + c); o2[q] = *(const u32x4*)(AO + ((size_t)2 * MS + r) * 512 + c);
            zb[q] = *(const u32x4*)(P + r * INW + C_ZB + c);
            l0[q] = LSE[(size_t)hh * MS + r]; l1[q] = LSE[(size_t)(4 + hh) * MS + r]; l2[q] = LSE[(size_t)(8 + hh) * MS + r]; }
#pragma unroll
        for (int q = 0; q < 2; ++q) {
            const float mx = fmaxf(l0[q], fmaxf(l1[q], l2[q]));
            float w0 = __expf(l0[q] - mx), w1 = __expf(l1[q] - mx), w2 = __expf(l2[q] - mx); const float inv = 1.f / (w0 + w1 + w2); w0 *= inv; w1 *= inv; w2 *= inv;
            float f0[8], f1[8], f2[8], z[8], o[8]; unpack8(o0[q], f0); unpack8(o1[q], f1); unpack8(o2[q], f2); unpack8(zb[q], z);
#pragma unroll
            for (int e = 0; e < 8; ++e) o[e] = (w0 * f0[e] + w1 * f1[e] + w2 * f2[e]) * siluf_(z[e]);
            u32x4 ov; ov.x = pk2(o[0], o[1]); ov.y = pk2(o[2], o[3]); ov.z = pk2(o[4], o[5]); ov.w = pk2(o[6], o[7]);
            *(u32x4*)(UA + (size_t)(r0 + q) * 1536 + c) = ov;
        }
    }
}

__device__ __forceinline__ void phase_norm(const Args& a, int vcu, int G) {
    const int tid = opaque_tid(), lane = tid & 63, wave = tid >> 6;
    const float* rowss = (const float*)(a.ws + WS_CTL) + CW_ROWSS;
    const bf16* xn = (const bf16*)(a.ws + WS_H);
    for (int r0 = 2 * (vcu * NWAVES + wave); r0 < MALL; r0 += 2 * G * NWAVES) {
        u32x4 w[2][2]; float rinv[2];
#pragma unroll
        for (int q = 0; q < 2; ++q) { const u32x4* p = (const u32x4*)(xn + (size_t)(r0 + q) * DM) + lane; w[q][0] = p[0]; w[q][1] = p[64]; rinv[q] = 1.f / sqrtf(rowss[r0 + q] * (1.f / DM) + EPS); }
#pragma unroll
        for (int q = 0; q < 2; ++q)
#pragma unroll
            for (int hlf = 0; hlf < 2; ++hlf) { float f[8]; unpack8(w[q][hlf], f); const int c = 8 * lane + 512 * hlf;
                const f32x4 g0 = *(const f32x4*)(a.g_final + c), g1 = *(const f32x4*)(a.g_final + c + 4);
                float* op = a.out + (size_t)(r0 + q) * DM + c;
                *(f32x4*)op = (f32x4){f[0], f[1], f[2], f[3]} * rinv[q] * g0; *(f32x4*)(op + 4) = (f32x4){f[4], f[5], f[6], f[7]} * rinv[q] * g1; }
    }
}


#define LAS __attribute__((address_space(3)))
#define XB_TMO      128
#define XB_XCNT(j)  (256  + 64 * (j))
#define XB_XSUB(j)  (1280 + 64 * (j))
#define XB_XGEN(j)  (2304 + 64 * (j))
#define XB_TOP      3328
#define XB_TOPGEN   3392
#define XCD_BAR_WORDS 3456
#define XB_SPIN_CAP (1u << 22)
constexpr int CW_BAR = 4096;
__device__ __forceinline__ unsigned xb_ld(unsigned* p)              { return __hip_atomic_load(p, __ATOMIC_RELAXED, __HIP_MEMORY_SCOPE_AGENT); }
__device__ __forceinline__ unsigned xb_add(unsigned* p, unsigned v) { return __hip_atomic_fetch_add(p, v, __ATOMIC_RELAXED, __HIP_MEMORY_SCOPE_AGENT); }
__device__ __forceinline__ unsigned xb_xcc_id() { return (unsigned)__builtin_amdgcn_s_getreg((3 << 11) | 20) & 0xFu; }
#define XB_SPIN(cond, bar) do { unsigned _sp = 0; while (cond) { __builtin_amdgcn_s_sleep(1); \
    if ((++_sp & 255u) == 0u) { if (xb_ld(&(bar)[XB_TMO])) break; if (_sp > XB_SPIN_CAP) { atomicAdd(&(bar)[XB_TMO], 1u); break; } } } } while (0)
struct XcdBarrier { unsigned* bar; unsigned x; volatile LAS unsigned* st; };
__device__ __forceinline__ XcdBarrier xcd_barrier_post(unsigned* bar, volatile LAS unsigned* st) {
    XcdBarrier b; b.bar = bar; b.x = xb_xcc_id(); b.st = st;
    if (threadIdx.x == 0) (void)xb_add(&bar[XB_XCNT(b.x)], 1u);
    return b;
}
__device__ __forceinline__ void xcd_barrier_complete(unsigned* bar, unsigned x, unsigned& nloc, unsigned& nx) {
    const unsigned G = gridDim.x * gridDim.y * gridDim.z;
    unsigned sum, cnt, mine, sp = 0u;
    for (;;) {
        sum = 0u; cnt = 0u; mine = 0u;
#pragma unroll
        for (unsigned j = 0; j < 16; ++j) { const unsigned c = xb_ld(&bar[XB_XCNT(j)]); sum += c; cnt += (c > 0u) ? 1u : 0u; mine = (j == x) ? c : mine; }
        if (sum == G) break;
        __builtin_amdgcn_s_sleep(1);
        if ((++sp & 255u) == 0u) { if (xb_ld(&bar[XB_TMO])) break; if (sp > XB_SPIN_CAP) { atomicAdd(&bar[XB_TMO], 1u); break; } }
    }
    nloc = mine > 0u ? mine : 1u; nx = cnt > 0u ? cnt : 1u;
}
__device__ __forceinline__ void xcd_barrier(const XcdBarrier& b) {
    asm volatile("s_waitcnt vmcnt(0)" ::: "memory");
    __syncthreads();
    if (threadIdx.x == 0) {
        unsigned* bar = b.bar;
        __builtin_amdgcn_s_waitcnt(0);
        unsigned nloc = b.st[0], nx = b.st[1];
        if (nloc == 0u) { xcd_barrier_complete(bar, b.x, nloc, nx); b.st[0] = nloc; b.st[1] = nx; }
        const unsigned old = xb_add(&bar[XB_XSUB(b.x)], 1u);
        const unsigned gen = old / nloc;
        if (old + 1u == (gen + 1u) * nloc) {
            __builtin_amdgcn_fence(__ATOMIC_RELEASE, "agent");
            asm volatile("s_waitcnt vmcnt(0)" ::: "memory");
            const unsigned og = xb_add(&bar[XB_TOP], 1u);
            const unsigned tg = og / nx;
            if (og + 1u == (tg + 1u) * nx) xb_add(&bar[XB_TOPGEN], 1u);
            else XB_SPIN(xb_ld(&bar[XB_TOPGEN]) == tg, bar);
            __builtin_amdgcn_fence(__ATOMIC_ACQUIRE, "agent");
            xb_add(&bar[XB_XGEN(b.x)], 1u);
            asm volatile("s_waitcnt vmcnt(0)" ::: "memory");
        } else {
            XB_SPIN(xb_ld(&bar[XB_XGEN(b.x)]) == gen, bar);
            __builtin_amdgcn_fence(__ATOMIC_ACQUIRE, "agent");
            asm volatile("s_waitcnt vmcnt(0)" ::: "memory");
        }
    }
    __syncthreads();
}

constexpr int PH_PER_PASS = 7, PH_TOTAL = 2 + PH_PER_PASS * NPASS + 1;
#define PROBE_KIND_OF(k) ((k) == 0 ? K_INPROJ : (k) == 1 ? K_PREP : (k) == 2 ? K_CPREP : (k) == 3 ? K_MIX : (k) == 4 ? K_POST : (k) == 5 ? K_OUT1 : K_OUT2)
enum { K_PROLOGUE = 0, K_H = 1, K_INPROJ = 2, K_PREP = 3, K_QK = 4, K_MIX = 5, K_POST = 6, K_OUT1 = 7, K_OUT2 = 8, K_NORM = 9, K_CPREP = 10 };

__device__ __forceinline__ Args fresh_args() {
    Args a{};
#if defined(__HIP_DEVICE_COMPILE__)
    typedef const __attribute__((address_space(4))) unsigned long long* KP;
    KP q = (KP)__builtin_amdgcn_kernarg_segment_ptr(); asm volatile("" : "+s"(q));
    static_assert(sizeof(Args) == 22 * 8, "Args layout");
    unsigned long long w[22];
#pragma unroll
    for (int i = 0; i < 22; ++i) w[i] = q[i];
    __builtin_memcpy(&a, w, sizeof(Args));
#endif
    return a;
}
template <int KIND>
__device__ __forceinline__ void run_phase(const Args& args, unsigned char* lds, int pass, const XcdBarrier* pbar = nullptr) {
    const int G = gridDim.x; const int bx = blockIdx.x;
    const int vcu = (G % 8 == 0) ? (bx % 8) * (G / 8) + bx / 8 : bx;
    unsigned char* ws = args.ws;
    PG8_LAS unsigned char* lds3 = (PG8_LAS unsigned char*)lds;
    if constexpr (KIND == K_PROLOGUE) phase_prologue(args, lds, vcu, G);
    else if constexpr (KIND == K_H) phase_h(args, lds, vcu, G);
    else if constexpr (KIND == K_NORM) phase_norm(args, vcu, G);
    else if constexpr (KIND == K_INPROJ) {
        pg8::Gemm<1024, 1024, 1024> g{(const bf16*)(ws + WS_H) + (size_t)pass * MS * 1024, (const bf16*)(ws + WS_WIN)};
        pg8::StaticOrder S; S.init(MS, INW, G, bx);
        EpiProj E{(bf16*)(ws + WS_P), (const float*)(ws + WS_ROPE) + (size_t)pass * MS * 32};
        pg8::gemm_phase<EpiProj, pg8::StaticOrder, true, true>(lds3, g, S, E);
    } else if constexpr (KIND == K_PREP) phase_prep(args, lds, vcu, G, pass);
    else if constexpr (KIND == K_QK) {
        pg8::Gemm<1024, 256, 256, 512, 512 * 256 * 2> g{(const bf16*)(ws + WS_XC), (const bf16*)(ws + WS_WQK)};
        pg8::GroupOrder S; S.init(MS, G, bx);
        EpiQK E{(bf16*)(ws + WS_QM), (bf16*)(ws + WS_KM)};
        pg8::gemm_phase<EpiQK, pg8::GroupOrder, true, true>(lds3, g, S, E);
    } else if constexpr (KIND == K_CPREP) phase_cprep(args, lds, vcu, G);
    else if constexpr (KIND == K_MIX) phase_mix(args, lds, pass, pbar);
    else if constexpr (KIND == K_POST) phase_post(args, lds, vcu, G);
    else if constexpr (KIND == K_OUT1) {
        pg8::Gemm<1536, 1536, 1536> g{(const bf16*)(ws + WS_ACAT), (const bf16*)(ws + WS_WOM)};
        pg8::StaticOrder S; S.init(MS, 1024, G, bx);
        EpiMerge E{(const bf16*)(ws + WS_P), (bf16*)(ws + WS_MG)};
        pg8::gemm_phase<EpiMerge, pg8::StaticOrder, true, true>(lds3, g, S, E);
    } else if constexpr (KIND == K_OUT2) {
        pg8::Gemm<1024, 1024, 1024> g{(const bf16*)(ws + WS_MG), (const bf16*)(ws + WS_WO)};
        pg8::StaticOrder S; S.init(MS, 1024, G, bx);
        EpiOut E{args.x, (bf16*)(ws + WS_H), (const float*)(ws + WS_MOD) + 2048, (float*)(ws + WS_CTL) + CW_ROWSS, pass * MS};
        pg8::gemm_phase<EpiOut, pg8::StaticOrder, true, true>(lds3, g, S, E);
    }
}

#if !MK_ONE_LAUNCH
template <int KIND>
__global__ void __launch_bounds__(NTHR, 2) k_phase(Args args) {
    extern __shared__ __attribute__((aligned(16))) unsigned char lds[];
    run_phase<KIND>(args, lds, args.ph_lo);
}
#else
__global__ void __launch_bounds__(NTHR, 2) mk_fwd(Args args) {
    extern __shared__ __attribute__((aligned(16))) unsigned char lds[];
    volatile LAS unsigned* misc = (volatile LAS unsigned*)((LAS unsigned char*)lds + 131072 + 2048);
    if (threadIdx.x < 16) misc[threadIdx.x] = 0u;
    __syncthreads();
    XcdBarrier bar = xcd_barrier_post((unsigned*)(args.ws + WS_CTL) + CW_BAR, misc + 8);
#ifdef PROBE_TMASK
    unsigned long long pr_acc = 0ull;
#endif
    for (int gp = args.ph_lo; gp < args.ph_hi; ++gp) {
#ifdef PROBE_TMASK
        const unsigned long long pr_t0 = __builtin_amdgcn_s_memrealtime();
        int pr_kind;
        if (gp == 0) pr_kind = K_PROLOGUE; else if (gp == 1) pr_kind = K_H; else if (gp == PH_TOTAL - 1) pr_kind = K_NORM;
        else { const int k = (gp - 2) % PH_PER_PASS; pr_kind = PROBE_KIND_OF(k); }
#endif
        if (gp == 0) run_phase<K_PROLOGUE>(args, lds, 0);
        else if (gp == 1) run_phase<K_H>(args, lds, 0);
        else if (gp == PH_TOTAL - 1) run_phase<K_NORM>(args, lds, 0);
        else {
            const int pass = (gp - 2) / PH_PER_PASS, k = (gp - 2) % PH_PER_PASS;
            if (k == 0) run_phase<K_INPROJ>(args, lds, pass);
            else if (k == 1) run_phase<K_PREP>(args, lds, pass);
            else if (k == 2) run_phase<K_CPREP>(args, lds, pass);
            else if (k == 3) run_phase<K_MIX>(args, lds, pass, &bar);
            else if (k == 4) run_phase<K_POST>(args, lds, pass);
            else if (k == 5) run_phase<K_OUT1>(args, lds, pass);
            else run_phase<K_OUT2>(args, lds, pass);
        }
#ifdef PROBE_TMASK
        const unsigned long long pr_tb = __builtin_amdgcn_s_memrealtime();
#endif
        if (gp + 1 < args.ph_hi) xcd_barrier(bar);
#ifdef PROBE_TMASK
        else __syncthreads();
        if ((PROBE_TMASK >> 11) & 1) pr_acc += __builtin_amdgcn_s_memrealtime() - pr_tb;
        if ((PROBE_TMASK >> pr_kind) & 1) pr_acc += __builtin_amdgcn_s_memrealtime() - pr_t0;
#endif
    }
#ifdef PROBE_TMASK
    if (blockIdx.x == 0) { const unsigned long long t1 = __builtin_amdgcn_s_memrealtime(); while (__builtin_amdgcn_s_memrealtime() - t1 < 4ull * pr_acc) __builtin_amdgcn_s_sleep(8); }
#endif
}
#endif

extern "C" void kernel_launch(void* const* d_in, const int* in_sizes, int n_in, void* d_out, int out_size, void* d_ws, size_t ws_size, hipStream_t stream) {
    static int grid = 0;
    if (grid == 0) {
        if (n_in != 19 || in_sizes[0] != MALL * DM || out_size != MALL * DM || ws_size < WS_END) { fprintf(stderr, "kernel_launch: unexpected shapes (n_in %d, ws %zu)\n", n_in, ws_size); grid = -1; return; }
        int dev = 0, cus = 0, per_cu = 0;
        (void)hipGetDevice(&dev); (void)hipDeviceGetAttribute(&cus, hipDeviceAttributeMultiprocessorCount, dev);
#if MK_ONE_LAUNCH
        (void)hipFuncSetAttribute((const void*)mk_fwd, hipFuncAttributeMaxDynamicSharedMemorySize, LDS_BYTES);
        (void)hipOccupancyMaxActiveBlocksPerMultiprocessor(&per_cu, (const void*)mk_fwd, NTHR, LDS_BYTES);
        if (per_cu < 1) { fprintf(stderr, "kernel_launch: occupancy query says %d\n", per_cu); per_cu = 1; }
#else
#define SETATTR(KIND) (void)hipFuncSetAttribute((const void*)k_phase<KIND>, hipFuncAttributeMaxDynamicSharedMemorySize, LDS_BYTES)
        SETATTR(K_PROLOGUE); SETATTR(K_H); SETATTR(K_INPROJ); SETATTR(K_PREP); SETATTR(K_QK); SETATTR(K_MIX); SETATTR(K_POST); SETATTR(K_OUT1); SETATTR(K_OUT2); SETATTR(K_NORM); SETATTR(K_CPREP);
        (void)per_cu;
#endif
        (void)hipGetLastError();
        grid = cus;
    }
    if (grid < 0) return;
    (void)hipMemsetAsync((char*)d_ws + WS_CTL, 0, CTL_ZERO_BYTES, stream);
    Args a{};
    a.x = (const float*)d_in[0]; a.c = (const float*)d_in[1]; a.pos = (const int*)d_in[2]; a.w_ada = (const float*)d_in[3]; a.b_ada = (const float*)d_in[4];
    a.g_norm = (const float*)d_in[5]; a.w_in = (const float*)d_in[6]; a.b_ig = (const float*)d_in[7]; a.b_fg = (const float*)d_in[8]; a.w_conv = (const float*)d_in[9];
    a.b_conv = (const float*)d_in[10]; a.w_q = (const float*)d_in[11]; a.w_k = (const float*)d_in[12]; a.g_head = (const float*)d_in[13]; a.skip = (const float*)d_in[14];
    a.w_om = (const float*)d_in[15]; a.w_oa = (const float*)d_in[16]; a.w_o = (const float*)d_in[17]; a.g_final = (const float*)d_in[18];
    a.out = (float*)d_out; a.ws = (unsigned char*)d_ws;
#if MK_ONE_LAUNCH
    a.ph_lo = 0; a.ph_hi = PH_TOTAL;
    void* params[] = {&a};
    hipError_t e = hipLaunchCooperativeKernel((const void*)mk_fwd, dim3(grid), dim3(NTHR), params, LDS_BYTES, stream);
    if (e != hipSuccess) fprintf(stderr, "cooperative launch failed: %s\n", hipGetErrorString(e));
#else
#define LAUNCH(KIND, PASS) do { a.ph_lo = (PASS); a.ph_hi = 0; hipLaunchKernelGGL(k_phase<KIND>, dim3(grid), dim3(NTHR), LDS_BYTES, stream, a); } while (0)
    LAUNCH(K_PROLOGUE, 0); LAUNCH(K_H, 0);
    for (int p = 0; p < NPASS; ++p) { LAUNCH(K_INPROJ, p); LAUNCH(K_PREP, p); LAUNCH(K_CPREP, p); LAUNCH(K_MIX, p); LAUNCH(K_POST, p); LAUNCH(K_OUT1, p); LAUNCH(K_OUT2, p); }
    LAUNCH(K_NORM, 0);
#endif
}
```

```cpp
#include <hip/hip_runtime.h>
#include <hip/hip_cooperative_groups.h>
#include <cstdio>
#include <cstdint>
namespace cg = cooperative_groups;

#ifndef MK_ONE_LAUNCH
#define MK_ONE_LAUNCH 1
#endif

__device__ __forceinline__ int opaque_tid() { int t = threadIdx.x; asm volatile("" : "+v"(t)); return t; }
namespace pg8 {
#define PG8_LAS __attribute__((address_space(3)))
typedef unsigned short bf16_t;
typedef short bf16x8 __attribute__((ext_vector_type(8)));
typedef float f32x4 __attribute__((ext_vector_type(4)));
typedef unsigned u32x4 __attribute__((ext_vector_type(4)));
constexpr int BM = 256, BK = 64, HALF = 128, HTB = HALF * BK * 2, STAGE_BYTES = 8 * HTB, NXCD = 8, WGM = 8;

__host__ __device__ __forceinline__ int lds_byte(int r, int c) { const int st = (r >> 4) * 2 + (c >> 5), rr = r & 15, cc = c & 31, ob = rr * 64 + cc * 2; return st * 1024 + (ob ^ (((ob >> 9) & 1) << 5)); }
__host__ __device__ __forceinline__ void stage_rc(int b, int& R, int& C) { const int st = b / 1024, sb = b % 1024, swz = sb ^ (((sb >> 9) & 1) << 5); R = (st >> 1) * 16 + swz / 64; C = (st & 1) * 32 + (swz % 64) / 2; }
__host__ __device__ __forceinline__ int perm32(int rho) { const int n = rho >> 4, i = rho & 15; return 8 * (i >> 2) + 4 * n + (i & 3); }

struct Unit { int pm, pn, g; };
template <int LDA, int LDB, int KK, int AGS = 0, int BGS = 0> struct Gemm {
    const bf16_t* A; const bf16_t* Bt;
    static constexpr int lda = LDA, ldb = LDB, K = KK;
    __device__ __forceinline__ const char* abase(const Unit& u) const { return (const char*)A + (size_t)(u.g * AGS) + (size_t)u.pm * (size_t)(BM * 2 * LDA); }
    __device__ __forceinline__ const char* bbase(const Unit& u) const { return (const char*)Bt + (size_t)(u.g * BGS) + (size_t)u.pn * (size_t)(BM * 2 * LDB); }
};

struct StaticOrder {
    int nM, nN, nwg, G, c;
    __host__ __device__ void init(int M, int N, int G_, int c_) { nM = M / BM; nN = N / BM; nwg = nM * nN; G = G_; c = c_; }
    __host__ __device__ bool next(int i, Unit& u) const {
        const long L = (long)i * G + c; if (L >= nwg) return false;
        int wgid = (int)L; { const int q = nwg / NXCD, r = nwg % NXCD, xcd = wgid % NXCD, off = wgid / NXCD; wgid = (xcd < r ? xcd * (q + 1) : r * (q + 1) + (xcd - r) * q) + off; }
        const int nig = WGM * nN, gid = wgid / nig, fm = gid * WGM, gsz = (nM - fm) < WGM ? (nM - fm) : WGM;
        u.pm = fm + ((wgid % nig) % gsz); u.pn = (wgid % nig) / gsz; u.g = 0; return true;
    }
    __device__ __forceinline__ void a_ready(const Unit&) const {}
    __device__ __forceinline__ void done(const Unit&) const {}
};
struct GroupOrder {
    int nunits, G, c;
    __host__ __device__ void init(int M, int G_, int c_) { nunits = (M / BM) * 8; G = G_; c = c_; }
    __host__ __device__ bool next(int i, Unit& u) const {
        const long L = (long)i * G + c; if (L >= nunits) return false;
        u.pm = (int)(L >> 3); u.g = (int)((L & 7) >> 1); u.pn = (int)(L & 1); return true;
    }
    __device__ __forceinline__ void a_ready(const Unit&) const {}
    __device__ __forceinline__ void done(const Unit&) const {}
};

__device__ __forceinline__ unsigned cvt_pk_bf16(float lo, float hi) { unsigned r; asm volatile("v_cvt_pk_bf16_f32 %0, %1, %2" : "=v"(r) : "v"(lo), "v"(hi)); return r; }

template <class Epi, class Sched, bool ALIGN_EPI, bool SP2, class GemmT>
__device__ __forceinline__ void gemm_phase(PG8_LAS unsigned char* lds, const GemmT g, const Sched& S, const Epi& E) {
    const int tid = opaque_tid(), wid = __builtin_amdgcn_readfirstlane(tid >> 6), lane = tid & 63, wr = wid >> 2, wc = wid & 3, fr = lane & 15, fq = lane >> 4;
    constexpr int K = GemmT::K, nt = K / BK;
    unsigned voffA[2], voffB[2];
#pragma unroll
    for (int i = 0; i < 2; ++i) { int R, C; stage_rc(tid * 16 + i * 8192, R, C); const int Rb = Epi::PERM ? (64 * (R >> 5) + perm32(R & 31)) : R;
        voffA[i] = (unsigned)(R * g.lda + C) * 2u; voffB[i] = (unsigned)(Rb * g.ldb + C) * 2u; }
    const size_t kstep = (size_t)(BK * 2);
    const size_t hstepA = (size_t)HALF * g.lda * 2, hstepB = (size_t)(Epi::PERM ? 32 : HALF) * g.ldb * 2;
    const unsigned ldsw = (unsigned)wid * 1024u;
    const int aoff = lds_byte(wr * 64 + fr, fq * 8), boff = lds_byte(wc * 32 + fr, fq * 8);
#define PG8_SA(b, h) (((b) * 2 + (h)) * HTB)
#define PG8_SB(b, h) ((4 + (b) * 2 + (h)) * HTB)
#define PG8_STAGE(bufoff, gbase, voff) do { _Pragma("unroll") for (int _i = 0; _i < 2; ++_i) \
        __builtin_amdgcn_global_load_lds((const unsigned*)((const char*)(gbase) + (voff)[_i]), (PG8_LAS unsigned*)(lds + (bufoff) + ldsw + _i * 8192), 16, 0, 0); } while (0)
#define PG8_LDA(dst, b, h) do { _Pragma("unroll") for (int m = 0; m < 4; ++m) _Pragma("unroll") for (int k = 0; k < 2; ++k) dst[m][k] = *(const PG8_LAS bf16x8*)(lds + PG8_SA(b, h) + aoff + m * 2048 + k * 1024); } while (0)
#define PG8_LDB(dst, b, h) do { _Pragma("unroll") for (int n = 0; n < 2; ++n) _Pragma("unroll") for (int k = 0; k < 2; ++k) dst[n][k] = *(const PG8_LAS bf16x8*)(lds + PG8_SB(b, h) + boff + n * 2048 + k * 1024); } while (0)
#define PG8_MMA(ai, bj, At, Bt) do { __builtin_amdgcn_s_setprio(1); _Pragma("unroll") for (int m = 0; m < 4; ++m) _Pragma("unroll") for (int n = 0; n < 2; ++n) _Pragma("unroll") for (int k = 0; k < 2; ++k) \
        acc[ai][bj][m][n] = __builtin_amdgcn_mfma_f32_16x16x32_bf16(Bt[n][k], At[m][k], acc[ai][bj][m][n], 0, 0, 0); __builtin_amdgcn_s_setprio(0); } while (0)
#define PG8_WAIT_V(n) asm volatile("s_waitcnt vmcnt(" #n ")" ::: "memory")
#define PG8_WAIT_L(n) asm volatile("s_waitcnt lgkmcnt(" #n ")" ::: "memory")
#define PG8_BAR __builtin_amdgcn_s_barrier()
#define PG8_SCHED __builtin_amdgcn_sched_barrier(0)
    Unit cur, nxt; int ui = 0;
    if (!S.next(0, cur)) return;
    f32x4 acc[2][2][4][2];
#pragma unroll
    for (int a = 0; a < 2; ++a)
#pragma unroll
        for (int b = 0; b < 2; ++b)
#pragma unroll
            for (int m = 0; m < 4; ++m)
#pragma unroll
                for (int n = 0; n < 2; ++n) acc[a][b][m][n] = (f32x4){0.f, 0.f, 0.f, 0.f};
    bf16x8 At[4][2], B0[2][2], B1[2][2];
    const char* cA = g.abase(cur); const char* cB = g.bbase(cur);
    S.a_ready(cur);
    if constexpr (SP2) {
        PG8_STAGE(PG8_SB(0, 0), cB, voffB); PG8_STAGE(PG8_SB(0, 1), cB + hstepB, voffB); PG8_STAGE(PG8_SA(0, 0), cA, voffA); PG8_STAGE(PG8_SA(0, 1), cA + hstepA, voffA);
        if (wr == 1) PG8_BAR;
        PG8_WAIT_V(2); PG8_BAR;
        PG8_STAGE(PG8_SB(1, 0), cB + kstep, voffB); PG8_STAGE(PG8_SA(1, 0), cA + kstep, voffA); PG8_STAGE(PG8_SB(1, 1), cB + hstepB + kstep, voffB);
        PG8_WAIT_V(6); PG8_BAR;
    } else {
        PG8_STAGE(PG8_SB(0, 0), cB, voffB); PG8_STAGE(PG8_SA(0, 0), cA, voffA); PG8_STAGE(PG8_SB(0, 1), cB + hstepB, voffB); PG8_STAGE(PG8_SA(0, 1), cA + hstepA, voffA);
        if (wr == 1) PG8_BAR;
        PG8_WAIT_V(4); PG8_BAR;
        PG8_STAGE(PG8_SB(1, 0), cB + kstep, voffB); PG8_STAGE(PG8_SA(1, 0), cA + kstep, voffA); PG8_STAGE(PG8_SB(1, 1), cB + hstepB + kstep, voffB);
        PG8_WAIT_V(6); PG8_BAR;
    }
    for (;;) {
        const bool has_next = S.next(ui + 1, nxt);
        const char* nA = has_next ? g.abase(nxt) : cA; const char* nB = has_next ? g.bbase(nxt) : cB;
#pragma nounroll
        for (int t = 0; t < nt; t += 2) {
            const bool last = (t == nt - 2);
            const char* a1 = cA + (size_t)(t + 1) * kstep;
            const char* a2 = last ? nA : cA + (size_t)(t + 2) * kstep; const char* b2 = last ? nB : cB + (size_t)(t + 2) * kstep;
            const char* a3 = a2 + kstep; const char* b3 = b2 + kstep;
            if (last && has_next) S.a_ready(nxt);
            if constexpr (Epi::HOOK_T >= 0) { if (t == Epi::HOOK_T) E.hook(acc, cur, wr, wc, fr, fq); }
            if constexpr (SP2) {
            PG8_LDB(B0, 0, 0); PG8_LDB(B1, 0, 1); PG8_SCHED; PG8_LDA(At, 0, 0); PG8_STAGE(PG8_SA(1, 1), a1 + hstepA, voffA);
            PG8_WAIT_V(8); PG8_WAIT_L(0); PG8_BAR; PG8_MMA(0, 0, At, B0); PG8_MMA(0, 1, At, B1); PG8_BAR; PG8_SCHED;
            PG8_LDA(At, 0, 1); PG8_STAGE(PG8_SB(0, 0), b2, voffB); PG8_STAGE(PG8_SB(0, 1), b2 + hstepB, voffB); PG8_STAGE(PG8_SA(0, 0), a2, voffA);
            PG8_WAIT_V(8); PG8_WAIT_L(0); PG8_BAR; PG8_MMA(1, 0, At, B0); PG8_MMA(1, 1, At, B1); PG8_BAR; PG8_SCHED;
            PG8_LDB(B0, 1, 0); PG8_LDB(B1, 1, 1); PG8_SCHED; PG8_LDA(At, 1, 0); PG8_STAGE(PG8_SA(0, 1), a2 + hstepA, voffA);
            PG8_WAIT_V(8); PG8_WAIT_L(0); PG8_BAR; PG8_MMA(0, 0, At, B0); PG8_MMA(0, 1, At, B1); PG8_BAR; PG8_SCHED;
            PG8_LDA(At, 1, 1); PG8_STAGE(PG8_SB(1, 0), b3, voffB); PG8_STAGE(PG8_SB(1, 1), b3 + hstepB, voffB); PG8_STAGE(PG8_SA(1, 0), a3, voffA);
            PG8_WAIT_V(8); PG8_WAIT_L(0); PG8_BAR; PG8_MMA(1, 0, At, B0); PG8_MMA(1, 1, At, B1); PG8_BAR; PG8_SCHED;
            } else {
            PG8_LDB(B0, 0, 0); PG8_SCHED; PG8_LDA(At, 0, 0); PG8_STAGE(PG8_SA(1, 1), a1 + hstepA, voffA);
            PG8_WAIT_L(8); PG8_BAR; PG8_WAIT_L(0); PG8_MMA(0, 0, At, B0); PG8_BAR; PG8_SCHED;
            PG8_LDB(B1, 0, 1); PG8_STAGE(PG8_SB(0, 0), b2, voffB);
            PG8_BAR; PG8_WAIT_L(0); PG8_MMA(0, 1, At, B1); PG8_BAR;
            PG8_LDA(At, 0, 1); PG8_STAGE(PG8_SA(0, 0), a2, voffA);
            PG8_BAR; PG8_WAIT_L(0); PG8_MMA(1, 0, At, B0); PG8_BAR; PG8_SCHED;
            PG8_STAGE(PG8_SB(0, 1), b2 + hstepB, voffB);
            PG8_WAIT_V(6); PG8_BAR; PG8_MMA(1, 1, At, B1); PG8_BAR;
            PG8_LDB(B0, 1, 0); PG8_SCHED; PG8_LDA(At, 1, 0); PG8_STAGE(PG8_SA(0, 1), a2 + hstepA, voffA);
            PG8_WAIT_L(8); PG8_BAR; PG8_WAIT_L(0); PG8_MMA(0, 0, At, B0); PG8_BAR; PG8_SCHED;
            PG8_LDB(B1, 1, 1); PG8_STAGE(PG8_SB(1, 0), b3, voffB);
            PG8_BAR; PG8_WAIT_L(0); PG8_MMA(0, 1, At, B1); PG8_BAR;
            PG8_LDA(At, 1, 1); PG8_STAGE(PG8_SA(1, 0), a3, voffA);
            PG8_BAR; PG8_WAIT_L(0); PG8_MMA(1, 0, At, B0); PG8_BAR; PG8_SCHED;
            PG8_STAGE(PG8_SB(1, 1), b3 + hstepB, voffB);
            PG8_WAIT_V(6); PG8_BAR; PG8_MMA(1, 1, At, B1); PG8_BAR;
            }
        }
        if constexpr (ALIGN_EPI) { if (wr == 0) PG8_BAR; }
        E(acc, cur, wr, wc, fr, fq); S.done(cur);
        if (!has_next) break;
#pragma unroll
        for (int a = 0; a < 2; ++a)
#pragma unroll
            for (int b = 0; b < 2; ++b)
#pragma unroll
                for (int m = 0; m < 4; ++m)
#pragma unroll
                    for (int n = 0; n < 2; ++n) acc[a][b][m][n] = (f32x4){0.f, 0.f, 0.f, 0.f};
        cur = nxt; cA = nA; cB = nB; ++ui;
        if constexpr (ALIGN_EPI) { if (wr == 1) PG8_BAR; }
    }
    PG8_WAIT_V(0);
    if constexpr (!ALIGN_EPI) { if (wr == 0) PG8_BAR; }
    PG8_BAR;
#undef PG8_SA
#undef PG8_SB
#undef PG8_STAGE
#undef PG8_LDA
#undef PG8_LDB
#undef PG8_MMA
#undef PG8_WAIT_V
#undef PG8_WAIT_L
#undef PG8_BAR
#undef PG8_SCHED
}
}

constexpr int NWAVES = 8, NTHR = 512;
constexpr int DM = 1024, NBATCH = 16, SEQ = 4096, MALL = NBATCH * SEQ;
constexpr int NB_PASS = 4, MS = NB_PASS * SEQ, NPASS = NBATCH / NB_PASS;
constexpr int INW_SRC = 11272, INW = 11264;
constexpr int C_XA = 0, C_VA = 1024, C_OA = 2048, C_ZA = 3072, C_QA = 4096, C_KA = 5632, C_VT = 7168, C_ZB = 8704, C_GA = 9216, C_GB = 10240;
constexpr float EPS = 1e-6f;

constexpr size_t MiB = 1u << 20;
constexpr size_t WS_CTL = 0, CTL_ZERO_BYTES = 1 * MiB;
constexpr size_t WS_MOD = 1 * MiB;
constexpr size_t WS_WG = 1 * MiB + 256 * 1024;
constexpr size_t WS_WIN = 2 * MiB;
constexpr size_t WS_WQK = 24 * MiB;
constexpr size_t WS_WOM = 25 * MiB, WS_WOA = 27 * MiB, WS_WO = 28 * MiB;
constexpr size_t WS_IG = 30 * MiB, WS_FG = 31 * MiB;
constexpr size_t WS_GSC = 32 * MiB;
constexpr size_t WS_LSE = 34 * MiB;
constexpr size_t WS_DEN = 35 * MiB;
constexpr size_t WS_H = 36 * MiB;
constexpr size_t WS_P = 164 * MiB;
constexpr size_t WS_XC = 516 * MiB;
constexpr size_t WS_QM = 548 * MiB, WS_KM = 580 * MiB;
constexpr size_t WS_HR = 612 * MiB;
constexpr size_t WS_AO = 644 * MiB;
constexpr size_t WS_UA = 692 * MiB;
constexpr size_t WS_ACAT = 708 * MiB;
constexpr size_t WS_MG = 772 * MiB;
constexpr size_t WS_SG = 804 * MiB;
constexpr size_t WS_KTG = 812 * MiB;
constexpr size_t WS_VTG = 844 * MiB;
constexpr size_t WS_CS = 876 * MiB;
constexpr size_t WS_NS = 1004 * MiB;
constexpr size_t WS_ROPE = 1005 * MiB;
constexpr size_t WS_END = 1013 * MiB;
constexpr int CW_QCTR = 1024;
constexpr int CW_ROWSS = 65536;
static_assert((CW_ROWSS + MALL) * 4 <= (int)CTL_ZERO_BYTES, "ctl");

constexpr int LDS_BYTES = 147456;

typedef unsigned short bf16;
typedef float f32x4 __attribute__((ext_vector_type(4)));
typedef float f32x2 __attribute__((ext_vector_type(2)));
typedef short bf16x8 __attribute__((ext_vector_type(8)));
typedef unsigned u32x4 __attribute__((ext_vector_type(4)));
typedef unsigned u32x2 __attribute__((ext_vector_type(2)));
typedef short s16x4 __attribute__((ext_vector_type(4)));

__device__ __forceinline__ unsigned f2bf(float f) { unsigned u = __builtin_bit_cast(unsigned, f); return (u + 0x7fffu + ((u >> 16) & 1u)) >> 16; }
__device__ __forceinline__ unsigned pk2(float lo, float hi) { return f2bf(lo) | (f2bf(hi) << 16); }
__device__ __forceinline__ float bflo(unsigned w) { return __builtin_bit_cast(float, w << 16); }
__device__ __forceinline__ float bfhi(unsigned w) { return __builtin_bit_cast(float, w & 0xffff0000u); }
__device__ __forceinline__ float bf1(bf16 v) { return __builtin_bit_cast(float, (unsigned)v << 16); }
__device__ __forceinline__ float sigmoidf_(float x) { return 1.f / (1.f + __expf(-x)); }
__device__ __forceinline__ float siluf_(float x) { return x / (1.f + __expf(-x)); }
__device__ __forceinline__ float wave_sum(float v) {
#pragma unroll
    for (int o = 1; o < 64; o <<= 1) v += __shfl_xor(v, o);
    return v;
}
__device__ __forceinline__ void unpack8(const u32x4 w, float* f) {
    f[0] = bflo(w.x); f[1] = bfhi(w.x); f[2] = bflo(w.y); f[3] = bfhi(w.y); f[4] = bflo(w.z); f[5] = bfhi(w.z); f[6] = bflo(w.w); f[7] = bfhi(w.w);
}

struct Args {
    const float* x; const float* c; const int* pos; const float* w_ada; const float* b_ada; const float* g_norm; const float* w_in;
    const float* b_ig; const float* b_fg; const float* w_conv; const float* b_conv; const float* w_q; const float* w_k; const float* g_head;
    const float* skip; const float* w_om; const float* w_oa; const float* w_o; const float* g_final;
    float* out; unsigned char* ws; int ph_lo, ph_hi;
};

__device__ __forceinline__ void transpose_item(const float* W, int K, int Nsrc, int nblk, int src_col_off, bf16* WT, int ldt, int row_off, float scale, float* scr, int item, int lane, bool frag = false) {
    const int kb = item / nblk, nb = item % nblk, k0 = 64 * kb, n0 = 32 * nb;
#pragma unroll 8
    for (int i = 0; i < 32; ++i) { const int kk = 2 * i + (lane >> 5); scr[kk * 33 + (lane & 31)] = W[(size_t)(k0 + kk) * Nsrc + src_col_off + n0 + (lane & 31)]; }
    __builtin_amdgcn_wave_barrier();
    asm volatile("s_waitcnt lgkmcnt(0)" ::: "memory");
    const int cc = lane & 7;
#pragma unroll
    for (int j = 0; j < 4; ++j) { const int n = (lane >> 3) + 8 * j; const float* s = scr + (8 * cc) * 33 + n;
        u32x4 o; o.x = pk2(s[0 * 33] * scale, s[1 * 33] * scale); o.y = pk2(s[2 * 33] * scale, s[3 * 33] * scale); o.z = pk2(s[4 * 33] * scale, s[5 * 33] * scale); o.w = pk2(s[6 * 33] * scale, s[7 * 33] * scale);
        if (frag) { const int nn = row_off + n0 + n, kc = (k0 >> 3) + cc; *(u32x4*)(WT + (size_t)((((nn >> 4) * (K >> 5) + (kc >> 2)) * 64 + (kc & 3) * 16 + (nn & 15)) * 8)) = o; }
        else *(u32x4*)(WT + (size_t)(row_off + n0 + n) * ldt + k0 + 8 * cc) = o; }
    asm volatile("s_waitcnt lgkmcnt(0)" ::: "memory");
    __builtin_amdgcn_wave_barrier();
}

__device__ __forceinline__ void phase_prologue(const Args& a, unsigned char* lds, int vcu, int G) {
    const int tid = opaque_tid(), lane = tid & 63, wave = tid >> 6;
    unsigned char* ws = a.ws;
    if (vcu < 48) {
        float* sc = (float*)lds;
        float* red = (float*)(lds + 65536);
        for (int i = tid; i < 16 * 1024; i += NTHR) sc[i] = siluf_(a.c[i]);
        __syncthreads();
        const int n = vcu * 64 + lane;
        float acc[16];
#pragma unroll
        for (int b = 0; b < 16; ++b) acc[b] = 0.f;
        const int k0 = wave * 128;
#pragma unroll 16
        for (int k = k0; k < k0 + 128; ++k) { const float w = a.w_ada[(size_t)k * 3072 + n];
#pragma unroll
            for (int b = 0; b < 16; ++b) acc[b] += sc[b * 1024 + k] * w; }
#pragma unroll
        for (int b = 0; b < 16; ++b) red[(wave * 16 + b) * 64 + lane] = acc[b];
        __syncthreads();
        float* mod = (float*)(ws + WS_MOD);
        for (int i = tid; i < 16 * 64; i += NTHR) { const int b = i >> 6, l = i & 63, nn = vcu * 64 + l; float s = 0.f;
#pragma unroll
            for (int w = 0; w < 8; ++w) s += red[(w * 16 + b) * 64 + l];
            s += a.b_ada[nn];
            const int part = nn >> 10, col = nn & 1023;
            if (part == 1) s = a.g_norm[col] * (1.f + s);
            mod[b * 3072 + nn] = s; }
        __syncthreads();
    }
    {
        float* scr = (float*)lds + wave * (64 * 33);
        const int gw = vcu * NWAVES + wave, NGW = G * NWAVES;
        constexpr int I_IN = (1024 / 64) * (INW / 32);
        constexpr int I_QK = 8 * (256 / 64) * (256 / 32);
        constexpr int I_OM = 16 * 32, I_OA = 8 * 32, I_O = 16 * 32;
        constexpr int NITEMS = I_IN + I_QK + I_OM + I_OA + I_O;
        for (int it = gw; it < NITEMS; it += NGW) {
            int r = it;
            if (r < I_IN) { const int nb = r % (INW / 32); const int off = (nb * 32 >= 4096) ? 8 : 0;
                transpose_item(a.w_in, 1024, INW_SRC, INW / 32, off, (bf16*)(ws + WS_WIN), 1024, 0, 1.f, scr, r, lane); continue; } r -= I_IN;
            if (r < I_QK) { const int mtx = r >> 5, rr = r & 31, h = mtx >> 1, isk = mtx & 1;
                const float* W = (isk ? a.w_k : a.w_q) + (size_t)h * 65536;
                transpose_item(W, 256, 256, 8, 0, (bf16*)(ws + WS_WQK) + (size_t)h * 512 * 256, 256, isk * 256, isk ? 0.0625f : 1.f, scr, rr, lane, true); continue; } r -= I_QK;
            if (r < I_OM) { transpose_item(a.w_om, 1024, 1024, 32, 0, (bf16*)(ws + WS_WOM), 1536, 0, 1.f, scr, r, lane); continue; } r -= I_OM;
            if (r < I_OA) { transpose_item(a.w_oa, 512, 1024, 32, 0, (bf16*)(ws + WS_WOM) + 1024, 1536, 0, 1.f, scr, r, lane); continue; } r -= I_OA;
            transpose_item(a.w_o, 1024, 1024, 32, 0, (bf16*)(ws + WS_WO), 1024, 0, 1.f, scr, r, lane);
        }
        float* wg = (float*)(ws + WS_WG);
        for (int i = (vcu * NTHR + tid); i < 8 * 1024; i += G * NTHR) { const int j = i >> 10, k = i & 1023; wg[i] = a.w_in[(size_t)k * INW_SRC + 4096 + j]; }
    }
}

__constant__ double c_inv_freq[16] = {1.0, 0.44036660267178046, 0.19392274474868576, 0.08539710028576561, 0.03760603093086393, 0.016560440080994446, 0.007292664737217109, 0.003211445994752591,
    0.001414213562373095, 0.000622772421914596, 0.0002742481756762073, 0.00012076973741146504, 5.318295896944988e-05, 2.341999896140934e-05, 1.031338537721246e-05, 4.5416704806078695e-06};

__device__ __forceinline__ void phase_h(const Args& a, unsigned char* lds, int vcu, int G) {
    const int tid = opaque_tid(), lane = tid & 63, wave = tid >> 6;
    unsigned char* ws = a.ws;
    float* wg = (float*)lds;
    { const float* src = (const float*)(ws + WS_WG); for (int i = tid; i < 8192; i += NTHR) wg[i] = src[i]; }
    __syncthreads();
    const float* mod = (const float*)(ws + WS_MOD);
    bf16* H = (bf16*)(ws + WS_H);
    float* IG = (float*)(ws + WS_IG); float* FG = (float*)(ws + WS_FG); float* ROPE = (float*)(ws + WS_ROPE);
    const int gw = vcu * NWAVES + wave, NGW = G * NWAVES;
    for (int row0 = 2 * gw; row0 < MALL; row0 += 2 * NGW) {
        f32x4 v[2][4]; float ss[2] = {0.f, 0.f};
#pragma unroll
        for (int rr = 0; rr < 2; ++rr) { const f32x4* xr = (const f32x4*)(a.x + (size_t)(row0 + rr) * DM) + lane;
#pragma unroll
            for (int j = 0; j < 4; ++j) v[rr][j] = xr[64 * j]; }
        { const int rr = lane >> 5, fi = lane & 15; const int pos = a.pos[row0 + rr];
            const double rev = (double)pos * c_inv_freq[fi] * 0.15915494309189535; const float fr_ = (float)(rev - rint(rev));
            ROPE[(size_t)row0 * 32 + lane] = (lane & 16) ? __builtin_amdgcn_sinf(fr_) : __builtin_amdgcn_cosf(fr_); }
#pragma unroll
        for (int rr = 0; rr < 2; ++rr) {
#pragma unroll
            for (int j = 0; j < 4; ++j) ss[rr] += (v[rr][j].x * v[rr][j].x + v[rr][j].y * v[rr][j].y) + (v[rr][j].z * v[rr][j].z + v[rr][j].w * v[rr][j].w);
        }
#pragma unroll
        for (int o = 1; o < 64; o <<= 1) { ss[0] += __shfl_xor(ss[0], o); ss[1] += __shfl_xor(ss[1], o); }
        const int b = row0 >> 12;
        float pg[2][8];
#pragma unroll
        for (int rr = 0; rr < 2; ++rr)
#pragma unroll
            for (int g = 0; g < 8; ++g) pg[rr][g] = 0.f;
        const float rinv[2] = {1.f / sqrtf(ss[0] * (1.f / DM) + EPS), 1.f / sqrtf(ss[1] * (1.f / DM) + EPS)};
#pragma unroll
        for (int j = 0; j < 4; ++j) {
            const int col = 4 * lane + 256 * j;
            const f32x4 sh = *(const f32x4*)(mod + b * 3072 + col), gs = *(const f32x4*)(mod + b * 3072 + 1024 + col);
            f32x4 h[2];
#pragma unroll
            for (int rr = 0; rr < 2; ++rr) { h[rr] = v[rr][j] * rinv[rr] * gs + sh;
                u32x2 o; o.x = pk2(h[rr].x, h[rr].y); o.y = pk2(h[rr].z, h[rr].w); *((u32x2*)(H + (size_t)(row0 + rr) * DM) + lane + 64 * j) = o; }
#pragma unroll
            for (int g = 0; g < 8; ++g) { const f32x4 w = *(const f32x4*)(wg + g * 1024 + col);
                pg[0][g] += (h[0].x * w.x + h[0].y * w.y) + (h[0].z * w.z + h[0].w * w.w); pg[1][g] += (h[1].x * w.x + h[1].y * w.y) + (h[1].z * w.z + h[1].w * w.w); }
            __builtin_amdgcn_sched_barrier(0);
        }
#pragma unroll
        for (int o = 1; o < 64; o <<= 1)
#pragma unroll
            for (int g = 0; g < 8; ++g) { pg[0][g] += __shfl_xor(pg[0][g], o); pg[1][g] += __shfl_xor(pg[1][g], o); }
        if (lane < 2) { const int rr = lane; const float* p = rr ? pg[1] : pg[0];
            f32x4 ig = {p[0] + a.b_ig[0], p[1] + a.b_ig[1], p[2] + a.b_ig[2], p[3] + a.b_ig[3]};
            f32x4 fg = {p[4] + a.b_fg[0], p[5] + a.b_fg[1], p[6] + a.b_fg[2], p[7] + a.b_fg[3]};
            *(f32x4*)(IG + (size_t)(row0 + rr) * 4) = ig; *(f32x4*)(FG + (size_t)(row0 + rr) * 4) = fg; }
    }
}

struct EpiProj {
    static constexpr bool PERM = true; static constexpr int HOOK_T = -1;
    bf16* P; const float* rope;
    __device__ __forceinline__ void operator()(const f32x4 (&acc)[2][2][4][2], const pg8::Unit& u, int wr, int wc, int fr, int fq) const {
        const int row0 = u.pm * 256 + wr * 64 + fr, col0 = u.pn * 256 + wc * 64 + 8 * fq;
        const bool rot = (u.pn >= 16) && (u.pn < 28) && ((wc & 1) == 0);
#pragma unroll
        for (int ai = 0; ai < 2; ++ai)
#pragma unroll
            for (int m = 0; m < 4; ++m) { const int r = row0 + ai * 128 + m * 16; bf16* rowp = P + (size_t)r * INW + col0;
#pragma unroll
                for (int bj = 0; bj < 2; ++bj) { f32x4 v0 = acc[ai][bj][m][0], v1 = acc[ai][bj][m][1];
                    if (bj == 0 && rot) {
                        const float* tp = rope + (size_t)r * 32 + 8 * (fq & 1);
                        const f32x4 c0 = *(const f32x4*)tp, c1 = *(const f32x4*)(tp + 4), s0 = *(const f32x4*)(tp + 16), s1 = *(const f32x4*)(tp + 20);
                        f32x4 p0, p1;
#pragma unroll
                        for (int e = 0; e < 4; ++e) { p0[e] = __shfl_xor(v0[e], 32); p1[e] = __shfl_xor(v1[e], 32); }
                        const float sg = (fq < 2) ? -1.f : 1.f;
                        v0 = v0 * c0 + p0 * s0 * sg; v1 = v1 * c1 + p1 * s1 * sg;
                    }
                    u32x4 w; w.x = pg8::cvt_pk_bf16(v0[0], v0[1]); w.y = pg8::cvt_pk_bf16(v0[2], v0[3]); w.z = pg8::cvt_pk_bf16(v1[0], v1[1]); w.w = pg8::cvt_pk_bf16(v1[2], v1[3]);
                    *(u32x4*)(rowp + bj * 32) = w; } }
    }
};
struct EpiQK {
    static constexpr bool PERM = true; static constexpr int HOOK_T = -1;
    bf16* QM; bf16* KM;
    __device__ __forceinline__ void operator()(const f32x4 (&acc)[2][2][4][2], const pg8::Unit& u, int wr, int wc, int fr, int fq) const {
        const int row0 = u.pm * 256 + wr * 64 + fr, col0 = u.g * 256 + wc * 64 + 8 * fq;
        bf16* base = u.pn ? KM : QM;
#pragma unroll
        for (int ai = 0; ai < 2; ++ai)
#pragma unroll
            for (int m = 0; m < 4; ++m) { bf16* rowp = base + (size_t)(row0 + ai * 128 + m * 16) * 1024 + col0;
#pragma unroll
                for (int bj = 0; bj < 2; ++bj) { const f32x4 v0 = acc[ai][bj][m][0], v1 = acc[ai][bj][m][1];
                    u32x4 w; w.x = pg8::cvt_pk_bf16(v0[0], v0[1]); w.y = pg8::cvt_pk_bf16(v0[2], v0[3]); w.z = pg8::cvt_pk_bf16(v1[0], v1[1]); w.w = pg8::cvt_pk_bf16(v1[2], v1[3]);
                    *(u32x4*)(rowp + bj * 32) = w; } }
    }
};
struct EpiMerge {
    static constexpr bool PERM = true; static constexpr int HOOK_T = 16;
    const bf16* P; bf16* MG;
    __device__ __forceinline__ void hook(f32x4 (&acc)[2][2][4][2], const pg8::Unit& u, int wr, int wc, int fr, int fq) const {
        int row0 = u.pm * 256 + wr * 64 + fr, col0 = u.pn * 256 + wc * 64 + 8 * fq;
        asm volatile("" : "+v"(row0), "+v"(col0));
#pragma unroll
        for (int ai = 0; ai < 2; ++ai)
#pragma unroll
            for (int m = 0; m < 4; ++m) { const size_t r = (size_t)(row0 + ai * 128 + m * 16);
#pragma unroll
                for (int bj = 0; bj < 2; ++bj) { const int c = col0 + bj * 32;
                    const u32x4 gaw = *(const u32x4*)(P + r * INW + C_GA + c), gbw = *(const u32x4*)(P + r * INW + C_GB + c);
                    float ga[8], gb[8]; unpack8(gaw, ga); unpack8(gbw, gb);
#pragma unroll
                    for (int e = 0; e < 4; ++e) {
                        acc[ai][bj][m][0][e] *= (1.f + __expf(-gb[e])) / (1.f + __expf(-ga[e]));
                        acc[ai][bj][m][1][e] *= (1.f + __expf(-gb[4 + e])) / (1.f + __expf(-ga[4 + e])); } }
                __builtin_amdgcn_sched_barrier(0); }
    }
    __device__ __forceinline__ void operator()(const f32x4 (&acc)[2][2][4][2], const pg8::Unit& u, int wr, int wc, int fr, int fq) const {
        const int row0 = u.pm * 256 + wr * 64 + fr, col0 = u.pn * 256 + wc * 64 + 8 * fq;
#pragma unroll
        for (int ai = 0; ai < 2; ++ai)
#pragma unroll
            for (int m = 0; m < 4; ++m) { const size_t r = (size_t)(row0 + ai * 128 + m * 16);
#pragma unroll
                for (int bj = 0; bj < 2; ++bj) { const int c = col0 + bj * 32;
                    const u32x4 gbw = *(const u32x4*)(P + r * INW + C_GB + c); float gb[8]; unpack8(gbw, gb);
                    const f32x4 v0 = acc[ai][bj][m][0], v1 = acc[ai][bj][m][1];
                    float o[8];
#pragma unroll
                    for (int e = 0; e < 4; ++e) { o[e] = sigmoidf_(gb[e]) * v0[e]; o[4 + e] = sigmoidf_(gb[4 + e]) * v1[e]; }
                    u32x4 w; w.x = pg8::cvt_pk_bf16(o[0], o[1]); w.y = pg8::cvt_pk_bf16(o[2], o[3]); w.z = pg8::cvt_pk_bf16(o[4], o[5]); w.w = pg8::cvt_pk_bf16(o[6], o[7]);
                    *(u32x4*)(MG + r * 1024 + c) = w; } }
    }
};
struct EpiOut {
    static constexpr bool PERM = true; static constexpr int HOOK_T = -1;
    const float* x; bf16* xn; const float* gate; float* rowss; int grow0;
    __device__ __forceinline__ void operator()(const f32x4 (&acc)[2][2][4][2], const pg8::Unit& u, int wr, int wc, int fr, int fq) const {
        const int row0 = grow0 + u.pm * 256 + wr * 64 + fr, col0 = u.pn * 256 + wc * 64 + 8 * fq;
#pragma unroll
        for (int ai = 0; ai < 2; ++ai)
#pragma unroll
            for (int m = 0; m < 4; ++m) { const int r = row0 + ai * 128 + m * 16; const int b = r >> 12; float ss = 0.f;
#pragma unroll
                for (int bj = 0; bj < 2; ++bj) { const int c = col0 + bj * 32;
                    const float* gp = gate + b * 3072 + c; const f32x4 g0 = *(const f32x4*)gp, g1 = *(const f32x4*)(gp + 4);
                    const float* xp = x + (size_t)r * 1024 + c; const f32x4 x0 = *(const f32x4*)xp, x1 = *(const f32x4*)(xp + 4);
                    const f32x4 o0 = x0 + g0 * acc[ai][bj][m][0], o1 = x1 + g1 * acc[ai][bj][m][1];
                    ss += (o0[0] * o0[0] + o0[1] * o0[1]) + (o0[2] * o0[2] + o0[3] * o0[3]) + (o1[0] * o1[0] + o1[1] * o1[1]) + (o1[2] * o1[2] + o1[3] * o1[3]);
                    u32x4 w; w.x = pg8::cvt_pk_bf16(o0[0], o0[1]); w.y = pg8::cvt_pk_bf16(o0[2], o0[3]); w.z = pg8::cvt_pk_bf16(o1[0], o1[1]); w.w = pg8::cvt_pk_bf16(o1[2], o1[3]);
                    *(u32x4*)(xn + (size_t)r * 1024 + c) = w; }
                ss += __shfl_xor(ss, 16); ss += __shfl_xor(ss, 32);
                if (fq == 0) atomicAdd(rowss + r, ss); }
    }
};

__device__ __forceinline__ void phase_prep(const Args& a, unsigned char* lds, int vcu, int G, int pass) {
    const int tid = opaque_tid(), lane = tid & 63, wave = tid >> 6;
    unsigned char* ws = a.ws;
    bf16* P = (bf16*)(ws + WS_P);
    if (vcu < NB_PASS * 4) {
        const int bl = vcu >> 2, h = vcu & 3;
        const float* IG = (const float*)(ws + WS_IG); const float* FG = (const float*)(ws + WS_FG);
        float* gsc = (float*)(ws + WS_GSC);
        float* A1 = gsc, *B1 = gsc + MS * 4, *WI = gsc + 2 * MS * 4, *EF = gsc + 3 * MS * 4, *WK = gsc + 4 * MS * 4, *DEC = gsc + 5 * MS * 4;
        float* cg = (float*)lds; float* cp = cg + 64;
        float f[8], ii[8];
#pragma unroll
        for (int q = 0; q < 8; ++q) { const size_t grow = (size_t)pass * MS + bl * SEQ + (wave * 8 + q) * 64 + lane; f[q] = FG[grow * 4 + h]; ii[q] = IG[grow * 4 + h]; }
        float acs[8], b1[8], pm[8];
#pragma unroll
        for (int q = 0; q < 8; ++q) {
            float x = fminf(f[q], 0.f) - log1pf(expf(-fabsf(f[q])));
#pragma unroll
            for (int o = 1; o < 64; o <<= 1) { const float t = __shfl_up(x, o); if (lane >= o) x += t; }
            acs[q] = x; b1[q] = ii[q] - x;
            float m = b1[q];
#pragma unroll
            for (int o = 1; o < 64; o <<= 1) { const float t = __shfl_up(m, o); if (lane >= o) m = fmaxf(m, t); }
            pm[q] = m;
            if (lane == 63) { cg[wave * 8 + q] = x; cp[wave * 8 + q] = m; }
        }
        __syncthreads();
        float m_prev = 0.f, mp[8], Ms8[8];
        for (int j = 0; j < 64; ++j) { const float Ms = fmaxf(m_prev, cp[j]);
#pragma unroll
            for (int q = 0; q < 8; ++q) if (j == wave * 8 + q) { mp[q] = m_prev; Ms8[q] = Ms; }
            m_prev = cg[j] + Ms; }
#pragma unroll
        for (int q = 0; q < 8; ++q) {
            const int j = wave * 8 + q, lrow = bl * SEQ + j * 64 + lane;
            const float mx = fmaxf(mp[q], pm[q]);
            A1[h * MS + lrow] = -mx; B1[h * MS + lrow] = b1[q]; WI[h * MS + lrow] = expf(mp[q] - mx); EF[h * MS + lrow] = expf(-(acs[q] + mx)); WK[h * MS + lrow] = expf(b1[q] - Ms8[q]);
            if (lane == 0) { DEC[h * (MS / 64) + bl * 64 + j] = expf(mp[q] - Ms8[q]); DEC[4 * (MS / 64) + h * (MS / 64) + bl * 64 + j] = Ms8[q]; }
        }
    }
    {
        bf16* XC = (bf16*)(ws + WS_XC);
        const int cg8 = (tid & 127) * 8, rq = tid >> 7;
        float wc[4][8], bc[8];
#pragma unroll
        for (int j = 0; j < 4; ++j)
#pragma unroll
            for (int e = 0; e < 8; ++e) wc[j][e] = a.w_conv[j * 1024 + cg8 + e];
#pragma unroll
        for (int e = 0; e < 8; ++e) bc[e] = a.b_conv[cg8 + e];
        for (int it = vcu; it < MS / 32; it += G) {
            const int r0 = it * 32 + rq * 8, t0 = r0 & (SEQ - 1);
            u32x4 w[11];
#pragma unroll
            for (int k = 0; k < 11; ++k) { const int rr = r0 - 3 + k; w[k] = (k >= 3 || t0 >= 3) ? *(const u32x4*)(P + (size_t)rr * INW + C_XA + cg8) : (u32x4){0u, 0u, 0u, 0u}; }
            float xin[11][8];
#pragma unroll
            for (int k = 0; k < 11; ++k) unpack8(w[k], xin[k]);
#pragma unroll
            for (int k = 0; k < 8; ++k) { float o[8];
#pragma unroll
                for (int e = 0; e < 8; ++e) o[e] = siluf_(bc[e] + wc[0][e] * xin[k][e] + wc[1][e] * xin[k + 1][e] + wc[2][e] * xin[k + 2][e] + wc[3][e] * xin[k + 3][e]);
                u32x4 ov; ov.x = pk2(o[0], o[1]); ov.y = pk2(o[2], o[3]); ov.z = pk2(o[4], o[5]); ov.w = pk2(o[6], o[7]);
                *(u32x4*)(XC + (size_t)(r0 + k) * 1024 + cg8) = ov; }
        }
    }
}

__device__ __forceinline__ f32x4 mfma16(bf16x8 a, bf16x8 b, f32x4 c) { return __builtin_amdgcn_mfma_f32_16x16x32_bf16(a, b, c, 0, 0, 0); }

constexpr int TPS = 72;
constexpr int XCS = 264;
constexpr int L_QC_X = 0, L_QC_Q = 36864, L_QC_KT = L_QC_Q + 64 * XCS * 2, L_QC_ST = L_QC_KT + 256 * TPS * 2, L_QC_END = L_QC_ST + 64 * TPS * 2;
static_assert(64 * XCS * 2 <= 36864 && 256 * TPS * 2 <= 36864 && L_QC_END <= 131072, "qkc lds");
__device__ __forceinline__ void phase_cprep(const Args& a, unsigned char* lds, int vcu, int G) {
    const int tid = opaque_tid(), lane = tid & 63, wave = __builtin_amdgcn_readfirstlane(tid >> 6);
    const int fr = lane & 15, fq = lane >> 4;
    unsigned char* ws = a.ws;
    const bf16* P = (const bf16*)(ws + WS_P); const bf16* XC = (const bf16*)(ws + WS_XC); bf16* QM = (bf16*)(ws + WS_QM);
    const bf16* WF = (const bf16*)(ws + WS_WQK);
    const float* gsc = (const float*)(ws + WS_GSC);
    const float* gA1 = gsc, *gWK = gsc + 4 * MS * 4, *gMS = gsc + 5 * MS * 4 + 4 * (MS / 64);
    bf16* SG = (bf16*)(ws + WS_SG); bf16* KTG = (bf16*)(ws + WS_KTG); bf16* VTG = (bf16*)(ws + WS_VTG);
    bf16* XS = (bf16*)(lds + L_QC_X); bf16* VT = (bf16*)(lds + L_QC_X); bf16* QL = (bf16*)(lds + L_QC_Q); bf16* KT = (bf16*)(lds + L_QC_KT); bf16* ST = (bf16*)(lds + L_QC_ST);
    const int ti = wave >> 1, tj0 = 2 * (wave & 1);
    for (int ci = vcu; ci < (MS / 64) * 4; ci += G) {
        const int h = ci & 3, t0 = (ci >> 2) * 64;
        u32x4 xw[4], vw[4];
#pragma unroll
        for (int i = 0; i < 4; ++i) { const int c = tid + NTHR * i, row = c >> 5, cc = c & 31;
            xw[i] = *(const u32x4*)(XC + (size_t)(t0 + row) * 1024 + h * 256 + 8 * cc); }
#pragma unroll
        for (int i = 0; i < 4; ++i) { const int c = tid + NTHR * i, l = c & 63, dc = c >> 6;
            vw[i] = *(const u32x4*)(P + (size_t)(t0 + l) * INW + C_VA + h * 256 + 8 * dc); }
        float wkr[4][4], a1l[4];
        if (wave >= 4) {
#pragma unroll
            for (int lt = 0; lt < 4; ++lt)
#pragma unroll
                for (int i = 0; i < 4; ++i) wkr[lt][i] = gWK[h * MS + t0 + 16 * lt + 4 * fq + i];
        }
#pragma unroll
        for (int i = 0; i < 4; ++i) a1l[i] = gA1[h * MS + t0 + 16 * ti + 4 * fq + i];
        const float msc = gMS[h * (MS / 64) + (ci >> 2)];
        __syncthreads();
#pragma unroll
        for (int i = 0; i < 4; ++i) { const int c = tid + NTHR * i, row = c >> 5, cc = c & 31; *(u32x4*)(XS + row * XCS + 8 * cc) = xw[i]; }
        __syncthreads();
        const bf16* wf = WF + (size_t)h * 512 * 256;
#pragma unroll 1
        for (int ct = 0; ct < 4; ++ct) {
            const int nt = 4 * wave + ct;
            bf16x8 bq[8];
#pragma unroll
            for (int ks = 0; ks < 8; ++ks) bq[ks] = *(const bf16x8*)(wf + (size_t)((nt * 8 + ks) * 64 + lane) * 8);
#pragma unroll
            for (int lt = 0; lt < 4; ++lt) {
                f32x4 acc = {0.f, 0.f, 0.f, 0.f};
#pragma unroll
                for (int ks = 0; ks < 8; ++ks) { const bf16x8 af = *(const bf16x8*)(XS + (16 * lt + fr) * XCS + 32 * ks + 8 * fq); acc = mfma16(af, bq[ks], acc); }
                if (wave < 4) {
#pragma unroll
                    for (int i = 0; i < 4; ++i) QL[(16 * lt + 4 * fq + i) * XCS + 64 * wave + 16 * ct + fr] = (bf16)f2bf(acc[i]);
                } else {
                    const int d = 64 * (wave - 4) + 16 * ct + fr;
                    u32x2 o; o.x = pk2(acc[0] * wkr[lt][0], acc[1] * wkr[lt][1]); o.y = pk2(acc[2] * wkr[lt][2], acc[3] * wkr[lt][3]);
                    *(u32x2*)(KT + d * TPS + 16 * lt + 4 * fq) = o;
                }
            }
        }
        __syncthreads();
#pragma unroll
        for (int i = 0; i < 4; ++i) { const int c = tid + NTHR * i, l = c & 63, dc = c >> 6;
            const u32x4 w = vw[i]; bf16* dv = VT + (8 * dc) * TPS + l;
            dv[0 * TPS] = (bf16)(w.x & 0xffff); dv[1 * TPS] = (bf16)(w.x >> 16); dv[2 * TPS] = (bf16)(w.y & 0xffff); dv[3 * TPS] = (bf16)(w.y >> 16);
            dv[4 * TPS] = (bf16)(w.z & 0xffff); dv[5 * TPS] = (bf16)(w.z >> 16); dv[6 * TPS] = (bf16)(w.w & 0xffff); dv[7 * TPS] = (bf16)(w.w >> 16); }
#pragma unroll
        for (int i = 0; i < 4; ++i) { const int c = tid + NTHR * i, row = c >> 5, cc = c & 31;
            *(u32x4*)(QM + (size_t)(t0 + row) * 1024 + h * 256 + 8 * cc) = *(const u32x4*)(QL + row * XCS + 8 * cc); }
#pragma unroll
        for (int tt = 0; tt < 2; ++tt) {
            const int tj = tj0 + tt;
            f32x4 sacc = {0.f, 0.f, 0.f, 0.f};
            if (tj <= ti) {
#pragma unroll
                for (int ks = 0; ks < 8; ++ks) {
                    const bf16x8 qf = *(const bf16x8*)(QL + (16 * ti + fr) * XCS + 32 * ks + 8 * fq);
                    const bf16* kp = KT + (32 * ks + 8 * fq + (fr >> 2)) * TPS + 16 * tj + 4 * (fr & 3);
                    const s16x4 k0 = __builtin_amdgcn_ds_read_tr16_b64_v4i16((__attribute__((address_space(3))) s16x4*)(kp));
                    const s16x4 k1 = __builtin_amdgcn_ds_read_tr16_b64_v4i16((__attribute__((address_space(3))) s16x4*)(kp + 4 * TPS));
                    bf16x8 kb; kb[0] = k0[0]; kb[1] = k0[1]; kb[2] = k0[2]; kb[3] = k0[3]; kb[4] = k1[0]; kb[5] = k1[1]; kb[6] = k1[2]; kb[7] = k1[3];
                    sacc = mfma16(qf, kb, sacc); }
            }
            const int sidx = 16 * tj + fr;
#pragma unroll
            for (int i = 0; i < 4; ++i) { const int l = 16 * ti + 4 * fq + i;
                float v = 0.f;
                if (sidx <= l) v = sacc[i] * __expf(a1l[i] + msc);
                ST[l * TPS + sidx] = (bf16)f2bf(v); }
        }
        __syncthreads();
        { const int row = tid >> 3, ch = tid & 7; *(u32x4*)(SG + (size_t)ci * 4096 + row * 64 + 8 * ch) = *(const u32x4*)(ST + row * TPS + 8 * ch); }
#pragma unroll
        for (int i = 0; i < 4; ++i) { const int p = tid + NTHR * i, blk = p >> 6, ln = p & 63, row = (blk >> 1) * 16 + (ln & 15), ch = (blk & 1) * 4 + (ln >> 4);
            *(u32x4*)(KTG + (size_t)ci * 16384 + p * 8) = *(const u32x4*)(KT + row * TPS + 8 * ch);
            *(u32x4*)(VTG + (size_t)ci * 16384 + p * 8) = *(const u32x4*)(VT + row * TPS + 8 * ch); }
    }
}

constexpr int SA_DEPTH = 5, SA_PATCH = 32 * 32 * 2 + 128;
struct ScanA { const bf16* KTG; const bf16* VTG; const float* gDEC; bf16* CS; float* NS; int bl, h, dblk, eblk, wave, fr, fq; unsigned koff, voff; bool do_den; };
struct ScanAOps { bf16x8 k[2][2], v[2][2]; float decay; };
__device__ __forceinline__ void scana_load(const ScanA& c, int j, ScanAOps& o) {
    const int ci = (c.bl * 64 + j) * 4 + c.h;
    const bf16* kb = c.KTG + (size_t)ci * 16384; const bf16* vb = c.VTG + (size_t)ci * 16384;
#pragma unroll
    for (int dt = 0; dt < 2; ++dt)
#pragma unroll
        for (int k2 = 0; k2 < 2; ++k2) o.k[dt][k2] = *(const bf16x8*)(kb + (c.koff + (unsigned)((dt * 2 + k2) * 512)));
#pragma unroll
    for (int et = 0; et < 2; ++et)
#pragma unroll
        for (int k2 = 0; k2 < 2; ++k2) o.v[et][k2] = *(const bf16x8*)(vb + (c.voff + (unsigned)((et * 2 + k2) * 512)));
    o.decay = c.gDEC[c.h * (MS / 64) + c.bl * 64 + j];
}
__device__ __forceinline__ void scana_step(const ScanA& c, unsigned char* lds, int j, f32x4 (&Cacc)[2][2], f32x4 (&Nacc)[2], const ScanAOps& o, const bf16x8 ones) {
    const int ci = (c.bl * 64 + j) * 4 + c.h;
    unsigned char* patch = lds + c.wave * SA_PATCH;
    const int lane = c.fq * 16 + c.fr;
    if ((j & 1) == 0) {
#pragma unroll
    for (int dt = 0; dt < 2; ++dt) {
#pragma unroll
        for (int et = 0; et < 2; ++et) { const f32x4 cc = Cacc[dt][et]; u32x2 w; w.x = pk2(cc[0], cc[1]); w.y = pk2(cc[2], cc[3]);
            *(u32x2*)(patch + (16 * et + c.fr) * 64 + (16 * dt + 4 * c.fq) * 2) = w; }
        if (c.do_den && c.fr == 0) *(f32x4*)(patch + 2048 + (16 * dt + 4 * c.fq) * 4) = Nacc[dt];
    }
    { bf16* cs = c.CS + (size_t)ci * 65536 + (c.eblk * 8 + c.dblk) * 1024;
#pragma unroll
      for (int k = 0; k < 2; ++k) __builtin_nontemporal_store(*(const u32x4*)(patch + k * 1024 + lane * 16), (u32x4*)(cs + k * 512 + lane * 8));
      if (c.do_den && lane < 8) *(f32x4*)(c.NS + (size_t)ci * 256 + c.dblk * 32 + lane * 4) = *(const f32x4*)(patch + 2048 + lane * 16); }
    }
#pragma unroll
    for (int dt = 0; dt < 2; ++dt) {
#pragma unroll
        for (int et = 0; et < 2; ++et) {
            f32x4 cc = Cacc[dt][et] * o.decay;
#pragma unroll
            for (int k2 = 0; k2 < 2; ++k2) cc = mfma16(o.k[dt][k2], o.v[et][k2], cc);
            Cacc[dt][et] = cc;
        }
        if (c.do_den) {
            f32x4 cc = Nacc[dt] * o.decay;
#pragma unroll
            for (int k2 = 0; k2 < 2; ++k2) cc = mfma16(o.k[dt][k2], ones, cc);
            Nacc[dt] = cc;
        }
    }
}
__device__ __forceinline__ void scana_item(const Args& a, unsigned char* lds, int item) {
    const int tid = opaque_tid(), lane = tid & 63;
    unsigned char* ws = a.ws;
    ScanA c;
    c.wave = __builtin_amdgcn_readfirstlane(tid >> 6); c.fr = lane & 15; c.fq = lane >> 4;
    item = __builtin_amdgcn_readfirstlane(item);
    c.bl = item >> 5; c.h = (item >> 3) & 3; c.dblk = 2 * ((item >> 1) & 3) + (c.wave >> 2); c.eblk = 4 * (item & 1) + (c.wave & 3); c.do_den = (c.eblk == 0);
    c.koff = (unsigned)((4 * c.dblk) * 512 + lane * 8); c.voff = (unsigned)((4 * c.eblk) * 512 + lane * 8);
    c.KTG = (const bf16*)(ws + WS_KTG); c.VTG = (const bf16*)(ws + WS_VTG); c.gDEC = (const float*)(ws + WS_GSC) + 5 * MS * 4;
    c.CS = (bf16*)(ws + WS_CS); c.NS = (float*)(ws + WS_NS);
    f32x4 Cacc[2][2], Nacc[2];
#pragma unroll
    for (int x = 0; x < 2; ++x) { Nacc[x] = (f32x4){0.f, 0.f, 0.f, 0.f};
#pragma unroll
        for (int y = 0; y < 2; ++y) Cacc[x][y] = (f32x4){0.f, 0.f, 0.f, 0.f}; }
    bf16x8 ones;
    { const short ov = (c.fr == 0) ? (short)0x3F80 : (short)0;
#pragma unroll
      for (int e = 0; e < 8; ++e) ones[e] = ov; }
    ScanAOps o0, o1, o2, o3, o4;
    scana_load(c, 0, o0); scana_load(c, 1, o1); scana_load(c, 2, o2); scana_load(c, 3, o3); scana_load(c, 4, o4);
#define SA_STEP(jj, ob) do { scana_step(c, lds, (jj), Cacc, Nacc, ob, ones); __builtin_amdgcn_sched_barrier(0); scana_load(c, (jj) + SA_DEPTH < 64 ? (jj) + SA_DEPTH : 63, ob); __builtin_amdgcn_sched_barrier(0); } while (0)
#pragma nounroll
    for (int j = 0; j < 60; j += 5) { SA_STEP(j, o0); SA_STEP(j + 1, o1); SA_STEP(j + 2, o2); SA_STEP(j + 3, o3); SA_STEP(j + 4, o4); }
    SA_STEP(60, o0); SA_STEP(61, o1); SA_STEP(62, o2); SA_STEP(63, o3);
#undef SA_STEP
    asm volatile("s_waitcnt vmcnt(0)" ::: "memory");
}

constexpr int AKS = 136;
constexpr int L_AK = 0, L_AV = L_AK + 128 * AKS * 2, L_AP = L_AV + 128 * AKS * 2, L_ATT_END = L_AP + 8 * 16 * AKS * 2;
static_assert(L_ATT_END <= 131072, "attn lds");

__device__ __forceinline__ void attn_item(const Args& a, unsigned char* lds, int item) {
    const int tid = opaque_tid(), lane = tid & 63, wave = __builtin_amdgcn_readfirstlane(tid >> 6);
    const int fr = lane & 15, fq = lane >> 4;
    unsigned char* ws = a.ws;
    const int blk = item & 31, hh = (item >> 5) & 3, bl = (item >> 7) & 3, g = item >> 9;
    const int dil = g == 0 ? 1 : g == 1 ? 4 : 16, nb = 32 / dil;
    const int r = blk / nb, n = blk % nb;
    const bf16* P = (const bf16*)(ws + WS_P);
    const int H = 4 * g + hh;
    const bf16* Qb = P + C_QA + H * 128; const bf16* Kb = P + C_KA + H * 128; const bf16* Vb = P + C_VT + H * 128;
    bf16* Ks = (bf16*)(lds + L_AK); bf16* VTs = (bf16*)(lds + L_AV); bf16* Pw = (bf16*)(lds + L_AP) + wave * 16 * AKS;
    const int rowbase = bl * SEQ + r;
    bf16x8 qf[4];
    { const size_t qrow = (size_t)(rowbase + (128 * n + 16 * wave + fr) * dil);
#pragma unroll
      for (int ks = 0; ks < 4; ++ks) qf[ks] = *(const bf16x8*)(Qb + qrow * INW + 32 * ks + 8 * fq); }
    f32x4 O[8];
#pragma unroll
    for (int i = 0; i < 8; ++i) O[i] = (f32x4){0.f, 0.f, 0.f, 0.f};
    float mrow = -INFINITY, lrow = 0.f;
    const float scale = 0.08838834764831845f;
#define ATT_BAR() do { asm volatile("s_waitcnt lgkmcnt(0)" ::: "memory"); __builtin_amdgcn_s_barrier(); asm volatile("" ::: "memory"); } while (0)
    const int half0 = (n == 0 ? 1 : 0);
    u32x4 kreg[4], vreg[4];
#pragma unroll
    for (int i = 0; i < 4; ++i) { const int c = tid + NTHR * i, key = c >> 4, dc = c & 15;
        const size_t krow = (size_t)(rowbase + (128 * (n - 1 + half0) + key) * dil);
        kreg[i] = *(const u32x4*)(Kb + krow * INW + 8 * dc); vreg[i] = *(const u32x4*)(Vb + krow * INW + 8 * dc); }
    for (int half = half0; half < 2; ++half) {
        ATT_BAR();
#pragma unroll
        for (int i = 0; i < 4; ++i) { const int c = tid + NTHR * i, key = c >> 4, dc = c & 15;
            *(u32x4*)(Ks + key * AKS + 8 * dc) = kreg[i]; *(u32x4*)(VTs + key * AKS + 8 * dc) = vreg[i]; }
        if (half == 0) {
#pragma unroll
            for (int i = 0; i < 4; ++i) { const int c = tid + NTHR * i, key = c >> 4, dc = c & 15;
                const size_t krow = (size_t)(rowbase + (128 * n + key) * dil);
                kreg[i] = *(const u32x4*)(Kb + krow * INW + 8 * dc); vreg[i] = *(const u32x4*)(Vb + krow * INW + 8 * dc); }
        }
        ATT_BAR();
        f32x4 S[8];
        const int p = 16 * wave + fr;
        float mx = -INFINITY;
#pragma unroll
        for (int kt = 0; kt < 8; ++kt) {
            const bool act = half == 0 ? (kt >= wave) : (kt <= wave);
            f32x4 sacc = {0.f, 0.f, 0.f, 0.f};
            if (act) {
#pragma unroll
                for (int ks = 0; ks < 4; ++ks) { const bf16x8 kf = *(const bf16x8*)(Ks + (16 * kt + fr) * AKS + 32 * ks + 8 * fq); sacc = mfma16(kf, qf[ks], sacc); }
#pragma unroll
                for (int i = 0; i < 4; ++i) { const int kk = 16 * kt + 4 * fq + i; const bool ok = half == 0 ? (kk >= p) : (kk <= p);
                    const float v = ok ? sacc[i] * scale : -INFINITY; sacc[i] = v; mx = fmaxf(mx, v); }
            }
            S[kt] = sacc;
        }
        mx = fmaxf(mx, __shfl_xor(mx, 16)); mx = fmaxf(mx, __shfl_xor(mx, 32));
        const float mn = fmaxf(mrow, mx), alpha = __expf(mrow - mn); mrow = mn;
        float rs = 0.f;
        unsigned pk[8][2];
#pragma unroll
        for (int kt = 0; kt < 8; ++kt) {
            const bool act = half == 0 ? (kt >= wave) : (kt <= wave);
            if (act) { const float p0 = __expf(S[kt][0] - mn), p1 = __expf(S[kt][1] - mn), p2 = __expf(S[kt][2] - mn), p3 = __expf(S[kt][3] - mn);
                rs += (p0 + p1) + (p2 + p3); pk[kt][0] = pk2(p0, p1); pk[kt][1] = pk2(p2, p3); }
            else { pk[kt][0] = 0u; pk[kt][1] = 0u; }
        }
        rs += __shfl_xor(rs, 16); rs += __shfl_xor(rs, 32);
        lrow = lrow * alpha + rs;
        float al[4];
#pragma unroll
        for (int i = 0; i < 4; ++i) al[i] = __shfl(alpha, 4 * fq + i);
#pragma unroll
        for (int dtile = 0; dtile < 8; ++dtile)
#pragma unroll
            for (int i = 0; i < 4; ++i) O[dtile][i] *= al[i];
#pragma unroll
        for (int ks = 0; ks < 4; ++ks) {
            const bool act = half == 0 ? (2 * ks + 1 >= wave) : (2 * ks <= wave);
            if (act) {
                u32x4 pw; pw.x = pk[2 * ks][0]; pw.y = pk[2 * ks][1]; pw.z = pk[2 * ks + 1][0]; pw.w = pk[2 * ks + 1][1];
                const bf16x8 pa = __builtin_bit_cast(bf16x8, pw);
#pragma unroll
                for (int dtile = 0; dtile < 8; ++dtile) {
                    const bf16* vp = VTs + (32 * ks + 4 * fq + (fr >> 2)) * AKS + 16 * dtile + 4 * (fr & 3);
                    const s16x4 v0 = __builtin_amdgcn_ds_read_tr16_b64_v4i16((__attribute__((address_space(3))) s16x4*)(vp));
                    const s16x4 v1 = __builtin_amdgcn_ds_read_tr16_b64_v4i16((__attribute__((address_space(3))) s16x4*)(vp + 16 * AKS));
                    bf16x8 vb; vb[0] = v0[0]; vb[1] = v0[1]; vb[2] = v0[2]; vb[3] = v0[3]; vb[4] = v1[0]; vb[5] = v1[1]; vb[6] = v1[2]; vb[7] = v1[3];
                    O[dtile] = mfma16(pa, vb, O[dtile]); }
            }
        }
    }
    bf16* AO = (bf16*)(ws + WS_AO) + (size_t)g * MS * 512; float* LSE = (float*)(ws + WS_LSE) + (size_t)g * MS * 4;
    {
        const float inv_l = 1.f / lrow;
        float il[4];
#pragma unroll
        for (int i = 0; i < 4; ++i) il[i] = __shfl(inv_l, 4 * fq + i);
#pragma unroll
        for (int dtile = 0; dtile < 8; ++dtile)
#pragma unroll
            for (int i = 0; i < 4; ++i) Pw[(4 * fq + i) * AKS + 16 * dtile + fr] = (bf16)f2bf(O[dtile][i] * il[i]);
        if (fq == 0) { const size_t row = (size_t)(rowbase + (128 * n + 16 * wave + fr) * dil); LSE[(size_t)hh * MS + row] = mrow + logf(lrow); }
#pragma unroll
        for (int k = 0; k < 4; ++k) { const int c = lane + 64 * k, q = c >> 4, ch = c & 15;
            const size_t row = (size_t)(rowbase + (128 * n + 16 * wave + q) * dil);
            *(u32x4*)(AO + row * 512 + hh * 128 + 8 * ch) = *(const u32x4*)(Pw + q * AKS + 8 * ch); }
    }
    __syncthreads();
}

constexpr int N_SCAN_ITEMS = NB_PASS * 32, N_ATT_ITEMS = 3 * NB_PASS * 4 * 32;
#ifndef PROBE_ATT_REP
#define PROBE_ATT_REP 1
#endif
struct XcdBarrier;
__device__ __forceinline__ void xcd_barrier(const XcdBarrier& b);
__device__ __forceinline__ void phase_mix(const Args& a, unsigned char* lds, int pass, const XcdBarrier* pbar) {
    volatile int* slot = (volatile int*)(lds + 131072 + 1024);
#ifdef PROBE_SPLIT
    for (int it = blockIdx.x; it < N_SCAN_ITEMS; it += gridDim.x) scana_item(a, lds, it);
    xcd_barrier(*pbar);
    for (int rep = 0; rep < PROBE_ATT_REP; ++rep)
    for (int it = blockIdx.x; it < N_ATT_ITEMS; it += gridDim.x) attn_item(a, lds, it);
#else
    if ((int)blockIdx.x < N_SCAN_ITEMS && gridDim.x >= (unsigned)N_SCAN_ITEMS) {
        const int x = blockIdx.x & 7, k = blockIdx.x >> 3, g = x + 8 * (k >> 3), m = k & 7;
        scana_item(a, lds, g * 8 + m);
    } else if (gridDim.x < (unsigned)N_SCAN_ITEMS) { for (int it = blockIdx.x; it < N_SCAN_ITEMS; it += gridDim.x) scana_item(a, lds, it); }
    constexpr int QN = N_ATT_ITEMS / 8;
    for (int qo = 0; qo < 8; ++qo) {
        const int qx = (int)((blockIdx.x + qo) & 7);
        unsigned* qc = (unsigned*)(a.ws + WS_CTL) + CW_QCTR + (pass * 8 + qx) * 64;
        for (;;) {
            __syncthreads();
            if (opaque_tid() == 0) *slot = (int)atomicAdd(qc, 1u);
            __syncthreads();
            const int L = *slot;
            if (L >= QN) break;
            attn_item(a, lds, ((L >> 3) * 8 + qx) * 8 + (L & 7));
        }
    }
#endif
}

constexpr int QS_STRIDE = 264, SS_STRIDE = 72;
constexpr int L_QS = 0, L_SS = L_QS + 64 * QS_STRIDE * 2, L_DENL = L_SS + 64 * SS_STRIDE * 2, L_WIL = L_DENL + 256, L_NUM = L_WIL + 256, L_SB_END = L_NUM + 64 * QS_STRIDE * 2;
static_assert(L_SB_END <= 131072, "scan-B lds");
constexpr int L_KTL = L_SB_END, L_XS = L_KTL + 256 * TPS * 2, L_SB2_END = L_XS + 64 * TPS * 2;
static_assert(L_SB2_END <= 131072, "scan-B lds");
struct SBCtx { const bf16* P; const bf16* XC; const bf16* QM; const bf16* SG; const bf16* VTG; const bf16* KTG; const bf16* CS; const float* NS; const float* gWI; const float* gEF; const float* gDEC; bf16* UM; int tid, lane, wave, fr, fq; };

__device__ __forceinline__ void scanb_tail(const Args& a, const SBCtx& c, const bf16* NUMS, const float* DENL, int h, int t0) {
    const int lane = c.lane, wave = c.wave, col = h * 256 + 4 * lane;
    const f32x4 gh = *(const f32x4*)(a.g_head + col), sk = *(const f32x4*)(a.skip + col);
#pragma unroll
    for (int hb = 0; hb < 2; ++hb) {
        u32x2 ow[4], zw[4], xw[4];
#pragma unroll
        for (int q = 0; q < 4; ++q) { const size_t r = (size_t)(t0 + 8 * wave + 4 * hb + q);
            ow[q] = *(const u32x2*)(c.P + r * INW + C_OA + col); zw[q] = *(const u32x2*)(c.P + r * INW + C_ZA + col); xw[q] = *(const u32x2*)(c.XC + r * 1024 + col); }
#pragma unroll
        for (int q = 0; q < 4; ++q) {
            const int l = 8 * wave + 4 * hb + q; const size_t r = (size_t)(t0 + l);
            const u32x2 hw = *(const u32x2*)(NUMS + l * QS_STRIDE + 4 * lane);
            const float rd = DENL[l];
            float hm[4] = {sigmoidf_(bflo(ow[q].x)) * bflo(hw.x) * rd, sigmoidf_(bfhi(ow[q].x)) * bfhi(hw.x) * rd, sigmoidf_(bflo(ow[q].y)) * bflo(hw.y) * rd, sigmoidf_(bfhi(ow[q].y)) * bfhi(hw.y) * rd};
            float ss = (hm[0] * hm[0] + hm[1] * hm[1]) + (hm[2] * hm[2] + hm[3] * hm[3]);
            ss = wave_sum(ss);
            const float rinv = 1.f / sqrtf(ss * (1.f / 256.f) + EPS);
            const float xc[4] = {bflo(xw[q].x), bfhi(xw[q].x), bflo(xw[q].y), bfhi(xw[q].y)}, za[4] = {bflo(zw[q].x), bfhi(zw[q].x), bflo(zw[q].y), bfhi(zw[q].y)};
            float o[4];
#pragma unroll
            for (int e = 0; e < 4; ++e) o[e] = (hm[e] * rinv * gh[e] + sk[e] * xc[e]) * siluf_(za[e]);
            u32x2 ov; ov.x = pk2(o[0], o[1]); ov.y = pk2(o[2], o[3]);
            *(u32x2*)(c.UM + r * 1536 + col) = ov;
        }
        __builtin_amdgcn_sched_barrier(0);
    }
}

__device__ __forceinline__ void scanb_run(const Args& a, unsigned char* lds, int vcu, int G, int pass) {
    SBCtx c;
    c.tid = opaque_tid(); c.lane = c.tid & 63; c.wave = __builtin_amdgcn_readfirstlane(c.tid >> 6); c.fr = c.lane & 15; c.fq = c.lane >> 4;
    unsigned char* ws = a.ws;
    c.P = (const bf16*)(ws + WS_P); c.XC = (const bf16*)(ws + WS_XC); c.QM = (const bf16*)(ws + WS_QM); c.SG = (const bf16*)(ws + WS_SG); c.VTG = (const bf16*)(ws + WS_VTG); c.KTG = (const bf16*)(ws + WS_KTG);
    c.CS = (const bf16*)(ws + WS_CS); c.NS = (const float*)(ws + WS_NS); c.gWI = (const float*)(ws + WS_GSC) + 2 * MS * 4; c.gEF = (const float*)(ws + WS_GSC) + 3 * MS * 4; c.gDEC = (const float*)(ws + WS_GSC) + 5 * MS * 4;
    c.UM = (bf16*)(ws + WS_ACAT);
    const int tid = c.tid, lane = c.lane, wave = c.wave, fr = c.fr, fq = c.fq;
    bf16* QS = (bf16*)(lds + L_QS); bf16* SS = (bf16*)(lds + L_SS); float* DENL = (float*)(lds + L_DENL); float* WIL = (float*)(lds + L_WIL); bf16* NUMS = (bf16*)(lds + L_NUM);
    bf16* KTL = (bf16*)(lds + L_KTL); bf16* XS = (bf16*)(lds + L_XS);
    unsigned* qc = (unsigned*)(ws + WS_CTL) + CW_QCTR + 2048 + pass * 64;
    volatile int* slot = (volatile int*)(lds + 131072 + 1024);
    constexpr int NITEMS = (MS / 128) * 4;
    bf16x8 ones;
    { const short ov = (fr == 0) ? (short)0x3F80 : (short)0;
#pragma unroll
      for (int e = 0; e < 8; ++e) ones[e] = ov; }
    int it = vcu;
    while (it < NITEMS) {
        const int h = it & 3, pr = it >> 2, chA = (2 * pr) * 4 + h, chB = chA + 4, tA = (2 * pr) * 64, tB = tA + 64;
        bf16x8 cb[2][8], vtA[2][2], vtB[2][2];
#pragma unroll
        for (int t = 0; t < 2; ++t) {
#pragma unroll
            for (int ks = 0; ks < 8; ++ks) cb[t][ks] = *(const bf16x8*)(c.CS + (size_t)chA * 65536 + (wave * 8 + ks) * 1024 + (16 * t + fr) * 32 + 8 * fq);
#pragma unroll
            for (int k2 = 0; k2 < 2; ++k2) { vtA[t][k2] = *(const bf16x8*)(c.VTG + (size_t)chA * 16384 + (((2 * wave + t) * 2 + k2) * 64 + lane) * 8);
                                             vtB[t][k2] = *(const bf16x8*)(c.VTG + (size_t)chB * 16384 + (((2 * wave + t) * 2 + k2) * 64 + lane) * 8); }
        }
        const float decA = c.gDEC[h * (MS / 64) + 2 * pr];
        if (tid == 0) *slot = (int)atomicAdd(qc, 1u);
        __syncthreads();
#pragma unroll
        for (int i = 0; i < 4; ++i) { const int q = tid + NTHR * i, row = q >> 5, cc = q & 31; *(u32x4*)(QS + row * QS_STRIDE + 8 * cc) = *(const u32x4*)(c.QM + (size_t)(tA + row) * 1024 + h * 256 + 8 * cc); }
        { const int row = tid >> 3, cc = tid & 7; *(u32x4*)(SS + row * SS_STRIDE + 8 * cc) = *(const u32x4*)(c.SG + (size_t)chA * 4096 + row * 64 + 8 * cc); }
        if (tid < 64) WIL[tid] = c.gWI[h * MS + tA + tid];
#pragma unroll
        for (int i = 0; i < 4; ++i) { const int p = tid + NTHR * i, blk = p >> 6, ln = p & 63, row = (blk >> 1) * 16 + (ln & 15), ch8 = (blk & 1) * 4 + (ln >> 4);
            *(u32x4*)(KTL + row * TPS + 8 * ch8) = *(const u32x4*)(c.KTG + (size_t)chA * 16384 + p * 8); }
        __syncthreads();
        const int nit = G + *slot;
#pragma unroll
        for (int lt = 0; lt < 4; ++lt) {
            bf16x8 qf[8], sf[2];
#pragma unroll
            for (int ks = 0; ks < 8; ++ks) qf[ks] = *(const bf16x8*)(QS + (16 * lt + fr) * QS_STRIDE + 32 * ks + 8 * fq);
#pragma unroll
            for (int k2 = 0; k2 < 2; ++k2) sf[k2] = *(const bf16x8*)(SS + (16 * lt + fr) * SS_STRIDE + 32 * k2 + 8 * fq);
#pragma unroll
            for (int t = 0; t < 2; ++t) {
                f32x4 a1 = {0.f, 0.f, 0.f, 0.f}, a2 = {0.f, 0.f, 0.f, 0.f}, a3 = {0.f, 0.f, 0.f, 0.f};
#pragma unroll
                for (int k2 = 0; k2 < 2; ++k2) a1 = mfma16(sf[k2], vtA[t][k2], a1);
#pragma unroll
                for (int ks = 0; ks < 8; ks += 2) { a2 = mfma16(qf[ks], cb[t][ks], a2); a3 = mfma16(qf[ks + 1], cb[t][ks + 1], a3); }
#pragma unroll
                for (int i = 0; i < 4; ++i) NUMS[(16 * lt + 4 * fq + i) * QS_STRIDE + 32 * wave + 16 * t + fr] = (bf16)f2bf(a1[i] + WIL[16 * lt + 4 * fq + i] * (a2[i] + a3[i]));
            }
        }
        if (wave == 0) {
            bf16x8 nb[8];
#pragma unroll
            for (int ks = 0; ks < 8; ++ks) { const f32x4 n0 = *(const f32x4*)(c.NS + (size_t)chA * 256 + 32 * ks + 8 * fq), n1 = *(const f32x4*)(c.NS + (size_t)chA * 256 + 32 * ks + 8 * fq + 4);
                u32x4 w; w.x = pk2(n0[0], n0[1]); w.y = pk2(n0[2], n0[3]); w.z = pk2(n1[0], n1[1]); w.w = pk2(n1[2], n1[3]);
                if (fr != 0) w = (u32x4){0u, 0u, 0u, 0u};
                nb[ks] = __builtin_bit_cast(bf16x8, w); }
#pragma unroll
            for (int lt = 0; lt < 4; ++lt) {
                f32x4 a1 = {0.f, 0.f, 0.f, 0.f}, a2 = {0.f, 0.f, 0.f, 0.f};
#pragma unroll
                for (int k2 = 0; k2 < 2; ++k2) { const bf16x8 sf = *(const bf16x8*)(SS + (16 * lt + fr) * SS_STRIDE + 32 * k2 + 8 * fq); a1 = mfma16(sf, ones, a1); }
#pragma unroll
                for (int ks = 0; ks < 8; ++ks) { const bf16x8 qf = *(const bf16x8*)(QS + (16 * lt + fr) * QS_STRIDE + 32 * ks + 8 * fq); a2 = mfma16(qf, nb[ks], a2); }
                if (fr == 0) {
#pragma unroll
                    for (int i = 0; i < 4; ++i) { const int l = 16 * lt + 4 * fq + i; const float den = a1[i] + WIL[l] * a2[i]; DENL[l] = 1.f / fmaxf(fabsf(den), c.gEF[h * MS + tA + l]); } }
            }
        }
        __syncthreads();
#pragma unroll
        for (int i = 0; i < 4; ++i) { const int q = tid + NTHR * i, row = q >> 5, cc = q & 31; *(u32x4*)(QS + row * QS_STRIDE + 8 * cc) = *(const u32x4*)(c.QM + (size_t)(tB + row) * 1024 + h * 256 + 8 * cc); }
        { const int row = tid >> 3, cc = tid & 7; *(u32x4*)(SS + row * SS_STRIDE + 8 * cc) = *(const u32x4*)(c.SG + (size_t)chB * 4096 + row * 64 + 8 * cc); }
        scanb_tail(a, c, NUMS, DENL, h, tA);
        __syncthreads();
        if (tid < 64) WIL[tid] = c.gWI[h * MS + tB + tid];
        {
            const int ti = wave >> 1;
            bf16x8 qf[8];
#pragma unroll
            for (int ks = 0; ks < 8; ++ks) qf[ks] = *(const bf16x8*)(QS + (16 * ti + fr) * QS_STRIDE + 32 * ks + 8 * fq);
#pragma unroll
            for (int tt = 0; tt < 2; ++tt) { const int tj = 2 * (wave & 1) + tt;
                f32x4 xacc = {0.f, 0.f, 0.f, 0.f};
#pragma unroll
                for (int ks = 0; ks < 8; ++ks) {
                    const bf16* kp = KTL + (32 * ks + 8 * fq + (fr >> 2)) * TPS + 16 * tj + 4 * (fr & 3);
                    const s16x4 k0 = __builtin_amdgcn_ds_read_tr16_b64_v4i16((__attribute__((address_space(3))) s16x4*)(kp));
                    const s16x4 k1 = __builtin_amdgcn_ds_read_tr16_b64_v4i16((__attribute__((address_space(3))) s16x4*)(kp + 4 * TPS));
                    bf16x8 kb; kb[0] = k0[0]; kb[1] = k0[1]; kb[2] = k0[2]; kb[3] = k0[3]; kb[4] = k1[0]; kb[5] = k1[1]; kb[6] = k1[2]; kb[7] = k1[3];
                    xacc = mfma16(qf[ks], kb, xacc); }
#pragma unroll
                for (int i = 0; i < 4; ++i) XS[(16 * ti + 4 * fq + i) * TPS + 16 * tj + fr] = (bf16)f2bf(xacc[i]); }
        }
        __syncthreads();
#pragma unroll
        for (int lt = 0; lt < 4; ++lt) {
            bf16x8 qf[8], sf[2], xf[2];
#pragma unroll
            for (int ks = 0; ks < 8; ++ks) qf[ks] = *(const bf16x8*)(QS + (16 * lt + fr) * QS_STRIDE + 32 * ks + 8 * fq);
#pragma unroll
            for (int k2 = 0; k2 < 2; ++k2) { sf[k2] = *(const bf16x8*)(SS + (16 * lt + fr) * SS_STRIDE + 32 * k2 + 8 * fq); xf[k2] = *(const bf16x8*)(XS + (16 * lt + fr) * TPS + 32 * k2 + 8 * fq); }
#pragma unroll
            for (int t = 0; t < 2; ++t) {
                f32x4 a1 = {0.f, 0.f, 0.f, 0.f}, a2 = {0.f, 0.f, 0.f, 0.f}, a3 = {0.f, 0.f, 0.f, 0.f}, a4 = {0.f, 0.f, 0.f, 0.f};
#pragma unroll
                for (int k2 = 0; k2 < 2; ++k2) { a1 = mfma16(sf[k2], vtB[t][k2], a1); a4 = mfma16(xf[k2], vtA[t][k2], a4); }
#pragma unroll
                for (int ks = 0; ks < 8; ks += 2) { a2 = mfma16(qf[ks], cb[t][ks], a2); a3 = mfma16(qf[ks + 1], cb[t][ks + 1], a3); }
#pragma unroll
                for (int i = 0; i < 4; ++i) NUMS[(16 * lt + 4 * fq + i) * QS_STRIDE + 32 * wave + 16 * t + fr] = (bf16)f2bf(a1[i] + WIL[16 * lt + 4 * fq + i] * (decA * (a2[i] + a3[i]) + a4[i]));
            }
        }
        if (wave == 0) {
            bf16x8 nb[8];
#pragma unroll
            for (int ks = 0; ks < 8; ++ks) { const f32x4 n0 = *(const f32x4*)(c.NS + (size_t)chA * 256 + 32 * ks + 8 * fq), n1 = *(const f32x4*)(c.NS + (size_t)chA * 256 + 32 * ks + 8 * fq + 4);
                u32x4 w; w.x = pk2(n0[0], n0[1]); w.y = pk2(n0[2], n0[3]); w.z = pk2(n1[0], n1[1]); w.w = pk2(n1[2], n1[3]);
                if (fr != 0) w = (u32x4){0u, 0u, 0u, 0u};
                nb[ks] = __builtin_bit_cast(bf16x8, w); }
#pragma unroll
            for (int lt = 0; lt < 4; ++lt) {
                f32x4 a1 = {0.f, 0.f, 0.f, 0.f}, a2 = {0.f, 0.f, 0.f, 0.f}, a4 = {0.f, 0.f, 0.f, 0.f};
#pragma unroll
                for (int k2 = 0; k2 < 2; ++k2) { const bf16x8 sf = *(const bf16x8*)(SS + (16 * lt + fr) * SS_STRIDE + 32 * k2 + 8 * fq); a1 = mfma16(sf, ones, a1);
                                                 const bf16x8 xf = *(const bf16x8*)(XS + (16 * lt + fr) * TPS + 32 * k2 + 8 * fq); a4 = mfma16(xf, ones, a4); }
#pragma unroll
                for (int ks = 0; ks < 8; ++ks) { const bf16x8 qf = *(const bf16x8*)(QS + (16 * lt + fr) * QS_STRIDE + 32 * ks + 8 * fq); a2 = mfma16(qf, nb[ks], a2); }
                if (fr == 0) {
#pragma unroll
                    for (int i = 0; i < 4; ++i) { const int l = 16 * lt + 4 * fq + i; const float den = a1[i] + WIL[l] * (decA * a2[i] + a4[i]); DENL[l] = 1.f / fmaxf(fabsf(den), c.gEF[h * MS + tB + l]); } }
            }
        }
        __syncthreads();
        scanb_tail(a, c, NUMS, DENL, h, tB);
        it = nit;
    }
    __syncthreads();
}

__device__ __forceinline__ void phase_post(const Args& a, unsigned char* lds, int vcu, int G, int pass) {
    scanb_run(a, lds, vcu, G, pass);
    const int tid = opaque_tid(), lane = tid & 63, wave = tid >> 6;
    unsigned char* ws = a.ws;
    const bf16* P = (const bf16*)(ws + WS_P);
    const bf16* AO = (const bf16*)(ws + WS_AO); const float* LSE = (const float*)(ws + WS_LSE); bf16* UA = (bf16*)(ws + WS_ACAT) + 1024;
    const int hh = lane >> 4, c = hh * 128 + 8 * (lane & 15);
    for (int r0 = 2 * (vcu * NWAVES + wave); r0 < MS; r0 += 2 * G * NWAVES) {
        u32x4 o0[2], o1[2], o2[2], zb[2]; float l0[2], l1[2], l2[2];
#pragma unroll
        for (int q = 0; q < 2; ++q) { const size_t r = (size_t)(r0 + q);
            o0[q] = *(const u32x4*)(AO + r * 512 + c); o1[q] = *(const u32x4*)(AO + ((size_t)MS + r) * 512 + c); o2[q] = *(const u32x4*)(AO + ((size_t)2 * MS + r) * 512 + c);
            zb[q] = *(const u32x4*)(P + r * INW + C_ZB + c);
            l0[q] = LSE[(size_t)hh * MS + r]; l1[q] = LSE[(size_t)(4 + hh) * MS + r]; l2[q] = LSE[(size_t)(8 + hh) * MS + r]; }
#pragma unroll
        for (int q = 0; q < 2; ++q) {
            const float mx = fmaxf(l0[q], fmaxf(l1[q], l2[q]));
            float w0 = __expf(l0[q] - mx), w1 = __expf(l1[q] - mx), w2 = __expf(l2[q] - mx); const float inv = 1.f / (w0 + w1 + w2); w0 *= inv; w1 *= inv; w2 *= inv;
            float f0[8], f1[8], f2[8], z[8], o[8]; unpack8(o0[q], f0); unpack8(o1[q], f1); unpack8(o2[q], f2); unpack8(zb[q], z);
#pragma unroll
            for (int e = 0; e < 8; ++e) o[e] = (w0 * f0[e] + w1 * f1[e] + w2 * f2[e]) * siluf_(z[e]);
            u32x4 ov; ov.x = pk2(o[0], o[1]); ov.y = pk2(o[2], o[3]); ov.z = pk2(o[4], o[5]); ov.w = pk2(o[6], o[7]);
            *(u32x4*)(UA + (size_t)(r0 + q) * 1536 + c) = ov;
        }
    }
}

__device__ __forceinline__ void phase_norm(const Args& a, int vcu, int G) {
    const int tid = opaque_tid(), lane = tid & 63, wave = tid >> 6;
    const float* rowss = (const float*)(a.ws + WS_CTL) + CW_ROWSS;
    const bf16* xn = (const bf16*)(a.ws + WS_H);
    for (int r0 = 2 * (vcu * NWAVES + wave); r0 < MALL; r0 += 2 * G * NWAVES) {
        u32x4 w[2][2]; float rinv[2];
#pragma unroll
        for (int q = 0; q < 2; ++q) { const u32x4* p = (const u32x4*)(xn + (size_t)(r0 + q) * DM) + lane; w[q][0] = p[0]; w[q][1] = p[64]; rinv[q] = 1.f / sqrtf(rowss[r0 + q] * (1.f / DM) + EPS); }
#pragma unroll
        for (int q = 0; q < 2; ++q)
#pragma unroll
            for (int hlf = 0; hlf < 2; ++hlf) { float f[8]; unpack8(w[q][hlf], f); const int c = 8 * lane + 512 * hlf;
                const f32x4 g0 = *(const f32x4*)(a.g_final + c), g1 = *(const f32x4*)(a.g_final + c + 4);
                float* op = a.out + (size_t)(r0 + q) * DM + c;
                *(f32x4*)op = (f32x4){f[0], f[1], f[2], f[3]} * rinv[q] * g0; *(f32x4*)(op + 4) = (f32x4){f[4], f[5], f[6], f[7]} * rinv[q] * g1; }
    }
}


#define LAS __attribute__((address_space(3)))
#define XB_TMO      128
#define XB_XCNT(j)  (256  + 64 * (j))
#define XB_XSUB(j)  (1280 + 64 * (j))
#define XB_XGEN(j)  (2304 + 64 * (j))
#define XB_TOP      3328
#define XB_TOPGEN   3392
#define XCD_BAR_WORDS 3456
#define XB_SPIN_CAP (1u << 22)
constexpr int CW_BAR = 4096;
__device__ __forceinline__ unsigned xb_ld(unsigned* p)              { return __hip_atomic_load(p, __ATOMIC_RELAXED, __HIP_MEMORY_SCOPE_AGENT); }
__device__ __forceinline__ unsigned xb_add(unsigned* p, unsigned v) { return __hip_atomic_fetch_add(p, v, __ATOMIC_RELAXED, __HIP_MEMORY_SCOPE_AGENT); }
__device__ __forceinline__ unsigned xb_xcc_id() { return (unsigned)__builtin_amdgcn_s_getreg((3 << 11) | 20) & 0xFu; }
#define XB_SPIN(cond, bar) do { unsigned _sp = 0; while (cond) { __builtin_amdgcn_s_sleep(1); \
    if ((++_sp & 255u) == 0u) { if (xb_ld(&(bar)[XB_TMO])) break; if (_sp > XB_SPIN_CAP) { atomicAdd(&(bar)[XB_TMO], 1u); break; } } } } while (0)
struct XcdBarrier { unsigned* bar; unsigned x; volatile LAS unsigned* st; };
__device__ __forceinline__ XcdBarrier xcd_barrier_post(unsigned* bar, volatile LAS unsigned* st) {
    XcdBarrier b; b.bar = bar; b.x = xb_xcc_id(); b.st = st;
    if (threadIdx.x == 0) (void)xb_add(&bar[XB_XCNT(b.x)], 1u);
    return b;
}
__device__ __forceinline__ void xcd_barrier_complete(unsigned* bar, unsigned x, unsigned& nloc, unsigned& nx) {
    const unsigned G = gridDim.x * gridDim.y * gridDim.z;
    unsigned sum, cnt, mine, sp = 0u;
    for (;;) {
        sum = 0u; cnt = 0u; mine = 0u;
#pragma unroll
        for (unsigned j = 0; j < 16; ++j) { const unsigned c = xb_ld(&bar[XB_XCNT(j)]); sum += c; cnt += (c > 0u) ? 1u : 0u; mine = (j == x) ? c : mine; }
        if (sum == G) break;
        __builtin_amdgcn_s_sleep(1);
        if ((++sp & 255u) == 0u) { if (xb_ld(&bar[XB_TMO])) break; if (sp > XB_SPIN_CAP) { atomicAdd(&bar[XB_TMO], 1u); break; } }
    }
    nloc = mine > 0u ? mine : 1u; nx = cnt > 0u ? cnt : 1u;
}
__device__ __forceinline__ void xcd_barrier(const XcdBarrier& b) {
    asm volatile("s_waitcnt vmcnt(0)" ::: "memory");
    __syncthreads();
    if (threadIdx.x == 0) {
        unsigned* bar = b.bar;
        __builtin_amdgcn_s_waitcnt(0);
        unsigned nloc = b.st[0], nx = b.st[1];
        if (nloc == 0u) { xcd_barrier_complete(bar, b.x, nloc, nx); b.st[0] = nloc; b.st[1] = nx; }
        const unsigned old = xb_add(&bar[XB_XSUB(b.x)], 1u);
        const unsigned gen = old / nloc;
        if (old + 1u == (gen + 1u) * nloc) {
            __builtin_amdgcn_fence(__ATOMIC_RELEASE, "agent");
            asm volatile("s_waitcnt vmcnt(0)" ::: "memory");
            const unsigned og = xb_add(&bar[XB_TOP], 1u);
            const unsigned tg = og / nx;
            if (og + 1u == (tg + 1u) * nx) xb_add(&bar[XB_TOPGEN], 1u);
            else XB_SPIN(xb_ld(&bar[XB_TOPGEN]) == tg, bar);
            __builtin_amdgcn_fence(__ATOMIC_ACQUIRE, "agent");
            xb_add(&bar[XB_XGEN(b.x)], 1u);
            asm volatile("s_waitcnt vmcnt(0)" ::: "memory");
        } else {
            XB_SPIN(xb_ld(&bar[XB_XGEN(b.x)]) == gen, bar);
            __builtin_amdgcn_fence(__ATOMIC_ACQUIRE, "agent");
            asm volatile("s_waitcnt vmcnt(0)" ::: "memory");
        }
    }
    __syncthreads();
}

constexpr int PH_PER_PASS = 7, PH_TOTAL = 2 + PH_PER_PASS * NPASS + 1;
#define PROBE_KIND_OF(k) ((k) == 0 ? K_INPROJ : (k) == 1 ? K_PREP : (k) == 2 ? K_CPREP : (k) == 3 ? K_MIX : (k) == 4 ? K_POST : (k) == 5 ? K_OUT1 : K_OUT2)
enum { K_PROLOGUE = 0, K_H = 1, K_INPROJ = 2, K_PREP = 3, K_QK = 4, K_MIX = 5, K_POST = 6, K_OUT1 = 7, K_OUT2 = 8, K_NORM = 9, K_CPREP = 10 };

__device__ __forceinline__ Args fresh_args() {
    Args a{};
#if defined(__HIP_DEVICE_COMPILE__)
    typedef const __attribute__((address_space(4))) unsigned long long* KP;
    KP q = (KP)__builtin_amdgcn_kernarg_segment_ptr(); asm volatile("" : "+s"(q));
    static_assert(sizeof(Args) == 22 * 8, "Args layout");
    unsigned long long w[22];
#pragma unroll
    for (int i = 0; i < 22; ++i) w[i] = q[i];
    __builtin_memcpy(&a, w, sizeof(Args));
#endif
    return a;
}
template <int KIND>
__device__ __forceinline__ void run_phase(const Args& args, unsigned char* lds, int pass, const XcdBarrier* pbar = nullptr) {
    const int G = gridDim.x; const int bx = blockIdx.x;
    const int vcu = (G % 8 == 0) ? (bx % 8) * (G / 8) + bx / 8 : bx;
    unsigned char* ws = args.ws;
    PG8_LAS unsigned char* lds3 = (PG8_LAS unsigned char*)lds;
    if constexpr (KIND == K_PROLOGUE) phase_prologue(args, lds, vcu, G);
    else if constexpr (KIND == K_H) phase_h(args, lds, vcu, G);
    else if constexpr (KIND == K_NORM) phase_norm(args, vcu, G);
    else if constexpr (KIND == K_INPROJ) {
        pg8::Gemm<1024, 1024, 1024> g{(const bf16*)(ws + WS_H) + (size_t)pass * MS * 1024, (const bf16*)(ws + WS_WIN)};
        pg8::StaticOrder S; S.init(MS, INW, G, bx);
        EpiProj E{(bf16*)(ws + WS_P), (const float*)(ws + WS_ROPE) + (size_t)pass * MS * 32};
        pg8::gemm_phase<EpiProj, pg8::StaticOrder, true, true>(lds3, g, S, E);
    } else if constexpr (KIND == K_PREP) phase_prep(args, lds, vcu, G, pass);
    else if constexpr (KIND == K_QK) {
        pg8::Gemm<1024, 256, 256, 512, 512 * 256 * 2> g{(const bf16*)(ws + WS_XC), (const bf16*)(ws + WS_WQK)};
        pg8::GroupOrder S; S.init(MS, G, bx);
        EpiQK E{(bf16*)(ws + WS_QM), (bf16*)(ws + WS_KM)};
        pg8::gemm_phase<EpiQK, pg8::GroupOrder, true, true>(lds3, g, S, E);
    } else if constexpr (KIND == K_CPREP) phase_cprep(args, lds, vcu, G);
    else if constexpr (KIND == K_MIX) phase_mix(args, lds, pass, pbar);
    else if constexpr (KIND == K_POST) phase_post(args, lds, vcu, G, pass);
    else if constexpr (KIND == K_OUT1) {
        pg8::Gemm<1536, 1536, 1536> g{(const bf16*)(ws + WS_ACAT), (const bf16*)(ws + WS_WOM)};
        pg8::StaticOrder S; S.init(MS, 1024, G, bx);
        EpiMerge E{(const bf16*)(ws + WS_P), (bf16*)(ws + WS_MG)};
        pg8::gemm_phase<EpiMerge, pg8::StaticOrder, true, true>(lds3, g, S, E);
    } else if constexpr (KIND == K_OUT2) {
        pg8::Gemm<1024, 1024, 1024> g{(const bf16*)(ws + WS_MG), (const bf16*)(ws + WS_WO)};
        pg8::StaticOrder S; S.init(MS, 1024, G, bx);
        EpiOut E{args.x, (bf16*)(ws + WS_H), (const float*)(ws + WS_MOD) + 2048, (float*)(ws + WS_CTL) + CW_ROWSS, pass * MS};
        pg8::gemm_phase<EpiOut, pg8::StaticOrder, true, true>(lds3, g, S, E);
    }
}

#if !MK_ONE_LAUNCH
template <int KIND>
__global__ void __launch_bounds__(NTHR, 2) k_phase(Args args) {
    extern __shared__ __attribute__((aligned(16))) unsigned char lds[];
    run_phase<KIND>(args, lds, args.ph_lo);
}
#else
__global__ void __launch_bounds__(NTHR, 2) mk_fwd(Args args) {
    extern __shared__ __attribute__((aligned(16))) unsigned char lds[];
    volatile LAS unsigned* misc = (volatile LAS unsigned*)((LAS unsigned char*)lds + 131072 + 2048);
    if (threadIdx.x < 16) misc[threadIdx.x] = 0u;
    __syncthreads();
    XcdBarrier bar = xcd_barrier_post((unsigned*)(args.ws + WS_CTL) + CW_BAR, misc + 8);
#ifdef PROBE_TMASK
    unsigned long long pr_acc = 0ull;
#endif
    for (int gp = args.ph_lo; gp < args.ph_hi; ++gp) {
#ifdef PROBE_TMASK
        const unsigned long long pr_t0 = __builtin_amdgcn_s_memrealtime();
        int pr_kind;
        if (gp == 0) pr_kind = K_PROLOGUE; else if (gp == 1) pr_kind = K_H; else if (gp == PH_TOTAL - 1) pr_kind = K_NORM;
        else { const int k = (gp - 2) % PH_PER_PASS; pr_kind = PROBE_KIND_OF(k); }
#endif
        if (gp == 0) run_phase<K_PROLOGUE>(args, lds, 0);
        else if (gp == 1) run_phase<K_H>(args, lds, 0);
        else if (gp == PH_TOTAL - 1) run_phase<K_NORM>(args, lds, 0);
        else {
            const int pass = (gp - 2) / PH_PER_PASS, k = (gp - 2) % PH_PER_PASS;
            if (k == 0) run_phase<K_INPROJ>(args, lds, pass);
            else if (k == 1) run_phase<K_PREP>(args, lds, pass);
            else if (k == 2) run_phase<K_CPREP>(args, lds, pass);
            else if (k == 3) run_phase<K_MIX>(args, lds, pass, &bar);
            else if (k == 4) run_phase<K_POST>(args, lds, pass);
            else if (k == 5) run_phase<K_OUT1>(args, lds, pass);
            else run_phase<K_OUT2>(args, lds, pass);
        }
#ifdef PROBE_TMASK
        const unsigned long long pr_tb = __builtin_amdgcn_s_memrealtime();
#endif
        if (gp + 1 < args.ph_hi) xcd_barrier(bar);
#ifdef PROBE_TMASK
        else __syncthreads();
        if ((PROBE_TMASK >> 11) & 1) pr_acc += __builtin_amdgcn_s_memrealtime() - pr_tb;
        if ((PROBE_TMASK >> pr_kind) & 1) pr_acc += __builtin_amdgcn_s_memrealtime() - pr_t0;
#endif
    }
#ifdef PROBE_TMASK
    if (blockIdx.x == 0) { const unsigned long long t1 = __builtin_amdgcn_s_memrealtime(); while (__builtin_amdgcn_s_memrealtime() - t1 < 4ull * pr_acc) __builtin_amdgcn_s_sleep(8); }
#endif
}
#endif

extern "C" void kernel_launch(void* const* d_in, const int* in_sizes, int n_in, void* d_out, int out_size, void* d_ws, size_t ws_size, hipStream_t stream) {
    static int grid = 0;
    if (grid == 0) {
        if (n_in != 19 || in_sizes[0] != MALL * DM || out_size != MALL * DM || ws_size < WS_END) { fprintf(stderr, "kernel_launch: unexpected shapes (n_in %d, ws %zu)\n", n_in, ws_size); grid = -1; return; }
        int dev = 0, cus = 0, per_cu = 0;
        (void)hipGetDevice(&dev); (void)hipDeviceGetAttribute(&cus, hipDeviceAttributeMultiprocessorCount, dev);
#if MK_ONE_LAUNCH
        (void)hipFuncSetAttribute((const void*)mk_fwd, hipFuncAttributeMaxDynamicSharedMemorySize, LDS_BYTES);
        (void)hipOccupancyMaxActiveBlocksPerMultiprocessor(&per_cu, (const void*)mk_fwd, NTHR, LDS_BYTES);
        if (per_cu < 1) { fprintf(stderr, "kernel_launch: occupancy query says %d\n", per_cu); per_cu = 1; }
#else
#define SETATTR(KIND) (void)hipFuncSetAttribute((const void*)k_phase<KIND>, hipFuncAttributeMaxDynamicSharedMemorySize, LDS_BYTES)
        SETATTR(K_PROLOGUE); SETATTR(K_H); SETATTR(K_INPROJ); SETATTR(K_PREP); SETATTR(K_QK); SETATTR(K_MIX); SETATTR(K_POST); SETATTR(K_OUT1); SETATTR(K_OUT2); SETATTR(K_NORM); SETATTR(K_CPREP);
        (void)per_cu;
#endif
        (void)hipGetLastError();
        grid = cus;
    }
    if (grid < 0) return;
    (void)hipMemsetAsync((char*)d_ws + WS_CTL, 0, CTL_ZERO_BYTES, stream);
    Args a{};
    a.x = (const float*)d_in[0]; a.c = (const float*)d_in[1]; a.pos = (const int*)d_in[2]; a.w_ada = (const float*)d_in[3]; a.b_ada = (const float*)d_in[4];
    a.g_norm = (const float*)d_in[5]; a.w_in = (const float*)d_in[6]; a.b_ig = (const float*)d_in[7]; a.b_fg = (const float*)d_in[8]; a.w_conv = (const float*)d_in[9];
    a.b_conv = (const float*)d_in[10]; a.w_q = (const float*)d_in[11]; a.w_k = (const float*)d_in[12]; a.g_head = (const float*)d_in[13]; a.skip = (const float*)d_in[14];
    a.w_om = (const float*)d_in[15]; a.w_oa = (const float*)d_in[16]; a.w_o = (const float*)d_in[17]; a.g_final = (const float*)d_in[18];
    a.out = (float*)d_out; a.ws = (unsigned char*)d_ws;
#if MK_ONE_LAUNCH
    a.ph_lo = 0; a.ph_hi = PH_TOTAL;
    void* params[] = {&a};
    hipError_t e = hipLaunchCooperativeKernel((const void*)mk_fwd, dim3(grid), dim3(NTHR), params, LDS_BYTES, stream);
    if (e != hipSuccess) fprintf(stderr, "cooperative launch failed: %s\n", hipGetErrorString(e));
#else
#define LAUNCH(KIND, PASS) do { a.ph_lo = (PASS); a.ph_hi = 0; hipLaunchKernelGGL(k_phase<KIND>, dim3(grid), dim3(NTHR), LDS_BYTES, stream, a); } while (0)
    LAUNCH(K_PROLOGUE, 0); LAUNCH(K_H, 0);
    for (int p = 0; p < NPASS; ++p) { LAUNCH(K_INPROJ, p); LAUNCH(K_PREP, p); LAUNCH(K_CPREP, p); LAUNCH(K_MIX, p); LAUNCH(K_POST, p); LAUNCH(K_OUT1, p); LAUNCH(K_OUT2, p); }
    LAUNCH(K_NORM, 0);
#endif
}
```

```cpp
#include <hip/hip_runtime.h>
#include <hip/hip_cooperative_groups.h>
#include <cstdio>
#include <cstdint>
namespace cg = cooperative_groups;

#ifndef MK_ONE_LAUNCH
#define MK_ONE_LAUNCH 1
#endif

__device__ __forceinline__ int opaque_tid() { int t = threadIdx.x; asm volatile("" : "+v"(t)); return t; }
namespace pg8 {
#define PG8_LAS __attribute__((address_space(3)))
typedef unsigned short bf16_t;
typedef short bf16x8 __attribute__((ext_vector_type(8)));
typedef float f32x4 __attribute__((ext_vector_type(4)));
typedef unsigned u32x4 __attribute__((ext_vector_type(4)));
constexpr int BM = 256, BK = 64, HALF = 128, HTB = HALF * BK * 2, STAGE_BYTES = 8 * HTB, NXCD = 8, WGM = 8;

__host__ __device__ __forceinline__ int lds_byte(int r, int c) { const int st = (r >> 4) * 2 + (c >> 5), rr = r & 15, cc = c & 31, ob = rr * 64 + cc * 2; return st * 1024 + (ob ^ (((ob >> 9) & 1) << 5)); }
__host__ __device__ __forceinline__ void stage_rc(int b, int& R, int& C) { const int st = b / 1024, sb = b % 1024, swz = sb ^ (((sb >> 9) & 1) << 5); R = (st >> 1) * 16 + swz / 64; C = (st & 1) * 32 + (swz % 64) / 2; }
__host__ __device__ __forceinline__ int perm32(int rho) { const int n = rho >> 4, i = rho & 15; return 8 * (i >> 2) + 4 * n + (i & 3); }

struct Unit { int pm, pn, g; };
template <int LDA, int LDB, int KK, int AGS = 0, int BGS = 0> struct Gemm {
    const bf16_t* A; const bf16_t* Bt;
    static constexpr int lda = LDA, ldb = LDB, K = KK;
    __device__ __forceinline__ const char* abase(const Unit& u) const { return (const char*)A + (size_t)(u.g * AGS) + (size_t)u.pm * (size_t)(BM * 2 * LDA); }
    __device__ __forceinline__ const char* bbase(const Unit& u) const { return (const char*)Bt + (size_t)(u.g * BGS) + (size_t)u.pn * (size_t)(BM * 2 * LDB); }
};

struct StaticOrder {
    int nM, nN, nwg, G, c;
    __host__ __device__ void init(int M, int N, int G_, int c_) { nM = M / BM; nN = N / BM; nwg = nM * nN; G = G_; c = c_; }
    __host__ __device__ bool next(int i, Unit& u) const {
        const long L = (long)i * G + c; if (L >= nwg) return false;
        int wgid = (int)L; { const int q = nwg / NXCD, r = nwg % NXCD, xcd = wgid % NXCD, off = wgid / NXCD; wgid = (xcd < r ? xcd * (q + 1) : r * (q + 1) + (xcd - r) * q) + off; }
        const int nig = WGM * nN, gid = wgid / nig, fm = gid * WGM, gsz = (nM - fm) < WGM ? (nM - fm) : WGM;
        u.pm = fm + ((wgid % nig) % gsz); u.pn = (wgid % nig) / gsz; u.g = 0; return true;
    }
    __device__ __forceinline__ void a_ready(const Unit&) const {}
    __device__ __forceinline__ void done(const Unit&) const {}
};
struct GroupOrder {
    int nunits, G, c;
    __host__ __device__ void init(int M, int G_, int c_) { nunits = (M / BM) * 8; G = G_; c = c_; }
    __host__ __device__ bool next(int i, Unit& u) const {
        const long L = (long)i * G + c; if (L >= nunits) return false;
        u.pm = (int)(L >> 3); u.g = (int)((L & 7) >> 1); u.pn = (int)(L & 1); return true;
    }
    __device__ __forceinline__ void a_ready(const Unit&) const {}
    __device__ __forceinline__ void done(const Unit&) const {}
};

__device__ __forceinline__ unsigned cvt_pk_bf16(float lo, float hi) { unsigned r; asm volatile("v_cvt_pk_bf16_f32 %0, %1, %2" : "=v"(r) : "v"(lo), "v"(hi)); return r; }

template <class Epi, class Sched, bool ALIGN_EPI, bool SP2, class GemmT>
__device__ __forceinline__ void gemm_phase(PG8_LAS unsigned char* lds, const GemmT g, const Sched& S, const Epi& E) {
    const int tid = opaque_tid(), wid = __builtin_amdgcn_readfirstlane(tid >> 6), lane = tid & 63, wr = wid >> 2, wc = wid & 3, fr = lane & 15, fq = lane >> 4;
    constexpr int K = GemmT::K, nt = K / BK;
    unsigned voffA[2], voffB[2];
#pragma unroll
    for (int i = 0; i < 2; ++i) { int R, C; stage_rc(tid * 16 + i * 8192, R, C); const int Rb = Epi::PERM ? (64 * (R >> 5) + perm32(R & 31)) : R;
        voffA[i] = (unsigned)(R * g.lda + C) * 2u; voffB[i] = (unsigned)(Rb * g.ldb + C) * 2u; }
    const size_t kstep = (size_t)(BK * 2);
    const size_t hstepA = (size_t)HALF * g.lda * 2, hstepB = (size_t)(Epi::PERM ? 32 : HALF) * g.ldb * 2;
    const unsigned ldsw = (unsigned)wid * 1024u;
    const int aoff = lds_byte(wr * 64 + fr, fq * 8), boff = lds_byte(wc * 32 + fr, fq * 8);
#define PG8_SA(b, h) (((b) * 2 + (h)) * HTB)
#define PG8_SB(b, h) ((4 + (b) * 2 + (h)) * HTB)
#define PG8_STAGE(bufoff, gbase, voff) do { _Pragma("unroll") for (int _i = 0; _i < 2; ++_i) \
        __builtin_amdgcn_global_load_lds((const unsigned*)((const char*)(gbase) + (voff)[_i]), (PG8_LAS unsigned*)(lds + (bufoff) + ldsw + _i * 8192), 16, 0, 0); } while (0)
#define PG8_LDA(dst, b, h) do { _Pragma("unroll") for (int m = 0; m < 4; ++m) _Pragma("unroll") for (int k = 0; k < 2; ++k) dst[m][k] = *(const PG8_LAS bf16x8*)(lds + PG8_SA(b, h) + aoff + m * 2048 + k * 1024); } while (0)
#define PG8_LDB(dst, b, h) do { _Pragma("unroll") for (int n = 0; n < 2; ++n) _Pragma("unroll") for (int k = 0; k < 2; ++k) dst[n][k] = *(const PG8_LAS bf16x8*)(lds + PG8_SB(b, h) + boff + n * 2048 + k * 1024); } while (0)
#define PG8_MMA(ai, bj, At, Bt) do { __builtin_amdgcn_s_setprio(1); _Pragma("unroll") for (int m = 0; m < 4; ++m) _Pragma("unroll") for (int n = 0; n < 2; ++n) _Pragma("unroll") for (int k = 0; k < 2; ++k) \
        acc[ai][bj][m][n] = __builtin_amdgcn_mfma_f32_16x16x32_bf16(Bt[n][k], At[m][k], acc[ai][bj][m][n], 0, 0, 0); __builtin_amdgcn_s_setprio(0); } while (0)
#define PG8_WAIT_V(n) asm volatile("s_waitcnt vmcnt(" #n ")" ::: "memory")
#define PG8_WAIT_L(n) asm volatile("s_waitcnt lgkmcnt(" #n ")" ::: "memory")
#define PG8_BAR __builtin_amdgcn_s_barrier()
#define PG8_SCHED __builtin_amdgcn_sched_barrier(0)
    Unit cur, nxt; int ui = 0;
    if (!S.next(0, cur)) return;
    f32x4 acc[2][2][4][2];
#pragma unroll
    for (int a = 0; a < 2; ++a)
#pragma unroll
        for (int b = 0; b < 2; ++b)
#pragma unroll
            for (int m = 0; m < 4; ++m)
#pragma unroll
                for (int n = 0; n < 2; ++n) acc[a][b][m][n] = (f32x4){0.f, 0.f, 0.f, 0.f};
    bf16x8 At[4][2], B0[2][2], B1[2][2];
    const char* cA = g.abase(cur); const char* cB = g.bbase(cur);
    S.a_ready(cur);
    if constexpr (SP2) {
        PG8_STAGE(PG8_SB(0, 0), cB, voffB); PG8_STAGE(PG8_SB(0, 1), cB + hstepB, voffB); PG8_STAGE(PG8_SA(0, 0), cA, voffA); PG8_STAGE(PG8_SA(0, 1), cA + hstepA, voffA);
        if (wr == 1) PG8_BAR;
        PG8_WAIT_V(2); PG8_BAR;
        PG8_STAGE(PG8_SB(1, 0), cB + kstep, voffB); PG8_STAGE(PG8_SA(1, 0), cA + kstep, voffA); PG8_STAGE(PG8_SB(1, 1), cB + hstepB + kstep, voffB);
        PG8_WAIT_V(6); PG8_BAR;
    } else {
        PG8_STAGE(PG8_SB(0, 0), cB, voffB); PG8_STAGE(PG8_SA(0, 0), cA, voffA); PG8_STAGE(PG8_SB(0, 1), cB + hstepB, voffB); PG8_STAGE(PG8_SA(0, 1), cA + hstepA, voffA);
        if (wr == 1) PG8_BAR;
        PG8_WAIT_V(4); PG8_BAR;
        PG8_STAGE(PG8_SB(1, 0), cB + kstep, voffB); PG8_STAGE(PG8_SA(1, 0), cA + kstep, voffA); PG8_STAGE(PG8_SB(1, 1), cB + hstepB + kstep, voffB);
        PG8_WAIT_V(6); PG8_BAR;
    }
    for (;;) {
        const bool has_next = S.next(ui + 1, nxt);
        const char* nA = has_next ? g.abase(nxt) : cA; const char* nB = has_next ? g.bbase(nxt) : cB;
#pragma nounroll
        for (int t = 0; t < nt; t += 2) {
            const bool last = (t == nt - 2);
            const char* a1 = cA + (size_t)(t + 1) * kstep;
            const char* a2 = last ? nA : cA + (size_t)(t + 2) * kstep; const char* b2 = last ? nB : cB + (size_t)(t + 2) * kstep;
            const char* a3 = a2 + kstep; const char* b3 = b2 + kstep;
            if (last && has_next) S.a_ready(nxt);
            if constexpr (Epi::HOOK_T >= 0) { if (t == Epi::HOOK_T) E.hook(acc, cur, wr, wc, fr, fq); }
            if constexpr (SP2) {
            PG8_LDB(B0, 0, 0); PG8_LDB(B1, 0, 1); PG8_SCHED; PG8_LDA(At, 0, 0); PG8_STAGE(PG8_SA(1, 1), a1 + hstepA, voffA);
            PG8_WAIT_V(8); PG8_WAIT_L(0); PG8_BAR; PG8_MMA(0, 0, At, B0); PG8_MMA(0, 1, At, B1); PG8_BAR; PG8_SCHED;
            PG8_LDA(At, 0, 1); PG8_STAGE(PG8_SB(0, 0), b2, voffB); PG8_STAGE(PG8_SB(0, 1), b2 + hstepB, voffB); PG8_STAGE(PG8_SA(0, 0), a2, voffA);
            PG8_WAIT_V(8); PG8_WAIT_L(0); PG8_BAR; PG8_MMA(1, 0, At, B0); PG8_MMA(1, 1, At, B1); PG8_BAR; PG8_SCHED;
            PG8_LDB(B0, 1, 0); PG8_LDB(B1, 1, 1); PG8_SCHED; PG8_LDA(At, 1, 0); PG8_STAGE(PG8_SA(0, 1), a2 + hstepA, voffA);
            PG8_WAIT_V(8); PG8_WAIT_L(0); PG8_BAR; PG8_MMA(0, 0, At, B0); PG8_MMA(0, 1, At, B1); PG8_BAR; PG8_SCHED;
            PG8_LDA(At, 1, 1); PG8_STAGE(PG8_SB(1, 0), b3, voffB); PG8_STAGE(PG8_SB(1, 1), b3 + hstepB, voffB); PG8_STAGE(PG8_SA(1, 0), a3, voffA);
            PG8_WAIT_V(8); PG8_WAIT_L(0); PG8_BAR; PG8_MMA(1, 0, At, B0); PG8_MMA(1, 1, At, B1); PG8_BAR; PG8_SCHED;
            } else {
            PG8_LDB(B0, 0, 0); PG8_SCHED; PG8_LDA(At, 0, 0); PG8_STAGE(PG8_SA(1, 1), a1 + hstepA, voffA);
            PG8_WAIT_L(8); PG8_BAR; PG8_WAIT_L(0); PG8_MMA(0, 0, At, B0); PG8_BAR; PG8_SCHED;
            PG8_LDB(B1, 0, 1); PG8_STAGE(PG8_SB(0, 0), b2, voffB);
            PG8_BAR; PG8_WAIT_L(0); PG8_MMA(0, 1, At, B1); PG8_BAR;
            PG8_LDA(At, 0, 1); PG8_STAGE(PG8_SA(0, 0), a2, voffA);
            PG8_BAR; PG8_WAIT_L(0); PG8_MMA(1, 0, At, B0); PG8_BAR; PG8_SCHED;
            PG8_STAGE(PG8_SB(0, 1), b2 + hstepB, voffB);
            PG8_WAIT_V(6); PG8_BAR; PG8_MMA(1, 1, At, B1); PG8_BAR;
            PG8_LDB(B0, 1, 0); PG8_SCHED; PG8_LDA(At, 1, 0); PG8_STAGE(PG8_SA(0, 1), a2 + hstepA, voffA);
            PG8_WAIT_L(8); PG8_BAR; PG8_WAIT_L(0); PG8_MMA(0, 0, At, B0); PG8_BAR; PG8_SCHED;
            PG8_LDB(B1, 1, 1); PG8_STAGE(PG8_SB(1, 0), b3, voffB);
            PG8_BAR; PG8_WAIT_L(0); PG8_MMA(0, 1, At, B1); PG8_BAR;
            PG8_LDA(At, 1, 1); PG8_STAGE(PG8_SA(1, 0), a3, voffA);
            PG8_BAR; PG8_WAIT_L(0); PG8_MMA(1, 0, At, B0); PG8_BAR; PG8_SCHED;
            PG8_STAGE(PG8_SB(1, 1), b3 + hstepB, voffB);
            PG8_WAIT_V(6); PG8_BAR; PG8_MMA(1, 1, At, B1); PG8_BAR;
            }
        }
        if constexpr (ALIGN_EPI) { if (wr == 0) PG8_BAR; }
        E(acc, cur, wr, wc, fr, fq); S.done(cur);
        if (!has_next) break;
#pragma unroll
        for (int a = 0; a < 2; ++a)
#pragma unroll
            for (int b = 0; b < 2; ++b)
#pragma unroll
                for (int m = 0; m < 4; ++m)
#pragma unroll
                    for (int n = 0; n < 2; ++n) acc[a][b][m][n] = (f32x4){0.f, 0.f, 0.f, 0.f};
        cur = nxt; cA = nA; cB = nB; ++ui;
        if constexpr (ALIGN_EPI) { if (wr == 1) PG8_BAR; }
    }
    PG8_WAIT_V(0);
    if constexpr (!ALIGN_EPI) { if (wr == 0) PG8_BAR; }
    PG8_BAR;
#undef PG8_SA
#undef PG8_SB
#undef PG8_STAGE
#undef PG8_LDA
#undef PG8_LDB
#undef PG8_MMA
#undef PG8_WAIT_V
#undef PG8_WAIT_L
#undef PG8_BAR
#undef PG8_SCHED
}
}

constexpr int NWAVES = 8, NTHR = 512;
constexpr int DM = 1024, NBATCH = 16, SEQ = 4096, MALL = NBATCH * SEQ;
constexpr int NB_PASS = 4, MS = NB_PASS * SEQ, NPASS = NBATCH / NB_PASS;
constexpr int INW_SRC = 11272, INW = 11264;
constexpr int C_XA = 0, C_VA = 1024, C_OA = 2048, C_ZA = 3072, C_QA = 4096, C_KA = 5632, C_VT = 7168, C_ZB = 8704, C_GA = 9216, C_GB = 10240;
constexpr float EPS = 1e-6f;

constexpr size_t MiB = 1u << 20;
constexpr size_t WS_CTL = 0, CTL_ZERO_BYTES = 1 * MiB;
constexpr size_t WS_MOD = 1 * MiB;
constexpr size_t WS_WG = 1 * MiB + 256 * 1024;
constexpr size_t WS_WIN = 2 * MiB;
constexpr size_t WS_WQK = 24 * MiB;
constexpr size_t WS_WOM = 25 * MiB, WS_WOA = 27 * MiB, WS_WO = 28 * MiB;
constexpr size_t WS_IG = 30 * MiB, WS_FG = 31 * MiB;
constexpr size_t WS_GSC = 32 * MiB;
constexpr size_t WS_LSE = 34 * MiB;
constexpr size_t WS_DEN = 35 * MiB;
constexpr size_t WS_H = 36 * MiB;
constexpr size_t WS_P = 164 * MiB;
constexpr size_t WS_XC = 516 * MiB;
constexpr size_t WS_QM = 548 * MiB, WS_KM = 580 * MiB;
constexpr size_t WS_HR = 612 * MiB;
constexpr size_t WS_AO = 644 * MiB;
constexpr size_t WS_UA = 692 * MiB;
constexpr size_t WS_ACAT = 708 * MiB;
constexpr size_t WS_MG = 772 * MiB;
constexpr size_t WS_SG = 804 * MiB;
constexpr size_t WS_KTG = 812 * MiB;
constexpr size_t WS_VTG = 844 * MiB;
constexpr size_t WS_CS = 876 * MiB;
constexpr size_t WS_NS = 1004 * MiB;
constexpr size_t WS_ROPE = 1005 * MiB;
constexpr size_t WS_END = 1013 * MiB;
constexpr int CW_QCTR = 1024;
constexpr int CW_ROWSS = 65536;
static_assert((CW_ROWSS + MALL) * 4 <= (int)CTL_ZERO_BYTES, "ctl");

constexpr int LDS_BYTES = 147456;

typedef unsigned short bf16;
typedef float f32x4 __attribute__((ext_vector_type(4)));
typedef float f32x2 __attribute__((ext_vector_type(2)));
typedef short bf16x8 __attribute__((ext_vector_type(8)));
typedef unsigned u32x4 __attribute__((ext_vector_type(4)));
typedef unsigned u32x2 __attribute__((ext_vector_type(2)));
typedef short s16x4 __attribute__((ext_vector_type(4)));

__device__ __forceinline__ unsigned f2bf(float f) { unsigned u = __builtin_bit_cast(unsigned, f); return (u + 0x7fffu + ((u >> 16) & 1u)) >> 16; }
__device__ __forceinline__ unsigned pk2(float lo, float hi) { return f2bf(lo) | (f2bf(hi) << 16); }
__device__ __forceinline__ float bflo(unsigned w) { return __builtin_bit_cast(float, w << 16); }
__device__ __forceinline__ float bfhi(unsigned w) { return __builtin_bit_cast(float, w & 0xffff0000u); }
__device__ __forceinline__ float bf1(bf16 v) { return __builtin_bit_cast(float, (unsigned)v << 16); }
__device__ __forceinline__ float sigmoidf_(float x) { return 1.f / (1.f + __expf(-x)); }
__device__ __forceinline__ float siluf_(float x) { return x / (1.f + __expf(-x)); }
__device__ __forceinline__ float wave_sum(float v) {
#pragma unroll
    for (int o = 1; o < 64; o <<= 1) v += __shfl_xor(v, o);
    return v;
}
__device__ __forceinline__ void unpack8(const u32x4 w, float* f) {
    f[0] = bflo(w.x); f[1] = bfhi(w.x); f[2] = bflo(w.y); f[3] = bfhi(w.y); f[4] = bflo(w.z); f[5] = bfhi(w.z); f[6] = bflo(w.w); f[7] = bfhi(w.w);
}

struct Args {
    const float* x; const float* c; const int* pos; const float* w_ada; const float* b_ada; const float* g_norm; const float* w_in;
    const float* b_ig; const float* b_fg; const float* w_conv; const float* b_conv; const float* w_q; const float* w_k; const float* g_head;
    const float* skip; const float* w_om; const float* w_oa; const float* w_o; const float* g_final;
    float* out; unsigned char* ws; int ph_lo, ph_hi;
};

__device__ __forceinline__ void transpose_item(const float* W, int K, int Nsrc, int nblk, int src_col_off, bf16* WT, int ldt, int row_off, float scale, float* scr, int item, int lane, bool frag = false) {
    const int kb = item / nblk, nb = item % nblk, k0 = 64 * kb, n0 = 32 * nb;
#pragma unroll 8
    for (int i = 0; i < 32; ++i) { const int kk = 2 * i + (lane >> 5); scr[kk * 33 + (lane & 31)] = W[(size_t)(k0 + kk) * Nsrc + src_col_off + n0 + (lane & 31)]; }
    __builtin_amdgcn_wave_barrier();
    asm volatile("s_waitcnt lgkmcnt(0)" ::: "memory");
    const int cc = lane & 7;
#pragma unroll
    for (int j = 0; j < 4; ++j) { const int n = (lane >> 3) + 8 * j; const float* s = scr + (8 * cc) * 33 + n;
        u32x4 o; o.x = pk2(s[0 * 33] * scale, s[1 * 33] * scale); o.y = pk2(s[2 * 33] * scale, s[3 * 33] * scale); o.z = pk2(s[4 * 33] * scale, s[5 * 33] * scale); o.w = pk2(s[6 * 33] * scale, s[7 * 33] * scale);
        if (frag) { const int nn = row_off + n0 + n, kc = (k0 >> 3) + cc; *(u32x4*)(WT + (size_t)((((nn >> 4) * (K >> 5) + (kc >> 2)) * 64 + (kc & 3) * 16 + (nn & 15)) * 8)) = o; }
        else *(u32x4*)(WT + (size_t)(row_off + n0 + n) * ldt + k0 + 8 * cc) = o; }
    asm volatile("s_waitcnt lgkmcnt(0)" ::: "memory");
    __builtin_amdgcn_wave_barrier();
}

__device__ __forceinline__ void phase_prologue(const Args& a, unsigned char* lds, int vcu, int G) {
    const int tid = opaque_tid(), lane = tid & 63, wave = tid >> 6;
    unsigned char* ws = a.ws;
    if (vcu < 192) {
        float* sc = (float*)lds;
        float* red = (float*)(lds + 65536);
        for (int i = tid; i < 16 * 1024; i += NTHR) sc[i] = siluf_(a.c[i]);
        __syncthreads();
        const int col = lane & 15, ksub = lane >> 4, n = vcu * 16 + col;
        float acc[16];
#pragma unroll
        for (int b = 0; b < 16; ++b) acc[b] = 0.f;
        const int k0 = wave * 128 + ksub * 32;
        const float* wp = a.w_ada + (size_t)k0 * 3072 + n;
#pragma unroll 1
        for (int kc = 0; kc < 8; ++kc) {
            const float w0 = wp[(size_t)(4 * kc) * 3072], w1 = wp[(size_t)(4 * kc + 1) * 3072], w2 = wp[(size_t)(4 * kc + 2) * 3072], w3 = wp[(size_t)(4 * kc + 3) * 3072];
#pragma unroll
            for (int b = 0; b < 16; ++b) { const f32x4 s4 = *(const f32x4*)(sc + b * 1024 + k0 + 4 * kc); acc[b] += (s4.x * w0 + s4.y * w1) + (s4.z * w2 + s4.w * w3); }
        }
#pragma unroll
        for (int b = 0; b < 16; ++b) { float v = acc[b]; v += __shfl_xor(v, 16); v += __shfl_xor(v, 32); if (ksub == 0) red[(wave * 16 + b) * 16 + col] = v; }
        __syncthreads();
        float* mod = (float*)(ws + WS_MOD);
        if (tid < 256) { const int b = tid >> 4, l = tid & 15, nn = vcu * 16 + l; float s_ = 0.f;
#pragma unroll
            for (int w = 0; w < 8; ++w) s_ += red[(w * 16 + b) * 16 + l];
            s_ += a.b_ada[nn];
            const int part = nn >> 10, cc = nn & 1023;
            if (part == 1) s_ = a.g_norm[cc] * (1.f + s_);
            mod[b * 3072 + nn] = s_; }
        __syncthreads();
    }
    {
        float* scr = (float*)lds + wave * (64 * 33);
        const int gw = vcu * NWAVES + wave, NGW = G * NWAVES;
        constexpr int I_IN = (1024 / 64) * (INW / 32);
        constexpr int I_QK = 8 * (256 / 64) * (256 / 32);
        constexpr int I_OM = 16 * 32, I_OA = 8 * 32, I_O = 16 * 32;
        constexpr int NITEMS = I_IN + I_QK + I_OM + I_OA + I_O;
        for (int it = gw; it < NITEMS; it += NGW) {
            int r = it;
            if (r < I_IN) { const int nb = r % (INW / 32); const int off = (nb * 32 >= 4096) ? 8 : 0;
                transpose_item(a.w_in, 1024, INW_SRC, INW / 32, off, (bf16*)(ws + WS_WIN), 1024, 0, 1.f, scr, r, lane); continue; } r -= I_IN;
            if (r < I_QK) { const int mtx = r >> 5, rr = r & 31, h = mtx >> 1, isk = mtx & 1;
                const float* W = (isk ? a.w_k : a.w_q) + (size_t)h * 65536;
                transpose_item(W, 256, 256, 8, 0, (bf16*)(ws + WS_WQK) + (size_t)h * 512 * 256, 256, isk * 256, isk ? 0.0625f : 1.f, scr, rr, lane, true); continue; } r -= I_QK;
            if (r < I_OM) { transpose_item(a.w_om, 1024, 1024, 32, 0, (bf16*)(ws + WS_WOM), 1536, 0, 1.f, scr, r, lane); continue; } r -= I_OM;
            if (r < I_OA) { transpose_item(a.w_oa, 512, 1024, 32, 0, (bf16*)(ws + WS_WOM) + 1024, 1536, 0, 1.f, scr, r, lane); continue; } r -= I_OA;
            transpose_item(a.w_o, 1024, 1024, 32, 0, (bf16*)(ws + WS_WO), 1024, 0, 1.f, scr, r, lane);
        }
        float* wg = (float*)(ws + WS_WG);
        for (int i = (vcu * NTHR + tid); i < 8 * 1024; i += G * NTHR) { const int j = i >> 10, k = i & 1023; wg[i] = a.w_in[(size_t)k * INW_SRC + 4096 + j]; }
    }
}

__constant__ double c_inv_freq[16] = {1.0, 0.44036660267178046, 0.19392274474868576, 0.08539710028576561, 0.03760603093086393, 0.016560440080994446, 0.007292664737217109, 0.003211445994752591,
    0.001414213562373095, 0.000622772421914596, 0.0002742481756762073, 0.00012076973741146504, 5.318295896944988e-05, 2.341999896140934e-05, 1.031338537721246e-05, 4.5416704806078695e-06};

__device__ __forceinline__ void phase_h(const Args& a, unsigned char* lds, int vcu, int G) {
    const int tid = opaque_tid(), lane = tid & 63, wave = tid >> 6;
    unsigned char* ws = a.ws;
    float* wg = (float*)lds;
    { const float* src = (const float*)(ws + WS_WG); for (int i = tid; i < 8192; i += NTHR) wg[i] = src[i]; }
    __syncthreads();
    const float* mod = (const float*)(ws + WS_MOD);
    bf16* H = (bf16*)(ws + WS_H);
    float* IG = (float*)(ws + WS_IG); float* FG = (float*)(ws + WS_FG); float* ROPE = (float*)(ws + WS_ROPE);
    const int gw = vcu * NWAVES + wave, NGW = G * NWAVES;
    for (int row0 = 2 * gw; row0 < MALL; row0 += 2 * NGW) {
        f32x4 v[2][4]; float ss[2] = {0.f, 0.f};
#pragma unroll
        for (int rr = 0; rr < 2; ++rr) { const f32x4* xr = (const f32x4*)(a.x + (size_t)(row0 + rr) * DM) + lane;
#pragma unroll
            for (int j = 0; j < 4; ++j) v[rr][j] = xr[64 * j]; }
        { const int rr = lane >> 5, fi = lane & 15; const int pos = a.pos[row0 + rr];
            const double rev = (double)pos * c_inv_freq[fi] * 0.15915494309189535; const float fr_ = (float)(rev - rint(rev));
            ROPE[(size_t)row0 * 32 + lane] = (lane & 16) ? __builtin_amdgcn_sinf(fr_) : __builtin_amdgcn_cosf(fr_); }
#pragma unroll
        for (int rr = 0; rr < 2; ++rr) {
#pragma unroll
            for (int j = 0; j < 4; ++j) ss[rr] += (v[rr][j].x * v[rr][j].x + v[rr][j].y * v[rr][j].y) + (v[rr][j].z * v[rr][j].z + v[rr][j].w * v[rr][j].w);
        }
#pragma unroll
        for (int o = 1; o < 64; o <<= 1) { ss[0] += __shfl_xor(ss[0], o); ss[1] += __shfl_xor(ss[1], o); }
        const int b = row0 >> 12;
        float pg[2][8];
#pragma unroll
        for (int rr = 0; rr < 2; ++rr)
#pragma unroll
            for (int g = 0; g < 8; ++g) pg[rr][g] = 0.f;
        const float rinv[2] = {1.f / sqrtf(ss[0] * (1.f / DM) + EPS), 1.f / sqrtf(ss[1] * (1.f / DM) + EPS)};
#pragma unroll
        for (int j = 0; j < 4; ++j) {
            const int col = 4 * lane + 256 * j;
            const f32x4 sh = *(const f32x4*)(mod + b * 3072 + col), gs = *(const f32x4*)(mod + b * 3072 + 1024 + col);
            f32x4 h[2];
#pragma unroll
            for (int rr = 0; rr < 2; ++rr) { h[rr] = v[rr][j] * rinv[rr] * gs + sh;
                u32x2 o; o.x = pk2(h[rr].x, h[rr].y); o.y = pk2(h[rr].z, h[rr].w); *((u32x2*)(H + (size_t)(row0 + rr) * DM) + lane + 64 * j) = o; }
#pragma unroll
            for (int g = 0; g < 8; ++g) { const f32x4 w = *(const f32x4*)(wg + g * 1024 + col);
                pg[0][g] += (h[0].x * w.x + h[0].y * w.y) + (h[0].z * w.z + h[0].w * w.w); pg[1][g] += (h[1].x * w.x + h[1].y * w.y) + (h[1].z * w.z + h[1].w * w.w); }
            __builtin_amdgcn_sched_barrier(0);
        }
#pragma unroll
        for (int o = 1; o < 64; o <<= 1)
#pragma unroll
            for (int g = 0; g < 8; ++g) { pg[0][g] += __shfl_xor(pg[0][g], o); pg[1][g] += __shfl_xor(pg[1][g], o); }
        if (lane < 2) { const int rr = lane; const float* p = rr ? pg[1] : pg[0];
            f32x4 ig = {p[0] + a.b_ig[0], p[1] + a.b_ig[1], p[2] + a.b_ig[2], p[3] + a.b_ig[3]};
            f32x4 fg = {p[4] + a.b_fg[0], p[5] + a.b_fg[1], p[6] + a.b_fg[2], p[7] + a.b_fg[3]};
            *(f32x4*)(IG + (size_t)(row0 + rr) * 4) = ig; *(f32x4*)(FG + (size_t)(row0 + rr) * 4) = fg; }
    }
}

struct EpiProj {
    static constexpr bool PERM = true; static constexpr int HOOK_T = -1;
    bf16* P; const float* rope;
    __device__ __forceinline__ void operator()(const f32x4 (&acc)[2][2][4][2], const pg8::Unit& u, int wr, int wc, int fr, int fq) const {
        const int row0 = u.pm * 256 + wr * 64 + fr, col0 = u.pn * 256 + wc * 64 + 8 * fq;
        const bool rot = (u.pn >= 16) && (u.pn < 28) && ((wc & 1) == 0);
#pragma unroll
        for (int ai = 0; ai < 2; ++ai)
#pragma unroll
            for (int m = 0; m < 4; ++m) { const int r = row0 + ai * 128 + m * 16; bf16* rowp = P + (size_t)r * INW + col0;
#pragma unroll
                for (int bj = 0; bj < 2; ++bj) { f32x4 v0 = acc[ai][bj][m][0], v1 = acc[ai][bj][m][1];
                    if (bj == 0 && rot) {
                        const float* tp = rope + (size_t)r * 32 + 8 * (fq & 1);
                        const f32x4 c0 = *(const f32x4*)tp, c1 = *(const f32x4*)(tp + 4), s0 = *(const f32x4*)(tp + 16), s1 = *(const f32x4*)(tp + 20);
                        f32x4 p0, p1;
#pragma unroll
                        for (int e = 0; e < 4; ++e) { p0[e] = __shfl_xor(v0[e], 32); p1[e] = __shfl_xor(v1[e], 32); }
                        const float sg = (fq < 2) ? -1.f : 1.f;
                        v0 = v0 * c0 + p0 * s0 * sg; v1 = v1 * c1 + p1 * s1 * sg;
                    }
                    u32x4 w; w.x = pg8::cvt_pk_bf16(v0[0], v0[1]); w.y = pg8::cvt_pk_bf16(v0[2], v0[3]); w.z = pg8::cvt_pk_bf16(v1[0], v1[1]); w.w = pg8::cvt_pk_bf16(v1[2], v1[3]);
                    *(u32x4*)(rowp + bj * 32) = w; } }
    }
};
struct EpiQK {
    static constexpr bool PERM = true; static constexpr int HOOK_T = -1;
    bf16* QM; bf16* KM;
    __device__ __forceinline__ void operator()(const f32x4 (&acc)[2][2][4][2], const pg8::Unit& u, int wr, int wc, int fr, int fq) const {
        const int row0 = u.pm * 256 + wr * 64 + fr, col0 = u.g * 256 + wc * 64 + 8 * fq;
        bf16* base = u.pn ? KM : QM;
#pragma unroll
        for (int ai = 0; ai < 2; ++ai)
#pragma unroll
            for (int m = 0; m < 4; ++m) { bf16* rowp = base + (size_t)(row0 + ai * 128 + m * 16) * 1024 + col0;
#pragma unroll
                for (int bj = 0; bj < 2; ++bj) { const f32x4 v0 = acc[ai][bj][m][0], v1 = acc[ai][bj][m][1];
                    u32x4 w; w.x = pg8::cvt_pk_bf16(v0[0], v0[1]); w.y = pg8::cvt_pk_bf16(v0[2], v0[3]); w.z = pg8::cvt_pk_bf16(v1[0], v1[1]); w.w = pg8::cvt_pk_bf16(v1[2], v1[3]);
                    *(u32x4*)(rowp + bj * 32) = w; } }
    }
};
struct EpiMerge {
    static constexpr bool PERM = true; static constexpr int HOOK_T = 16;
    const bf16* P; bf16* MG;
    __device__ __forceinline__ void hook(f32x4 (&acc)[2][2][4][2], const pg8::Unit& u, int wr, int wc, int fr, int fq) const {
        int row0 = u.pm * 256 + wr * 64 + fr, col0 = u.pn * 256 + wc * 64 + 8 * fq;
        asm volatile("" : "+v"(row0), "+v"(col0));
#pragma unroll
        for (int ai = 0; ai < 2; ++ai)
#pragma unroll
            for (int m = 0; m < 4; ++m) { const size_t r = (size_t)(row0 + ai * 128 + m * 16);
#pragma unroll
                for (int bj = 0; bj < 2; ++bj) { const int c = col0 + bj * 32;
                    const u32x4 gaw = *(const u32x4*)(P + r * INW + C_GA + c), gbw = *(const u32x4*)(P + r * INW + C_GB + c);
                    float ga[8], gb[8]; unpack8(gaw, ga); unpack8(gbw, gb);
#pragma unroll
                    for (int e = 0; e < 4; ++e) {
                        acc[ai][bj][m][0][e] *= (1.f + __expf(-gb[e])) / (1.f + __expf(-ga[e]));
                        acc[ai][bj][m][1][e] *= (1.f + __expf(-gb[4 + e])) / (1.f + __expf(-ga[4 + e])); } }
                __builtin_amdgcn_sched_barrier(0); }
    }
    __device__ __forceinline__ void operator()(const f32x4 (&acc)[2][2][4][2], const pg8::Unit& u, int wr, int wc, int fr, int fq) const {
        const int row0 = u.pm * 256 + wr * 64 + fr, col0 = u.pn * 256 + wc * 64 + 8 * fq;
#pragma unroll
        for (int ai = 0; ai < 2; ++ai)
#pragma unroll
            for (int m = 0; m < 4; ++m) { const size_t r = (size_t)(row0 + ai * 128 + m * 16);
#pragma unroll
                for (int bj = 0; bj < 2; ++bj) { const int c = col0 + bj * 32;
                    const u32x4 gbw = *(const u32x4*)(P + r * INW + C_GB + c); float gb[8]; unpack8(gbw, gb);
                    const f32x4 v0 = acc[ai][bj][m][0], v1 = acc[ai][bj][m][1];
                    float o[8];
#pragma unroll
                    for (int e = 0; e < 4; ++e) { o[e] = sigmoidf_(gb[e]) * v0[e]; o[4 + e] = sigmoidf_(gb[4 + e]) * v1[e]; }
                    u32x4 w; w.x = pg8::cvt_pk_bf16(o[0], o[1]); w.y = pg8::cvt_pk_bf16(o[2], o[3]); w.z = pg8::cvt_pk_bf16(o[4], o[5]); w.w = pg8::cvt_pk_bf16(o[6], o[7]);
                    *(u32x4*)(MG + r * 1024 + c) = w; } }
    }
};
struct EpiOut {
    static constexpr bool PERM = true; static constexpr int HOOK_T = -1;
    const float* x; bf16* xn; const float* gate; float* rowss; int grow0;
    __device__ __forceinline__ void operator()(const f32x4 (&acc)[2][2][4][2], const pg8::Unit& u, int wr, int wc, int fr, int fq) const {
        const int row0 = grow0 + u.pm * 256 + wr * 64 + fr, col0 = u.pn * 256 + wc * 64 + 8 * fq;
#pragma unroll
        for (int ai = 0; ai < 2; ++ai)
#pragma unroll
            for (int m = 0; m < 4; ++m) { const int r = row0 + ai * 128 + m * 16; const int b = r >> 12; float ss = 0.f;
#pragma unroll
                for (int bj = 0; bj < 2; ++bj) { const int c = col0 + bj * 32;
                    const float* gp = gate + b * 3072 + c; const f32x4 g0 = *(const f32x4*)gp, g1 = *(const f32x4*)(gp + 4);
                    const float* xp = x + (size_t)r * 1024 + c; const f32x4 x0 = *(const f32x4*)xp, x1 = *(const f32x4*)(xp + 4);
                    const f32x4 o0 = x0 + g0 * acc[ai][bj][m][0], o1 = x1 + g1 * acc[ai][bj][m][1];
                    ss += (o0[0] * o0[0] + o0[1] * o0[1]) + (o0[2] * o0[2] + o0[3] * o0[3]) + (o1[0] * o1[0] + o1[1] * o1[1]) + (o1[2] * o1[2] + o1[3] * o1[3]);
                    u32x4 w; w.x = pg8::cvt_pk_bf16(o0[0], o0[1]); w.y = pg8::cvt_pk_bf16(o0[2], o0[3]); w.z = pg8::cvt_pk_bf16(o1[0], o1[1]); w.w = pg8::cvt_pk_bf16(o1[2], o1[3]);
                    *(u32x4*)(xn + (size_t)r * 1024 + c) = w; }
                ss += __shfl_xor(ss, 16); ss += __shfl_xor(ss, 32);
                if (fq == 0) atomicAdd(rowss + r, ss); }
    }
};

__device__ __forceinline__ void phase_prep(const Args& a, unsigned char* lds, int vcu, int G, int pass) {
    const int tid = opaque_tid(), lane = tid & 63, wave = tid >> 6;
    unsigned char* ws = a.ws;
    bf16* P = (bf16*)(ws + WS_P);
    if (vcu < NB_PASS * 4) {
        const int bl = vcu >> 2, h = vcu & 3;
        const float* IG = (const float*)(ws + WS_IG); const float* FG = (const float*)(ws + WS_FG);
        float* gsc = (float*)(ws + WS_GSC);
        float* A1 = gsc, *B1 = gsc + MS * 4, *WI = gsc + 2 * MS * 4, *EF = gsc + 3 * MS * 4, *WK = gsc + 4 * MS * 4, *DEC = gsc + 5 * MS * 4;
        float* cg = (float*)lds; float* cp = cg + 64;
        float f[8], ii[8];
#pragma unroll
        for (int q = 0; q < 8; ++q) { const size_t grow = (size_t)pass * MS + bl * SEQ + (wave * 8 + q) * 64 + lane; f[q] = FG[grow * 4 + h]; ii[q] = IG[grow * 4 + h]; }
        float acs[8], b1[8], pm[8];
#pragma unroll
        for (int q = 0; q < 8; ++q) {
            float x = fminf(f[q], 0.f) - log1pf(expf(-fabsf(f[q])));
#pragma unroll
            for (int o = 1; o < 64; o <<= 1) { const float t = __shfl_up(x, o); if (lane >= o) x += t; }
            acs[q] = x; b1[q] = ii[q] - x;
            float m = b1[q];
#pragma unroll
            for (int o = 1; o < 64; o <<= 1) { const float t = __shfl_up(m, o); if (lane >= o) m = fmaxf(m, t); }
            pm[q] = m;
            if (lane == 63) { cg[wave * 8 + q] = x; cp[wave * 8 + q] = m; }
        }
        __syncthreads();
        float m_prev = 0.f, mp[8], Ms8[8];
        for (int j = 0; j < 64; ++j) { const float Ms = fmaxf(m_prev, cp[j]);
#pragma unroll
            for (int q = 0; q < 8; ++q) if (j == wave * 8 + q) { mp[q] = m_prev; Ms8[q] = Ms; }
            m_prev = cg[j] + Ms; }
#pragma unroll
        for (int q = 0; q < 8; ++q) {
            const int j = wave * 8 + q, lrow = bl * SEQ + j * 64 + lane;
            const float mx = fmaxf(mp[q], pm[q]);
            A1[h * MS + lrow] = -mx; B1[h * MS + lrow] = b1[q]; WI[h * MS + lrow] = expf(mp[q] - mx); EF[h * MS + lrow] = expf(-(acs[q] + mx)); WK[h * MS + lrow] = expf(b1[q] - Ms8[q]);
            if (lane == 0) { DEC[h * (MS / 64) + bl * 64 + j] = expf(mp[q] - Ms8[q]); DEC[4 * (MS / 64) + h * (MS / 64) + bl * 64 + j] = Ms8[q]; }
        }
    }
    {
        bf16* XC = (bf16*)(ws + WS_XC);
        const int cg8 = (tid & 127) * 8, rq = tid >> 7;
        float wc[4][8], bc[8];
#pragma unroll
        for (int j = 0; j < 4; ++j)
#pragma unroll
            for (int e = 0; e < 8; ++e) wc[j][e] = a.w_conv[j * 1024 + cg8 + e];
#pragma unroll
        for (int e = 0; e < 8; ++e) bc[e] = a.b_conv[cg8 + e];
        for (int it = vcu; it < MS / 32; it += G) {
            const int r0 = it * 32 + rq * 8, t0 = r0 & (SEQ - 1);
            u32x4 w[11];
#pragma unroll
            for (int k = 0; k < 11; ++k) { const int rr = r0 - 3 + k; w[k] = (k >= 3 || t0 >= 3) ? *(const u32x4*)(P + (size_t)rr * INW + C_XA + cg8) : (u32x4){0u, 0u, 0u, 0u}; }
            float xin[11][8];
#pragma unroll
            for (int k = 0; k < 11; ++k) unpack8(w[k], xin[k]);
#pragma unroll
            for (int k = 0; k < 8; ++k) { float o[8];
#pragma unroll
                for (int e = 0; e < 8; ++e) o[e] = siluf_(bc[e] + wc[0][e] * xin[k][e] + wc[1][e] * xin[k + 1][e] + wc[2][e] * xin[k + 2][e] + wc[3][e] * xin[k + 3][e]);
                u32x4 ov; ov.x = pk2(o[0], o[1]); ov.y = pk2(o[2], o[3]); ov.z = pk2(o[4], o[5]); ov.w = pk2(o[6], o[7]);
                *(u32x4*)(XC + (size_t)(r0 + k) * 1024 + cg8) = ov; }
        }
    }
}

__device__ __forceinline__ f32x4 mfma16(bf16x8 a, bf16x8 b, f32x4 c) { return __builtin_amdgcn_mfma_f32_16x16x32_bf16(a, b, c, 0, 0, 0); }

constexpr int TPS = 72;
constexpr int XCS = 264;
constexpr int L_QC_X = 0, L_QC_Q = 36864, L_QC_KT = L_QC_Q + 64 * XCS * 2, L_QC_ST = L_QC_KT + 256 * TPS * 2, L_QC_END = L_QC_ST + 64 * TPS * 2;
static_assert(64 * XCS * 2 <= 36864 && 256 * TPS * 2 <= 36864 && L_QC_END <= 131072, "qkc lds");
__device__ __forceinline__ void phase_cprep(const Args& a, unsigned char* lds, int vcu, int G) {
    const int tid = opaque_tid(), lane = tid & 63, wave = __builtin_amdgcn_readfirstlane(tid >> 6);
    const int fr = lane & 15, fq = lane >> 4;
    unsigned char* ws = a.ws;
    const bf16* P = (const bf16*)(ws + WS_P); const bf16* XC = (const bf16*)(ws + WS_XC); bf16* QM = (bf16*)(ws + WS_QM);
    const bf16* WF = (const bf16*)(ws + WS_WQK);
    const float* gsc = (const float*)(ws + WS_GSC);
    const float* gA1 = gsc, *gWK = gsc + 4 * MS * 4, *gMS = gsc + 5 * MS * 4 + 4 * (MS / 64);
    bf16* SG = (bf16*)(ws + WS_SG); bf16* KTG = (bf16*)(ws + WS_KTG); bf16* VTG = (bf16*)(ws + WS_VTG);
    bf16* XS = (bf16*)(lds + L_QC_X); bf16* VT = (bf16*)(lds + L_QC_X); bf16* QL = (bf16*)(lds + L_QC_Q); bf16* KT = (bf16*)(lds + L_QC_KT); bf16* ST = (bf16*)(lds + L_QC_ST);
    const int ti = wave >> 1, tj0 = 2 * (wave & 1);
    for (int ci = vcu; ci < (MS / 64) * 4; ci += G) {
        const int h = ci & 3, t0 = (ci >> 2) * 64;
        u32x4 xw[4], vw[4];
#pragma unroll
        for (int i = 0; i < 4; ++i) { const int c = tid + NTHR * i, row = c >> 5, cc = c & 31;
            xw[i] = *(const u32x4*)(XC + (size_t)(t0 + row) * 1024 + h * 256 + 8 * cc); }
#pragma unroll
        for (int i = 0; i < 4; ++i) { const int c = tid + NTHR * i, l = c & 63, dc = c >> 6;
            vw[i] = *(const u32x4*)(P + (size_t)(t0 + l) * INW + C_VA + h * 256 + 8 * dc); }
        float wkr[4][4], a1l[4];
        if (wave >= 4) {
#pragma unroll
            for (int lt = 0; lt < 4; ++lt)
#pragma unroll
                for (int i = 0; i < 4; ++i) wkr[lt][i] = gWK[h * MS + t0 + 16 * lt + 4 * fq + i];
        }
#pragma unroll
        for (int i = 0; i < 4; ++i) a1l[i] = gA1[h * MS + t0 + 16 * ti + 4 * fq + i];
        const float msc = gMS[h * (MS / 64) + (ci >> 2)];
        __syncthreads();
#pragma unroll
        for (int i = 0; i < 4; ++i) { const int c = tid + NTHR * i, row = c >> 5, cc = c & 31; *(u32x4*)(XS + row * XCS + 8 * cc) = xw[i]; }
        __syncthreads();
        const bf16* wf = WF + (size_t)h * 512 * 256;
#pragma unroll 1
        for (int ct = 0; ct < 4; ++ct) {
            const int nt = 4 * wave + ct;
            bf16x8 bq[8];
#pragma unroll
            for (int ks = 0; ks < 8; ++ks) bq[ks] = *(const bf16x8*)(wf + (size_t)((nt * 8 + ks) * 64 + lane) * 8);
#pragma unroll
            for (int lt = 0; lt < 4; ++lt) {
                f32x4 acc = {0.f, 0.f, 0.f, 0.f};
#pragma unroll
                for (int ks = 0; ks < 8; ++ks) { const bf16x8 af = *(const bf16x8*)(XS + (16 * lt + fr) * XCS + 32 * ks + 8 * fq); acc = mfma16(af, bq[ks], acc); }
                if (wave < 4) {
#pragma unroll
                    for (int i = 0; i < 4; ++i) QL[(16 * lt + 4 * fq + i) * XCS + 64 * wave + 16 * ct + fr] = (bf16)f2bf(acc[i]);
                } else {
                    const int d = 64 * (wave - 4) + 16 * ct + fr;
                    u32x2 o; o.x = pk2(acc[0] * wkr[lt][0], acc[1] * wkr[lt][1]); o.y = pk2(acc[2] * wkr[lt][2], acc[3] * wkr[lt][3]);
                    *(u32x2*)(KT + d * TPS + 16 * lt + 4 * fq) = o;
                }
            }
        }
        __syncthreads();
#pragma unroll
        for (int i = 0; i < 4; ++i) { const int c = tid + NTHR * i, l = c & 63, dc = c >> 6;
            const u32x4 w = vw[i]; bf16* dv = VT + (8 * dc) * TPS + l;
            dv[0 * TPS] = (bf16)(w.x & 0xffff); dv[1 * TPS] = (bf16)(w.x >> 16); dv[2 * TPS] = (bf16)(w.y & 0xffff); dv[3 * TPS] = (bf16)(w.y >> 16);
            dv[4 * TPS] = (bf16)(w.z & 0xffff); dv[5 * TPS] = (bf16)(w.z >> 16); dv[6 * TPS] = (bf16)(w.w & 0xffff); dv[7 * TPS] = (bf16)(w.w >> 16); }
#pragma unroll
        for (int i = 0; i < 4; ++i) { const int c = tid + NTHR * i, row = c >> 5, cc = c & 31;
            *(u32x4*)(QM + (size_t)(t0 + row) * 1024 + h * 256 + 8 * cc) = *(const u32x4*)(QL + row * XCS + 8 * cc); }
#pragma unroll
        for (int tt = 0; tt < 2; ++tt) {
            const int tj = tj0 + tt;
            f32x4 sacc = {0.f, 0.f, 0.f, 0.f};
            if (tj <= ti) {
#pragma unroll
                for (int ks = 0; ks < 8; ++ks) {
                    const bf16x8 qf = *(const bf16x8*)(QL + (16 * ti + fr) * XCS + 32 * ks + 8 * fq);
                    const bf16* kp = KT + (32 * ks + 8 * fq + (fr >> 2)) * TPS + 16 * tj + 4 * (fr & 3);
                    const s16x4 k0 = __builtin_amdgcn_ds_read_tr16_b64_v4i16((__attribute__((address_space(3))) s16x4*)(kp));
                    const s16x4 k1 = __builtin_amdgcn_ds_read_tr16_b64_v4i16((__attribute__((address_space(3))) s16x4*)(kp + 4 * TPS));
                    bf16x8 kb; kb[0] = k0[0]; kb[1] = k0[1]; kb[2] = k0[2]; kb[3] = k0[3]; kb[4] = k1[0]; kb[5] = k1[1]; kb[6] = k1[2]; kb[7] = k1[3];
                    sacc = mfma16(qf, kb, sacc); }
            }
            const int sidx = 16 * tj + fr;
#pragma unroll
            for (int i = 0; i < 4; ++i) { const int l = 16 * ti + 4 * fq + i;
                float v = 0.f;
                if (sidx <= l) v = sacc[i] * __expf(a1l[i] + msc);
                ST[l * TPS + sidx] = (bf16)f2bf(v); }
        }
        __syncthreads();
        { const int row = tid >> 3, ch = tid & 7; *(u32x4*)(SG + (size_t)ci * 4096 + row * 64 + 8 * ch) = *(const u32x4*)(ST + row * TPS + 8 * ch); }
#pragma unroll
        for (int i = 0; i < 4; ++i) { const int p = tid + NTHR * i, blk = p >> 6, ln = p & 63, row = (blk >> 1) * 16 + (ln & 15), ch = (blk & 1) * 4 + (ln >> 4);
            *(u32x4*)(KTG + (size_t)ci * 16384 + p * 8) = *(const u32x4*)(KT + row * TPS + 8 * ch);
            *(u32x4*)(VTG + (size_t)ci * 16384 + p * 8) = *(const u32x4*)(VT + row * TPS + 8 * ch); }
    }
}

constexpr int SA_DEPTH = 5, SA_PATCH = 32 * 32 * 2 + 128;
struct ScanA { const bf16* KTG; const bf16* VTG; const float* gDEC; bf16* CS; float* NS; int bl, h, dblk, eblk, wave, fr, fq; unsigned koff, voff; bool do_den; };
struct ScanAOps { bf16x8 k[2][2], v[2][2]; float decay; };
__device__ __forceinline__ void scana_load(const ScanA& c, int j, ScanAOps& o) {
    const int ci = (c.bl * 64 + j) * 4 + c.h;
    const bf16* kb = c.KTG + (size_t)ci * 16384; const bf16* vb = c.VTG + (size_t)ci * 16384;
#pragma unroll
    for (int dt = 0; dt < 2; ++dt)
#pragma unroll
        for (int k2 = 0; k2 < 2; ++k2) o.k[dt][k2] = *(const bf16x8*)(kb + (c.koff + (unsigned)((dt * 2 + k2) * 512)));
#pragma unroll
    for (int et = 0; et < 2; ++et)
#pragma unroll
        for (int k2 = 0; k2 < 2; ++k2) o.v[et][k2] = *(const bf16x8*)(vb + (c.voff + (unsigned)((et * 2 + k2) * 512)));
    o.decay = c.gDEC[c.h * (MS / 64) + c.bl * 64 + j];
}
__device__ __forceinline__ void scana_step(const ScanA& c, unsigned char* lds, int j, f32x4 (&Cacc)[2][2], f32x4 (&Nacc)[2], const ScanAOps& o, const bf16x8 ones) {
    const int ci = (c.bl * 64 + j) * 4 + c.h;
    unsigned char* patch = lds + c.wave * SA_PATCH;
    const int lane = c.fq * 16 + c.fr;
    if ((j & 1) == 0) {
#pragma unroll
    for (int dt = 0; dt < 2; ++dt) {
#pragma unroll
        for (int et = 0; et < 2; ++et) { const f32x4 cc = Cacc[dt][et]; u32x2 w; w.x = pk2(cc[0], cc[1]); w.y = pk2(cc[2], cc[3]);
            *(u32x2*)(patch + (16 * et + c.fr) * 64 + (16 * dt + 4 * c.fq) * 2) = w; }
        if (c.do_den && c.fr == 0) *(f32x4*)(patch + 2048 + (16 * dt + 4 * c.fq) * 4) = Nacc[dt];
    }
    { bf16* cs = c.CS + (size_t)ci * 65536 + (c.eblk * 8 + c.dblk) * 1024;
#pragma unroll
      for (int k = 0; k < 2; ++k) __builtin_nontemporal_store(*(const u32x4*)(patch + k * 1024 + lane * 16), (u32x4*)(cs + k * 512 + lane * 8));
      if (c.do_den && lane < 8) *(f32x4*)(c.NS + (size_t)ci * 256 + c.dblk * 32 + lane * 4) = *(const f32x4*)(patch + 2048 + lane * 16); }
    }
#pragma unroll
    for (int dt = 0; dt < 2; ++dt) {
#pragma unroll
        for (int et = 0; et < 2; ++et) {
            f32x4 cc = Cacc[dt][et] * o.decay;
#pragma unroll
            for (int k2 = 0; k2 < 2; ++k2) cc = mfma16(o.k[dt][k2], o.v[et][k2], cc);
            Cacc[dt][et] = cc;
        }
        if (c.do_den) {
            f32x4 cc = Nacc[dt] * o.decay;
#pragma unroll
            for (int k2 = 0; k2 < 2; ++k2) cc = mfma16(o.k[dt][k2], ones, cc);
            Nacc[dt] = cc;
        }
    }
}
__device__ __forceinline__ void scana_item(const Args& a, unsigned char* lds, int item) {
    const int tid = opaque_tid(), lane = tid & 63;
    unsigned char* ws = a.ws;
    ScanA c;
    c.wave = __builtin_amdgcn_readfirstlane(tid >> 6); c.fr = lane & 15; c.fq = lane >> 4;
    item = __builtin_amdgcn_readfirstlane(item);
    c.bl = item >> 5; c.h = (item >> 3) & 3; c.dblk = 2 * ((item >> 1) & 3) + (c.wave >> 2); c.eblk = 4 * (item & 1) + (c.wave & 3); c.do_den = (c.eblk == 0);
    c.koff = (unsigned)((4 * c.dblk) * 512 + lane * 8); c.voff = (unsigned)((4 * c.eblk) * 512 + lane * 8);
    c.KTG = (const bf16*)(ws + WS_KTG); c.VTG = (const bf16*)(ws + WS_VTG); c.gDEC = (const float*)(ws + WS_GSC) + 5 * MS * 4;
    c.CS = (bf16*)(ws + WS_CS); c.NS = (float*)(ws + WS_NS);
    f32x4 Cacc[2][2], Nacc[2];
#pragma unroll
    for (int x = 0; x < 2; ++x) { Nacc[x] = (f32x4){0.f, 0.f, 0.f, 0.f};
#pragma unroll
        for (int y = 0; y < 2; ++y) Cacc[x][y] = (f32x4){0.f, 0.f, 0.f, 0.f}; }
    bf16x8 ones;
    { const short ov = (c.fr == 0) ? (short)0x3F80 : (short)0;
#pragma unroll
      for (int e = 0; e < 8; ++e) ones[e] = ov; }
    ScanAOps o0, o1, o2, o3, o4;
    scana_load(c, 0, o0); scana_load(c, 1, o1); scana_load(c, 2, o2); scana_load(c, 3, o3); scana_load(c, 4, o4);
#define SA_STEP(jj, ob) do { scana_step(c, lds, (jj), Cacc, Nacc, ob, ones); __builtin_amdgcn_sched_barrier(0); scana_load(c, (jj) + SA_DEPTH < 64 ? (jj) + SA_DEPTH : 63, ob); __builtin_amdgcn_sched_barrier(0); } while (0)
#pragma nounroll
    for (int j = 0; j < 60; j += 5) { SA_STEP(j, o0); SA_STEP(j + 1, o1); SA_STEP(j + 2, o2); SA_STEP(j + 3, o3); SA_STEP(j + 4, o4); }
    SA_STEP(60, o0); SA_STEP(61, o1); SA_STEP(62, o2); SA_STEP(63, o3);
#undef SA_STEP
    asm volatile("s_waitcnt vmcnt(0)" ::: "memory");
}

constexpr int AKS = 136;
constexpr int L_AK = 0, L_AV = L_AK + 128 * AKS * 2, L_AP = L_AV + 128 * AKS * 2, L_ATT_END = L_AP + 8 * 16 * AKS * 2;
static_assert(L_ATT_END <= 131072, "attn lds");

__device__ __forceinline__ void attn_item(const Args& a, unsigned char* lds, int item) {
    const int tid = opaque_tid(), lane = tid & 63, wave = __builtin_amdgcn_readfirstlane(tid >> 6);
    const int fr = lane & 15, fq = lane >> 4;
    unsigned char* ws = a.ws;
    const int blk = item & 31, hh = (item >> 5) & 3, bl = (item >> 7) & 3, g = item >> 9;
    const int dil = g == 0 ? 1 : g == 1 ? 4 : 16, nb = 32 / dil;
    const int r = blk / nb, n = blk % nb;
    const bf16* P = (const bf16*)(ws + WS_P);
    const int H = 4 * g + hh;
    const bf16* Qb = P + C_QA + H * 128; const bf16* Kb = P + C_KA + H * 128; const bf16* Vb = P + C_VT + H * 128;
    bf16* Ks = (bf16*)(lds + L_AK); bf16* VTs = (bf16*)(lds + L_AV); bf16* Pw = (bf16*)(lds + L_AP) + wave * 16 * AKS;
    const int rowbase = bl * SEQ + r;
    bf16x8 qf[4];
    { const size_t qrow = (size_t)(rowbase + (128 * n + 16 * wave + fr) * dil);
#pragma unroll
      for (int ks = 0; ks < 4; ++ks) qf[ks] = *(const bf16x8*)(Qb + qrow * INW + 32 * ks + 8 * fq); }
    f32x4 O[8];
#pragma unroll
    for (int i = 0; i < 8; ++i) O[i] = (f32x4){0.f, 0.f, 0.f, 0.f};
    float mrow = -INFINITY, lrow = 0.f;
    const float scale = 0.08838834764831845f;
#define ATT_BAR() do { asm volatile("s_waitcnt lgkmcnt(0)" ::: "memory"); __builtin_amdgcn_s_barrier(); asm volatile("" ::: "memory"); } while (0)
    const int half0 = (n == 0 ? 1 : 0);
    u32x4 kreg[4], vreg[4];
#pragma unroll
    for (int i = 0; i < 4; ++i) { const int c = tid + NTHR * i, key = c >> 4, dc = c & 15;
        const size_t krow = (size_t)(rowbase + (128 * (n - 1 + half0) + key) * dil);
        kreg[i] = *(const u32x4*)(Kb + krow * INW + 8 * dc); vreg[i] = *(const u32x4*)(Vb + krow * INW + 8 * dc); }
    for (int half = half0; half < 2; ++half) {
        ATT_BAR();
#pragma unroll
        for (int i = 0; i < 4; ++i) { const int c = tid + NTHR * i, key = c >> 4, dc = c & 15;
            *(u32x4*)(Ks + key * AKS + 8 * dc) = kreg[i]; *(u32x4*)(VTs + key * AKS + 8 * dc) = vreg[i]; }
        if (half == 0) {
#pragma unroll
            for (int i = 0; i < 4; ++i) { const int c = tid + NTHR * i, key = c >> 4, dc = c & 15;
                const size_t krow = (size_t)(rowbase + (128 * n + key) * dil);
                kreg[i] = *(const u32x4*)(Kb + krow * INW + 8 * dc); vreg[i] = *(const u32x4*)(Vb + krow * INW + 8 * dc); }
        }
        ATT_BAR();
        f32x4 S[8];
        const int p = 16 * wave + fr;
        float mx = -INFINITY;
#pragma unroll
        for (int kt = 0; kt < 8; ++kt) {
            const bool act = half == 0 ? (kt >= wave) : (kt <= wave);
            f32x4 sacc = {0.f, 0.f, 0.f, 0.f};
            if (act) {
#pragma unroll
                for (int ks = 0; ks < 4; ++ks) { const bf16x8 kf = *(const bf16x8*)(Ks + (16 * kt + fr) * AKS + 32 * ks + 8 * fq); sacc = mfma16(kf, qf[ks], sacc); }
#pragma unroll
                for (int i = 0; i < 4; ++i) { const int kk = 16 * kt + 4 * fq + i; const bool ok = half == 0 ? (kk >= p) : (kk <= p);
                    const float v = ok ? sacc[i] * scale : -INFINITY; sacc[i] = v; mx = fmaxf(mx, v); }
            }
            S[kt] = sacc;
        }
        mx = fmaxf(mx, __shfl_xor(mx, 16)); mx = fmaxf(mx, __shfl_xor(mx, 32));
        const float mn = fmaxf(mrow, mx), alpha = __expf(mrow - mn); mrow = mn;
        float rs = 0.f;
        unsigned pk[8][2];
#pragma unroll
        for (int kt = 0; kt < 8; ++kt) {
            const bool act = half == 0 ? (kt >= wave) : (kt <= wave);
            if (act) { const float p0 = __expf(S[kt][0] - mn), p1 = __expf(S[kt][1] - mn), p2 = __expf(S[kt][2] - mn), p3 = __expf(S[kt][3] - mn);
                rs += (p0 + p1) + (p2 + p3); pk[kt][0] = pk2(p0, p1); pk[kt][1] = pk2(p2, p3); }
            else { pk[kt][0] = 0u; pk[kt][1] = 0u; }
        }
        rs += __shfl_xor(rs, 16); rs += __shfl_xor(rs, 32);
        lrow = lrow * alpha + rs;
        float al[4];
#pragma unroll
        for (int i = 0; i < 4; ++i) al[i] = __shfl(alpha, 4 * fq + i);
#pragma unroll
        for (int dtile = 0; dtile < 8; ++dtile)
#pragma unroll
            for (int i = 0; i < 4; ++i) O[dtile][i] *= al[i];
#pragma unroll
        for (int ks = 0; ks < 4; ++ks) {
            const bool act = half == 0 ? (2 * ks + 1 >= wave) : (2 * ks <= wave);
            if (act) {
                u32x4 pw; pw.x = pk[2 * ks][0]; pw.y = pk[2 * ks][1]; pw.z = pk[2 * ks + 1][0]; pw.w = pk[2 * ks + 1][1];
                const bf16x8 pa = __builtin_bit_cast(bf16x8, pw);
#pragma unroll
                for (int dtile = 0; dtile < 8; ++dtile) {
                    const bf16* vp = VTs + (32 * ks + 4 * fq + (fr >> 2)) * AKS + 16 * dtile + 4 * (fr & 3);
                    const s16x4 v0 = __builtin_amdgcn_ds_read_tr16_b64_v4i16((__attribute__((address_space(3))) s16x4*)(vp));
                    const s16x4 v1 = __builtin_amdgcn_ds_read_tr16_b64_v4i16((__attribute__((address_space(3))) s16x4*)(vp + 16 * AKS));
                    bf16x8 vb; vb[0] = v0[0]; vb[1] = v0[1]; vb[2] = v0[2]; vb[3] = v0[3]; vb[4] = v1[0]; vb[5] = v1[1]; vb[6] = v1[2]; vb[7] = v1[3];
                    O[dtile] = mfma16(pa, vb, O[dtile]); }
            }
        }
    }
    bf16* AO = (bf16*)(ws + WS_AO) + (size_t)g * MS * 512; float* LSE = (float*)(ws + WS_LSE) + (size_t)g * MS * 4;
    {
        const float inv_l = 1.f / lrow;
        float il[4];
#pragma unroll
        for (int i = 0; i < 4; ++i) il[i] = __shfl(inv_l, 4 * fq + i);
#pragma unroll
        for (int dtile = 0; dtile < 8; ++dtile)
#pragma unroll
            for (int i = 0; i < 4; ++i) Pw[(4 * fq + i) * AKS + 16 * dtile + fr] = (bf16)f2bf(O[dtile][i] * il[i]);
        if (fq == 0) { const size_t row = (size_t)(rowbase + (128 * n + 16 * wave + fr) * dil); LSE[(size_t)hh * MS + row] = mrow + logf(lrow); }
#pragma unroll
        for (int k = 0; k < 4; ++k) { const int c = lane + 64 * k, q = c >> 4, ch = c & 15;
            const size_t row = (size_t)(rowbase + (128 * n + 16 * wave + q) * dil);
            *(u32x4*)(AO + row * 512 + hh * 128 + 8 * ch) = *(const u32x4*)(Pw + q * AKS + 8 * ch); }
    }
    __syncthreads();
}

constexpr int N_SCAN_ITEMS = NB_PASS * 32, N_ATT_ITEMS = 3 * NB_PASS * 4 * 32;
#ifndef PROBE_ATT_REP
#define PROBE_ATT_REP 1
#endif
struct XcdBarrier;
__device__ __forceinline__ void xcd_barrier(const XcdBarrier& b);
__device__ __forceinline__ void phase_mix(const Args& a, unsigned char* lds, int pass, const XcdBarrier* pbar) {
    volatile int* slot = (volatile int*)(lds + 131072 + 1024);
#ifdef PROBE_SPLIT
    for (int it = blockIdx.x; it < N_SCAN_ITEMS; it += gridDim.x) scana_item(a, lds, it);
    xcd_barrier(*pbar);
    for (int rep = 0; rep < PROBE_ATT_REP; ++rep)
    for (int it = blockIdx.x; it < N_ATT_ITEMS; it += gridDim.x) attn_item(a, lds, it);
#else
    if ((int)blockIdx.x < N_SCAN_ITEMS && gridDim.x >= (unsigned)N_SCAN_ITEMS) {
        const int x = blockIdx.x & 7, k = blockIdx.x >> 3, g = x + 8 * (k >> 3), m = k & 7;
        scana_item(a, lds, g * 8 + m);
    } else if (gridDim.x < (unsigned)N_SCAN_ITEMS) { for (int it = blockIdx.x; it < N_SCAN_ITEMS; it += gridDim.x) scana_item(a, lds, it); }
    constexpr int QN = N_ATT_ITEMS / 8;
    for (int qo = 0; qo < 8; ++qo) {
        const int qx = (int)((blockIdx.x + qo) & 7);
        unsigned* qc = (unsigned*)(a.ws + WS_CTL) + CW_QCTR + (pass * 8 + qx) * 64;
        for (;;) {
            __syncthreads();
            if (opaque_tid() == 0) *slot = (int)atomicAdd(qc, 1u);
            __syncthreads();
            const int L = *slot;
            if (L >= QN) break;
            attn_item(a, lds, ((L >> 3) * 8 + qx) * 8 + (L & 7));
        }
    }
#endif
}

constexpr int QS_STRIDE = 264, SS_STRIDE = 72;
constexpr int L_QS = 0, L_SS = L_QS + 64 * QS_STRIDE * 2, L_DENL = L_SS + 64 * SS_STRIDE * 2, L_WIL = L_DENL + 256, L_NUM = L_WIL + 256, L_SB_END = L_NUM + 64 * QS_STRIDE * 2;
static_assert(L_SB_END <= 131072, "scan-B lds");
constexpr int L_KTL = L_SB_END, L_XS = L_KTL + 256 * TPS * 2, L_SB2_END = L_XS + 64 * TPS * 2;
static_assert(L_SB2_END <= 131072, "scan-B lds");
struct SBCtx { const bf16* P; const bf16* XC; const bf16* QM; const bf16* SG; const bf16* VTG; const bf16* KTG; const bf16* CS; const float* NS; const float* gWI; const float* gEF; const float* gDEC; bf16* UM; int tid, lane, wave, fr, fq; };

__device__ __forceinline__ void scanb_tail(const Args& a, const SBCtx& c, const bf16* NUMS, const float* DENL, int h, int t0) {
    const int lane = c.lane, wave = c.wave, col = h * 256 + 4 * lane;
    const f32x4 gh = *(const f32x4*)(a.g_head + col), sk = *(const f32x4*)(a.skip + col);
#pragma unroll
    for (int hb = 0; hb < 2; ++hb) {
        u32x2 ow[4], zw[4], xw[4];
#pragma unroll
        for (int q = 0; q < 4; ++q) { const size_t r = (size_t)(t0 + 8 * wave + 4 * hb + q);
            ow[q] = *(const u32x2*)(c.P + r * INW + C_OA + col); zw[q] = *(const u32x2*)(c.P + r * INW + C_ZA + col); xw[q] = *(const u32x2*)(c.XC + r * 1024 + col); }
#pragma unroll
        for (int q = 0; q < 4; ++q) {
            const int l = 8 * wave + 4 * hb + q; const size_t r = (size_t)(t0 + l);
            const u32x2 hw = *(const u32x2*)(NUMS + l * QS_STRIDE + 4 * lane);
            const float rd = DENL[l];
            float hm[4] = {sigmoidf_(bflo(ow[q].x)) * bflo(hw.x) * rd, sigmoidf_(bfhi(ow[q].x)) * bfhi(hw.x) * rd, sigmoidf_(bflo(ow[q].y)) * bflo(hw.y) * rd, sigmoidf_(bfhi(ow[q].y)) * bfhi(hw.y) * rd};
            float ss = (hm[0] * hm[0] + hm[1] * hm[1]) + (hm[2] * hm[2] + hm[3] * hm[3]);
            ss = wave_sum(ss);
            const float rinv = 1.f / sqrtf(ss * (1.f / 256.f) + EPS);
            const float xc[4] = {bflo(xw[q].x), bfhi(xw[q].x), bflo(xw[q].y), bfhi(xw[q].y)}, za[4] = {bflo(zw[q].x), bfhi(zw[q].x), bflo(zw[q].y), bfhi(zw[q].y)};
            float o[4];
#pragma unroll
            for (int e = 0; e < 4; ++e) o[e] = (hm[e] * rinv * gh[e] + sk[e] * xc[e]) * siluf_(za[e]);
            u32x2 ov; ov.x = pk2(o[0], o[1]); ov.y = pk2(o[2], o[3]);
            *(u32x2*)(c.UM + r * 1536 + col) = ov;
        }
        __builtin_amdgcn_sched_barrier(0);
    }
}

__device__ __forceinline__ void scanb_run(const Args& a, unsigned char* lds, int vcu, int G, int pass) {
    SBCtx c;
    c.tid = opaque_tid(); c.lane = c.tid & 63; c.wave = __builtin_amdgcn_readfirstlane(c.tid >> 6); c.fr = c.lane & 15; c.fq = c.lane >> 4;
    unsigned char* ws = a.ws;
    c.P = (const bf16*)(ws + WS_P); c.XC = (const bf16*)(ws + WS_XC); c.QM = (const bf16*)(ws + WS_QM); c.SG = (const bf16*)(ws + WS_SG); c.VTG = (const bf16*)(ws + WS_VTG); c.KTG = (const bf16*)(ws + WS_KTG);
    c.CS = (const bf16*)(ws + WS_CS); c.NS = (const float*)(ws + WS_NS); c.gWI = (const float*)(ws + WS_GSC) + 2 * MS * 4; c.gEF = (const float*)(ws + WS_GSC) + 3 * MS * 4; c.gDEC = (const float*)(ws + WS_GSC) + 5 * MS * 4;
    c.UM = (bf16*)(ws + WS_ACAT);
    const int tid = c.tid, lane = c.lane, wave = c.wave, fr = c.fr, fq = c.fq;
    bf16* QS = (bf16*)(lds + L_QS); bf16* SS = (bf16*)(lds + L_SS); float* DENL = (float*)(lds + L_DENL); float* WIL = (float*)(lds + L_WIL); bf16* NUMS = (bf16*)(lds + L_NUM);
    bf16* KTL = (bf16*)(lds + L_KTL); bf16* XS = (bf16*)(lds + L_XS);
    unsigned* qc = (unsigned*)(ws + WS_CTL) + CW_QCTR + 2048 + pass * 64;
    volatile int* slot = (volatile int*)(lds + 131072 + 1024);
    constexpr int NITEMS = (MS / 128) * 4;
    bf16x8 ones;
    { const short ov = (fr == 0) ? (short)0x3F80 : (short)0;
#pragma unroll
      for (int e = 0; e < 8; ++e) ones[e] = ov; }
    int it = vcu;
    while (it < NITEMS) {
        const int h = it & 3, pr = it >> 2, chA = (2 * pr) * 4 + h, chB = chA + 4, tA = (2 * pr) * 64, tB = tA + 64;
        bf16x8 cb[2][8], vtA[2][2], vtB[2][2];
#pragma unroll
        for (int t = 0; t < 2; ++t) {
#pragma unroll
            for (int ks = 0; ks < 8; ++ks) cb[t][ks] = *(const bf16x8*)(c.CS + (size_t)chA * 65536 + (wave * 8 + ks) * 1024 + (16 * t + fr) * 32 + 8 * fq);
#pragma unroll
            for (int k2 = 0; k2 < 2; ++k2) { vtA[t][k2] = *(const bf16x8*)(c.VTG + (size_t)chA * 16384 + (((2 * wave + t) * 2 + k2) * 64 + lane) * 8);
                                             vtB[t][k2] = *(const bf16x8*)(c.VTG + (size_t)chB * 16384 + (((2 * wave + t) * 2 + k2) * 64 + lane) * 8); }
        }
        const float decA = c.gDEC[h * (MS / 64) + 2 * pr];
        if (tid == 0) *slot = (int)atomicAdd(qc, 1u);
        __syncthreads();
#pragma unroll
        for (int i = 0; i < 4; ++i) { const int q = tid + NTHR * i, row = q >> 5, cc = q & 31; *(u32x4*)(QS + row * QS_STRIDE + 8 * cc) = *(const u32x4*)(c.QM + (size_t)(tA + row) * 1024 + h * 256 + 8 * cc); }
        { const int row = tid >> 3, cc = tid & 7; *(u32x4*)(SS + row * SS_STRIDE + 8 * cc) = *(const u32x4*)(c.SG + (size_t)chA * 4096 + row * 64 + 8 * cc); }
        if (tid < 64) WIL[tid] = c.gWI[h * MS + tA + tid];
#pragma unroll
        for (int i = 0; i < 4; ++i) { const int p = tid + NTHR * i, blk = p >> 6, ln = p & 63, row = (blk >> 1) * 16 + (ln & 15), ch8 = (blk & 1) * 4 + (ln >> 4);
            *(u32x4*)(KTL + row * TPS + 8 * ch8) = *(const u32x4*)(c.KTG + (size_t)chA * 16384 + p * 8); }
        __syncthreads();
        const int nit = G + *slot;
#pragma unroll
        for (int lt = 0; lt < 4; ++lt) {
            bf16x8 qf[8], sf[2];
#pragma unroll
            for (int ks = 0; ks < 8; ++ks) qf[ks] = *(const bf16x8*)(QS + (16 * lt + fr) * QS_STRIDE + 32 * ks + 8 * fq);
#pragma unroll
            for (int k2 = 0; k2 < 2; ++k2) sf[k2] = *(const bf16x8*)(SS + (16 * lt + fr) * SS_STRIDE + 32 * k2 + 8 * fq);
#pragma unroll
            for (int t = 0; t < 2; ++t) {
                f32x4 a1 = {0.f, 0.f, 0.f, 0.f}, a2 = {0.f, 0.f, 0.f, 0.f}, a3 = {0.f, 0.f, 0.f, 0.f};
#pragma unroll
                for (int k2 = 0; k2 < 2; ++k2) a1 = mfma16(sf[k2], vtA[t][k2], a1);
#pragma unroll
                for (int ks = 0; ks < 8; ks += 2) { a2 = mfma16(qf[ks], cb[t][ks], a2); a3 = mfma16(qf[ks + 1], cb[t][ks + 1], a3); }
#pragma unroll
                for (int i = 0; i < 4; ++i) NUMS[(16 * lt + 4 * fq + i) * QS_STRIDE + 32 * wave + 16 * t + fr] = (bf16)f2bf(a1[i] + WIL[16 * lt + 4 * fq + i] * (a2[i] + a3[i]));
            }
        }
        if (wave == 0) {
            bf16x8 nb[8];
#pragma unroll
            for (int ks = 0; ks < 8; ++ks) { const f32x4 n0 = *(const f32x4*)(c.NS + (size_t)chA * 256 + 32 * ks + 8 * fq), n1 = *(const f32x4*)(c.NS + (size_t)chA * 256 + 32 * ks + 8 * fq + 4);
                u32x4 w; w.x = pk2(n0[0], n0[1]); w.y = pk2(n0[2], n0[3]); w.z = pk2(n1[0], n1[1]); w.w = pk2(n1[2], n1[3]);
                if (fr != 0) w = (u32x4){0u, 0u, 0u, 0u};
                nb[ks] = __builtin_bit_cast(bf16x8, w); }
#pragma unroll
            for (int lt = 0; lt < 4; ++lt) {
                f32x4 a1 = {0.f, 0.f, 0.f, 0.f}, a2 = {0.f, 0.f, 0.f, 0.f};
#pragma unroll
                for (int k2 = 0; k2 < 2; ++k2) { const bf16x8 sf = *(const bf16x8*)(SS + (16 * lt + fr) * SS_STRIDE + 32 * k2 + 8 * fq); a1 = mfma16(sf, ones, a1); }
#pragma unroll
                for (int ks = 0; ks < 8; ++ks) { const bf16x8 qf = *(const bf16x8*)(QS + (16 * lt + fr) * QS_STRIDE + 32 * ks + 8 * fq); a2 = mfma16(qf, nb[ks], a2); }
                if (fr == 0) {
#pragma unroll
                    for (int i = 0; i < 4; ++i) { const int l = 16 * lt + 4 * fq + i; const float den = a1[i] + WIL[l] * a2[i]; DENL[l] = 1.f / fmaxf(fabsf(den), c.gEF[h * MS + tA + l]); } }
            }
        }
        __syncthreads();
#pragma unroll
        for (int i = 0; i < 4; ++i) { const int q = tid + NTHR * i, row = q >> 5, cc = q & 31; *(u32x4*)(QS + row * QS_STRIDE + 8 * cc) = *(const u32x4*)(c.QM + (size_t)(tB + row) * 1024 + h * 256 + 8 * cc); }
        { const int row = tid >> 3, cc = tid & 7; *(u32x4*)(SS + row * SS_STRIDE + 8 * cc) = *(const u32x4*)(c.SG + (size_t)chB * 4096 + row * 64 + 8 * cc); }
        scanb_tail(a, c, NUMS, DENL, h, tA);
        __syncthreads();
        if (tid < 64) WIL[tid] = c.gWI[h * MS + tB + tid];
        {
            const int ti = wave >> 1;
            bf16x8 qf[8];
#pragma unroll
            for (int ks = 0; ks < 8; ++ks) qf[ks] = *(const bf16x8*)(QS + (16 * ti + fr) * QS_STRIDE + 32 * ks + 8 * fq);
#pragma unroll
            for (int tt = 0; tt < 2; ++tt) { const int tj = 2 * (wave & 1) + tt;
                f32x4 xacc = {0.f, 0.f, 0.f, 0.f};
#pragma unroll
                for (int ks = 0; ks < 8; ++ks) {
                    const bf16* kp = KTL + (32 * ks + 8 * fq + (fr >> 2)) * TPS + 16 * tj + 4 * (fr & 3);
                    const s16x4 k0 = __builtin_amdgcn_ds_read_tr16_b64_v4i16((__attribute__((address_space(3))) s16x4*)(kp));
                    const s16x4 k1 = __builtin_amdgcn_ds_read_tr16_b64_v4i16((__attribute__((address_space(3))) s16x4*)(kp + 4 * TPS));
                    bf16x8 kb; kb[0] = k0[0]; kb[1] = k0[1]; kb[2] = k0[2]; kb[3] = k0[3]; kb[4] = k1[0]; kb[5] = k1[1]; kb[6] = k1[2]; kb[7] = k1[3];
                    xacc = mfma16(qf[ks], kb, xacc); }
#pragma unroll
                for (int i = 0; i < 4; ++i) XS[(16 * ti + 4 * fq + i) * TPS + 16 * tj + fr] = (bf16)f2bf(xacc[i]); }
        }
        __syncthreads();
#pragma unroll
        for (int lt = 0; lt < 4; ++lt) {
            bf16x8 qf[8], sf[2], xf[2];
#pragma unroll
            for (int ks = 0; ks < 8; ++ks) qf[ks] = *(const bf16x8*)(QS + (16 * lt + fr) * QS_STRIDE + 32 * ks + 8 * fq);
#pragma unroll
            for (int k2 = 0; k2 < 2; ++k2) { sf[k2] = *(const bf16x8*)(SS + (16 * lt + fr) * SS_STRIDE + 32 * k2 + 8 * fq); xf[k2] = *(const bf16x8*)(XS + (16 * lt + fr) * TPS + 32 * k2 + 8 * fq); }
#pragma unroll
            for (int t = 0; t < 2; ++t) {
                f32x4 a1 = {0.f, 0.f, 0.f, 0.f}, a2 = {0.f, 0.f, 0.f, 0.f}, a3 = {0.f, 0.f, 0.f, 0.f}, a4 = {0.f, 0.f, 0.f, 0.f};
#pragma unroll
                for (int k2 = 0; k2 < 2; ++k2) { a1 = mfma16(sf[k2], vtB[t][k2], a1); a4 = mfma16(xf[k2], vtA[t][k2], a4); }
#pragma unroll
                for (int ks = 0; ks < 8; ks += 2) { a2 = mfma16(qf[ks], cb[t][ks], a2); a3 = mfma16(qf[ks + 1], cb[t][ks + 1], a3); }
#pragma unroll
                for (int i = 0; i < 4; ++i) NUMS[(16 * lt + 4 * fq + i) * QS_STRIDE + 32 * wave + 16 * t + fr] = (bf16)f2bf(a1[i] + WIL[16 * lt + 4 * fq + i] * (decA * (a2[i] + a3[i]) + a4[i]));
            }
        }
        if (wave == 0) {
            bf16x8 nb[8];
#pragma unroll
            for (int ks = 0; ks < 8; ++ks) { const f32x4 n0 = *(const f32x4*)(c.NS + (size_t)chA * 256 + 32 * ks + 8 * fq), n1 = *(const f32x4*)(c.NS + (size_t)chA * 256 + 32 * ks + 8 * fq + 4);
                u32x4 w; w.x = pk2(n0[0], n0[1]); w.y = pk2(n0[2], n0[3]); w.z = pk2(n1[0], n1[1]); w.w = pk2(n1[2], n1[3]);
                if (fr != 0) w = (u32x4){0u, 0u, 0u, 0u};
                nb[ks] = __builtin_bit_cast(bf16x8, w); }
#pragma unroll
            for (int lt = 0; lt < 4; ++lt) {
                f32x4 a1 = {0.f, 0.f, 0.f, 0.f}, a2 = {0.f, 0.f, 0.f, 0.f}, a4 = {0.f, 0.f, 0.f, 0.f};
#pragma unroll
                for (int k2 = 0; k2 < 2; ++k2) { const bf16x8 sf = *(const bf16x8*)(SS + (16 * lt + fr) * SS_STRIDE + 32 * k2 + 8 * fq); a1 = mfma16(sf, ones, a1);
                                                 const bf16x8 xf = *(const bf16x8*)(XS + (16 * lt + fr) * TPS + 32 * k2 + 8 * fq); a4 = mfma16(xf, ones, a4); }
#pragma unroll
                for (int ks = 0; ks < 8; ++ks) { const bf16x8 qf = *(const bf16x8*)(QS + (16 * lt + fr) * QS_STRIDE + 32 * ks + 8 * fq); a2 = mfma16(qf, nb[ks], a2); }
                if (fr == 0) {
#pragma unroll
                    for (int i = 0; i < 4; ++i) { const int l = 16 * lt + 4 * fq + i; const float den = a1[i] + WIL[l] * (decA * a2[i] + a4[i]); DENL[l] = 1.f / fmaxf(fabsf(den), c.gEF[h * MS + tB + l]); } }
            }
        }
        __syncthreads();
        scanb_tail(a, c, NUMS, DENL, h, tB);
        it = nit;
    }
    __syncthreads();
}

__device__ __forceinline__ void phase_post(const Args& a, unsigned char* lds, int vcu, int G, int pass) {
    scanb_run(a, lds, vcu, G, pass);
    const int tid = opaque_tid(), lane = tid & 63, wave = tid >> 6;
    unsigned char* ws = a.ws;
    const bf16* P = (const bf16*)(ws + WS_P);
    const bf16* AO = (const bf16*)(ws + WS_AO); const float* LSE = (const float*)(ws + WS_LSE); bf16* UA = (bf16*)(ws + WS_ACAT) + 1024;
    const int hh = lane >> 4, c = hh * 128 + 8 * (lane & 15);
    for (int r0 = 2 * (vcu * NWAVES + wave); r0 < MS; r0 += 2 * G * NWAVES) {
        u32x4 o0[2], o1[2], o2[2], zb[2]; float l0[2], l1[2], l2[2];
#pragma unroll
        for (int q = 0; q < 2; ++q) { const size_t r = (size_t)(r0 + q);
            o0[q] = *(const u32x4*)(AO + r * 512 + c); o1[q] = *(const u32x4*)(AO + ((size_t)MS + r) * 512 + c); o2[q] = *(const u32x4*)(AO + ((size_t)2 * MS + r) * 512 + c);
            zb[q] = *(const u32x4*)(P + r * INW + C_ZB + c);
            l0[q] = LSE[(size_t)hh * MS + r]; l1[q] = LSE[(size_t)(4 + hh) * MS + r]; l2[q] = LSE[(size_t)(8 + hh) * MS + r]; }
#pragma unroll
        for (int q = 0; q < 2; ++q) {
            const float mx = fmaxf(l0[q], fmaxf(l1[q], l2[q]));
            float w0 = __expf(l0[q] - mx), w1 = __expf(l1[q] - mx), w2 = __expf(l2[q] - mx); const float inv = 1.f / (w0 + w1 + w2); w0 *= inv; w1 *= inv; w2 *= inv;
            float f0[8], f1[8], f2[8], z[8], o[8]; unpack8(o0[q], f0); unpack8(o1[q], f1); unpack8(o2[q], f2); unpack8(zb[q], z);
#pragma unroll
            for (int e = 0; e < 8; ++e) o[e] = (w0 * f0[e] + w1 * f1[e] + w2 * f2[e]) * siluf_(z[e]);
            u32x4 ov; ov.x = pk2(o[0], o[1]); ov.y = pk2(o[2], o[3]); ov.z = pk2(o[4], o[5]); ov.w = pk2(o[6], o[7]);
            *(u32x4*)(UA + (size_t)(r0 + q) * 1536 + c) = ov;
        }
    }
}

__device__ __forceinline__ void phase_norm(const Args& a, int vcu, int G) {
    const int tid = opaque_tid(), lane = tid & 63, wave = tid >> 6;
    const float* rowss = (const float*)(a.ws + WS_CTL) + CW_ROWSS;
    const bf16* xn = (const bf16*)(a.ws + WS_H);
    for (int r0 = 2 * (vcu * NWAVES + wave); r0 < MALL; r0 += 2 * G * NWAVES) {
        u32x4 w[2][2]; float rinv[2];
#pragma unroll
        for (int q = 0; q < 2; ++q) { const u32x4* p = (const u32x4*)(xn + (size_t)(r0 + q) * DM) + lane; w[q][0] = p[0]; w[q][1] = p[64]; rinv[q] = 1.f / sqrtf(rowss[r0 + q] * (1.f / DM) + EPS); }
#pragma unroll
        for (int q = 0; q < 2; ++q)
#pragma unroll
            for (int hlf = 0; hlf < 2; ++hlf) { float f[8]; unpack8(w[q][hlf], f); const int c = 8 * lane + 512 * hlf;
                const f32x4 g0 = *(const f32x4*)(a.g_final + c), g1 = *(const f32x4*)(a.g_final + c + 4);
                float* op = a.out + (size_t)(r0 + q) * DM + c;
                *(f32x4*)op = (f32x4){f[0], f[1], f[2], f[3]} * rinv[q] * g0; *(f32x4*)(op + 4) = (f32x4){f[4], f[5], f[6], f[7]} * rinv[q] * g1; }
    }
}


#define LAS __attribute__((address_space(3)))
#define XB_TMO      128
#define XB_XCNT(j)  (256  + 64 * (j))
#define XB_XSUB(j)  (1280 + 64 * (j))
#define XB_XGEN(j)  (2304 + 64 * (j))
#define XB_TOP      3328
#define XB_TOPGEN   3392
#define XCD_BAR_WORDS 3456
#define XB_SPIN_CAP (1u << 22)
constexpr int CW_BAR = 4096;
__device__ __forceinline__ unsigned xb_ld(unsigned* p)              { return __hip_atomic_load(p, __ATOMIC_RELAXED, __HIP_MEMORY_SCOPE_AGENT); }
__device__ __forceinline__ unsigned xb_add(unsigned* p, unsigned v) { return __hip_atomic_fetch_add(p, v, __ATOMIC_RELAXED, __HIP_MEMORY_SCOPE_AGENT); }
__device__ __forceinline__ unsigned xb_xcc_id() { return (unsigned)__builtin_amdgcn_s_getreg((3 << 11) | 20) & 0xFu; }
#define XB_SPIN(cond, bar) do { unsigned _sp = 0; while (cond) { __builtin_amdgcn_s_sleep(1); \
    if ((++_sp & 255u) == 0u) { if (xb_ld(&(bar)[XB_TMO])) break; if (_sp > XB_SPIN_CAP) { atomicAdd(&(bar)[XB_TMO], 1u); break; } } } } while (0)
struct XcdBarrier { unsigned* bar; unsigned x; volatile LAS unsigned* st; };
__device__ __forceinline__ XcdBarrier xcd_barrier_post(unsigned* bar, volatile LAS unsigned* st) {
    XcdBarrier b; b.bar = bar; b.x = xb_xcc_id(); b.st = st;
    if (threadIdx.x == 0) (void)xb_add(&bar[XB_XCNT(b.x)], 1u);
    return b;
}
__device__ __forceinline__ void xcd_barrier_complete(unsigned* bar, unsigned x, unsigned& nloc, unsigned& nx) {
    const unsigned G = gridDim.x * gridDim.y * gridDim.z;
    unsigned sum, cnt, mine, sp = 0u;
    for (;;) {
        sum = 0u; cnt = 0u; mine = 0u;
#pragma unroll
        for (unsigned j = 0; j < 16; ++j) { const unsigned c = xb_ld(&bar[XB_XCNT(j)]); sum += c; cnt += (c > 0u) ? 1u : 0u; mine = (j == x) ? c : mine; }
        if (sum == G) break;
        __builtin_amdgcn_s_sleep(1);
        if ((++sp & 255u) == 0u) { if (xb_ld(&bar[XB_TMO])) break; if (sp > XB_SPIN_CAP) { atomicAdd(&bar[XB_TMO], 1u); break; } }
    }
    nloc = mine > 0u ? mine : 1u; nx = cnt > 0u ? cnt : 1u;
}
__device__ __forceinline__ void xcd_barrier(const XcdBarrier& b) {
    asm volatile("s_waitcnt vmcnt(0)" ::: "memory");
    __syncthreads();
    if (threadIdx.x == 0) {
        unsigned* bar = b.bar;
        __builtin_amdgcn_s_waitcnt(0);
        unsigned nloc = b.st[0], nx = b.st[1];
        if (nloc == 0u) { xcd_barrier_complete(bar, b.x, nloc, nx); b.st[0] = nloc; b.st[1] = nx; }
        const unsigned old = xb_add(&bar[XB_XSUB(b.x)], 1u);
        const unsigned gen = old / nloc;
        if (old + 1u == (gen + 1u) * nloc) {
            __builtin_amdgcn_fence(__ATOMIC_RELEASE, "agent");
            asm volatile("s_waitcnt vmcnt(0)" ::: "memory");
            const unsigned og = xb_add(&bar[XB_TOP], 1u);
            const unsigned tg = og / nx;
            if (og + 1u == (tg + 1u) * nx) xb_add(&bar[XB_TOPGEN], 1u);
            else XB_SPIN(xb_ld(&bar[XB_TOPGEN]) == tg, bar);
            __builtin_amdgcn_fence(__ATOMIC_ACQUIRE, "agent");
            xb_add(&bar[XB_XGEN(b.x)], 1u);
            asm volatile("s_waitcnt vmcnt(0)" ::: "memory");
        } else {
            XB_SPIN(xb_ld(&bar[XB_XGEN(b.x)]) == gen, bar);
            __builtin_amdgcn_fence(__ATOMIC_ACQUIRE, "agent");
            asm volatile("s_waitcnt vmcnt(0)" ::: "memory");
        }
    }
    __syncthreads();
}

constexpr int PH_PER_PASS = 7, PH_TOTAL = 2 + PH_PER_PASS * NPASS + 1;
#define PROBE_KIND_OF(k) ((k) == 0 ? K_INPROJ : (k) == 1 ? K_PREP : (k) == 2 ? K_CPREP : (k) == 3 ? K_MIX : (k) == 4 ? K_POST : (k) == 5 ? K_OUT1 : K_OUT2)
enum { K_PROLOGUE = 0, K_H = 1, K_INPROJ = 2, K_PREP = 3, K_QK = 4, K_MIX = 5, K_POST = 6, K_OUT1 = 7, K_OUT2 = 8, K_NORM = 9, K_CPREP = 10 };

__device__ __forceinline__ Args fresh_args() {
    Args a{};
#if defined(__HIP_DEVICE_COMPILE__)
    typedef const __attribute__((address_space(4))) unsigned long long* KP;
    KP q = (KP)__builtin_amdgcn_kernarg_segment_ptr(); asm volatile("" : "+s"(q));
    static_assert(sizeof(Args) == 22 * 8, "Args layout");
    unsigned long long w[22];
#pragma unroll
    for (int i = 0; i < 22; ++i) w[i] = q[i];
    __builtin_memcpy(&a, w, sizeof(Args));
#endif
    return a;
}
template <int KIND>
__device__ __forceinline__ void run_phase(const Args& args, unsigned char* lds, int pass, const XcdBarrier* pbar = nullptr) {
    const int G = gridDim.x; const int bx = blockIdx.x;
    const int vcu = (G % 8 == 0) ? (bx % 8) * (G / 8) + bx / 8 : bx;
    unsigned char* ws = args.ws;
    PG8_LAS unsigned char* lds3 = (PG8_LAS unsigned char*)lds;
    if constexpr (KIND == K_PROLOGUE) phase_prologue(args, lds, vcu, G);
    else if constexpr (KIND == K_H) phase_h(args, lds, vcu, G);
    else if constexpr (KIND == K_NORM) phase_norm(args, vcu, G);
    else if constexpr (KIND == K_INPROJ) {
        pg8::Gemm<1024, 1024, 1024> g{(const bf16*)(ws + WS_H) + (size_t)pass * MS * 1024, (const bf16*)(ws + WS_WIN)};
        pg8::StaticOrder S; S.init(MS, INW, G, bx);
        EpiProj E{(bf16*)(ws + WS_P), (const float*)(ws + WS_ROPE) + (size_t)pass * MS * 32};
        pg8::gemm_phase<EpiProj, pg8::StaticOrder, true, true>(lds3, g, S, E);
    } else if constexpr (KIND == K_PREP) phase_prep(args, lds, vcu, G, pass);
    else if constexpr (KIND == K_QK) {
        pg8::Gemm<1024, 256, 256, 512, 512 * 256 * 2> g{(const bf16*)(ws + WS_XC), (const bf16*)(ws + WS_WQK)};
        pg8::GroupOrder S; S.init(MS, G, bx);
        EpiQK E{(bf16*)(ws + WS_QM), (bf16*)(ws + WS_KM)};
        pg8::gemm_phase<EpiQK, pg8::GroupOrder, true, true>(lds3, g, S, E);
    } else if constexpr (KIND == K_CPREP) phase_cprep(args, lds, vcu, G);
    else if constexpr (KIND == K_MIX) phase_mix(args, lds, pass, pbar);
    else if constexpr (KIND == K_POST) phase_post(args, lds, vcu, G, pass);
    else if constexpr (KIND == K_OUT1) {
        pg8::Gemm<1536, 1536, 1536> g{(const bf16*)(ws + WS_ACAT), (const bf16*)(ws + WS_WOM)};
        pg8::StaticOrder S; S.init(MS, 1024, G, bx);
        EpiMerge E{(const bf16*)(ws + WS_P), (bf16*)(ws + WS_MG)};
        pg8::gemm_phase<EpiMerge, pg8::StaticOrder, true, true>(lds3, g, S, E);
    } else if constexpr (KIND == K_OUT2) {
        pg8::Gemm<1024, 1024, 1024> g{(const bf16*)(ws + WS_MG), (const bf16*)(ws + WS_WO)};
        pg8::StaticOrder S; S.init(MS, 1024, G, bx);
        EpiOut E{args.x, (bf16*)(ws + WS_H), (const float*)(ws + WS_MOD) + 2048, (float*)(ws + WS_CTL) + CW_ROWSS, pass * MS};
        pg8::gemm_phase<EpiOut, pg8::StaticOrder, true, true>(lds3, g, S, E);
    }
}

#if !MK_ONE_LAUNCH
template <int KIND>
__global__ void __launch_bounds__(NTHR, 2) k_phase(Args args) {
    extern __shared__ __attribute__((aligned(16))) unsigned char lds[];
    run_phase<KIND>(args, lds, args.ph_lo);
}
#else
__global__ void __launch_bounds__(NTHR, 2) mk_fwd(Args args) {
    extern __shared__ __attribute__((aligned(16))) unsigned char lds[];
    volatile LAS unsigned* misc = (volatile LAS unsigned*)((LAS unsigned char*)lds + 131072 + 2048);
    if (threadIdx.x < 16) misc[threadIdx.x] = 0u;
    __syncthreads();
    XcdBarrier bar = xcd_barrier_post((unsigned*)(args.ws + WS_CTL) + CW_BAR, misc + 8);
#ifdef PROBE_TMASK
    unsigned long long pr_acc = 0ull;
#endif
    for (int gp = args.ph_lo; gp < args.ph_hi; ++gp) {
#ifdef PROBE_TMASK
        const unsigned long long pr_t0 = __builtin_amdgcn_s_memrealtime();
        int pr_kind;
        if (gp == 0) pr_kind = K_PROLOGUE; else if (gp == 1) pr_kind = K_H; else if (gp == PH_TOTAL - 1) pr_kind = K_NORM;
        else { const int k = (gp - 2) % PH_PER_PASS; pr_kind = PROBE_KIND_OF(k); }
#endif
        if (gp == 0) run_phase<K_PROLOGUE>(args, lds, 0);
        else if (gp == 1) run_phase<K_H>(args, lds, 0);
        else if (gp == PH_TOTAL - 1) run_phase<K_NORM>(args, lds, 0);
        else {
            const int pass = (gp - 2) / PH_PER_PASS, k = (gp - 2) % PH_PER_PASS;
            if (k == 0) run_phase<K_INPROJ>(args, lds, pass);
            else if (k == 1) run_phase<K_PREP>(args, lds, pass);
            else if (k == 2) run_phase<K_CPREP>(args, lds, pass);
            else if (k == 3) run_phase<K_MIX>(args, lds, pass, &bar);
            else if (k == 4) run_phase<K_POST>(args, lds, pass);
            else if (k == 5) run_phase<K_OUT1>(args, lds, pass);
            else run_phase<K_OUT2>(args, lds, pass);
        }
#ifdef PROBE_TMASK
        const unsigned long long pr_tb = __builtin_amdgcn_s_memrealtime();
#endif
        if (gp + 1 < args.ph_hi) xcd_barrier(bar);
#ifdef PROBE_TMASK
        else __syncthreads();
        if ((PROBE_TMASK >> 11) & 1) pr_acc += __builtin_amdgcn_s_memrealtime() - pr_tb;
        if ((PROBE_TMASK >> pr_kind) & 1) pr_acc += __builtin_amdgcn_s_memrealtime() - pr_t0;
#endif
    }
#ifdef PROBE_TMASK
    if (blockIdx.x == 0) { const unsigned long long t1 = __builtin_amdgcn_s_memrealtime(); while (__builtin_amdgcn_s_memrealtime() - t1 < 4ull * pr_acc) __builtin_amdgcn_s_sleep(8); }
#endif
}
#endif

extern "C" void kernel_launch(void* const* d_in, const int* in_sizes, int n_in, void* d_out, int out_size, void* d_ws, size_t ws_size, hipStream_t stream) {
    static int grid = 0;
    if (grid == 0) {
        if (n_in != 19 || in_sizes[0] != MALL * DM || out_size != MALL * DM || ws_size < WS_END) { fprintf(stderr, "kernel_launch: unexpected shapes (n_in %d, ws %zu)\n", n_in, ws_size); grid = -1; return; }
        int dev = 0, cus = 0, per_cu = 0;
        (void)hipGetDevice(&dev); (void)hipDeviceGetAttribute(&cus, hipDeviceAttributeMultiprocessorCount, dev);
#if MK_ONE_LAUNCH
        (void)hipFuncSetAttribute((const void*)mk_fwd, hipFuncAttributeMaxDynamicSharedMemorySize, LDS_BYTES);
        (void)hipOccupancyMaxActiveBlocksPerMultiprocessor(&per_cu, (const void*)mk_fwd, NTHR, LDS_BYTES);
        if (per_cu < 1) { fprintf(stderr, "kernel_launch: occupancy query says %d\n", per_cu); per_cu = 1; }
#else
#define SETATTR(KIND) (void)hipFuncSetAttribute((const void*)k_phase<KIND>, hipFuncAttributeMaxDynamicSharedMemorySize, LDS_BYTES)
        SETATTR(K_PROLOGUE); SETATTR(K_H); SETATTR(K_INPROJ); SETATTR(K_PREP); SETATTR(K_QK); SETATTR(K_MIX); SETATTR(K_POST); SETATTR(K_OUT1); SETATTR(K_OUT2); SETATTR(K_NORM); SETATTR(K_CPREP);
        (void)per_cu;
#endif
        (void)hipGetLastError();
        grid = cus;
    }
    if (grid < 0) return;
    (void)hipMemsetAsync((char*)d_ws + WS_CTL, 0, CTL_ZERO_BYTES, stream);
    Args a{};
    a.x = (const float*)d_in[0]; a.c = (const float*)d_in[1]; a.pos = (const int*)d_in[2]; a.w_ada = (const float*)d_in[3]; a.b_ada = (const float*)d_in[4];
    a.g_norm = (const float*)d_in[5]; a.w_in = (const float*)d_in[6]; a.b_ig = (const float*)d_in[7]; a.b_fg = (const float*)d_in[8]; a.w_conv = (const float*)d_in[9];
    a.b_conv = (const float*)d_in[10]; a.w_q = (const float*)d_in[11]; a.w_k = (const float*)d_in[12]; a.g_head = (const float*)d_in[13]; a.skip = (const float*)d_in[14];
    a.w_om = (const float*)d_in[15]; a.w_oa = (const float*)d_in[16]; a.w_o = (const float*)d_in[17]; a.g_final = (const float*)d_in[18];
    a.out = (float*)d_out; a.ws = (unsigned char*)d_ws;
#if MK_ONE_LAUNCH
    a.ph_lo = 0; a.ph_hi = PH_TOTAL;
    void* params[] = {&a};
    hipError_t e = hipLaunchCooperativeKernel((const void*)mk_fwd, dim3(grid), dim3(NTHR), params, LDS_BYTES, stream);
    if (e != hipSuccess) fprintf(stderr, "cooperative launch failed: %s\n", hipGetErrorString(e));
#else
#define LAUNCH(KIND, PASS) do { a.ph_lo = (PASS); a.ph_hi = 0; hipLaunchKernelGGL(k_phase<KIND>, dim3(grid), dim3(NTHR), LDS_BYTES, stream, a); } while (0)
    LAUNCH(K_PROLOGUE, 0); LAUNCH(K_H, 0);
    for (int p = 0; p < NPASS; ++p) { LAUNCH(K_INPROJ, p); LAUNCH(K_PREP, p); LAUNCH(K_CPREP, p); LAUNCH(K_MIX, p); LAUNCH(K_POST, p); LAUNCH(K_OUT1, p); LAUNCH(K_OUT2, p); }
    LAUNCH(K_NORM, 0);
#endif
}
```

```cpp
#include <hip/hip_runtime.h>
#include <hip/hip_cooperative_groups.h>
#include <cstdio>
#include <cstdint>
namespace cg = cooperative_groups;

#ifndef MK_ONE_LAUNCH
#define MK_ONE_LAUNCH 1
#endif

__device__ __forceinline__ int opaque_tid() { int t = threadIdx.x; asm volatile("" : "+v"(t)); return t; }
namespace pg8 {
#define PG8_LAS __attribute__((address_space(3)))
typedef unsigned short bf16_t;
typedef short bf16x8 __attribute__((ext_vector_type(8)));
typedef float f32x4 __attribute__((ext_vector_type(4)));
typedef unsigned u32x4 __attribute__((ext_vector_type(4)));
constexpr int BM = 256, BK = 64, HALF = 128, HTB = HALF * BK * 2, STAGE_BYTES = 8 * HTB, NXCD = 8, WGM = 8;

__host__ __device__ __forceinline__ int lds_byte(int r, int c) { const int st = (r >> 4) * 2 + (c >> 5), rr = r & 15, cc = c & 31, ob = rr * 64 + cc * 2; return st * 1024 + (ob ^ (((ob >> 9) & 1) << 5)); }
__host__ __device__ __forceinline__ void stage_rc(int b, int& R, int& C) { const int st = b / 1024, sb = b % 1024, swz = sb ^ (((sb >> 9) & 1) << 5); R = (st >> 1) * 16 + swz / 64; C = (st & 1) * 32 + (swz % 64) / 2; }
__host__ __device__ __forceinline__ int perm32(int rho) { const int n = rho >> 4, i = rho & 15; return 8 * (i >> 2) + 4 * n + (i & 3); }

struct Unit { int pm, pn, g; };
template <int LDA, int LDB, int KK, int AGS = 0, int BGS = 0> struct Gemm {
    const bf16_t* A; const bf16_t* Bt;
    static constexpr int lda = LDA, ldb = LDB, K = KK;
    __device__ __forceinline__ const char* abase(const Unit& u) const { return (const char*)A + (size_t)(u.g * AGS) + (size_t)u.pm * (size_t)(BM * 2 * LDA); }
    __device__ __forceinline__ const char* bbase(const Unit& u) const { return (const char*)Bt + (size_t)(u.g * BGS) + (size_t)u.pn * (size_t)(BM * 2 * LDB); }
};

struct StaticOrder {
    int nM, nN, nwg, G, c;
    __host__ __device__ void init(int M, int N, int G_, int c_) { nM = M / BM; nN = N / BM; nwg = nM * nN; G = G_; c = c_; }
    __host__ __device__ bool next(int i, Unit& u) const {
        const long L = (long)i * G + c; if (L >= nwg) return false;
        int wgid = (int)L; { const int q = nwg / NXCD, r = nwg % NXCD, xcd = wgid % NXCD, off = wgid / NXCD; wgid = (xcd < r ? xcd * (q + 1) : r * (q + 1) + (xcd - r) * q) + off; }
        const int nig = WGM * nN, gid = wgid / nig, fm = gid * WGM, gsz = (nM - fm) < WGM ? (nM - fm) : WGM;
        u.pm = fm + ((wgid % nig) % gsz); u.pn = (wgid % nig) / gsz; u.g = 0; return true;
    }
    __device__ __forceinline__ void a_ready(const Unit&) const {}
    __device__ __forceinline__ void done(const Unit&) const {}
};
struct GroupOrder {
    int nunits, G, c;
    __host__ __device__ void init(int M, int G_, int c_) { nunits = (M / BM) * 8; G = G_; c = c_; }
    __host__ __device__ bool next(int i, Unit& u) const {
        const long L = (long)i * G + c; if (L >= nunits) return false;
        u.pm = (int)(L >> 3); u.g = (int)((L & 7) >> 1); u.pn = (int)(L & 1); return true;
    }
    __device__ __forceinline__ void a_ready(const Unit&) const {}
    __device__ __forceinline__ void done(const Unit&) const {}
};

__device__ __forceinline__ unsigned cvt_pk_bf16(float lo, float hi) { unsigned r; asm volatile("v_cvt_pk_bf16_f32 %0, %1, %2" : "=v"(r) : "v"(lo), "v"(hi)); return r; }

template <class Epi, class Sched, bool ALIGN_EPI, bool SP2, class GemmT>
__device__ __forceinline__ void gemm_phase(PG8_LAS unsigned char* lds, const GemmT g, const Sched& S, const Epi& E) {
    const int tid = opaque_tid(), wid = __builtin_amdgcn_readfirstlane(tid >> 6), lane = tid & 63, wr = wid >> 2, wc = wid & 3, fr = lane & 15, fq = lane >> 4;
    constexpr int K = GemmT::K, nt = K / BK;
    unsigned voffA[2], voffB[2];
#pragma unroll
    for (int i = 0; i < 2; ++i) { int R, C; stage_rc(tid * 16 + i * 8192, R, C); const int Rb = Epi::PERM ? (64 * (R >> 5) + perm32(R & 31)) : R;
        voffA[i] = (unsigned)(R * g.lda + C) * 2u; voffB[i] = (unsigned)(Rb * g.ldb + C) * 2u; }
    const size_t kstep = (size_t)(BK * 2);
    const size_t hstepA = (size_t)HALF * g.lda * 2, hstepB = (size_t)(Epi::PERM ? 32 : HALF) * g.ldb * 2;
    const unsigned ldsw = (unsigned)wid * 1024u;
    const int aoff = lds_byte(wr * 64 + fr, fq * 8), boff = lds_byte(wc * 32 + fr, fq * 8);
#define PG8_SA(b, h) (((b) * 2 + (h)) * HTB)
#define PG8_SB(b, h) ((4 + (b) * 2 + (h)) * HTB)
#define PG8_STAGE(bufoff, gbase, voff) do { _Pragma("unroll") for (int _i = 0; _i < 2; ++_i) \
        __builtin_amdgcn_global_load_lds((const unsigned*)((const char*)(gbase) + (voff)[_i]), (PG8_LAS unsigned*)(lds + (bufoff) + ldsw + _i * 8192), 16, 0, 0); } while (0)
#define PG8_LDA(dst, b, h) do { _Pragma("unroll") for (int m = 0; m < 4; ++m) _Pragma("unroll") for (int k = 0; k < 2; ++k) dst[m][k] = *(const PG8_LAS bf16x8*)(lds + PG8_SA(b, h) + aoff + m * 2048 + k * 1024); } while (0)
#define PG8_LDB(dst, b, h) do { _Pragma("unroll") for (int n = 0; n < 2; ++n) _Pragma("unroll") for (int k = 0; k < 2; ++k) dst[n][k] = *(const PG8_LAS bf16x8*)(lds + PG8_SB(b, h) + boff + n * 2048 + k * 1024); } while (0)
#define PG8_MMA(ai, bj, At, Bt) do { __builtin_amdgcn_s_setprio(1); _Pragma("unroll") for (int m = 0; m < 4; ++m) _Pragma("unroll") for (int n = 0; n < 2; ++n) _Pragma("unroll") for (int k = 0; k < 2; ++k) \
        acc[ai][bj][m][n] = __builtin_amdgcn_mfma_f32_16x16x32_bf16(Bt[n][k], At[m][k], acc[ai][bj][m][n], 0, 0, 0); __builtin_amdgcn_s_setprio(0); } while (0)
#define PG8_WAIT_V(n) asm volatile("s_waitcnt vmcnt(" #n ")" ::: "memory")
#define PG8_WAIT_L(n) asm volatile("s_waitcnt lgkmcnt(" #n ")" ::: "memory")
#define PG8_BAR __builtin_amdgcn_s_barrier()
#define PG8_SCHED __builtin_amdgcn_sched_barrier(0)
    Unit cur, nxt; int ui = 0;
    if (!S.next(0, cur)) return;
    f32x4 acc[2][2][4][2];
#pragma unroll
    for (int a = 0; a < 2; ++a)
#pragma unroll
        for (int b = 0; b < 2; ++b)
#pragma unroll
            for (int m = 0; m < 4; ++m)
#pragma unroll
                for (int n = 0; n < 2; ++n) acc[a][b][m][n] = (f32x4){0.f, 0.f, 0.f, 0.f};
    bf16x8 At[4][2], B0[2][2], B1[2][2];
    const char* cA = g.abase(cur); const char* cB = g.bbase(cur);
    S.a_ready(cur);
    if constexpr (SP2) {
        PG8_STAGE(PG8_SB(0, 0), cB, voffB); PG8_STAGE(PG8_SB(0, 1), cB + hstepB, voffB); PG8_STAGE(PG8_SA(0, 0), cA, voffA); PG8_STAGE(PG8_SA(0, 1), cA + hstepA, voffA);
        if (wr == 1) PG8_BAR;
        PG8_WAIT_V(2); PG8_BAR;
        PG8_STAGE(PG8_SB(1, 0), cB + kstep, voffB); PG8_STAGE(PG8_SA(1, 0), cA + kstep, voffA); PG8_STAGE(PG8_SB(1, 1), cB + hstepB + kstep, voffB);
        PG8_WAIT_V(6); PG8_BAR;
    } else {
        PG8_STAGE(PG8_SB(0, 0), cB, voffB); PG8_STAGE(PG8_SA(0, 0), cA, voffA); PG8_STAGE(PG8_SB(0, 1), cB + hstepB, voffB); PG8_STAGE(PG8_SA(0, 1), cA + hstepA, voffA);
        if (wr == 1) PG8_BAR;
        PG8_WAIT_V(4); PG8_BAR;
        PG8_STAGE(PG8_SB(1, 0), cB + kstep, voffB); PG8_STAGE(PG8_SA(1, 0), cA + kstep, voffA); PG8_STAGE(PG8_SB(1, 1), cB + hstepB + kstep, voffB);
        PG8_WAIT_V(6); PG8_BAR;
    }
    for (;;) {
        const bool has_next = S.next(ui + 1, nxt);
        const char* nA = has_next ? g.abase(nxt) : cA; const char* nB = has_next ? g.bbase(nxt) : cB;
#pragma nounroll
        for (int t = 0; t < nt; t += 2) {
            const bool last = (t == nt - 2);
            const char* a1 = cA + (size_t)(t + 1) * kstep;
            const char* a2 = last ? nA : cA + (size_t)(t + 2) * kstep; const char* b2 = last ? nB : cB + (size_t)(t + 2) * kstep;
            const char* a3 = a2 + kstep; const char* b3 = b2 + kstep;
            if (last && has_next) S.a_ready(nxt);
            if constexpr (Epi::HOOK_T >= 0) { if (t == Epi::HOOK_T) E.hook(acc, cur, wr, wc, fr, fq); }
            if constexpr (SP2) {
            PG8_LDB(B0, 0, 0); PG8_LDB(B1, 0, 1); PG8_SCHED; PG8_LDA(At, 0, 0); PG8_STAGE(PG8_SA(1, 1), a1 + hstepA, voffA);
            PG8_WAIT_V(8); PG8_WAIT_L(0); PG8_BAR; PG8_MMA(0, 0, At, B0); PG8_MMA(0, 1, At, B1); PG8_BAR; PG8_SCHED;
            PG8_LDA(At, 0, 1); PG8_STAGE(PG8_SB(0, 0), b2, voffB); PG8_STAGE(PG8_SB(0, 1), b2 + hstepB, voffB); PG8_STAGE(PG8_SA(0, 0), a2, voffA);
            PG8_WAIT_V(8); PG8_WAIT_L(0); PG8_BAR; PG8_MMA(1, 0, At, B0); PG8_MMA(1, 1, At, B1); PG8_BAR; PG8_SCHED;
            PG8_LDB(B0, 1, 0); PG8_LDB(B1, 1, 1); PG8_SCHED; PG8_LDA(At, 1, 0); PG8_STAGE(PG8_SA(0, 1), a2 + hstepA, voffA);
            PG8_WAIT_V(8); PG8_WAIT_L(0); PG8_BAR; PG8_MMA(0, 0, At, B0); PG8_MMA(0, 1, At, B1); PG8_BAR; PG8_SCHED;
            PG8_LDA(At, 1, 1); PG8_STAGE(PG8_SB(1, 0), b3, voffB); PG8_STAGE(PG8_SB(1, 1), b3 + hstepB, voffB); PG8_STAGE(PG8_SA(1, 0), a3, voffA);
            PG8_WAIT_V(8); PG8_WAIT_L(0); PG8_BAR; PG8_MMA(1, 0, At, B0); PG8_MMA(1, 1, At, B1); PG8_BAR; PG8_SCHED;
            } else {
            PG8_LDB(B0, 0, 0); PG8_SCHED; PG8_LDA(At, 0, 0); PG8_STAGE(PG8_SA(1, 1), a1 + hstepA, voffA);
            PG8_WAIT_L(8); PG8_BAR; PG8_WAIT_L(0); PG8_MMA(0, 0, At, B0); PG8_BAR; PG8_SCHED;
            PG8_LDB(B1, 0, 1); PG8_STAGE(PG8_SB(0, 0), b2, voffB);
            PG8_BAR; PG8_WAIT_L(0); PG8_MMA(0, 1, At, B1); PG8_BAR;
            PG8_LDA(At, 0, 1); PG8_STAGE(PG8_SA(0, 0), a2, voffA);
            PG8_BAR; PG8_WAIT_L(0); PG8_MMA(1, 0, At, B0); PG8_BAR; PG8_SCHED;
            PG8_STAGE(PG8_SB(0, 1), b2 + hstepB, voffB);
            PG8_WAIT_V(6); PG8_BAR; PG8_MMA(1, 1, At, B1); PG8_BAR;
            PG8_LDB(B0, 1, 0); PG8_SCHED; PG8_LDA(At, 1, 0); PG8_STAGE(PG8_SA(0, 1), a2 + hstepA, voffA);
            PG8_WAIT_L(8); PG8_BAR; PG8_WAIT_L(0); PG8_MMA(0, 0, At, B0); PG8_BAR; PG8_SCHED;
            PG8_LDB(B1, 1, 1); PG8_STAGE(PG8_SB(1, 0), b3, voffB);
            PG8_BAR; PG8_WAIT_L(0); PG8_MMA(0, 1, At, B1); PG8_BAR;
            PG8_LDA(At, 1, 1); PG8_STAGE(PG8_SA(1, 0), a3, voffA);
            PG8_BAR; PG8_WAIT_L(0); PG8_MMA(1, 0, At, B0); PG8_BAR; PG8_SCHED;
            PG8_STAGE(PG8_SB(1, 1), b3 + hstepB, voffB);
            PG8_WAIT_V(6); PG8_BAR; PG8_MMA(1, 1, At, B1); PG8_BAR;
            }
        }
        if constexpr (ALIGN_EPI) { if (wr == 0) PG8_BAR; }
        E(acc, cur, wr, wc, fr, fq); S.done(cur);
        if (!has_next) break;
#pragma unroll
        for (int a = 0; a < 2; ++a)
#pragma unroll
            for (int b = 0; b < 2; ++b)
#pragma unroll
                for (int m = 0; m < 4; ++m)
#pragma unroll
                    for (int n = 0; n < 2; ++n) acc[a][b][m][n] = (f32x4){0.f, 0.f, 0.f, 0.f};
        cur = nxt; cA = nA; cB = nB; ++ui;
        if constexpr (ALIGN_EPI) { if (wr == 1) PG8_BAR; }
    }
    PG8_WAIT_V(0);
    if constexpr (!ALIGN_EPI) { if (wr == 0) PG8_BAR; }
    PG8_BAR;
#undef PG8_SA
#undef PG8_SB
#undef PG8_STAGE
#undef PG8_LDA
#undef PG8_LDB
#undef PG8_MMA
#undef PG8_WAIT_V
#undef PG8_WAIT_L
#undef PG8_BAR
#undef PG8_SCHED
}
}

constexpr int NWAVES = 8, NTHR = 512;
constexpr int DM = 1024, NBATCH = 16, SEQ = 4096, MALL = NBATCH * SEQ;
constexpr int NB_PASS = 4, MS = NB_PASS * SEQ, NPASS = NBATCH / NB_PASS;
constexpr int INW_SRC = 11272, INW = 11264;
constexpr int C_XA = 0, C_VA = 1024, C_OA = 2048, C_ZA = 3072, C_QA = 4096, C_KA = 5632, C_VT = 7168, C_ZB = 8704, C_GA = 9216, C_GB = 10240;
constexpr float EPS = 1e-6f;

constexpr size_t MiB = 1u << 20;
constexpr size_t WS_CTL = 0, CTL_ZERO_BYTES = 1 * MiB;
constexpr size_t WS_MOD = 1 * MiB;
constexpr size_t WS_WG = 1 * MiB + 256 * 1024;
constexpr size_t WS_WIN = 2 * MiB;
constexpr size_t WS_WQK = 24 * MiB;
constexpr size_t WS_WOM = 25 * MiB, WS_WOA = 27 * MiB, WS_WO = 28 * MiB;
constexpr size_t WS_IG = 30 * MiB, WS_FG = 31 * MiB;
constexpr size_t WS_GSC = 32 * MiB;
constexpr size_t WS_LSE = 34 * MiB;
constexpr size_t WS_DEN = 35 * MiB;
constexpr size_t WS_H = 36 * MiB;
constexpr size_t WS_P = 164 * MiB;
constexpr size_t WS_XC = 516 * MiB;
constexpr size_t WS_QM = 548 * MiB, WS_KM = 580 * MiB;
constexpr size_t WS_HR = 612 * MiB;
constexpr size_t WS_AO = 644 * MiB;
constexpr size_t WS_UA = 692 * MiB;
constexpr size_t WS_ACAT = 708 * MiB;
constexpr size_t WS_MG = 772 * MiB;
constexpr size_t WS_SG = 804 * MiB;
constexpr size_t WS_KTG = 812 * MiB;
constexpr size_t WS_VTG = 844 * MiB;
constexpr size_t WS_CS = 876 * MiB;
constexpr size_t WS_NS = 1004 * MiB;
constexpr size_t WS_ROPE = 1005 * MiB;
constexpr size_t WS_END = 1013 * MiB;
constexpr int CW_QCTR = 1024;
constexpr int CW_ROWSS = 65536;
static_assert((CW_ROWSS + MALL) * 4 <= (int)CTL_ZERO_BYTES, "ctl");

constexpr int LDS_BYTES = 147456;

typedef unsigned short bf16;
typedef float f32x4 __attribute__((ext_vector_type(4)));
typedef float f32x2 __attribute__((ext_vector_type(2)));
typedef short bf16x8 __attribute__((ext_vector_type(8)));
typedef unsigned u32x4 __attribute__((ext_vector_type(4)));
typedef unsigned u32x2 __attribute__((ext_vector_type(2)));
typedef short s16x4 __attribute__((ext_vector_type(4)));

__device__ __forceinline__ unsigned f2bf(float f) { unsigned u = __builtin_bit_cast(unsigned, f); return (u + 0x7fffu + ((u >> 16) & 1u)) >> 16; }
__device__ __forceinline__ unsigned pk2(float lo, float hi) { return f2bf(lo) | (f2bf(hi) << 16); }
__device__ __forceinline__ float bflo(unsigned w) { return __builtin_bit_cast(float, w << 16); }
__device__ __forceinline__ float bfhi(unsigned w) { return __builtin_bit_cast(float, w & 0xffff0000u); }
__device__ __forceinline__ float bf1(bf16 v) { return __builtin_bit_cast(float, (unsigned)v << 16); }
__device__ __forceinline__ float sigmoidf_(float x) { return 1.f / (1.f + __expf(-x)); }
__device__ __forceinline__ float siluf_(float x) { return x / (1.f + __expf(-x)); }
__device__ __forceinline__ float wave_sum(float v) {
#pragma unroll
    for (int o = 1; o < 64; o <<= 1) v += __shfl_xor(v, o);
    return v;
}
__device__ __forceinline__ void unpack8(const u32x4 w, float* f) {
    f[0] = bflo(w.x); f[1] = bfhi(w.x); f[2] = bflo(w.y); f[3] = bfhi(w.y); f[4] = bflo(w.z); f[5] = bfhi(w.z); f[6] = bflo(w.w); f[7] = bfhi(w.w);
}

struct Args {
    const float* x; const float* c; const int* pos; const float* w_ada; const float* b_ada; const float* g_norm; const float* w_in;
    const float* b_ig; const float* b_fg; const float* w_conv; const float* b_conv; const float* w_q; const float* w_k; const float* g_head;
    const float* skip; const float* w_om; const float* w_oa; const float* w_o; const float* g_final;
    float* out; unsigned char* ws; int ph_lo, ph_hi;
};

__device__ __forceinline__ void transpose_item(const float* W, int K, int Nsrc, int nblk, int src_col_off, bf16* WT, int ldt, int row_off, float scale, float* scr, int item, int lane, bool frag = false) {
    const int kb = item / nblk, nb = item % nblk, k0 = 64 * kb, n0 = 32 * nb;
#pragma unroll 8
    for (int i = 0; i < 32; ++i) { const int kk = 2 * i + (lane >> 5); scr[kk * 33 + (lane & 31)] = W[(size_t)(k0 + kk) * Nsrc + src_col_off + n0 + (lane & 31)]; }
    __builtin_amdgcn_wave_barrier();
    asm volatile("s_waitcnt lgkmcnt(0)" ::: "memory");
    const int cc = lane & 7;
#pragma unroll
    for (int j = 0; j < 4; ++j) { const int n = (lane >> 3) + 8 * j; const float* s = scr + (8 * cc) * 33 + n;
        u32x4 o; o.x = pk2(s[0 * 33] * scale, s[1 * 33] * scale); o.y = pk2(s[2 * 33] * scale, s[3 * 33] * scale); o.z = pk2(s[4 * 33] * scale, s[5 * 33] * scale); o.w = pk2(s[6 * 33] * scale, s[7 * 33] * scale);
        if (frag) { const int nn = row_off + n0 + n, kc = (k0 >> 3) + cc; *(u32x4*)(WT + (size_t)((((nn >> 4) * (K >> 5) + (kc >> 2)) * 64 + (kc & 3) * 16 + (nn & 15)) * 8)) = o; }
        else *(u32x4*)(WT + (size_t)(row_off + n0 + n) * ldt + k0 + 8 * cc) = o; }
    asm volatile("s_waitcnt lgkmcnt(0)" ::: "memory");
    __builtin_amdgcn_wave_barrier();
}

__device__ __forceinline__ void phase_prologue(const Args& a, unsigned char* lds, int vcu, int G) {
    const int tid = opaque_tid(), lane = tid & 63, wave = tid >> 6;
    unsigned char* ws = a.ws;
    if (vcu < 192) {
        float* sc = (float*)lds;
        float* red = (float*)(lds + 65536);
        for (int i = tid; i < 16 * 1024; i += NTHR) sc[i] = siluf_(a.c[i]);
        __syncthreads();
        const int col = lane & 15, ksub = lane >> 4, n = vcu * 16 + col;
        float acc[16];
#pragma unroll
        for (int b = 0; b < 16; ++b) acc[b] = 0.f;
        const int k0 = wave * 128 + ksub * 32;
        const float* wp = a.w_ada + (size_t)k0 * 3072 + n;
#pragma unroll 1
        for (int kc = 0; kc < 8; ++kc) {
            const float w0 = wp[(size_t)(4 * kc) * 3072], w1 = wp[(size_t)(4 * kc + 1) * 3072], w2 = wp[(size_t)(4 * kc + 2) * 3072], w3 = wp[(size_t)(4 * kc + 3) * 3072];
#pragma unroll
            for (int b = 0; b < 16; ++b) { const f32x4 s4 = *(const f32x4*)(sc + b * 1024 + k0 + 4 * kc); acc[b] += (s4.x * w0 + s4.y * w1) + (s4.z * w2 + s4.w * w3); }
        }
#pragma unroll
        for (int b = 0; b < 16; ++b) { float v = acc[b]; v += __shfl_xor(v, 16); v += __shfl_xor(v, 32); if (ksub == 0) red[(wave * 16 + b) * 16 + col] = v; }
        __syncthreads();
        float* mod = (float*)(ws + WS_MOD);
        if (tid < 256) { const int b = tid >> 4, l = tid & 15, nn = vcu * 16 + l; float s_ = 0.f;
#pragma unroll
            for (int w = 0; w < 8; ++w) s_ += red[(w * 16 + b) * 16 + l];
            s_ += a.b_ada[nn];
            const int part = nn >> 10, cc = nn & 1023;
            if (part == 1) s_ = a.g_norm[cc] * (1.f + s_);
            mod[b * 3072 + nn] = s_; }
        __syncthreads();
    }
    {
        float* scr = (float*)lds + wave * (64 * 33);
        const int gw = vcu * NWAVES + wave, NGW = G * NWAVES;
        constexpr int I_IN = (1024 / 64) * (INW / 32);
        constexpr int I_QK = 8 * (256 / 64) * (256 / 32);
        constexpr int I_OM = 16 * 32, I_OA = 8 * 32, I_O = 16 * 32;
        constexpr int NITEMS = I_IN + I_QK + I_OM + I_OA + I_O;
        for (int it = gw; it < NITEMS; it += NGW) {
            int r = it;
            if (r < I_IN) { const int nb = r % (INW / 32); const int off = (nb * 32 >= 4096) ? 8 : 0;
                transpose_item(a.w_in, 1024, INW_SRC, INW / 32, off, (bf16*)(ws + WS_WIN), 1024, 0, 1.f, scr, r, lane); continue; } r -= I_IN;
            if (r < I_QK) { const int mtx = r >> 5, rr = r & 31, h = mtx >> 1, isk = mtx & 1;
                const float* W = (isk ? a.w_k : a.w_q) + (size_t)h * 65536;
                transpose_item(W, 256, 256, 8, 0, (bf16*)(ws + WS_WQK) + (size_t)h * 512 * 256, 256, isk * 256, isk ? 0.0625f : 1.f, scr, rr, lane, true); continue; } r -= I_QK;
            if (r < I_OM) { transpose_item(a.w_om, 1024, 1024, 32, 0, (bf16*)(ws + WS_WOM), 1536, 0, 1.f, scr, r, lane); continue; } r -= I_OM;
            if (r < I_OA) { transpose_item(a.w_oa, 512, 1024, 32, 0, (bf16*)(ws + WS_WOM) + 1024, 1536, 0, 1.f, scr, r, lane); continue; } r -= I_OA;
            transpose_item(a.w_o, 1024, 1024, 32, 0, (bf16*)(ws + WS_WO), 1024, 0, 1.f, scr, r, lane);
        }
        float* wg = (float*)(ws + WS_WG);
        for (int i = (vcu * NTHR + tid); i < 8 * 1024; i += G * NTHR) { const int j = i >> 10, k = i & 1023; wg[i] = a.w_in[(size_t)k * INW_SRC + 4096 + j]; }
    }
}

__constant__ double c_inv_freq[16] = {1.0, 0.44036660267178046, 0.19392274474868576, 0.08539710028576561, 0.03760603093086393, 0.016560440080994446, 0.007292664737217109, 0.003211445994752591,
    0.001414213562373095, 0.000622772421914596, 0.0002742481756762073, 0.00012076973741146504, 5.318295896944988e-05, 2.341999896140934e-05, 1.031338537721246e-05, 4.5416704806078695e-06};

__device__ __forceinline__ void phase_h(const Args& a, unsigned char* lds, int vcu, int G) {
    const int tid = opaque_tid(), lane = tid & 63, wave = tid >> 6;
    unsigned char* ws = a.ws;
    float* wg = (float*)lds;
    { const float* src = (const float*)(ws + WS_WG); for (int i = tid; i < 8192; i += NTHR) wg[i] = src[i]; }
    __syncthreads();
    const float* mod = (const float*)(ws + WS_MOD);
    bf16* H = (bf16*)(ws + WS_H);
    float* IG = (float*)(ws + WS_IG); float* FG = (float*)(ws + WS_FG); float* ROPE = (float*)(ws + WS_ROPE);
    const int gw = vcu * NWAVES + wave, NGW = G * NWAVES;
    for (int row0 = 2 * gw; row0 < MALL; row0 += 2 * NGW) {
        f32x4 v[2][4]; float ss[2] = {0.f, 0.f};
#pragma unroll
        for (int rr = 0; rr < 2; ++rr) { const f32x4* xr = (const f32x4*)(a.x + (size_t)(row0 + rr) * DM) + lane;
#pragma unroll
            for (int j = 0; j < 4; ++j) v[rr][j] = xr[64 * j]; }
        { const int rr = lane >> 5, fi = lane & 15; const int pos = a.pos[row0 + rr];
            const double rev = (double)pos * c_inv_freq[fi] * 0.15915494309189535; const float fr_ = (float)(rev - rint(rev));
            ROPE[(size_t)row0 * 32 + lane] = (lane & 16) ? __builtin_amdgcn_sinf(fr_) : __builtin_amdgcn_cosf(fr_); }
#pragma unroll
        for (int rr = 0; rr < 2; ++rr) {
#pragma unroll
            for (int j = 0; j < 4; ++j) ss[rr] += (v[rr][j].x * v[rr][j].x + v[rr][j].y * v[rr][j].y) + (v[rr][j].z * v[rr][j].z + v[rr][j].w * v[rr][j].w);
        }
#pragma unroll
        for (int o = 1; o < 64; o <<= 1) { ss[0] += __shfl_xor(ss[0], o); ss[1] += __shfl_xor(ss[1], o); }
        const int b = row0 >> 12;
        float pg[2][8];
#pragma unroll
        for (int rr = 0; rr < 2; ++rr)
#pragma unroll
            for (int g = 0; g < 8; ++g) pg[rr][g] = 0.f;
        const float rinv[2] = {1.f / sqrtf(ss[0] * (1.f / DM) + EPS), 1.f / sqrtf(ss[1] * (1.f / DM) + EPS)};
#pragma unroll
        for (int j = 0; j < 4; ++j) {
            const int col = 4 * lane + 256 * j;
            const f32x4 sh = *(const f32x4*)(mod + b * 3072 + col), gs = *(const f32x4*)(mod + b * 3072 + 1024 + col);
            f32x4 h[2];
#pragma unroll
            for (int rr = 0; rr < 2; ++rr) { h[rr] = v[rr][j] * rinv[rr] * gs + sh;
                u32x2 o; o.x = pk2(h[rr].x, h[rr].y); o.y = pk2(h[rr].z, h[rr].w); *((u32x2*)(H + (size_t)(row0 + rr) * DM) + lane + 64 * j) = o; }
#pragma unroll
            for (int g = 0; g < 8; ++g) { const f32x4 w = *(const f32x4*)(wg + g * 1024 + col);
                pg[0][g] += (h[0].x * w.x + h[0].y * w.y) + (h[0].z * w.z + h[0].w * w.w); pg[1][g] += (h[1].x * w.x + h[1].y * w.y) + (h[1].z * w.z + h[1].w * w.w); }
            __builtin_amdgcn_sched_barrier(0);
        }
#pragma unroll
        for (int o = 1; o < 64; o <<= 1)
#pragma unroll
            for (int g = 0; g < 8; ++g) { pg[0][g] += __shfl_xor(pg[0][g], o); pg[1][g] += __shfl_xor(pg[1][g], o); }
        if (lane < 2) { const int rr = lane; const float* p = rr ? pg[1] : pg[0];
            f32x4 ig = {p[0] + a.b_ig[0], p[1] + a.b_ig[1], p[2] + a.b_ig[2], p[3] + a.b_ig[3]};
            f32x4 fg = {p[4] + a.b_fg[0], p[5] + a.b_fg[1], p[6] + a.b_fg[2], p[7] + a.b_fg[3]};
            *(f32x4*)(IG + (size_t)(row0 + rr) * 4) = ig; *(f32x4*)(FG + (size_t)(row0 + rr) * 4) = fg; }
    }
}

struct EpiProj {
    static constexpr bool PERM = true; static constexpr int HOOK_T = -1;
    bf16* P; const float* rope;
    __device__ __forceinline__ void operator()(const f32x4 (&acc)[2][2][4][2], const pg8::Unit& u, int wr, int wc, int fr, int fq) const {
        const int row0 = u.pm * 256 + wr * 64 + fr, col0 = u.pn * 256 + wc * 64 + 8 * fq;
        const bool rot = (u.pn >= 16) && (u.pn < 28) && ((wc & 1) == 0);
#pragma unroll
        for (int ai = 0; ai < 2; ++ai)
#pragma unroll
            for (int m = 0; m < 4; ++m) { const int r = row0 + ai * 128 + m * 16; bf16* rowp = P + (size_t)r * INW + col0;
#pragma unroll
                for (int bj = 0; bj < 2; ++bj) { f32x4 v0 = acc[ai][bj][m][0], v1 = acc[ai][bj][m][1];
                    if (bj == 0 && rot) {
                        const float* tp = rope + (size_t)r * 32 + 8 * (fq & 1);
                        const f32x4 c0 = *(const f32x4*)tp, c1 = *(const f32x4*)(tp + 4), s0 = *(const f32x4*)(tp + 16), s1 = *(const f32x4*)(tp + 20);
                        f32x4 p0, p1;
#pragma unroll
                        for (int e = 0; e < 4; ++e) { p0[e] = __shfl_xor(v0[e], 32); p1[e] = __shfl_xor(v1[e], 32); }
                        const float sg = (fq < 2) ? -1.f : 1.f;
                        v0 = v0 * c0 + p0 * s0 * sg; v1 = v1 * c1 + p1 * s1 * sg;
                    }
                    u32x4 w; w.x = pg8::cvt_pk_bf16(v0[0], v0[1]); w.y = pg8::cvt_pk_bf16(v0[2], v0[3]); w.z = pg8::cvt_pk_bf16(v1[0], v1[1]); w.w = pg8::cvt_pk_bf16(v1[2], v1[3]);
                    *(u32x4*)(rowp + bj * 32) = w; } }
    }
};
struct EpiQK {
    static constexpr bool PERM = true; static constexpr int HOOK_T = -1;
    bf16* QM; bf16* KM;
    __device__ __forceinline__ void operator()(const f32x4 (&acc)[2][2][4][2], const pg8::Unit& u, int wr, int wc, int fr, int fq) const {
        const int row0 = u.pm * 256 + wr * 64 + fr, col0 = u.g * 256 + wc * 64 + 8 * fq;
        bf16* base = u.pn ? KM : QM;
#pragma unroll
        for (int ai = 0; ai < 2; ++ai)
#pragma unroll
            for (int m = 0; m < 4; ++m) { bf16* rowp = base + (size_t)(row0 + ai * 128 + m * 16) * 1024 + col0;
#pragma unroll
                for (int bj = 0; bj < 2; ++bj) { const f32x4 v0 = acc[ai][bj][m][0], v1 = acc[ai][bj][m][1];
                    u32x4 w; w.x = pg8::cvt_pk_bf16(v0[0], v0[1]); w.y = pg8::cvt_pk_bf16(v0[2], v0[3]); w.z = pg8::cvt_pk_bf16(v1[0], v1[1]); w.w = pg8::cvt_pk_bf16(v1[2], v1[3]);
                    *(u32x4*)(rowp + bj * 32) = w; } }
    }
};
struct EpiMerge {
    static constexpr bool PERM = true; static constexpr int HOOK_T = 16;
    const bf16* P; bf16* MG;
    __device__ __forceinline__ void hook(f32x4 (&acc)[2][2][4][2], const pg8::Unit& u, int wr, int wc, int fr, int fq) const {
        int row0 = u.pm * 256 + wr * 64 + fr, col0 = u.pn * 256 + wc * 64 + 8 * fq;
        asm volatile("" : "+v"(row0), "+v"(col0));
#pragma unroll
        for (int ai = 0; ai < 2; ++ai)
#pragma unroll
            for (int m = 0; m < 4; ++m) { const size_t r = (size_t)(row0 + ai * 128 + m * 16);
#pragma unroll
                for (int bj = 0; bj < 2; ++bj) { const int c = col0 + bj * 32;
                    const u32x4 gaw = *(const u32x4*)(P + r * INW + C_GA + c), gbw = *(const u32x4*)(P + r * INW + C_GB + c);
                    float ga[8], gb[8]; unpack8(gaw, ga); unpack8(gbw, gb);
#pragma unroll
                    for (int e = 0; e < 4; ++e) {
                        acc[ai][bj][m][0][e] *= (1.f + __expf(-gb[e])) / (1.f + __expf(-ga[e]));
                        acc[ai][bj][m][1][e] *= (1.f + __expf(-gb[4 + e])) / (1.f + __expf(-ga[4 + e])); } }
                __builtin_amdgcn_sched_barrier(0); }
    }
    __device__ __forceinline__ void operator()(const f32x4 (&acc)[2][2][4][2], const pg8::Unit& u, int wr, int wc, int fr, int fq) const {
        const int row0 = u.pm * 256 + wr * 64 + fr, col0 = u.pn * 256 + wc * 64 + 8 * fq;
#pragma unroll
        for (int ai = 0; ai < 2; ++ai)
#pragma unroll
            for (int m = 0; m < 4; ++m) { const size_t r = (size_t)(row0 + ai * 128 + m * 16);
#pragma unroll
                for (int bj = 0; bj < 2; ++bj) { const int c = col0 + bj * 32;
                    const u32x4 gbw = *(const u32x4*)(P + r * INW + C_GB + c); float gb[8]; unpack8(gbw, gb);
                    const f32x4 v0 = acc[ai][bj][m][0], v1 = acc[ai][bj][m][1];
                    float o[8];
#pragma unroll
                    for (int e = 0; e < 4; ++e) { o[e] = sigmoidf_(gb[e]) * v0[e]; o[4 + e] = sigmoidf_(gb[4 + e]) * v1[e]; }
                    u32x4 w; w.x = pg8::cvt_pk_bf16(o[0], o[1]); w.y = pg8::cvt_pk_bf16(o[2], o[3]); w.z = pg8::cvt_pk_bf16(o[4], o[5]); w.w = pg8::cvt_pk_bf16(o[6], o[7]);
                    *(u32x4*)(MG + r * 1024 + c) = w; } }
    }
};
struct EpiOut {
    static constexpr bool PERM = true; static constexpr int HOOK_T = -1;
    bf16* dl; const float* gate; int grow0;
    __device__ __forceinline__ void operator()(const f32x4 (&acc)[2][2][4][2], const pg8::Unit& u, int wr, int wc, int fr, int fq) const {
        const int row0 = grow0 + u.pm * 256 + wr * 64 + fr, col0 = u.pn * 256 + wc * 64 + 8 * fq;
        const int b = row0 >> 12;
#pragma unroll
        for (int ai = 0; ai < 2; ++ai)
#pragma unroll
            for (int m = 0; m < 4; ++m) { const int r = row0 + ai * 128 + m * 16;
#pragma unroll
                for (int bj = 0; bj < 2; ++bj) { const int c = col0 + bj * 32;
                    const float* gp = gate + b * 3072 + c; const f32x4 g0 = *(const f32x4*)gp, g1 = *(const f32x4*)(gp + 4);
                    const f32x4 o0 = g0 * acc[ai][bj][m][0], o1 = g1 * acc[ai][bj][m][1];
                    u32x4 w; w.x = pg8::cvt_pk_bf16(o0[0], o0[1]); w.y = pg8::cvt_pk_bf16(o0[2], o0[3]); w.z = pg8::cvt_pk_bf16(o1[0], o1[1]); w.w = pg8::cvt_pk_bf16(o1[2], o1[3]);
                    *(u32x4*)(dl + (size_t)r * 1024 + c) = w; } }
    }
};

struct ComboOrder {
    pg8::StaticOrder so, si; int nO, G, c;
    __device__ void init(int G_, int c_) { G = G_; c = c_; so.init(MS, 1024, 1, 0); si.init(MS, INW, 1, 0); nO = so.nwg; }
    __device__ bool next(int i, pg8::Unit& u) const {
        const int L = i * G + c;
        if (L < nO) { so.next(L, u); u.g = 0; return true; }
        if (!si.next(L - nO, u)) return false;
        u.g = 1; return true;
    }
    __device__ __forceinline__ void a_ready(const pg8::Unit&) const {}
    __device__ __forceinline__ void done(const pg8::Unit&) const {}
};
struct GemmCombo {
    const bf16* A0; const bf16* B0; const bf16* A1; const bf16* B1;
    static constexpr int lda = 1024, ldb = 1024, K = 1024;
    __device__ __forceinline__ const char* abase(const pg8::Unit& u) const { return (const char*)(u.g ? A1 : A0) + (size_t)u.pm * (size_t)(pg8::BM * 2 * 1024); }
    __device__ __forceinline__ const char* bbase(const pg8::Unit& u) const { return (const char*)(u.g ? B1 : B0) + (size_t)u.pn * (size_t)(pg8::BM * 2 * 1024); }
};
struct EpiCombo {
    static constexpr bool PERM = true; static constexpr int HOOK_T = -1;
    EpiOut eo; EpiProj ep;
    __device__ __forceinline__ void operator()(const f32x4 (&acc)[2][2][4][2], const pg8::Unit& u, int wr, int wc, int fr, int fq) const {
        if (u.g) ep(acc, u, wr, wc, fr, fq); else eo(acc, u, wr, wc, fr, fq);
    }
};

__device__ __forceinline__ void phase_prep(const Args& a, unsigned char* lds, int vcu, int G, int pass) {
    const int tid = opaque_tid(), lane = tid & 63, wave = tid >> 6;
    unsigned char* ws = a.ws;
    bf16* P = (bf16*)(ws + WS_P);
    if (vcu < NB_PASS * 4) {
        const int bl = vcu >> 2, h = vcu & 3;
        const float* IG = (const float*)(ws + WS_IG); const float* FG = (const float*)(ws + WS_FG);
        float* gsc = (float*)(ws + WS_GSC);
        float* A1 = gsc, *B1 = gsc + MS * 4, *WI = gsc + 2 * MS * 4, *EF = gsc + 3 * MS * 4, *WK = gsc + 4 * MS * 4, *DEC = gsc + 5 * MS * 4;
        float* cg = (float*)lds; float* cp = cg + 64;
        float f[8], ii[8];
#pragma unroll
        for (int q = 0; q < 8; ++q) { const size_t grow = (size_t)pass * MS + bl * SEQ + (wave * 8 + q) * 64 + lane; f[q] = FG[grow * 4 + h]; ii[q] = IG[grow * 4 + h]; }
        float acs[8], b1[8], pm[8];
#pragma unroll
        for (int q = 0; q < 8; ++q) {
            float x = fminf(f[q], 0.f) - log1pf(expf(-fabsf(f[q])));
#pragma unroll
            for (int o = 1; o < 64; o <<= 1) { const float t = __shfl_up(x, o); if (lane >= o) x += t; }
            acs[q] = x; b1[q] = ii[q] - x;
            float m = b1[q];
#pragma unroll
            for (int o = 1; o < 64; o <<= 1) { const float t = __shfl_up(m, o); if (lane >= o) m = fmaxf(m, t); }
            pm[q] = m;
            if (lane == 63) { cg[wave * 8 + q] = x; cp[wave * 8 + q] = m; }
        }
        __syncthreads();
        float m_prev = 0.f, mp[8], Ms8[8];
        for (int j = 0; j < 64; ++j) { const float Ms = fmaxf(m_prev, cp[j]);
#pragma unroll
            for (int q = 0; q < 8; ++q) if (j == wave * 8 + q) { mp[q] = m_prev; Ms8[q] = Ms; }
            m_prev = cg[j] + Ms; }
#pragma unroll
        for (int q = 0; q < 8; ++q) {
            const int j = wave * 8 + q, lrow = bl * SEQ + j * 64 + lane;
            const float mx = fmaxf(mp[q], pm[q]);
            A1[h * MS + lrow] = -mx; B1[h * MS + lrow] = b1[q]; WI[h * MS + lrow] = expf(mp[q] - mx); EF[h * MS + lrow] = expf(-(acs[q] + mx)); WK[h * MS + lrow] = expf(b1[q] - Ms8[q]);
            if (lane == 0) { DEC[h * (MS / 64) + bl * 64 + j] = expf(mp[q] - Ms8[q]); DEC[4 * (MS / 64) + h * (MS / 64) + bl * 64 + j] = Ms8[q]; }
        }
    }
    {
        bf16* XC = (bf16*)(ws + WS_XC);
        const int cg8 = (tid & 127) * 8, rq = tid >> 7;
        float wc[4][8], bc[8];
#pragma unroll
        for (int j = 0; j < 4; ++j)
#pragma unroll
            for (int e = 0; e < 8; ++e) wc[j][e] = a.w_conv[j * 1024 + cg8 + e];
#pragma unroll
        for (int e = 0; e < 8; ++e) bc[e] = a.b_conv[cg8 + e];
        for (int it = vcu; it < MS / 32; it += G) {
            const int r0 = it * 32 + rq * 8, t0 = r0 & (SEQ - 1);
            u32x4 w[11];
#pragma unroll
            for (int k = 0; k < 11; ++k) { const int rr = r0 - 3 + k; w[k] = (k >= 3 || t0 >= 3) ? *(const u32x4*)(P + (size_t)rr * INW + C_XA + cg8) : (u32x4){0u, 0u, 0u, 0u}; }
            float xin[11][8];
#pragma unroll
            for (int k = 0; k < 11; ++k) unpack8(w[k], xin[k]);
#pragma unroll
            for (int k = 0; k < 8; ++k) { float o[8];
#pragma unroll
                for (int e = 0; e < 8; ++e) o[e] = siluf_(bc[e] + wc[0][e] * xin[k][e] + wc[1][e] * xin[k + 1][e] + wc[2][e] * xin[k + 2][e] + wc[3][e] * xin[k + 3][e]);
                u32x4 ov; ov.x = pk2(o[0], o[1]); ov.y = pk2(o[2], o[3]); ov.z = pk2(o[4], o[5]); ov.w = pk2(o[6], o[7]);
                *(u32x4*)(XC + (size_t)(r0 + k) * 1024 + cg8) = ov; }
        }
    }
}

__device__ __forceinline__ f32x4 mfma16(bf16x8 a, bf16x8 b, f32x4 c) { return __builtin_amdgcn_mfma_f32_16x16x32_bf16(a, b, c, 0, 0, 0); }

constexpr int TPS = 72;
constexpr int XCS = 264;
constexpr int L_QC_X = 0, L_QC_Q = 36864, L_QC_KT = L_QC_Q + 64 * XCS * 2, L_QC_ST = L_QC_KT + 256 * TPS * 2, L_QC_END = L_QC_ST + 64 * TPS * 2;
static_assert(64 * XCS * 2 <= 36864 && 256 * TPS * 2 <= 36864 && L_QC_END <= 131072, "qkc lds");
__device__ __forceinline__ void phase_cprep(const Args& a, unsigned char* lds, int vcu, int G) {
    const int tid = opaque_tid(), lane = tid & 63, wave = __builtin_amdgcn_readfirstlane(tid >> 6);
    const int fr = lane & 15, fq = lane >> 4;
    unsigned char* ws = a.ws;
    const bf16* P = (const bf16*)(ws + WS_P); const bf16* XC = (const bf16*)(ws + WS_XC); bf16* QM = (bf16*)(ws + WS_QM);
    const bf16* WF = (const bf16*)(ws + WS_WQK);
    const float* gsc = (const float*)(ws + WS_GSC);
    const float* gA1 = gsc, *gWK = gsc + 4 * MS * 4, *gMS = gsc + 5 * MS * 4 + 4 * (MS / 64);
    bf16* SG = (bf16*)(ws + WS_SG); bf16* KTG = (bf16*)(ws + WS_KTG); bf16* VTG = (bf16*)(ws + WS_VTG);
    bf16* XS = (bf16*)(lds + L_QC_X); bf16* VT = (bf16*)(lds + L_QC_X); bf16* QL = (bf16*)(lds + L_QC_Q); bf16* KT = (bf16*)(lds + L_QC_KT); bf16* ST = (bf16*)(lds + L_QC_ST);
    const int ti = wave >> 1, tj0 = 2 * (wave & 1);
    for (int ci = vcu; ci < (MS / 64) * 4; ci += G) {
        const int h = ci & 3, t0 = (ci >> 2) * 64;
        u32x4 xw[4], vw[4];
#pragma unroll
        for (int i = 0; i < 4; ++i) { const int c = tid + NTHR * i, row = c >> 5, cc = c & 31;
            xw[i] = *(const u32x4*)(XC + (size_t)(t0 + row) * 1024 + h * 256 + 8 * cc); }
#pragma unroll
        for (int i = 0; i < 4; ++i) { const int c = tid + NTHR * i, l = c & 63, dc = c >> 6;
            vw[i] = *(const u32x4*)(P + (size_t)(t0 + l) * INW + C_VA + h * 256 + 8 * dc); }
        float wkr[4][4], a1l[4];
        if (wave >= 4) {
#pragma unroll
            for (int lt = 0; lt < 4; ++lt)
#pragma unroll
                for (int i = 0; i < 4; ++i) wkr[lt][i] = gWK[h * MS + t0 + 16 * lt + 4 * fq + i];
        }
#pragma unroll
        for (int i = 0; i < 4; ++i) a1l[i] = gA1[h * MS + t0 + 16 * ti + 4 * fq + i];
        const float msc = gMS[h * (MS / 64) + (ci >> 2)];
        __syncthreads();
#pragma unroll
        for (int i = 0; i < 4; ++i) { const int c = tid + NTHR * i, row = c >> 5, cc = c & 31; *(u32x4*)(XS + row * XCS + 8 * cc) = xw[i]; }
        __syncthreads();
        const bf16* wf = WF + (size_t)h * 512 * 256;
#pragma unroll 1
        for (int ct = 0; ct < 4; ++ct) {
            const int nt = 4 * wave + ct;
            bf16x8 bq[8];
#pragma unroll
            for (int ks = 0; ks < 8; ++ks) bq[ks] = *(const bf16x8*)(wf + (size_t)((nt * 8 + ks) * 64 + lane) * 8);
#pragma unroll
            for (int lt = 0; lt < 4; ++lt) {
                f32x4 acc = {0.f, 0.f, 0.f, 0.f};
#pragma unroll
                for (int ks = 0; ks < 8; ++ks) { const bf16x8 af = *(const bf16x8*)(XS + (16 * lt + fr) * XCS + 32 * ks + 8 * fq); acc = mfma16(af, bq[ks], acc); }
                if (wave < 4) {
#pragma unroll
                    for (int i = 0; i < 4; ++i) QL[(16 * lt + 4 * fq + i) * XCS + 64 * wave + 16 * ct + fr] = (bf16)f2bf(acc[i]);
                } else {
                    const int d = 64 * (wave - 4) + 16 * ct + fr;
                    u32x2 o; o.x = pk2(acc[0] * wkr[lt][0], acc[1] * wkr[lt][1]); o.y = pk2(acc[2] * wkr[lt][2], acc[3] * wkr[lt][3]);
                    *(u32x2*)(KT + d * TPS + 16 * lt + 4 * fq) = o;
                }
            }
        }
        __syncthreads();
#pragma unroll
        for (int i = 0; i < 4; ++i) { const int c = tid + NTHR * i, l = c & 63, dc = c >> 6;
            const u32x4 w = vw[i]; bf16* dv = VT + (8 * dc) * TPS + l;
            dv[0 * TPS] = (bf16)(w.x & 0xffff); dv[1 * TPS] = (bf16)(w.x >> 16); dv[2 * TPS] = (bf16)(w.y & 0xffff); dv[3 * TPS] = (bf16)(w.y >> 16);
            dv[4 * TPS] = (bf16)(w.z & 0xffff); dv[5 * TPS] = (bf16)(w.z >> 16); dv[6 * TPS] = (bf16)(w.w & 0xffff); dv[7 * TPS] = (bf16)(w.w >> 16); }
#pragma unroll
        for (int i = 0; i < 4; ++i) { const int c = tid + NTHR * i, row = c >> 5, cc = c & 31;
            *(u32x4*)(QM + (size_t)(t0 + row) * 1024 + h * 256 + 8 * cc) = *(const u32x4*)(QL + row * XCS + 8 * cc); }
#pragma unroll
        for (int tt = 0; tt < 2; ++tt) {
            const int tj = tj0 + tt;
            f32x4 sacc = {0.f, 0.f, 0.f, 0.f};
            if (tj <= ti) {
#pragma unroll
                for (int ks = 0; ks < 8; ++ks) {
                    const bf16x8 qf = *(const bf16x8*)(QL + (16 * ti + fr) * XCS + 32 * ks + 8 * fq);
                    const bf16* kp = KT + (32 * ks + 8 * fq + (fr >> 2)) * TPS + 16 * tj + 4 * (fr & 3);
                    const s16x4 k0 = __builtin_amdgcn_ds_read_tr16_b64_v4i16((__attribute__((address_space(3))) s16x4*)(kp));
                    const s16x4 k1 = __builtin_amdgcn_ds_read_tr16_b64_v4i16((__attribute__((address_space(3))) s16x4*)(kp + 4 * TPS));
                    bf16x8 kb; kb[0] = k0[0]; kb[1] = k0[1]; kb[2] = k0[2]; kb[3] = k0[3]; kb[4] = k1[0]; kb[5] = k1[1]; kb[6] = k1[2]; kb[7] = k1[3];
                    sacc = mfma16(qf, kb, sacc); }
            }
            const int sidx = 16 * tj + fr;
#pragma unroll
            for (int i = 0; i < 4; ++i) { const int l = 16 * ti + 4 * fq + i;
                float v = 0.f;
                if (sidx <= l) v = sacc[i] * __expf(a1l[i] + msc);
                ST[l * TPS + sidx] = (bf16)f2bf(v); }
        }
        __syncthreads();
        { const int row = tid >> 3, ch = tid & 7; *(u32x4*)(SG + (size_t)ci * 4096 + row * 64 + 8 * ch) = *(const u32x4*)(ST + row * TPS + 8 * ch); }
#pragma unroll
        for (int i = 0; i < 4; ++i) { const int p = tid + NTHR * i, blk = p >> 6, ln = p & 63, row = (blk >> 1) * 16 + (ln & 15), ch = (blk & 1) * 4 + (ln >> 4);
            *(u32x4*)(KTG + (size_t)ci * 16384 + p * 8) = *(const u32x4*)(KT + row * TPS + 8 * ch);
            *(u32x4*)(VTG + (size_t)ci * 16384 + p * 8) = *(const u32x4*)(VT + row * TPS + 8 * ch); }
    }
}

constexpr int SA_DEPTH = 5, SA_PATCH = 32 * 32 * 2 + 128;
struct ScanA { const bf16* KTG; const bf16* VTG; const float* gDEC; bf16* CS; float* NS; int bl, h, dblk, eblk, wave, fr, fq; unsigned koff, voff; bool do_den; };
struct ScanAOps { bf16x8 k[2][2], v[2][2]; float decay; };
__device__ __forceinline__ void scana_load(const ScanA& c, int j, ScanAOps& o) {
    const int ci = (c.bl * 64 + j) * 4 + c.h;
    const bf16* kb = c.KTG + (size_t)ci * 16384; const bf16* vb = c.VTG + (size_t)ci * 16384;
#pragma unroll
    for (int dt = 0; dt < 2; ++dt)
#pragma unroll
        for (int k2 = 0; k2 < 2; ++k2) o.k[dt][k2] = *(const bf16x8*)(kb + (c.koff + (unsigned)((dt * 2 + k2) * 512)));
#pragma unroll
    for (int et = 0; et < 2; ++et)
#pragma unroll
        for (int k2 = 0; k2 < 2; ++k2) o.v[et][k2] = *(const bf16x8*)(vb + (c.voff + (unsigned)((et * 2 + k2) * 512)));
    o.decay = c.gDEC[c.h * (MS / 64) + c.bl * 64 + j];
}
__device__ __forceinline__ void scana_step(const ScanA& c, unsigned char* lds, int j, f32x4 (&Cacc)[2][2], f32x4 (&Nacc)[2], const ScanAOps& o, const bf16x8 ones) {
    const int ci = (c.bl * 64 + j) * 4 + c.h;
    unsigned char* patch = lds + c.wave * SA_PATCH;
    const int lane = c.fq * 16 + c.fr;
    if ((j & 1) == 0) {
#pragma unroll
    for (int dt = 0; dt < 2; ++dt) {
#pragma unroll
        for (int et = 0; et < 2; ++et) { const f32x4 cc = Cacc[dt][et]; u32x2 w; w.x = pk2(cc[0], cc[1]); w.y = pk2(cc[2], cc[3]);
            *(u32x2*)(patch + (16 * et + c.fr) * 64 + (16 * dt + 4 * c.fq) * 2) = w; }
        if (c.do_den && c.fr == 0) *(f32x4*)(patch + 2048 + (16 * dt + 4 * c.fq) * 4) = Nacc[dt];
    }
    { bf16* cs = c.CS + (size_t)ci * 65536 + (c.eblk * 8 + c.dblk) * 1024;
#pragma unroll
      for (int k = 0; k < 2; ++k) __builtin_nontemporal_store(*(const u32x4*)(patch + k * 1024 + lane * 16), (u32x4*)(cs + k * 512 + lane * 8));
      if (c.do_den && lane < 8) *(f32x4*)(c.NS + (size_t)ci * 256 + c.dblk * 32 + lane * 4) = *(const f32x4*)(patch + 2048 + lane * 16); }
    }
#pragma unroll
    for (int dt = 0; dt < 2; ++dt) {
#pragma unroll
        for (int et = 0; et < 2; ++et) {
            f32x4 cc = Cacc[dt][et] * o.decay;
#pragma unroll
            for (int k2 = 0; k2 < 2; ++k2) cc = mfma16(o.k[dt][k2], o.v[et][k2], cc);
            Cacc[dt][et] = cc;
        }
        if (c.do_den) {
            f32x4 cc = Nacc[dt] * o.decay;
#pragma unroll
            for (int k2 = 0; k2 < 2; ++k2) cc = mfma16(o.k[dt][k2], ones, cc);
            Nacc[dt] = cc;
        }
    }
}
__device__ __forceinline__ void scana_item(const Args& a, unsigned char* lds, int item) {
    const int tid = opaque_tid(), lane = tid & 63;
    unsigned char* ws = a.ws;
    ScanA c;
    c.wave = __builtin_amdgcn_readfirstlane(tid >> 6); c.fr = lane & 15; c.fq = lane >> 4;
    item = __builtin_amdgcn_readfirstlane(item);
    c.bl = item >> 5; c.h = (item >> 3) & 3; c.dblk = 2 * ((item >> 1) & 3) + (c.wave >> 2); c.eblk = 4 * (item & 1) + (c.wave & 3); c.do_den = (c.eblk == 0);
    c.koff = (unsigned)((4 * c.dblk) * 512 + lane * 8); c.voff = (unsigned)((4 * c.eblk) * 512 + lane * 8);
    c.KTG = (const bf16*)(ws + WS_KTG); c.VTG = (const bf16*)(ws + WS_VTG); c.gDEC = (const float*)(ws + WS_GSC) + 5 * MS * 4;
    c.CS = (bf16*)(ws + WS_CS); c.NS = (float*)(ws + WS_NS);
    f32x4 Cacc[2][2], Nacc[2];
#pragma unroll
    for (int x = 0; x < 2; ++x) { Nacc[x] = (f32x4){0.f, 0.f, 0.f, 0.f};
#pragma unroll
        for (int y = 0; y < 2; ++y) Cacc[x][y] = (f32x4){0.f, 0.f, 0.f, 0.f}; }
    bf16x8 ones;
    { const short ov = (c.fr == 0) ? (short)0x3F80 : (short)0;
#pragma unroll
      for (int e = 0; e < 8; ++e) ones[e] = ov; }
    ScanAOps o0, o1, o2, o3, o4;
    scana_load(c, 0, o0); scana_load(c, 1, o1); scana_load(c, 2, o2); scana_load(c, 3, o3); scana_load(c, 4, o4);
#define SA_STEP(jj, ob) do { scana_step(c, lds, (jj), Cacc, Nacc, ob, ones); __builtin_amdgcn_sched_barrier(0); scana_load(c, (jj) + SA_DEPTH < 64 ? (jj) + SA_DEPTH : 63, ob); __builtin_amdgcn_sched_barrier(0); } while (0)
#pragma nounroll
    for (int j = 0; j < 60; j += 5) { SA_STEP(j, o0); SA_STEP(j + 1, o1); SA_STEP(j + 2, o2); SA_STEP(j + 3, o3); SA_STEP(j + 4, o4); }
    SA_STEP(60, o0); SA_STEP(61, o1); SA_STEP(62, o2); SA_STEP(63, o3);
#undef SA_STEP
    asm volatile("s_waitcnt vmcnt(0)" ::: "memory");
}

constexpr int AKS = 136;
constexpr int L_AK = 0, L_AV = L_AK + 128 * AKS * 2, L_AP = L_AV + 128 * AKS * 2, L_ATT_END = L_AP + 8 * 16 * AKS * 2;
static_assert(L_ATT_END <= 131072, "attn lds");

__device__ __forceinline__ void attn_item(const Args& a, unsigned char* lds, int item) {
    const int tid = opaque_tid(), lane = tid & 63, wave = __builtin_amdgcn_readfirstlane(tid >> 6);
    const int fr = lane & 15, fq = lane >> 4;
    unsigned char* ws = a.ws;
    const int blk = item & 31, hh = (item >> 5) & 3, bl = (item >> 7) & 3, g = item >> 9;
    const int dil = g == 0 ? 1 : g == 1 ? 4 : 16, nb = 32 / dil;
    const int r = blk / nb, n = blk % nb;
    const bf16* P = (const bf16*)(ws + WS_P);
    const int H = 4 * g + hh;
    const bf16* Qb = P + C_QA + H * 128; const bf16* Kb = P + C_KA + H * 128; const bf16* Vb = P + C_VT + H * 128;
    bf16* Ks = (bf16*)(lds + L_AK); bf16* VTs = (bf16*)(lds + L_AV); bf16* Pw = (bf16*)(lds + L_AP) + wave * 16 * AKS;
    const int rowbase = bl * SEQ + r;
    bf16x8 qf[4];
    { const size_t qrow = (size_t)(rowbase + (128 * n + 16 * wave + fr) * dil);
#pragma unroll
      for (int ks = 0; ks < 4; ++ks) qf[ks] = *(const bf16x8*)(Qb + qrow * INW + 32 * ks + 8 * fq); }
    f32x4 O[8];
#pragma unroll
    for (int i = 0; i < 8; ++i) O[i] = (f32x4){0.f, 0.f, 0.f, 0.f};
    float mrow = -INFINITY, lrow = 0.f;
    const float scale = 0.08838834764831845f;
#define ATT_BAR() do { asm volatile("s_waitcnt lgkmcnt(0)" ::: "memory"); __builtin_amdgcn_s_barrier(); asm volatile("" ::: "memory"); } while (0)
    const int half0 = (n == 0 ? 1 : 0);
    u32x4 kreg[4], vreg[4];
#pragma unroll
    for (int i = 0; i < 4; ++i) { const int c = tid + NTHR * i, key = c >> 4, dc = c & 15;
        const size_t krow = (size_t)(rowbase + (128 * (n - 1 + half0) + key) * dil);
        kreg[i] = *(const u32x4*)(Kb + krow * INW + 8 * dc); vreg[i] = *(const u32x4*)(Vb + krow * INW + 8 * dc); }
    for (int half = half0; half < 2; ++half) {
        ATT_BAR();
#pragma unroll
        for (int i = 0; i < 4; ++i) { const int c = tid + NTHR * i, key = c >> 4, dc = c & 15;
            *(u32x4*)(Ks + key * AKS + 8 * dc) = kreg[i]; *(u32x4*)(VTs + key * AKS + 8 * dc) = vreg[i]; }
        if (half == 0) {
#pragma unroll
            for (int i = 0; i < 4; ++i) { const int c = tid + NTHR * i, key = c >> 4, dc = c & 15;
                const size_t krow = (size_t)(rowbase + (128 * n + key) * dil);
                kreg[i] = *(const u32x4*)(Kb + krow * INW + 8 * dc); vreg[i] = *(const u32x4*)(Vb + krow * INW + 8 * dc); }
        }
        ATT_BAR();
        f32x4 S[8];
        const int p = 16 * wave + fr;
        float mx = -INFINITY;
#pragma unroll
        for (int kt = 0; kt < 8; ++kt) {
            const bool act = half == 0 ? (kt >= wave) : (kt <= wave);
            f32x4 sacc = {0.f, 0.f, 0.f, 0.f};
            if (act) {
#pragma unroll
                for (int ks = 0; ks < 4; ++ks) { const bf16x8 kf = *(const bf16x8*)(Ks + (16 * kt + fr) * AKS + 32 * ks + 8 * fq); sacc = mfma16(kf, qf[ks], sacc); }
#pragma unroll
                for (int i = 0; i < 4; ++i) { const int kk = 16 * kt + 4 * fq + i; const bool ok = half == 0 ? (kk >= p) : (kk <= p);
                    const float v = ok ? sacc[i] * scale : -INFINITY; sacc[i] = v; mx = fmaxf(mx, v); }
            }
            S[kt] = sacc;
        }
        mx = fmaxf(mx, __shfl_xor(mx, 16)); mx = fmaxf(mx, __shfl_xor(mx, 32));
        const float mn = fmaxf(mrow, mx), alpha = __expf(mrow - mn); mrow = mn;
        float rs = 0.f;
        unsigned pk[8][2];
#pragma unroll
        for (int kt = 0; kt < 8; ++kt) {
            const bool act = half == 0 ? (kt >= wave) : (kt <= wave);
            if (act) { const float p0 = __expf(S[kt][0] - mn), p1 = __expf(S[kt][1] - mn), p2 = __expf(S[kt][2] - mn), p3 = __expf(S[kt][3] - mn);
                rs += (p0 + p1) + (p2 + p3); pk[kt][0] = pk2(p0, p1); pk[kt][1] = pk2(p2, p3); }
            else { pk[kt][0] = 0u; pk[kt][1] = 0u; }
        }
        rs += __shfl_xor(rs, 16); rs += __shfl_xor(rs, 32);
        lrow = lrow * alpha + rs;
        float al[4];
#pragma unroll
        for (int i = 0; i < 4; ++i) al[i] = __shfl(alpha, 4 * fq + i);
#pragma unroll
        for (int dtile = 0; dtile < 8; ++dtile)
#pragma unroll
            for (int i = 0; i < 4; ++i) O[dtile][i] *= al[i];
#pragma unroll
        for (int ks = 0; ks < 4; ++ks) {
            const bool act = half == 0 ? (2 * ks + 1 >= wave) : (2 * ks <= wave);
            if (act) {
                u32x4 pw; pw.x = pk[2 * ks][0]; pw.y = pk[2 * ks][1]; pw.z = pk[2 * ks + 1][0]; pw.w = pk[2 * ks + 1][1];
                const bf16x8 pa = __builtin_bit_cast(bf16x8, pw);
#pragma unroll
                for (int dtile = 0; dtile < 8; ++dtile) {
                    const bf16* vp = VTs + (32 * ks + 4 * fq + (fr >> 2)) * AKS + 16 * dtile + 4 * (fr & 3);
                    const s16x4 v0 = __builtin_amdgcn_ds_read_tr16_b64_v4i16((__attribute__((address_space(3))) s16x4*)(vp));
                    const s16x4 v1 = __builtin_amdgcn_ds_read_tr16_b64_v4i16((__attribute__((address_space(3))) s16x4*)(vp + 16 * AKS));
                    bf16x8 vb; vb[0] = v0[0]; vb[1] = v0[1]; vb[2] = v0[2]; vb[3] = v0[3]; vb[4] = v1[0]; vb[5] = v1[1]; vb[6] = v1[2]; vb[7] = v1[3];
                    O[dtile] = mfma16(pa, vb, O[dtile]); }
            }
        }
    }
    bf16* AO = (bf16*)(ws + WS_AO) + (size_t)g * MS * 512; float* LSE = (float*)(ws + WS_LSE) + (size_t)g * MS * 4;
    {
        const float inv_l = 1.f / lrow;
        float il[4];
#pragma unroll
        for (int i = 0; i < 4; ++i) il[i] = __shfl(inv_l, 4 * fq + i);
#pragma unroll
        for (int dtile = 0; dtile < 8; ++dtile)
#pragma unroll
            for (int i = 0; i < 4; ++i) Pw[(4 * fq + i) * AKS + 16 * dtile + fr] = (bf16)f2bf(O[dtile][i] * il[i]);
        if (fq == 0) { const size_t row = (size_t)(rowbase + (128 * n + 16 * wave + fr) * dil); LSE[(size_t)hh * MS + row] = mrow + logf(lrow); }
#pragma unroll
        for (int k = 0; k < 4; ++k) { const int c = lane + 64 * k, q = c >> 4, ch = c & 15;
            const size_t row = (size_t)(rowbase + (128 * n + 16 * wave + q) * dil);
            *(u32x4*)(AO + row * 512 + hh * 128 + 8 * ch) = *(const u32x4*)(Pw + q * AKS + 8 * ch); }
    }
    __syncthreads();
}

constexpr int N_SCAN_ITEMS = NB_PASS * 32, N_ATT_ITEMS = 3 * NB_PASS * 4 * 32;
#ifndef PROBE_ATT_REP
#define PROBE_ATT_REP 1
#endif
struct XcdBarrier;
__device__ __forceinline__ void xcd_barrier(const XcdBarrier& b);
__device__ __forceinline__ void phase_mix(const Args& a, unsigned char* lds, int pass, const XcdBarrier* pbar) {
    volatile int* slot = (volatile int*)(lds + 131072 + 1024);
#ifdef PROBE_SPLIT
    for (int it = blockIdx.x; it < N_SCAN_ITEMS; it += gridDim.x) scana_item(a, lds, it);
    xcd_barrier(*pbar);
    for (int rep = 0; rep < PROBE_ATT_REP; ++rep)
    for (int it = blockIdx.x; it < N_ATT_ITEMS; it += gridDim.x) attn_item(a, lds, it);
#else
    if ((int)blockIdx.x < N_SCAN_ITEMS && gridDim.x >= (unsigned)N_SCAN_ITEMS) {
        const int x = blockIdx.x & 7, k = blockIdx.x >> 3, g = x + 8 * (k >> 3), m = k & 7;
        scana_item(a, lds, g * 8 + m);
    } else if (gridDim.x < (unsigned)N_SCAN_ITEMS) { for (int it = blockIdx.x; it < N_SCAN_ITEMS; it += gridDim.x) scana_item(a, lds, it); }
    constexpr int QN = N_ATT_ITEMS / 8;
    for (int qo = 0; qo < 8; ++qo) {
        const int qx = (int)((blockIdx.x + qo) & 7);
        unsigned* qc = (unsigned*)(a.ws + WS_CTL) + CW_QCTR + (pass * 8 + qx) * 64;
        for (;;) {
            __syncthreads();
            if (opaque_tid() == 0) *slot = (int)atomicAdd(qc, 1u);
            __syncthreads();
            const int L = *slot;
            if (L >= QN) break;
            attn_item(a, lds, ((L >> 3) * 8 + qx) * 8 + (L & 7));
        }
    }
#endif
}

constexpr int QS_STRIDE = 264, SS_STRIDE = 72;
constexpr int L_QS = 0, L_SS = L_QS + 64 * QS_STRIDE * 2, L_DENL = L_SS + 64 * SS_STRIDE * 2, L_WIL = L_DENL + 256, L_NUM = L_WIL + 256, L_SB_END = L_NUM + 64 * QS_STRIDE * 2;
static_assert(L_SB_END <= 131072, "scan-B lds");
constexpr int L_KTL = L_SB_END, L_XS = L_KTL + 256 * TPS * 2, L_SB2_END = L_XS + 64 * TPS * 2;
static_assert(L_SB2_END <= 131072, "scan-B lds");
struct SBCtx { const bf16* P; const bf16* XC; const bf16* QM; const bf16* SG; const bf16* VTG; const bf16* KTG; const bf16* CS; const float* NS; const float* gWI; const float* gEF; const float* gDEC; bf16* UM; int tid, lane, wave, fr, fq; };

__device__ __forceinline__ void scanb_tail(const Args& a, const SBCtx& c, const bf16* NUMS, const float* DENL, int h, int t0) {
    const int lane = c.lane, wave = c.wave, col = h * 256 + 4 * lane;
    const f32x4 gh = *(const f32x4*)(a.g_head + col), sk = *(const f32x4*)(a.skip + col);
#pragma unroll
    for (int hb = 0; hb < 2; ++hb) {
        u32x2 ow[4], zw[4], xw[4];
#pragma unroll
        for (int q = 0; q < 4; ++q) { const size_t r = (size_t)(t0 + 8 * wave + 4 * hb + q);
            ow[q] = *(const u32x2*)(c.P + r * INW + C_OA + col); zw[q] = *(const u32x2*)(c.P + r * INW + C_ZA + col); xw[q] = *(const u32x2*)(c.XC + r * 1024 + col); }
#pragma unroll
        for (int q = 0; q < 4; ++q) {
            const int l = 8 * wave + 4 * hb + q; const size_t r = (size_t)(t0 + l);
            const u32x2 hw = *(const u32x2*)(NUMS + l * QS_STRIDE + 4 * lane);
            const float rd = DENL[l];
            float hm[4] = {sigmoidf_(bflo(ow[q].x)) * bflo(hw.x) * rd, sigmoidf_(bfhi(ow[q].x)) * bfhi(hw.x) * rd, sigmoidf_(bflo(ow[q].y)) * bflo(hw.y) * rd, sigmoidf_(bfhi(ow[q].y)) * bfhi(hw.y) * rd};
            float ss = (hm[0] * hm[0] + hm[1] * hm[1]) + (hm[2] * hm[2] + hm[3] * hm[3]);
            ss = wave_sum(ss);
            const float rinv = 1.f / sqrtf(ss * (1.f / 256.f) + EPS);
            const float xc[4] = {bflo(xw[q].x), bfhi(xw[q].x), bflo(xw[q].y), bfhi(xw[q].y)}, za[4] = {bflo(zw[q].x), bfhi(zw[q].x), bflo(zw[q].y), bfhi(zw[q].y)};
            float o[4];
#pragma unroll
            for (int e = 0; e < 4; ++e) o[e] = (hm[e] * rinv * gh[e] + sk[e] * xc[e]) * siluf_(za[e]);
            u32x2 ov; ov.x = pk2(o[0], o[1]); ov.y = pk2(o[2], o[3]);
            *(u32x2*)(c.UM + r * 1536 + col) = ov;
        }
        __builtin_amdgcn_sched_barrier(0);
    }
}

__device__ __forceinline__ void scanb_run(const Args& a, unsigned char* lds, int vcu, int G, int pass) {
    SBCtx c;
    c.tid = opaque_tid(); c.lane = c.tid & 63; c.wave = __builtin_amdgcn_readfirstlane(c.tid >> 6); c.fr = c.lane & 15; c.fq = c.lane >> 4;
    unsigned char* ws = a.ws;
    c.P = (const bf16*)(ws + WS_P); c.XC = (const bf16*)(ws + WS_XC); c.QM = (const bf16*)(ws + WS_QM); c.SG = (const bf16*)(ws + WS_SG); c.VTG = (const bf16*)(ws + WS_VTG); c.KTG = (const bf16*)(ws + WS_KTG);
    c.CS = (const bf16*)(ws + WS_CS); c.NS = (const float*)(ws + WS_NS); c.gWI = (const float*)(ws + WS_GSC) + 2 * MS * 4; c.gEF = (const float*)(ws + WS_GSC) + 3 * MS * 4; c.gDEC = (const float*)(ws + WS_GSC) + 5 * MS * 4;
    c.UM = (bf16*)(ws + WS_ACAT);
    const int wave = c.wave;
    bf16* QS = (bf16*)(lds + L_QS); bf16* SS = (bf16*)(lds + L_SS); float* DENL = (float*)(lds + L_DENL); float* WIL = (float*)(lds + L_WIL); bf16* NUMS = (bf16*)(lds + L_NUM);
    bf16* KTL = (bf16*)(lds + L_KTL); bf16* XS = (bf16*)(lds + L_XS);
    unsigned* qc = (unsigned*)(ws + WS_CTL) + CW_QCTR + 2048 + pass * 64;
    volatile int* slot = (volatile int*)(lds + 131072 + 1024);
    constexpr int NITEMS = (MS / 128) * 4;
    bf16x8 ones;
    { const short ov = (c.fr == 0) ? (short)0x3F80 : (short)0;
#pragma unroll
      for (int e = 0; e < 8; ++e) ones[e] = ov; }
    int it = vcu;
    while (it < NITEMS) {
        { int t_ = c.tid; asm volatile("" : "+v"(t_)); c.tid = t_; c.lane = t_ & 63; c.fr = c.lane & 15; c.fq = c.lane >> 4; }
        const int tid = c.tid, lane = c.lane, fr = c.fr, fq = c.fq;
        const int h = it & 3, pr = it >> 2, chA = (2 * pr) * 4 + h, chB = chA + 4, tA = (2 * pr) * 64, tB = tA + 64;
        bf16x8 cb[2][8], vtA[2][2], vtB[2][2];
#pragma unroll
        for (int t = 0; t < 2; ++t) {
#pragma unroll
            for (int ks = 0; ks < 8; ++ks) cb[t][ks] = *(const bf16x8*)(c.CS + (size_t)chA * 65536 + (wave * 8 + ks) * 1024 + (16 * t + fr) * 32 + 8 * fq);
#pragma unroll
            for (int k2 = 0; k2 < 2; ++k2) vtA[t][k2] = *(const bf16x8*)(c.VTG + (size_t)chA * 16384 + (((2 * wave + t) * 2 + k2) * 64 + lane) * 8);
        }
        const float decA = c.gDEC[h * (MS / 64) + 2 * pr];
        if (tid == 0) *slot = (int)atomicAdd(qc, 1u);
        __syncthreads();
#pragma unroll
        for (int i = 0; i < 4; ++i) { const int q = tid + NTHR * i, row = q >> 5, cc = q & 31; *(u32x4*)(QS + row * QS_STRIDE + 8 * cc) = *(const u32x4*)(c.QM + (size_t)(tA + row) * 1024 + h * 256 + 8 * cc); }
        { const int row = tid >> 3, cc = tid & 7; *(u32x4*)(SS + row * SS_STRIDE + 8 * cc) = *(const u32x4*)(c.SG + (size_t)chA * 4096 + row * 64 + 8 * cc); }
        if (tid < 64) WIL[tid] = c.gWI[h * MS + tA + tid];
#pragma unroll
        for (int i = 0; i < 4; ++i) { const int p = tid + NTHR * i, blk = p >> 6, ln = p & 63, row = (blk >> 1) * 16 + (ln & 15), ch8 = (blk & 1) * 4 + (ln >> 4);
            *(u32x4*)(KTL + row * TPS + 8 * ch8) = *(const u32x4*)(c.KTG + (size_t)chA * 16384 + p * 8); }
        __syncthreads();
        const int nit = G + *slot;
#pragma unroll
        for (int lt = 0; lt < 4; ++lt) {
            bf16x8 qf[8], sf[2];
#pragma unroll
            for (int ks = 0; ks < 8; ++ks) qf[ks] = *(const bf16x8*)(QS + (16 * lt + fr) * QS_STRIDE + 32 * ks + 8 * fq);
#pragma unroll
            for (int k2 = 0; k2 < 2; ++k2) sf[k2] = *(const bf16x8*)(SS + (16 * lt + fr) * SS_STRIDE + 32 * k2 + 8 * fq);
#pragma unroll
            for (int t = 0; t < 2; ++t) {
                f32x4 a1 = {0.f, 0.f, 0.f, 0.f}, a2 = {0.f, 0.f, 0.f, 0.f}, a3 = {0.f, 0.f, 0.f, 0.f};
#pragma unroll
                for (int k2 = 0; k2 < 2; ++k2) a1 = mfma16(sf[k2], vtA[t][k2], a1);
#pragma unroll
                for (int ks = 0; ks < 8; ks += 2) { a2 = mfma16(qf[ks], cb[t][ks], a2); a3 = mfma16(qf[ks + 1], cb[t][ks + 1], a3); }
#pragma unroll
                for (int i = 0; i < 4; ++i) NUMS[(16 * lt + 4 * fq + i) * QS_STRIDE + 32 * wave + 16 * t + fr] = (bf16)f2bf(a1[i] + WIL[16 * lt + 4 * fq + i] * (a2[i] + a3[i]));
            }
        }
        if (wave == 0) {
            bf16x8 nb[8];
#pragma unroll
            for (int ks = 0; ks < 8; ++ks) { const f32x4 n0 = *(const f32x4*)(c.NS + (size_t)chA * 256 + 32 * ks + 8 * fq), n1 = *(const f32x4*)(c.NS + (size_t)chA * 256 + 32 * ks + 8 * fq + 4);
                u32x4 w; w.x = pk2(n0[0], n0[1]); w.y = pk2(n0[2], n0[3]); w.z = pk2(n1[0], n1[1]); w.w = pk2(n1[2], n1[3]);
                if (fr != 0) w = (u32x4){0u, 0u, 0u, 0u};
                nb[ks] = __builtin_bit_cast(bf16x8, w); }
#pragma unroll
            for (int lt = 0; lt < 4; ++lt) {
                f32x4 a1 = {0.f, 0.f, 0.f, 0.f}, a2 = {0.f, 0.f, 0.f, 0.f};
#pragma unroll
                for (int k2 = 0; k2 < 2; ++k2) { const bf16x8 sf = *(const bf16x8*)(SS + (16 * lt + fr) * SS_STRIDE + 32 * k2 + 8 * fq); a1 = mfma16(sf, ones, a1); }
#pragma unroll
                for (int ks = 0; ks < 8; ++ks) { const bf16x8 qf = *(const bf16x8*)(QS + (16 * lt + fr) * QS_STRIDE + 32 * ks + 8 * fq); a2 = mfma16(qf, nb[ks], a2); }
                if (fr == 0) {
#pragma unroll
                    for (int i = 0; i < 4; ++i) { const int l = 16 * lt + 4 * fq + i; const float den = a1[i] + WIL[l] * a2[i]; DENL[l] = 1.f / fmaxf(fabsf(den), c.gEF[h * MS + tA + l]); } }
            }
        }
        __syncthreads();
#pragma unroll
        for (int i = 0; i < 4; ++i) { const int q = tid + NTHR * i, row = q >> 5, cc = q & 31; *(u32x4*)(QS + row * QS_STRIDE + 8 * cc) = *(const u32x4*)(c.QM + (size_t)(tB + row) * 1024 + h * 256 + 8 * cc); }
        { const int row = tid >> 3, cc = tid & 7; *(u32x4*)(SS + row * SS_STRIDE + 8 * cc) = *(const u32x4*)(c.SG + (size_t)chB * 4096 + row * 64 + 8 * cc); }
        scanb_tail(a, c, NUMS, DENL, h, tA);
#pragma unroll
        for (int t = 0; t < 2; ++t)
#pragma unroll
            for (int k2 = 0; k2 < 2; ++k2) vtB[t][k2] = *(const bf16x8*)(c.VTG + (size_t)chB * 16384 + (((2 * wave + t) * 2 + k2) * 64 + lane) * 8);
        __syncthreads();
        if (tid < 64) WIL[tid] = c.gWI[h * MS + tB + tid];
        {
            const int ti = wave >> 1;
            bf16x8 qf[8];
#pragma unroll
            for (int ks = 0; ks < 8; ++ks) qf[ks] = *(const bf16x8*)(QS + (16 * ti + fr) * QS_STRIDE + 32 * ks + 8 * fq);
#pragma unroll
            for (int tt = 0; tt < 2; ++tt) { const int tj = 2 * (wave & 1) + tt;
                f32x4 xacc = {0.f, 0.f, 0.f, 0.f};
#pragma unroll
                for (int ks = 0; ks < 8; ++ks) {
                    const bf16* kp = KTL + (32 * ks + 8 * fq + (fr >> 2)) * TPS + 16 * tj + 4 * (fr & 3);
                    const s16x4 k0 = __builtin_amdgcn_ds_read_tr16_b64_v4i16((__attribute__((address_space(3))) s16x4*)(kp));
                    const s16x4 k1 = __builtin_amdgcn_ds_read_tr16_b64_v4i16((__attribute__((address_space(3))) s16x4*)(kp + 4 * TPS));
                    bf16x8 kb; kb[0] = k0[0]; kb[1] = k0[1]; kb[2] = k0[2]; kb[3] = k0[3]; kb[4] = k1[0]; kb[5] = k1[1]; kb[6] = k1[2]; kb[7] = k1[3];
                    xacc = mfma16(qf[ks], kb, xacc); }
#pragma unroll
                for (int i = 0; i < 4; ++i) XS[(16 * ti + 4 * fq + i) * TPS + 16 * tj + fr] = (bf16)f2bf(xacc[i]); }
        }
        __syncthreads();
#pragma unroll
        for (int lt = 0; lt < 4; ++lt) {
            bf16x8 qf[8], sf[2], xf[2];
#pragma unroll
            for (int ks = 0; ks < 8; ++ks) qf[ks] = *(const bf16x8*)(QS + (16 * lt + fr) * QS_STRIDE + 32 * ks + 8 * fq);
#pragma unroll
            for (int k2 = 0; k2 < 2; ++k2) { sf[k2] = *(const bf16x8*)(SS + (16 * lt + fr) * SS_STRIDE + 32 * k2 + 8 * fq); xf[k2] = *(const bf16x8*)(XS + (16 * lt + fr) * TPS + 32 * k2 + 8 * fq); }
#pragma unroll
            for (int t = 0; t < 2; ++t) {
                f32x4 a1 = {0.f, 0.f, 0.f, 0.f}, a2 = {0.f, 0.f, 0.f, 0.f}, a3 = {0.f, 0.f, 0.f, 0.f}, a4 = {0.f, 0.f, 0.f, 0.f};
#pragma unroll
                for (int k2 = 0; k2 < 2; ++k2) { a1 = mfma16(sf[k2], vtB[t][k2], a1); a4 = mfma16(xf[k2], vtA[t][k2], a4); }
#pragma unroll
                for (int ks = 0; ks < 8; ks += 2) { a2 = mfma16(qf[ks], cb[t][ks], a2); a3 = mfma16(qf[ks + 1], cb[t][ks + 1], a3); }
#pragma unroll
                for (int i = 0; i < 4; ++i) NUMS[(16 * lt + 4 * fq + i) * QS_STRIDE + 32 * wave + 16 * t + fr] = (bf16)f2bf(a1[i] + WIL[16 * lt + 4 * fq + i] * (decA * (a2[i] + a3[i]) + a4[i]));
            }
        }
        if (wave == 0) {
            bf16x8 nb[8];
#pragma unroll
            for (int ks = 0; ks < 8; ++ks) { const f32x4 n0 = *(const f32x4*)(c.NS + (size_t)chA * 256 + 32 * ks + 8 * fq), n1 = *(const f32x4*)(c.NS + (size_t)chA * 256 + 32 * ks + 8 * fq + 4);
                u32x4 w; w.x = pk2(n0[0], n0[1]); w.y = pk2(n0[2], n0[3]); w.z = pk2(n1[0], n1[1]); w.w = pk2(n1[2], n1[3]);
                if (fr != 0) w = (u32x4){0u, 0u, 0u, 0u};
                nb[ks] = __builtin_bit_cast(bf16x8, w); }
#pragma unroll
            for (int lt = 0; lt < 4; ++lt) {
                f32x4 a1 = {0.f, 0.f, 0.f, 0.f}, a2 = {0.f, 0.f, 0.f, 0.f}, a4 = {0.f, 0.f, 0.f, 0.f};
#pragma unroll
                for (int k2 = 0; k2 < 2; ++k2) { const bf16x8 sf = *(const bf16x8*)(SS + (16 * lt + fr) * SS_STRIDE + 32 * k2 + 8 * fq); a1 = mfma16(sf, ones, a1);
                                                 const bf16x8 xf = *(const bf16x8*)(XS + (16 * lt + fr) * TPS + 32 * k2 + 8 * fq); a4 = mfma16(xf, ones, a4); }
#pragma unroll
                for (int ks = 0; ks < 8; ++ks) { const bf16x8 qf = *(const bf16x8*)(QS + (16 * lt + fr) * QS_STRIDE + 32 * ks + 8 * fq); a2 = mfma16(qf, nb[ks], a2); }
                if (fr == 0) {
#pragma unroll
                    for (int i = 0; i < 4; ++i) { const int l = 16 * lt + 4 * fq + i; const float den = a1[i] + WIL[l] * (decA * a2[i] + a4[i]); DENL[l] = 1.f / fmaxf(fabsf(den), c.gEF[h * MS + tB + l]); } }
            }
        }
        __syncthreads();
        scanb_tail(a, c, NUMS, DENL, h, tB);
        it = nit;
    }
    __syncthreads();
}

__device__ __forceinline__ void phase_post(const Args& a, unsigned char* lds, int vcu, int G, int pass) {
    scanb_run(a, lds, vcu, G, pass);
    const int tid = opaque_tid(), lane = tid & 63, wave = tid >> 6;
    unsigned char* ws = a.ws;
    const bf16* P = (const bf16*)(ws + WS_P);
    const bf16* AO = (const bf16*)(ws + WS_AO); const float* LSE = (const float*)(ws + WS_LSE); bf16* UA = (bf16*)(ws + WS_ACAT) + 1024;
    const int hh = lane >> 4, c = hh * 128 + 8 * (lane & 15);
    for (int r0 = 2 * (vcu * NWAVES + wave); r0 < MS; r0 += 2 * G * NWAVES) {
        u32x4 o0[2], o1[2], o2[2], zb[2]; float l0[2], l1[2], l2[2];
#pragma unroll
        for (int q = 0; q < 2; ++q) { const size_t r = (size_t)(r0 + q);
            o0[q] = *(const u32x4*)(AO + r * 512 + c); o1[q] = *(const u32x4*)(AO + ((size_t)MS + r) * 512 + c); o2[q] = *(const u32x4*)(AO + ((size_t)2 * MS + r) * 512 + c);
            zb[q] = *(const u32x4*)(P + r * INW + C_ZB + c);
            l0[q] = LSE[(size_t)hh * MS + r]; l1[q] = LSE[(size_t)(4 + hh) * MS + r]; l2[q] = LSE[(size_t)(8 + hh) * MS + r]; }
#pragma unroll
        for (int q = 0; q < 2; ++q) {
            const float mx = fmaxf(l0[q], fmaxf(l1[q], l2[q]));
            float w0 = __expf(l0[q] - mx), w1 = __expf(l1[q] - mx), w2 = __expf(l2[q] - mx); const float inv = 1.f / (w0 + w1 + w2); w0 *= inv; w1 *= inv; w2 *= inv;
            float f0[8], f1[8], f2[8], z[8], o[8]; unpack8(o0[q], f0); unpack8(o1[q], f1); unpack8(o2[q], f2); unpack8(zb[q], z);
#pragma unroll
            for (int e = 0; e < 8; ++e) o[e] = (w0 * f0[e] + w1 * f1[e] + w2 * f2[e]) * siluf_(z[e]);
            u32x4 ov; ov.x = pk2(o[0], o[1]); ov.y = pk2(o[2], o[3]); ov.z = pk2(o[4], o[5]); ov.w = pk2(o[6], o[7]);
            *(u32x4*)(UA + (size_t)(r0 + q) * 1536 + c) = ov;
        }
    }
}

__device__ __forceinline__ void phase_norm(const Args& a, int vcu, int G) {
    const int tid = opaque_tid(), lane = tid & 63, wave = tid >> 6;
    const bf16* dl = (const bf16*)(a.ws + WS_H);
    for (int r0 = 2 * (vcu * NWAVES + wave); r0 < MALL; r0 += 2 * G * NWAVES) {
        f32x4 v[2][4]; u32x2 d[2][4]; float ss[2] = {0.f, 0.f};
#pragma unroll
        for (int q = 0; q < 2; ++q) { const f32x4* xr = (const f32x4*)(a.x + (size_t)(r0 + q) * DM) + lane; const u32x2* dr = (const u32x2*)(dl + (size_t)(r0 + q) * DM) + lane;
#pragma unroll
            for (int j = 0; j < 4; ++j) { v[q][j] = xr[64 * j]; d[q][j] = dr[64 * j]; } }
#pragma unroll
        for (int q = 0; q < 2; ++q)
#pragma unroll
            for (int j = 0; j < 4; ++j) { v[q][j] += (f32x4){bflo(d[q][j].x), bfhi(d[q][j].x), bflo(d[q][j].y), bfhi(d[q][j].y)};
                ss[q] += (v[q][j].x * v[q][j].x + v[q][j].y * v[q][j].y) + (v[q][j].z * v[q][j].z + v[q][j].w * v[q][j].w); }
#pragma unroll
        for (int o = 1; o < 64; o <<= 1) { ss[0] += __shfl_xor(ss[0], o); ss[1] += __shfl_xor(ss[1], o); }
#pragma unroll
        for (int q = 0; q < 2; ++q) { const float rinv = 1.f / sqrtf(ss[q] * (1.f / DM) + EPS);
#pragma unroll
            for (int j = 0; j < 4; ++j) { const f32x4 gf = *((const f32x4*)a.g_final + lane + 64 * j); *((f32x4*)(a.out + (size_t)(r0 + q) * DM) + lane + 64 * j) = v[q][j] * rinv * gf; } }
    }
}


#define LAS __attribute__((address_space(3)))
#define XB_TMO      128
#define XB_XCNT(j)  (256  + 64 * (j))
#define XB_XSUB(j)  (1280 + 64 * (j))
#define XB_XGEN(j)  (2304 + 64 * (j))
#define XB_TOP      3328
#define XB_TOPGEN   3392
#define XCD_BAR_WORDS 3456
#define XB_SPIN_CAP (1u << 22)
constexpr int CW_BAR = 4096;
__device__ __forceinline__ unsigned xb_ld(unsigned* p)              { return __hip_atomic_load(p, __ATOMIC_RELAXED, __HIP_MEMORY_SCOPE_AGENT); }
__device__ __forceinline__ unsigned xb_add(unsigned* p, unsigned v) { return __hip_atomic_fetch_add(p, v, __ATOMIC_RELAXED, __HIP_MEMORY_SCOPE_AGENT); }
__device__ __forceinline__ unsigned xb_xcc_id() { return (unsigned)__builtin_amdgcn_s_getreg((3 << 11) | 20) & 0xFu; }
#define XB_SPIN(cond, bar) do { unsigned _sp = 0; while (cond) { __builtin_amdgcn_s_sleep(1); \
    if ((++_sp & 255u) == 0u) { if (xb_ld(&(bar)[XB_TMO])) break; if (_sp > XB_SPIN_CAP) { atomicAdd(&(bar)[XB_TMO], 1u); break; } } } } while (0)
struct XcdBarrier { unsigned* bar; unsigned x; volatile LAS unsigned* st; };
__device__ __forceinline__ XcdBarrier xcd_barrier_post(unsigned* bar, volatile LAS unsigned* st) {
    XcdBarrier b; b.bar = bar; b.x = xb_xcc_id(); b.st = st;
    if (threadIdx.x == 0) (void)xb_add(&bar[XB_XCNT(b.x)], 1u);
    return b;
}
__device__ __forceinline__ void xcd_barrier_complete(unsigned* bar, unsigned x, unsigned& nloc, unsigned& nx) {
    const unsigned G = gridDim.x * gridDim.y * gridDim.z;
    unsigned sum, cnt, mine, sp = 0u;
    for (;;) {
        sum = 0u; cnt = 0u; mine = 0u;
#pragma unroll
        for (unsigned j = 0; j < 16; ++j) { const unsigned c = xb_ld(&bar[XB_XCNT(j)]); sum += c; cnt += (c > 0u) ? 1u : 0u; mine = (j == x) ? c : mine; }
        if (sum == G) break;
        __builtin_amdgcn_s_sleep(1);
        if ((++sp & 255u) == 0u) { if (xb_ld(&bar[XB_TMO])) break; if (sp > XB_SPIN_CAP) { atomicAdd(&bar[XB_TMO], 1u); break; } }
    }
    nloc = mine > 0u ? mine : 1u; nx = cnt > 0u ? cnt : 1u;
}
__device__ __forceinline__ void xcd_barrier(const XcdBarrier& b) {
    asm volatile("s_waitcnt vmcnt(0)" ::: "memory");
    __syncthreads();
    if (threadIdx.x == 0) {
        unsigned* bar = b.bar;
        __builtin_amdgcn_s_waitcnt(0);
        unsigned nloc = b.st[0], nx = b.st[1];
        if (nloc == 0u) { xcd_barrier_complete(bar, b.x, nloc, nx); b.st[0] = nloc; b.st[1] = nx; }
        const unsigned old = xb_add(&bar[XB_XSUB(b.x)], 1u);
        const unsigned gen = old / nloc;
        if (old + 1u == (gen + 1u) * nloc) {
            __builtin_amdgcn_fence(__ATOMIC_RELEASE, "agent");
            asm volatile("s_waitcnt vmcnt(0)" ::: "memory");
            const unsigned og = xb_add(&bar[XB_TOP], 1u);
            const unsigned tg = og / nx;
            if (og + 1u == (tg + 1u) * nx) xb_add(&bar[XB_TOPGEN], 1u);
            else XB_SPIN(xb_ld(&bar[XB_TOPGEN]) == tg, bar);
            __builtin_amdgcn_fence(__ATOMIC_ACQUIRE, "agent");
            xb_add(&bar[XB_XGEN(b.x)], 1u);
            asm volatile("s_waitcnt vmcnt(0)" ::: "memory");
        } else {
            XB_SPIN(xb_ld(&bar[XB_XGEN(b.x)]) == gen, bar);
            __builtin_amdgcn_fence(__ATOMIC_ACQUIRE, "agent");
            asm volatile("s_waitcnt vmcnt(0)" ::: "memory");
        }
    }
    __syncthreads();
}

constexpr int PH_PER_PASS = 6, PH_TOTAL = 3 + PH_PER_PASS * NPASS + 1;
#define PROBE_KIND_OF(k) ((k) == 0 ? K_PREP : (k) == 1 ? K_CPREP : (k) == 2 ? K_MIX : (k) == 3 ? K_POST : (k) == 4 ? K_OUT1 : K_OUT2)
enum { K_PROLOGUE = 0, K_H = 1, K_INPROJ = 2, K_PREP = 3, K_QK = 4, K_MIX = 5, K_POST = 6, K_OUT1 = 7, K_OUT2 = 8, K_NORM = 9, K_CPREP = 10, K_OUT2IN = 12 };

__device__ __forceinline__ Args fresh_args() {
    Args a{};
#if defined(__HIP_DEVICE_COMPILE__)
    typedef const __attribute__((address_space(4))) unsigned long long* KP;
    KP q = (KP)__builtin_amdgcn_kernarg_segment_ptr(); asm volatile("" : "+s"(q));
    static_assert(sizeof(Args) == 22 * 8, "Args layout");
    unsigned long long w[22];
#pragma unroll
    for (int i = 0; i < 22; ++i) w[i] = q[i];
    __builtin_memcpy(&a, w, sizeof(Args));
#endif
    return a;
}
template <int KIND>
__device__ __forceinline__ void run_phase(const Args& args, unsigned char* lds, int pass, const XcdBarrier* pbar = nullptr) {
    const int G = gridDim.x; const int bx = blockIdx.x;
    const int vcu = (G % 8 == 0) ? (bx % 8) * (G / 8) + bx / 8 : bx;
    unsigned char* ws = args.ws;
    PG8_LAS unsigned char* lds3 = (PG8_LAS unsigned char*)lds;
    if constexpr (KIND == K_PROLOGUE) phase_prologue(args, lds, vcu, G);
    else if constexpr (KIND == K_H) phase_h(args, lds, vcu, G);
    else if constexpr (KIND == K_NORM) phase_norm(args, vcu, G);
    else if constexpr (KIND == K_INPROJ) {
        pg8::Gemm<1024, 1024, 1024> g{(const bf16*)(ws + WS_H) + (size_t)pass * MS * 1024, (const bf16*)(ws + WS_WIN)};
        pg8::StaticOrder S; S.init(MS, INW, G, bx);
        EpiProj E{(bf16*)(ws + WS_P), (const float*)(ws + WS_ROPE) + (size_t)pass * MS * 32};
        pg8::gemm_phase<EpiProj, pg8::StaticOrder, true, true>(lds3, g, S, E);
    } else if constexpr (KIND == K_PREP) phase_prep(args, lds, vcu, G, pass);
    else if constexpr (KIND == K_QK) {
        pg8::Gemm<1024, 256, 256, 512, 512 * 256 * 2> g{(const bf16*)(ws + WS_XC), (const bf16*)(ws + WS_WQK)};
        pg8::GroupOrder S; S.init(MS, G, bx);
        EpiQK E{(bf16*)(ws + WS_QM), (bf16*)(ws + WS_KM)};
        pg8::gemm_phase<EpiQK, pg8::GroupOrder, true, true>(lds3, g, S, E);
    } else if constexpr (KIND == K_CPREP) phase_cprep(args, lds, vcu, G);
    else if constexpr (KIND == K_MIX) phase_mix(args, lds, pass, pbar);
    else if constexpr (KIND == K_POST) phase_post(args, lds, vcu, G, pass);
    else if constexpr (KIND == K_OUT1) {
        pg8::Gemm<1536, 1536, 1536> g{(const bf16*)(ws + WS_ACAT), (const bf16*)(ws + WS_WOM)};
        pg8::StaticOrder S; S.init(MS, 1024, G, bx);
        EpiMerge E{(const bf16*)(ws + WS_P), (bf16*)(ws + WS_MG)};
        pg8::gemm_phase<EpiMerge, pg8::StaticOrder, true, true>(lds3, g, S, E);
    } else if constexpr (KIND == K_OUT2IN) {
        GemmCombo g{(const bf16*)(ws + WS_MG), (const bf16*)(ws + WS_WO), (const bf16*)(ws + WS_H) + (size_t)(pass + 1) * MS * 1024, (const bf16*)(ws + WS_WIN)};
        ComboOrder S; S.init(G, bx);
        EpiCombo E{EpiOut{(bf16*)(ws + WS_H), (const float*)(ws + WS_MOD) + 2048, pass * MS}, EpiProj{(bf16*)(ws + WS_P), (const float*)(ws + WS_ROPE) + (size_t)(pass + 1) * MS * 32}};
        pg8::gemm_phase<EpiCombo, ComboOrder, true, true>(lds3, g, S, E);
    } else if constexpr (KIND == K_OUT2) {
        pg8::Gemm<1024, 1024, 1024> g{(const bf16*)(ws + WS_MG), (const bf16*)(ws + WS_WO)};
        pg8::StaticOrder S; S.init(MS, 1024, G, bx);
        EpiOut E{(bf16*)(ws + WS_H), (const float*)(ws + WS_MOD) + 2048, pass * MS};
        pg8::gemm_phase<EpiOut, pg8::StaticOrder, true, true>(lds3, g, S, E);
    }
}

#if !MK_ONE_LAUNCH
template <int KIND>
__global__ void __launch_bounds__(NTHR, 2) k_phase(Args args) {
    extern __shared__ __attribute__((aligned(16))) unsigned char lds[];
    run_phase<KIND>(args, lds, args.ph_lo);
}
#else
__global__ void __launch_bounds__(NTHR, 2) mk_fwd(Args args) {
    extern __shared__ __attribute__((aligned(16))) unsigned char lds[];
    volatile LAS unsigned* misc = (volatile LAS unsigned*)((LAS unsigned char*)lds + 131072 + 2048);
    if (threadIdx.x < 16) misc[threadIdx.x] = 0u;
    __syncthreads();
    XcdBarrier bar = xcd_barrier_post((unsigned*)(args.ws + WS_CTL) + CW_BAR, misc + 8);
#ifdef PROBE_TMASK
    unsigned long long pr_acc = 0ull;
#endif
    for (int gp = args.ph_lo; gp < args.ph_hi; ++gp) {
#ifdef PROBE_TMASK
        const unsigned long long pr_t0 = __builtin_amdgcn_s_memrealtime();
        int pr_kind;
        if (gp == 0) pr_kind = K_PROLOGUE; else if (gp == 1) pr_kind = K_H; else if (gp == 2) pr_kind = K_INPROJ; else if (gp == PH_TOTAL - 1) pr_kind = K_NORM;
        else { const int k = (gp - 3) % PH_PER_PASS; pr_kind = PROBE_KIND_OF(k); }
#endif
        if (gp == 0) run_phase<K_PROLOGUE>(args, lds, 0);
        else if (gp == 1) run_phase<K_H>(args, lds, 0);
        else if (gp == 2) run_phase<K_INPROJ>(args, lds, 0);
        else if (gp == PH_TOTAL - 1) run_phase<K_NORM>(args, lds, 0);
        else {
            const int pass = (gp - 3) / PH_PER_PASS, k = (gp - 3) % PH_PER_PASS;
            if (k == 0) run_phase<K_PREP>(args, lds, pass);
            else if (k == 1) run_phase<K_CPREP>(args, lds, pass);
            else if (k == 2) run_phase<K_MIX>(args, lds, pass, &bar);
            else if (k == 3) run_phase<K_POST>(args, lds, pass);
            else if (k == 4) run_phase<K_OUT1>(args, lds, pass);
            else if (pass + 1 < NPASS) run_phase<K_OUT2IN>(args, lds, pass);
            else run_phase<K_OUT2>(args, lds, pass);
        }
#ifdef PROBE_TMASK
        const unsigned long long pr_tb = __builtin_amdgcn_s_memrealtime();
#endif
        if (gp + 1 < args.ph_hi) xcd_barrier(bar);
#ifdef PROBE_TMASK
        else __syncthreads();
        if ((PROBE_TMASK >> 11) & 1) pr_acc += __builtin_amdgcn_s_memrealtime() - pr_tb;
        if ((PROBE_TMASK >> pr_kind) & 1) pr_acc += __builtin_amdgcn_s_memrealtime() - pr_t0;
#endif
    }
#ifdef PROBE_TMASK
    if (blockIdx.x == 0) { const unsigned long long t1 = __builtin_amdgcn_s_memrealtime(); while (__builtin_amdgcn_s_memrealtime() - t1 < 4ull * pr_acc) __builtin_amdgcn_s_sleep(8); }
#endif
}
#endif

extern "C" void kernel_launch(void* const* d_in, const int* in_sizes, int n_in, void* d_out, int out_size, void* d_ws, size_t ws_size, hipStream_t stream) {
    static int grid = 0;
    if (grid == 0) {
        if (n_in != 19 || in_sizes[0] != MALL * DM || out_size != MALL * DM || ws_size < WS_END) { fprintf(stderr, "kernel_launch: unexpected shapes (n_in %d, ws %zu)\n", n_in, ws_size); grid = -1; return; }
        int dev = 0, cus = 0, per_cu = 0;
        (void)hipGetDevice(&dev); (void)hipDeviceGetAttribute(&cus, hipDeviceAttributeMultiprocessorCount, dev);
#if MK_ONE_LAUNCH
        (void)hipFuncSetAttribute((const void*)mk_fwd, hipFuncAttributeMaxDynamicSharedMemorySize, LDS_BYTES);
        (void)hipOccupancyMaxActiveBlocksPerMultiprocessor(&per_cu, (const void*)mk_fwd, NTHR, LDS_BYTES);
        if (per_cu < 1) { fprintf(stderr, "kernel_launch: occupancy query says %d\n", per_cu); per_cu = 1; }
#else
#define SETATTR(KIND) (void)hipFuncSetAttribute((const void*)k_phase<KIND>, hipFuncAttributeMaxDynamicSharedMemorySize, LDS_BYTES)
        SETATTR(K_PROLOGUE); SETATTR(K_H); SETATTR(K_INPROJ); SETATTR(K_PREP); SETATTR(K_QK); SETATTR(K_MIX); SETATTR(K_POST); SETATTR(K_OUT1); SETATTR(K_OUT2); SETATTR(K_NORM); SETATTR(K_CPREP); SETATTR(K_OUT2IN);
        (void)per_cu;
#endif
        (void)hipGetLastError();
        grid = cus;
    }
    if (grid < 0) return;
    (void)hipMemsetAsync((char*)d_ws + WS_CTL, 0, CTL_ZERO_BYTES, stream);
    Args a{};
    a.x = (const float*)d_in[0]; a.c = (const float*)d_in[1]; a.pos = (const int*)d_in[2]; a.w_ada = (const float*)d_in[3]; a.b_ada = (const float*)d_in[4];
    a.g_norm = (const float*)d_in[5]; a.w_in = (const float*)d_in[6]; a.b_ig = (const float*)d_in[7]; a.b_fg = (const float*)d_in[8]; a.w_conv = (const float*)d_in[9];
    a.b_conv = (const float*)d_in[10]; a.w_q = (const float*)d_in[11]; a.w_k = (const float*)d_in[12]; a.g_head = (const float*)d_in[13]; a.skip = (const float*)d_in[14];
    a.w_om = (const float*)d_in[15]; a.w_oa = (const float*)d_in[16]; a.w_o = (const float*)d_in[17]; a.g_final = (const float*)d_in[18];
    a.out = (float*)d_out; a.ws = (unsigned char*)d_ws;
#if MK_ONE_LAUNCH
    a.ph_lo = 0; a.ph_hi = PH_TOTAL;
    void* params[] = {&a};
    hipError_t e = hipLaunchCooperativeKernel((const void*)mk_fwd, dim3(grid), dim3(NTHR), params, LDS_BYTES, stream);
    if (e != hipSuccess) fprintf(stderr, "cooperative launch failed: %s\n", hipGetErrorString(e));
#else
#define LAUNCH(KIND, PASS) do { a.ph_lo = (PASS); a.ph_hi = 0; hipLaunchKernelGGL(k_phase<KIND>, dim3(grid), dim3(NTHR), LDS_BYTES, stream, a); } while (0)
    LAUNCH(K_PROLOGUE, 0); LAUNCH(K_H, 0);
    LAUNCH(K_INPROJ, 0);
    for (int p = 0; p < NPASS; ++p) { LAUNCH(K_PREP, p); LAUNCH(K_CPREP, p); LAUNCH(K_MIX, p); LAUNCH(K_POST, p); LAUNCH(K_OUT1, p); if (p + 1 < NPASS) LAUNCH(K_OUT2IN, p); else LAUNCH(K_OUT2, p); }
    LAUNCH(K_NORM, 0);
#endif
}
```

```cpp
#include <hip/hip_runtime.h>
#include <hip/hip_cooperative_groups.h>
#include <cstdio>
#include <cstdint>
namespace cg = cooperative_groups;

#ifndef MK_ONE_LAUNCH
#define MK_ONE_LAUNCH 1
#endif

__device__ __forceinline__ int opaque_tid() { int t = threadIdx.x; asm volatile("" : "+v"(t)); return t; }
namespace pg8 {
#define PG8_LAS __attribute__((address_space(3)))
typedef unsigned short bf16_t;
typedef short bf16x8 __attribute__((ext_vector_type(8)));
typedef float f32x4 __attribute__((ext_vector_type(4)));
typedef unsigned u32x4 __attribute__((ext_vector_type(4)));
constexpr int BM = 256, BK = 64, HALF = 128, HTB = HALF * BK * 2, STAGE_BYTES = 8 * HTB, NXCD = 8, WGM = 8;

__host__ __device__ __forceinline__ int lds_byte(int r, int c) { const int st = (r >> 4) * 2 + (c >> 5), rr = r & 15, cc = c & 31, ob = rr * 64 + cc * 2; return st * 1024 + (ob ^ (((ob >> 9) & 1) << 5)); }
__host__ __device__ __forceinline__ void stage_rc(int b, int& R, int& C) { const int st = b / 1024, sb = b % 1024, swz = sb ^ (((sb >> 9) & 1) << 5); R = (st >> 1) * 16 + swz / 64; C = (st & 1) * 32 + (swz % 64) / 2; }
__host__ __device__ __forceinline__ int perm32(int rho) { const int n = rho >> 4, i = rho & 15; return 8 * (i >> 2) + 4 * n + (i & 3); }

struct Unit { int pm, pn, g; };
template <int LDA, int LDB, int KK, int AGS = 0, int BGS = 0> struct Gemm {
    const bf16_t* A; const bf16_t* Bt;
    static constexpr int lda = LDA, ldb = LDB, K = KK;
    __device__ __forceinline__ const char* abase(const Unit& u) const { return (const char*)A + (size_t)(u.g * AGS) + (size_t)u.pm * (size_t)(BM * 2 * LDA); }
    __device__ __forceinline__ const char* bbase(const Unit& u) const { return (const char*)Bt + (size_t)(u.g * BGS) + (size_t)u.pn * (size_t)(BM * 2 * LDB); }
};

struct StaticOrder {
    int nM, nN, nwg, G, c;
    __host__ __device__ void init(int M, int N, int G_, int c_) { nM = M / BM; nN = N / BM; nwg = nM * nN; G = G_; c = c_; }
    __host__ __device__ bool next(int i, Unit& u) const {
        const long L = (long)i * G + c; if (L >= nwg) return false;
        int wgid = (int)L; { const int q = nwg / NXCD, r = nwg % NXCD, xcd = wgid % NXCD, off = wgid / NXCD; wgid = (xcd < r ? xcd * (q + 1) : r * (q + 1) + (xcd - r) * q) + off; }
        const int nig = WGM * nN, gid = wgid / nig, fm = gid * WGM, gsz = (nM - fm) < WGM ? (nM - fm) : WGM;
        u.pm = fm + ((wgid % nig) % gsz); u.pn = (wgid % nig) / gsz; u.g = 0; return true;
    }
    __device__ __forceinline__ void a_ready(const Unit&) const {}
    __device__ __forceinline__ void done(const Unit&) const {}
};
struct GroupOrder {
    int nunits, G, c;
    __host__ __device__ void init(int M, int G_, int c_) { nunits = (M / BM) * 8; G = G_; c = c_; }
    __host__ __device__ bool next(int i, Unit& u) const {
        const long L = (long)i * G + c; if (L >= nunits) return false;
        u.pm = (int)(L >> 3); u.g = (int)((L & 7) >> 1); u.pn = (int)(L & 1); return true;
    }
    __device__ __forceinline__ void a_ready(const Unit&) const {}
    __device__ __forceinline__ void done(const Unit&) const {}
};

__device__ __forceinline__ unsigned cvt_pk_bf16(float lo, float hi) { unsigned r; asm volatile("v_cvt_pk_bf16_f32 %0, %1, %2" : "=v"(r) : "v"(lo), "v"(hi)); return r; }

template <class Epi, class Sched, bool ALIGN_EPI, bool SP2, class GemmT>
__device__ __forceinline__ void gemm_phase(PG8_LAS unsigned char* lds, const GemmT g, const Sched& S, const Epi& E) {
    const int tid = opaque_tid(), wid = __builtin_amdgcn_readfirstlane(tid >> 6), lane = tid & 63, wr = wid >> 2, wc = wid & 3, fr = lane & 15, fq = lane >> 4;
    constexpr int K = GemmT::K, nt = K / BK;
    unsigned voffA[2], voffB[2];
#pragma unroll
    for (int i = 0; i < 2; ++i) { int R, C; stage_rc(tid * 16 + i * 8192, R, C); const int Rb = Epi::PERM ? (64 * (R >> 5) + perm32(R & 31)) : R;
        voffA[i] = (unsigned)(R * g.lda + C) * 2u; voffB[i] = (unsigned)(Rb * g.ldb + C) * 2u; }
    const size_t kstep = (size_t)(BK * 2);
    const size_t hstepA = (size_t)HALF * g.lda * 2, hstepB = (size_t)(Epi::PERM ? 32 : HALF) * g.ldb * 2;
    const unsigned ldsw = (unsigned)wid * 1024u;
    const int aoff = lds_byte(wr * 64 + fr, fq * 8), boff = lds_byte(wc * 32 + fr, fq * 8);
#define PG8_SA(b, h) (((b) * 2 + (h)) * HTB)
#define PG8_SB(b, h) ((4 + (b) * 2 + (h)) * HTB)
#define PG8_STAGE(bufoff, gbase, voff) do { _Pragma("unroll") for (int _i = 0; _i < 2; ++_i) \
        __builtin_amdgcn_global_load_lds((const unsigned*)((const char*)(gbase) + (voff)[_i]), (PG8_LAS unsigned*)(lds + (bufoff) + ldsw + _i * 8192), 16, 0, 0); } while (0)
#define PG8_LDA(dst, b, h) do { _Pragma("unroll") for (int m = 0; m < 4; ++m) _Pragma("unroll") for (int k = 0; k < 2; ++k) dst[m][k] = *(const PG8_LAS bf16x8*)(lds + PG8_SA(b, h) + aoff + m * 2048 + k * 1024); } while (0)
#define PG8_LDB(dst, b, h) do { _Pragma("unroll") for (int n = 0; n < 2; ++n) _Pragma("unroll") for (int k = 0; k < 2; ++k) dst[n][k] = *(const PG8_LAS bf16x8*)(lds + PG8_SB(b, h) + boff + n * 2048 + k * 1024); } while (0)
#define PG8_MMA(ai, bj, At, Bt) do { __builtin_amdgcn_s_setprio(1); _Pragma("unroll") for (int m = 0; m < 4; ++m) _Pragma("unroll") for (int n = 0; n < 2; ++n) _Pragma("unroll") for (int k = 0; k < 2; ++k) \
        acc[ai][bj][m][n] = __builtin_amdgcn_mfma_f32_16x16x32_bf16(Bt[n][k], At[m][k], acc[ai][bj][m][n], 0, 0, 0); __builtin_amdgcn_s_setprio(0); } while (0)
#define PG8_WAIT_V(n) asm volatile("s_waitcnt vmcnt(" #n ")" ::: "memory")
#define PG8_WAIT_L(n) asm volatile("s_waitcnt lgkmcnt(" #n ")" ::: "memory")
#define PG8_BAR __builtin_amdgcn_s_barrier()
#define PG8_SCHED __builtin_amdgcn_sched_barrier(0)
    Unit cur, nxt; int ui = 0;
    if (!S.next(0, cur)) return;
    f32x4 acc[2][2][4][2];
#pragma unroll
    for (int a = 0; a < 2; ++a)
#pragma unroll
        for (int b = 0; b < 2; ++b)
#pragma unroll
            for (int m = 0; m < 4; ++m)
#pragma unroll
                for (int n = 0; n < 2; ++n) acc[a][b][m][n] = (f32x4){0.f, 0.f, 0.f, 0.f};
    bf16x8 At[4][2], B0[2][2], B1[2][2];
    const char* cA = g.abase(cur); const char* cB = g.bbase(cur);
    S.a_ready(cur);
    if constexpr (SP2) {
        PG8_STAGE(PG8_SB(0, 0), cB, voffB); PG8_STAGE(PG8_SB(0, 1), cB + hstepB, voffB); PG8_STAGE(PG8_SA(0, 0), cA, voffA); PG8_STAGE(PG8_SA(0, 1), cA + hstepA, voffA);
        if (wr == 1) PG8_BAR;
        PG8_WAIT_V(2); PG8_BAR;
        PG8_STAGE(PG8_SB(1, 0), cB + kstep, voffB); PG8_STAGE(PG8_SA(1, 0), cA + kstep, voffA); PG8_STAGE(PG8_SB(1, 1), cB + hstepB + kstep, voffB);
        PG8_WAIT_V(6); PG8_BAR;
    } else {
        PG8_STAGE(PG8_SB(0, 0), cB, voffB); PG8_STAGE(PG8_SA(0, 0), cA, voffA); PG8_STAGE(PG8_SB(0, 1), cB + hstepB, voffB); PG8_STAGE(PG8_SA(0, 1), cA + hstepA, voffA);
        if (wr == 1) PG8_BAR;
        PG8_WAIT_V(4); PG8_BAR;
        PG8_STAGE(PG8_SB(1, 0), cB + kstep, voffB); PG8_STAGE(PG8_SA(1, 0), cA + kstep, voffA); PG8_STAGE(PG8_SB(1, 1), cB + hstepB + kstep, voffB);
        PG8_WAIT_V(6); PG8_BAR;
    }
    for (;;) {
        const bool has_next = S.next(ui + 1, nxt);
        const char* nA = has_next ? g.abase(nxt) : cA; const char* nB = has_next ? g.bbase(nxt) : cB;
#pragma nounroll
        for (int t = 0; t < nt; t += 2) {
            const bool last = (t == nt - 2);
            const char* a1 = cA + (size_t)(t + 1) * kstep;
            const char* a2 = last ? nA : cA + (size_t)(t + 2) * kstep; const char* b2 = last ? nB : cB + (size_t)(t + 2) * kstep;
            const char* a3 = a2 + kstep; const char* b3 = b2 + kstep;
            if (last && has_next) S.a_ready(nxt);
            if constexpr (Epi::HOOK_T >= 0) { if (t == Epi::HOOK_T) E.hook(acc, cur, wr, wc, fr, fq); }
            if constexpr (SP2) {
            PG8_LDB(B0, 0, 0); PG8_LDB(B1, 0, 1); PG8_SCHED; PG8_LDA(At, 0, 0); PG8_STAGE(PG8_SA(1, 1), a1 + hstepA, voffA);
            PG8_WAIT_V(8); PG8_WAIT_L(0); PG8_BAR; PG8_MMA(0, 0, At, B0); PG8_MMA(0, 1, At, B1); PG8_BAR; PG8_SCHED;
            PG8_LDA(At, 0, 1); PG8_STAGE(PG8_SB(0, 0), b2, voffB); PG8_STAGE(PG8_SB(0, 1), b2 + hstepB, voffB); PG8_STAGE(PG8_SA(0, 0), a2, voffA);
            PG8_WAIT_V(8); PG8_WAIT_L(0); PG8_BAR; PG8_MMA(1, 0, At, B0); PG8_MMA(1, 1, At, B1); PG8_BAR; PG8_SCHED;
            PG8_LDB(B0, 1, 0); PG8_LDB(B1, 1, 1); PG8_SCHED; PG8_LDA(At, 1, 0); PG8_STAGE(PG8_SA(0, 1), a2 + hstepA, voffA);
            PG8_WAIT_V(8); PG8_WAIT_L(0); PG8_BAR; PG8_MMA(0, 0, At, B0); PG8_MMA(0, 1, At, B1); PG8_BAR; PG8_SCHED;
            PG8_LDA(At, 1, 1); PG8_STAGE(PG8_SB(1, 0), b3, voffB); PG8_STAGE(PG8_SB(1, 1), b3 + hstepB, voffB); PG8_STAGE(PG8_SA(1, 0), a3, voffA);
            PG8_WAIT_V(8); PG8_WAIT_L(0); PG8_BAR; PG8_MMA(1, 0, At, B0); PG8_MMA(1, 1, At, B1); PG8_BAR; PG8_SCHED;
            } else {
            PG8_LDB(B0, 0, 0); PG8_SCHED; PG8_LDA(At, 0, 0); PG8_STAGE(PG8_SA(1, 1), a1 + hstepA, voffA);
            PG8_WAIT_L(8); PG8_BAR; PG8_WAIT_L(0); PG8_MMA(0, 0, At, B0); PG8_BAR; PG8_SCHED;
            PG8_LDB(B1, 0, 1); PG8_STAGE(PG8_SB(0, 0), b2, voffB);
            PG8_BAR; PG8_WAIT_L(0); PG8_MMA(0, 1, At, B1); PG8_BAR;
            PG8_LDA(At, 0, 1); PG8_STAGE(PG8_SA(0, 0), a2, voffA);
            PG8_BAR; PG8_WAIT_L(0); PG8_MMA(1, 0, At, B0); PG8_BAR; PG8_SCHED;
            PG8_STAGE(PG8_SB(0, 1), b2 + hstepB, voffB);
            PG8_WAIT_V(6); PG8_BAR; PG8_MMA(1, 1, At, B1); PG8_BAR;
            PG8_LDB(B0, 1, 0); PG8_SCHED; PG8_LDA(At, 1, 0); PG8_STAGE(PG8_SA(0, 1), a2 + hstepA, voffA);
            PG8_WAIT_L(8); PG8_BAR; PG8_WAIT_L(0); PG8_MMA(0, 0, At, B0); PG8_BAR; PG8_SCHED;
            PG8_LDB(B1, 1, 1); PG8_STAGE(PG8_SB(1, 0), b3, voffB);
            PG8_BAR; PG8_WAIT_L(0); PG8_MMA(0, 1, At, B1); PG8_BAR;
            PG8_LDA(At, 1, 1); PG8_STAGE(PG8_SA(1, 0), a3, voffA);
            PG8_BAR; PG8_WAIT_L(0); PG8_MMA(1, 0, At, B0); PG8_BAR; PG8_SCHED;
            PG8_STAGE(PG8_SB(1, 1), b3 + hstepB, voffB);
            PG8_WAIT_V(6); PG8_BAR; PG8_MMA(1, 1, At, B1); PG8_BAR;
            }
        }
        if constexpr (ALIGN_EPI) { if (wr == 0) PG8_BAR; }
        E(acc, cur, wr, wc, fr, fq); S.done(cur);
        if (!has_next) break;
#pragma unroll
        for (int a = 0; a < 2; ++a)
#pragma unroll
            for (int b = 0; b < 2; ++b)
#pragma unroll
                for (int m = 0; m < 4; ++m)
#pragma unroll
                    for (int n = 0; n < 2; ++n) acc[a][b][m][n] = (f32x4){0.f, 0.f, 0.f, 0.f};
        cur = nxt; cA = nA; cB = nB; ++ui;
        if constexpr (ALIGN_EPI) { if (wr == 1) PG8_BAR; }
    }
    PG8_WAIT_V(0);
    if constexpr (!ALIGN_EPI) { if (wr == 0) PG8_BAR; }
    PG8_BAR;
#undef PG8_SA
#undef PG8_SB
#undef PG8_STAGE
#undef PG8_LDA
#undef PG8_LDB
#undef PG8_MMA
#undef PG8_WAIT_V
#undef PG8_WAIT_L
#undef PG8_BAR
#undef PG8_SCHED
}
}

constexpr int NWAVES = 8, NTHR = 512;
constexpr int DM = 1024, NBATCH = 16, SEQ = 4096, MALL = NBATCH * SEQ;
constexpr int NB_PASS = 4, MS = NB_PASS * SEQ, NPASS = NBATCH / NB_PASS;
constexpr int INW_SRC = 11272, INW = 11264;
constexpr int C_XA = 0, C_VA = 1024, C_OA = 2048, C_ZA = 3072, C_QA = 4096, C_KA = 5632, C_VT = 7168, C_ZB = 8704, C_GA = 9216, C_GB = 10240;
constexpr float EPS = 1e-6f;

constexpr size_t MiB = 1u << 20;
constexpr size_t WS_CTL = 0, CTL_ZERO_BYTES = 1 * MiB;
constexpr size_t WS_MOD = 1 * MiB;
constexpr size_t WS_WG = 1 * MiB + 256 * 1024;
constexpr size_t WS_WIN = 2 * MiB;
constexpr size_t WS_WQK = 24 * MiB;
constexpr size_t WS_WOM = 25 * MiB, WS_WOA = 27 * MiB, WS_WO = 28 * MiB;
constexpr size_t WS_IG = 30 * MiB, WS_FG = 31 * MiB;
constexpr size_t WS_GSC = 580 * MiB, GSC_STRIDE = 2 * MiB;
constexpr size_t WS_LSE = 34 * MiB;
constexpr size_t WS_DEN = 35 * MiB;
constexpr size_t WS_H = 36 * MiB;
constexpr size_t WS_P = 164 * MiB;
constexpr size_t WS_XC = 516 * MiB;
constexpr size_t WS_QM = 548 * MiB, WS_KM = 580 * MiB;
constexpr size_t WS_HR = 612 * MiB;
constexpr size_t WS_AO = 644 * MiB;
constexpr size_t WS_UA = 692 * MiB;
constexpr size_t WS_ACAT = 708 * MiB;
constexpr size_t WS_MG = 772 * MiB;
constexpr size_t WS_SG = 804 * MiB;
constexpr size_t WS_KTG = 812 * MiB;
constexpr size_t WS_VTG = 844 * MiB;
constexpr size_t WS_CS = 876 * MiB;
constexpr size_t WS_NS = 1004 * MiB;
constexpr size_t WS_ROPE = 1005 * MiB;
constexpr size_t WS_END = 1013 * MiB;
constexpr int CW_QCTR = 1024;
constexpr int CW_ROWSS = 65536;
static_assert((CW_ROWSS + MALL) * 4 <= (int)CTL_ZERO_BYTES, "ctl");

constexpr int LDS_BYTES = 147456;

typedef unsigned short bf16;
typedef float f32x4 __attribute__((ext_vector_type(4)));
typedef float f32x2 __attribute__((ext_vector_type(2)));
typedef short bf16x8 __attribute__((ext_vector_type(8)));
typedef unsigned u32x4 __attribute__((ext_vector_type(4)));
typedef unsigned u32x2 __attribute__((ext_vector_type(2)));
typedef short s16x4 __attribute__((ext_vector_type(4)));

__device__ __forceinline__ unsigned f2bf(float f) { unsigned u = __builtin_bit_cast(unsigned, f); return (u + 0x7fffu + ((u >> 16) & 1u)) >> 16; }
__device__ __forceinline__ unsigned pk2(float lo, float hi) { return f2bf(lo) | (f2bf(hi) << 16); }
__device__ __forceinline__ float bflo(unsigned w) { return __builtin_bit_cast(float, w << 16); }
__device__ __forceinline__ float bfhi(unsigned w) { return __builtin_bit_cast(float, w & 0xffff0000u); }
__device__ __forceinline__ float bf1(bf16 v) { return __builtin_bit_cast(float, (unsigned)v << 16); }
__device__ __forceinline__ float sigmoidf_(float x) { return 1.f / (1.f + __expf(-x)); }
__device__ __forceinline__ float siluf_(float x) { return x / (1.f + __expf(-x)); }
__device__ __forceinline__ float wave_sum(float v) {
#pragma unroll
    for (int o = 1; o < 64; o <<= 1) v += __shfl_xor(v, o);
    return v;
}
__device__ __forceinline__ void unpack8(const u32x4 w, float* f) {
    f[0] = bflo(w.x); f[1] = bfhi(w.x); f[2] = bflo(w.y); f[3] = bfhi(w.y); f[4] = bflo(w.z); f[5] = bfhi(w.z); f[6] = bflo(w.w); f[7] = bfhi(w.w);
}

struct Args {
    const float* x; const float* c; const int* pos; const float* w_ada; const float* b_ada; const float* g_norm; const float* w_in;
    const float* b_ig; const float* b_fg; const float* w_conv; const float* b_conv; const float* w_q; const float* w_k; const float* g_head;
    const float* skip; const float* w_om; const float* w_oa; const float* w_o; const float* g_final;
    float* out; unsigned char* ws; int ph_lo, ph_hi;
};

__device__ __forceinline__ void transpose_item(const float* W, int K, int Nsrc, int nblk, int src_col_off, bf16* WT, int ldt, int row_off, float scale, float* scr, int item, int lane, bool frag = false) {
    const int kb = item / nblk, nb = item % nblk, k0 = 64 * kb, n0 = 32 * nb;
#pragma unroll 8
    for (int i = 0; i < 32; ++i) { const int kk = 2 * i + (lane >> 5); scr[kk * 33 + (lane & 31)] = W[(size_t)(k0 + kk) * Nsrc + src_col_off + n0 + (lane & 31)]; }
    __builtin_amdgcn_wave_barrier();
    asm volatile("s_waitcnt lgkmcnt(0)" ::: "memory");
    const int cc = lane & 7;
#pragma unroll
    for (int j = 0; j < 4; ++j) { const int n = (lane >> 3) + 8 * j; const float* s = scr + (8 * cc) * 33 + n;
        u32x4 o; o.x = pk2(s[0 * 33] * scale, s[1 * 33] * scale); o.y = pk2(s[2 * 33] * scale, s[3 * 33] * scale); o.z = pk2(s[4 * 33] * scale, s[5 * 33] * scale); o.w = pk2(s[6 * 33] * scale, s[7 * 33] * scale);
        if (frag) { const int nn = row_off + n0 + n, kc = (k0 >> 3) + cc; *(u32x4*)(WT + (size_t)((((nn >> 4) * (K >> 5) + (kc >> 2)) * 64 + (kc & 3) * 16 + (nn & 15)) * 8)) = o; }
        else *(u32x4*)(WT + (size_t)(row_off + n0 + n) * ldt + k0 + 8 * cc) = o; }
    asm volatile("s_waitcnt lgkmcnt(0)" ::: "memory");
    __builtin_amdgcn_wave_barrier();
}

__device__ __forceinline__ void phase_prologue(const Args& a, unsigned char* lds, int vcu, int G) {
    const int tid = opaque_tid(), lane = tid & 63, wave = tid >> 6;
    unsigned char* ws = a.ws;
    if (vcu < 192) {
        float* sc = (float*)lds;
        float* red = (float*)(lds + 65536);
        for (int i = tid; i < 16 * 1024; i += NTHR) sc[i] = siluf_(a.c[i]);
        __syncthreads();
        const int col = lane & 15, ksub = lane >> 4, n = vcu * 16 + col;
        float acc[16];
#pragma unroll
        for (int b = 0; b < 16; ++b) acc[b] = 0.f;
        const int k0 = wave * 128 + ksub * 32;
        const float* wp = a.w_ada + (size_t)k0 * 3072 + n;
#pragma unroll 1
        for (int kc = 0; kc < 8; ++kc) {
            const float w0 = wp[(size_t)(4 * kc) * 3072], w1 = wp[(size_t)(4 * kc + 1) * 3072], w2 = wp[(size_t)(4 * kc + 2) * 3072], w3 = wp[(size_t)(4 * kc + 3) * 3072];
#pragma unroll
            for (int b = 0; b < 16; ++b) { const f32x4 s4 = *(const f32x4*)(sc + b * 1024 + k0 + 4 * kc); acc[b] += (s4.x * w0 + s4.y * w1) + (s4.z * w2 + s4.w * w3); }
        }
#pragma unroll
        for (int b = 0; b < 16; ++b) { float v = acc[b]; v += __shfl_xor(v, 16); v += __shfl_xor(v, 32); if (ksub == 0) red[(wave * 16 + b) * 16 + col] = v; }
        __syncthreads();
        float* mod = (float*)(ws + WS_MOD);
        if (tid < 256) { const int b = tid >> 4, l = tid & 15, nn = vcu * 16 + l; float s_ = 0.f;
#pragma unroll
            for (int w = 0; w < 8; ++w) s_ += red[(w * 16 + b) * 16 + l];
            s_ += a.b_ada[nn];
            const int part = nn >> 10, cc = nn & 1023;
            if (part == 1) s_ = a.g_norm[cc] * (1.f + s_);
            mod[b * 3072 + nn] = s_; }
        __syncthreads();
    }
    {
        float* scr = (float*)lds + wave * (64 * 33);
        const int gw = vcu * NWAVES + wave, NGW = G * NWAVES;
        constexpr int I_IN = (1024 / 64) * (INW / 32);
        constexpr int I_QK = 8 * (256 / 64) * (256 / 32);
        constexpr int I_OM = 16 * 32, I_OA = 8 * 32, I_O = 16 * 32;
        constexpr int NITEMS = I_IN + I_QK + I_OM + I_OA + I_O;
        for (int it = gw; it < NITEMS; it += NGW) {
            int r = it;
            if (r < I_IN) { const int nb = r % (INW / 32); const int off = (nb * 32 >= 4096) ? 8 : 0;
                transpose_item(a.w_in, 1024, INW_SRC, INW / 32, off, (bf16*)(ws + WS_WIN), 1024, 0, 1.f, scr, r, lane); continue; } r -= I_IN;
            if (r < I_QK) { const int mtx = r >> 5, rr = r & 31, h = mtx >> 1, isk = mtx & 1;
                const float* W = (isk ? a.w_k : a.w_q) + (size_t)h * 65536;
                transpose_item(W, 256, 256, 8, 0, (bf16*)(ws + WS_WQK) + (size_t)h * 512 * 256, 256, isk * 256, isk ? 0.0625f : 1.f, scr, rr, lane, true); continue; } r -= I_QK;
            if (r < I_OM) { transpose_item(a.w_om, 1024, 1024, 32, 0, (bf16*)(ws + WS_WOM), 1536, 0, 1.f, scr, r, lane); continue; } r -= I_OM;
            if (r < I_OA) { transpose_item(a.w_oa, 512, 1024, 32, 0, (bf16*)(ws + WS_WOM) + 1024, 1536, 0, 1.f, scr, r, lane); continue; } r -= I_OA;
            transpose_item(a.w_o, 1024, 1024, 32, 0, (bf16*)(ws + WS_WO), 1024, 0, 1.f, scr, r, lane);
        }
        float* wg = (float*)(ws + WS_WG);
        for (int i = (vcu * NTHR + tid); i < 8 * 1024; i += G * NTHR) { const int j = i >> 10, k = i & 1023; wg[i] = a.w_in[(size_t)k * INW_SRC + 4096 + j]; }
    }
}

__constant__ double c_inv_freq[16] = {1.0, 0.44036660267178046, 0.19392274474868576, 0.08539710028576561, 0.03760603093086393, 0.016560440080994446, 0.007292664737217109, 0.003211445994752591,
    0.001414213562373095, 0.000622772421914596, 0.0002742481756762073, 0.00012076973741146504, 5.318295896944988e-05, 2.341999896140934e-05, 1.031338537721246e-05, 4.5416704806078695e-06};

__device__ __forceinline__ void phase_h(const Args& a, unsigned char* lds, int vcu, int G) {
    const int tid = opaque_tid(), lane = tid & 63, wave = tid >> 6;
    unsigned char* ws = a.ws;
    float* wg = (float*)lds;
    { const float* src = (const float*)(ws + WS_WG); for (int i = tid; i < 8192; i += NTHR) wg[i] = src[i]; }
    __syncthreads();
    const float* mod = (const float*)(ws + WS_MOD);
    bf16* H = (bf16*)(ws + WS_H);
    float* IG = (float*)(ws + WS_IG); float* FG = (float*)(ws + WS_FG); float* ROPE = (float*)(ws + WS_ROPE);
    const int gw = vcu * NWAVES + wave, NGW = G * NWAVES;
    for (int row0 = 2 * gw; row0 < MALL; row0 += 2 * NGW) {
        f32x4 v[2][4]; float ss[2] = {0.f, 0.f};
#pragma unroll
        for (int rr = 0; rr < 2; ++rr) { const f32x4* xr = (const f32x4*)(a.x + (size_t)(row0 + rr) * DM) + lane;
#pragma unroll
            for (int j = 0; j < 4; ++j) v[rr][j] = xr[64 * j]; }
        { const int rr = lane >> 5, fi = lane & 15; const int pos = a.pos[row0 + rr];
            const double rev = (double)pos * c_inv_freq[fi] * 0.15915494309189535; const float fr_ = (float)(rev - rint(rev));
            ROPE[(size_t)row0 * 32 + lane] = (lane & 16) ? __builtin_amdgcn_sinf(fr_) : __builtin_amdgcn_cosf(fr_); }
#pragma unroll
        for (int rr = 0; rr < 2; ++rr) {
#pragma unroll
            for (int j = 0; j < 4; ++j) ss[rr] += (v[rr][j].x * v[rr][j].x + v[rr][j].y * v[rr][j].y) + (v[rr][j].z * v[rr][j].z + v[rr][j].w * v[rr][j].w);
        }
#pragma unroll
        for (int o = 1; o < 64; o <<= 1) { ss[0] += __shfl_xor(ss[0], o); ss[1] += __shfl_xor(ss[1], o); }
        const int b = row0 >> 12;
        float pg[2][8];
#pragma unroll
        for (int rr = 0; rr < 2; ++rr)
#pragma unroll
            for (int g = 0; g < 8; ++g) pg[rr][g] = 0.f;
        const float rinv[2] = {1.f / sqrtf(ss[0] * (1.f / DM) + EPS), 1.f / sqrtf(ss[1] * (1.f / DM) + EPS)};
#pragma unroll
        for (int j = 0; j < 4; ++j) {
            const int col = 4 * lane + 256 * j;
            const f32x4 sh = *(const f32x4*)(mod + b * 3072 + col), gs = *(const f32x4*)(mod + b * 3072 + 1024 + col);
            f32x4 h[2];
#pragma unroll
            for (int rr = 0; rr < 2; ++rr) { h[rr] = v[rr][j] * rinv[rr] * gs + sh;
                u32x2 o; o.x = pk2(h[rr].x, h[rr].y); o.y = pk2(h[rr].z, h[rr].w); *((u32x2*)(H + (size_t)(row0 + rr) * DM) + lane + 64 * j) = o; }
#pragma unroll
            for (int g = 0; g < 8; ++g) { const f32x4 w = *(const f32x4*)(wg + g * 1024 + col);
                pg[0][g] += (h[0].x * w.x + h[0].y * w.y) + (h[0].z * w.z + h[0].w * w.w); pg[1][g] += (h[1].x * w.x + h[1].y * w.y) + (h[1].z * w.z + h[1].w * w.w); }
            __builtin_amdgcn_sched_barrier(0);
        }
#pragma unroll
        for (int o = 1; o < 64; o <<= 1)
#pragma unroll
            for (int g = 0; g < 8; ++g) { pg[0][g] += __shfl_xor(pg[0][g], o); pg[1][g] += __shfl_xor(pg[1][g], o); }
        if (lane < 2) { const int rr = lane; const float* p = rr ? pg[1] : pg[0];
            f32x4 ig = {p[0] + a.b_ig[0], p[1] + a.b_ig[1], p[2] + a.b_ig[2], p[3] + a.b_ig[3]};
            f32x4 fg = {p[4] + a.b_fg[0], p[5] + a.b_fg[1], p[6] + a.b_fg[2], p[7] + a.b_fg[3]};
            *(f32x4*)(IG + (size_t)(row0 + rr) * 4) = ig; *(f32x4*)(FG + (size_t)(row0 + rr) * 4) = fg; }
    }
}

struct EpiProj {
    static constexpr bool PERM = true; static constexpr int HOOK_T = -1;
    bf16* P; const float* rope;
    __device__ __forceinline__ void operator()(const f32x4 (&acc)[2][2][4][2], const pg8::Unit& u, int wr, int wc, int fr, int fq) const {
        const int row0 = u.pm * 256 + wr * 64 + fr, col0 = u.pn * 256 + wc * 64 + 8 * fq;
        const bool rot = (u.pn >= 16) && (u.pn < 28) && ((wc & 1) == 0);
#pragma unroll
        for (int ai = 0; ai < 2; ++ai)
#pragma unroll
            for (int m = 0; m < 4; ++m) { const int r = row0 + ai * 128 + m * 16; bf16* rowp = P + (size_t)r * INW + col0;
#pragma unroll
                for (int bj = 0; bj < 2; ++bj) { f32x4 v0 = acc[ai][bj][m][0], v1 = acc[ai][bj][m][1];
                    if (bj == 0 && rot) {
                        const float* tp = rope + (size_t)r * 32 + 8 * (fq & 1);
                        const f32x4 c0 = *(const f32x4*)tp, c1 = *(const f32x4*)(tp + 4), s0 = *(const f32x4*)(tp + 16), s1 = *(const f32x4*)(tp + 20);
                        f32x4 p0, p1;
#pragma unroll
                        for (int e = 0; e < 4; ++e) { p0[e] = __shfl_xor(v0[e], 32); p1[e] = __shfl_xor(v1[e], 32); }
                        const float sg = (fq < 2) ? -1.f : 1.f;
                        v0 = v0 * c0 + p0 * s0 * sg; v1 = v1 * c1 + p1 * s1 * sg;
                    }
                    u32x4 w; w.x = pg8::cvt_pk_bf16(v0[0], v0[1]); w.y = pg8::cvt_pk_bf16(v0[2], v0[3]); w.z = pg8::cvt_pk_bf16(v1[0], v1[1]); w.w = pg8::cvt_pk_bf16(v1[2], v1[3]);
                    *(u32x4*)(rowp + bj * 32) = w; } }
    }
};
struct EpiQK {
    static constexpr bool PERM = true; static constexpr int HOOK_T = -1;
    bf16* QM; bf16* KM;
    __device__ __forceinline__ void operator()(const f32x4 (&acc)[2][2][4][2], const pg8::Unit& u, int wr, int wc, int fr, int fq) const {
        const int row0 = u.pm * 256 + wr * 64 + fr, col0 = u.g * 256 + wc * 64 + 8 * fq;
        bf16* base = u.pn ? KM : QM;
#pragma unroll
        for (int ai = 0; ai < 2; ++ai)
#pragma unroll
            for (int m = 0; m < 4; ++m) { bf16* rowp = base + (size_t)(row0 + ai * 128 + m * 16) * 1024 + col0;
#pragma unroll
                for (int bj = 0; bj < 2; ++bj) { const f32x4 v0 = acc[ai][bj][m][0], v1 = acc[ai][bj][m][1];
                    u32x4 w; w.x = pg8::cvt_pk_bf16(v0[0], v0[1]); w.y = pg8::cvt_pk_bf16(v0[2], v0[3]); w.z = pg8::cvt_pk_bf16(v1[0], v1[1]); w.w = pg8::cvt_pk_bf16(v1[2], v1[3]);
                    *(u32x4*)(rowp + bj * 32) = w; } }
    }
};
struct EpiMerge {
    static constexpr bool PERM = true; static constexpr int HOOK_T = 16;
    const bf16* P; bf16* MG;
    __device__ __forceinline__ void hook(f32x4 (&acc)[2][2][4][2], const pg8::Unit& u, int wr, int wc, int fr, int fq) const {
        int row0 = u.pm * 256 + wr * 64 + fr, col0 = u.pn * 256 + wc * 64 + 8 * fq;
        asm volatile("" : "+v"(row0), "+v"(col0));
#pragma unroll
        for (int ai = 0; ai < 2; ++ai)
#pragma unroll
            for (int m = 0; m < 4; ++m) { const size_t r = (size_t)(row0 + ai * 128 + m * 16);
#pragma unroll
                for (int bj = 0; bj < 2; ++bj) { const int c = col0 + bj * 32;
                    const u32x4 gaw = *(const u32x4*)(P + r * INW + C_GA + c), gbw = *(const u32x4*)(P + r * INW + C_GB + c);
                    float ga[8], gb[8]; unpack8(gaw, ga); unpack8(gbw, gb);
#pragma unroll
                    for (int e = 0; e < 4; ++e) {
                        acc[ai][bj][m][0][e] *= (1.f + __expf(-gb[e])) / (1.f + __expf(-ga[e]));
                        acc[ai][bj][m][1][e] *= (1.f + __expf(-gb[4 + e])) / (1.f + __expf(-ga[4 + e])); } }
                __builtin_amdgcn_sched_barrier(0); }
    }
    __device__ __forceinline__ void operator()(const f32x4 (&acc)[2][2][4][2], const pg8::Unit& u, int wr, int wc, int fr, int fq) const {
        const int row0 = u.pm * 256 + wr * 64 + fr, col0 = u.pn * 256 + wc * 64 + 8 * fq;
#pragma unroll
        for (int ai = 0; ai < 2; ++ai)
#pragma unroll
            for (int m = 0; m < 4; ++m) { const size_t r = (size_t)(row0 + ai * 128 + m * 16);
#pragma unroll
                for (int bj = 0; bj < 2; ++bj) { const int c = col0 + bj * 32;
                    const u32x4 gbw = *(const u32x4*)(P + r * INW + C_GB + c); float gb[8]; unpack8(gbw, gb);
                    const f32x4 v0 = acc[ai][bj][m][0], v1 = acc[ai][bj][m][1];
                    float o[8];
#pragma unroll
                    for (int e = 0; e < 4; ++e) { o[e] = sigmoidf_(gb[e]) * v0[e]; o[4 + e] = sigmoidf_(gb[4 + e]) * v1[e]; }
                    u32x4 w; w.x = pg8::cvt_pk_bf16(o[0], o[1]); w.y = pg8::cvt_pk_bf16(o[2], o[3]); w.z = pg8::cvt_pk_bf16(o[4], o[5]); w.w = pg8::cvt_pk_bf16(o[6], o[7]);
                    *(u32x4*)(MG + r * 1024 + c) = w; } }
    }
};
struct EpiOut {
    static constexpr bool PERM = true; static constexpr int HOOK_T = -1;
    bf16* dl; const float* gate; int grow0;
    __device__ __forceinline__ void operator()(const f32x4 (&acc)[2][2][4][2], const pg8::Unit& u, int wr, int wc, int fr, int fq) const {
        const int row0 = grow0 + u.pm * 256 + wr * 64 + fr, col0 = u.pn * 256 + wc * 64 + 8 * fq;
        const int b = row0 >> 12;
#pragma unroll
        for (int ai = 0; ai < 2; ++ai)
#pragma unroll
            for (int m = 0; m < 4; ++m) { const int r = row0 + ai * 128 + m * 16;
#pragma unroll
                for (int bj = 0; bj < 2; ++bj) { const int c = col0 + bj * 32;
                    const float* gp = gate + b * 3072 + c; const f32x4 g0 = *(const f32x4*)gp, g1 = *(const f32x4*)(gp + 4);
                    const f32x4 o0 = g0 * acc[ai][bj][m][0], o1 = g1 * acc[ai][bj][m][1];
                    u32x4 w; w.x = pg8::cvt_pk_bf16(o0[0], o0[1]); w.y = pg8::cvt_pk_bf16(o0[2], o0[3]); w.z = pg8::cvt_pk_bf16(o1[0], o1[1]); w.w = pg8::cvt_pk_bf16(o1[2], o1[3]);
                    *(u32x4*)(dl + (size_t)r * 1024 + c) = w; } }
    }
};

struct ComboOrder {
    pg8::StaticOrder so, si; int nO, G, c;
    __device__ void init(int G_, int c_) { G = G_; c = c_; so.init(MS, 1024, 1, 0); si.init(MS, INW, 1, 0); nO = so.nwg; }
    __device__ bool next(int i, pg8::Unit& u) const {
        const int L = i * G + c;
        if (L < nO) { so.next(L, u); u.g = 0; return true; }
        if (!si.next(L - nO, u)) return false;
        u.g = 1; return true;
    }
    __device__ __forceinline__ void a_ready(const pg8::Unit&) const {}
    __device__ __forceinline__ void done(const pg8::Unit&) const {}
};
struct GemmCombo {
    const bf16* A0; const bf16* B0; const bf16* A1; const bf16* B1;
    static constexpr int lda = 1024, ldb = 1024, K = 1024;
    __device__ __forceinline__ const char* abase(const pg8::Unit& u) const { return (const char*)(u.g ? A1 : A0) + (size_t)u.pm * (size_t)(pg8::BM * 2 * 1024); }
    __device__ __forceinline__ const char* bbase(const pg8::Unit& u) const { return (const char*)(u.g ? B1 : B0) + (size_t)u.pn * (size_t)(pg8::BM * 2 * 1024); }
};
struct EpiCombo {
    static constexpr bool PERM = true; static constexpr int HOOK_T = -1;
    EpiOut eo; EpiProj ep;
    __device__ __forceinline__ void operator()(const f32x4 (&acc)[2][2][4][2], const pg8::Unit& u, int wr, int wc, int fr, int fq) const {
        if (u.g) ep(acc, u, wr, wc, fr, fq); else eo(acc, u, wr, wc, fr, fq);
    }
};

__device__ __forceinline__ void phase_gates(const Args& a, unsigned char* lds, int vcu, int G) {
    const int tid = opaque_tid(), lane = tid & 63, wave = tid >> 6;
    unsigned char* ws = a.ws;
    for (int gi = vcu; gi < NBATCH * 4; gi += G) {
        const int pass = gi >> 4, bl = (gi >> 2) & 3, h = gi & 3;
        const float* IG = (const float*)(ws + WS_IG); const float* FG = (const float*)(ws + WS_FG);
        float* gsc = (float*)(ws + WS_GSC + (size_t)pass * GSC_STRIDE);
        float* A1 = gsc, *B1 = gsc + MS * 4, *WI = gsc + 2 * MS * 4, *EF = gsc + 3 * MS * 4, *WK = gsc + 4 * MS * 4, *DEC = gsc + 5 * MS * 4;
        float* cg = (float*)lds; float* cp = cg + 64;
        __syncthreads();
        float f[8], ii[8];
#pragma unroll
        for (int q = 0; q < 8; ++q) { const size_t grow = (size_t)pass * MS + bl * SEQ + (wave * 8 + q) * 64 + lane; f[q] = FG[grow * 4 + h]; ii[q] = IG[grow * 4 + h]; }
        float acs[8], b1[8], pm[8];
#pragma unroll
        for (int q = 0; q < 8; ++q) {
            float x = fminf(f[q], 0.f) - log1pf(expf(-fabsf(f[q])));
#pragma unroll
            for (int o = 1; o < 64; o <<= 1) { const float t = __shfl_up(x, o); if (lane >= o) x += t; }
            acs[q] = x; b1[q] = ii[q] - x;
            float m = b1[q];
#pragma unroll
            for (int o = 1; o < 64; o <<= 1) { const float t = __shfl_up(m, o); if (lane >= o) m = fmaxf(m, t); }
            pm[q] = m;
            if (lane == 63) { cg[wave * 8 + q] = x; cp[wave * 8 + q] = m; }
        }
        __syncthreads();
        float m_prev = 0.f, mp[8], Ms8[8];
        for (int j = 0; j < 64; ++j) { const float Ms = fmaxf(m_prev, cp[j]);
#pragma unroll
            for (int q = 0; q < 8; ++q) if (j == wave * 8 + q) { mp[q] = m_prev; Ms8[q] = Ms; }
            m_prev = cg[j] + Ms; }
#pragma unroll
        for (int q = 0; q < 8; ++q) {
            const int j = wave * 8 + q, lrow = bl * SEQ + j * 64 + lane;
            const float mx = fmaxf(mp[q], pm[q]);
            A1[h * MS + lrow] = -mx; B1[h * MS + lrow] = b1[q]; WI[h * MS + lrow] = expf(mp[q] - mx); EF[h * MS + lrow] = expf(-(acs[q] + mx)); WK[h * MS + lrow] = expf(b1[q] - Ms8[q]);
            if (lane == 0) { DEC[h * (MS / 64) + bl * 64 + j] = expf(mp[q] - Ms8[q]); DEC[4 * (MS / 64) + h * (MS / 64) + bl * 64 + j] = Ms8[q]; }
        }
    }
}

__device__ __forceinline__ f32x4 mfma16(bf16x8 a, bf16x8 b, f32x4 c) { return __builtin_amdgcn_mfma_f32_16x16x32_bf16(a, b, c, 0, 0, 0); }

constexpr int TPS = 72;
constexpr int XCS = 264;
constexpr int L_QC_X = 0, L_QC_Q = 36864, L_QC_KT = L_QC_Q + 64 * XCS * 2, L_QC_ST = L_QC_KT + 256 * TPS * 2, L_QC_END = L_QC_ST + 64 * TPS * 2;
static_assert(64 * XCS * 2 <= 36864 && 256 * TPS * 2 <= 36864 && L_QC_END <= 131072, "qkc lds");
__device__ __forceinline__ void phase_cprep(const Args& a, unsigned char* lds, int vcu, int G, int pass) {
    const int tid = opaque_tid(), lane = tid & 63, wave = __builtin_amdgcn_readfirstlane(tid >> 6);
    const int fr = lane & 15, fq = lane >> 4;
    unsigned char* ws = a.ws;
    const bf16* P = (const bf16*)(ws + WS_P); bf16* XCW = (bf16*)(ws + WS_XC); bf16* QM = (bf16*)(ws + WS_QM);
    const bf16* WF = (const bf16*)(ws + WS_WQK);
    const float* gsc = (const float*)(ws + WS_GSC + (size_t)pass * GSC_STRIDE);
    const float* gA1 = gsc, *gWK = gsc + 4 * MS * 4, *gMS = gsc + 5 * MS * 4 + 4 * (MS / 64);
    bf16* SG = (bf16*)(ws + WS_SG); bf16* KTG = (bf16*)(ws + WS_KTG); bf16* VTG = (bf16*)(ws + WS_VTG);
    bf16* XS = (bf16*)(lds + L_QC_X); bf16* VT = (bf16*)(lds + L_QC_X); bf16* QL = (bf16*)(lds + L_QC_Q); bf16* KT = (bf16*)(lds + L_QC_KT); bf16* ST = (bf16*)(lds + L_QC_ST);
    const int ti = wave >> 1, tj0 = 2 * (wave & 1);
    for (int ci = vcu; ci < (MS / 64) * 4; ci += G) {
        const int h = ci & 3, t0 = (ci >> 2) * 64;
        u32x4 xw[4], vw[4];
        {
            const int cc = tid & 31, ch0 = h * 256 + 8 * cc;
            float wc[4][8], bc[8];
#pragma unroll
            for (int j = 0; j < 4; ++j) { const f32x4 w0 = *(const f32x4*)(a.w_conv + j * 1024 + ch0), w1 = *(const f32x4*)(a.w_conv + j * 1024 + ch0 + 4);
                wc[j][0] = w0[0]; wc[j][1] = w0[1]; wc[j][2] = w0[2]; wc[j][3] = w0[3]; wc[j][4] = w1[0]; wc[j][5] = w1[1]; wc[j][6] = w1[2]; wc[j][7] = w1[3]; }
            { const f32x4 b0 = *(const f32x4*)(a.b_conv + ch0), b1 = *(const f32x4*)(a.b_conv + ch0 + 4);
              bc[0] = b0[0]; bc[1] = b0[1]; bc[2] = b0[2]; bc[3] = b0[3]; bc[4] = b1[0]; bc[5] = b1[1]; bc[6] = b1[2]; bc[7] = b1[3]; }
            u32x4 xr[4][4];
#pragma unroll
            for (int i = 0; i < 4; ++i) { const int row = (tid >> 5) + 16 * i, tpos = (t0 + row) & (SEQ - 1);
#pragma unroll
                for (int j = 0; j < 4; ++j) xr[i][j] = (tpos - 3 + j >= 0) ? *(const u32x4*)(P + (size_t)(t0 + row - 3 + j) * INW + C_XA + ch0) : (u32x4){0u, 0u, 0u, 0u}; }
#pragma unroll
            for (int i = 0; i < 4; ++i) { float y[8];
#pragma unroll
                for (int e = 0; e < 8; ++e) y[e] = bc[e];
#pragma unroll
                for (int j = 0; j < 4; ++j) { float xv[8]; unpack8(xr[i][j], xv);
#pragma unroll
                    for (int e = 0; e < 8; ++e) y[e] += wc[j][e] * xv[e]; }
                u32x4 o; o.x = pk2(siluf_(y[0]), siluf_(y[1])); o.y = pk2(siluf_(y[2]), siluf_(y[3])); o.z = pk2(siluf_(y[4]), siluf_(y[5])); o.w = pk2(siluf_(y[6]), siluf_(y[7]));
                xw[i] = o;
                *(u32x4*)(XCW + (size_t)(t0 + (tid >> 5) + 16 * i) * 1024 + ch0) = o; }
        }
#pragma unroll
        for (int i = 0; i < 4; ++i) { const int c = tid + NTHR * i, l = c & 63, dc = c >> 6;
            vw[i] = *(const u32x4*)(P + (size_t)(t0 + l) * INW + C_VA + h * 256 + 8 * dc); }
        float wkr[4][4], a1l[4];
        if (wave >= 4) {
#pragma unroll
            for (int lt = 0; lt < 4; ++lt)
#pragma unroll
                for (int i = 0; i < 4; ++i) wkr[lt][i] = gWK[h * MS + t0 + 16 * lt + 4 * fq + i];
        }
#pragma unroll
        for (int i = 0; i < 4; ++i) a1l[i] = gA1[h * MS + t0 + 16 * ti + 4 * fq + i];
        const float msc = gMS[h * (MS / 64) + (ci >> 2)];
        __syncthreads();
#pragma unroll
        for (int i = 0; i < 4; ++i) { const int c = tid + NTHR * i, row = c >> 5, cc = c & 31; *(u32x4*)(XS + row * XCS + 8 * cc) = xw[i]; }
        __syncthreads();
        const bf16* wf = WF + (size_t)h * 512 * 256;
#pragma unroll 1
        for (int ct = 0; ct < 4; ++ct) {
            const int nt = 4 * wave + ct;
            bf16x8 bq[8];
#pragma unroll
            for (int ks = 0; ks < 8; ++ks) bq[ks] = *(const bf16x8*)(wf + (size_t)((nt * 8 + ks) * 64 + lane) * 8);
#pragma unroll
            for (int lt = 0; lt < 4; ++lt) {
                f32x4 acc = {0.f, 0.f, 0.f, 0.f};
#pragma unroll
                for (int ks = 0; ks < 8; ++ks) { const bf16x8 af = *(const bf16x8*)(XS + (16 * lt + fr) * XCS + 32 * ks + 8 * fq); acc = mfma16(af, bq[ks], acc); }
                if (wave < 4) {
#pragma unroll
                    for (int i = 0; i < 4; ++i) QL[(16 * lt + 4 * fq + i) * XCS + 64 * wave + 16 * ct + fr] = (bf16)f2bf(acc[i]);
                } else {
                    const int d = 64 * (wave - 4) + 16 * ct + fr;
                    u32x2 o; o.x = pk2(acc[0] * wkr[lt][0], acc[1] * wkr[lt][1]); o.y = pk2(acc[2] * wkr[lt][2], acc[3] * wkr[lt][3]);
                    *(u32x2*)(KT + d * TPS + 16 * lt + 4 * fq) = o;
                }
            }
        }
        __syncthreads();
#pragma unroll
        for (int i = 0; i < 4; ++i) { const int c = tid + NTHR * i, l = c & 63, dc = c >> 6;
            const u32x4 w = vw[i]; bf16* dv = VT + (8 * dc) * TPS + l;
            dv[0 * TPS] = (bf16)(w.x & 0xffff); dv[1 * TPS] = (bf16)(w.x >> 16); dv[2 * TPS] = (bf16)(w.y & 0xffff); dv[3 * TPS] = (bf16)(w.y >> 16);
            dv[4 * TPS] = (bf16)(w.z & 0xffff); dv[5 * TPS] = (bf16)(w.z >> 16); dv[6 * TPS] = (bf16)(w.w & 0xffff); dv[7 * TPS] = (bf16)(w.w >> 16); }
#pragma unroll
        for (int i = 0; i < 4; ++i) { const int c = tid + NTHR * i, row = c >> 5, cc = c & 31;
            *(u32x4*)(QM + (size_t)(t0 + row) * 1024 + h * 256 + 8 * cc) = *(const u32x4*)(QL + row * XCS + 8 * cc); }
#pragma unroll
        for (int tt = 0; tt < 2; ++tt) {
            const int tj = tj0 + tt;
            f32x4 sacc = {0.f, 0.f, 0.f, 0.f};
            if (tj <= ti) {
#pragma unroll
                for (int ks = 0; ks < 8; ++ks) {
                    const bf16x8 qf = *(const bf16x8*)(QL + (16 * ti + fr) * XCS + 32 * ks + 8 * fq);
                    const bf16* kp = KT + (32 * ks + 8 * fq + (fr >> 2)) * TPS + 16 * tj + 4 * (fr & 3);
                    const s16x4 k0 = __builtin_amdgcn_ds_read_tr16_b64_v4i16((__attribute__((address_space(3))) s16x4*)(kp));
                    const s16x4 k1 = __builtin_amdgcn_ds_read_tr16_b64_v4i16((__attribute__((address_space(3))) s16x4*)(kp + 4 * TPS));
                    bf16x8 kb; kb[0] = k0[0]; kb[1] = k0[1]; kb[2] = k0[2]; kb[3] = k0[3]; kb[4] = k1[0]; kb[5] = k1[1]; kb[6] = k1[2]; kb[7] = k1[3];
                    sacc = mfma16(qf, kb, sacc); }
            }
            const int sidx = 16 * tj + fr;
#pragma unroll
            for (int i = 0; i < 4; ++i) { const int l = 16 * ti + 4 * fq + i;
                float v = 0.f;
                if (sidx <= l) v = sacc[i] * __expf(a1l[i] + msc);
                ST[l * TPS + sidx] = (bf16)f2bf(v); }
        }
        __syncthreads();
        { const int row = tid >> 3, ch = tid & 7; *(u32x4*)(SG + (size_t)ci * 4096 + row * 64 + 8 * ch) = *(const u32x4*)(ST + row * TPS + 8 * ch); }
#pragma unroll
        for (int i = 0; i < 4; ++i) { const int p = tid + NTHR * i, blk = p >> 6, ln = p & 63, row = (blk >> 1) * 16 + (ln & 15), ch = (blk & 1) * 4 + (ln >> 4);
            *(u32x4*)(KTG + (size_t)ci * 16384 + p * 8) = *(const u32x4*)(KT + row * TPS + 8 * ch);
            *(u32x4*)(VTG + (size_t)ci * 16384 + p * 8) = *(const u32x4*)(VT + row * TPS + 8 * ch); }
    }
}

constexpr int SA_DEPTH = 5, SA_PATCH = 32 * 32 * 2 + 128;
struct ScanA { const bf16* KTG; const bf16* VTG; const float* gDEC; bf16* CS; float* NS; int bl, h, dblk, eblk, wave, fr, fq; unsigned koff, voff; bool do_den; };
struct ScanAOps { bf16x8 k[2][2], v[2][2]; float decay; };
__device__ __forceinline__ void scana_load(const ScanA& c, int j, ScanAOps& o) {
    const int ci = (c.bl * 64 + j) * 4 + c.h;
    const bf16* kb = c.KTG + (size_t)ci * 16384; const bf16* vb = c.VTG + (size_t)ci * 16384;
#pragma unroll
    for (int dt = 0; dt < 2; ++dt)
#pragma unroll
        for (int k2 = 0; k2 < 2; ++k2) o.k[dt][k2] = *(const bf16x8*)(kb + (c.koff + (unsigned)((dt * 2 + k2) * 512)));
#pragma unroll
    for (int et = 0; et < 2; ++et)
#pragma unroll
        for (int k2 = 0; k2 < 2; ++k2) o.v[et][k2] = *(const bf16x8*)(vb + (c.voff + (unsigned)((et * 2 + k2) * 512)));
    o.decay = c.gDEC[c.h * (MS / 64) + c.bl * 64 + j];
}
__device__ __forceinline__ void scana_step(const ScanA& c, unsigned char* lds, int j, f32x4 (&Cacc)[2][2], f32x4 (&Nacc)[2], const ScanAOps& o, const bf16x8 ones) {
    const int ci = (c.bl * 64 + j) * 4 + c.h;
    unsigned char* patch = lds + c.wave * SA_PATCH;
    const int lane = c.fq * 16 + c.fr;
    if ((j & 1) == 0) {
#pragma unroll
    for (int dt = 0; dt < 2; ++dt) {
#pragma unroll
        for (int et = 0; et < 2; ++et) { const f32x4 cc = Cacc[dt][et]; u32x2 w; w.x = pk2(cc[0], cc[1]); w.y = pk2(cc[2], cc[3]);
            *(u32x2*)(patch + (16 * et + c.fr) * 64 + (16 * dt + 4 * c.fq) * 2) = w; }
        if (c.do_den && c.fr == 0) *(f32x4*)(patch + 2048 + (16 * dt + 4 * c.fq) * 4) = Nacc[dt];
    }
    { bf16* cs = c.CS + (size_t)ci * 65536 + (c.eblk * 8 + c.dblk) * 1024;
#pragma unroll
      for (int k = 0; k < 2; ++k) __builtin_nontemporal_store(*(const u32x4*)(patch + k * 1024 + lane * 16), (u32x4*)(cs + k * 512 + lane * 8));
      if (c.do_den && lane < 8) *(f32x4*)(c.NS + (size_t)ci * 256 + c.dblk * 32 + lane * 4) = *(const f32x4*)(patch + 2048 + lane * 16); }
    }
#pragma unroll
    for (int dt = 0; dt < 2; ++dt) {
#pragma unroll
        for (int et = 0; et < 2; ++et) {
            f32x4 cc = Cacc[dt][et] * o.decay;
#pragma unroll
            for (int k2 = 0; k2 < 2; ++k2) cc = mfma16(o.k[dt][k2], o.v[et][k2], cc);
            Cacc[dt][et] = cc;
        }
        if (c.do_den) {
            f32x4 cc = Nacc[dt] * o.decay;
#pragma unroll
            for (int k2 = 0; k2 < 2; ++k2) cc = mfma16(o.k[dt][k2], ones, cc);
            Nacc[dt] = cc;
        }
    }
}
__device__ __forceinline__ void scana_item(const Args& a, unsigned char* lds, int item, int pass) {
    const int tid = opaque_tid(), lane = tid & 63;
    unsigned char* ws = a.ws;
    ScanA c;
    c.wave = __builtin_amdgcn_readfirstlane(tid >> 6); c.fr = lane & 15; c.fq = lane >> 4;
    item = __builtin_amdgcn_readfirstlane(item);
    c.bl = item >> 5; c.h = (item >> 3) & 3; c.dblk = 2 * ((item >> 1) & 3) + (c.wave >> 2); c.eblk = 4 * (item & 1) + (c.wave & 3); c.do_den = (c.eblk == 0);
    c.koff = (unsigned)((4 * c.dblk) * 512 + lane * 8); c.voff = (unsigned)((4 * c.eblk) * 512 + lane * 8);
    c.KTG = (const bf16*)(ws + WS_KTG); c.VTG = (const bf16*)(ws + WS_VTG); c.gDEC = (const float*)(ws + WS_GSC + (size_t)pass * GSC_STRIDE) + 5 * MS * 4;
    c.CS = (bf16*)(ws + WS_CS); c.NS = (float*)(ws + WS_NS);
    f32x4 Cacc[2][2], Nacc[2];
#pragma unroll
    for (int x = 0; x < 2; ++x) { Nacc[x] = (f32x4){0.f, 0.f, 0.f, 0.f};
#pragma unroll
        for (int y = 0; y < 2; ++y) Cacc[x][y] = (f32x4){0.f, 0.f, 0.f, 0.f}; }
    bf16x8 ones;
    { const short ov = (c.fr == 0) ? (short)0x3F80 : (short)0;
#pragma unroll
      for (int e = 0; e < 8; ++e) ones[e] = ov; }
    ScanAOps o0, o1, o2, o3, o4;
    scana_load(c, 0, o0); scana_load(c, 1, o1); scana_load(c, 2, o2); scana_load(c, 3, o3); scana_load(c, 4, o4);
#define SA_STEP(jj, ob) do { scana_step(c, lds, (jj), Cacc, Nacc, ob, ones); __builtin_amdgcn_sched_barrier(0); scana_load(c, (jj) + SA_DEPTH < 64 ? (jj) + SA_DEPTH : 63, ob); __builtin_amdgcn_sched_barrier(0); } while (0)
#pragma nounroll
    for (int j = 0; j < 60; j += 5) { SA_STEP(j, o0); SA_STEP(j + 1, o1); SA_STEP(j + 2, o2); SA_STEP(j + 3, o3); SA_STEP(j + 4, o4); }
    SA_STEP(60, o0); SA_STEP(61, o1); SA_STEP(62, o2); SA_STEP(63, o3);
#undef SA_STEP
    asm volatile("s_waitcnt vmcnt(0)" ::: "memory");
}

constexpr int AKS = 136;
constexpr int L_AK = 0, L_AV = L_AK + 128 * AKS * 2, L_AP = L_AV + 128 * AKS * 2, L_ATT_END = L_AP + 8 * 16 * AKS * 2;
static_assert(L_ATT_END <= 131072, "attn lds");

__device__ __forceinline__ void attn_item(const Args& a, unsigned char* lds, int item) {
    const int tid = opaque_tid(), lane = tid & 63, wave = __builtin_amdgcn_readfirstlane(tid >> 6);
    const int fr = lane & 15, fq = lane >> 4;
    unsigned char* ws = a.ws;
    const int blk = item & 31, hh = (item >> 5) & 3, bl = (item >> 7) & 3, g = item >> 9;
    const int dil = g == 0 ? 1 : g == 1 ? 4 : 16, nb = 32 / dil;
    const int r = blk / nb, n = blk % nb;
    const bf16* P = (const bf16*)(ws + WS_P);
    const int H = 4 * g + hh;
    const bf16* Qb = P + C_QA + H * 128; const bf16* Kb = P + C_KA + H * 128; const bf16* Vb = P + C_VT + H * 128;
    bf16* Ks = (bf16*)(lds + L_AK); bf16* VTs = (bf16*)(lds + L_AV); bf16* Pw = (bf16*)(lds + L_AP) + wave * 16 * AKS;
    const int rowbase = bl * SEQ + r;
    bf16x8 qf[4];
    { const size_t qrow = (size_t)(rowbase + (128 * n + 16 * wave + fr) * dil);
#pragma unroll
      for (int ks = 0; ks < 4; ++ks) qf[ks] = *(const bf16x8*)(Qb + qrow * INW + 32 * ks + 8 * fq); }
    f32x4 O[8];
#pragma unroll
    for (int i = 0; i < 8; ++i) O[i] = (f32x4){0.f, 0.f, 0.f, 0.f};
    float mrow = -INFINITY, lrow = 0.f;
    const float scale = 0.08838834764831845f;
#define ATT_BAR() do { asm volatile("s_waitcnt lgkmcnt(0)" ::: "memory"); __builtin_amdgcn_s_barrier(); asm volatile("" ::: "memory"); } while (0)
    const int half0 = (n == 0 ? 1 : 0);
    u32x4 kreg[4], vreg[4];
#pragma unroll
    for (int i = 0; i < 4; ++i) { const int c = tid + NTHR * i, key = c >> 4, dc = c & 15;
        const size_t krow = (size_t)(rowbase + (128 * (n - 1 + half0) + key) * dil);
        kreg[i] = *(const u32x4*)(Kb + krow * INW + 8 * dc); vreg[i] = *(const u32x4*)(Vb + krow * INW + 8 * dc); }
    for (int half = half0; half < 2; ++half) {
        ATT_BAR();
#pragma unroll
        for (int i = 0; i < 4; ++i) { const int c = tid + NTHR * i, key = c >> 4, dc = c & 15;
            *(u32x4*)(Ks + key * AKS + 8 * dc) = kreg[i]; *(u32x4*)(VTs + key * AKS + 8 * dc) = vreg[i]; }
        if (half == 0) {
#pragma unroll
            for (int i = 0; i < 4; ++i) { const int c = tid + NTHR * i, key = c >> 4, dc = c & 15;
                const size_t krow = (size_t)(rowbase + (128 * n + key) * dil);
                kreg[i] = *(const u32x4*)(Kb + krow * INW + 8 * dc); vreg[i] = *(const u32x4*)(Vb + krow * INW + 8 * dc); }
        }
        ATT_BAR();
        f32x4 S[8];
        const int p = 16 * wave + fr;
        float mx = -INFINITY;
#pragma unroll
        for (int kt = 0; kt < 8; ++kt) {
            const bool act = half == 0 ? (kt >= wave) : (kt <= wave);
            f32x4 sacc = {0.f, 0.f, 0.f, 0.f};
            if (act) {
#pragma unroll
                for (int ks = 0; ks < 4; ++ks) { const bf16x8 kf = *(const bf16x8*)(Ks + (16 * kt + fr) * AKS + 32 * ks + 8 * fq); sacc = mfma16(kf, qf[ks], sacc); }
#pragma unroll
                for (int i = 0; i < 4; ++i) { const int kk = 16 * kt + 4 * fq + i; const bool ok = half == 0 ? (kk >= p) : (kk <= p);
                    const float v = ok ? sacc[i] * scale : -INFINITY; sacc[i] = v; mx = fmaxf(mx, v); }
            }
            S[kt] = sacc;
        }
        mx = fmaxf(mx, __shfl_xor(mx, 16)); mx = fmaxf(mx, __shfl_xor(mx, 32));
        const float mn = fmaxf(mrow, mx), alpha = __expf(mrow - mn); mrow = mn;
        float rs = 0.f;
        unsigned pk[8][2];
#pragma unroll
        for (int kt = 0; kt < 8; ++kt) {
            const bool act = half == 0 ? (kt >= wave) : (kt <= wave);
            if (act) { const float p0 = __expf(S[kt][0] - mn), p1 = __expf(S[kt][1] - mn), p2 = __expf(S[kt][2] - mn), p3 = __expf(S[kt][3] - mn);
                rs += (p0 + p1) + (p2 + p3); pk[kt][0] = pk2(p0, p1); pk[kt][1] = pk2(p2, p3); }
            else { pk[kt][0] = 0u; pk[kt][1] = 0u; }
        }
        rs += __shfl_xor(rs, 16); rs += __shfl_xor(rs, 32);
        lrow = lrow * alpha + rs;
        float al[4];
#pragma unroll
        for (int i = 0; i < 4; ++i) al[i] = __shfl(alpha, 4 * fq + i);
#pragma unroll
        for (int dtile = 0; dtile < 8; ++dtile)
#pragma unroll
            for (int i = 0; i < 4; ++i) O[dtile][i] *= al[i];
#pragma unroll
        for (int ks = 0; ks < 4; ++ks) {
            const bool act = half == 0 ? (2 * ks + 1 >= wave) : (2 * ks <= wave);
            if (act) {
                u32x4 pw; pw.x = pk[2 * ks][0]; pw.y = pk[2 * ks][1]; pw.z = pk[2 * ks + 1][0]; pw.w = pk[2 * ks + 1][1];
                const bf16x8 pa = __builtin_bit_cast(bf16x8, pw);
#pragma unroll
                for (int dtile = 0; dtile < 8; ++dtile) {
                    const bf16* vp = VTs + (32 * ks + 4 * fq + (fr >> 2)) * AKS + 16 * dtile + 4 * (fr & 3);
                    const s16x4 v0 = __builtin_amdgcn_ds_read_tr16_b64_v4i16((__attribute__((address_space(3))) s16x4*)(vp));
                    const s16x4 v1 = __builtin_amdgcn_ds_read_tr16_b64_v4i16((__attribute__((address_space(3))) s16x4*)(vp + 16 * AKS));
                    bf16x8 vb; vb[0] = v0[0]; vb[1] = v0[1]; vb[2] = v0[2]; vb[3] = v0[3]; vb[4] = v1[0]; vb[5] = v1[1]; vb[6] = v1[2]; vb[7] = v1[3];
                    O[dtile] = mfma16(pa, vb, O[dtile]); }
            }
        }
    }
    bf16* AO = (bf16*)(ws + WS_AO) + (size_t)g * MS * 512; float* LSE = (float*)(ws + WS_LSE) + (size_t)g * MS * 4;
    {
        const float inv_l = 1.f / lrow;
        float il[4];
#pragma unroll
        for (int i = 0; i < 4; ++i) il[i] = __shfl(inv_l, 4 * fq + i);
#pragma unroll
        for (int dtile = 0; dtile < 8; ++dtile)
#pragma unroll
            for (int i = 0; i < 4; ++i) Pw[(4 * fq + i) * AKS + 16 * dtile + fr] = (bf16)f2bf(O[dtile][i] * il[i]);
        if (fq == 0) { const size_t row = (size_t)(rowbase + (128 * n + 16 * wave + fr) * dil); LSE[(size_t)hh * MS + row] = mrow + logf(lrow); }
#pragma unroll
        for (int k = 0; k < 4; ++k) { const int c = lane + 64 * k, q = c >> 4, ch = c & 15;
            const size_t row = (size_t)(rowbase + (128 * n + 16 * wave + q) * dil);
            *(u32x4*)(AO + row * 512 + hh * 128 + 8 * ch) = *(const u32x4*)(Pw + q * AKS + 8 * ch); }
    }
    __syncthreads();
}

constexpr int N_SCAN_ITEMS = NB_PASS * 32, N_ATT_ITEMS = 3 * NB_PASS * 4 * 32;
#ifndef PROBE_ATT_REP
#define PROBE_ATT_REP 1
#endif
struct XcdBarrier;
__device__ __forceinline__ void xcd_barrier(const XcdBarrier& b);
__device__ __forceinline__ void phase_mix(const Args& a, unsigned char* lds, int pass, const XcdBarrier* pbar) {
    volatile int* slot = (volatile int*)(lds + 131072 + 1024);
#ifdef PROBE_SPLIT
    for (int it = blockIdx.x; it < N_SCAN_ITEMS; it += gridDim.x) scana_item(a, lds, it, pass);
    xcd_barrier(*pbar);
    for (int rep = 0; rep < PROBE_ATT_REP; ++rep)
    for (int it = blockIdx.x; it < N_ATT_ITEMS; it += gridDim.x) attn_item(a, lds, it);
#else
    if ((int)blockIdx.x < N_SCAN_ITEMS && gridDim.x >= (unsigned)N_SCAN_ITEMS) {
        const int x = blockIdx.x & 7, k = blockIdx.x >> 3, g = x + 8 * (k >> 3), m = k & 7;
        scana_item(a, lds, g * 8 + m, pass);
    } else if (gridDim.x < (unsigned)N_SCAN_ITEMS) { for (int it = blockIdx.x; it < N_SCAN_ITEMS; it += gridDim.x) scana_item(a, lds, it, pass); }
    constexpr int QN = N_ATT_ITEMS / 8;
    for (int qo = 0; qo < 8; ++qo) {
        const int qx = (int)((blockIdx.x + qo) & 7);
        unsigned* qc = (unsigned*)(a.ws + WS_CTL) + CW_QCTR + (pass * 8 + qx) * 64;
        for (;;) {
            __syncthreads();
            if (opaque_tid() == 0) *slot = (int)atomicAdd(qc, 1u);
            __syncthreads();
            const int L = *slot;
            if (L >= QN) break;
            attn_item(a, lds, ((L >> 3) * 8 + qx) * 8 + (L & 7));
        }
    }
#endif
}

constexpr int QS_STRIDE = 264, SS_STRIDE = 72;
constexpr int L_QS = 0, L_SS = L_QS + 64 * QS_STRIDE * 2, L_DENL = L_SS + 64 * SS_STRIDE * 2, L_WIL = L_DENL + 256, L_NUM = L_WIL + 256, L_SB_END = L_NUM + 64 * QS_STRIDE * 2;
static_assert(L_SB_END <= 131072, "scan-B lds");
constexpr int L_KTL = L_SB_END, L_XS = L_KTL + 256 * TPS * 2, L_SB2_END = L_XS + 64 * TPS * 2;
static_assert(L_SB2_END <= 131072, "scan-B lds");
struct SBCtx { const bf16* P; const bf16* XC; const bf16* QM; const bf16* SG; const bf16* VTG; const bf16* KTG; const bf16* CS; const float* NS; const float* gWI; const float* gEF; const float* gDEC; bf16* UM; int tid, lane, wave, fr, fq; };

__device__ __forceinline__ void scanb_tail(const Args& a, const SBCtx& c, const bf16* NUMS, const float* DENL, int h, int t0) {
    const int lane = c.lane, wave = c.wave, col = h * 256 + 4 * lane;
    const f32x4 gh = *(const f32x4*)(a.g_head + col), sk = *(const f32x4*)(a.skip + col);
#pragma unroll
    for (int hb = 0; hb < 2; ++hb) {
        u32x2 ow[4], zw[4], xw[4];
#pragma unroll
        for (int q = 0; q < 4; ++q) { const size_t r = (size_t)(t0 + 8 * wave + 4 * hb + q);
            ow[q] = *(const u32x2*)(c.P + r * INW + C_OA + col); zw[q] = *(const u32x2*)(c.P + r * INW + C_ZA + col); xw[q] = *(const u32x2*)(c.XC + r * 1024 + col); }
#pragma unroll
        for (int q = 0; q < 4; ++q) {
            const int l = 8 * wave + 4 * hb + q; const size_t r = (size_t)(t0 + l);
            const u32x2 hw = *(const u32x2*)(NUMS + l * QS_STRIDE + 4 * lane);
            const float rd = DENL[l];
            float hm[4] = {sigmoidf_(bflo(ow[q].x)) * bflo(hw.x) * rd, sigmoidf_(bfhi(ow[q].x)) * bfhi(hw.x) * rd, sigmoidf_(bflo(ow[q].y)) * bflo(hw.y) * rd, sigmoidf_(bfhi(ow[q].y)) * bfhi(hw.y) * rd};
            float ss = (hm[0] * hm[0] + hm[1] * hm[1]) + (hm[2] * hm[2] + hm[3] * hm[3]);
            ss = wave_sum(ss);
            const float rinv = 1.f / sqrtf(ss * (1.f / 256.f) + EPS);
            const float xc[4] = {bflo(xw[q].x), bfhi(xw[q].x), bflo(xw[q].y), bfhi(xw[q].y)}, za[4] = {bflo(zw[q].x), bfhi(zw[q].x), bflo(zw[q].y), bfhi(zw[q].y)};
            float o[4];
#pragma unroll
            for (int e = 0; e < 4; ++e) o[e] = (hm[e] * rinv * gh[e] + sk[e] * xc[e]) * siluf_(za[e]);
            u32x2 ov; ov.x = pk2(o[0], o[1]); ov.y = pk2(o[2], o[3]);
            *(u32x2*)(c.UM + r * 1536 + col) = ov;
        }
        __builtin_amdgcn_sched_barrier(0);
    }
}

__device__ __forceinline__ void scanb_run(const Args& a, unsigned char* lds, int vcu, int G, int pass) {
    SBCtx c;
    c.tid = opaque_tid(); c.lane = c.tid & 63; c.wave = __builtin_amdgcn_readfirstlane(c.tid >> 6); c.fr = c.lane & 15; c.fq = c.lane >> 4;
    unsigned char* ws = a.ws;
    c.P = (const bf16*)(ws + WS_P); c.XC = (const bf16*)(ws + WS_XC); c.QM = (const bf16*)(ws + WS_QM); c.SG = (const bf16*)(ws + WS_SG); c.VTG = (const bf16*)(ws + WS_VTG); c.KTG = (const bf16*)(ws + WS_KTG);
    c.CS = (const bf16*)(ws + WS_CS); c.NS = (const float*)(ws + WS_NS); { const float* gsc = (const float*)(ws + WS_GSC + (size_t)pass * GSC_STRIDE); c.gWI = gsc + 2 * MS * 4; c.gEF = gsc + 3 * MS * 4; c.gDEC = gsc + 5 * MS * 4; }
    c.UM = (bf16*)(ws + WS_ACAT);
    const int wave = c.wave;
    bf16* QS = (bf16*)(lds + L_QS); bf16* SS = (bf16*)(lds + L_SS); float* DENL = (float*)(lds + L_DENL); float* WIL = (float*)(lds + L_WIL); bf16* NUMS = (bf16*)(lds + L_NUM);
    bf16* KTL = (bf16*)(lds + L_KTL); bf16* XS = (bf16*)(lds + L_XS);
    unsigned* qc = (unsigned*)(ws + WS_CTL) + CW_QCTR + 2048 + pass * 64;
    volatile int* slot = (volatile int*)(lds + 131072 + 1024);
    constexpr int NITEMS = (MS / 128) * 4;
    bf16x8 ones;
    { const short ov = (c.fr == 0) ? (short)0x3F80 : (short)0;
#pragma unroll
      for (int e = 0; e < 8; ++e) ones[e] = ov; }
    int it = vcu;
    while (it < NITEMS) {
        { int t_ = c.tid; asm volatile("" : "+v"(t_)); c.tid = t_; c.lane = t_ & 63; c.fr = c.lane & 15; c.fq = c.lane >> 4; }
        const int tid = c.tid, lane = c.lane, fr = c.fr, fq = c.fq;
        const int h = it & 3, pr = it >> 2, chA = (2 * pr) * 4 + h, chB = chA + 4, tA = (2 * pr) * 64, tB = tA + 64;
        bf16x8 cb[2][8], vtA[2][2], vtB[2][2];
#pragma unroll
        for (int t = 0; t < 2; ++t) {
#pragma unroll
            for (int ks = 0; ks < 8; ++ks) cb[t][ks] = *(const bf16x8*)(c.CS + (size_t)chA * 65536 + (wave * 8 + ks) * 1024 + (16 * t + fr) * 32 + 8 * fq);
#pragma unroll
            for (int k2 = 0; k2 < 2; ++k2) vtA[t][k2] = *(const bf16x8*)(c.VTG + (size_t)chA * 16384 + (((2 * wave + t) * 2 + k2) * 64 + lane) * 8);
        }
        const float decA = c.gDEC[h * (MS / 64) + 2 * pr];
        if (tid == 0) *slot = (int)atomicAdd(qc, 1u);
        __syncthreads();
#pragma unroll
        for (int i = 0; i < 4; ++i) { const int q = tid + NTHR * i, row = q >> 5, cc = q & 31; *(u32x4*)(QS + row * QS_STRIDE + 8 * cc) = *(const u32x4*)(c.QM + (size_t)(tA + row) * 1024 + h * 256 + 8 * cc); }
        { const int row = tid >> 3, cc = tid & 7; *(u32x4*)(SS + row * SS_STRIDE + 8 * cc) = *(const u32x4*)(c.SG + (size_t)chA * 4096 + row * 64 + 8 * cc); }
        if (tid < 64) WIL[tid] = c.gWI[h * MS + tA + tid];
#pragma unroll
        for (int i = 0; i < 4; ++i) { const int p = tid + NTHR * i, blk = p >> 6, ln = p & 63, row = (blk >> 1) * 16 + (ln & 15), ch8 = (blk & 1) * 4 + (ln >> 4);
            *(u32x4*)(KTL + row * TPS + 8 * ch8) = *(const u32x4*)(c.KTG + (size_t)chA * 16384 + p * 8); }
        __syncthreads();
        const int nit = G + *slot;
#pragma unroll
        for (int lt = 0; lt < 4; ++lt) {
            bf16x8 qf[8], sf[2];
#pragma unroll
            for (int ks = 0; ks < 8; ++ks) qf[ks] = *(const bf16x8*)(QS + (16 * lt + fr) * QS_STRIDE + 32 * ks + 8 * fq);
#pragma unroll
            for (int k2 = 0; k2 < 2; ++k2) sf[k2] = *(const bf16x8*)(SS + (16 * lt + fr) * SS_STRIDE + 32 * k2 + 8 * fq);
#pragma unroll
            for (int t = 0; t < 2; ++t) {
                f32x4 a1 = {0.f, 0.f, 0.f, 0.f}, a2 = {0.f, 0.f, 0.f, 0.f}, a3 = {0.f, 0.f, 0.f, 0.f};
#pragma unroll
                for (int k2 = 0; k2 < 2; ++k2) a1 = mfma16(sf[k2], vtA[t][k2], a1);
#pragma unroll
                for (int ks = 0; ks < 8; ks += 2) { a2 = mfma16(qf[ks], cb[t][ks], a2); a3 = mfma16(qf[ks + 1], cb[t][ks + 1], a3); }
#pragma unroll
                for (int i = 0; i < 4; ++i) NUMS[(16 * lt + 4 * fq + i) * QS_STRIDE + 32 * wave + 16 * t + fr] = (bf16)f2bf(a1[i] + WIL[16 * lt + 4 * fq + i] * (a2[i] + a3[i]));
            }
        }
        if (wave == 0) {
            bf16x8 nb[8];
#pragma unroll
            for (int ks = 0; ks < 8; ++ks) { const f32x4 n0 = *(const f32x4*)(c.NS + (size_t)chA * 256 + 32 * ks + 8 * fq), n1 = *(const f32x4*)(c.NS + (size_t)chA * 256 + 32 * ks + 8 * fq + 4);
                u32x4 w; w.x = pk2(n0[0], n0[1]); w.y = pk2(n0[2], n0[3]); w.z = pk2(n1[0], n1[1]); w.w = pk2(n1[2], n1[3]);
                if (fr != 0) w = (u32x4){0u, 0u, 0u, 0u};
                nb[ks] = __builtin_bit_cast(bf16x8, w); }
#pragma unroll
            for (int lt = 0; lt < 4; ++lt) {
                f32x4 a1 = {0.f, 0.f, 0.f, 0.f}, a2 = {0.f, 0.f, 0.f, 0.f};
#pragma unroll
                for (int k2 = 0; k2 < 2; ++k2) { const bf16x8 sf = *(const bf16x8*)(SS + (16 * lt + fr) * SS_STRIDE + 32 * k2 + 8 * fq); a1 = mfma16(sf, ones, a1); }
#pragma unroll
                for (int ks = 0; ks < 8; ++ks) { const bf16x8 qf = *(const bf16x8*)(QS + (16 * lt + fr) * QS_STRIDE + 32 * ks + 8 * fq); a2 = mfma16(qf, nb[ks], a2); }
                if (fr == 0) {
#pragma unroll
                    for (int i = 0; i < 4; ++i) { const int l = 16 * lt + 4 * fq + i; const float den = a1[i] + WIL[l] * a2[i]; DENL[l] = 1.f / fmaxf(fabsf(den), c.gEF[h * MS + tA + l]); } }
            }
        }
        __syncthreads();
#pragma unroll
        for (int i = 0; i < 4; ++i) { const int q = tid + NTHR * i, row = q >> 5, cc = q & 31; *(u32x4*)(QS + row * QS_STRIDE + 8 * cc) = *(const u32x4*)(c.QM + (size_t)(tB + row) * 1024 + h * 256 + 8 * cc); }
        { const int row = tid >> 3, cc = tid & 7; *(u32x4*)(SS + row * SS_STRIDE + 8 * cc) = *(const u32x4*)(c.SG + (size_t)chB * 4096 + row * 64 + 8 * cc); }
        scanb_tail(a, c, NUMS, DENL, h, tA);
#pragma unroll
        for (int t = 0; t < 2; ++t)
#pragma unroll
            for (int k2 = 0; k2 < 2; ++k2) vtB[t][k2] = *(const bf16x8*)(c.VTG + (size_t)chB * 16384 + (((2 * wave + t) * 2 + k2) * 64 + lane) * 8);
        __syncthreads();
        if (tid < 64) WIL[tid] = c.gWI[h * MS + tB + tid];
        {
            const int ti = wave >> 1;
            bf16x8 qf[8];
#pragma unroll
            for (int ks = 0; ks < 8; ++ks) qf[ks] = *(const bf16x8*)(QS + (16 * ti + fr) * QS_STRIDE + 32 * ks + 8 * fq);
#pragma unroll
            for (int tt = 0; tt < 2; ++tt) { const int tj = 2 * (wave & 1) + tt;
                f32x4 xacc = {0.f, 0.f, 0.f, 0.f};
#pragma unroll
                for (int ks = 0; ks < 8; ++ks) {
                    const bf16* kp = KTL + (32 * ks + 8 * fq + (fr >> 2)) * TPS + 16 * tj + 4 * (fr & 3);
                    const s16x4 k0 = __builtin_amdgcn_ds_read_tr16_b64_v4i16((__attribute__((address_space(3))) s16x4*)(kp));
                    const s16x4 k1 = __builtin_amdgcn_ds_read_tr16_b64_v4i16((__attribute__((address_space(3))) s16x4*)(kp + 4 * TPS));
                    bf16x8 kb; kb[0] = k0[0]; kb[1] = k0[1]; kb[2] = k0[2]; kb[3] = k0[3]; kb[4] = k1[0]; kb[5] = k1[1]; kb[6] = k1[2]; kb[7] = k1[3];
                    xacc = mfma16(qf[ks], kb, xacc); }
#pragma unroll
                for (int i = 0; i < 4; ++i) XS[(16 * ti + 4 * fq + i) * TPS + 16 * tj + fr] = (bf16)f2bf(xacc[i]); }
        }
        __syncthreads();
#pragma unroll
        for (int lt = 0; lt < 4; ++lt) {
            bf16x8 qf[8], sf[2], xf[2];
#pragma unroll
            for (int ks = 0; ks < 8; ++ks) qf[ks] = *(const bf16x8*)(QS + (16 * lt + fr) * QS_STRIDE + 32 * ks + 8 * fq);
#pragma unroll
            for (int k2 = 0; k2 < 2; ++k2) { sf[k2] = *(const bf16x8*)(SS + (16 * lt + fr) * SS_STRIDE + 32 * k2 + 8 * fq); xf[k2] = *(const bf16x8*)(XS + (16 * lt + fr) * TPS + 32 * k2 + 8 * fq); }
#pragma unroll
            for (int t = 0; t < 2; ++t) {
                f32x4 a1 = {0.f, 0.f, 0.f, 0.f}, a2 = {0.f, 0.f, 0.f, 0.f}, a3 = {0.f, 0.f, 0.f, 0.f}, a4 = {0.f, 0.f, 0.f, 0.f};
#pragma unroll
                for (int k2 = 0; k2 < 2; ++k2) { a1 = mfma16(sf[k2], vtB[t][k2], a1); a4 = mfma16(xf[k2], vtA[t][k2], a4); }
#pragma unroll
                for (int ks = 0; ks < 8; ks += 2) { a2 = mfma16(qf[ks], cb[t][ks], a2); a3 = mfma16(qf[ks + 1], cb[t][ks + 1], a3); }
#pragma unroll
                for (int i = 0; i < 4; ++i) NUMS[(16 * lt + 4 * fq + i) * QS_STRIDE + 32 * wave + 16 * t + fr] = (bf16)f2bf(a1[i] + WIL[16 * lt + 4 * fq + i] * (decA * (a2[i] + a3[i]) + a4[i]));
            }
        }
        if (wave == 0) {
            bf16x8 nb[8];
#pragma unroll
            for (int ks = 0; ks < 8; ++ks) { const f32x4 n0 = *(const f32x4*)(c.NS + (size_t)chA * 256 + 32 * ks + 8 * fq), n1 = *(const f32x4*)(c.NS + (size_t)chA * 256 + 32 * ks + 8 * fq + 4);
                u32x4 w; w.x = pk2(n0[0], n0[1]); w.y = pk2(n0[2], n0[3]); w.z = pk2(n1[0], n1[1]); w.w = pk2(n1[2], n1[3]);
                if (fr != 0) w = (u32x4){0u, 0u, 0u, 0u};
                nb[ks] = __builtin_bit_cast(bf16x8, w); }
#pragma unroll
            for (int lt = 0; lt < 4; ++lt) {
                f32x4 a1 = {0.f, 0.f, 0.f, 0.f}, a2 = {0.f, 0.f, 0.f, 0.f}, a4 = {0.f, 0.f, 0.f, 0.f};
#pragma unroll
                for (int k2 = 0; k2 < 2; ++k2) { const bf16x8 sf = *(const bf16x8*)(SS + (16 * lt + fr) * SS_STRIDE + 32 * k2 + 8 * fq); a1 = mfma16(sf, ones, a1);
                                                 const bf16x8 xf = *(const bf16x8*)(XS + (16 * lt + fr) * TPS + 32 * k2 + 8 * fq); a4 = mfma16(xf, ones, a4); }
#pragma unroll
                for (int ks = 0; ks < 8; ++ks) { const bf16x8 qf = *(const bf16x8*)(QS + (16 * lt + fr) * QS_STRIDE + 32 * ks + 8 * fq); a2 = mfma16(qf, nb[ks], a2); }
                if (fr == 0) {
#pragma unroll
                    for (int i = 0; i < 4; ++i) { const int l = 16 * lt + 4 * fq + i; const float den = a1[i] + WIL[l] * (decA * a2[i] + a4[i]); DENL[l] = 1.f / fmaxf(fabsf(den), c.gEF[h * MS + tB + l]); } }
            }
        }
        __syncthreads();
        scanb_tail(a, c, NUMS, DENL, h, tB);
        it = nit;
    }
    __syncthreads();
}

__device__ __forceinline__ void phase_post(const Args& a, unsigned char* lds, int vcu, int G, int pass) {
    scanb_run(a, lds, vcu, G, pass);
    const int tid = opaque_tid(), lane = tid & 63, wave = tid >> 6;
    unsigned char* ws = a.ws;
    const bf16* P = (const bf16*)(ws + WS_P);
    const bf16* AO = (const bf16*)(ws + WS_AO); const float* LSE = (const float*)(ws + WS_LSE); bf16* UA = (bf16*)(ws + WS_ACAT) + 1024;
    const int hh = lane >> 4, c = hh * 128 + 8 * (lane & 15);
    for (int r0 = 2 * (vcu * NWAVES + wave); r0 < MS; r0 += 2 * G * NWAVES) {
        u32x4 o0[2], o1[2], o2[2], zb[2]; float l0[2], l1[2], l2[2];
#pragma unroll
        for (int q = 0; q < 2; ++q) { const size_t r = (size_t)(r0 + q);
            o0[q] = *(const u32x4*)(AO + r * 512 + c); o1[q] = *(const u32x4*)(AO + ((size_t)MS + r) * 512 + c); o2[q] = *(const u32x4*)(AO + ((size_t)2 * MS + r) * 512 + c);
            zb[q] = *(const u32x4*)(P + r * INW + C_ZB + c);
            l0[q] = LSE[(size_t)hh * MS + r]; l1[q] = LSE[(size_t)(4 + hh) * MS + r]; l2[q] = LSE[(size_t)(8 + hh) * MS + r]; }
#pragma unroll
        for (int q = 0; q < 2; ++q) {
            const float mx = fmaxf(l0[q], fmaxf(l1[q], l2[q]));
            float w0 = __expf(l0[q] - mx), w1 = __expf(l1[q] - mx), w2 = __expf(l2[q] - mx); const float inv = 1.f / (w0 + w1 + w2); w0 *= inv; w1 *= inv; w2 *= inv;
            float f0[8], f1[8], f2[8], z[8], o[8]; unpack8(o0[q], f0); unpack8(o1[q], f1); unpack8(o2[q], f2); unpack8(zb[q], z);
#pragma unroll
            for (int e = 0; e < 8; ++e) o[e] = (w0 * f0[e] + w1 * f1[e] + w2 * f2[e]) * siluf_(z[e]);
            u32x4 ov; ov.x = pk2(o[0], o[1]); ov.y = pk2(o[2], o[3]); ov.z = pk2(o[4], o[5]); ov.w = pk2(o[6], o[7]);
            *(u32x4*)(UA + (size_t)(r0 + q) * 1536 + c) = ov;
        }
    }
}

__device__ __forceinline__ void phase_norm(const Args& a, int vcu, int G) {
    const int tid = opaque_tid(), lane = tid & 63, wave = tid >> 6;
    const bf16* dl = (const bf16*)(a.ws + WS_H);
    for (int r0 = 2 * (vcu * NWAVES + wave); r0 < MALL; r0 += 2 * G * NWAVES) {
        f32x4 v[2][4]; u32x2 d[2][4]; float ss[2] = {0.f, 0.f};
#pragma unroll
        for (int q = 0; q < 2; ++q) { const f32x4* xr = (const f32x4*)(a.x + (size_t)(r0 + q) * DM) + lane; const u32x2* dr = (const u32x2*)(dl + (size_t)(r0 + q) * DM) + lane;
#pragma unroll
            for (int j = 0; j < 4; ++j) { v[q][j] = xr[64 * j]; d[q][j] = dr[64 * j]; } }
#pragma unroll
        for (int q = 0; q < 2; ++q)
#pragma unroll
            for (int j = 0; j < 4; ++j) { v[q][j] += (f32x4){bflo(d[q][j].x), bfhi(d[q][j].x), bflo(d[q][j].y), bfhi(d[q][j].y)};
                ss[q] += (v[q][j].x * v[q][j].x + v[q][j].y * v[q][j].y) + (v[q][j].z * v[q][j].z + v[q][j].w * v[q][j].w); }
#pragma unroll
        for (int o = 1; o < 64; o <<= 1) { ss[0] += __shfl_xor(ss[0], o); ss[1] += __shfl_xor(ss[1], o); }
#pragma unroll
        for (int q = 0; q < 2; ++q) { const float rinv = 1.f / sqrtf(ss[q] * (1.f / DM) + EPS);
#pragma unroll
            for (int j = 0; j < 4; ++j) { const f32x4 gf = *((const f32x4*)a.g_final + lane + 64 * j); *((f32x4*)(a.out + (size_t)(r0 + q) * DM) + lane + 64 * j) = v[q][j] * rinv * gf; } }
    }
}


#define LAS __attribute__((address_space(3)))
#define XB_TMO      128
#define XB_XCNT(j)  (256  + 64 * (j))
#define XB_XSUB(j)  (1280 + 64 * (j))
#define XB_XGEN(j)  (2304 + 64 * (j))
#define XB_TOP      3328
#define XB_TOPGEN   3392
#define XCD_BAR_WORDS 3456
#define XB_SPIN_CAP (1u << 22)
constexpr int CW_BAR = 4096;
__device__ __forceinline__ unsigned xb_ld(unsigned* p)              { return __hip_atomic_load(p, __ATOMIC_RELAXED, __HIP_MEMORY_SCOPE_AGENT); }
__device__ __forceinline__ unsigned xb_add(unsigned* p, unsigned v) { return __hip_atomic_fetch_add(p, v, __ATOMIC_RELAXED, __HIP_MEMORY_SCOPE_AGENT); }
__device__ __forceinline__ unsigned xb_xcc_id() { return (unsigned)__builtin_amdgcn_s_getreg((3 << 11) | 20) & 0xFu; }
#define XB_SPIN(cond, bar) do { unsigned _sp = 0; while (cond) { __builtin_amdgcn_s_sleep(1); \
    if ((++_sp & 255u) == 0u) { if (xb_ld(&(bar)[XB_TMO])) break; if (_sp > XB_SPIN_CAP) { atomicAdd(&(bar)[XB_TMO], 1u); break; } } } } while (0)
struct XcdBarrier { unsigned* bar; unsigned x; volatile LAS unsigned* st; };
__device__ __forceinline__ XcdBarrier xcd_barrier_post(unsigned* bar, volatile LAS unsigned* st) {
    XcdBarrier b; b.bar = bar; b.x = xb_xcc_id(); b.st = st;
    if (threadIdx.x == 0) (void)xb_add(&bar[XB_XCNT(b.x)], 1u);
    return b;
}
__device__ __forceinline__ void xcd_barrier_complete(unsigned* bar, unsigned x, unsigned& nloc, unsigned& nx) {
    const unsigned G = gridDim.x * gridDim.y * gridDim.z;
    unsigned sum, cnt, mine, sp = 0u;
    for (;;) {
        sum = 0u; cnt = 0u; mine = 0u;
#pragma unroll
        for (unsigned j = 0; j < 16; ++j) { const unsigned c = xb_ld(&bar[XB_XCNT(j)]); sum += c; cnt += (c > 0u) ? 1u : 0u; mine = (j == x) ? c : mine; }
        if (sum == G) break;
        __builtin_amdgcn_s_sleep(1);
        if ((++sp & 255u) == 0u) { if (xb_ld(&bar[XB_TMO])) break; if (sp > XB_SPIN_CAP) { atomicAdd(&bar[XB_TMO], 1u); break; } }
    }
    nloc = mine > 0u ? mine : 1u; nx = cnt > 0u ? cnt : 1u;
}
__device__ __forceinline__ void xcd_barrier(const XcdBarrier& b) {
    asm volatile("s_waitcnt vmcnt(0)" ::: "memory");
    __syncthreads();
    if (threadIdx.x == 0) {
        unsigned* bar = b.bar;
        __builtin_amdgcn_s_waitcnt(0);
        unsigned nloc = b.st[0], nx = b.st[1];
        if (nloc == 0u) { xcd_barrier_complete(bar, b.x, nloc, nx); b.st[0] = nloc; b.st[1] = nx; }
        const unsigned old = xb_add(&bar[XB_XSUB(b.x)], 1u);
        const unsigned gen = old / nloc;
        if (old + 1u == (gen + 1u) * nloc) {
            __builtin_amdgcn_fence(__ATOMIC_RELEASE, "agent");
            asm volatile("s_waitcnt vmcnt(0)" ::: "memory");
            const unsigned og = xb_add(&bar[XB_TOP], 1u);
            const unsigned tg = og / nx;
            if (og + 1u == (tg + 1u) * nx) xb_add(&bar[XB_TOPGEN], 1u);
            else XB_SPIN(xb_ld(&bar[XB_TOPGEN]) == tg, bar);
            __builtin_amdgcn_fence(__ATOMIC_ACQUIRE, "agent");
            xb_add(&bar[XB_XGEN(b.x)], 1u);
            asm volatile("s_waitcnt vmcnt(0)" ::: "memory");
        } else {
            XB_SPIN(xb_ld(&bar[XB_XGEN(b.x)]) == gen, bar);
            __builtin_amdgcn_fence(__ATOMIC_ACQUIRE, "agent");
            asm volatile("s_waitcnt vmcnt(0)" ::: "memory");
        }
    }
    __syncthreads();
}

constexpr int PH_PER_PASS = 5, PH_TOTAL = 4 + PH_PER_PASS * NPASS + 1;
#define PROBE_KIND_OF(k) ((k) == 0 ? K_CPREP : (k) == 1 ? K_MIX : (k) == 2 ? K_POST : (k) == 3 ? K_OUT1 : K_OUT2)
enum { K_PROLOGUE = 0, K_H = 1, K_INPROJ = 2, K_PREP = 3, K_QK = 4, K_MIX = 5, K_POST = 6, K_OUT1 = 7, K_OUT2 = 8, K_NORM = 9, K_CPREP = 10, K_OUT2IN = 12 };

__device__ __forceinline__ Args fresh_args() {
    Args a{};
#if defined(__HIP_DEVICE_COMPILE__)
    typedef const __attribute__((address_space(4))) unsigned long long* KP;
    KP q = (KP)__builtin_amdgcn_kernarg_segment_ptr(); asm volatile("" : "+s"(q));
    static_assert(sizeof(Args) == 22 * 8, "Args layout");
    unsigned long long w[22];
#pragma unroll
    for (int i = 0; i < 22; ++i) w[i] = q[i];
    __builtin_memcpy(&a, w, sizeof(Args));
#endif
    return a;
}
template <int KIND>
__device__ __forceinline__ void run_phase(const Args& args, unsigned char* lds, int pass, const XcdBarrier* pbar = nullptr) {
    const int G = gridDim.x; const int bx = blockIdx.x;
    const int vcu = (G % 8 == 0) ? (bx % 8) * (G / 8) + bx / 8 : bx;
    unsigned char* ws = args.ws;
    PG8_LAS unsigned char* lds3 = (PG8_LAS unsigned char*)lds;
    if constexpr (KIND == K_PROLOGUE) phase_prologue(args, lds, vcu, G);
    else if constexpr (KIND == K_H) phase_h(args, lds, vcu, G);
    else if constexpr (KIND == K_NORM) phase_norm(args, vcu, G);
    else if constexpr (KIND == K_INPROJ) {
        pg8::Gemm<1024, 1024, 1024> g{(const bf16*)(ws + WS_H) + (size_t)pass * MS * 1024, (const bf16*)(ws + WS_WIN)};
        pg8::StaticOrder S; S.init(MS, INW, G, bx);
        EpiProj E{(bf16*)(ws + WS_P), (const float*)(ws + WS_ROPE) + (size_t)pass * MS * 32};
        pg8::gemm_phase<EpiProj, pg8::StaticOrder, true, true>(lds3, g, S, E);
    } else if constexpr (KIND == K_PREP) phase_gates(args, lds, vcu, G);
    else if constexpr (KIND == K_QK) {
        pg8::Gemm<1024, 256, 256, 512, 512 * 256 * 2> g{(const bf16*)(ws + WS_XC), (const bf16*)(ws + WS_WQK)};
        pg8::GroupOrder S; S.init(MS, G, bx);
        EpiQK E{(bf16*)(ws + WS_QM), (bf16*)(ws + WS_KM)};
        pg8::gemm_phase<EpiQK, pg8::GroupOrder, true, true>(lds3, g, S, E);
    } else if constexpr (KIND == K_CPREP) phase_cprep(args, lds, vcu, G, pass);
    else if constexpr (KIND == K_MIX) phase_mix(args, lds, pass, pbar);
    else if constexpr (KIND == K_POST) phase_post(args, lds, vcu, G, pass);
    else if constexpr (KIND == K_OUT1) {
        pg8::Gemm<1536, 1536, 1536> g{(const bf16*)(ws + WS_ACAT), (const bf16*)(ws + WS_WOM)};
        pg8::StaticOrder S; S.init(MS, 1024, G, bx);
        EpiMerge E{(const bf16*)(ws + WS_P), (bf16*)(ws + WS_MG)};
        pg8::gemm_phase<EpiMerge, pg8::StaticOrder, true, true>(lds3, g, S, E);
    } else if constexpr (KIND == K_OUT2IN) {
        GemmCombo g{(const bf16*)(ws + WS_MG), (const bf16*)(ws + WS_WO), (const bf16*)(ws + WS_H) + (size_t)(pass + 1) * MS * 1024, (const bf16*)(ws + WS_WIN)};
        ComboOrder S; S.init(G, bx);
        EpiCombo E{EpiOut{(bf16*)(ws + WS_H), (const float*)(ws + WS_MOD) + 2048, pass * MS}, EpiProj{(bf16*)(ws + WS_P), (const float*)(ws + WS_ROPE) + (size_t)(pass + 1) * MS * 32}};
        pg8::gemm_phase<EpiCombo, ComboOrder, true, true>(lds3, g, S, E);
    } else if constexpr (KIND == K_OUT2) {
        pg8::Gemm<1024, 1024, 1024> g{(const bf16*)(ws + WS_MG), (const bf16*)(ws + WS_WO)};
        pg8::StaticOrder S; S.init(MS, 1024, G, bx);
        EpiOut E{(bf16*)(ws + WS_H), (const float*)(ws + WS_MOD) + 2048, pass * MS};
        pg8::gemm_phase<EpiOut, pg8::StaticOrder, true, true>(lds3, g, S, E);
    }
}

#if !MK_ONE_LAUNCH
template <int KIND>
__global__ void __launch_bounds__(NTHR, 2) k_phase(Args args) {
    extern __shared__ __attribute__((aligned(16))) unsigned char lds[];
    run_phase<KIND>(args, lds, args.ph_lo);
}
#else
__global__ void __launch_bounds__(NTHR, 2) mk_fwd(Args args) {
    extern __shared__ __attribute__((aligned(16))) unsigned char lds[];
    volatile LAS unsigned* misc = (volatile LAS unsigned*)((LAS unsigned char*)lds + 131072 + 2048);
    if (threadIdx.x < 16) misc[threadIdx.x] = 0u;
    __syncthreads();
    XcdBarrier bar = xcd_barrier_post((unsigned*)(args.ws + WS_CTL) + CW_BAR, misc + 8);
#ifdef PROBE_TMASK
    unsigned long long pr_acc = 0ull;
#endif
    for (int gp = args.ph_lo; gp < args.ph_hi; ++gp) {
#ifdef PROBE_TMASK
        const unsigned long long pr_t0 = __builtin_amdgcn_s_memrealtime();
        int pr_kind;
        if (gp == 0) pr_kind = K_PROLOGUE; else if (gp == 1) pr_kind = K_H; else if (gp == 2) pr_kind = K_PREP; else if (gp == 3) pr_kind = K_INPROJ; else if (gp == PH_TOTAL - 1) pr_kind = K_NORM;
        else { const int k = (gp - 4) % PH_PER_PASS; pr_kind = PROBE_KIND_OF(k); }
#endif
        if (gp == 0) run_phase<K_PROLOGUE>(args, lds, 0);
        else if (gp == 1) run_phase<K_H>(args, lds, 0);
        else if (gp == 2) run_phase<K_PREP>(args, lds, 0);
        else if (gp == 3) run_phase<K_INPROJ>(args, lds, 0);
        else if (gp == PH_TOTAL - 1) run_phase<K_NORM>(args, lds, 0);
        else {
            const int pass = (gp - 4) / PH_PER_PASS, k = (gp - 4) % PH_PER_PASS;
            if (k == 0) run_phase<K_CPREP>(args, lds, pass);
            else if (k == 1) run_phase<K_MIX>(args, lds, pass, &bar);
            else if (k == 2) run_phase<K_POST>(args, lds, pass);
            else if (k == 3) run_phase<K_OUT1>(args, lds, pass);
            else if (pass + 1 < NPASS) run_phase<K_OUT2IN>(args, lds, pass);
            else run_phase<K_OUT2>(args, lds, pass);
        }
#ifdef PROBE_TMASK
        const unsigned long long pr_tb = __builtin_amdgcn_s_memrealtime();
#endif
        if (gp + 1 < args.ph_hi) xcd_barrier(bar);
#ifdef PROBE_TMASK
        else __syncthreads();
        if ((PROBE_TMASK >> 11) & 1) pr_acc += __builtin_amdgcn_s_memrealtime() - pr_tb;
        if ((PROBE_TMASK >> pr_kind) & 1) pr_acc += __builtin_amdgcn_s_memrealtime() - pr_t0;
#endif
    }
#ifdef PROBE_TMASK
    if (blockIdx.x == 0) { const unsigned long long t1 = __builtin_amdgcn_s_memrealtime(); while (__builtin_amdgcn_s_memrealtime() - t1 < 4ull * pr_acc) __builtin_amdgcn_s_sleep(8); }
#endif
}
#endif

extern "C" void kernel_launch(void* const* d_in, const int* in_sizes, int n_in, void* d_out, int out_size, void* d_ws, size_t ws_size, hipStream_t stream) {
    static int grid = 0;
    if (grid == 0) {
        if (n_in != 19 || in_sizes[0] != MALL * DM || out_size != MALL * DM || ws_size < WS_END) { fprintf(stderr, "kernel_launch: unexpected shapes (n_in %d, ws %zu)\n", n_in, ws_size); grid = -1; return; }
        int dev = 0, cus = 0, per_cu = 0;
        (void)hipGetDevice(&dev); (void)hipDeviceGetAttribute(&cus, hipDeviceAttributeMultiprocessorCount, dev);
#if MK_ONE_LAUNCH
        (void)hipFuncSetAttribute((const void*)mk_fwd, hipFuncAttributeMaxDynamicSharedMemorySize, LDS_BYTES);
        (void)hipOccupancyMaxActiveBlocksPerMultiprocessor(&per_cu, (const void*)mk_fwd, NTHR, LDS_BYTES);
        if (per_cu < 1) { fprintf(stderr, "kernel_launch: occupancy query says %d\n", per_cu); per_cu = 1; }
#else
#define SETATTR(KIND) (void)hipFuncSetAttribute((const void*)k_phase<KIND>, hipFuncAttributeMaxDynamicSharedMemorySize, LDS_BYTES)
        SETATTR(K_PROLOGUE); SETATTR(K_H); SETATTR(K_INPROJ); SETATTR(K_PREP); SETATTR(K_QK); SETATTR(K_MIX); SETATTR(K_POST); SETATTR(K_OUT1); SETATTR(K_OUT2); SETATTR(K_NORM); SETATTR(K_CPREP); SETATTR(K_OUT2IN);
        (void)per_cu;
#endif
        (void)hipGetLastError();
        grid = cus;
    }
    if (grid < 0) return;
    (void)hipMemsetAsync((char*)d_ws + WS_CTL, 0, CTL_ZERO_BYTES, stream);
    Args a{};
    a.x = (const float*)d_in[0]; a.c = (const float*)d_in[1]; a.pos = (const int*)d_in[2]; a.w_ada = (const float*)d_in[3]; a.b_ada = (const float*)d_in[4];
    a.g_norm = (const float*)d_in[5]; a.w_in = (const float*)d_in[6]; a.b_ig = (const float*)d_in[7]; a.b_fg = (const float*)d_in[8]; a.w_conv = (const float*)d_in[9];
    a.b_conv = (const float*)d_in[10]; a.w_q = (const float*)d_in[11]; a.w_k = (const float*)d_in[12]; a.g_head = (const float*)d_in[13]; a.skip = (const float*)d_in[14];
    a.w_om = (const float*)d_in[15]; a.w_oa = (const float*)d_in[16]; a.w_o = (const float*)d_in[17]; a.g_final = (const float*)d_in[18];
    a.out = (float*)d_out; a.ws = (unsigned char*)d_ws;
#if MK_ONE_LAUNCH
    a.ph_lo = 0; a.ph_hi = PH_TOTAL;
    void* params[] = {&a};
    hipError_t e = hipLaunchCooperativeKernel((const void*)mk_fwd, dim3(grid), dim3(NTHR), params, LDS_BYTES, stream);
    if (e != hipSuccess) fprintf(stderr, "cooperative launch failed: %s\n", hipGetErrorString(e));
#else
#define LAUNCH(KIND, PASS) do { a.ph_lo = (PASS); a.ph_hi = 0; hipLaunchKernelGGL(k_phase<KIND>, dim3(grid), dim3(NTHR), LDS_BYTES, stream, a); } while (0)
    LAUNCH(K_PROLOGUE, 0); LAUNCH(K_H, 0);
    LAUNCH(K_PREP, 0); LAUNCH(K_INPROJ, 0);
    for (int p = 0; p < NPASS; ++p) { LAUNCH(K_CPREP, p); LAUNCH(K_MIX, p); LAUNCH(K_POST, p); LAUNCH(K_OUT1, p); if (p + 1 < NPASS) LAUNCH(K_OUT2IN, p); else LAUNCH(K_OUT2, p); }
    LAUNCH(K_NORM, 0);
#endif
}
```

```cpp
#include <hip/hip_runtime.h>
#include <hip/hip_cooperative_groups.h>
#include <cstdio>
#include <cstdint>
namespace cg = cooperative_groups;

#ifndef MK_ONE_LAUNCH
#define MK_ONE_LAUNCH 1
#endif

__device__ __forceinline__ int opaque_tid() { int t = threadIdx.x; asm volatile("" : "+v"(t)); return t; }
namespace pg8 {
#define PG8_LAS __attribute__((address_space(3)))
typedef unsigned short bf16_t;
typedef short bf16x8 __attribute__((ext_vector_type(8)));
typedef float f32x4 __attribute__((ext_vector_type(4)));
typedef unsigned u32x4 __attribute__((ext_vector_type(4)));
constexpr int BM = 256, BK = 64, HALF = 128, HTB = HALF * BK * 2, STAGE_BYTES = 8 * HTB, NXCD = 8, WGM = 8;

__host__ __device__ __forceinline__ int lds_byte(int r, int c) { const int st = (r >> 4) * 2 + (c >> 5), rr = r & 15, cc = c & 31, ob = rr * 64 + cc * 2; return st * 1024 + (ob ^ (((ob >> 9) & 1) << 5)); }
__host__ __device__ __forceinline__ void stage_rc(int b, int& R, int& C) { const int st = b / 1024, sb = b % 1024, swz = sb ^ (((sb >> 9) & 1) << 5); R = (st >> 1) * 16 + swz / 64; C = (st & 1) * 32 + (swz % 64) / 2; }
__host__ __device__ __forceinline__ int perm32(int rho) { const int n = rho >> 4, i = rho & 15; return 8 * (i >> 2) + 4 * n + (i & 3); }

struct Unit { int pm, pn, g; };
template <int LDA, int LDB, int KK, int AGS = 0, int BGS = 0> struct Gemm {
    const bf16_t* A; const bf16_t* Bt;
    static constexpr int lda = LDA, ldb = LDB, K = KK;
    __device__ __forceinline__ const char* abase(const Unit& u) const { return (const char*)A + (size_t)(u.g * AGS) + (size_t)u.pm * (size_t)(BM * 2 * LDA); }
    __device__ __forceinline__ const char* bbase(const Unit& u) const { return (const char*)Bt + (size_t)(u.g * BGS) + (size_t)u.pn * (size_t)(BM * 2 * LDB); }
};

struct StaticOrder {
    int nM, nN, nwg, G, c;
    __host__ __device__ void init(int M, int N, int G_, int c_) { nM = M / BM; nN = N / BM; nwg = nM * nN; G = G_; c = c_; }
    __host__ __device__ bool next(int i, Unit& u) const {
        const long L = (long)i * G + c; if (L >= nwg) return false;
        int wgid = (int)L; { const int q = nwg / NXCD, r = nwg % NXCD, xcd = wgid % NXCD, off = wgid / NXCD; wgid = (xcd < r ? xcd * (q + 1) : r * (q + 1) + (xcd - r) * q) + off; }
        const int nig = WGM * nN, gid = wgid / nig, fm = gid * WGM, gsz = (nM - fm) < WGM ? (nM - fm) : WGM;
        u.pm = fm + ((wgid % nig) % gsz); u.pn = (wgid % nig) / gsz; u.g = 0; return true;
    }
    __device__ __forceinline__ void a_ready(const Unit&) const {}
    __device__ __forceinline__ void done(const Unit&) const {}
};
struct GroupOrder {
    int nunits, G, c;
    __host__ __device__ void init(int M, int G_, int c_) { nunits = (M / BM) * 8; G = G_; c = c_; }
    __host__ __device__ bool next(int i, Unit& u) const {
        const long L = (long)i * G + c; if (L >= nunits) return false;
        u.pm = (int)(L >> 3); u.g = (int)((L & 7) >> 1); u.pn = (int)(L & 1); return true;
    }
    __device__ __forceinline__ void a_ready(const Unit&) const {}
    __device__ __forceinline__ void done(const Unit&) const {}
};

__device__ __forceinline__ unsigned cvt_pk_bf16(float lo, float hi) { unsigned r; asm volatile("v_cvt_pk_bf16_f32 %0, %1, %2" : "=v"(r) : "v"(lo), "v"(hi)); return r; }

template <class Epi, class Sched, bool ALIGN_EPI, bool SP2, class GemmT>
__device__ __forceinline__ void gemm_phase(PG8_LAS unsigned char* lds, const GemmT g, const Sched& S, const Epi& E) {
    const int tid = opaque_tid(), wid = __builtin_amdgcn_readfirstlane(tid >> 6), lane = tid & 63, wr = wid >> 2, wc = wid & 3, fr = lane & 15, fq = lane >> 4;
    constexpr int K = GemmT::K, nt = K / BK;
    unsigned voffA[2], voffB[2];
#pragma unroll
    for (int i = 0; i < 2; ++i) { int R, C; stage_rc(tid * 16 + i * 8192, R, C); const int Rb = Epi::PERM ? (64 * (R >> 5) + perm32(R & 31)) : R;
        voffA[i] = (unsigned)(R * g.lda + C) * 2u; voffB[i] = (unsigned)(Rb * g.ldb + C) * 2u; }
    const size_t kstep = (size_t)(BK * 2);
    const size_t hstepA = (size_t)HALF * g.lda * 2, hstepB = (size_t)(Epi::PERM ? 32 : HALF) * g.ldb * 2;
    const unsigned ldsw = (unsigned)wid * 1024u;
    const int aoff = lds_byte(wr * 64 + fr, fq * 8), boff = lds_byte(wc * 32 + fr, fq * 8);
#define PG8_SA(b, h) (((b) * 2 + (h)) * HTB)
#define PG8_SB(b, h) ((4 + (b) * 2 + (h)) * HTB)
#define PG8_STAGE(bufoff, gbase, voff) do { _Pragma("unroll") for (int _i = 0; _i < 2; ++_i) \
        __builtin_amdgcn_global_load_lds((const unsigned*)((const char*)(gbase) + (voff)[_i]), (PG8_LAS unsigned*)(lds + (bufoff) + ldsw + _i * 8192), 16, 0, 0); } while (0)
#define PG8_LDA(dst, b, h) do { _Pragma("unroll") for (int m = 0; m < 4; ++m) _Pragma("unroll") for (int k = 0; k < 2; ++k) dst[m][k] = *(const PG8_LAS bf16x8*)(lds + PG8_SA(b, h) + aoff + m * 2048 + k * 1024); } while (0)
#define PG8_LDB(dst, b, h) do { _Pragma("unroll") for (int n = 0; n < 2; ++n) _Pragma("unroll") for (int k = 0; k < 2; ++k) dst[n][k] = *(const PG8_LAS bf16x8*)(lds + PG8_SB(b, h) + boff + n * 2048 + k * 1024); } while (0)
#define PG8_MMA(ai, bj, At, Bt) do { __builtin_amdgcn_s_setprio(1); _Pragma("unroll") for (int m = 0; m < 4; ++m) _Pragma("unroll") for (int n = 0; n < 2; ++n) _Pragma("unroll") for (int k = 0; k < 2; ++k) \
        acc[ai][bj][m][n] = __builtin_amdgcn_mfma_f32_16x16x32_bf16(Bt[n][k], At[m][k], acc[ai][bj][m][n], 0, 0, 0); __builtin_amdgcn_s_setprio(0); } while (0)
#define PG8_WAIT_V(n) asm volatile("s_waitcnt vmcnt(" #n ")" ::: "memory")
#define PG8_WAIT_L(n) asm volatile("s_waitcnt lgkmcnt(" #n ")" ::: "memory")
#define PG8_BAR __builtin_amdgcn_s_barrier()
#define PG8_SCHED __builtin_amdgcn_sched_barrier(0)
    Unit cur, nxt; int ui = 0;
    if (!S.next(0, cur)) return;
    f32x4 acc[2][2][4][2];
#pragma unroll
    for (int a = 0; a < 2; ++a)
#pragma unroll
        for (int b = 0; b < 2; ++b)
#pragma unroll
            for (int m = 0; m < 4; ++m)
#pragma unroll
                for (int n = 0; n < 2; ++n) acc[a][b][m][n] = (f32x4){0.f, 0.f, 0.f, 0.f};
    bf16x8 At[4][2], B0[2][2], B1[2][2];
    const char* cA = g.abase(cur); const char* cB = g.bbase(cur);
    S.a_ready(cur);
    if constexpr (SP2) {
        PG8_STAGE(PG8_SB(0, 0), cB, voffB); PG8_STAGE(PG8_SB(0, 1), cB + hstepB, voffB); PG8_STAGE(PG8_SA(0, 0), cA, voffA); PG8_STAGE(PG8_SA(0, 1), cA + hstepA, voffA);
        if (wr == 1) PG8_BAR;
        PG8_WAIT_V(2); PG8_BAR;
        PG8_STAGE(PG8_SB(1, 0), cB + kstep, voffB); PG8_STAGE(PG8_SA(1, 0), cA + kstep, voffA); PG8_STAGE(PG8_SB(1, 1), cB + hstepB + kstep, voffB);
        PG8_WAIT_V(6); PG8_BAR;
    } else {
        PG8_STAGE(PG8_SB(0, 0), cB, voffB); PG8_STAGE(PG8_SA(0, 0), cA, voffA); PG8_STAGE(PG8_SB(0, 1), cB + hstepB, voffB); PG8_STAGE(PG8_SA(0, 1), cA + hstepA, voffA);
        if (wr == 1) PG8_BAR;
        PG8_WAIT_V(4); PG8_BAR;
        PG8_STAGE(PG8_SB(1, 0), cB + kstep, voffB); PG8_STAGE(PG8_SA(1, 0), cA + kstep, voffA); PG8_STAGE(PG8_SB(1, 1), cB + hstepB + kstep, voffB);
        PG8_WAIT_V(6); PG8_BAR;
    }
    for (;;) {
        const bool has_next = S.next(ui + 1, nxt);
        const char* nA = has_next ? g.abase(nxt) : cA; const char* nB = has_next ? g.bbase(nxt) : cB;
#pragma nounroll
        for (int t = 0; t < nt; t += 2) {
            const bool last = (t == nt - 2);
            const char* a1 = cA + (size_t)(t + 1) * kstep;
            const char* a2 = last ? nA : cA + (size_t)(t + 2) * kstep; const char* b2 = last ? nB : cB + (size_t)(t + 2) * kstep;
            const char* a3 = a2 + kstep; const char* b3 = b2 + kstep;
            if (last && has_next) S.a_ready(nxt);
            if constexpr (Epi::HOOK_T >= 0) { if (t == Epi::HOOK_T) E.hook(acc, cur, wr, wc, fr, fq); }
            if constexpr (SP2) {
            PG8_LDB(B0, 0, 0); PG8_LDB(B1, 0, 1); PG8_SCHED; PG8_LDA(At, 0, 0); PG8_STAGE(PG8_SA(1, 1), a1 + hstepA, voffA);
            PG8_WAIT_V(8); PG8_WAIT_L(0); PG8_BAR; PG8_MMA(0, 0, At, B0); PG8_MMA(0, 1, At, B1); PG8_BAR; PG8_SCHED;
            PG8_LDA(At, 0, 1); PG8_STAGE(PG8_SB(0, 0), b2, voffB); PG8_STAGE(PG8_SB(0, 1), b2 + hstepB, voffB); PG8_STAGE(PG8_SA(0, 0), a2, voffA);
            PG8_WAIT_V(8); PG8_WAIT_L(0); PG8_BAR; PG8_MMA(1, 0, At, B0); PG8_MMA(1, 1, At, B1); PG8_BAR; PG8_SCHED;
            PG8_LDB(B0, 1, 0); PG8_LDB(B1, 1, 1); PG8_SCHED; PG8_LDA(At, 1, 0); PG8_STAGE(PG8_SA(0, 1), a2 + hstepA, voffA);
            PG8_WAIT_V(8); PG8_WAIT_L(0); PG8_BAR; PG8_MMA(0, 0, At, B0); PG8_MMA(0, 1, At, B1); PG8_BAR; PG8_SCHED;
            PG8_LDA(At, 1, 1); PG8_STAGE(PG8_SB(1, 0), b3, voffB); PG8_STAGE(PG8_SB(1, 1), b3 + hstepB, voffB); PG8_STAGE(PG8_SA(1, 0), a3, voffA);
            PG8_WAIT_V(8); PG8_WAIT_L(0); PG8_BAR; PG8_MMA(1, 0, At, B0); PG8_MMA(1, 1, At, B1); PG8_BAR; PG8_SCHED;
            } else {
            PG8_LDB(B0, 0, 0); PG8_SCHED; PG8_LDA(At, 0, 0); PG8_STAGE(PG8_SA(1, 1), a1 + hstepA, voffA);
            PG8_WAIT_L(8); PG8_BAR; PG8_WAIT_L(0); PG8_MMA(0, 0, At, B0); PG8_BAR; PG8_SCHED;
            PG8_LDB(B1, 0, 1); PG8_STAGE(PG8_SB(0, 0), b2, voffB);
            PG8_BAR; PG8_WAIT_L(0); PG8_MMA(0, 1, At, B1); PG8_BAR;
            PG8_LDA(At, 0, 1); PG8_STAGE(PG8_SA(0, 0), a2, voffA);
            PG8_BAR; PG8_WAIT_L(0); PG8_MMA(1, 0, At, B0); PG8_BAR; PG8_SCHED;
            PG8_STAGE(PG8_SB(0, 1), b2 + hstepB, voffB);
            PG8_WAIT_V(6); PG8_BAR; PG8_MMA(1, 1, At, B1); PG8_BAR;
            PG8_LDB(B0, 1, 0); PG8_SCHED; PG8_LDA(At, 1, 0); PG8_STAGE(PG8_SA(0, 1), a2 + hstepA, voffA);
            PG8_WAIT_L(8); PG8_BAR; PG8_WAIT_L(0); PG8_MMA(0, 0, At, B0); PG8_BAR; PG8_SCHED;
            PG8_LDB(B1, 1, 1); PG8_STAGE(PG8_SB(1, 0), b3, voffB);
            PG8_BAR; PG8_WAIT_L(0); PG8_MMA(0, 1, At, B1); PG8_BAR;
            PG8_LDA(At, 1, 1); PG8_STAGE(PG8_SA(1, 0), a3, voffA);
            PG8_BAR; PG8_WAIT_L(0); PG8_MMA(1, 0, At, B0); PG8_BAR; PG8_SCHED;
            PG8_STAGE(PG8_SB(1, 1), b3 + hstepB, voffB);
            PG8_WAIT_V(6); PG8_BAR; PG8_MMA(1, 1, At, B1); PG8_BAR;
            }
        }
        if constexpr (ALIGN_EPI) { if (wr == 0) PG8_BAR; }
        E(acc, cur, wr, wc, fr, fq); S.done(cur);
        if (!has_next) break;
#pragma unroll
        for (int a = 0; a < 2; ++a)
#pragma unroll
            for (int b = 0; b < 2; ++b)
#pragma unroll
                for (int m = 0; m < 4; ++m)
#pragma unroll
                    for (int n = 0; n < 2; ++n) acc[a][b][m][n] = (f32x4){0.f, 0.f, 0.f, 0.f};
        cur = nxt; cA = nA; cB = nB; ++ui;
        if constexpr (ALIGN_EPI) { if (wr == 1) PG8_BAR; }
    }
    PG8_WAIT_V(0);
    if constexpr (!ALIGN_EPI) { if (wr == 0) PG8_BAR; }
    PG8_BAR;
#undef PG8_SA
#undef PG8_SB
#undef PG8_STAGE
#undef PG8_LDA
#undef PG8_LDB
#undef PG8_MMA
#undef PG8_WAIT_V
#undef PG8_WAIT_L
#undef PG8_BAR
#undef PG8_SCHED
}
}

constexpr int NWAVES = 8, NTHR = 512;
constexpr int DM = 1024, NBATCH = 16, SEQ = 4096, MALL = NBATCH * SEQ;
constexpr int NB_PASS = 4, MS = NB_PASS * SEQ, NPASS = NBATCH / NB_PASS;
constexpr int INW_SRC = 11272, INW = 11264;
constexpr int C_XA = 0, C_VA = 1024, C_OA = 2048, C_ZA = 3072, C_QA = 4096, C_KA = 5632, C_VT = 7168, C_ZB = 8704, C_GA = 9216, C_GB = 10240;
constexpr float EPS = 1e-6f;

constexpr size_t MiB = 1u << 20;
constexpr size_t WS_CTL = 0, CTL_ZERO_BYTES = 1 * MiB;
constexpr size_t WS_MOD = 1 * MiB;
constexpr size_t WS_WG = 1 * MiB + 256 * 1024;
constexpr size_t WS_WIN = 2 * MiB;
constexpr size_t WS_WQK = 24 * MiB;
constexpr size_t WS_WOM = 25 * MiB, WS_WOA = 27 * MiB, WS_WO = 28 * MiB;
constexpr size_t WS_IG = 30 * MiB, WS_FG = 31 * MiB;
constexpr size_t WS_GSC = 580 * MiB, GSC_STRIDE = 2 * MiB;
constexpr size_t WS_LSE = 34 * MiB;
constexpr size_t WS_DEN = 35 * MiB;
constexpr size_t WS_H = 36 * MiB;
constexpr size_t WS_P = 164 * MiB;
constexpr size_t WS_XC = 516 * MiB;
constexpr size_t WS_QM = 548 * MiB, WS_KM = 580 * MiB;
constexpr size_t WS_HR = 612 * MiB;
constexpr size_t WS_AO = 644 * MiB;
constexpr size_t WS_UA = 692 * MiB;
constexpr size_t WS_ACAT = 708 * MiB;
constexpr size_t WS_MG = 772 * MiB;
constexpr size_t WS_SG = 804 * MiB;
constexpr size_t WS_KTG = 812 * MiB;
constexpr size_t WS_VTG = 844 * MiB;
constexpr size_t WS_CS = 876 * MiB;
constexpr size_t WS_NS = 1004 * MiB;
constexpr size_t WS_ROPE = 1005 * MiB;
constexpr size_t WS_END = 1013 * MiB;
constexpr int CW_QCTR = 1024;
constexpr int CW_ROWSS = 65536;
static_assert((CW_ROWSS + MALL) * 4 <= (int)CTL_ZERO_BYTES, "ctl");

constexpr int LDS_BYTES = 147456;

typedef unsigned short bf16;
typedef float f32x4 __attribute__((ext_vector_type(4)));
typedef float f32x2 __attribute__((ext_vector_type(2)));
typedef short bf16x8 __attribute__((ext_vector_type(8)));
typedef unsigned u32x4 __attribute__((ext_vector_type(4)));
typedef unsigned u32x2 __attribute__((ext_vector_type(2)));
typedef short s16x4 __attribute__((ext_vector_type(4)));

__device__ __forceinline__ unsigned f2bf(float f) { unsigned u = __builtin_bit_cast(unsigned, f); return (u + 0x7fffu + ((u >> 16) & 1u)) >> 16; }
__device__ __forceinline__ unsigned pk2(float lo, float hi) { return f2bf(lo) | (f2bf(hi) << 16); }
__device__ __forceinline__ float bflo(unsigned w) { return __builtin_bit_cast(float, w << 16); }
__device__ __forceinline__ float bfhi(unsigned w) { return __builtin_bit_cast(float, w & 0xffff0000u); }
__device__ __forceinline__ float bf1(bf16 v) { return __builtin_bit_cast(float, (unsigned)v << 16); }
__device__ __forceinline__ float sigmoidf_(float x) { return 1.f / (1.f + __expf(-x)); }
__device__ __forceinline__ float siluf_(float x) { return x / (1.f + __expf(-x)); }
__device__ __forceinline__ float wave_sum(float v) {
#pragma unroll
    for (int o = 1; o < 64; o <<= 1) v += __shfl_xor(v, o);
    return v;
}
__device__ __forceinline__ void unpack8(const u32x4 w, float* f) {
    f[0] = bflo(w.x); f[1] = bfhi(w.x); f[2] = bflo(w.y); f[3] = bfhi(w.y); f[4] = bflo(w.z); f[5] = bfhi(w.z); f[6] = bflo(w.w); f[7] = bfhi(w.w);
}

struct Args {
    const float* x; const float* c; const int* pos; const float* w_ada; const float* b_ada; const float* g_norm; const float* w_in;
    const float* b_ig; const float* b_fg; const float* w_conv; const float* b_conv; const float* w_q; const float* w_k; const float* g_head;
    const float* skip; const float* w_om; const float* w_oa; const float* w_o; const float* g_final;
    float* out; unsigned char* ws; int ph_lo, ph_hi;
};

__device__ __forceinline__ void transpose_item(const float* W, int K, int Nsrc, int nblk, int src_col_off, bf16* WT, int ldt, int row_off, float scale, float* scr, int item, int lane, bool frag = false) {
    const int kb = item / nblk, nb = item % nblk, k0 = 64 * kb, n0 = 32 * nb;
#pragma unroll 8
    for (int i = 0; i < 32; ++i) { const int kk = 2 * i + (lane >> 5); scr[kk * 33 + (lane & 31)] = W[(size_t)(k0 + kk) * Nsrc + src_col_off + n0 + (lane & 31)]; }
    __builtin_amdgcn_wave_barrier();
    asm volatile("s_waitcnt lgkmcnt(0)" ::: "memory");
    const int cc = lane & 7;
#pragma unroll
    for (int j = 0; j < 4; ++j) { const int n = (lane >> 3) + 8 * j; const float* s = scr + (8 * cc) * 33 + n;
        u32x4 o; o.x = pk2(s[0 * 33] * scale, s[1 * 33] * scale); o.y = pk2(s[2 * 33] * scale, s[3 * 33] * scale); o.z = pk2(s[4 * 33] * scale, s[5 * 33] * scale); o.w = pk2(s[6 * 33] * scale, s[7 * 33] * scale);
        if (frag) { const int nn = row_off + n0 + n, kc = (k0 >> 3) + cc; *(u32x4*)(WT + (size_t)((((nn >> 4) * (K >> 5) + (kc >> 2)) * 64 + (kc & 3) * 16 + (nn & 15)) * 8)) = o; }
        else *(u32x4*)(WT + (size_t)(row_off + n0 + n) * ldt + k0 + 8 * cc) = o; }
    asm volatile("s_waitcnt lgkmcnt(0)" ::: "memory");
    __builtin_amdgcn_wave_barrier();
}

__device__ __forceinline__ void phase_prologue(const Args& a, unsigned char* lds, int vcu, int G) {
    const int tid = opaque_tid(), lane = tid & 63, wave = tid >> 6;
    unsigned char* ws = a.ws;
    if (vcu < 192) {
        float* sc = (float*)lds;
        float* red = (float*)(lds + 65536);
        for (int i = tid; i < 16 * 1024; i += NTHR) sc[i] = siluf_(a.c[i]);
        __syncthreads();
        const int col = lane & 15, ksub = lane >> 4, n = vcu * 16 + col;
        float acc[16];
#pragma unroll
        for (int b = 0; b < 16; ++b) acc[b] = 0.f;
        const int k0 = wave * 128 + ksub * 32;
        const float* wp = a.w_ada + (size_t)k0 * 3072 + n;
#pragma unroll 1
        for (int kc = 0; kc < 8; ++kc) {
            const float w0 = wp[(size_t)(4 * kc) * 3072], w1 = wp[(size_t)(4 * kc + 1) * 3072], w2 = wp[(size_t)(4 * kc + 2) * 3072], w3 = wp[(size_t)(4 * kc + 3) * 3072];
#pragma unroll
            for (int b = 0; b < 16; ++b) { const f32x4 s4 = *(const f32x4*)(sc + b * 1024 + k0 + 4 * kc); acc[b] += (s4.x * w0 + s4.y * w1) + (s4.z * w2 + s4.w * w3); }
        }
#pragma unroll
        for (int b = 0; b < 16; ++b) { float v = acc[b]; v += __shfl_xor(v, 16); v += __shfl_xor(v, 32); if (ksub == 0) red[(wave * 16 + b) * 16 + col] = v; }
        __syncthreads();
        float* mod = (float*)(ws + WS_MOD);
        if (tid < 256) { const int b = tid >> 4, l = tid & 15, nn = vcu * 16 + l; float s_ = 0.f;
#pragma unroll
            for (int w = 0; w < 8; ++w) s_ += red[(w * 16 + b) * 16 + l];
            s_ += a.b_ada[nn];
            const int part = nn >> 10, cc = nn & 1023;
            if (part == 1) s_ = a.g_norm[cc] * (1.f + s_);
            mod[b * 3072 + nn] = s_; }
        __syncthreads();
    }
    {
        float* scr = (float*)lds + wave * (64 * 33);
        const int gw = vcu * NWAVES + wave, NGW = G * NWAVES;
        constexpr int I_IN = (1024 / 64) * (INW / 32);
        constexpr int I_QK = 8 * (256 / 64) * (256 / 32);
        constexpr int I_OM = 16 * 32, I_OA = 8 * 32, I_O = 16 * 32;
        constexpr int NITEMS = I_IN + I_QK + I_OM + I_OA + I_O;
        for (int it = gw; it < NITEMS; it += NGW) {
            int r = it;
            if (r < I_IN) { const int nb = r % (INW / 32); const int off = (nb * 32 >= 4096) ? 8 : 0;
                transpose_item(a.w_in, 1024, INW_SRC, INW / 32, off, (bf16*)(ws + WS_WIN), 1024, 0, 1.f, scr, r, lane); continue; } r -= I_IN;
            if (r < I_QK) { const int mtx = r >> 5, rr = r & 31, h = mtx >> 1, isk = mtx & 1;
                const float* W = (isk ? a.w_k : a.w_q) + (size_t)h * 65536;
                transpose_item(W, 256, 256, 8, 0, (bf16*)(ws + WS_WQK) + (size_t)h * 512 * 256, 256, isk * 256, isk ? 0.0625f : 1.f, scr, rr, lane, true); continue; } r -= I_QK;
            if (r < I_OM) { transpose_item(a.w_om, 1024, 1024, 32, 0, (bf16*)(ws + WS_WOM), 1536, 0, 1.f, scr, r, lane); continue; } r -= I_OM;
            if (r < I_OA) { transpose_item(a.w_oa, 512, 1024, 32, 0, (bf16*)(ws + WS_WOM) + 1024, 1536, 0, 1.f, scr, r, lane); continue; } r -= I_OA;
            transpose_item(a.w_o, 1024, 1024, 32, 0, (bf16*)(ws + WS_WO), 1024, 0, 1.f, scr, r, lane);
        }
        float* wg = (float*)(ws + WS_WG);
        for (int i = (vcu * NTHR + tid); i < 8 * 1024; i += G * NTHR) { const int j = i >> 10, k = i & 1023; wg[i] = a.w_in[(size_t)k * INW_SRC + 4096 + j]; }
    }
}

__constant__ double c_inv_freq[16] = {1.0, 0.44036660267178046, 0.19392274474868576, 0.08539710028576561, 0.03760603093086393, 0.016560440080994446, 0.007292664737217109, 0.003211445994752591,
    0.001414213562373095, 0.000622772421914596, 0.0002742481756762073, 0.00012076973741146504, 5.318295896944988e-05, 2.341999896140934e-05, 1.031338537721246e-05, 4.5416704806078695e-06};

__device__ __forceinline__ void phase_h(const Args& a, unsigned char* lds, int vcu, int G) {
    const int tid = opaque_tid(), lane = tid & 63, wave = tid >> 6;
    unsigned char* ws = a.ws;
    float* wg = (float*)lds;
    { const float* src = (const float*)(ws + WS_WG); for (int i = tid; i < 8192; i += NTHR) wg[i] = src[i]; }
    __syncthreads();
    const float* mod = (const float*)(ws + WS_MOD);
    bf16* H = (bf16*)(ws + WS_H);
    float* IG = (float*)(ws + WS_IG); float* FG = (float*)(ws + WS_FG); float* ROPE = (float*)(ws + WS_ROPE);
    const int gw = vcu * NWAVES + wave, NGW = G * NWAVES;
    for (int row0 = 2 * gw; row0 < MALL; row0 += 2 * NGW) {
        f32x4 v[2][4]; float ss[2] = {0.f, 0.f};
#pragma unroll
        for (int rr = 0; rr < 2; ++rr) { const f32x4* xr = (const f32x4*)(a.x + (size_t)(row0 + rr) * DM) + lane;
#pragma unroll
            for (int j = 0; j < 4; ++j) v[rr][j] = xr[64 * j]; }
        { const int rr = lane >> 5, fi = lane & 15; const int pos = a.pos[row0 + rr];
            const double rev = (double)pos * c_inv_freq[fi] * 0.15915494309189535; const float fr_ = (float)(rev - rint(rev));
            ROPE[(size_t)row0 * 32 + lane] = (lane & 16) ? __builtin_amdgcn_sinf(fr_) : __builtin_amdgcn_cosf(fr_); }
#pragma unroll
        for (int rr = 0; rr < 2; ++rr) {
#pragma unroll
            for (int j = 0; j < 4; ++j) ss[rr] += (v[rr][j].x * v[rr][j].x + v[rr][j].y * v[rr][j].y) + (v[rr][j].z * v[rr][j].z + v[rr][j].w * v[rr][j].w);
        }
#pragma unroll
        for (int o = 1; o < 64; o <<= 1) { ss[0] += __shfl_xor(ss[0], o); ss[1] += __shfl_xor(ss[1], o); }
        const int b = row0 >> 12;
        float pg[2][8];
#pragma unroll
        for (int rr = 0; rr < 2; ++rr)
#pragma unroll
            for (int g = 0; g < 8; ++g) pg[rr][g] = 0.f;
        const float rinv[2] = {1.f / sqrtf(ss[0] * (1.f / DM) + EPS), 1.f / sqrtf(ss[1] * (1.f / DM) + EPS)};
#pragma unroll
        for (int j = 0; j < 4; ++j) {
            const int col = 4 * lane + 256 * j;
            const f32x4 sh = *(const f32x4*)(mod + b * 3072 + col), gs = *(const f32x4*)(mod + b * 3072 + 1024 + col);
            f32x4 h[2];
#pragma unroll
            for (int rr = 0; rr < 2; ++rr) { h[rr] = v[rr][j] * rinv[rr] * gs + sh;
                u32x2 o; o.x = pk2(h[rr].x, h[rr].y); o.y = pk2(h[rr].z, h[rr].w); *((u32x2*)(H + (size_t)(row0 + rr) * DM) + lane + 64 * j) = o; }
#pragma unroll
            for (int g = 0; g < 8; ++g) { const f32x4 w = *(const f32x4*)(wg + g * 1024 + col);
                pg[0][g] += (h[0].x * w.x + h[0].y * w.y) + (h[0].z * w.z + h[0].w * w.w); pg[1][g] += (h[1].x * w.x + h[1].y * w.y) + (h[1].z * w.z + h[1].w * w.w); }
            __builtin_amdgcn_sched_barrier(0);
        }
#pragma unroll
        for (int o = 1; o < 64; o <<= 1)
#pragma unroll
            for (int g = 0; g < 8; ++g) { pg[0][g] += __shfl_xor(pg[0][g], o); pg[1][g] += __shfl_xor(pg[1][g], o); }
        if (lane < 2) { const int rr = lane; const float* p = rr ? pg[1] : pg[0];
            f32x4 ig = {p[0] + a.b_ig[0], p[1] + a.b_ig[1], p[2] + a.b_ig[2], p[3] + a.b_ig[3]};
            f32x4 fg = {p[4] + a.b_fg[0], p[5] + a.b_fg[1], p[6] + a.b_fg[2], p[7] + a.b_fg[3]};
            *(f32x4*)(IG + (size_t)(row0 + rr) * 4) = ig; *(f32x4*)(FG + (size_t)(row0 + rr) * 4) = fg; }
    }
}

struct EpiProj {
    static constexpr bool PERM = true; static constexpr int HOOK_T = -1;
    bf16* P; const float* rope;
    __device__ __forceinline__ void operator()(const f32x4 (&acc)[2][2][4][2], const pg8::Unit& u, int wr, int wc, int fr, int fq) const {
        const int row0 = u.pm * 256 + wr * 64 + fr, col0 = u.pn * 256 + wc * 64 + 8 * fq;
        const bool rot = (u.pn >= 16) && (u.pn < 28) && ((wc & 1) == 0);
#pragma unroll
        for (int ai = 0; ai < 2; ++ai)
#pragma unroll
            for (int m = 0; m < 4; ++m) { const int r = row0 + ai * 128 + m * 16; bf16* rowp = P + (size_t)r * INW + col0;
#pragma unroll
                for (int bj = 0; bj < 2; ++bj) { f32x4 v0 = acc[ai][bj][m][0], v1 = acc[ai][bj][m][1];
                    if (bj == 0 && rot) {
                        const float* tp = rope + (size_t)r * 32 + 8 * (fq & 1);
                        const f32x4 c0 = *(const f32x4*)tp, c1 = *(const f32x4*)(tp + 4), s0 = *(const f32x4*)(tp + 16), s1 = *(const f32x4*)(tp + 20);
                        f32x4 p0, p1;
#pragma unroll
                        for (int e = 0; e < 4; ++e) { p0[e] = __shfl_xor(v0[e], 32); p1[e] = __shfl_xor(v1[e], 32); }
                        const float sg = (fq < 2) ? -1.f : 1.f;
                        v0 = v0 * c0 + p0 * s0 * sg; v1 = v1 * c1 + p1 * s1 * sg;
                    }
                    u32x4 w; w.x = pg8::cvt_pk_bf16(v0[0], v0[1]); w.y = pg8::cvt_pk_bf16(v0[2], v0[3]); w.z = pg8::cvt_pk_bf16(v1[0], v1[1]); w.w = pg8::cvt_pk_bf16(v1[2], v1[3]);
                    *(u32x4*)(rowp + bj * 32) = w; } }
    }
};
struct EpiQK {
    static constexpr bool PERM = true; static constexpr int HOOK_T = -1;
    bf16* QM; bf16* KM;
    __device__ __forceinline__ void operator()(const f32x4 (&acc)[2][2][4][2], const pg8::Unit& u, int wr, int wc, int fr, int fq) const {
        const int row0 = u.pm * 256 + wr * 64 + fr, col0 = u.g * 256 + wc * 64 + 8 * fq;
        bf16* base = u.pn ? KM : QM;
#pragma unroll
        for (int ai = 0; ai < 2; ++ai)
#pragma unroll
            for (int m = 0; m < 4; ++m) { bf16* rowp = base + (size_t)(row0 + ai * 128 + m * 16) * 1024 + col0;
#pragma unroll
                for (int bj = 0; bj < 2; ++bj) { const f32x4 v0 = acc[ai][bj][m][0], v1 = acc[ai][bj][m][1];
                    u32x4 w; w.x = pg8::cvt_pk_bf16(v0[0], v0[1]); w.y = pg8::cvt_pk_bf16(v0[2], v0[3]); w.z = pg8::cvt_pk_bf16(v1[0], v1[1]); w.w = pg8::cvt_pk_bf16(v1[2], v1[3]);
                    *(u32x4*)(rowp + bj * 32) = w; } }
    }
};
struct EpiMerge {
    static constexpr bool PERM = true; static constexpr int HOOK_T = 16;
    const bf16* P; bf16* MG;
    __device__ __forceinline__ void hook(f32x4 (&acc)[2][2][4][2], const pg8::Unit& u, int wr, int wc, int fr, int fq) const {
        int row0 = u.pm * 256 + wr * 64 + fr, col0 = u.pn * 256 + wc * 64 + 8 * fq;
        asm volatile("" : "+v"(row0), "+v"(col0));
#pragma unroll
        for (int ai = 0; ai < 2; ++ai)
#pragma unroll
            for (int m = 0; m < 4; ++m) { const size_t r = (size_t)(row0 + ai * 128 + m * 16);
#pragma unroll
                for (int bj = 0; bj < 2; ++bj) { const int c = col0 + bj * 32;
                    const u32x4 gaw = *(const u32x4*)(P + r * INW + C_GA + c), gbw = *(const u32x4*)(P + r * INW + C_GB + c);
                    float ga[8], gb[8]; unpack8(gaw, ga); unpack8(gbw, gb);
#pragma unroll
                    for (int e = 0; e < 4; ++e) {
                        acc[ai][bj][m][0][e] *= (1.f + __expf(-gb[e])) / (1.f + __expf(-ga[e]));
                        acc[ai][bj][m][1][e] *= (1.f + __expf(-gb[4 + e])) / (1.f + __expf(-ga[4 + e])); } }
                __builtin_amdgcn_sched_barrier(0); }
    }
    __device__ __forceinline__ void operator()(const f32x4 (&acc)[2][2][4][2], const pg8::Unit& u, int wr, int wc, int fr, int fq) const {
        const int row0 = u.pm * 256 + wr * 64 + fr, col0 = u.pn * 256 + wc * 64 + 8 * fq;
#pragma unroll
        for (int ai = 0; ai < 2; ++ai)
#pragma unroll
            for (int m = 0; m < 4; ++m) { const size_t r = (size_t)(row0 + ai * 128 + m * 16);
#pragma unroll
                for (int bj = 0; bj < 2; ++bj) { const int c = col0 + bj * 32;
                    const u32x4 gbw = *(const u32x4*)(P + r * INW + C_GB + c); float gb[8]; unpack8(gbw, gb);
                    const f32x4 v0 = acc[ai][bj][m][0], v1 = acc[ai][bj][m][1];
                    float o[8];
#pragma unroll
                    for (int e = 0; e < 4; ++e) { o[e] = sigmoidf_(gb[e]) * v0[e]; o[4 + e] = sigmoidf_(gb[4 + e]) * v1[e]; }
                    u32x4 w; w.x = pg8::cvt_pk_bf16(o[0], o[1]); w.y = pg8::cvt_pk_bf16(o[2], o[3]); w.z = pg8::cvt_pk_bf16(o[4], o[5]); w.w = pg8::cvt_pk_bf16(o[6], o[7]);
                    *(u32x4*)(MG + r * 1024 + c) = w; } }
    }
};
struct EpiOut {
    static constexpr bool PERM = true; static constexpr int HOOK_T = -1;
    bf16* dl; const float* gate; int grow0;
    __device__ __forceinline__ void operator()(const f32x4 (&acc)[2][2][4][2], const pg8::Unit& u, int wr, int wc, int fr, int fq) const {
        const int row0 = grow0 + u.pm * 256 + wr * 64 + fr, col0 = u.pn * 256 + wc * 64 + 8 * fq;
        const int b = row0 >> 12;
#pragma unroll
        for (int ai = 0; ai < 2; ++ai)
#pragma unroll
            for (int m = 0; m < 4; ++m) { const int r = row0 + ai * 128 + m * 16;
#pragma unroll
                for (int bj = 0; bj < 2; ++bj) { const int c = col0 + bj * 32;
                    const float* gp = gate + b * 3072 + c; const f32x4 g0 = *(const f32x4*)gp, g1 = *(const f32x4*)(gp + 4);
                    const f32x4 o0 = g0 * acc[ai][bj][m][0], o1 = g1 * acc[ai][bj][m][1];
                    u32x4 w; w.x = pg8::cvt_pk_bf16(o0[0], o0[1]); w.y = pg8::cvt_pk_bf16(o0[2], o0[3]); w.z = pg8::cvt_pk_bf16(o1[0], o1[1]); w.w = pg8::cvt_pk_bf16(o1[2], o1[3]);
                    *(u32x4*)(dl + (size_t)r * 1024 + c) = w; } }
    }
};

struct ComboOrder {
    int nO, G, c;
    static constexpr int nV = (1024 / 256) * (MS / 256);
    __device__ void init(int G_, int c_, bool with_out2) { G = G_; c = c_; nO = with_out2 ? (MS / 256) * 4 : 0; }
    __device__ bool next(int i, pg8::Unit& u) const {
        const int L = i * G + c;
        pg8::StaticOrder o;
        if (L < nO) { o.init(MS, 1024, 1, 0); o.next(L, u); u.g = 0; return true; }
        if (L < nO + nV) { o.init(1024, MS, 1, 0); o.next(L - nO, u); u.g = 2; return true; }
        o.init(MS, INW - 1024, 1, 0);
        if (!o.next(L - nO - nV, u)) return false;
        if (u.pn >= 4) u.pn += 4;
        u.g = 1; return true;
    }
    __device__ __forceinline__ void a_ready(const pg8::Unit&) const {}
    __device__ __forceinline__ void done(const pg8::Unit&) const {}
};
struct GemmCombo {
    const char* ws; size_t hoff;
    static constexpr int lda = 1024, ldb = 1024, K = 1024;
    __device__ __forceinline__ const char* abase(const pg8::Unit& u) const {
        size_t off = WS_MG; if (u.g == 1) off = hoff; if (u.g == 2) off = WS_WIN + (size_t)C_VA * 2048;
        return ws + off + (size_t)u.pm * (size_t)(pg8::BM * 2 * 1024); }
    __device__ __forceinline__ const char* bbase(const pg8::Unit& u) const {
        size_t off = WS_WO; if (u.g == 1) off = WS_WIN; if (u.g == 2) off = hoff;
        return ws + off + (size_t)u.pn * (size_t)(pg8::BM * 2 * 1024); }
};
struct EpiVT {
    static constexpr bool PERM = true; static constexpr int HOOK_T = -1;
    bf16* VTG;
    __device__ __forceinline__ void operator()(const f32x4 (&acc)[2][2][4][2], const pg8::Unit& u, int wr, int wc, int fr, int fq) const {
        const int row0 = u.pm * 256 + wr * 64 + fr, col0 = u.pn * 256 + wc * 64 + 8 * fq;
#pragma unroll
        for (int ai = 0; ai < 2; ++ai)
#pragma unroll
            for (int m = 0; m < 4; ++m) { const int r = row0 + ai * 128 + m * 16, h = r >> 8, e = r & 255;
#pragma unroll
                for (int bj = 0; bj < 2; ++bj) { const int c = col0 + bj * 32, chunk = c >> 6, l = c & 63;
                    const f32x4 v0 = acc[ai][bj][m][0], v1 = acc[ai][bj][m][1];
                    u32x4 w; w.x = pg8::cvt_pk_bf16(v0[0], v0[1]); w.y = pg8::cvt_pk_bf16(v0[2], v0[3]); w.z = pg8::cvt_pk_bf16(v1[0], v1[1]); w.w = pg8::cvt_pk_bf16(v1[2], v1[3]);
                    *(u32x4*)(VTG + (size_t)(chunk * 4 + h) * 16384 + (((e >> 4) * 2 + (l >> 5)) * 64 + ((l >> 3) & 3) * 16 + (e & 15)) * 8) = w; } }
    }
};
struct EpiCombo {
    static constexpr bool PERM = true; static constexpr int HOOK_T = -1;
    EpiOut eo; EpiProj ep; EpiVT ev;
    __device__ __forceinline__ void operator()(const f32x4 (&acc)[2][2][4][2], const pg8::Unit& u, int wr, int wc, int fr, int fq) const {
        if (u.g == 1) ep(acc, u, wr, wc, fr, fq); else if (u.g == 2) ev(acc, u, wr, wc, fr, fq); else eo(acc, u, wr, wc, fr, fq);
    }
};

__device__ __forceinline__ void phase_gates(const Args& a, unsigned char* lds, int vcu, int G) {
    const int tid = opaque_tid(), lane = tid & 63, wave = tid >> 6;
    unsigned char* ws = a.ws;
    for (int gi = vcu; gi < NBATCH * 4; gi += G) {
        const int pass = gi >> 4, bl = (gi >> 2) & 3, h = gi & 3;
        const float* IG = (const float*)(ws + WS_IG); const float* FG = (const float*)(ws + WS_FG);
        float* gsc = (float*)(ws + WS_GSC + (size_t)pass * GSC_STRIDE);
        float* A1 = gsc, *B1 = gsc + MS * 4, *WI = gsc + 2 * MS * 4, *EF = gsc + 3 * MS * 4, *WK = gsc + 4 * MS * 4, *DEC = gsc + 5 * MS * 4;
        float* cg = (float*)lds; float* cp = cg + 64;
        __syncthreads();
        float f[8], ii[8];
#pragma unroll
        for (int q = 0; q < 8; ++q) { const size_t grow = (size_t)pass * MS + bl * SEQ + (wave * 8 + q) * 64 + lane; f[q] = FG[grow * 4 + h]; ii[q] = IG[grow * 4 + h]; }
        float acs[8], b1[8], pm[8];
#pragma unroll
        for (int q = 0; q < 8; ++q) {
            float x = fminf(f[q], 0.f) - log1pf(expf(-fabsf(f[q])));
#pragma unroll
            for (int o = 1; o < 64; o <<= 1) { const float t = __shfl_up(x, o); if (lane >= o) x += t; }
            acs[q] = x; b1[q] = ii[q] - x;
            float m = b1[q];
#pragma unroll
            for (int o = 1; o < 64; o <<= 1) { const float t = __shfl_up(m, o); if (lane >= o) m = fmaxf(m, t); }
            pm[q] = m;
            if (lane == 63) { cg[wave * 8 + q] = x; cp[wave * 8 + q] = m; }
        }
        __syncthreads();
        float m_prev = 0.f, mp[8], Ms8[8];
        for (int j = 0; j < 64; ++j) { const float Ms = fmaxf(m_prev, cp[j]);
#pragma unroll
            for (int q = 0; q < 8; ++q) if (j == wave * 8 + q) { mp[q] = m_prev; Ms8[q] = Ms; }
            m_prev = cg[j] + Ms; }
#pragma unroll
        for (int q = 0; q < 8; ++q) {
            const int j = wave * 8 + q, lrow = bl * SEQ + j * 64 + lane;
            const float mx = fmaxf(mp[q], pm[q]);
            A1[h * MS + lrow] = -mx; B1[h * MS + lrow] = b1[q]; WI[h * MS + lrow] = expf(mp[q] - mx); EF[h * MS + lrow] = expf(-(acs[q] + mx)); WK[h * MS + lrow] = expf(b1[q] - Ms8[q]);
            if (lane == 0) { DEC[h * (MS / 64) + bl * 64 + j] = expf(mp[q] - Ms8[q]); DEC[4 * (MS / 64) + h * (MS / 64) + bl * 64 + j] = Ms8[q]; }
        }
    }
}

__device__ __forceinline__ f32x4 mfma16(bf16x8 a, bf16x8 b, f32x4 c) { return __builtin_amdgcn_mfma_f32_16x16x32_bf16(a, b, c, 0, 0, 0); }

constexpr int TPS = 72;
constexpr int XCS = 264;
constexpr int L_QC_X = 0, L_QC_Q = 36864, L_QC_KT = L_QC_Q + 64 * XCS * 2, L_QC_ST = L_QC_KT + 256 * TPS * 2, L_QC_END = L_QC_ST + 64 * TPS * 2;
static_assert(64 * XCS * 2 <= 36864 && 256 * TPS * 2 <= 36864 && L_QC_END <= 131072, "qkc lds");
__device__ __forceinline__ void phase_cprep(const Args& a, unsigned char* lds, int vcu, int G, int pass) {
    const int tid = opaque_tid(), lane = tid & 63, wave = __builtin_amdgcn_readfirstlane(tid >> 6);
    const int fr = lane & 15, fq = lane >> 4;
    unsigned char* ws = a.ws;
    const bf16* P = (const bf16*)(ws + WS_P); bf16* XCW = (bf16*)(ws + WS_XC); bf16* QM = (bf16*)(ws + WS_QM);
    const bf16* WF = (const bf16*)(ws + WS_WQK);
    const float* gsc = (const float*)(ws + WS_GSC + (size_t)pass * GSC_STRIDE);
    const float* gA1 = gsc, *gWK = gsc + 4 * MS * 4, *gMS = gsc + 5 * MS * 4 + 4 * (MS / 64);
    bf16* SG = (bf16*)(ws + WS_SG); bf16* KTG = (bf16*)(ws + WS_KTG); bf16* VTG = (bf16*)(ws + WS_VTG);
    bf16* XS = (bf16*)(lds + L_QC_X); bf16* VT = (bf16*)(lds + L_QC_X); bf16* QL = (bf16*)(lds + L_QC_Q); bf16* KT = (bf16*)(lds + L_QC_KT); bf16* ST = (bf16*)(lds + L_QC_ST);
    const int ti = wave >> 1, tj0 = 2 * (wave & 1);
    for (int ci = vcu; ci < (MS / 64) * 4; ci += G) {
        const int h = ci & 3, t0 = (ci >> 2) * 64;
        u32x4 xw[4];
        {
            const int cc = tid & 31, ch0 = h * 256 + 8 * cc;
            float wc[4][8], bc[8];
#pragma unroll
            for (int j = 0; j < 4; ++j) { const f32x4 w0 = *(const f32x4*)(a.w_conv + j * 1024 + ch0), w1 = *(const f32x4*)(a.w_conv + j * 1024 + ch0 + 4);
                wc[j][0] = w0[0]; wc[j][1] = w0[1]; wc[j][2] = w0[2]; wc[j][3] = w0[3]; wc[j][4] = w1[0]; wc[j][5] = w1[1]; wc[j][6] = w1[2]; wc[j][7] = w1[3]; }
            { const f32x4 b0 = *(const f32x4*)(a.b_conv + ch0), b1 = *(const f32x4*)(a.b_conv + ch0 + 4);
              bc[0] = b0[0]; bc[1] = b0[1]; bc[2] = b0[2]; bc[3] = b0[3]; bc[4] = b1[0]; bc[5] = b1[1]; bc[6] = b1[2]; bc[7] = b1[3]; }
            u32x4 xr[4][4];
#pragma unroll
            for (int i = 0; i < 4; ++i) { const int row = (tid >> 5) + 16 * i, tpos = (t0 + row) & (SEQ - 1);
#pragma unroll
                for (int j = 0; j < 4; ++j) xr[i][j] = (tpos - 3 + j >= 0) ? *(const u32x4*)(P + (size_t)(t0 + row - 3 + j) * INW + C_XA + ch0) : (u32x4){0u, 0u, 0u, 0u}; }
#pragma unroll
            for (int i = 0; i < 4; ++i) { float y[8];
#pragma unroll
                for (int e = 0; e < 8; ++e) y[e] = bc[e];
#pragma unroll
                for (int j = 0; j < 4; ++j) { float xv[8]; unpack8(xr[i][j], xv);
#pragma unroll
                    for (int e = 0; e < 8; ++e) y[e] += wc[j][e] * xv[e]; }
                u32x4 o; o.x = pk2(siluf_(y[0]), siluf_(y[1])); o.y = pk2(siluf_(y[2]), siluf_(y[3])); o.z = pk2(siluf_(y[4]), siluf_(y[5])); o.w = pk2(siluf_(y[6]), siluf_(y[7]));
                xw[i] = o;
                *(u32x4*)(XCW + (size_t)(t0 + (tid >> 5) + 16 * i) * 1024 + ch0) = o; }
        }
        float wkr[4][4], a1l[4];
        if (wave >= 4) {
#pragma unroll
            for (int lt = 0; lt < 4; ++lt)
#pragma unroll
                for (int i = 0; i < 4; ++i) wkr[lt][i] = gWK[h * MS + t0 + 16 * lt + 4 * fq + i];
        }
#pragma unroll
        for (int i = 0; i < 4; ++i) a1l[i] = gA1[h * MS + t0 + 16 * ti + 4 * fq + i];
        const float msc = gMS[h * (MS / 64) + (ci >> 2)];
        __syncthreads();
#pragma unroll
        for (int i = 0; i < 4; ++i) { const int c = tid + NTHR * i, row = c >> 5, cc = c & 31; *(u32x4*)(XS + row * XCS + 8 * cc) = xw[i]; }
        __syncthreads();
        const bf16* wf = WF + (size_t)h * 512 * 256;
#pragma unroll 1
        for (int ct = 0; ct < 4; ++ct) {
            const int nt = 4 * wave + ct;
            bf16x8 bq[8];
#pragma unroll
            for (int ks = 0; ks < 8; ++ks) bq[ks] = *(const bf16x8*)(wf + (size_t)((nt * 8 + ks) * 64 + lane) * 8);
#pragma unroll
            for (int lt = 0; lt < 4; ++lt) {
                f32x4 acc = {0.f, 0.f, 0.f, 0.f};
#pragma unroll
                for (int ks = 0; ks < 8; ++ks) { const bf16x8 af = *(const bf16x8*)(XS + (16 * lt + fr) * XCS + 32 * ks + 8 * fq); acc = mfma16(af, bq[ks], acc); }
                if (wave < 4) {
#pragma unroll
                    for (int i = 0; i < 4; ++i) QL[(16 * lt + 4 * fq + i) * XCS + 64 * wave + 16 * ct + fr] = (bf16)f2bf(acc[i]);
                } else {
                    const int d = 64 * (wave - 4) + 16 * ct + fr;
                    u32x2 o; o.x = pk2(acc[0] * wkr[lt][0], acc[1] * wkr[lt][1]); o.y = pk2(acc[2] * wkr[lt][2], acc[3] * wkr[lt][3]);
                    *(u32x2*)(KT + d * TPS + 16 * lt + 4 * fq) = o;
                }
            }
        }
        __syncthreads();
#pragma unroll
        for (int i = 0; i < 4; ++i) { const int c = tid + NTHR * i, row = c >> 5, cc = c & 31;
            *(u32x4*)(QM + (size_t)(t0 + row) * 1024 + h * 256 + 8 * cc) = *(const u32x4*)(QL + row * XCS + 8 * cc); }
#pragma unroll
        for (int tt = 0; tt < 2; ++tt) {
            const int tj = tj0 + tt;
            f32x4 sacc = {0.f, 0.f, 0.f, 0.f};
            if (tj <= ti) {
#pragma unroll
                for (int ks = 0; ks < 8; ++ks) {
                    const bf16x8 qf = *(const bf16x8*)(QL + (16 * ti + fr) * XCS + 32 * ks + 8 * fq);
                    const bf16* kp = KT + (32 * ks + 8 * fq + (fr >> 2)) * TPS + 16 * tj + 4 * (fr & 3);
                    const s16x4 k0 = __builtin_amdgcn_ds_read_tr16_b64_v4i16((__attribute__((address_space(3))) s16x4*)(kp));
                    const s16x4 k1 = __builtin_amdgcn_ds_read_tr16_b64_v4i16((__attribute__((address_space(3))) s16x4*)(kp + 4 * TPS));
                    bf16x8 kb; kb[0] = k0[0]; kb[1] = k0[1]; kb[2] = k0[2]; kb[3] = k0[3]; kb[4] = k1[0]; kb[5] = k1[1]; kb[6] = k1[2]; kb[7] = k1[3];
                    sacc = mfma16(qf, kb, sacc); }
            }
            const int sidx = 16 * tj + fr;
#pragma unroll
            for (int i = 0; i < 4; ++i) { const int l = 16 * ti + 4 * fq + i;
                float v = 0.f;
                if (sidx <= l) v = sacc[i] * __expf(a1l[i] + msc);
                ST[l * TPS + sidx] = (bf16)f2bf(v); }
        }
        __syncthreads();
        { const int row = tid >> 3, ch = tid & 7; *(u32x4*)(SG + (size_t)ci * 4096 + row * 64 + 8 * ch) = *(const u32x4*)(ST + row * TPS + 8 * ch); }
#pragma unroll
        for (int i = 0; i < 4; ++i) { const int p = tid + NTHR * i, blk = p >> 6, ln = p & 63, row = (blk >> 1) * 16 + (ln & 15), ch = (blk & 1) * 4 + (ln >> 4);
            *(u32x4*)(KTG + (size_t)ci * 16384 + p * 8) = *(const u32x4*)(KT + row * TPS + 8 * ch); }
    }
}

constexpr int SA_DEPTH = 5, SA_PATCH = 32 * 32 * 2 + 128;
struct ScanA { const bf16* KTG; const bf16* VTG; const float* gDEC; bf16* CS; float* NS; int bl, h, dblk, eblk, wave, fr, fq; unsigned koff, voff; bool do_den; };
struct ScanAOps { bf16x8 k[2][2], v[2][2]; float decay; };
__device__ __forceinline__ void scana_load(const ScanA& c, int j, ScanAOps& o) {
    const int ci = (c.bl * 64 + j) * 4 + c.h;
    const bf16* kb = c.KTG + (size_t)ci * 16384; const bf16* vb = c.VTG + (size_t)ci * 16384;
#pragma unroll
    for (int dt = 0; dt < 2; ++dt)
#pragma unroll
        for (int k2 = 0; k2 < 2; ++k2) o.k[dt][k2] = *(const bf16x8*)(kb + (c.koff + (unsigned)((dt * 2 + k2) * 512)));
#pragma unroll
    for (int et = 0; et < 2; ++et)
#pragma unroll
        for (int k2 = 0; k2 < 2; ++k2) o.v[et][k2] = *(const bf16x8*)(vb + (c.voff + (unsigned)((et * 2 + k2) * 512)));
    o.decay = c.gDEC[c.h * (MS / 64) + c.bl * 64 + j];
}
__device__ __forceinline__ void scana_step(const ScanA& c, unsigned char* lds, int j, f32x4 (&Cacc)[2][2], f32x4 (&Nacc)[2], const ScanAOps& o, const bf16x8 ones) {
    const int ci = (c.bl * 64 + j) * 4 + c.h;
    unsigned char* patch = lds + c.wave * SA_PATCH;
    const int lane = c.fq * 16 + c.fr;
    if ((j & 1) == 0) {
#pragma unroll
    for (int dt = 0; dt < 2; ++dt) {
#pragma unroll
        for (int et = 0; et < 2; ++et) { const f32x4 cc = Cacc[dt][et]; u32x2 w; w.x = pk2(cc[0], cc[1]); w.y = pk2(cc[2], cc[3]);
            *(u32x2*)(patch + (16 * et + c.fr) * 64 + (16 * dt + 4 * c.fq) * 2) = w; }
        if (c.do_den && c.fr == 0) *(f32x4*)(patch + 2048 + (16 * dt + 4 * c.fq) * 4) = Nacc[dt];
    }
    { bf16* cs = c.CS + (size_t)ci * 65536 + (c.eblk * 8 + c.dblk) * 1024;
#pragma unroll
      for (int k = 0; k < 2; ++k) __builtin_nontemporal_store(*(const u32x4*)(patch + k * 1024 + lane * 16), (u32x4*)(cs + k * 512 + lane * 8));
      if (c.do_den && lane < 8) *(f32x4*)(c.NS + (size_t)ci * 256 + c.dblk * 32 + lane * 4) = *(const f32x4*)(patch + 2048 + lane * 16); }
    }
#pragma unroll
    for (int dt = 0; dt < 2; ++dt) {
#pragma unroll
        for (int et = 0; et < 2; ++et) {
            f32x4 cc = Cacc[dt][et] * o.decay;
#pragma unroll
            for (int k2 = 0; k2 < 2; ++k2) cc = mfma16(o.k[dt][k2], o.v[et][k2], cc);
            Cacc[dt][et] = cc;
        }
        if (c.do_den) {
            f32x4 cc = Nacc[dt] * o.decay;
#pragma unroll
            for (int k2 = 0; k2 < 2; ++k2) cc = mfma16(o.k[dt][k2], ones, cc);
            Nacc[dt] = cc;
        }
    }
}
__device__ __forceinline__ void scana_item(const Args& a, unsigned char* lds, int item, int pass) {
    const int tid = opaque_tid(), lane = tid & 63;
    unsigned char* ws = a.ws;
    ScanA c;
    c.wave = __builtin_amdgcn_readfirstlane(tid >> 6); c.fr = lane & 15; c.fq = lane >> 4;
    item = __builtin_amdgcn_readfirstlane(item);
    c.bl = item >> 5; c.h = (item >> 3) & 3; c.dblk = 2 * ((item >> 1) & 3) + (c.wave >> 2); c.eblk = 4 * (item & 1) + (c.wave & 3); c.do_den = (c.eblk == 0);
    c.koff = (unsigned)((4 * c.dblk) * 512 + lane * 8); c.voff = (unsigned)((4 * c.eblk) * 512 + lane * 8);
    c.KTG = (const bf16*)(ws + WS_KTG); c.VTG = (const bf16*)(ws + WS_VTG); c.gDEC = (const float*)(ws + WS_GSC + (size_t)pass * GSC_STRIDE) + 5 * MS * 4;
    c.CS = (bf16*)(ws + WS_CS); c.NS = (float*)(ws + WS_NS);
    f32x4 Cacc[2][2], Nacc[2];
#pragma unroll
    for (int x = 0; x < 2; ++x) { Nacc[x] = (f32x4){0.f, 0.f, 0.f, 0.f};
#pragma unroll
        for (int y = 0; y < 2; ++y) Cacc[x][y] = (f32x4){0.f, 0.f, 0.f, 0.f}; }
    bf16x8 ones;
    { const short ov = (c.fr == 0) ? (short)0x3F80 : (short)0;
#pragma unroll
      for (int e = 0; e < 8; ++e) ones[e] = ov; }
    ScanAOps o0, o1, o2, o3, o4;
    scana_load(c, 0, o0); scana_load(c, 1, o1); scana_load(c, 2, o2); scana_load(c, 3, o3); scana_load(c, 4, o4);
#define SA_STEP(jj, ob) do { scana_step(c, lds, (jj), Cacc, Nacc, ob, ones); __builtin_amdgcn_sched_barrier(0); scana_load(c, (jj) + SA_DEPTH < 64 ? (jj) + SA_DEPTH : 63, ob); __builtin_amdgcn_sched_barrier(0); } while (0)
#pragma nounroll
    for (int j = 0; j < 60; j += 5) { SA_STEP(j, o0); SA_STEP(j + 1, o1); SA_STEP(j + 2, o2); SA_STEP(j + 3, o3); SA_STEP(j + 4, o4); }
    SA_STEP(60, o0); SA_STEP(61, o1); SA_STEP(62, o2); SA_STEP(63, o3);
#undef SA_STEP
    asm volatile("s_waitcnt vmcnt(0)" ::: "memory");
}

constexpr int AKS = 136;
constexpr int L_AK = 0, L_AV = L_AK + 128 * AKS * 2, L_AP = L_AV + 128 * AKS * 2, L_ATT_END = L_AP + 8 * 16 * AKS * 2;
static_assert(L_ATT_END <= 131072, "attn lds");

__device__ __forceinline__ void attn_item(const Args& a, unsigned char* lds, int item) {
    const int tid = opaque_tid(), lane = tid & 63, wave = __builtin_amdgcn_readfirstlane(tid >> 6);
    const int fr = lane & 15, fq = lane >> 4;
    unsigned char* ws = a.ws;
    const int blk = item & 31, hh = (item >> 5) & 3, bl = (item >> 7) & 3, g = item >> 9;
    const int dil = g == 0 ? 1 : g == 1 ? 4 : 16, nb = 32 / dil;
    const int r = blk / nb, n = blk % nb;
    const bf16* P = (const bf16*)(ws + WS_P);
    const int H = 4 * g + hh;
    const bf16* Qb = P + C_QA + H * 128; const bf16* Kb = P + C_KA + H * 128; const bf16* Vb = P + C_VT + H * 128;
    bf16* Ks = (bf16*)(lds + L_AK); bf16* VTs = (bf16*)(lds + L_AV); bf16* Pw = (bf16*)(lds + L_AP) + wave * 16 * AKS;
    const int rowbase = bl * SEQ + r;
    bf16x8 qf[4];
    { const size_t qrow = (size_t)(rowbase + (128 * n + 16 * wave + fr) * dil);
#pragma unroll
      for (int ks = 0; ks < 4; ++ks) qf[ks] = *(const bf16x8*)(Qb + qrow * INW + 32 * ks + 8 * fq); }
    f32x4 O[8];
#pragma unroll
    for (int i = 0; i < 8; ++i) O[i] = (f32x4){0.f, 0.f, 0.f, 0.f};
    float mrow = -INFINITY, lrow = 0.f;
    const float scale = 0.08838834764831845f;
#define ATT_BAR() do { asm volatile("s_waitcnt lgkmcnt(0)" ::: "memory"); __builtin_amdgcn_s_barrier(); asm volatile("" ::: "memory"); } while (0)
    const int half0 = (n == 0 ? 1 : 0);
    u32x4 kreg[4], vreg[4];
#pragma unroll
    for (int i = 0; i < 4; ++i) { const int c = tid + NTHR * i, key = c >> 4, dc = c & 15;
        const size_t krow = (size_t)(rowbase + (128 * (n - 1 + half0) + key) * dil);
        kreg[i] = *(const u32x4*)(Kb + krow * INW + 8 * dc); vreg[i] = *(const u32x4*)(Vb + krow * INW + 8 * dc); }
    for (int half = half0; half < 2; ++half) {
        ATT_BAR();
#pragma unroll
        for (int i = 0; i < 4; ++i) { const int c = tid + NTHR * i, key = c >> 4, dc = c & 15;
            *(u32x4*)(Ks + key * AKS + 8 * dc) = kreg[i]; *(u32x4*)(VTs + key * AKS + 8 * dc) = vreg[i]; }
        if (half == 0) {
#pragma unroll
            for (int i = 0; i < 4; ++i) { const int c = tid + NTHR * i, key = c >> 4, dc = c & 15;
                const size_t krow = (size_t)(rowbase + (128 * n + key) * dil);
                kreg[i] = *(const u32x4*)(Kb + krow * INW + 8 * dc); vreg[i] = *(const u32x4*)(Vb + krow * INW + 8 * dc); }
        }
        ATT_BAR();
        f32x4 S[8];
        const int p = 16 * wave + fr;
        float mx = -INFINITY;
#pragma unroll
        for (int kt = 0; kt < 8; ++kt) {
            const bool act = half == 0 ? (kt >= wave) : (kt <= wave);
            f32x4 sacc = {0.f, 0.f, 0.f, 0.f};
            if (act) {
#pragma unroll
                for (int ks = 0; ks < 4; ++ks) { const bf16x8 kf = *(const bf16x8*)(Ks + (16 * kt + fr) * AKS + 32 * ks + 8 * fq); sacc = mfma16(kf, qf[ks], sacc); }
#pragma unroll
                for (int i = 0; i < 4; ++i) { const int kk = 16 * kt + 4 * fq + i; const bool ok = half == 0 ? (kk >= p) : (kk <= p);
                    const float v = ok ? sacc[i] * scale : -INFINITY; sacc[i] = v; mx = fmaxf(mx, v); }
            }
            S[kt] = sacc;
        }
        mx = fmaxf(mx, __shfl_xor(mx, 16)); mx = fmaxf(mx, __shfl_xor(mx, 32));
        const float mn = fmaxf(mrow, mx), alpha = __expf(mrow - mn); mrow = mn;
        float rs = 0.f;
        unsigned pk[8][2];
#pragma unroll
        for (int kt = 0; kt < 8; ++kt) {
            const bool act = half == 0 ? (kt >= wave) : (kt <= wave);
            if (act) { const float p0 = __expf(S[kt][0] - mn), p1 = __expf(S[kt][1] - mn), p2 = __expf(S[kt][2] - mn), p3 = __expf(S[kt][3] - mn);
                rs += (p0 + p1) + (p2 + p3); pk[kt][0] = pk2(p0, p1); pk[kt][1] = pk2(p2, p3); }
            else { pk[kt][0] = 0u; pk[kt][1] = 0u; }
        }
        rs += __shfl_xor(rs, 16); rs += __shfl_xor(rs, 32);
        lrow = lrow * alpha + rs;
        float al[4];
#pragma unroll
        for (int i = 0; i < 4; ++i) al[i] = __shfl(alpha, 4 * fq + i);
#pragma unroll
        for (int dtile = 0; dtile < 8; ++dtile)
#pragma unroll
            for (int i = 0; i < 4; ++i) O[dtile][i] *= al[i];
#pragma unroll
        for (int ks = 0; ks < 4; ++ks) {
            const bool act = half == 0 ? (2 * ks + 1 >= wave) : (2 * ks <= wave);
            if (act) {
                u32x4 pw; pw.x = pk[2 * ks][0]; pw.y = pk[2 * ks][1]; pw.z = pk[2 * ks + 1][0]; pw.w = pk[2 * ks + 1][1];
                const bf16x8 pa = __builtin_bit_cast(bf16x8, pw);
#pragma unroll
                for (int dtile = 0; dtile < 8; ++dtile) {
                    const bf16* vp = VTs + (32 * ks + 4 * fq + (fr >> 2)) * AKS + 16 * dtile + 4 * (fr & 3);
                    const s16x4 v0 = __builtin_amdgcn_ds_read_tr16_b64_v4i16((__attribute__((address_space(3))) s16x4*)(vp));
                    const s16x4 v1 = __builtin_amdgcn_ds_read_tr16_b64_v4i16((__attribute__((address_space(3))) s16x4*)(vp + 16 * AKS));
                    bf16x8 vb; vb[0] = v0[0]; vb[1] = v0[1]; vb[2] = v0[2]; vb[3] = v0[3]; vb[4] = v1[0]; vb[5] = v1[1]; vb[6] = v1[2]; vb[7] = v1[3];
                    O[dtile] = mfma16(pa, vb, O[dtile]); }
            }
        }
    }
    bf16* AO = (bf16*)(ws + WS_AO) + (size_t)g * MS * 512; float* LSE = (float*)(ws + WS_LSE) + (size_t)g * MS * 4;
    {
        const float inv_l = 1.f / lrow;
        float il[4];
#pragma unroll
        for (int i = 0; i < 4; ++i) il[i] = __shfl(inv_l, 4 * fq + i);
#pragma unroll
        for (int dtile = 0; dtile < 8; ++dtile)
#pragma unroll
            for (int i = 0; i < 4; ++i) Pw[(4 * fq + i) * AKS + 16 * dtile + fr] = (bf16)f2bf(O[dtile][i] * il[i]);
        if (fq == 0) { const size_t row = (size_t)(rowbase + (128 * n + 16 * wave + fr) * dil); LSE[(size_t)hh * MS + row] = mrow + logf(lrow); }
#pragma unroll
        for (int k = 0; k < 4; ++k) { const int c = lane + 64 * k, q = c >> 4, ch = c & 15;
            const size_t row = (size_t)(rowbase + (128 * n + 16 * wave + q) * dil);
            *(u32x4*)(AO + row * 512 + hh * 128 + 8 * ch) = *(const u32x4*)(Pw + q * AKS + 8 * ch); }
    }
    __syncthreads();
}

constexpr int N_SCAN_ITEMS = NB_PASS * 32, N_ATT_ITEMS = 3 * NB_PASS * 4 * 32;
#ifndef PROBE_ATT_REP
#define PROBE_ATT_REP 1
#endif
struct XcdBarrier;
__device__ __forceinline__ void xcd_barrier(const XcdBarrier& b);
__device__ __forceinline__ void phase_mix(const Args& a, unsigned char* lds, int pass, const XcdBarrier* pbar) {
    volatile int* slot = (volatile int*)(lds + 131072 + 1024);
#ifdef PROBE_SPLIT
    for (int it = blockIdx.x; it < N_SCAN_ITEMS; it += gridDim.x) scana_item(a, lds, it, pass);
    xcd_barrier(*pbar);
    for (int rep = 0; rep < PROBE_ATT_REP; ++rep)
    for (int it = blockIdx.x; it < N_ATT_ITEMS; it += gridDim.x) attn_item(a, lds, it);
#else
    if ((int)blockIdx.x < N_SCAN_ITEMS && gridDim.x >= (unsigned)N_SCAN_ITEMS) {
        const int x = blockIdx.x & 7, k = blockIdx.x >> 3, g = x + 8 * (k >> 3), m = k & 7;
        scana_item(a, lds, g * 8 + m, pass);
    } else if (gridDim.x < (unsigned)N_SCAN_ITEMS) { for (int it = blockIdx.x; it < N_SCAN_ITEMS; it += gridDim.x) scana_item(a, lds, it, pass); }
    constexpr int QN = N_ATT_ITEMS / 8;
    for (int qo = 0; qo < 8; ++qo) {
        const int qx = (int)((blockIdx.x + qo) & 7);
        unsigned* qc = (unsigned*)(a.ws + WS_CTL) + CW_QCTR + (pass * 8 + qx) * 64;
        for (;;) {
            __syncthreads();
            if (opaque_tid() == 0) *slot = (int)atomicAdd(qc, 1u);
            __syncthreads();
            const int L = *slot;
            if (L >= QN) break;
            attn_item(a, lds, ((L >> 3) * 8 + qx) * 8 + (L & 7));
        }
    }
#endif
}

constexpr int QS_STRIDE = 264, SS_STRIDE = 72;
constexpr int L_QS = 0, L_SS = L_QS + 64 * QS_STRIDE * 2, L_DENL = L_SS + 64 * SS_STRIDE * 2, L_WIL = L_DENL + 256, L_NUM = L_WIL + 256, L_SB_END = L_NUM + 64 * QS_STRIDE * 2;
static_assert(L_SB_END <= 131072, "scan-B lds");
constexpr int L_KTL = L_SB_END, L_XS = L_KTL + 256 * TPS * 2, L_SB2_END = L_XS + 64 * TPS * 2;
static_assert(L_SB2_END <= 131072, "scan-B lds");
struct SBCtx { const bf16* P; const bf16* XC; const bf16* QM; const bf16* SG; const bf16* VTG; const bf16* KTG; const bf16* CS; const float* NS; const float* gWI; const float* gEF; const float* gDEC; bf16* UM; int tid, lane, wave, fr, fq; };

__device__ __forceinline__ void scanb_tail(const Args& a, const SBCtx& c, const bf16* NUMS, const float* DENL, int h, int t0) {
    const int lane = c.lane, wave = c.wave, col = h * 256 + 4 * lane;
    const f32x4 gh = *(const f32x4*)(a.g_head + col), sk = *(const f32x4*)(a.skip + col);
#pragma unroll
    for (int hb = 0; hb < 2; ++hb) {
        u32x2 ow[4], zw[4], xw[4];
#pragma unroll
        for (int q = 0; q < 4; ++q) { const size_t r = (size_t)(t0 + 8 * wave + 4 * hb + q);
            ow[q] = *(const u32x2*)(c.P + r * INW + C_OA + col); zw[q] = *(const u32x2*)(c.P + r * INW + C_ZA + col); xw[q] = *(const u32x2*)(c.XC + r * 1024 + col); }
#pragma unroll
        for (int q = 0; q < 4; ++q) {
            const int l = 8 * wave + 4 * hb + q; const size_t r = (size_t)(t0 + l);
            const u32x2 hw = *(const u32x2*)(NUMS + l * QS_STRIDE + 4 * lane);
            const float rd = DENL[l];
            float hm[4] = {sigmoidf_(bflo(ow[q].x)) * bflo(hw.x) * rd, sigmoidf_(bfhi(ow[q].x)) * bfhi(hw.x) * rd, sigmoidf_(bflo(ow[q].y)) * bflo(hw.y) * rd, sigmoidf_(bfhi(ow[q].y)) * bfhi(hw.y) * rd};
            float ss = (hm[0] * hm[0] + hm[1] * hm[1]) + (hm[2] * hm[2] + hm[3] * hm[3]);
            ss = wave_sum(ss);
            const float rinv = 1.f / sqrtf(ss * (1.f / 256.f) + EPS);
            const float xc[4] = {bflo(xw[q].x), bfhi(xw[q].x), bflo(xw[q].y), bfhi(xw[q].y)}, za[4] = {bflo(zw[q].x), bfhi(zw[q].x), bflo(zw[q].y), bfhi(zw[q].y)};
            float o[4];
#pragma unroll
            for (int e = 0; e < 4; ++e) o[e] = (hm[e] * rinv * gh[e] + sk[e] * xc[e]) * siluf_(za[e]);
            u32x2 ov; ov.x = pk2(o[0], o[1]); ov.y = pk2(o[2], o[3]);
            *(u32x2*)(c.UM + r * 1536 + col) = ov;
        }
        __builtin_amdgcn_sched_barrier(0);
    }
}

__device__ __forceinline__ void scanb_run(const Args& a, unsigned char* lds, int vcu, int G, int pass) {
    SBCtx c;
    c.tid = opaque_tid(); c.lane = c.tid & 63; c.wave = __builtin_amdgcn_readfirstlane(c.tid >> 6); c.fr = c.lane & 15; c.fq = c.lane >> 4;
    unsigned char* ws = a.ws;
    c.P = (const bf16*)(ws + WS_P); c.XC = (const bf16*)(ws + WS_XC); c.QM = (const bf16*)(ws + WS_QM); c.SG = (const bf16*)(ws + WS_SG); c.VTG = (const bf16*)(ws + WS_VTG); c.KTG = (const bf16*)(ws + WS_KTG);
    c.CS = (const bf16*)(ws + WS_CS); c.NS = (const float*)(ws + WS_NS); { const float* gsc = (const float*)(ws + WS_GSC + (size_t)pass * GSC_STRIDE); c.gWI = gsc + 2 * MS * 4; c.gEF = gsc + 3 * MS * 4; c.gDEC = gsc + 5 * MS * 4; }
    c.UM = (bf16*)(ws + WS_ACAT);
    const int wave = c.wave;
    bf16* QS = (bf16*)(lds + L_QS); bf16* SS = (bf16*)(lds + L_SS); float* DENL = (float*)(lds + L_DENL); float* WIL = (float*)(lds + L_WIL); bf16* NUMS = (bf16*)(lds + L_NUM);
    bf16* KTL = (bf16*)(lds + L_KTL); bf16* XS = (bf16*)(lds + L_XS);
    unsigned* qc = (unsigned*)(ws + WS_CTL) + CW_QCTR + 2048 + pass * 64;
    volatile int* slot = (volatile int*)(lds + 131072 + 1024);
    constexpr int NITEMS = (MS / 128) * 4;
    bf16x8 ones;
    { const short ov = (c.fr == 0) ? (short)0x3F80 : (short)0;
#pragma unroll
      for (int e = 0; e < 8; ++e) ones[e] = ov; }
    int it = vcu;
    while (it < NITEMS) {
        { int t_ = c.tid; asm volatile("" : "+v"(t_)); c.tid = t_; c.lane = t_ & 63; c.fr = c.lane & 15; c.fq = c.lane >> 4; }
        const int tid = c.tid, lane = c.lane, fr = c.fr, fq = c.fq;
        const int h = it & 3, pr = it >> 2, chA = (2 * pr) * 4 + h, chB = chA + 4, tA = (2 * pr) * 64, tB = tA + 64;
        bf16x8 cb[2][8], vtA[2][2], vtB[2][2];
#pragma unroll
        for (int t = 0; t < 2; ++t) {
#pragma unroll
            for (int ks = 0; ks < 8; ++ks) cb[t][ks] = *(const bf16x8*)(c.CS + (size_t)chA * 65536 + (wave * 8 + ks) * 1024 + (16 * t + fr) * 32 + 8 * fq);
#pragma unroll
            for (int k2 = 0; k2 < 2; ++k2) vtA[t][k2] = *(const bf16x8*)(c.VTG + (size_t)chA * 16384 + (((2 * wave + t) * 2 + k2) * 64 + lane) * 8);
        }
        const float decA = c.gDEC[h * (MS / 64) + 2 * pr];
        if (tid == 0) *slot = (int)atomicAdd(qc, 1u);
        __syncthreads();
#pragma unroll
        for (int i = 0; i < 4; ++i) { const int q = tid + NTHR * i, row = q >> 5, cc = q & 31; *(u32x4*)(QS + row * QS_STRIDE + 8 * cc) = *(const u32x4*)(c.QM + (size_t)(tA + row) * 1024 + h * 256 + 8 * cc); }
        { const int row = tid >> 3, cc = tid & 7; *(u32x4*)(SS + row * SS_STRIDE + 8 * cc) = *(const u32x4*)(c.SG + (size_t)chA * 4096 + row * 64 + 8 * cc); }
        if (tid < 64) WIL[tid] = c.gWI[h * MS + tA + tid];
#pragma unroll
        for (int i = 0; i < 4; ++i) { const int p = tid + NTHR * i, blk = p >> 6, ln = p & 63, row = (blk >> 1) * 16 + (ln & 15), ch8 = (blk & 1) * 4 + (ln >> 4);
            *(u32x4*)(KTL + row * TPS + 8 * ch8) = *(const u32x4*)(c.KTG + (size_t)chA * 16384 + p * 8); }
        __syncthreads();
        const int nit = G + *slot;
#pragma unroll
        for (int lt = 0; lt < 4; ++lt) {
            bf16x8 qf[8], sf[2];
#pragma unroll
            for (int ks = 0; ks < 8; ++ks) qf[ks] = *(const bf16x8*)(QS + (16 * lt + fr) * QS_STRIDE + 32 * ks + 8 * fq);
#pragma unroll
            for (int k2 = 0; k2 < 2; ++k2) sf[k2] = *(const bf16x8*)(SS + (16 * lt + fr) * SS_STRIDE + 32 * k2 + 8 * fq);
#pragma unroll
            for (int t = 0; t < 2; ++t) {
                f32x4 a1 = {0.f, 0.f, 0.f, 0.f}, a2 = {0.f, 0.f, 0.f, 0.f}, a3 = {0.f, 0.f, 0.f, 0.f};
#pragma unroll
                for (int k2 = 0; k2 < 2; ++k2) a1 = mfma16(sf[k2], vtA[t][k2], a1);
#pragma unroll
                for (int ks = 0; ks < 8; ks += 2) { a2 = mfma16(qf[ks], cb[t][ks], a2); a3 = mfma16(qf[ks + 1], cb[t][ks + 1], a3); }
#pragma unroll
                for (int i = 0; i < 4; ++i) NUMS[(16 * lt + 4 * fq + i) * QS_STRIDE + 32 * wave + 16 * t + fr] = (bf16)f2bf(a1[i] + WIL[16 * lt + 4 * fq + i] * (a2[i] + a3[i]));
            }
        }
        if (wave == 0) {
            bf16x8 nb[8];
#pragma unroll
            for (int ks = 0; ks < 8; ++ks) { const f32x4 n0 = *(const f32x4*)(c.NS + (size_t)chA * 256 + 32 * ks + 8 * fq), n1 = *(const f32x4*)(c.NS + (size_t)chA * 256 + 32 * ks + 8 * fq + 4);
                u32x4 w; w.x = pk2(n0[0], n0[1]); w.y = pk2(n0[2], n0[3]); w.z = pk2(n1[0], n1[1]); w.w = pk2(n1[2], n1[3]);
                if (fr != 0) w = (u32x4){0u, 0u, 0u, 0u};
                nb[ks] = __builtin_bit_cast(bf16x8, w); }
#pragma unroll
            for (int lt = 0; lt < 4; ++lt) {
                f32x4 a1 = {0.f, 0.f, 0.f, 0.f}, a2 = {0.f, 0.f, 0.f, 0.f};
#pragma unroll
                for (int k2 = 0; k2 < 2; ++k2) { const bf16x8 sf = *(const bf16x8*)(SS + (16 * lt + fr) * SS_STRIDE + 32 * k2 + 8 * fq); a1 = mfma16(sf, ones, a1); }
#pragma unroll
                for (int ks = 0; ks < 8; ++ks) { const bf16x8 qf = *(const bf16x8*)(QS + (16 * lt + fr) * QS_STRIDE + 32 * ks + 8 * fq); a2 = mfma16(qf, nb[ks], a2); }
                if (fr == 0) {
#pragma unroll
                    for (int i = 0; i < 4; ++i) { const int l = 16 * lt + 4 * fq + i; const float den = a1[i] + WIL[l] * a2[i]; DENL[l] = 1.f / fmaxf(fabsf(den), c.gEF[h * MS + tA + l]); } }
            }
        }
        __syncthreads();
#pragma unroll
        for (int i = 0; i < 4; ++i) { const int q = tid + NTHR * i, row = q >> 5, cc = q & 31; *(u32x4*)(QS + row * QS_STRIDE + 8 * cc) = *(const u32x4*)(c.QM + (size_t)(tB + row) * 1024 + h * 256 + 8 * cc); }
        { const int row = tid >> 3, cc = tid & 7; *(u32x4*)(SS + row * SS_STRIDE + 8 * cc) = *(const u32x4*)(c.SG + (size_t)chB * 4096 + row * 64 + 8 * cc); }
        scanb_tail(a, c, NUMS, DENL, h, tA);
#pragma unroll
        for (int t = 0; t < 2; ++t)
#pragma unroll
            for (int k2 = 0; k2 < 2; ++k2) vtB[t][k2] = *(const bf16x8*)(c.VTG + (size_t)chB * 16384 + (((2 * wave + t) * 2 + k2) * 64 + lane) * 8);
        __syncthreads();
        if (tid < 64) WIL[tid] = c.gWI[h * MS + tB + tid];
        {
            const int ti = wave >> 1;
            bf16x8 qf[8];
#pragma unroll
            for (int ks = 0; ks < 8; ++ks) qf[ks] = *(const bf16x8*)(QS + (16 * ti + fr) * QS_STRIDE + 32 * ks + 8 * fq);
#pragma unroll
            for (int tt = 0; tt < 2; ++tt) { const int tj = 2 * (wave & 1) + tt;
                f32x4 xacc = {0.f, 0.f, 0.f, 0.f};
#pragma unroll
                for (int ks = 0; ks < 8; ++ks) {
                    const bf16* kp = KTL + (32 * ks + 8 * fq + (fr >> 2)) * TPS + 16 * tj + 4 * (fr & 3);
                    const s16x4 k0 = __builtin_amdgcn_ds_read_tr16_b64_v4i16((__attribute__((address_space(3))) s16x4*)(kp));
                    const s16x4 k1 = __builtin_amdgcn_ds_read_tr16_b64_v4i16((__attribute__((address_space(3))) s16x4*)(kp + 4 * TPS));
                    bf16x8 kb; kb[0] = k0[0]; kb[1] = k0[1]; kb[2] = k0[2]; kb[3] = k0[3]; kb[4] = k1[0]; kb[5] = k1[1]; kb[6] = k1[2]; kb[7] = k1[3];
                    xacc = mfma16(qf[ks], kb, xacc); }
#pragma unroll
                for (int i = 0; i < 4; ++i) XS[(16 * ti + 4 * fq + i) * TPS + 16 * tj + fr] = (bf16)f2bf(xacc[i]); }
        }
        __syncthreads();
#pragma unroll
        for (int lt = 0; lt < 4; ++lt) {
            bf16x8 qf[8], sf[2], xf[2];
#pragma unroll
            for (int ks = 0; ks < 8; ++ks) qf[ks] = *(const bf16x8*)(QS + (16 * lt + fr) * QS_STRIDE + 32 * ks + 8 * fq);
#pragma unroll
            for (int k2 = 0; k2 < 2; ++k2) { sf[k2] = *(const bf16x8*)(SS + (16 * lt + fr) * SS_STRIDE + 32 * k2 + 8 * fq); xf[k2] = *(const bf16x8*)(XS + (16 * lt + fr) * TPS + 32 * k2 + 8 * fq); }
#pragma unroll
            for (int t = 0; t < 2; ++t) {
                f32x4 a1 = {0.f, 0.f, 0.f, 0.f}, a2 = {0.f, 0.f, 0.f, 0.f}, a3 = {0.f, 0.f, 0.f, 0.f}, a4 = {0.f, 0.f, 0.f, 0.f};
#pragma unroll
                for (int k2 = 0; k2 < 2; ++k2) { a1 = mfma16(sf[k2], vtB[t][k2], a1); a4 = mfma16(xf[k2], vtA[t][k2], a4); }
#pragma unroll
                for (int ks = 0; ks < 8; ks += 2) { a2 = mfma16(qf[ks], cb[t][ks], a2); a3 = mfma16(qf[ks + 1], cb[t][ks + 1], a3); }
#pragma unroll
                for (int i = 0; i < 4; ++i) NUMS[(16 * lt + 4 * fq + i) * QS_STRIDE + 32 * wave + 16 * t + fr] = (bf16)f2bf(a1[i] + WIL[16 * lt + 4 * fq + i] * (decA * (a2[i] + a3[i]) + a4[i]));
            }
        }
        if (wave == 0) {
            bf16x8 nb[8];
#pragma unroll
            for (int ks = 0; ks < 8; ++ks) { const f32x4 n0 = *(const f32x4*)(c.NS + (size_t)chA * 256 + 32 * ks + 8 * fq), n1 = *(const f32x4*)(c.NS + (size_t)chA * 256 + 32 * ks + 8 * fq + 4);
                u32x4 w; w.x = pk2(n0[0], n0[1]); w.y = pk2(n0[2], n0[3]); w.z = pk2(n1[0], n1[1]); w.w = pk2(n1[2], n1[3]);
                if (fr != 0) w = (u32x4){0u, 0u, 0u, 0u};
                nb[ks] = __builtin_bit_cast(bf16x8, w); }
#pragma unroll
            for (int lt = 0; lt < 4; ++lt) {
                f32x4 a1 = {0.f, 0.f, 0.f, 0.f}, a2 = {0.f, 0.f, 0.f, 0.f}, a4 = {0.f, 0.f, 0.f, 0.f};
#pragma unroll
                for (int k2 = 0; k2 < 2; ++k2) { const bf16x8 sf = *(const bf16x8*)(SS + (16 * lt + fr) * SS_STRIDE + 32 * k2 + 8 * fq); a1 = mfma16(sf, ones, a1);
                                                 const bf16x8 xf = *(const bf16x8*)(XS + (16 * lt + fr) * TPS + 32 * k2 + 8 * fq); a4 = mfma16(xf, ones, a4); }
#pragma unroll
                for (int ks = 0; ks < 8; ++ks) { const bf16x8 qf = *(const bf16x8*)(QS + (16 * lt + fr) * QS_STRIDE + 32 * ks + 8 * fq); a2 = mfma16(qf, nb[ks], a2); }
                if (fr == 0) {
#pragma unroll
                    for (int i = 0; i < 4; ++i) { const int l = 16 * lt + 4 * fq + i; const float den = a1[i] + WIL[l] * (decA * a2[i] + a4[i]); DENL[l] = 1.f / fmaxf(fabsf(den), c.gEF[h * MS + tB + l]); } }
            }
        }
        __syncthreads();
        scanb_tail(a, c, NUMS, DENL, h, tB);
        it = nit;
    }
    __syncthreads();
}

__device__ __forceinline__ void phase_post(const Args& a, unsigned char* lds, int vcu, int G, int pass) {
    scanb_run(a, lds, vcu, G, pass);
    const int tid = opaque_tid(), lane = tid & 63, wave = tid >> 6;
    unsigned char* ws = a.ws;
    const bf16* P = (const bf16*)(ws + WS_P);
    const bf16* AO = (const bf16*)(ws + WS_AO); const float* LSE = (const float*)(ws + WS_LSE); bf16* UA = (bf16*)(ws + WS_ACAT) + 1024;
    const int hh = lane >> 4, c = hh * 128 + 8 * (lane & 15);
    for (int r0 = 2 * (vcu * NWAVES + wave); r0 < MS; r0 += 2 * G * NWAVES) {
        u32x4 o0[2], o1[2], o2[2], zb[2]; float l0[2], l1[2], l2[2];
#pragma unroll
        for (int q = 0; q < 2; ++q) { const size_t r = (size_t)(r0 + q);
            o0[q] = *(const u32x4*)(AO + r * 512 + c); o1[q] = *(const u32x4*)(AO + ((size_t)MS + r) * 512 + c); o2[q] = *(const u32x4*)(AO + ((size_t)2 * MS + r) * 512 + c);
            zb[q] = *(const u32x4*)(P + r * INW + C_ZB + c);
            l0[q] = LSE[(size_t)hh * MS + r]; l1[q] = LSE[(size_t)(4 + hh) * MS + r]; l2[q] = LSE[(size_t)(8 + hh) * MS + r]; }
#pragma unroll
        for (int q = 0; q < 2; ++q) {
            const float mx = fmaxf(l0[q], fmaxf(l1[q], l2[q]));
            float w0 = __expf(l0[q] - mx), w1 = __expf(l1[q] - mx), w2 = __expf(l2[q] - mx); const float inv = 1.f / (w0 + w1 + w2); w0 *= inv; w1 *= inv; w2 *= inv;
            float f0[8], f1[8], f2[8], z[8], o[8]; unpack8(o0[q], f0); unpack8(o1[q], f1); unpack8(o2[q], f2); unpack8(zb[q], z);
#pragma unroll
            for (int e = 0; e < 8; ++e) o[e] = (w0 * f0[e] + w1 * f1[e] + w2 * f2[e]) * siluf_(z[e]);
            u32x4 ov; ov.x = pk2(o[0], o[1]); ov.y = pk2(o[2], o[3]); ov.z = pk2(o[4], o[5]); ov.w = pk2(o[6], o[7]);
            *(u32x4*)(UA + (size_t)(r0 + q) * 1536 + c) = ov;
        }
    }
}

__device__ __forceinline__ void phase_norm(const Args& a, int vcu, int G) {
    const int tid = opaque_tid(), lane = tid & 63, wave = tid >> 6;
    const bf16* dl = (const bf16*)(a.ws + WS_H);
    for (int r0 = 2 * (vcu * NWAVES + wave); r0 < MALL; r0 += 2 * G * NWAVES) {
        f32x4 v[2][4]; u32x2 d[2][4]; float ss[2] = {0.f, 0.f};
#pragma unroll
        for (int q = 0; q < 2; ++q) { const f32x4* xr = (const f32x4*)(a.x + (size_t)(r0 + q) * DM) + lane; const u32x2* dr = (const u32x2*)(dl + (size_t)(r0 + q) * DM) + lane;
#pragma unroll
            for (int j = 0; j < 4; ++j) { v[q][j] = xr[64 * j]; d[q][j] = dr[64 * j]; } }
#pragma unroll
        for (int q = 0; q < 2; ++q)
#pragma unroll
            for (int j = 0; j < 4; ++j) { v[q][j] += (f32x4){bflo(d[q][j].x), bfhi(d[q][j].x), bflo(d[q][j].y), bfhi(d[q][j].y)};
                ss[q] += (v[q][j].x * v[q][j].x + v[q][j].y * v[q][j].y) + (v[q][j].z * v[q][j].z + v[q][j].w * v[q][j].w); }
#pragma unroll
        for (int o = 1; o < 64; o <<= 1) { ss[0] += __shfl_xor(ss[0], o); ss[1] += __shfl_xor(ss[1], o); }
#pragma unroll
        for (int q = 0; q < 2; ++q) { const float rinv = 1.f / sqrtf(ss[q] * (1.f / DM) + EPS);
#pragma unroll
            for (int j = 0; j < 4; ++j) { const f32x4 gf = *((const f32x4*)a.g_final + lane + 64 * j); *((f32x4*)(a.out + (size_t)(r0 + q) * DM) + lane + 64 * j) = v[q][j] * rinv * gf; } }
    }
}


#define LAS __attribute__((address_space(3)))
#define XB_TMO      128
#define XB_XCNT(j)  (256  + 64 * (j))
#define XB_XSUB(j)  (1280 + 64 * (j))
#define XB_XGEN(j)  (2304 + 64 * (j))
#define XB_TOP      3328
#define XB_TOPGEN   3392
#define XCD_BAR_WORDS 3456
#define XB_SPIN_CAP (1u << 22)
constexpr int CW_BAR = 4096;
__device__ __forceinline__ unsigned xb_ld(unsigned* p)              { return __hip_atomic_load(p, __ATOMIC_RELAXED, __HIP_MEMORY_SCOPE_AGENT); }
__device__ __forceinline__ unsigned xb_add(unsigned* p, unsigned v) { return __hip_atomic_fetch_add(p, v, __ATOMIC_RELAXED, __HIP_MEMORY_SCOPE_AGENT); }
__device__ __forceinline__ unsigned xb_xcc_id() { return (unsigned)__builtin_amdgcn_s_getreg((3 << 11) | 20) & 0xFu; }
#define XB_SPIN(cond, bar) do { unsigned _sp = 0; while (cond) { __builtin_amdgcn_s_sleep(1); \
    if ((++_sp & 255u) == 0u) { if (xb_ld(&(bar)[XB_TMO])) break; if (_sp > XB_SPIN_CAP) { atomicAdd(&(bar)[XB_TMO], 1u); break; } } } } while (0)
struct XcdBarrier { unsigned* bar; unsigned x; volatile LAS unsigned* st; };
__device__ __forceinline__ XcdBarrier xcd_barrier_post(unsigned* bar, volatile LAS unsigned* st) {
    XcdBarrier b; b.bar = bar; b.x = xb_xcc_id(); b.st = st;
    if (threadIdx.x == 0) (void)xb_add(&bar[XB_XCNT(b.x)], 1u);
    return b;
}
__device__ __forceinline__ void xcd_barrier_complete(unsigned* bar, unsigned x, unsigned& nloc, unsigned& nx) {
    const unsigned G = gridDim.x * gridDim.y * gridDim.z;
    unsigned sum, cnt, mine, sp = 0u;
    for (;;) {
        sum = 0u; cnt = 0u; mine = 0u;
#pragma unroll
        for (unsigned j = 0; j < 16; ++j) { const unsigned c = xb_ld(&bar[XB_XCNT(j)]); sum += c; cnt += (c > 0u) ? 1u : 0u; mine = (j == x) ? c : mine; }
        if (sum == G) break;
        __builtin_amdgcn_s_sleep(1);
        if ((++sp & 255u) == 0u) { if (xb_ld(&bar[XB_TMO])) break; if (sp > XB_SPIN_CAP) { atomicAdd(&bar[XB_TMO], 1u); break; } }
    }
    nloc = mine > 0u ? mine : 1u; nx = cnt > 0u ? cnt : 1u;
}
__device__ __forceinline__ void xcd_barrier(const XcdBarrier& b) {
    asm volatile("s_waitcnt vmcnt(0)" ::: "memory");
    __syncthreads();
    if (threadIdx.x == 0) {
        unsigned* bar = b.bar;
        __builtin_amdgcn_s_waitcnt(0);
        unsigned nloc = b.st[0], nx = b.st[1];
        if (nloc == 0u) { xcd_barrier_complete(bar, b.x, nloc, nx); b.st[0] = nloc; b.st[1] = nx; }
        const unsigned old = xb_add(&bar[XB_XSUB(b.x)], 1u);
        const unsigned gen = old / nloc;
        if (old + 1u == (gen + 1u) * nloc) {
            __builtin_amdgcn_fence(__ATOMIC_RELEASE, "agent");
            asm volatile("s_waitcnt vmcnt(0)" ::: "memory");
            const unsigned og = xb_add(&bar[XB_TOP], 1u);
            const unsigned tg = og / nx;
            if (og + 1u == (tg + 1u) * nx) xb_add(&bar[XB_TOPGEN], 1u);
            else XB_SPIN(xb_ld(&bar[XB_TOPGEN]) == tg, bar);
            __builtin_amdgcn_fence(__ATOMIC_ACQUIRE, "agent");
            xb_add(&bar[XB_XGEN(b.x)], 1u);
            asm volatile("s_waitcnt vmcnt(0)" ::: "memory");
        } else {
            XB_SPIN(xb_ld(&bar[XB_XGEN(b.x)]) == gen, bar);
            __builtin_amdgcn_fence(__ATOMIC_ACQUIRE, "agent");
            asm volatile("s_waitcnt vmcnt(0)" ::: "memory");
        }
    }
    __syncthreads();
}

constexpr int PH_PER_PASS = 5, PH_TOTAL = 4 + PH_PER_PASS * NPASS + 1;
#define PROBE_KIND_OF(k) ((k) == 0 ? K_CPREP : (k) == 1 ? K_MIX : (k) == 2 ? K_POST : (k) == 3 ? K_OUT1 : K_OUT2)
enum { K_PROLOGUE = 0, K_H = 1, K_INPROJ = 2, K_PREP = 3, K_QK = 4, K_MIX = 5, K_POST = 6, K_OUT1 = 7, K_OUT2 = 8, K_NORM = 9, K_CPREP = 10, K_OUT2IN = 12 };

__device__ __forceinline__ Args fresh_args() {
    Args a{};
#if defined(__HIP_DEVICE_COMPILE__)
    typedef const __attribute__((address_space(4))) unsigned long long* KP;
    KP q = (KP)__builtin_amdgcn_kernarg_segment_ptr(); asm volatile("" : "+s"(q));
    static_assert(sizeof(Args) == 22 * 8, "Args layout");
    unsigned long long w[22];
#pragma unroll
    for (int i = 0; i < 22; ++i) w[i] = q[i];
    __builtin_memcpy(&a, w, sizeof(Args));
#endif
    return a;
}
template <int KIND>
__device__ __forceinline__ void run_phase(const Args& args, unsigned char* lds, int pass, const XcdBarrier* pbar = nullptr) {
    const int G = gridDim.x; const int bx = blockIdx.x;
    const int vcu = (G % 8 == 0) ? (bx % 8) * (G / 8) + bx / 8 : bx;
    unsigned char* ws = args.ws;
    PG8_LAS unsigned char* lds3 = (PG8_LAS unsigned char*)lds;
    if constexpr (KIND == K_PROLOGUE) phase_prologue(args, lds, vcu, G);
    else if constexpr (KIND == K_H) phase_h(args, lds, vcu, G);
    else if constexpr (KIND == K_NORM) phase_norm(args, vcu, G);
    else if constexpr (KIND == K_INPROJ) {
        GemmCombo g{(const char*)ws, WS_H + (size_t)pass * MS * 2048};
        ComboOrder S; S.init(G, bx, false);
        EpiCombo E{EpiOut{(bf16*)(ws + WS_H), (const float*)(ws + WS_MOD) + 2048, 0}, EpiProj{(bf16*)(ws + WS_P), (const float*)(ws + WS_ROPE) + (size_t)pass * MS * 32}, EpiVT{(bf16*)(ws + WS_VTG)}};
        pg8::gemm_phase<EpiCombo, ComboOrder, true, true>(lds3, g, S, E);
    } else if constexpr (KIND == K_PREP) phase_gates(args, lds, vcu, G);
    else if constexpr (KIND == K_QK) {
        pg8::Gemm<1024, 256, 256, 512, 512 * 256 * 2> g{(const bf16*)(ws + WS_XC), (const bf16*)(ws + WS_WQK)};
        pg8::GroupOrder S; S.init(MS, G, bx);
        EpiQK E{(bf16*)(ws + WS_QM), (bf16*)(ws + WS_KM)};
        pg8::gemm_phase<EpiQK, pg8::GroupOrder, true, true>(lds3, g, S, E);
    } else if constexpr (KIND == K_CPREP) phase_cprep(args, lds, vcu, G, pass);
    else if constexpr (KIND == K_MIX) phase_mix(args, lds, pass, pbar);
    else if constexpr (KIND == K_POST) phase_post(args, lds, vcu, G, pass);
    else if constexpr (KIND == K_OUT1) {
        pg8::Gemm<1536, 1536, 1536> g{(const bf16*)(ws + WS_ACAT), (const bf16*)(ws + WS_WOM)};
        pg8::StaticOrder S; S.init(MS, 1024, G, bx);
        EpiMerge E{(const bf16*)(ws + WS_P), (bf16*)(ws + WS_MG)};
        pg8::gemm_phase<EpiMerge, pg8::StaticOrder, true, true>(lds3, g, S, E);
    } else if constexpr (KIND == K_OUT2IN) {
        GemmCombo g{(const char*)ws, WS_H + (size_t)(pass + 1) * MS * 2048};
        ComboOrder S; S.init(G, bx, true);
        EpiCombo E{EpiOut{(bf16*)(ws + WS_H), (const float*)(ws + WS_MOD) + 2048, pass * MS}, EpiProj{(bf16*)(ws + WS_P), (const float*)(ws + WS_ROPE) + (size_t)(pass + 1) * MS * 32}, EpiVT{(bf16*)(ws + WS_VTG)}};
        pg8::gemm_phase<EpiCombo, ComboOrder, true, true>(lds3, g, S, E);
    } else if constexpr (KIND == K_OUT2) {
        pg8::Gemm<1024, 1024, 1024> g{(const bf16*)(ws + WS_MG), (const bf16*)(ws + WS_WO)};
        pg8::StaticOrder S; S.init(MS, 1024, G, bx);
        EpiOut E{(bf16*)(ws + WS_H), (const float*)(ws + WS_MOD) + 2048, pass * MS};
        pg8::gemm_phase<EpiOut, pg8::StaticOrder, true, true>(lds3, g, S, E);
    }
}

#if !MK_ONE_LAUNCH
template <int KIND>
__global__ void __launch_bounds__(NTHR, 2) k_phase(Args args) {
    extern __shared__ __attribute__((aligned(16))) unsigned char lds[];
    run_phase<KIND>(args, lds, args.ph_lo);
}
#else
__global__ void __launch_bounds__(NTHR, 2) mk_fwd(Args args) {
    extern __shared__ __attribute__((aligned(16))) unsigned char lds[];
    volatile LAS unsigned* misc = (volatile LAS unsigned*)((LAS unsigned char*)lds + 131072 + 2048);
    if (threadIdx.x < 16) misc[threadIdx.x] = 0u;
    __syncthreads();
    XcdBarrier bar = xcd_barrier_post((unsigned*)(args.ws + WS_CTL) + CW_BAR, misc + 8);
#ifdef PROBE_TMASK
    unsigned long long pr_acc = 0ull;
#endif
    for (int gp = args.ph_lo; gp < args.ph_hi; ++gp) {
#ifdef PROBE_TMASK
        const unsigned long long pr_t0 = __builtin_amdgcn_s_memrealtime();
        int pr_kind;
        if (gp == 0) pr_kind = K_PROLOGUE; else if (gp == 1) pr_kind = K_H; else if (gp == 2) pr_kind = K_PREP; else if (gp == 3) pr_kind = K_INPROJ; else if (gp == PH_TOTAL - 1) pr_kind = K_NORM;
        else { const int k = (gp - 4) % PH_PER_PASS; pr_kind = PROBE_KIND_OF(k); }
#endif
        if (gp == 0) run_phase<K_PROLOGUE>(args, lds, 0);
        else if (gp == 1) run_phase<K_H>(args, lds, 0);
        else if (gp == 2) run_phase<K_PREP>(args, lds, 0);
        else if (gp == 3) run_phase<K_INPROJ>(args, lds, 0);
        else if (gp == PH_TOTAL - 1) run_phase<K_NORM>(args, lds, 0);
        else {
            const int pass = (gp - 4) / PH_PER_PASS, k = (gp - 4) % PH_PER_PASS;
            if (k == 0) run_phase<K_CPREP>(args, lds, pass);
            else if (k == 1) run_phase<K_MIX>(args, lds, pass, &bar);
            else if (k == 2) run_phase<K_POST>(args, lds, pass);
            else if (k == 3) run_phase<K_OUT1>(args, lds, pass);
            else if (pass + 1 < NPASS) run_phase<K_OUT2IN>(args, lds, pass);
            else run_phase<K_OUT2>(args, lds, pass);
        }
#ifdef PROBE_TMASK
        const unsigned long long pr_tb = __builtin_amdgcn_s_memrealtime();
#endif
        if (gp + 1 < args.ph_hi) xcd_barrier(bar);
#ifdef PROBE_TMASK
        else __syncthreads();
        if ((PROBE_TMASK >> 11) & 1) pr_acc += __builtin_amdgcn_s_memrealtime() - pr_tb;
        if ((PROBE_TMASK >> pr_kind) & 1) pr_acc += __builtin_amdgcn_s_memrealtime() - pr_t0;
#endif
    }
#ifdef PROBE_TMASK
    if (blockIdx.x == 0) { const unsigned long long t1 = __builtin_amdgcn_s_memrealtime(); while (__builtin_amdgcn_s_memrealtime() - t1 < 4ull * pr_acc) __builtin_amdgcn_s_sleep(8); }
#endif
}
#endif

extern "C" void kernel_launch(void* const* d_in, const int* in_sizes, int n_in, void* d_out, int out_size, void* d_ws, size_t ws_size, hipStream_t stream) {
    static int grid = 0;
    if (grid == 0) {
        if (n_in != 19 || in_sizes[0] != MALL * DM || out_size != MALL * DM || ws_size < WS_END) { fprintf(stderr, "kernel_launch: unexpected shapes (n_in %d, ws %zu)\n", n_in, ws_size); grid = -1; return; }
        int dev = 0, cus = 0, per_cu = 0;
        (void)hipGetDevice(&dev); (void)hipDeviceGetAttribute(&cus, hipDeviceAttributeMultiprocessorCount, dev);
#if MK_ONE_LAUNCH
        (void)hipFuncSetAttribute((const void*)mk_fwd, hipFuncAttributeMaxDynamicSharedMemorySize, LDS_BYTES);
        (void)hipOccupancyMaxActiveBlocksPerMultiprocessor(&per_cu, (const void*)mk_fwd, NTHR, LDS_BYTES);
        if (per_cu < 1) { fprintf(stderr, "kernel_launch: occupancy query says %d\n", per_cu); per_cu = 1; }
#else
#define SETATTR(KIND) (void)hipFuncSetAttribute((const void*)k_phase<KIND>, hipFuncAttributeMaxDynamicSharedMemorySize, LDS_BYTES)
        SETATTR(K_PROLOGUE); SETATTR(K_H); SETATTR(K_INPROJ); SETATTR(K_PREP); SETATTR(K_QK); SETATTR(K_MIX); SETATTR(K_POST); SETATTR(K_OUT1); SETATTR(K_OUT2); SETATTR(K_NORM); SETATTR(K_CPREP); SETATTR(K_OUT2IN);
        (void)per_cu;
#endif
        (void)hipGetLastError();
        grid = cus;
    }
    if (grid < 0) return;
    (void)hipMemsetAsync((char*)d_ws + WS_CTL, 0, CTL_ZERO_BYTES, stream);
    Args a{};
    a.x = (const float*)d_in[0]; a.c = (const float*)d_in[1]; a.pos = (const int*)d_in[2]; a.w_ada = (const float*)d_in[3]; a.b_ada = (const float*)d_in[4];
    a.g_norm = (const float*)d_in[5]; a.w_in = (const float*)d_in[6]; a.b_ig = (const float*)d_in[7]; a.b_fg = (const float*)d_in[8]; a.w_conv = (const float*)d_in[9];
    a.b_conv = (const float*)d_in[10]; a.w_q = (const float*)d_in[11]; a.w_k = (const float*)d_in[12]; a.g_head = (const float*)d_in[13]; a.skip = (const float*)d_in[14];
    a.w_om = (const float*)d_in[15]; a.w_oa = (const float*)d_in[16]; a.w_o = (const float*)d_in[17]; a.g_final = (const float*)d_in[18];
    a.out = (float*)d_out; a.ws = (unsigned char*)d_ws;
#if MK_ONE_LAUNCH
    a.ph_lo = 0; a.ph_hi = PH_TOTAL;
    void* params[] = {&a};
    hipError_t e = hipLaunchCooperativeKernel((const void*)mk_fwd, dim3(grid), dim3(NTHR), params, LDS_BYTES, stream);
    if (e != hipSuccess) fprintf(stderr, "cooperative launch failed: %s\n", hipGetErrorString(e));
#else
#define LAUNCH(KIND, PASS) do { a.ph_lo = (PASS); a.ph_hi = 0; hipLaunchKernelGGL(k_phase<KIND>, dim3(grid), dim3(NTHR), LDS_BYTES, stream, a); } while (0)
    LAUNCH(K_PROLOGUE, 0); LAUNCH(K_H, 0);
    LAUNCH(K_PREP, 0); LAUNCH(K_INPROJ, 0);
    for (int p = 0; p < NPASS; ++p) { LAUNCH(K_CPREP, p); LAUNCH(K_MIX, p); LAUNCH(K_POST, p); LAUNCH(K_OUT1, p); if (p + 1 < NPASS) LAUNCH(K_OUT2IN, p); else LAUNCH(K_OUT2, p); }
    LAUNCH(K_NORM, 0);
#endif
}
```

```cpp
#include <hip/hip_runtime.h>
#include <hip/hip_cooperative_groups.h>
#include <cstdio>
#include <cstdint>
namespace cg = cooperative_groups;

#ifndef MK_ONE_LAUNCH
#define MK_ONE_LAUNCH 1
#endif

__device__ __forceinline__ int opaque_tid() { int t = threadIdx.x; asm volatile("" : "+v"(t)); return t; }
namespace pg8 {
#define PG8_LAS __attribute__((address_space(3)))
typedef unsigned short bf16_t;
typedef short bf16x8 __attribute__((ext_vector_type(8)));
typedef float f32x4 __attribute__((ext_vector_type(4)));
typedef unsigned u32x4 __attribute__((ext_vector_type(4)));
constexpr int BM = 256, BK = 64, HALF = 128, HTB = HALF * BK * 2, STAGE_BYTES = 8 * HTB, NXCD = 8, WGM = 8;

__host__ __device__ __forceinline__ int lds_byte(int r, int c) { const int st = (r >> 4) * 2 + (c >> 5), rr = r & 15, cc = c & 31, ob = rr * 64 + cc * 2; return st * 1024 + (ob ^ (((ob >> 9) & 1) << 5)); }
__host__ __device__ __forceinline__ void stage_rc(int b, int& R, int& C) { const int st = b / 1024, sb = b % 1024, swz = sb ^ (((sb >> 9) & 1) << 5); R = (st >> 1) * 16 + swz / 64; C = (st & 1) * 32 + (swz % 64) / 2; }
__host__ __device__ __forceinline__ int perm32(int rho) { const int n = rho >> 4, i = rho & 15; return 8 * (i >> 2) + 4 * n + (i & 3); }

struct Unit { int pm, pn, g; };
template <int LDA, int LDB, int KK, int AGS = 0, int BGS = 0> struct Gemm {
    const bf16_t* A; const bf16_t* Bt;
    static constexpr int lda = LDA, ldb = LDB, K = KK; static constexpr bool MULTI = false;
    __device__ __forceinline__ const char* abase(const Unit& u) const { return (const char*)A + (size_t)(u.g * AGS) + (size_t)u.pm * (size_t)(BM * 2 * LDA); }
    __device__ __forceinline__ const char* bbase(const Unit& u) const { return (const char*)Bt + (size_t)(u.g * BGS) + (size_t)u.pn * (size_t)(BM * 2 * LDB); }
};

struct StaticOrder {
    int nM, nN, nwg, G, c;
    __host__ __device__ void init(int M, int N, int G_, int c_) { nM = M / BM; nN = N / BM; nwg = nM * nN; G = G_; c = c_; }
    __host__ __device__ bool next(int i, Unit& u) const {
        const long L = (long)i * G + c; if (L >= nwg) return false;
        int wgid = (int)L; { const int q = nwg / NXCD, r = nwg % NXCD, xcd = wgid % NXCD, off = wgid / NXCD; wgid = (xcd < r ? xcd * (q + 1) : r * (q + 1) + (xcd - r) * q) + off; }
        const int nig = WGM * nN, gid = wgid / nig, fm = gid * WGM, gsz = (nM - fm) < WGM ? (nM - fm) : WGM;
        u.pm = fm + ((wgid % nig) % gsz); u.pn = (wgid % nig) / gsz; u.g = 0; return true;
    }
    __device__ __forceinline__ void a_ready(const Unit&) const {}
    __device__ __forceinline__ void done(const Unit&) const {}
};
struct GroupOrder {
    int nunits, G, c;
    __host__ __device__ void init(int M, int G_, int c_) { nunits = (M / BM) * 8; G = G_; c = c_; }
    __host__ __device__ bool next(int i, Unit& u) const {
        const long L = (long)i * G + c; if (L >= nunits) return false;
        u.pm = (int)(L >> 3); u.g = (int)((L & 7) >> 1); u.pn = (int)(L & 1); return true;
    }
    __device__ __forceinline__ void a_ready(const Unit&) const {}
    __device__ __forceinline__ void done(const Unit&) const {}
};

__device__ __forceinline__ unsigned cvt_pk_bf16(float lo, float hi) { unsigned r; asm volatile("v_cvt_pk_bf16_f32 %0, %1, %2" : "=v"(r) : "v"(lo), "v"(hi)); return r; }

template <class Epi, class Sched, bool ALIGN_EPI, bool SP2, class GemmT>
__device__ __forceinline__ void gemm_phase(PG8_LAS unsigned char* lds, const GemmT g, const Sched& S, const Epi& E) {
    const int tid = opaque_tid(), wid = __builtin_amdgcn_readfirstlane(tid >> 6), lane = tid & 63, wr = wid >> 2, wc = wid & 3, fr = lane & 15, fq = lane >> 4;
    constexpr int K = GemmT::K, nt = K / BK;
    constexpr bool MULTI = GemmT::MULTI;
    unsigned voffA[2], voffB[2];
#pragma unroll
    for (int i = 0; i < 2; ++i) { int R, C; stage_rc(tid * 16 + i * 8192, R, C); const int Rb = Epi::PERM ? (64 * (R >> 5) + perm32(R & 31)) : R;
        voffA[i] = (unsigned)(R * g.lda + C) * 2u; voffB[i] = (unsigned)(Rb * g.ldb + C) * 2u; }
    const size_t kstep = (size_t)(BK * 2);
    const size_t hstepA = (size_t)HALF * g.lda * 2, hstepB = (size_t)(Epi::PERM ? 32 : HALF) * g.ldb * 2;
    const unsigned ldsw = (unsigned)wid * 1024u;
    const int aoff = lds_byte(wr * 64 + fr, fq * 8), boff = lds_byte(wc * 32 + fr, fq * 8);
#define PG8_SA(b, h) (((b) * 2 + (h)) * HTB)
#define PG8_SB(b, h) ((4 + (b) * 2 + (h)) * HTB)
#define PG8_STAGE(bufoff, gbase, voff) do { _Pragma("unroll") for (int _i = 0; _i < 2; ++_i) \
        __builtin_amdgcn_global_load_lds((const unsigned*)((const char*)(gbase) + (voff)[_i]), (PG8_LAS unsigned*)(lds + (bufoff) + ldsw + _i * 8192), 16, 0, 0); } while (0)
#define PG8_LDA(dst, b, h) do { _Pragma("unroll") for (int m = 0; m < 4; ++m) _Pragma("unroll") for (int k = 0; k < 2; ++k) dst[m][k] = *(const PG8_LAS bf16x8*)(lds + PG8_SA(b, h) + aoff + m * 2048 + k * 1024); } while (0)
#define PG8_LDB(dst, b, h) do { _Pragma("unroll") for (int n = 0; n < 2; ++n) _Pragma("unroll") for (int k = 0; k < 2; ++k) dst[n][k] = *(const PG8_LAS bf16x8*)(lds + PG8_SB(b, h) + boff + n * 2048 + k * 1024); } while (0)
#define PG8_MMA(ai, bj, At, Bt) do { __builtin_amdgcn_s_setprio(1); _Pragma("unroll") for (int m = 0; m < 4; ++m) _Pragma("unroll") for (int n = 0; n < 2; ++n) _Pragma("unroll") for (int k = 0; k < 2; ++k) \
        acc[ai][bj][m][n] = __builtin_amdgcn_mfma_f32_16x16x32_bf16(Bt[n][k], At[m][k], acc[ai][bj][m][n], 0, 0, 0); __builtin_amdgcn_s_setprio(0); } while (0)
#define PG8_WAIT_V(n) asm volatile("s_waitcnt vmcnt(" #n ")" ::: "memory")
#define PG8_WAIT_L(n) asm volatile("s_waitcnt lgkmcnt(" #n ")" ::: "memory")
#define PG8_BAR __builtin_amdgcn_s_barrier()
#define PG8_SCHED __builtin_amdgcn_sched_barrier(0)
    Unit cur, nxt; int ui = 0;
    if (!S.next(0, cur)) return;
    f32x4 acc[2][2][4][2];
#pragma unroll
    for (int a = 0; a < 2; ++a)
#pragma unroll
        for (int b = 0; b < 2; ++b)
#pragma unroll
            for (int m = 0; m < 4; ++m)
#pragma unroll
                for (int n = 0; n < 2; ++n) acc[a][b][m][n] = (f32x4){0.f, 0.f, 0.f, 0.f};
    bf16x8 At[4][2], B0[2][2], B1[2][2];
    const char* cA = g.abase(cur); const char* cB = g.bbase(cur);
    int ntc = nt;
    if constexpr (MULTI) ntc = g.ntiles(cur);
    S.a_ready(cur);
    if constexpr (SP2) {
        PG8_STAGE(PG8_SB(0, 0), cB, voffB); PG8_STAGE(PG8_SB(0, 1), cB + hstepB, voffB); PG8_STAGE(PG8_SA(0, 0), cA, voffA); PG8_STAGE(PG8_SA(0, 1), cA + hstepA, voffA);
        if (wr == 1) PG8_BAR;
        PG8_WAIT_V(2); PG8_BAR;
        PG8_STAGE(PG8_SB(1, 0), cB + kstep, voffB); PG8_STAGE(PG8_SA(1, 0), cA + kstep, voffA); PG8_STAGE(PG8_SB(1, 1), cB + hstepB + kstep, voffB);
        PG8_WAIT_V(6); PG8_BAR;
    } else {
        PG8_STAGE(PG8_SB(0, 0), cB, voffB); PG8_STAGE(PG8_SA(0, 0), cA, voffA); PG8_STAGE(PG8_SB(0, 1), cB + hstepB, voffB); PG8_STAGE(PG8_SA(0, 1), cA + hstepA, voffA);
        if (wr == 1) PG8_BAR;
        PG8_WAIT_V(4); PG8_BAR;
        PG8_STAGE(PG8_SB(1, 0), cB + kstep, voffB); PG8_STAGE(PG8_SA(1, 0), cA + kstep, voffA); PG8_STAGE(PG8_SB(1, 1), cB + hstepB + kstep, voffB);
        PG8_WAIT_V(6); PG8_BAR;
    }
    for (;;) {
        const bool has_next = S.next(ui + 1, nxt);
        const char* nA = has_next ? g.abase(nxt) : cA; const char* nB = has_next ? g.bbase(nxt) : cB;
#pragma nounroll
        for (int t = 0; t < ntc; t += 2) {
            const bool last = (t == ntc - 2);
            const char* a1 = cA + (size_t)(t + 1) * kstep;
            const char* a2 = last ? nA : cA + (size_t)(t + 2) * kstep; const char* b2 = last ? nB : cB + (size_t)(t + 2) * kstep;
            const char* a3 = a2 + kstep; const char* b3 = b2 + kstep;
            if (last && has_next) S.a_ready(nxt);
            if constexpr (Epi::HOOK_T >= 0) { if (t == Epi::HOOK_T) E.hook(acc, cur, wr, wc, fr, fq); }
            if constexpr (SP2) {
            PG8_LDB(B0, 0, 0); PG8_LDB(B1, 0, 1); PG8_SCHED; PG8_LDA(At, 0, 0); PG8_STAGE(PG8_SA(1, 1), a1 + hstepA, voffA);
            PG8_WAIT_V(8); PG8_WAIT_L(0); PG8_BAR; PG8_MMA(0, 0, At, B0); PG8_MMA(0, 1, At, B1); PG8_BAR; PG8_SCHED;
            PG8_LDA(At, 0, 1); PG8_STAGE(PG8_SB(0, 0), b2, voffB); PG8_STAGE(PG8_SB(0, 1), b2 + hstepB, voffB); PG8_STAGE(PG8_SA(0, 0), a2, voffA);
            PG8_WAIT_V(8); PG8_WAIT_L(0); PG8_BAR; PG8_MMA(1, 0, At, B0); PG8_MMA(1, 1, At, B1); PG8_BAR; PG8_SCHED;
            PG8_LDB(B0, 1, 0); PG8_LDB(B1, 1, 1); PG8_SCHED; PG8_LDA(At, 1, 0); PG8_STAGE(PG8_SA(0, 1), a2 + hstepA, voffA);
            PG8_WAIT_V(8); PG8_WAIT_L(0); PG8_BAR; PG8_MMA(0, 0, At, B0); PG8_MMA(0, 1, At, B1); PG8_BAR; PG8_SCHED;
            PG8_LDA(At, 1, 1); PG8_STAGE(PG8_SB(1, 0), b3, voffB); PG8_STAGE(PG8_SB(1, 1), b3 + hstepB, voffB); PG8_STAGE(PG8_SA(1, 0), a3, voffA);
            PG8_WAIT_V(8); PG8_WAIT_L(0); PG8_BAR; PG8_MMA(1, 0, At, B0); PG8_MMA(1, 1, At, B1); PG8_BAR; PG8_SCHED;
            } else {
            PG8_LDB(B0, 0, 0); PG8_SCHED; PG8_LDA(At, 0, 0); PG8_STAGE(PG8_SA(1, 1), a1 + hstepA, voffA);
            PG8_WAIT_L(8); PG8_BAR; PG8_WAIT_L(0); PG8_MMA(0, 0, At, B0); PG8_BAR; PG8_SCHED;
            PG8_LDB(B1, 0, 1); PG8_STAGE(PG8_SB(0, 0), b2, voffB);
            PG8_BAR; PG8_WAIT_L(0); PG8_MMA(0, 1, At, B1); PG8_BAR;
            PG8_LDA(At, 0, 1); PG8_STAGE(PG8_SA(0, 0), a2, voffA);
            PG8_BAR; PG8_WAIT_L(0); PG8_MMA(1, 0, At, B0); PG8_BAR; PG8_SCHED;
            PG8_STAGE(PG8_SB(0, 1), b2 + hstepB, voffB);
            PG8_WAIT_V(6); PG8_BAR; PG8_MMA(1, 1, At, B1); PG8_BAR;
            PG8_LDB(B0, 1, 0); PG8_SCHED; PG8_LDA(At, 1, 0); PG8_STAGE(PG8_SA(0, 1), a2 + hstepA, voffA);
            PG8_WAIT_L(8); PG8_BAR; PG8_WAIT_L(0); PG8_MMA(0, 0, At, B0); PG8_BAR; PG8_SCHED;
            PG8_LDB(B1, 1, 1); PG8_STAGE(PG8_SB(1, 0), b3, voffB);
            PG8_BAR; PG8_WAIT_L(0); PG8_MMA(0, 1, At, B1); PG8_BAR;
            PG8_LDA(At, 1, 1); PG8_STAGE(PG8_SA(1, 0), a3, voffA);
            PG8_BAR; PG8_WAIT_L(0); PG8_MMA(1, 0, At, B0); PG8_BAR; PG8_SCHED;
            PG8_STAGE(PG8_SB(1, 1), b3 + hstepB, voffB);
            PG8_WAIT_V(6); PG8_BAR; PG8_MMA(1, 1, At, B1); PG8_BAR;
            }
        }
        if constexpr (ALIGN_EPI) { if (wr == 0) PG8_BAR; }
        E(acc, cur, wr, wc, fr, fq); S.done(cur);
        if (!has_next) break;
#pragma unroll
        for (int a = 0; a < 2; ++a)
#pragma unroll
            for (int b = 0; b < 2; ++b)
#pragma unroll
                for (int m = 0; m < 4; ++m)
#pragma unroll
                    for (int n = 0; n < 2; ++n) acc[a][b][m][n] = (f32x4){0.f, 0.f, 0.f, 0.f};
        cur = nxt; cA = nA; cB = nB; ++ui;
        if constexpr (MULTI) ntc = g.ntiles(cur);
        if constexpr (ALIGN_EPI) { if (wr == 1) PG8_BAR; }
    }
    PG8_WAIT_V(0);
    if constexpr (!ALIGN_EPI) { if (wr == 0) PG8_BAR; }
    PG8_BAR;
#undef PG8_SA
#undef PG8_SB
#undef PG8_STAGE
#undef PG8_LDA
#undef PG8_LDB
#undef PG8_MMA
#undef PG8_WAIT_V
#undef PG8_WAIT_L
#undef PG8_BAR
#undef PG8_SCHED
}
}

constexpr int NWAVES = 8, NTHR = 512;
constexpr int DM = 1024, NBATCH = 16, SEQ = 4096, MALL = NBATCH * SEQ;
constexpr int NB_PASS = 4, MS = NB_PASS * SEQ, NPASS = NBATCH / NB_PASS;
constexpr int INW_SRC = 11272, INW = 11264;
constexpr int C_XA = 0, C_VA = 1024, C_OA = 2048, C_ZA = 3072, C_QA = 4096, C_KA = 5632, C_VT = 7168, C_ZB = 8704, C_GA = 9216, C_GB = 10240;
constexpr float EPS = 1e-6f;

constexpr size_t MiB = 1u << 20;
constexpr size_t WS_CTL = 0, CTL_ZERO_BYTES = 1 * MiB;
constexpr size_t WS_MOD = 1 * MiB;
constexpr size_t WS_WG = 1 * MiB + 256 * 1024;
constexpr size_t WS_WIN = 2 * MiB;
constexpr size_t WS_WQK = 24 * MiB;
constexpr size_t WS_WOM = 25 * MiB, WS_WO = 28 * MiB, WS_WOA2 = 32 * MiB;
constexpr size_t WS_IG = 30 * MiB, WS_FG = 31 * MiB;
constexpr size_t WS_LSE = 34 * MiB;
constexpr size_t WS_DEN = 35 * MiB;
constexpr size_t WS_H = 36 * MiB;
constexpr size_t WS_P = 164 * MiB;
constexpr size_t WS_XC = 516 * MiB;
constexpr size_t WS_QM = 548 * MiB, WS_KM = WS_QM;
constexpr size_t WS_GSC = 580 * MiB, GSC_STRIDE = 2 * MiB;
constexpr size_t WS_AO = 588 * MiB;
constexpr size_t WS_ACAT = 636 * MiB;
constexpr size_t WS_UA2 = WS_ACAT + 32 * MiB;
constexpr size_t WS_MG = 700 * MiB;
constexpr size_t WS_SG = 732 * MiB;
constexpr size_t WS_KTG = 740 * MiB;
constexpr size_t WS_VTG = 772 * MiB;
constexpr size_t WS_CS = 804 * MiB;
constexpr size_t WS_NS = 868 * MiB;
constexpr size_t WS_ROPE = 869 * MiB;
constexpr size_t WS_QKV = 877 * MiB;
constexpr size_t WS_END = 1021 * MiB;
constexpr int CW_QCTR = 1024;
constexpr int CW_ROWSS = 65536;
static_assert((CW_ROWSS + MALL) * 4 <= (int)CTL_ZERO_BYTES, "ctl");

constexpr int LDS_BYTES = 147456;

typedef unsigned short bf16;
typedef float f32x4 __attribute__((ext_vector_type(4)));
typedef float f32x2 __attribute__((ext_vector_type(2)));
typedef short bf16x8 __attribute__((ext_vector_type(8)));
typedef unsigned u32x4 __attribute__((ext_vector_type(4)));
typedef unsigned u32x2 __attribute__((ext_vector_type(2)));
typedef short s16x4 __attribute__((ext_vector_type(4)));

__device__ __forceinline__ unsigned f2bf(float f) { unsigned u = __builtin_bit_cast(unsigned, f); return (u + 0x7fffu + ((u >> 16) & 1u)) >> 16; }
__device__ __forceinline__ unsigned pk2(float lo, float hi) { return f2bf(lo) | (f2bf(hi) << 16); }
__device__ __forceinline__ float bflo(unsigned w) { return __builtin_bit_cast(float, w << 16); }
__device__ __forceinline__ float bfhi(unsigned w) { return __builtin_bit_cast(float, w & 0xffff0000u); }
__device__ __forceinline__ float bf1(bf16 v) { return __builtin_bit_cast(float, (unsigned)v << 16); }
__device__ __forceinline__ float sigmoidf_(float x) { return 1.f / (1.f + __expf(-x)); }
__device__ __forceinline__ float siluf_(float x) { return x / (1.f + __expf(-x)); }
__device__ __forceinline__ float wave_sum(float v) {
#pragma unroll
    for (int o = 1; o < 64; o <<= 1) v += __shfl_xor(v, o);
    return v;
}
__device__ __forceinline__ void unpack8(const u32x4 w, float* f) {
    f[0] = bflo(w.x); f[1] = bfhi(w.x); f[2] = bflo(w.y); f[3] = bfhi(w.y); f[4] = bflo(w.z); f[5] = bfhi(w.z); f[6] = bflo(w.w); f[7] = bfhi(w.w);
}

struct Args {
    const float* x; const float* c; const int* pos; const float* w_ada; const float* b_ada; const float* g_norm; const float* w_in;
    const float* b_ig; const float* b_fg; const float* w_conv; const float* b_conv; const float* w_q; const float* w_k; const float* g_head;
    const float* skip; const float* w_om; const float* w_oa; const float* w_o; const float* g_final;
    float* out; unsigned char* ws; int ph_lo, ph_hi;
};

__device__ __forceinline__ void transpose_item(const float* W, int K, int Nsrc, int nblk, int src_col_off, bf16* WT, int ldt, int row_off, float scale, float* scr, int item, int lane, bool frag = false) {
    const int kb = item / nblk, nb = item % nblk, k0 = 64 * kb, n0 = 32 * nb;
#pragma unroll 8
    for (int i = 0; i < 32; ++i) { const int kk = 2 * i + (lane >> 5); scr[kk * 33 + (lane & 31)] = W[(size_t)(k0 + kk) * Nsrc + src_col_off + n0 + (lane & 31)]; }
    __builtin_amdgcn_wave_barrier();
    asm volatile("s_waitcnt lgkmcnt(0)" ::: "memory");
    const int cc = lane & 7;
#pragma unroll
    for (int j = 0; j < 4; ++j) { const int n = (lane >> 3) + 8 * j; const float* s = scr + (8 * cc) * 33 + n;
        u32x4 o; o.x = pk2(s[0 * 33] * scale, s[1 * 33] * scale); o.y = pk2(s[2 * 33] * scale, s[3 * 33] * scale); o.z = pk2(s[4 * 33] * scale, s[5 * 33] * scale); o.w = pk2(s[6 * 33] * scale, s[7 * 33] * scale);
        if (frag) { const int nn = row_off + n0 + n, kc = (k0 >> 3) + cc; *(u32x4*)(WT + (size_t)((((nn >> 4) * (K >> 5) + (kc >> 2)) * 64 + (kc & 3) * 16 + (nn & 15)) * 8)) = o; }
        else *(u32x4*)(WT + (size_t)(row_off + n0 + n) * ldt + k0 + 8 * cc) = o; }
    asm volatile("s_waitcnt lgkmcnt(0)" ::: "memory");
    __builtin_amdgcn_wave_barrier();
}

__device__ __forceinline__ void phase_prologue(const Args& a, unsigned char* lds, int vcu, int G) {
    const int tid = opaque_tid(), lane = tid & 63, wave = tid >> 6;
    unsigned char* ws = a.ws;
    if (vcu < 192) {
        float* sc = (float*)lds;
        float* red = (float*)(lds + 65536);
        for (int i = tid; i < 16 * 1024; i += NTHR) sc[i] = siluf_(a.c[i]);
        __syncthreads();
        const int col = lane & 15, ksub = lane >> 4, n = vcu * 16 + col;
        float acc[16];
#pragma unroll
        for (int b = 0; b < 16; ++b) acc[b] = 0.f;
        const int k0 = wave * 128 + ksub * 32;
        const float* wp = a.w_ada + (size_t)k0 * 3072 + n;
#pragma unroll 1
        for (int kc = 0; kc < 8; ++kc) {
            const float w0 = wp[(size_t)(4 * kc) * 3072], w1 = wp[(size_t)(4 * kc + 1) * 3072], w2 = wp[(size_t)(4 * kc + 2) * 3072], w3 = wp[(size_t)(4 * kc + 3) * 3072];
#pragma unroll
            for (int b = 0; b < 16; ++b) { const f32x4 s4 = *(const f32x4*)(sc + b * 1024 + k0 + 4 * kc); acc[b] += (s4.x * w0 + s4.y * w1) + (s4.z * w2 + s4.w * w3); }
        }
#pragma unroll
        for (int b = 0; b < 16; ++b) { float v = acc[b]; v += __shfl_xor(v, 16); v += __shfl_xor(v, 32); if (ksub == 0) red[(wave * 16 + b) * 16 + col] = v; }
        __syncthreads();
        float* mod = (float*)(ws + WS_MOD);
        if (tid < 256) { const int b = tid >> 4, l = tid & 15, nn = vcu * 16 + l; float s_ = 0.f;
#pragma unroll
            for (int w = 0; w < 8; ++w) s_ += red[(w * 16 + b) * 16 + l];
            s_ += a.b_ada[nn];
            const int part = nn >> 10, cc = nn & 1023;
            if (part == 1) s_ = a.g_norm[cc] * (1.f + s_);
            mod[b * 3072 + nn] = s_; }
        __syncthreads();
    }
    {
        float* scr = (float*)lds + wave * (64 * 33);
        const int gw = vcu * NWAVES + wave, NGW = G * NWAVES;
        constexpr int I_IN = (1024 / 64) * (INW / 32);
        constexpr int I_QK = 8 * (256 / 64) * (256 / 32);
        constexpr int I_OM = 16 * 32, I_OA = 8 * 32, I_O = 16 * 32;
        constexpr int NITEMS = I_IN + I_QK + I_OM + I_OA + I_O;
        for (int it = gw; it < NITEMS; it += NGW) {
            int r = it;
            if (r < I_IN) { const int nb = r % (INW / 32); const int off = (nb * 32 >= 4096) ? 8 : 0;
                transpose_item(a.w_in, 1024, INW_SRC, INW / 32, off, (bf16*)(ws + WS_WIN), 1024, 0, 1.f, scr, r, lane); continue; } r -= I_IN;
            if (r < I_QK) { const int mtx = r >> 5, rr = r & 31, h = mtx >> 1, isk = mtx & 1;
                const float* W = (isk ? a.w_k : a.w_q) + (size_t)h * 65536;
                transpose_item(W, 256, 256, 8, 0, (bf16*)(ws + WS_WQK) + (size_t)h * 512 * 256, 256, isk * 256, isk ? 0.0625f : 1.f, scr, rr, lane, true); continue; } r -= I_QK;
            if (r < I_OM) { transpose_item(a.w_om, 1024, 1024, 32, 0, (bf16*)(ws + WS_WOM), 1024, 0, 1.f, scr, r, lane); continue; } r -= I_OM;
            if (r < I_OA) { transpose_item(a.w_oa, 512, 1024, 32, 0, (bf16*)(ws + WS_WOA2), 1024, 0, 1.f, scr, r, lane); continue; } r -= I_OA;
            transpose_item(a.w_o, 1024, 1024, 32, 0, (bf16*)(ws + WS_WO), 1024, 0, 1.f, scr, r, lane);
        }
        float* wg = (float*)(ws + WS_WG);
        for (int i = (vcu * NTHR + tid); i < 8 * 1024; i += G * NTHR) { const int j = i >> 10, k = i & 1023; wg[i] = a.w_in[(size_t)k * INW_SRC + 4096 + j]; }
    }
}

__constant__ double c_inv_freq[16] = {1.0, 0.44036660267178046, 0.19392274474868576, 0.08539710028576561, 0.03760603093086393, 0.016560440080994446, 0.007292664737217109, 0.003211445994752591,
    0.001414213562373095, 0.000622772421914596, 0.0002742481756762073, 0.00012076973741146504, 5.318295896944988e-05, 2.341999896140934e-05, 1.031338537721246e-05, 4.5416704806078695e-06};

__device__ __forceinline__ void phase_h(const Args& a, unsigned char* lds, int vcu, int G) {
    const int tid = opaque_tid(), lane = tid & 63, wave = tid >> 6;
    unsigned char* ws = a.ws;
    float* wg = (float*)lds;
    { const float* src = (const float*)(ws + WS_WG); for (int i = tid; i < 8192; i += NTHR) wg[i] = src[i]; }
    __syncthreads();
    const float* mod = (const float*)(ws + WS_MOD);
    bf16* H = (bf16*)(ws + WS_H);
    float* IG = (float*)(ws + WS_IG); float* FG = (float*)(ws + WS_FG); float* ROPE = (float*)(ws + WS_ROPE);
    const int gw = vcu * NWAVES + wave, NGW = G * NWAVES;
    for (int row0 = 2 * gw; row0 < MALL; row0 += 2 * NGW) {
        f32x4 v[2][4]; float ss[2] = {0.f, 0.f};
#pragma unroll
        for (int rr = 0; rr < 2; ++rr) { const f32x4* xr = (const f32x4*)(a.x + (size_t)(row0 + rr) * DM) + lane;
#pragma unroll
            for (int j = 0; j < 4; ++j) v[rr][j] = xr[64 * j]; }
        { const int rr = lane >> 5, fi = lane & 15; const int pos = a.pos[row0 + rr];
            const double rev = (double)pos * c_inv_freq[fi] * 0.15915494309189535; const float fr_ = (float)(rev - rint(rev));
            ROPE[(size_t)row0 * 32 + lane] = (lane & 16) ? __builtin_amdgcn_sinf(fr_) : __builtin_amdgcn_cosf(fr_); }
#pragma unroll
        for (int rr = 0; rr < 2; ++rr) {
#pragma unroll
            for (int j = 0; j < 4; ++j) ss[rr] += (v[rr][j].x * v[rr][j].x + v[rr][j].y * v[rr][j].y) + (v[rr][j].z * v[rr][j].z + v[rr][j].w * v[rr][j].w);
        }
#pragma unroll
        for (int o = 1; o < 64; o <<= 1) { ss[0] += __shfl_xor(ss[0], o); ss[1] += __shfl_xor(ss[1], o); }
        const int b = row0 >> 12;
        float pg[2][8];
#pragma unroll
        for (int rr = 0; rr < 2; ++rr)
#pragma unroll
            for (int g = 0; g < 8; ++g) pg[rr][g] = 0.f;
        const float rinv[2] = {1.f / sqrtf(ss[0] * (1.f / DM) + EPS), 1.f / sqrtf(ss[1] * (1.f / DM) + EPS)};
#pragma unroll
        for (int j = 0; j < 4; ++j) {
            const int col = 4 * lane + 256 * j;
            const f32x4 sh = *(const f32x4*)(mod + b * 3072 + col), gs = *(const f32x4*)(mod + b * 3072 + 1024 + col);
            f32x4 h[2];
#pragma unroll
            for (int rr = 0; rr < 2; ++rr) { h[rr] = v[rr][j] * rinv[rr] * gs + sh;
                u32x2 o; o.x = pk2(h[rr].x, h[rr].y); o.y = pk2(h[rr].z, h[rr].w); *((u32x2*)(H + (size_t)(row0 + rr) * DM) + lane + 64 * j) = o; }
#pragma unroll
            for (int g = 0; g < 8; ++g) { const f32x4 w = *(const f32x4*)(wg + g * 1024 + col);
                pg[0][g] += (h[0].x * w.x + h[0].y * w.y) + (h[0].z * w.z + h[0].w * w.w); pg[1][g] += (h[1].x * w.x + h[1].y * w.y) + (h[1].z * w.z + h[1].w * w.w); }
            __builtin_amdgcn_sched_barrier(0);
        }
#pragma unroll
        for (int o = 1; o < 64; o <<= 1)
#pragma unroll
            for (int g = 0; g < 8; ++g) { pg[0][g] += __shfl_xor(pg[0][g], o); pg[1][g] += __shfl_xor(pg[1][g], o); }
        if (lane < 2) { const int rr = lane; const float* p = rr ? pg[1] : pg[0];
            f32x4 ig = {p[0] + a.b_ig[0], p[1] + a.b_ig[1], p[2] + a.b_ig[2], p[3] + a.b_ig[3]};
            f32x4 fg = {p[4] + a.b_fg[0], p[5] + a.b_fg[1], p[6] + a.b_fg[2], p[7] + a.b_fg[3]};
            *(f32x4*)(IG + (size_t)(row0 + rr) * 4) = ig; *(f32x4*)(FG + (size_t)(row0 + rr) * 4) = fg; }
    }
}

constexpr int GATE_COL = 4096;
struct EpiProj {
    static constexpr bool PERM = true; static constexpr int HOOK_T = -1;
    bf16* P; const float* rope; bf16* QKV;
    __device__ __forceinline__ void operator()(const f32x4 (&acc)[2][2][4][2], const pg8::Unit& u, int wr, int wc, int fr, int fq) const {
        const int row0 = u.pm * 256 + wr * 64 + fr, col0 = u.pn * 256 + wc * 64 + 8 * fq;
        const bool rot = (u.pn >= 16) && (u.pn < 28) && ((wc & 1) == 0);
        const bool att = (u.pn >= 16) && (u.pn < 34);
        const int hq = att ? (u.pn - 16) * 2 + (wc >> 1) : 0, lg = 2 * ((hq % 12) >> 2);
        const bool gat = u.pn >= 36;
        const int gq = gat ? (u.pm * 4 + ((u.pn - 36) & 3)) * 2 + ((u.pn - 36) >> 2) : 0;
#pragma unroll
        for (int ai = 0; ai < 2; ++ai)
#pragma unroll
            for (int m = 0; m < 4; ++m) { const int r = row0 + ai * 128 + m * 16; const int sq = r & (SEQ - 1);
                const int rq = (r & ~(SEQ - 1)) + ((sq & ((1 << lg) - 1)) << (12 - lg)) + (sq >> lg);
                bf16* rowp = att ? QKV + ((size_t)hq * MS + rq) * 128 + (wc & 1) * 64 + 8 * fq : P + (size_t)r * INW + col0;
                if (gat) rowp = P + (size_t)(gq * 16 + ai * 8 + m * 2) * INW + GATE_COL + (wr * 4 + wc) * 512 + (fq * 16 + fr) * 8;
#pragma unroll
                for (int bj = 0; bj < 2; ++bj) { f32x4 v0 = acc[ai][bj][m][0], v1 = acc[ai][bj][m][1];
                    if (bj == 0 && rot) {
                        const float* tp = rope + (size_t)r * 32 + 8 * (fq & 1);
                        const float sg = (fq < 2) ? -1.f : 1.f;
                        { const f32x4 c0 = *(const f32x4*)tp, s0 = *(const f32x4*)(tp + 16); f32x4 p0;
#pragma unroll
                          for (int e = 0; e < 4; ++e) p0[e] = __shfl_xor(v0[e], 32);
                          v0 = v0 * c0 + p0 * s0 * sg; }
                        __builtin_amdgcn_sched_barrier(0);
                        { const f32x4 c1 = *(const f32x4*)(tp + 4), s1 = *(const f32x4*)(tp + 20); f32x4 p1;
#pragma unroll
                          for (int e = 0; e < 4; ++e) p1[e] = __shfl_xor(v1[e], 32);
                          v1 = v1 * c1 + p1 * s1 * sg; }
                    }
                    u32x4 w; w.x = pg8::cvt_pk_bf16(v0[0], v0[1]); w.y = pg8::cvt_pk_bf16(v0[2], v0[3]); w.z = pg8::cvt_pk_bf16(v1[0], v1[1]); w.w = pg8::cvt_pk_bf16(v1[2], v1[3]);
                    *(u32x4*)(rowp + (gat ? bj * INW : bj * 32)) = w; }
                __builtin_amdgcn_sched_barrier(0); }
    }
};
struct EpiQK {
    static constexpr bool PERM = true; static constexpr int HOOK_T = -1;
    bf16* QM; bf16* KM;
    __device__ __forceinline__ void operator()(const f32x4 (&acc)[2][2][4][2], const pg8::Unit& u, int wr, int wc, int fr, int fq) const {
        const int row0 = u.pm * 256 + wr * 64 + fr, col0 = u.g * 256 + wc * 64 + 8 * fq;
        bf16* base = u.pn ? KM : QM;
#pragma unroll
        for (int ai = 0; ai < 2; ++ai)
#pragma unroll
            for (int m = 0; m < 4; ++m) { bf16* rowp = base + (size_t)(row0 + ai * 128 + m * 16) * 1024 + col0;
#pragma unroll
                for (int bj = 0; bj < 2; ++bj) { const f32x4 v0 = acc[ai][bj][m][0], v1 = acc[ai][bj][m][1];
                    u32x4 w; w.x = pg8::cvt_pk_bf16(v0[0], v0[1]); w.y = pg8::cvt_pk_bf16(v0[2], v0[3]); w.z = pg8::cvt_pk_bf16(v1[0], v1[1]); w.w = pg8::cvt_pk_bf16(v1[2], v1[3]);
                    *(u32x4*)(rowp + bj * 32) = w; } }
    }
};
struct EpiMerge {
    static constexpr bool PERM = true; static constexpr int HOOK_T = 16;
    const bf16* P; bf16* MG;
    __device__ __forceinline__ void hook(f32x4 (&acc)[2][2][4][2], const pg8::Unit& u, int wr, int wc, int fr, int fq) const {
        int lo = (wr * 4 + wc) * 512 + (fq * 16 + fr) * 8; const int gq0 = (u.pm * 4 + u.pn) * 2;
        asm volatile("" : "+v"(lo));
#pragma unroll
        for (int ai = 0; ai < 2; ++ai)
#pragma unroll
            for (int m = 0; m < 4; ++m) {
#pragma unroll
                for (int bj = 0; bj < 2; ++bj) {
                    const bf16* gp = P + (size_t)(gq0 * 16 + ai * 8 + m * 2 + bj) * INW + GATE_COL + lo;
                    const u32x4 gaw = *(const u32x4*)gp, gbw = *(const u32x4*)(gp + 16 * INW);
                    float ga[8], gb[8]; unpack8(gaw, ga); unpack8(gbw, gb);
#pragma unroll
                    for (int e = 0; e < 4; ++e) {
                        acc[ai][bj][m][0][e] *= (1.f + __expf(-gb[e])) / (1.f + __expf(-ga[e]));
                        acc[ai][bj][m][1][e] *= (1.f + __expf(-gb[4 + e])) / (1.f + __expf(-ga[4 + e])); } }
                __builtin_amdgcn_sched_barrier(0); }
    }
    __device__ __forceinline__ void operator()(const f32x4 (&acc)[2][2][4][2], const pg8::Unit& u, int wr, int wc, int fr, int fq) const {
        const int row0 = u.pm * 256 + wr * 64 + fr, col0 = u.pn * 256 + wc * 64 + 8 * fq;
        const int lo = (wr * 4 + wc) * 512 + (fq * 16 + fr) * 8, gq0 = (u.pm * 4 + u.pn) * 2;
#pragma unroll
        for (int ai = 0; ai < 2; ++ai)
#pragma unroll
            for (int m = 0; m < 4; ++m) { const size_t r = (size_t)(row0 + ai * 128 + m * 16);
#pragma unroll
                for (int bj = 0; bj < 2; ++bj) { const int c = col0 + bj * 32;
                    const u32x4 gbw = *(const u32x4*)(P + (size_t)(gq0 * 16 + 16 + ai * 8 + m * 2 + bj) * INW + GATE_COL + lo); float gb[8]; unpack8(gbw, gb);
                    const f32x4 v0 = acc[ai][bj][m][0], v1 = acc[ai][bj][m][1];
                    float o[8];
#pragma unroll
                    for (int e = 0; e < 4; ++e) { o[e] = sigmoidf_(gb[e]) * v0[e]; o[4 + e] = sigmoidf_(gb[4 + e]) * v1[e]; }
                    u32x4 w; w.x = pg8::cvt_pk_bf16(o[0], o[1]); w.y = pg8::cvt_pk_bf16(o[2], o[3]); w.z = pg8::cvt_pk_bf16(o[4], o[5]); w.w = pg8::cvt_pk_bf16(o[6], o[7]);
                    *(u32x4*)(MG + r * 1024 + c) = w; } }
    }
};
template <bool SECOND> struct EpiMergeAB {
    static constexpr bool PERM = true; static constexpr int HOOK_T = -1;
    const bf16* P; bf16* MG;
    __device__ __forceinline__ void operator()(const f32x4 (&acc)[2][2][4][2], const pg8::Unit& u, int wr, int wc, int fr, int fq) const {
        const int row0 = u.pm * 256 + wr * 64 + fr, col0 = u.pn * 256 + wc * 64 + 8 * fq;
        int lo = (wr * 4 + wc) * 512 + (fq * 16 + fr) * 8; const int gq0 = (u.pm * 4 + u.pn) * 2 + (SECOND ? 1 : 0);
        asm volatile("" : "+v"(lo));
#pragma unroll
        for (int ai = 0; ai < 2; ++ai)
#pragma unroll
            for (int m = 0; m < 4; ++m) { const size_t r = (size_t)(row0 + ai * 128 + m * 16);
#pragma unroll
                for (int bj = 0; bj < 2; ++bj) { const int c = col0 + bj * 32;
                    const u32x4 gw = *(const u32x4*)(P + (size_t)(gq0 * 16 + ai * 8 + m * 2 + bj) * INW + GATE_COL + lo); float gt[8]; unpack8(gw, gt);
                    const f32x4 v0 = acc[ai][bj][m][0], v1 = acc[ai][bj][m][1];
                    float o[8];
#pragma unroll
                    for (int e = 0; e < 4; ++e) { o[e] = sigmoidf_(gt[e]) * v0[e]; o[4 + e] = sigmoidf_(gt[4 + e]) * v1[e]; }
                    if (SECOND) { float pv[8]; unpack8(*(const u32x4*)(MG + r * 1024 + c), pv);
#pragma unroll
                        for (int e = 0; e < 8; ++e) o[e] += pv[e]; }
                    u32x4 w; w.x = pg8::cvt_pk_bf16(o[0], o[1]); w.y = pg8::cvt_pk_bf16(o[2], o[3]); w.z = pg8::cvt_pk_bf16(o[4], o[5]); w.w = pg8::cvt_pk_bf16(o[6], o[7]);
                    *(u32x4*)(MG + r * 1024 + c) = w; }
                __builtin_amdgcn_sched_barrier(0); }
    }
};
struct EpiOut {
    static constexpr bool PERM = true; static constexpr int HOOK_T = -1;
    bf16* dl; const float* gate; int grow0;
    __device__ __forceinline__ void operator()(const f32x4 (&acc)[2][2][4][2], const pg8::Unit& u, int wr, int wc, int fr, int fq) const {
        const int row0 = grow0 + u.pm * 256 + wr * 64 + fr, col0 = u.pn * 256 + wc * 64 + 8 * fq;
        const int b = row0 >> 12;
#pragma unroll
        for (int ai = 0; ai < 2; ++ai)
#pragma unroll
            for (int m = 0; m < 4; ++m) { const int r = row0 + ai * 128 + m * 16;
#pragma unroll
                for (int bj = 0; bj < 2; ++bj) { const int c = col0 + bj * 32;
                    const float* gp = gate + b * 3072 + c; const f32x4 g0 = *(const f32x4*)gp, g1 = *(const f32x4*)(gp + 4);
                    const f32x4 o0 = g0 * acc[ai][bj][m][0], o1 = g1 * acc[ai][bj][m][1];
                    u32x4 w; w.x = pg8::cvt_pk_bf16(o0[0], o0[1]); w.y = pg8::cvt_pk_bf16(o0[2], o0[3]); w.z = pg8::cvt_pk_bf16(o1[0], o1[1]); w.w = pg8::cvt_pk_bf16(o1[2], o1[3]);
                    *(u32x4*)(dl + (size_t)r * 1024 + c) = w; } }
    }
};

struct ComboOrder {
    int n1, nO, nV, npt, pmode, G, c;
    __device__ void init(int G_, int c_, int n1_, int nO_, int nV_, int npt_, int pmode_) { G = G_; c = c_; n1 = n1_; nO = nO_; nV = nV_; npt = npt_; pmode = pmode_; }
    __device__ bool next(int i, pg8::Unit& u) const {
        int L = i * G + c;
        pg8::StaticOrder o;
        if (L < 2 * n1) { const int sec = L >= n1 ? 1 : 0; o.init(MS, 1024, 1, 0); o.next(L - sec * n1, u); u.g = 3 + sec; return true; } L -= 2 * n1;
        if (L < nO) { o.init(MS, 1024, 1, 0); o.next(L, u); u.g = 0; return true; } L -= nO;
        if (L < nV) { o.init(1024, MS, 1, 0); o.next(L, u); u.g = 2; return true; } L -= nV;
        if (npt == 0) return false;
        o.init(MS, npt * 256, 1, 0);
        if (!o.next(L, u)) return false;
        if (pmode == 1) u.pn += 36;
        else if (u.pn >= 4) u.pn += 4;
        u.g = 1; return true;
    }
    __device__ __forceinline__ void a_ready(const pg8::Unit&) const {}
    __device__ __forceinline__ void done(const pg8::Unit&) const {}
};
constexpr int N_T256 = (MS / 256) * 4;
struct GemmCombo {
    const char* ws; size_t hoff;
    static constexpr int lda = 1024, ldb = 1024, K = 1024; static constexpr bool MULTI = true;
    __device__ __forceinline__ const char* abase(const pg8::Unit& u) const {
        size_t off = WS_MG; if (u.g == 1) off = hoff; if (u.g == 2) off = WS_WIN + (size_t)C_VA * 2048; if (u.g == 3) off = WS_ACAT; if (u.g == 4) off = WS_UA2;
        return ws + off + (size_t)u.pm * (size_t)(pg8::BM * 2 * 1024); }
    __device__ __forceinline__ const char* bbase(const pg8::Unit& u) const {
        size_t off = WS_WO; if (u.g == 1) off = WS_WIN; if (u.g == 2) off = hoff; if (u.g == 3) off = WS_WOM; if (u.g == 4) off = WS_WOA2;
        return ws + off + (size_t)u.pn * (size_t)(pg8::BM * 2 * 1024); }
    __device__ __forceinline__ int ntiles(const pg8::Unit& u) const { return u.g == 4 ? 8 : 16; }
};
struct EpiVT {
    static constexpr bool PERM = true; static constexpr int HOOK_T = -1;
    bf16* VTG;
    __device__ __forceinline__ void operator()(const f32x4 (&acc)[2][2][4][2], const pg8::Unit& u, int wr, int wc, int fr, int fq) const {
        const int row0 = u.pm * 256 + wr * 64 + fr, col0 = u.pn * 256 + wc * 64 + 8 * fq;
#pragma unroll
        for (int ai = 0; ai < 2; ++ai)
#pragma unroll
            for (int m = 0; m < 4; ++m) { const int r = row0 + ai * 128 + m * 16, h = r >> 8, e = r & 255;
#pragma unroll
                for (int bj = 0; bj < 2; ++bj) { const int c = col0 + bj * 32, chunk = c >> 6, l = c & 63;
                    const f32x4 v0 = acc[ai][bj][m][0], v1 = acc[ai][bj][m][1];
                    u32x4 w; w.x = pg8::cvt_pk_bf16(v0[0], v0[1]); w.y = pg8::cvt_pk_bf16(v0[2], v0[3]); w.z = pg8::cvt_pk_bf16(v1[0], v1[1]); w.w = pg8::cvt_pk_bf16(v1[2], v1[3]);
                    *(u32x4*)(VTG + (size_t)(chunk * 4 + h) * 16384 + (((e >> 4) * 2 + (l >> 5)) * 64 + ((l >> 3) & 3) * 16 + (e & 15)) * 8) = w; } }
    }
};
struct EpiCombo {
    static constexpr bool PERM = true; static constexpr int HOOK_T = -1;
    EpiOut eo; EpiProj ep; EpiVT ev; EpiMergeAB<false> ea; EpiMergeAB<true> eb;
    __device__ __forceinline__ void operator()(const f32x4 (&acc)[2][2][4][2], const pg8::Unit& u, int wr, int wc, int fr, int fq) const {
        if (u.g == 1) ep(acc, u, wr, wc, fr, fq); else if (u.g == 2) ev(acc, u, wr, wc, fr, fq); else if (u.g == 3) ea(acc, u, wr, wc, fr, fq); else if (u.g == 4) eb(acc, u, wr, wc, fr, fq); else eo(acc, u, wr, wc, fr, fq);
    }
};

__device__ __forceinline__ void phase_gates(const Args& a, unsigned char* lds, int vcu, int G) {
    const int tid = opaque_tid(), lane = tid & 63, wave = tid >> 6;
    unsigned char* ws = a.ws;
    for (int gi = vcu; gi < NBATCH * 4; gi += G) {
        const int pass = gi >> 4, bl = (gi >> 2) & 3, h = gi & 3;
        const float* IG = (const float*)(ws + WS_IG); const float* FG = (const float*)(ws + WS_FG);
        float* gsc = (float*)(ws + WS_GSC + (size_t)pass * GSC_STRIDE);
        float* A1 = gsc, *B1 = gsc + MS * 4, *WI = gsc + 2 * MS * 4, *EF = gsc + 3 * MS * 4, *WK = gsc + 4 * MS * 4, *DEC = gsc + 5 * MS * 4;
        float* cg = (float*)lds; float* cp = cg + 64;
        __syncthreads();
        float f[8], ii[8];
#pragma unroll
        for (int q = 0; q < 8; ++q) { const size_t grow = (size_t)pass * MS + bl * SEQ + (wave * 8 + q) * 64 + lane; f[q] = FG[grow * 4 + h]; ii[q] = IG[grow * 4 + h]; }
        float acs[8], b1[8], pm[8];
#pragma unroll
        for (int q = 0; q < 8; ++q) {
            float x = fminf(f[q], 0.f) - log1pf(expf(-fabsf(f[q])));
#pragma unroll
            for (int o = 1; o < 64; o <<= 1) { const float t = __shfl_up(x, o); if (lane >= o) x += t; }
            acs[q] = x; b1[q] = ii[q] - x;
            float m = b1[q];
#pragma unroll
            for (int o = 1; o < 64; o <<= 1) { const float t = __shfl_up(m, o); if (lane >= o) m = fmaxf(m, t); }
            pm[q] = m;
            if (lane == 63) { cg[wave * 8 + q] = x; cp[wave * 8 + q] = m; }
        }
        __syncthreads();
        float m_prev = 0.f, mp[8], Ms8[8];
        for (int j = 0; j < 64; ++j) { const float Ms = fmaxf(m_prev, cp[j]);
#pragma unroll
            for (int q = 0; q < 8; ++q) if (j == wave * 8 + q) { mp[q] = m_prev; Ms8[q] = Ms; }
            m_prev = cg[j] + Ms; }
#pragma unroll
        for (int q = 0; q < 8; ++q) {
            const int j = wave * 8 + q, lrow = bl * SEQ + j * 64 + lane;
            const float mx = fmaxf(mp[q], pm[q]);
            A1[h * MS + lrow] = -mx; B1[h * MS + lrow] = b1[q]; WI[h * MS + lrow] = expf(mp[q] - mx); EF[h * MS + lrow] = expf(-(acs[q] + mx)); WK[h * MS + lrow] = expf(b1[q] - Ms8[q]);
            if (lane == 0) { DEC[h * (MS / 64) + bl * 64 + j] = expf(mp[q] - Ms8[q]); DEC[4 * (MS / 64) + h * (MS / 64) + bl * 64 + j] = Ms8[q]; }
        }
    }
}

__device__ __forceinline__ f32x4 mfma16(bf16x8 a, bf16x8 b, f32x4 c) { return __builtin_amdgcn_mfma_f32_16x16x32_bf16(a, b, c, 0, 0, 0); }

constexpr int TPS = 72;
constexpr int XCS = 264;
constexpr int L_QC_X = 0, L_QC_Q = 36864, L_QC_KT = L_QC_Q + 64 * XCS * 2, L_QC_ST = L_QC_KT + 256 * TPS * 2, L_QC_END = L_QC_ST + 64 * TPS * 2;
static_assert(64 * XCS * 2 <= 36864 && 256 * TPS * 2 <= 36864 && L_QC_END + 768 + 5120 <= 131072, "qkc lds");
#define CP_BAR() do { asm volatile("s_waitcnt lgkmcnt(0)" ::: "memory"); __builtin_amdgcn_s_barrier(); asm volatile("" ::: "memory"); } while (0)
__device__ __forceinline__ void cprep_fetch(const bf16* P, const float* gsc, int ci, int tid, u32x4 (&xr)[7], float& gw) {
    const int h = ci & 3, t0 = (ci >> 2) * 64, ch0 = h * 256 + 8 * (tid & 31);
    const bf16* p0 = P + ((ptrdiff_t)(t0 + 4 * (tid >> 5) - 3)) * INW + C_XA + ch0;
#pragma unroll
    for (int k = 0; k < 7; ++k) xr[k] = *(const u32x4*)(p0 + (ptrdiff_t)k * INW);
    const int wv = tid >> 6;
    gw = gsc[wv == 0 ? 4 * MS * 4 + h * MS + t0 + (tid & 63) : wv == 1 ? h * MS + t0 + (tid & 63) : 5 * MS * 4 + 4 * (MS / 64) + h * (MS / 64) + (ci >> 2)];
}
__device__ __forceinline__ void phase_cprep(const Args& a, unsigned char* lds, int vcu, int G, int pass) {
    const int tid = opaque_tid(), lane = tid & 63, wave = __builtin_amdgcn_readfirstlane(tid >> 6);
    const int fr = lane & 15, fq = lane >> 4;
    unsigned char* ws = a.ws;
    const bf16* P = (const bf16*)(ws + WS_P); bf16* XCW = (bf16*)(ws + WS_XC); bf16* QM = (bf16*)(ws + WS_QM);
    const bf16* WF = (const bf16*)(ws + WS_WQK);
    const float* gsc = (const float*)(ws + WS_GSC + (size_t)pass * GSC_STRIDE);
    bf16* SG = (bf16*)(ws + WS_SG); bf16* KTG = (bf16*)(ws + WS_KTG);
    bf16* XS = (bf16*)(lds + L_QC_X); bf16* QL = (bf16*)(lds + L_QC_Q); bf16* KT = (bf16*)(lds + L_QC_KT); bf16* ST = (bf16*)(lds + L_QC_ST);
    float* GL = (float*)(lds + L_QC_END);
    float* CWL = GL + 192;
    int hw = -1;
    bf16x8 wq0[8], wq1[8], wq2[8], wq3[8];
    const int ti = wave >> 1, tj0 = 2 * (wave & 1);
    constexpr int NITEMS = (MS / 64) * 4;
    u32x4 xr[7]; float gw = 0.f;
    cprep_fetch(P, gsc, vcu < NITEMS ? vcu : 0, tid, xr, gw);
    const int tid0 = tid;
    for (int ci = vcu; ci < NITEMS; ci += G) {
        int tid = tid0; asm volatile("" : "+v"(tid));
        const int lane = tid & 63, fr = lane & 15, fq = lane >> 4;
        const int h = ci & 3, t0 = (ci >> 2) * 64;
        const bool has_next = ci + G < NITEMS, seq0 = (t0 & (SEQ - 1)) == 0;
        if (h != hw) {
            CP_BAR();
            for (int idx = tid; idx < 1280; idx += NTHR) CWL[idx] = idx < 1024 ? a.w_conv[(idx >> 8) * 1024 + h * 256 + (idx & 255)] : a.b_conv[h * 256 + idx - 1024];
            CP_BAR();
            hw = h;
            const bf16* wf = WF + (size_t)h * 512 * 256;
#define CP_LOADW(dst, ct) do { _Pragma("unroll") for (int ks = 0; ks < 8; ++ks) dst[ks] = *(const bf16x8*)(wf + (size_t)(((4 * wave + (ct)) * 8 + ks) * 64 + lane) * 8); } while (0)
            CP_LOADW(wq0, 0); CP_LOADW(wq1, 1); CP_LOADW(wq2, 2); CP_LOADW(wq3, 3);
#undef CP_LOADW
        }
        CP_BAR();
        {
            const int cc = tid & 31, rg = tid >> 5, ch0 = h * 256 + 8 * cc;
            if (seq0 && rg == 0) { xr[0] = (u32x4){0u, 0u, 0u, 0u}; xr[1] = (u32x4){0u, 0u, 0u, 0u}; xr[2] = (u32x4){0u, 0u, 0u, 0u}; }
            float bc[8];
            { const f32x4 b0 = *(const f32x4*)(CWL + 1024 + 8 * cc), b1 = *(const f32x4*)(CWL + 1024 + 8 * cc + 4);
              bc[0] = b0[0]; bc[1] = b0[1]; bc[2] = b0[2]; bc[3] = b0[3]; bc[4] = b1[0]; bc[5] = b1[1]; bc[6] = b1[2]; bc[7] = b1[3]; }
            float y[4][8];
#pragma unroll
            for (int i = 0; i < 4; ++i)
#pragma unroll
                for (int e = 0; e < 8; ++e) y[i][e] = bc[e];
#pragma unroll
            for (int j = 0; j < 4; ++j) {
                float wc[8];
                { const f32x4 w0 = *(const f32x4*)(CWL + j * 256 + 8 * cc), w1 = *(const f32x4*)(CWL + j * 256 + 8 * cc + 4);
                  wc[0] = w0[0]; wc[1] = w0[1]; wc[2] = w0[2]; wc[3] = w0[3]; wc[4] = w1[0]; wc[5] = w1[1]; wc[6] = w1[2]; wc[7] = w1[3]; }
#pragma unroll
                for (int i = 0; i < 4; ++i) { float xv[8]; unpack8(xr[i + j], xv);
#pragma unroll
                    for (int e = 0; e < 8; ++e) y[i][e] += wc[e] * xv[e]; }
            }
#pragma unroll
            for (int i = 0; i < 4; ++i) {
                u32x4 o; o.x = pk2(siluf_(y[i][0]), siluf_(y[i][1])); o.y = pk2(siluf_(y[i][2]), siluf_(y[i][3])); o.z = pk2(siluf_(y[i][4]), siluf_(y[i][5])); o.w = pk2(siluf_(y[i][6]), siluf_(y[i][7]));
                *(u32x4*)(XCW + (size_t)(t0 + 4 * rg + i) * 1024 + ch0) = o;
                *(u32x4*)(XS + (4 * rg + i) * XCS + 8 * cc) = o; }
        }
        if (tid < 192) GL[tid] = gw;
        CP_BAR();
#define CP_PROJ(bq, ct) do { \
            _Pragma("unroll") for (int lt = 0; lt < 4; ++lt) { \
                f32x4 acc = {0.f, 0.f, 0.f, 0.f}; \
                _Pragma("unroll") for (int ks = 0; ks < 8; ++ks) { const bf16x8 af = *(const bf16x8*)(XS + (16 * lt + fr) * XCS + 32 * ks + 8 * fq); acc = mfma16(af, bq[ks], acc); } \
                if (wave < 4) { \
                    _Pragma("unroll") for (int i = 0; i < 4; ++i) QL[(16 * lt + 4 * fq + i) * XCS + 64 * wave + 16 * (ct) + fr] = (bf16)f2bf(acc[i]); \
                } else { \
                    const int d = 64 * (wave - 4) + 16 * (ct) + fr; const f32x4 wk4 = *(const f32x4*)(GL + 16 * lt + 4 * fq); \
                    u32x2 o; o.x = pk2(acc[0] * wk4[0], acc[1] * wk4[1]); o.y = pk2(acc[2] * wk4[2], acc[3] * wk4[3]); \
                    *(u32x2*)(KT + d * TPS + 16 * lt + 4 * fq) = o; \
                } } } while (0)
        __builtin_amdgcn_sched_barrier(0);
        cprep_fetch(P, gsc, has_next ? ci + G : ci, tid, xr, gw);
        __builtin_amdgcn_sched_barrier(0);
        CP_PROJ(wq0, 0); __builtin_amdgcn_sched_barrier(0); CP_PROJ(wq1, 1); __builtin_amdgcn_sched_barrier(0);
        CP_PROJ(wq2, 2); __builtin_amdgcn_sched_barrier(0); CP_PROJ(wq3, 3); __builtin_amdgcn_sched_barrier(0);
#undef CP_PROJ
        CP_BAR();
#pragma unroll
        for (int i = 0; i < 4; ++i) { const int c = tid + NTHR * i, row = c >> 5, cc = c & 31;
            *(u32x4*)(QM + (size_t)(t0 + row) * 1024 + h * 256 + 8 * cc) = *(const u32x4*)(QL + row * XCS + 8 * cc); }
        const f32x4 a1l = *(const f32x4*)(GL + 64 + 16 * ti + 4 * fq); const float msc = GL[128];
#pragma unroll
        for (int tt = 0; tt < 2; ++tt) {
            const int tj = tj0 + tt;
            f32x4 sacc = {0.f, 0.f, 0.f, 0.f};
            if (tj <= ti) {
#pragma unroll
                for (int ks = 0; ks < 8; ++ks) {
                    const bf16x8 qf = *(const bf16x8*)(QL + (16 * ti + fr) * XCS + 32 * ks + 8 * fq);
                    const bf16* kp = KT + (32 * ks + 8 * fq + (fr >> 2)) * TPS + 16 * tj + 4 * (fr & 3);
                    const s16x4 k0 = __builtin_amdgcn_ds_read_tr16_b64_v4i16((__attribute__((address_space(3))) s16x4*)(kp));
                    const s16x4 k1 = __builtin_amdgcn_ds_read_tr16_b64_v4i16((__attribute__((address_space(3))) s16x4*)(kp + 4 * TPS));
                    bf16x8 kb; kb[0] = k0[0]; kb[1] = k0[1]; kb[2] = k0[2]; kb[3] = k0[3]; kb[4] = k1[0]; kb[5] = k1[1]; kb[6] = k1[2]; kb[7] = k1[3];
                    sacc = mfma16(qf, kb, sacc); }
            }
            const int sidx = 16 * tj + fr;
#pragma unroll
            for (int i = 0; i < 4; ++i) { const int l = 16 * ti + 4 * fq + i;
                float v = 0.f;
                if (sidx <= l) v = sacc[i] * __expf(a1l[i] + msc);
                ST[l * TPS + sidx] = (bf16)f2bf(v); }
        }
        CP_BAR();
        { const int row = tid >> 3, ch = tid & 7; *(u32x4*)(SG + (size_t)ci * 4096 + row * 64 + 8 * ch) = *(const u32x4*)(ST + row * TPS + 8 * ch); }
#pragma unroll
        for (int i = 0; i < 4; ++i) { const int p = tid + NTHR * i, blk = p >> 6, ln = p & 63, row = (blk >> 1) * 16 + (ln & 15), ch = (blk & 1) * 4 + (ln >> 4);
            *(u32x4*)(KTG + (size_t)ci * 16384 + p * 8) = *(const u32x4*)(KT + row * TPS + 8 * ch); }
    }
    __syncthreads();
}

constexpr int SA_DEPTH = 5, SA_PATCH = 32 * 32 * 2 + 128;
struct ScanA { const bf16* KTG; const bf16* VTG; const float* gDEC; bf16* CS; float* NS; int bl, h, dblk, eblk, wave, fr, fq; unsigned koff, voff; bool do_den; };
struct ScanAOps { bf16x8 k[2][2], v[2][2]; float decay; };
__device__ __forceinline__ void scana_load(const ScanA& c, int j, ScanAOps& o) {
    const int ci = (c.bl * 64 + j) * 4 + c.h;
    const bf16* kb = c.KTG + (size_t)ci * 16384; const bf16* vb = c.VTG + (size_t)ci * 16384;
#pragma unroll
    for (int dt = 0; dt < 2; ++dt)
#pragma unroll
        for (int k2 = 0; k2 < 2; ++k2) o.k[dt][k2] = *(const bf16x8*)(kb + (c.koff + (unsigned)((dt * 2 + k2) * 512)));
#pragma unroll
    for (int et = 0; et < 2; ++et)
#pragma unroll
        for (int k2 = 0; k2 < 2; ++k2) o.v[et][k2] = *(const bf16x8*)(vb + (c.voff + (unsigned)((et * 2 + k2) * 512)));
    o.decay = c.gDEC[c.h * (MS / 64) + c.bl * 64 + j];
}
__device__ __forceinline__ void scana_step(const ScanA& c, unsigned char* lds, int j, f32x4 (&Cacc)[2][2], f32x4 (&Nacc)[2], const ScanAOps& o, const bf16x8 ones) {
    const int ci = (c.bl * 64 + j) * 4 + c.h;
    unsigned char* patch = lds + c.wave * SA_PATCH;
    const int lane = c.fq * 16 + c.fr;
    if ((j & 1) == 0) {
#pragma unroll
    for (int dt = 0; dt < 2; ++dt) {
#pragma unroll
        for (int et = 0; et < 2; ++et) { const f32x4 cc = Cacc[dt][et]; u32x2 w; w.x = pk2(cc[0], cc[1]); w.y = pk2(cc[2], cc[3]);
            *(u32x2*)(patch + (16 * et + c.fr) * 64 + (16 * dt + 4 * c.fq) * 2) = w; }
        if (c.do_den && c.fr == 0) *(f32x4*)(patch + 2048 + (16 * dt + 4 * c.fq) * 4) = Nacc[dt];
    }
    { bf16* cs = c.CS + (size_t)((c.bl * 32 + (j >> 1)) * 4 + c.h) * 65536 + (c.eblk * 8 + c.dblk) * 1024;
#pragma unroll
      for (int k = 0; k < 2; ++k) __builtin_nontemporal_store(*(const u32x4*)(patch + k * 1024 + lane * 16), (u32x4*)(cs + k * 512 + lane * 8));
      if (c.do_den && lane < 8) *(f32x4*)(c.NS + (size_t)ci * 256 + c.dblk * 32 + lane * 4) = *(const f32x4*)(patch + 2048 + lane * 16); }
    }
#pragma unroll
    for (int dt = 0; dt < 2; ++dt) {
#pragma unroll
        for (int et = 0; et < 2; ++et) {
            f32x4 cc = Cacc[dt][et] * o.decay;
#pragma unroll
            for (int k2 = 0; k2 < 2; ++k2) cc = mfma16(o.k[dt][k2], o.v[et][k2], cc);
            Cacc[dt][et] = cc;
        }
        if (c.do_den) {
            f32x4 cc = Nacc[dt] * o.decay;
#pragma unroll
            for (int k2 = 0; k2 < 2; ++k2) cc = mfma16(o.k[dt][k2], ones, cc);
            Nacc[dt] = cc;
        }
    }
}
__device__ __forceinline__ void scana_item(const Args& a, unsigned char* lds, int item, int pass) {
    const int tid = opaque_tid(), lane = tid & 63;
    unsigned char* ws = a.ws;
    ScanA c;
    c.wave = __builtin_amdgcn_readfirstlane(tid >> 6); c.fr = lane & 15; c.fq = lane >> 4;
    item = __builtin_amdgcn_readfirstlane(item);
    c.bl = item >> 5; c.h = (item >> 3) & 3; c.dblk = 2 * ((item >> 1) & 3) + (c.wave >> 2); c.eblk = 4 * (item & 1) + (c.wave & 3); c.do_den = (c.eblk == 0);
    c.koff = (unsigned)((4 * c.dblk) * 512 + lane * 8); c.voff = (unsigned)((4 * c.eblk) * 512 + lane * 8);
    c.KTG = (const bf16*)(ws + WS_KTG); c.VTG = (const bf16*)(ws + WS_VTG); c.gDEC = (const float*)(ws + WS_GSC + (size_t)pass * GSC_STRIDE) + 5 * MS * 4;
    c.CS = (bf16*)(ws + WS_CS); c.NS = (float*)(ws + WS_NS);
    f32x4 Cacc[2][2], Nacc[2];
#pragma unroll
    for (int x = 0; x < 2; ++x) { Nacc[x] = (f32x4){0.f, 0.f, 0.f, 0.f};
#pragma unroll
        for (int y = 0; y < 2; ++y) Cacc[x][y] = (f32x4){0.f, 0.f, 0.f, 0.f}; }
    bf16x8 ones;
    { const short ov = (c.fr == 0) ? (short)0x3F80 : (short)0;
#pragma unroll
      for (int e = 0; e < 8; ++e) ones[e] = ov; }
    ScanAOps o0, o1, o2, o3, o4;
    scana_load(c, 0, o0); scana_load(c, 1, o1); scana_load(c, 2, o2); scana_load(c, 3, o3); scana_load(c, 4, o4);
#define SA_STEP(jj, ob) do { scana_step(c, lds, (jj), Cacc, Nacc, ob, ones); __builtin_amdgcn_sched_barrier(0); scana_load(c, (jj) + SA_DEPTH < 64 ? (jj) + SA_DEPTH : 63, ob); __builtin_amdgcn_sched_barrier(0); } while (0)
#pragma nounroll
    for (int j = 0; j < 60; j += 5) { SA_STEP(j, o0); SA_STEP(j + 1, o1); SA_STEP(j + 2, o2); SA_STEP(j + 3, o3); SA_STEP(j + 4, o4); }
    SA_STEP(60, o0); SA_STEP(61, o1); SA_STEP(62, o2); SA_STEP(63, o3);
#undef SA_STEP
    asm volatile("s_waitcnt vmcnt(0)" ::: "memory");
}

constexpr int AKS = 136;
constexpr int L_AK = 0, L_AV = L_AK + 128 * AKS * 2, L_AP = L_AV + 128 * AKS * 2, L_ATT_END = L_AP + 8 * 16 * AKS * 2;
static_assert(L_ATT_END <= 131072, "attn lds");

__device__ __forceinline__ void attn_item(const Args& a, unsigned char* lds, int item) {
    const int tid = opaque_tid(), lane = tid & 63, wave = __builtin_amdgcn_readfirstlane(tid >> 6);
    const int fr = lane & 15, fq = lane >> 4;
    unsigned char* ws = a.ws;
    const int blk = item & 15, hh = (item >> 4) & 3, bl = (item >> 6) & 3, g = item >> 8;
    const int dil = g == 0 ? 1 : g == 1 ? 4 : 16, nb = 16 / dil;
    const int r = blk / nb, n2 = blk % nb;
    const int H = 4 * g + hh;
    const bf16* Qb = (const bf16*)(ws + WS_QKV) + ((size_t)H * MS + bl * SEQ + r * (SEQ / dil)) * 128;
    const bf16* Kb = Qb + (size_t)12 * MS * 128; const bf16* Vb = Qb + (size_t)24 * MS * 128;
    bf16* Ks = (bf16*)(lds + L_AK); bf16* VTs = (bf16*)(lds + L_AV); bf16* Pw = (bf16*)(lds + L_AP) + wave * 16 * AKS;
    const int rowbase = bl * SEQ + r;
    bf16* AO = (bf16*)(ws + WS_AO) + (size_t)g * MS * 512; float* LSE = (float*)(ws + WS_LSE) + (size_t)g * MS * 4;
    bf16x8 qf[4];
    f32x4 O[8];
    float mrow = -INFINITY, lrow = 0.f;
    const float scale = 0.08838834764831845f;
#define ATT_BAR() do { asm volatile("s_waitcnt lgkmcnt(0)" ::: "memory"); __builtin_amdgcn_s_barrier(); asm volatile("" ::: "memory"); } while (0)
    const int step0 = (n2 == 0 ? 1 : 0);
    u32x4 kreg[4], vreg[4];
#pragma unroll
    for (int i = 0; i < 4; ++i) { const int c = tid + NTHR * i, key = c >> 4, dc = c & 15;
        const int krow = 128 * (2 * n2 - 1 + step0) + key;
        kreg[i] = *(const u32x4*)(Kb + krow * 128 + 8 * dc); vreg[i] = *(const u32x4*)(Vb + krow * 128 + 8 * dc); }
#pragma nounroll
    for (int step = step0; step < 4; ++step) {
        const int half = step & 1, n = 2 * n2 + (step >> 1);
        if (step == step0 || step == 2) {
            const int qrow = 128 * n + 16 * wave + fr;
#pragma unroll
            for (int ks = 0; ks < 4; ++ks) qf[ks] = *(const bf16x8*)(Qb + qrow * 128 + 32 * ks + 8 * fq);
#pragma unroll
            for (int i = 0; i < 8; ++i) O[i] = (f32x4){0.f, 0.f, 0.f, 0.f};
            mrow = -INFINITY; lrow = 0.f;
        }
        if (step != 2) {
            ATT_BAR();
#pragma unroll
            for (int i = 0; i < 4; ++i) { const int c = tid + NTHR * i, key = c >> 4, dc = c & 15;
                *(u32x4*)(Ks + key * AKS + 8 * dc) = kreg[i]; *(u32x4*)(VTs + key * AKS + 8 * dc) = vreg[i]; }
            if (step < 3) {
#pragma unroll
                for (int i = 0; i < 4; ++i) { const int c = tid + NTHR * i, key = c >> 4, dc = c & 15;
                    const int krow = 128 * (2 * n2 + step) + key;
                    kreg[i] = *(const u32x4*)(Kb + krow * 128 + 8 * dc); vreg[i] = *(const u32x4*)(Vb + krow * 128 + 8 * dc); }
            }
            ATT_BAR();
        }
        f32x4 S[8];
        const int p = 16 * wave + fr;
        float mx = -INFINITY;
#pragma unroll
        for (int kt = 0; kt < 8; ++kt) {
            const bool act = half == 0 ? (kt >= wave) : (kt <= wave);
            f32x4 sacc = {0.f, 0.f, 0.f, 0.f};
            if (act) {
#pragma unroll
                for (int ks = 0; ks < 4; ++ks) { const bf16x8 kf = *(const bf16x8*)(Ks + (16 * kt + fr) * AKS + 32 * ks + 8 * fq); sacc = mfma16(kf, qf[ks], sacc); }
#pragma unroll
                for (int i = 0; i < 4; ++i) { const int kk = 16 * kt + 4 * fq + i; const bool ok = half == 0 ? (kk >= p) : (kk <= p);
                    const float v = ok ? sacc[i] * scale : -INFINITY; sacc[i] = v; mx = fmaxf(mx, v); }
            }
            S[kt] = sacc;
        }
        mx = fmaxf(mx, __shfl_xor(mx, 16)); mx = fmaxf(mx, __shfl_xor(mx, 32));
        const float mn = fmaxf(mrow, mx), alpha = __expf(mrow - mn); mrow = mn;
        float rs = 0.f;
        unsigned pk[8][2];
#pragma unroll
        for (int kt = 0; kt < 8; ++kt) {
            const bool act = half == 0 ? (kt >= wave) : (kt <= wave);
            if (act) { const float p0 = __expf(S[kt][0] - mn), p1 = __expf(S[kt][1] - mn), p2 = __expf(S[kt][2] - mn), p3 = __expf(S[kt][3] - mn);
                rs += (p0 + p1) + (p2 + p3); pk[kt][0] = pk2(p0, p1); pk[kt][1] = pk2(p2, p3); }
            else { pk[kt][0] = 0u; pk[kt][1] = 0u; }
        }
        rs += __shfl_xor(rs, 16); rs += __shfl_xor(rs, 32);
        lrow = lrow * alpha + rs;
        float al[4];
#pragma unroll
        for (int i = 0; i < 4; ++i) al[i] = __shfl(alpha, 4 * fq + i);
#pragma unroll
        for (int dtile = 0; dtile < 8; ++dtile)
#pragma unroll
            for (int i = 0; i < 4; ++i) O[dtile][i] *= al[i];
#pragma unroll
        for (int ks = 0; ks < 4; ++ks) {
            const bool act = half == 0 ? (2 * ks + 1 >= wave) : (2 * ks <= wave);
            if (act) {
                u32x4 pw; pw.x = pk[2 * ks][0]; pw.y = pk[2 * ks][1]; pw.z = pk[2 * ks + 1][0]; pw.w = pk[2 * ks + 1][1];
                const bf16x8 pa = __builtin_bit_cast(bf16x8, pw);
#pragma unroll
                for (int dtile = 0; dtile < 8; ++dtile) {
                    const bf16* vp = VTs + (32 * ks + 4 * fq + (fr >> 2)) * AKS + 16 * dtile + 4 * (fr & 3);
                    const s16x4 v0 = __builtin_amdgcn_ds_read_tr16_b64_v4i16((__attribute__((address_space(3))) s16x4*)(vp));
                    const s16x4 v1 = __builtin_amdgcn_ds_read_tr16_b64_v4i16((__attribute__((address_space(3))) s16x4*)(vp + 16 * AKS));
                    bf16x8 vb; vb[0] = v0[0]; vb[1] = v0[1]; vb[2] = v0[2]; vb[3] = v0[3]; vb[4] = v1[0]; vb[5] = v1[1]; vb[6] = v1[2]; vb[7] = v1[3];
                    O[dtile] = mfma16(pa, vb, O[dtile]); }
            }
        }
        if (half == 1)
        {
            const float inv_l = 1.f / lrow;
            float il[4];
    #pragma unroll
            for (int i = 0; i < 4; ++i) il[i] = __shfl(inv_l, 4 * fq + i);
    #pragma unroll
            for (int dtile = 0; dtile < 8; ++dtile)
    #pragma unroll
                for (int i = 0; i < 4; ++i) Pw[(4 * fq + i) * AKS + 16 * dtile + fr] = (bf16)f2bf(O[dtile][i] * il[i]);
            if (fq == 0) { const size_t row = (size_t)(rowbase + (128 * n + 16 * wave + fr) * dil); LSE[(size_t)hh * MS + row] = mrow + logf(lrow); }
    #pragma unroll
            for (int k = 0; k < 4; ++k) { const int c = lane + 64 * k, q = c >> 4, ch = c & 15;
                const size_t row = (size_t)(rowbase + (128 * n + 16 * wave + q) * dil);
                *(u32x4*)(AO + row * 512 + hh * 128 + 8 * ch) = *(const u32x4*)(Pw + q * AKS + 8 * ch); }
        }
    }
    __syncthreads();
}

constexpr int N_SCAN_ITEMS = NB_PASS * 32, N_ATT_ITEMS = 3 * NB_PASS * 4 * 16;
#ifndef PROBE_ATT_REP
#define PROBE_ATT_REP 1
#endif
struct XcdBarrier;
__device__ __forceinline__ void xcd_barrier(const XcdBarrier& b);
__device__ __forceinline__ void phase_mix(const Args& a, unsigned char* lds, int pass, const XcdBarrier* pbar) {
    volatile int* slot = (volatile int*)(lds + 131072 + 1024);
#ifdef PROBE_SPLIT
    for (int it = blockIdx.x; it < N_SCAN_ITEMS; it += gridDim.x) scana_item(a, lds, it, pass);
    xcd_barrier(*pbar);
    for (int rep = 0; rep < PROBE_ATT_REP; ++rep)
    for (int it = blockIdx.x; it < N_ATT_ITEMS; it += gridDim.x) attn_item(a, lds, it);
#else
    if ((int)blockIdx.x < N_SCAN_ITEMS && gridDim.x >= (unsigned)N_SCAN_ITEMS) {
        const int x = blockIdx.x & 7, k = blockIdx.x >> 3, g = x + 8 * (k >> 3), m = k & 7;
        scana_item(a, lds, g * 8 + m, pass);
    } else if (gridDim.x < (unsigned)N_SCAN_ITEMS) { for (int it = blockIdx.x; it < N_SCAN_ITEMS; it += gridDim.x) scana_item(a, lds, it, pass); }
    constexpr int QN = N_ATT_ITEMS / 8;
    for (int qo = 0; qo < 8; ++qo) {
        const int qx = (int)((blockIdx.x + qo) & 7);
        unsigned* qc = (unsigned*)(a.ws + WS_CTL) + CW_QCTR + (pass * 8 + qx) * 64;
        for (;;) {
            __syncthreads();
            if (opaque_tid() == 0) *slot = (int)atomicAdd(qc, 1u);
            __syncthreads();
            const int L = *slot;
            if (L >= QN) break;
            attn_item(a, lds, ((L >> 3) * 8 + qx) * 8 + (L & 7));
        }
    }
#endif
}

constexpr int QS_STRIDE = 264, SS_STRIDE = 72;
constexpr int L_QS = 0, L_SS = L_QS + 64 * QS_STRIDE * 2, L_DENL = L_SS + 64 * SS_STRIDE * 2, L_WIL = L_DENL + 256, L_NUM = L_WIL + 256, L_SB_END = L_NUM + 64 * QS_STRIDE * 2;
static_assert(L_SB_END <= 131072, "scan-B lds");
constexpr int L_KTL = L_SB_END, L_XS = L_KTL + 256 * TPS * 2, L_SB2_END = L_XS + 64 * TPS * 2;
static_assert(L_SB2_END <= 131072, "scan-B lds");
struct SBCtx { const bf16* P; const bf16* XC; const bf16* QM; const bf16* SG; const bf16* VTG; const bf16* KTG; const bf16* CS; const float* NS; const float* gWI; const float* gEF; const float* gDEC; bf16* UM; int tid, lane, wave, fr, fq; };

__device__ __forceinline__ void scanb_tail(const Args& a, const SBCtx& c, const bf16* NUMS, const float* DENL, int h, int t0) {
    const int lane = c.lane, wave = c.wave, col = h * 256 + 4 * lane;
    const f32x4 gh = *(const f32x4*)(a.g_head + col), sk = *(const f32x4*)(a.skip + col);
#pragma unroll
    for (int hb = 0; hb < 2; ++hb) {
        u32x2 ow[4], zw[4], xw[4];
#pragma unroll
        for (int q = 0; q < 4; ++q) { const size_t r = (size_t)(t0 + 8 * wave + 4 * hb + q);
            ow[q] = *(const u32x2*)(c.P + r * INW + C_OA + col); zw[q] = *(const u32x2*)(c.P + r * INW + C_ZA + col); xw[q] = *(const u32x2*)(c.XC + r * 1024 + col); }
#pragma unroll
        for (int q = 0; q < 4; ++q) {
            const int l = 8 * wave + 4 * hb + q; const size_t r = (size_t)(t0 + l);
            const u32x2 hw = *(const u32x2*)(NUMS + l * QS_STRIDE + 4 * lane);
            const float rd = DENL[l];
            float hm[4] = {sigmoidf_(bflo(ow[q].x)) * bflo(hw.x) * rd, sigmoidf_(bfhi(ow[q].x)) * bfhi(hw.x) * rd, sigmoidf_(bflo(ow[q].y)) * bflo(hw.y) * rd, sigmoidf_(bfhi(ow[q].y)) * bfhi(hw.y) * rd};
            float ss = (hm[0] * hm[0] + hm[1] * hm[1]) + (hm[2] * hm[2] + hm[3] * hm[3]);
            ss = wave_sum(ss);
            const float rinv = 1.f / sqrtf(ss * (1.f / 256.f) + EPS);
            const float xc[4] = {bflo(xw[q].x), bfhi(xw[q].x), bflo(xw[q].y), bfhi(xw[q].y)}, za[4] = {bflo(zw[q].x), bfhi(zw[q].x), bflo(zw[q].y), bfhi(zw[q].y)};
            float o[4];
#pragma unroll
            for (int e = 0; e < 4; ++e) o[e] = (hm[e] * rinv * gh[e] + sk[e] * xc[e]) * siluf_(za[e]);
            u32x2 ov; ov.x = pk2(o[0], o[1]); ov.y = pk2(o[2], o[3]);
            *(u32x2*)(c.UM + r * 1024 + col) = ov;
        }
        __builtin_amdgcn_sched_barrier(0);
    }
}

__device__ __forceinline__ int scanb_run(const Args& a, unsigned char* lds, int vcu, int G, int pass) {
    SBCtx c;
    c.tid = opaque_tid(); c.lane = c.tid & 63; c.wave = __builtin_amdgcn_readfirstlane(c.tid >> 6); c.fr = c.lane & 15; c.fq = c.lane >> 4;
    unsigned char* ws = a.ws;
    c.P = (const bf16*)(ws + WS_P); c.XC = (const bf16*)(ws + WS_XC); c.QM = (const bf16*)(ws + WS_QM); c.SG = (const bf16*)(ws + WS_SG); c.VTG = (const bf16*)(ws + WS_VTG); c.KTG = (const bf16*)(ws + WS_KTG);
    c.CS = (const bf16*)(ws + WS_CS); c.NS = (const float*)(ws + WS_NS); { const float* gsc = (const float*)(ws + WS_GSC + (size_t)pass * GSC_STRIDE); c.gWI = gsc + 2 * MS * 4; c.gEF = gsc + 3 * MS * 4; c.gDEC = gsc + 5 * MS * 4; }
    c.UM = (bf16*)(ws + WS_ACAT);
    const int wave = c.wave;
    bf16* QS = (bf16*)(lds + L_QS); bf16* SS = (bf16*)(lds + L_SS); float* DENL = (float*)(lds + L_DENL); float* WIL = (float*)(lds + L_WIL); bf16* NUMS = (bf16*)(lds + L_NUM);
    bf16* KTL = (bf16*)(lds + L_KTL); bf16* XS = (bf16*)(lds + L_XS);
    unsigned* qc = (unsigned*)(ws + WS_CTL) + CW_QCTR + 2048 + pass * 64;
    volatile int* slot = (volatile int*)(lds + 131072 + 1024);
    constexpr int NITEMS = (MS / 128) * 4;
    bf16x8 ones;
    { const short ov = (c.fr == 0) ? (short)0x3F80 : (short)0;
#pragma unroll
      for (int e = 0; e < 8; ++e) ones[e] = ov; }
    int it = vcu;
    while (it < NITEMS) {
        { int t_ = c.tid; asm volatile("" : "+v"(t_)); c.tid = t_; c.lane = t_ & 63; c.fr = c.lane & 15; c.fq = c.lane >> 4; }
        const int tid = c.tid, lane = c.lane, fr = c.fr, fq = c.fq;
        const int h = it & 3, pr = it >> 2, chA = (2 * pr) * 4 + h, chB = chA + 4, tA = (2 * pr) * 64, tB = tA + 64;
        bf16x8 cb[2][8], vtA[2][2], vtB[2][2];
#pragma unroll
        for (int t = 0; t < 2; ++t) {
#pragma unroll
            for (int ks = 0; ks < 8; ++ks) cb[t][ks] = *(const bf16x8*)(c.CS + (size_t)it * 65536 + (wave * 8 + ks) * 1024 + (16 * t + fr) * 32 + 8 * fq);
#pragma unroll
            for (int k2 = 0; k2 < 2; ++k2) vtA[t][k2] = *(const bf16x8*)(c.VTG + (size_t)chA * 16384 + (((2 * wave + t) * 2 + k2) * 64 + lane) * 8);
        }
        const float decA = c.gDEC[h * (MS / 64) + 2 * pr];
        if (tid == 0) *slot = (int)atomicAdd(qc, 1u);
        __syncthreads();
#pragma unroll
        for (int i = 0; i < 4; ++i) { const int q = tid + NTHR * i, row = q >> 5, cc = q & 31; *(u32x4*)(QS + row * QS_STRIDE + 8 * cc) = *(const u32x4*)(c.QM + (size_t)(tA + row) * 1024 + h * 256 + 8 * cc); }
        { const int row = tid >> 3, cc = tid & 7; *(u32x4*)(SS + row * SS_STRIDE + 8 * cc) = *(const u32x4*)(c.SG + (size_t)chA * 4096 + row * 64 + 8 * cc); }
        if (tid < 64) WIL[tid] = c.gWI[h * MS + tA + tid];
#pragma unroll
        for (int i = 0; i < 4; ++i) { const int p = tid + NTHR * i, blk = p >> 6, ln = p & 63, row = (blk >> 1) * 16 + (ln & 15), ch8 = (blk & 1) * 4 + (ln >> 4);
            *(u32x4*)(KTL + row * TPS + 8 * ch8) = *(const u32x4*)(c.KTG + (size_t)chA * 16384 + p * 8); }
        __syncthreads();
        const int nit = G + *slot;
#pragma unroll
        for (int lt = 0; lt < 4; ++lt) {
            bf16x8 qf[8], sf[2];
#pragma unroll
            for (int ks = 0; ks < 8; ++ks) qf[ks] = *(const bf16x8*)(QS + (16 * lt + fr) * QS_STRIDE + 32 * ks + 8 * fq);
#pragma unroll
            for (int k2 = 0; k2 < 2; ++k2) sf[k2] = *(const bf16x8*)(SS + (16 * lt + fr) * SS_STRIDE + 32 * k2 + 8 * fq);
#pragma unroll
            for (int t = 0; t < 2; ++t) {
                f32x4 a1 = {0.f, 0.f, 0.f, 0.f}, a2 = {0.f, 0.f, 0.f, 0.f}, a3 = {0.f, 0.f, 0.f, 0.f};
#pragma unroll
                for (int k2 = 0; k2 < 2; ++k2) a1 = mfma16(sf[k2], vtA[t][k2], a1);
#pragma unroll
                for (int ks = 0; ks < 8; ks += 2) { a2 = mfma16(qf[ks], cb[t][ks], a2); a3 = mfma16(qf[ks + 1], cb[t][ks + 1], a3); }
#pragma unroll
                for (int i = 0; i < 4; ++i) NUMS[(16 * lt + 4 * fq + i) * QS_STRIDE + 32 * wave + 16 * t + fr] = (bf16)f2bf(a1[i] + WIL[16 * lt + 4 * fq + i] * (a2[i] + a3[i]));
            }
        }
        if (wave == 0) {
            bf16x8 nb[8];
#pragma unroll
            for (int ks = 0; ks < 8; ++ks) { const f32x4 n0 = *(const f32x4*)(c.NS + (size_t)chA * 256 + 32 * ks + 8 * fq), n1 = *(const f32x4*)(c.NS + (size_t)chA * 256 + 32 * ks + 8 * fq + 4);
                u32x4 w; w.x = pk2(n0[0], n0[1]); w.y = pk2(n0[2], n0[3]); w.z = pk2(n1[0], n1[1]); w.w = pk2(n1[2], n1[3]);
                if (fr != 0) w = (u32x4){0u, 0u, 0u, 0u};
                nb[ks] = __builtin_bit_cast(bf16x8, w); }
#pragma unroll
            for (int lt = 0; lt < 4; ++lt) {
                f32x4 a1 = {0.f, 0.f, 0.f, 0.f}, a2 = {0.f, 0.f, 0.f, 0.f};
#pragma unroll
                for (int k2 = 0; k2 < 2; ++k2) { const bf16x8 sf = *(const bf16x8*)(SS + (16 * lt + fr) * SS_STRIDE + 32 * k2 + 8 * fq); a1 = mfma16(sf, ones, a1); }
#pragma unroll
                for (int ks = 0; ks < 8; ++ks) { const bf16x8 qf = *(const bf16x8*)(QS + (16 * lt + fr) * QS_STRIDE + 32 * ks + 8 * fq); a2 = mfma16(qf, nb[ks], a2); }
                if (fr == 0) {
#pragma unroll
                    for (int i = 0; i < 4; ++i) { const int l = 16 * lt + 4 * fq + i; const float den = a1[i] + WIL[l] * a2[i]; DENL[l] = 1.f / fmaxf(fabsf(den), c.gEF[h * MS + tA + l]); } }
            }
        }
        __syncthreads();
#pragma unroll
        for (int i = 0; i < 4; ++i) { const int q = tid + NTHR * i, row = q >> 5, cc = q & 31; *(u32x4*)(QS + row * QS_STRIDE + 8 * cc) = *(const u32x4*)(c.QM + (size_t)(tB + row) * 1024 + h * 256 + 8 * cc); }
        { const int row = tid >> 3, cc = tid & 7; *(u32x4*)(SS + row * SS_STRIDE + 8 * cc) = *(const u32x4*)(c.SG + (size_t)chB * 4096 + row * 64 + 8 * cc); }
        scanb_tail(a, c, NUMS, DENL, h, tA);
#pragma unroll
        for (int t = 0; t < 2; ++t)
#pragma unroll
            for (int k2 = 0; k2 < 2; ++k2) vtB[t][k2] = *(const bf16x8*)(c.VTG + (size_t)chB * 16384 + (((2 * wave + t) * 2 + k2) * 64 + lane) * 8);
        __syncthreads();
        if (tid < 64) WIL[tid] = c.gWI[h * MS + tB + tid];
        {
            const int ti = wave >> 1;
            bf16x8 qf[8];
#pragma unroll
            for (int ks = 0; ks < 8; ++ks) qf[ks] = *(const bf16x8*)(QS + (16 * ti + fr) * QS_STRIDE + 32 * ks + 8 * fq);
#pragma unroll
            for (int tt = 0; tt < 2; ++tt) { const int tj = 2 * (wave & 1) + tt;
                f32x4 xacc = {0.f, 0.f, 0.f, 0.f};
#pragma unroll
                for (int ks = 0; ks < 8; ++ks) {
                    const bf16* kp = KTL + (32 * ks + 8 * fq + (fr >> 2)) * TPS + 16 * tj + 4 * (fr & 3);
                    const s16x4 k0 = __builtin_amdgcn_ds_read_tr16_b64_v4i16((__attribute__((address_space(3))) s16x4*)(kp));
                    const s16x4 k1 = __builtin_amdgcn_ds_read_tr16_b64_v4i16((__attribute__((address_space(3))) s16x4*)(kp + 4 * TPS));
                    bf16x8 kb; kb[0] = k0[0]; kb[1] = k0[1]; kb[2] = k0[2]; kb[3] = k0[3]; kb[4] = k1[0]; kb[5] = k1[1]; kb[6] = k1[2]; kb[7] = k1[3];
                    xacc = mfma16(qf[ks], kb, xacc); }
#pragma unroll
                for (int i = 0; i < 4; ++i) XS[(16 * ti + 4 * fq + i) * TPS + 16 * tj + fr] = (bf16)f2bf(xacc[i]); }
        }
        __syncthreads();
#pragma unroll
        for (int lt = 0; lt < 4; ++lt) {
            bf16x8 qf[8], sf[2], xf[2];
#pragma unroll
            for (int ks = 0; ks < 8; ++ks) qf[ks] = *(const bf16x8*)(QS + (16 * lt + fr) * QS_STRIDE + 32 * ks + 8 * fq);
#pragma unroll
            for (int k2 = 0; k2 < 2; ++k2) { sf[k2] = *(const bf16x8*)(SS + (16 * lt + fr) * SS_STRIDE + 32 * k2 + 8 * fq); xf[k2] = *(const bf16x8*)(XS + (16 * lt + fr) * TPS + 32 * k2 + 8 * fq); }
#pragma unroll
            for (int t = 0; t < 2; ++t) {
                f32x4 a1 = {0.f, 0.f, 0.f, 0.f}, a2 = {0.f, 0.f, 0.f, 0.f}, a3 = {0.f, 0.f, 0.f, 0.f}, a4 = {0.f, 0.f, 0.f, 0.f};
#pragma unroll
                for (int k2 = 0; k2 < 2; ++k2) { a1 = mfma16(sf[k2], vtB[t][k2], a1); a4 = mfma16(xf[k2], vtA[t][k2], a4); }
#pragma unroll
                for (int ks = 0; ks < 8; ks += 2) { a2 = mfma16(qf[ks], cb[t][ks], a2); a3 = mfma16(qf[ks + 1], cb[t][ks + 1], a3); }
#pragma unroll
                for (int i = 0; i < 4; ++i) NUMS[(16 * lt + 4 * fq + i) * QS_STRIDE + 32 * wave + 16 * t + fr] = (bf16)f2bf(a1[i] + WIL[16 * lt + 4 * fq + i] * (decA * (a2[i] + a3[i]) + a4[i]));
            }
        }
        if (wave == 0) {
            bf16x8 nb[8];
#pragma unroll
            for (int ks = 0; ks < 8; ++ks) { const f32x4 n0 = *(const f32x4*)(c.NS + (size_t)chA * 256 + 32 * ks + 8 * fq), n1 = *(const f32x4*)(c.NS + (size_t)chA * 256 + 32 * ks + 8 * fq + 4);
                u32x4 w; w.x = pk2(n0[0], n0[1]); w.y = pk2(n0[2], n0[3]); w.z = pk2(n1[0], n1[1]); w.w = pk2(n1[2], n1[3]);
                if (fr != 0) w = (u32x4){0u, 0u, 0u, 0u};
                nb[ks] = __builtin_bit_cast(bf16x8, w); }
#pragma unroll
            for (int lt = 0; lt < 4; ++lt) {
                f32x4 a1 = {0.f, 0.f, 0.f, 0.f}, a2 = {0.f, 0.f, 0.f, 0.f}, a4 = {0.f, 0.f, 0.f, 0.f};
#pragma unroll
                for (int k2 = 0; k2 < 2; ++k2) { const bf16x8 sf = *(const bf16x8*)(SS + (16 * lt + fr) * SS_STRIDE + 32 * k2 + 8 * fq); a1 = mfma16(sf, ones, a1);
                                                 const bf16x8 xf = *(const bf16x8*)(XS + (16 * lt + fr) * TPS + 32 * k2 + 8 * fq); a4 = mfma16(xf, ones, a4); }
#pragma unroll
                for (int ks = 0; ks < 8; ++ks) { const bf16x8 qf = *(const bf16x8*)(QS + (16 * lt + fr) * QS_STRIDE + 32 * ks + 8 * fq); a2 = mfma16(qf, nb[ks], a2); }
                if (fr == 0) {
#pragma unroll
                    for (int i = 0; i < 4; ++i) { const int l = 16 * lt + 4 * fq + i; const float den = a1[i] + WIL[l] * (decA * a2[i] + a4[i]); DENL[l] = 1.f / fmaxf(fabsf(den), c.gEF[h * MS + tB + l]); } }
            }
        }
        __syncthreads();
        scanb_tail(a, c, NUMS, DENL, h, tB);
        it = nit;
    }
    __syncthreads();
    if (vcu >= NITEMS) { if (opaque_tid() == 0) *slot = (int)atomicAdd(qc, 1u); __syncthreads(); it = G + *slot; __syncthreads(); }
    return it;
}

__device__ __forceinline__ void phase_post(const Args& a, unsigned char* lds, int vcu, int G, int pass) {
    int qi = scanb_run(a, lds, vcu, G, pass);
    const int tid = opaque_tid(), lane = tid & 63, wave = tid >> 6;
    unsigned char* ws = a.ws;
    const bf16* P = (const bf16*)(ws + WS_P);
    const bf16* AO = (const bf16*)(ws + WS_AO); const float* LSE = (const float*)(ws + WS_LSE); bf16* UA = (bf16*)(ws + WS_UA2);
    const int hh = lane >> 4, c = hh * 128 + 8 * (lane & 15);
    unsigned* qc = (unsigned*)(ws + WS_CTL) + CW_QCTR + 2048 + pass * 64;
    volatile int* slot = (volatile int*)(lds + 131072 + 1024);
    constexpr int NSB = (MS / 128) * 4, NCOMB = MS / 32;
    for (;;) {
        const int ci = qi - NSB;
        if (ci >= NCOMB) break;
        if (tid == 0) *slot = (int)atomicAdd(qc, 1u);
#pragma unroll 1
    for (int r0 = ci * 32 + 2 * wave; r0 < ci * 32 + 32; r0 += 16) {
        u32x4 o0[2], o1[2], o2[2], zb[2]; float l0[2], l1[2], l2[2];
#pragma unroll
        for (int q = 0; q < 2; ++q) { const size_t r = (size_t)(r0 + q);
            o0[q] = *(const u32x4*)(AO + r * 512 + c); o1[q] = *(const u32x4*)(AO + ((size_t)MS + r) * 512 + c); o2[q] = *(const u32x4*)(AO + ((size_t)2 * MS + r) * 512 + c);
            zb[q] = *(const u32x4*)(P + r * INW + C_ZB + c);
            l0[q] = LSE[(size_t)hh * MS + r]; l1[q] = LSE[(size_t)(4 + hh) * MS + r]; l2[q] = LSE[(size_t)(8 + hh) * MS + r]; }
#pragma unroll
        for (int q = 0; q < 2; ++q) {
            const float mx = fmaxf(l0[q], fmaxf(l1[q], l2[q]));
            float w0 = __expf(l0[q] - mx), w1 = __expf(l1[q] - mx), w2 = __expf(l2[q] - mx); const float inv = 1.f / (w0 + w1 + w2); w0 *= inv; w1 *= inv; w2 *= inv;
            float f0[8], f1[8], f2[8], z[8], o[8]; unpack8(o0[q], f0); unpack8(o1[q], f1); unpack8(o2[q], f2); unpack8(zb[q], z);
#pragma unroll
            for (int e = 0; e < 8; ++e) o[e] = (w0 * f0[e] + w1 * f1[e] + w2 * f2[e]) * siluf_(z[e]);
            u32x4 ov; ov.x = pk2(o[0], o[1]); ov.y = pk2(o[2], o[3]); ov.z = pk2(o[4], o[5]); ov.w = pk2(o[6], o[7]);
            *(u32x4*)(UA + (size_t)(r0 + q) * 1024 + c) = ov;
        }
    }
        __syncthreads();
        qi = G + *slot;
        __syncthreads();
    }
}

__device__ __forceinline__ void phase_norm(const Args& a, int vcu, int G) {
    const int tid = opaque_tid(), lane = tid & 63, wave = tid >> 6;
    const bf16* dl = (const bf16*)(a.ws + WS_H);
    for (int r0 = 2 * (vcu * NWAVES + wave); r0 < MALL; r0 += 2 * G * NWAVES) {
        f32x4 v[2][4]; u32x2 d[2][4]; float ss[2] = {0.f, 0.f};
#pragma unroll
        for (int q = 0; q < 2; ++q) { const f32x4* xr = (const f32x4*)(a.x + (size_t)(r0 + q) * DM) + lane; const u32x2* dr = (const u32x2*)(dl + (size_t)(r0 + q) * DM) + lane;
#pragma unroll
            for (int j = 0; j < 4; ++j) { v[q][j] = xr[64 * j]; d[q][j] = dr[64 * j]; } }
#pragma unroll
        for (int q = 0; q < 2; ++q)
#pragma unroll
            for (int j = 0; j < 4; ++j) { v[q][j] += (f32x4){bflo(d[q][j].x), bfhi(d[q][j].x), bflo(d[q][j].y), bfhi(d[q][j].y)};
                ss[q] += (v[q][j].x * v[q][j].x + v[q][j].y * v[q][j].y) + (v[q][j].z * v[q][j].z + v[q][j].w * v[q][j].w); }
#pragma unroll
        for (int o = 1; o < 64; o <<= 1) { ss[0] += __shfl_xor(ss[0], o); ss[1] += __shfl_xor(ss[1], o); }
#pragma unroll
        for (int q = 0; q < 2; ++q) { const float rinv = 1.f / sqrtf(ss[q] * (1.f / DM) + EPS);
#pragma unroll
            for (int j = 0; j < 4; ++j) { const f32x4 gf = *((const f32x4*)a.g_final + lane + 64 * j); *((f32x4*)(a.out + (size_t)(r0 + q) * DM) + lane + 64 * j) = v[q][j] * rinv * gf; } }
    }
}


#define LAS __attribute__((address_space(3)))
#define XB_TMO      128
#define XB_XCNT(j)  (256  + 64 * (j))
#define XB_XSUB(j)  (1280 + 64 * (j))
#define XB_XGEN(j)  (2304 + 64 * (j))
#define XB_TOP      3328
#define XB_TOPGEN   3392
#define XCD_BAR_WORDS 3456
#define XB_SPIN_CAP (1u << 22)
constexpr int CW_BAR = 4096;
__device__ __forceinline__ unsigned xb_ld(unsigned* p)              { return __hip_atomic_load(p, __ATOMIC_RELAXED, __HIP_MEMORY_SCOPE_AGENT); }
__device__ __forceinline__ unsigned xb_add(unsigned* p, unsigned v) { return __hip_atomic_fetch_add(p, v, __ATOMIC_RELAXED, __HIP_MEMORY_SCOPE_AGENT); }
__device__ __forceinline__ unsigned xb_xcc_id() { return (unsigned)__builtin_amdgcn_s_getreg((3 << 11) | 20) & 0xFu; }
#define XB_SPIN(cond, bar) do { unsigned _sp = 0; while (cond) { __builtin_amdgcn_s_sleep(1); \
    if ((++_sp & 255u) == 0u) { if (xb_ld(&(bar)[XB_TMO])) break; if (_sp > XB_SPIN_CAP) { atomicAdd(&(bar)[XB_TMO], 1u); break; } } } } while (0)
struct XcdBarrier { unsigned* bar; unsigned x; volatile LAS unsigned* st; };
__device__ __forceinline__ XcdBarrier xcd_barrier_post(unsigned* bar, volatile LAS unsigned* st) {
    XcdBarrier b; b.bar = bar; b.x = xb_xcc_id(); b.st = st;
    if (threadIdx.x == 0) (void)xb_add(&bar[XB_XCNT(b.x)], 1u);
    return b;
}
__device__ __forceinline__ void xcd_barrier_complete(unsigned* bar, unsigned x, unsigned& nloc, unsigned& nx) {
    const unsigned G = gridDim.x * gridDim.y * gridDim.z;
    unsigned sum, cnt, mine, sp = 0u;
    for (;;) {
        sum = 0u; cnt = 0u; mine = 0u;
#pragma unroll
        for (unsigned j = 0; j < 16; ++j) { const unsigned c = xb_ld(&bar[XB_XCNT(j)]); sum += c; cnt += (c > 0u) ? 1u : 0u; mine = (j == x) ? c : mine; }
        if (sum == G) break;
        __builtin_amdgcn_s_sleep(1);
        if ((++sp & 255u) == 0u) { if (xb_ld(&bar[XB_TMO])) break; if (sp > XB_SPIN_CAP) { atomicAdd(&bar[XB_TMO], 1u); break; } }
    }
    nloc = mine > 0u ? mine : 1u; nx = cnt > 0u ? cnt : 1u;
}
__device__ __forceinline__ void xcd_barrier(const XcdBarrier& b) {
    asm volatile("s_waitcnt vmcnt(0)" ::: "memory");
    __syncthreads();
    if (threadIdx.x == 0) {
        unsigned* bar = b.bar;
        __builtin_amdgcn_s_waitcnt(0);
        unsigned nloc = b.st[0], nx = b.st[1];
        if (nloc == 0u) { xcd_barrier_complete(bar, b.x, nloc, nx); b.st[0] = nloc; b.st[1] = nx; }
        const unsigned old = xb_add(&bar[XB_XSUB(b.x)], 1u);
        const unsigned gen = old / nloc;
        if (old + 1u == (gen + 1u) * nloc) {
            __builtin_amdgcn_fence(__ATOMIC_RELEASE, "agent");
            asm volatile("s_waitcnt vmcnt(0)" ::: "memory");
            const unsigned og = xb_add(&bar[XB_TOP], 1u);
            const unsigned tg = og / nx;
            if (og + 1u == (tg + 1u) * nx) xb_add(&bar[XB_TOPGEN], 1u);
            else XB_SPIN(xb_ld(&bar[XB_TOPGEN]) == tg, bar);
            __builtin_amdgcn_fence(__ATOMIC_ACQUIRE, "agent");
            xb_add(&bar[XB_XGEN(b.x)], 1u);
            asm volatile("s_waitcnt vmcnt(0)" ::: "memory");
        } else {
            XB_SPIN(xb_ld(&bar[XB_XGEN(b.x)]) == gen, bar);
            __builtin_amdgcn_fence(__ATOMIC_ACQUIRE, "agent");
            asm volatile("s_waitcnt vmcnt(0)" ::: "memory");
        }
    }
    __syncthreads();
}

constexpr int PH_PER_PASS = 5, PH_TOTAL = 4 + PH_PER_PASS * NPASS + 1;
#define PROBE_KIND_OF(k) ((k) == 0 ? K_CPREP : (k) == 1 ? K_MIX : (k) == 2 ? K_POST : (k) == 3 ? K_OUT1 : K_OUT2)
enum { K_PROLOGUE = 0, K_H = 1, K_INPROJ = 2, K_PREP = 3, K_QK = 4, K_MIX = 5, K_POST = 6, K_OUT1 = 7, K_OUT2 = 8, K_NORM = 9, K_CPREP = 10, K_OUT2IN = 12 };

__device__ __forceinline__ Args fresh_args() {
    Args a{};
#if defined(__HIP_DEVICE_COMPILE__)
    typedef const __attribute__((address_space(4))) unsigned long long* KP;
    KP q = (KP)__builtin_amdgcn_kernarg_segment_ptr(); asm volatile("" : "+s"(q));
    static_assert(sizeof(Args) == 22 * 8, "Args layout");
    unsigned long long w[22];
#pragma unroll
    for (int i = 0; i < 22; ++i) w[i] = q[i];
    __builtin_memcpy(&a, w, sizeof(Args));
#endif
    return a;
}
__device__ __forceinline__ void run_combo(const Args& args, unsigned char* lds, int pass, int mode) {
    const int G = gridDim.x; const int bx = blockIdx.x;
    unsigned char* ws = args.ws;
    const bool more = pass + 1 < NPASS;
    const int pp = mode == 0 ? 0 : pass + 1;
    int n1 = 0, nO = 0, nV = 0, npt = 0, pmode = 0;
    if (mode == 0) { nV = N_T256; npt = 40; }
    else if (mode == 1) { n1 = N_T256; if (more) { nV = N_T256; npt = 32; } }
    else { nO = N_T256; if (more) { npt = 8; pmode = 1; } }
    GemmCombo g{(const char*)ws, WS_H + (size_t)pp * MS * 2048};
    ComboOrder S; S.init(G, bx, n1, nO, nV, npt, pmode);
    EpiCombo E{EpiOut{(bf16*)(ws + WS_H), (const float*)(ws + WS_MOD) + 2048, pass * MS}, EpiProj{(bf16*)(ws + WS_P), (const float*)(ws + WS_ROPE) + (size_t)pp * MS * 32, (bf16*)(ws + WS_QKV)}, EpiVT{(bf16*)(ws + WS_VTG)},
               EpiMergeAB<false>{(const bf16*)(ws + WS_P), (bf16*)(ws + WS_MG)}, EpiMergeAB<true>{(const bf16*)(ws + WS_P), (bf16*)(ws + WS_MG)}};
    pg8::gemm_phase<EpiCombo, ComboOrder, true, true>((PG8_LAS unsigned char*)lds, g, S, E);
}
template <int KIND>
__device__ __forceinline__ void run_phase(const Args& args, unsigned char* lds, int pass, const XcdBarrier* pbar = nullptr) {
    const int G = gridDim.x; const int bx = blockIdx.x;
    const int vcu = (G % 8 == 0) ? (bx % 8) * (G / 8) + bx / 8 : bx;
    unsigned char* ws = args.ws;
    PG8_LAS unsigned char* lds3 = (PG8_LAS unsigned char*)lds;
    if constexpr (KIND == K_PROLOGUE) phase_prologue(args, lds, vcu, G);
    else if constexpr (KIND == K_H) phase_h(args, lds, vcu, G);
    else if constexpr (KIND == K_NORM) phase_norm(args, vcu, G);
    else if constexpr (KIND == K_INPROJ) {
        GemmCombo g{(const char*)ws, WS_H + (size_t)pass * MS * 2048};
        ComboOrder S; S.init(G, bx, 0, 0, N_T256, 40, 0);
        EpiCombo E{EpiOut{(bf16*)(ws + WS_H), (const float*)(ws + WS_MOD) + 2048, 0}, EpiProj{(bf16*)(ws + WS_P), (const float*)(ws + WS_ROPE) + (size_t)pass * MS * 32, (bf16*)(ws + WS_QKV)}, EpiVT{(bf16*)(ws + WS_VTG)}, EpiMergeAB<false>{(const bf16*)(ws + WS_P), (bf16*)(ws + WS_MG)}, EpiMergeAB<true>{(const bf16*)(ws + WS_P), (bf16*)(ws + WS_MG)}};
        pg8::gemm_phase<EpiCombo, ComboOrder, true, true>(lds3, g, S, E);
    } else if constexpr (KIND == K_PREP) phase_gates(args, lds, vcu, G);
    else if constexpr (KIND == K_QK) {
        pg8::Gemm<1024, 256, 256, 512, 512 * 256 * 2> g{(const bf16*)(ws + WS_XC), (const bf16*)(ws + WS_WQK)};
        pg8::GroupOrder S; S.init(MS, G, bx);
        EpiQK E{(bf16*)(ws + WS_QM), (bf16*)(ws + WS_KM)};
        pg8::gemm_phase<EpiQK, pg8::GroupOrder, true, true>(lds3, g, S, E);
    } else if constexpr (KIND == K_CPREP) phase_cprep(args, lds, vcu, G, pass);
    else if constexpr (KIND == K_MIX) phase_mix(args, lds, pass, pbar);
    else if constexpr (KIND == K_POST) phase_post(args, lds, vcu, G, pass);
    else if constexpr (KIND == K_OUT1) {
        const bool more = pass + 1 < NPASS;
        GemmCombo g{(const char*)ws, WS_H + (size_t)(pass + 1) * MS * 2048};
        ComboOrder S; S.init(G, bx, N_T256, 0, more ? N_T256 : 0, more ? 32 : 0, 0);
        EpiCombo E{EpiOut{(bf16*)(ws + WS_H), (const float*)(ws + WS_MOD) + 2048, pass * MS}, EpiProj{(bf16*)(ws + WS_P), (const float*)(ws + WS_ROPE) + (size_t)(pass + 1) * MS * 32, (bf16*)(ws + WS_QKV)}, EpiVT{(bf16*)(ws + WS_VTG)}, EpiMergeAB<false>{(const bf16*)(ws + WS_P), (bf16*)(ws + WS_MG)}, EpiMergeAB<true>{(const bf16*)(ws + WS_P), (bf16*)(ws + WS_MG)}};
        pg8::gemm_phase<EpiCombo, ComboOrder, true, true>(lds3, g, S, E);
    } else if constexpr (KIND == K_OUT2IN) {
        GemmCombo g{(const char*)ws, WS_H + (size_t)(pass + 1) * MS * 2048};
        ComboOrder S; S.init(G, bx, 0, N_T256, 0, 8, 1);
        EpiCombo E{EpiOut{(bf16*)(ws + WS_H), (const float*)(ws + WS_MOD) + 2048, pass * MS}, EpiProj{(bf16*)(ws + WS_P), (const float*)(ws + WS_ROPE) + (size_t)(pass + 1) * MS * 32, (bf16*)(ws + WS_QKV)}, EpiVT{(bf16*)(ws + WS_VTG)}, EpiMergeAB<false>{(const bf16*)(ws + WS_P), (bf16*)(ws + WS_MG)}, EpiMergeAB<true>{(const bf16*)(ws + WS_P), (bf16*)(ws + WS_MG)}};
        pg8::gemm_phase<EpiCombo, ComboOrder, true, true>(lds3, g, S, E);
    } else if constexpr (KIND == K_OUT2) {
        pg8::Gemm<1024, 1024, 1024> g{(const bf16*)(ws + WS_MG), (const bf16*)(ws + WS_WO)};
        pg8::StaticOrder S; S.init(MS, 1024, G, bx);
        EpiOut E{(bf16*)(ws + WS_H), (const float*)(ws + WS_MOD) + 2048, pass * MS};
        pg8::gemm_phase<EpiOut, pg8::StaticOrder, true, true>(lds3, g, S, E);
    }
}

#if !MK_ONE_LAUNCH
template <int KIND>
__global__ void __launch_bounds__(NTHR, 2) k_phase(Args args) {
    extern __shared__ __attribute__((aligned(16))) unsigned char lds[];
    run_phase<KIND>(args, lds, args.ph_lo);
}
#else
__global__ void __launch_bounds__(NTHR, 2) mk_fwd(Args args) {
    extern __shared__ __attribute__((aligned(16))) unsigned char lds[];
    volatile LAS unsigned* misc = (volatile LAS unsigned*)((LAS unsigned char*)lds + 131072 + 2048);
    if (threadIdx.x < 16) misc[threadIdx.x] = 0u;
    __syncthreads();
    XcdBarrier bar = xcd_barrier_post((unsigned*)(args.ws + WS_CTL) + CW_BAR, misc + 8);
#ifdef PROBE_TMASK
    unsigned long long pr_acc = 0ull;
#endif
    for (int gp = args.ph_lo; gp < args.ph_hi; ++gp) {
#ifdef PROBE_TMASK
        const unsigned long long pr_t0 = __builtin_amdgcn_s_memrealtime();
        int pr_kind;
        if (gp == 0) pr_kind = K_PROLOGUE; else if (gp == 1) pr_kind = K_H; else if (gp == 2) pr_kind = K_PREP; else if (gp == 3) pr_kind = K_INPROJ; else if (gp == PH_TOTAL - 1) pr_kind = K_NORM;
        else { const int k = (gp - 4) % PH_PER_PASS; pr_kind = PROBE_KIND_OF(k); }
#endif
        int cmode = -1;
        if (gp == 3) cmode = 0;
        else if (gp > 3 && gp < PH_TOTAL - 1) { const int k = (gp - 4) % PH_PER_PASS; if (k == 3) cmode = 1; else if (k == 4) cmode = 2; }
        if (cmode >= 0) run_combo(args, lds, gp == 3 ? 0 : (gp - 4) / PH_PER_PASS, cmode);
        else if (gp == 0) run_phase<K_PROLOGUE>(args, lds, 0);
        else if (gp == 1) run_phase<K_H>(args, lds, 0);
        else if (gp == 2) run_phase<K_PREP>(args, lds, 0);
        else if (gp == PH_TOTAL - 1) run_phase<K_NORM>(args, lds, 0);
        else {
            const int pass = (gp - 4) / PH_PER_PASS, k = (gp - 4) % PH_PER_PASS;
            if (k == 0) run_phase<K_CPREP>(args, lds, pass);
            else if (k == 1) run_phase<K_MIX>(args, lds, pass, &bar);
            else if (k == 2) run_phase<K_POST>(args, lds, pass);
        }
#ifdef PROBE_TMASK
        const unsigned long long pr_tb = __builtin_amdgcn_s_memrealtime();
#endif
        if (gp + 1 < args.ph_hi) xcd_barrier(bar);
#ifdef PROBE_TMASK
        else __syncthreads();
        if ((PROBE_TMASK >> 11) & 1) pr_acc += __builtin_amdgcn_s_memrealtime() - pr_tb;
        if ((PROBE_TMASK >> pr_kind) & 1) pr_acc += __builtin_amdgcn_s_memrealtime() - pr_t0;
#endif
    }
#ifdef PROBE_TMASK
    if (blockIdx.x == 0) { const unsigned long long t1 = __builtin_amdgcn_s_memrealtime(); while (__builtin_amdgcn_s_memrealtime() - t1 < 4ull * pr_acc) __builtin_amdgcn_s_sleep(8); }
#endif
}
#endif

extern "C" void kernel_launch(void* const* d_in, const int* in_sizes, int n_in, void* d_out, int out_size, void* d_ws, size_t ws_size, hipStream_t stream) {
    static int grid = 0;
    if (grid == 0) {
        if (n_in != 19 || in_sizes[0] != MALL * DM || out_size != MALL * DM || ws_size < WS_END) { fprintf(stderr, "kernel_launch: unexpected shapes (n_in %d, ws %zu)\n", n_in, ws_size); grid = -1; return; }
        int dev = 0, cus = 0, per_cu = 0;
        (void)hipGetDevice(&dev); (void)hipDeviceGetAttribute(&cus, hipDeviceAttributeMultiprocessorCount, dev);
#if MK_ONE_LAUNCH
        (void)hipFuncSetAttribute((const void*)mk_fwd, hipFuncAttributeMaxDynamicSharedMemorySize, LDS_BYTES);
        (void)hipOccupancyMaxActiveBlocksPerMultiprocessor(&per_cu, (const void*)mk_fwd, NTHR, LDS_BYTES);
        if (per_cu < 1) { fprintf(stderr, "kernel_launch: occupancy query says %d\n", per_cu); per_cu = 1; }
#else
#define SETATTR(KIND) (void)hipFuncSetAttribute((const void*)k_phase<KIND>, hipFuncAttributeMaxDynamicSharedMemorySize, LDS_BYTES)
        SETATTR(K_PROLOGUE); SETATTR(K_H); SETATTR(K_INPROJ); SETATTR(K_PREP); SETATTR(K_QK); SETATTR(K_MIX); SETATTR(K_POST); SETATTR(K_OUT1); SETATTR(K_OUT2); SETATTR(K_NORM); SETATTR(K_CPREP); SETATTR(K_OUT2IN);
        (void)per_cu;
#endif
        (void)hipGetLastError();
        grid = cus;
        if (N_T256 % grid != 0) { int g2 = 1; while (g2 * 2 <= cus && N_T256 % (g2 * 2) == 0) g2 *= 2; grid = g2; }
    }
    if (grid < 0) return;
    (void)hipMemsetAsync((char*)d_ws + WS_CTL, 0, CTL_ZERO_BYTES, stream);
    Args a{};
    a.x = (const float*)d_in[0]; a.c = (const float*)d_in[1]; a.pos = (const int*)d_in[2]; a.w_ada = (const float*)d_in[3]; a.b_ada = (const float*)d_in[4];
    a.g_norm = (const float*)d_in[5]; a.w_in = (const float*)d_in[6]; a.b_ig = (const float*)d_in[7]; a.b_fg = (const float*)d_in[8]; a.w_conv = (const float*)d_in[9];
    a.b_conv = (const float*)d_in[10]; a.w_q = (const float*)d_in[11]; a.w_k = (const float*)d_in[12]; a.g_head = (const float*)d_in[13]; a.skip = (const float*)d_in[14];
    a.w_om = (const float*)d_in[15]; a.w_oa = (const float*)d_in[16]; a.w_o = (const float*)d_in[17]; a.g_final = (const float*)d_in[18];
    a.out = (float*)d_out; a.ws = (unsigned char*)d_ws;
#if MK_ONE_LAUNCH
    a.ph_lo = 0; a.ph_hi = PH_TOTAL;
    void* params[] = {&a};
    hipError_t e = hipLaunchCooperativeKernel((const void*)mk_fwd, dim3(grid), dim3(NTHR), params, LDS_BYTES, stream);
    if (e != hipSuccess) fprintf(stderr, "cooperative launch failed: %s\n", hipGetErrorString(e));
#else
#define LAUNCH(KIND, PASS) do { a.ph_lo = (PASS); a.ph_hi = 0; hipLaunchKernelGGL(k_phase<KIND>, dim3(grid), dim3(NTHR), LDS_BYTES, stream, a); } while (0)
    LAUNCH(K_PROLOGUE, 0); LAUNCH(K_H, 0);
    LAUNCH(K_PREP, 0); LAUNCH(K_INPROJ, 0);
    for (int p = 0; p < NPASS; ++p) { LAUNCH(K_CPREP, p); LAUNCH(K_MIX, p); LAUNCH(K_POST, p); LAUNCH(K_OUT1, p); if (p + 1 < NPASS) LAUNCH(K_OUT2IN, p); else LAUNCH(K_OUT2, p); }
    LAUNCH(K_NORM, 0);
#endif
}
```

```cpp
#include <hip/hip_runtime.h>
#include <hip/hip_cooperative_groups.h>
#include <cstdio>
#include <cstdint>
namespace cg = cooperative_groups;

#ifndef MK_ONE_LAUNCH
#define MK_ONE_LAUNCH 1
#endif

__device__ __forceinline__ int opaque_tid() { int t = threadIdx.x; asm volatile("" : "+v"(t)); return t; }
namespace pg8 {
#define PG8_LAS __attribute__((address_space(3)))
typedef unsigned short bf16_t;
typedef short bf16x8 __attribute__((ext_vector_type(8)));
typedef float f32x4 __attribute__((ext_vector_type(4)));
typedef unsigned u32x4 __attribute__((ext_vector_type(4)));
constexpr int BM = 256, BK = 64, HALF = 128, HTB = HALF * BK * 2, STAGE_BYTES = 8 * HTB, NXCD = 8, WGM = 8;

__host__ __device__ __forceinline__ int lds_byte(int r, int c) { const int st = (r >> 4) * 2 + (c >> 5), rr = r & 15, cc = c & 31, ob = rr * 64 + cc * 2; return st * 1024 + (ob ^ (((ob >> 9) & 1) << 5)); }
__host__ __device__ __forceinline__ void stage_rc(int b, int& R, int& C) { const int st = b / 1024, sb = b % 1024, swz = sb ^ (((sb >> 9) & 1) << 5); R = (st >> 1) * 16 + swz / 64; C = (st & 1) * 32 + (swz % 64) / 2; }
__host__ __device__ __forceinline__ int perm32(int rho) { const int n = rho >> 4, i = rho & 15; return 8 * (i >> 2) + 4 * n + (i & 3); }

struct Unit { int pm, pn, g; };
template <int LDA, int LDB, int KK, int AGS = 0, int BGS = 0> struct Gemm {
    const bf16_t* A; const bf16_t* Bt;
    static constexpr int lda = LDA, ldb = LDB, K = KK;
    __device__ __forceinline__ const char* abase(const Unit& u) const { return (const char*)A + (size_t)(u.g * AGS) + (size_t)u.pm * (size_t)(BM * 2 * LDA); }
    __device__ __forceinline__ const char* bbase(const Unit& u) const { return (const char*)Bt + (size_t)(u.g * BGS) + (size_t)u.pn * (size_t)(BM * 2 * LDB); }
};

struct StaticOrder {
    int nM, nN, nwg, G, c;
    __host__ __device__ void init(int M, int N, int G_, int c_) { nM = M / BM; nN = N / BM; nwg = nM * nN; G = G_; c = c_; }
    __host__ __device__ bool next(int i, Unit& u) const {
        const long L = (long)i * G + c; if (L >= nwg) return false;
        int wgid = (int)L; { const int q = nwg / NXCD, r = nwg % NXCD, xcd = wgid % NXCD, off = wgid / NXCD; wgid = (xcd < r ? xcd * (q + 1) : r * (q + 1) + (xcd - r) * q) + off; }
        const int nig = WGM * nN, gid = wgid / nig, fm = gid * WGM, gsz = (nM - fm) < WGM ? (nM - fm) : WGM;
        u.pm = fm + ((wgid % nig) % gsz); u.pn = (wgid % nig) / gsz; u.g = 0; return true;
    }
    __device__ __forceinline__ void a_ready(const Unit&) const {}
    __device__ __forceinline__ void done(const Unit&) const {}
};
struct GroupOrder {
    int nunits, G, c;
    __host__ __device__ void init(int M, int G_, int c_) { nunits = (M / BM) * 8; G = G_; c = c_; }
    __host__ __device__ bool next(int i, Unit& u) const {
        const long L = (long)i * G + c; if (L >= nunits) return false;
        u.pm = (int)(L >> 3); u.g = (int)((L & 7) >> 1); u.pn = (int)(L & 1); return true;
    }
    __device__ __forceinline__ void a_ready(const Unit&) const {}
    __device__ __forceinline__ void done(const Unit&) const {}
};

__device__ __forceinline__ unsigned cvt_pk_bf16(float lo, float hi) { unsigned r; asm volatile("v_cvt_pk_bf16_f32 %0, %1, %2" : "=v"(r) : "v"(lo), "v"(hi)); return r; }

template <class Epi, class Sched, bool ALIGN_EPI, bool SP2, class GemmT>
__device__ __forceinline__ void gemm_phase(PG8_LAS unsigned char* lds, const GemmT g, const Sched& S, const Epi& E) {
    const int tid = opaque_tid(), wid = __builtin_amdgcn_readfirstlane(tid >> 6), lane = tid & 63, wr = wid >> 2, wc = wid & 3, fr = lane & 15, fq = lane >> 4;
    constexpr int K = GemmT::K, nt = K / BK;
    unsigned voffA[2], voffB[2];
#pragma unroll
    for (int i = 0; i < 2; ++i) { int R, C; stage_rc(tid * 16 + i * 8192, R, C); const int Rb = Epi::PERM ? (64 * (R >> 5) + perm32(R & 31)) : R;
        voffA[i] = (unsigned)(R * g.lda + C) * 2u; voffB[i] = (unsigned)(Rb * g.ldb + C) * 2u; }
    const size_t kstep = (size_t)(BK * 2);
    const size_t hstepA = (size_t)HALF * g.lda * 2, hstepB = (size_t)(Epi::PERM ? 32 : HALF) * g.ldb * 2;
    const unsigned ldsw = (unsigned)wid * 1024u;
    const int aoff = lds_byte(wr * 64 + fr, fq * 8), boff = lds_byte(wc * 32 + fr, fq * 8);
#define PG8_SA(b, h) (((b) * 2 + (h)) * HTB)
#define PG8_SB(b, h) ((4 + (b) * 2 + (h)) * HTB)
#define PG8_STAGE(bufoff, gbase, voff) do { _Pragma("unroll") for (int _i = 0; _i < 2; ++_i) \
        __builtin_amdgcn_global_load_lds((const unsigned*)((const char*)(gbase) + (voff)[_i]), (PG8_LAS unsigned*)(lds + (bufoff) + ldsw + _i * 8192), 16, 0, 0); } while (0)
#define PG8_LDA(dst, b, h) do { _Pragma("unroll") for (int m = 0; m < 4; ++m) _Pragma("unroll") for (int k = 0; k < 2; ++k) dst[m][k] = *(const PG8_LAS bf16x8*)(lds + PG8_SA(b, h) + aoff + m * 2048 + k * 1024); } while (0)
#define PG8_LDB(dst, b, h) do { _Pragma("unroll") for (int n = 0; n < 2; ++n) _Pragma("unroll") for (int k = 0; k < 2; ++k) dst[n][k] = *(const PG8_LAS bf16x8*)(lds + PG8_SB(b, h) + boff + n * 2048 + k * 1024); } while (0)
#define PG8_MMA(ai, bj, At, Bt) do { __builtin_amdgcn_s_setprio(1); _Pragma("unroll") for (int m = 0; m < 4; ++m) _Pragma("unroll") for (int n = 0; n < 2; ++n) _Pragma("unroll") for (int k = 0; k < 2; ++k) \
        acc[ai][bj][m][n] = __builtin_amdgcn_mfma_f32_16x16x32_bf16(Bt[n][k], At[m][k], acc[ai][bj][m][n], 0, 0, 0); __builtin_amdgcn_s_setprio(0); } while (0)
#define PG8_WAIT_V(n) asm volatile("s_waitcnt vmcnt(" #n ")" ::: "memory")
#define PG8_WAIT_L(n) asm volatile("s_waitcnt lgkmcnt(" #n ")" ::: "memory")
#define PG8_BAR __builtin_amdgcn_s_barrier()
#define PG8_SCHED __builtin_amdgcn_sched_barrier(0)
    Unit cur, nxt; int ui = 0;
    if (!S.next(0, cur)) return;
    f32x4 acc[2][2][4][2];
#pragma unroll
    for (int a = 0; a < 2; ++a)
#pragma unroll
        for (int b = 0; b < 2; ++b)
#pragma unroll
            for (int m = 0; m < 4; ++m)
#pragma unroll
                for (int n = 0; n < 2; ++n) acc[a][b][m][n] = (f32x4){0.f, 0.f, 0.f, 0.f};
    bf16x8 At[4][2], B0[2][2], B1[2][2];
    const char* cA = g.abase(cur); const char* cB = g.bbase(cur);
    S.a_ready(cur);
    if constexpr (SP2) {
        PG8_STAGE(PG8_SB(0, 0), cB, voffB); PG8_STAGE(PG8_SB(0, 1), cB + hstepB, voffB); PG8_STAGE(PG8_SA(0, 0), cA, voffA); PG8_STAGE(PG8_SA(0, 1), cA + hstepA, voffA);
        if (wr == 1) PG8_BAR;
        PG8_WAIT_V(2); PG8_BAR;
        PG8_STAGE(PG8_SB(1, 0), cB + kstep, voffB); PG8_STAGE(PG8_SA(1, 0), cA + kstep, voffA); PG8_STAGE(PG8_SB(1, 1), cB + hstepB + kstep, voffB);
        PG8_WAIT_V(6); PG8_BAR;
    } else {
        PG8_STAGE(PG8_SB(0, 0), cB, voffB); PG8_STAGE(PG8_SA(0, 0), cA, voffA); PG8_STAGE(PG8_SB(0, 1), cB + hstepB, voffB); PG8_STAGE(PG8_SA(0, 1), cA + hstepA, voffA);
        if (wr == 1) PG8_BAR;
        PG8_WAIT_V(4); PG8_BAR;
        PG8_STAGE(PG8_SB(1, 0), cB + kstep, voffB); PG8_STAGE(PG8_SA(1, 0), cA + kstep, voffA); PG8_STAGE(PG8_SB(1, 1), cB + hstepB + kstep, voffB);
        PG8_WAIT_V(6); PG8_BAR;
    }
    for (;;) {
        const bool has_next = S.next(ui + 1, nxt);
        const char* nA = has_next ? g.abase(nxt) : cA; const char* nB = has_next ? g.bbase(nxt) : cB;
#pragma nounroll
        for (int t = 0; t < nt; t += 2) {
            const bool last = (t == nt - 2);
            const char* a1 = cA + (size_t)(t + 1) * kstep;
            const char* a2 = last ? nA : cA + (size_t)(t + 2) * kstep; const char* b2 = last ? nB : cB + (size_t)(t + 2) * kstep;
            const char* a3 = a2 + kstep; const char* b3 = b2 + kstep;
            if (last && has_next) S.a_ready(nxt);
            if constexpr (Epi::HOOK_T >= 0) { if (t == Epi::HOOK_T) E.hook(acc, cur, wr, wc, fr, fq); }
            if constexpr (SP2) {
            PG8_LDB(B0, 0, 0); PG8_LDB(B1, 0, 1); PG8_SCHED; PG8_LDA(At, 0, 0); PG8_STAGE(PG8_SA(1, 1), a1 + hstepA, voffA);
            PG8_WAIT_V(8); PG8_WAIT_L(0); PG8_BAR; PG8_MMA(0, 0, At, B0); PG8_MMA(0, 1, At, B1); PG8_BAR; PG8_SCHED;
            PG8_LDA(At, 0, 1); PG8_STAGE(PG8_SB(0, 0), b2, voffB); PG8_STAGE(PG8_SB(0, 1), b2 + hstepB, voffB); PG8_STAGE(PG8_SA(0, 0), a2, voffA);
            PG8_WAIT_V(8); PG8_WAIT_L(0); PG8_BAR; PG8_MMA(1, 0, At, B0); PG8_MMA(1, 1, At, B1); PG8_BAR; PG8_SCHED;
            PG8_LDB(B0, 1, 0); PG8_LDB(B1, 1, 1); PG8_SCHED; PG8_LDA(At, 1, 0); PG8_STAGE(PG8_SA(0, 1), a2 + hstepA, voffA);
            PG8_WAIT_V(8); PG8_WAIT_L(0); PG8_BAR; PG8_MMA(0, 0, At, B0); PG8_MMA(0, 1, At, B1); PG8_BAR; PG8_SCHED;
            PG8_LDA(At, 1, 1); PG8_STAGE(PG8_SB(1, 0), b3, voffB); PG8_STAGE(PG8_SB(1, 1), b3 + hstepB, voffB); PG8_STAGE(PG8_SA(1, 0), a3, voffA);
            PG8_WAIT_V(8); PG8_WAIT_L(0); PG8_BAR; PG8_MMA(1, 0, At, B0); PG8_MMA(1, 1, At, B1); PG8_BAR; PG8_SCHED;
            } else {
            PG8_LDB(B0, 0, 0); PG8_SCHED; PG8_LDA(At, 0, 0); PG8_STAGE(PG8_SA(1, 1), a1 + hstepA, voffA);
            PG8_WAIT_L(8); PG8_BAR; PG8_WAIT_L(0); PG8_MMA(0, 0, At, B0); PG8_BAR; PG8_SCHED;
            PG8_LDB(B1, 0, 1); PG8_STAGE(PG8_SB(0, 0), b2, voffB);
            PG8_BAR; PG8_WAIT_L(0); PG8_MMA(0, 1, At, B1); PG8_BAR;
            PG8_LDA(At, 0, 1); PG8_STAGE(PG8_SA(0, 0), a2, voffA);
            PG8_BAR; PG8_WAIT_L(0); PG8_MMA(1, 0, At, B0); PG8_BAR; PG8_SCHED;
            PG8_STAGE(PG8_SB(0, 1), b2 + hstepB, voffB);
            PG8_WAIT_V(6); PG8_BAR; PG8_MMA(1, 1, At, B1); PG8_BAR;
            PG8_LDB(B0, 1, 0); PG8_SCHED; PG8_LDA(At, 1, 0); PG8_STAGE(PG8_SA(0, 1), a2 + hstepA, voffA);
            PG8_WAIT_L(8); PG8_BAR; PG8_WAIT_L(0); PG8_MMA(0, 0, At, B0); PG8_BAR; PG8_SCHED;
            PG8_LDB(B1, 1, 1); PG8_STAGE(PG8_SB(1, 0), b3, voffB);
            PG8_BAR; PG8_WAIT_L(0); PG8_MMA(0, 1, At, B1); PG8_BAR;
            PG8_LDA(At, 1, 1); PG8_STAGE(PG8_SA(1, 0), a3, voffA);
            PG8_BAR; PG8_WAIT_L(0); PG8_MMA(1, 0, At, B0); PG8_BAR; PG8_SCHED;
            PG8_STAGE(PG8_SB(1, 1), b3 + hstepB, voffB);
            PG8_WAIT_V(6); PG8_BAR; PG8_MMA(1, 1, At, B1); PG8_BAR;
            }
        }
        if constexpr (ALIGN_EPI) { if (wr == 0) PG8_BAR; }
        E(acc, cur, wr, wc, fr, fq); S.done(cur);
        if (!has_next) break;
#pragma unroll
        for (int a = 0; a < 2; ++a)
#pragma unroll
            for (int b = 0; b < 2; ++b)
#pragma unroll
                for (int m = 0; m < 4; ++m)
#pragma unroll
                    for (int n = 0; n < 2; ++n) acc[a][b][m][n] = (f32x4){0.f, 0.f, 0.f, 0.f};
        cur = nxt; cA = nA; cB = nB; ++ui;
        if constexpr (ALIGN_EPI) { if (wr == 1) PG8_BAR; }
    }
    PG8_WAIT_V(0);
    if constexpr (!ALIGN_EPI) { if (wr == 0) PG8_BAR; }
    PG8_BAR;
#undef PG8_SA
#undef PG8_SB
#undef PG8_STAGE
#undef PG8_LDA
#undef PG8_LDB
#undef PG8_MMA
#undef PG8_WAIT_V
#undef PG8_WAIT_L
#undef PG8_BAR
#undef PG8_SCHED
}
}

constexpr int NWAVES = 8, NTHR = 512;
constexpr int DM = 1024, NBATCH = 16, SEQ = 4096, MALL = NBATCH * SEQ;
constexpr int NB_PASS = 4, MS = NB_PASS * SEQ, NPASS = NBATCH / NB_PASS;
constexpr int INW_SRC = 11272, INW = 11264;
constexpr int C_XA = 0, C_VA = 1024, C_OA = 2048, C_ZA = 3072, C_QA = 4096, C_KA = 5632, C_VT = 7168, C_ZB = 8704, C_GA = 9216, C_GB = 10240;
constexpr float EPS = 1e-6f;

constexpr size_t MiB = 1u << 20;
constexpr size_t WS_CTL = 0, CTL_ZERO_BYTES = 1 * MiB;
constexpr size_t WS_MOD = 1 * MiB;
constexpr size_t WS_WG = 1 * MiB + 256 * 1024;
constexpr size_t WS_WIN = 2 * MiB;
constexpr size_t WS_WQK = 24 * MiB;
constexpr size_t WS_WOM = 25 * MiB, WS_WOA = 27 * MiB, WS_WO = 28 * MiB;
constexpr size_t WS_IG = 30 * MiB, WS_FG = 31 * MiB;
constexpr size_t WS_LSE = 34 * MiB;
constexpr size_t WS_DEN = 35 * MiB;
constexpr size_t WS_H = 36 * MiB;
constexpr size_t WS_P = 164 * MiB;
constexpr size_t WS_XC = 516 * MiB;
constexpr size_t WS_QM = 548 * MiB, WS_KM = WS_QM;
constexpr size_t WS_GSC = 580 * MiB, GSC_STRIDE = 2 * MiB;
constexpr size_t WS_AO = 588 * MiB;
constexpr size_t WS_ACAT = 636 * MiB;
constexpr size_t WS_MG = 684 * MiB;
constexpr size_t WS_SG = 716 * MiB;
constexpr size_t WS_KTG = 724 * MiB;
constexpr size_t WS_VTG = 756 * MiB;
constexpr size_t WS_CS = 788 * MiB;
constexpr size_t WS_NS = 852 * MiB;
constexpr size_t WS_ROPE = 853 * MiB;
constexpr size_t WS_QKV = 861 * MiB;
constexpr size_t WS_END = 1005 * MiB;
constexpr int CW_QCTR = 1024;
constexpr int CW_ROWSS = 65536;
static_assert((CW_ROWSS + MALL) * 4 <= (int)CTL_ZERO_BYTES, "ctl");

constexpr int LDS_BYTES = 147456;

typedef unsigned short bf16;
typedef float f32x4 __attribute__((ext_vector_type(4)));
typedef float f32x2 __attribute__((ext_vector_type(2)));
typedef short bf16x8 __attribute__((ext_vector_type(8)));
typedef unsigned u32x4 __attribute__((ext_vector_type(4)));
typedef unsigned u32x2 __attribute__((ext_vector_type(2)));
typedef short s16x4 __attribute__((ext_vector_type(4)));

__device__ __forceinline__ unsigned f2bf(float f) { unsigned u = __builtin_bit_cast(unsigned, f); return (u + 0x7fffu + ((u >> 16) & 1u)) >> 16; }
__device__ __forceinline__ unsigned pk2(float lo, float hi) { return f2bf(lo) | (f2bf(hi) << 16); }
__device__ __forceinline__ float bflo(unsigned w) { return __builtin_bit_cast(float, w << 16); }
__device__ __forceinline__ float bfhi(unsigned w) { return __builtin_bit_cast(float, w & 0xffff0000u); }
__device__ __forceinline__ float bf1(bf16 v) { return __builtin_bit_cast(float, (unsigned)v << 16); }
__device__ __forceinline__ float sigmoidf_(float x) { return 1.f / (1.f + __expf(-x)); }
__device__ __forceinline__ float siluf_(float x) { return x / (1.f + __expf(-x)); }
__device__ __forceinline__ float wave_sum(float v) {
#pragma unroll
    for (int o = 1; o < 64; o <<= 1) v += __shfl_xor(v, o);
    return v;
}
__device__ __forceinline__ void unpack8(const u32x4 w, float* f) {
    f[0] = bflo(w.x); f[1] = bfhi(w.x); f[2] = bflo(w.y); f[3] = bfhi(w.y); f[4] = bflo(w.z); f[5] = bfhi(w.z); f[6] = bflo(w.w); f[7] = bfhi(w.w);
}

struct Args {
    const float* x; const float* c; const int* pos; const float* w_ada; const float* b_ada; const float* g_norm; const float* w_in;
    const float* b_ig; const float* b_fg; const float* w_conv; const float* b_conv; const float* w_q; const float* w_k; const float* g_head;
    const float* skip; const float* w_om; const float* w_oa; const float* w_o; const float* g_final;
    float* out; unsigned char* ws; int ph_lo, ph_hi;
};

__device__ __forceinline__ void transpose_item(const float* W, int K, int Nsrc, int nblk, int src_col_off, bf16* WT, int ldt, int row_off, float scale, float* scr, int item, int lane, bool frag = false) {
    const int kb = item / nblk, nb = item % nblk, k0 = 64 * kb, n0 = 32 * nb;
#pragma unroll 8
    for (int i = 0; i < 32; ++i) { const int kk = 2 * i + (lane >> 5); scr[kk * 33 + (lane & 31)] = W[(size_t)(k0 + kk) * Nsrc + src_col_off + n0 + (lane & 31)]; }
    __builtin_amdgcn_wave_barrier();
    asm volatile("s_waitcnt lgkmcnt(0)" ::: "memory");
    const int cc = lane & 7;
#pragma unroll
    for (int j = 0; j < 4; ++j) { const int n = (lane >> 3) + 8 * j; const float* s = scr + (8 * cc) * 33 + n;
        u32x4 o; o.x = pk2(s[0 * 33] * scale, s[1 * 33] * scale); o.y = pk2(s[2 * 33] * scale, s[3 * 33] * scale); o.z = pk2(s[4 * 33] * scale, s[5 * 33] * scale); o.w = pk2(s[6 * 33] * scale, s[7 * 33] * scale);
        if (frag) { const int nn = row_off + n0 + n, kc = (k0 >> 3) + cc; *(u32x4*)(WT + (size_t)((((nn >> 4) * (K >> 5) + (kc >> 2)) * 64 + (kc & 3) * 16 + (nn & 15)) * 8)) = o; }
        else *(u32x4*)(WT + (size_t)(row_off + n0 + n) * ldt + k0 + 8 * cc) = o; }
    asm volatile("s_waitcnt lgkmcnt(0)" ::: "memory");
    __builtin_amdgcn_wave_barrier();
}

__device__ __forceinline__ void phase_prologue(const Args& a, unsigned char* lds, int vcu, int G) {
    const int tid = opaque_tid(), lane = tid & 63, wave = tid >> 6;
    unsigned char* ws = a.ws;
    if (vcu < 192) {
        float* sc = (float*)lds;
        float* red = (float*)(lds + 65536);
        for (int i = tid; i < 16 * 1024; i += NTHR) sc[i] = siluf_(a.c[i]);
        __syncthreads();
        const int col = lane & 15, ksub = lane >> 4, n = vcu * 16 + col;
        float acc[16];
#pragma unroll
        for (int b = 0; b < 16; ++b) acc[b] = 0.f;
        const int k0 = wave * 128 + ksub * 32;
        const float* wp = a.w_ada + (size_t)k0 * 3072 + n;
#pragma unroll 1
        for (int kh = 0; kh < 4; ++kh) {
            const float* wq = wp + (size_t)(8 * kh) * 3072; const float* sq = sc + k0 + 8 * kh;
            float wv[8];
#pragma unroll
            for (int q = 0; q < 8; ++q) wv[q] = wq[q * 3072];
            __builtin_amdgcn_sched_barrier(0);
#pragma unroll
            for (int kq = 0; kq < 2; ++kq) {
#pragma unroll
                for (int b = 0; b < 16; ++b) { const f32x4 s4 = *(const f32x4*)(sq + b * 1024 + 4 * kq); acc[b] += (s4.x * wv[4 * kq] + s4.y * wv[4 * kq + 1]) + (s4.z * wv[4 * kq + 2] + s4.w * wv[4 * kq + 3]); }
                asm volatile("" ::: "memory"); __builtin_amdgcn_sched_barrier(0);
            }
        }
#pragma unroll
        for (int b = 0; b < 16; ++b) { float v = acc[b]; v += __shfl_xor(v, 16); v += __shfl_xor(v, 32); if (ksub == 0) red[(wave * 16 + b) * 16 + col] = v; }
        __syncthreads();
        float* mod = (float*)(ws + WS_MOD);
        if (tid < 256) { const int b = tid >> 4, l = tid & 15, nn = vcu * 16 + l; float s_ = 0.f;
#pragma unroll
            for (int w = 0; w < 8; ++w) s_ += red[(w * 16 + b) * 16 + l];
            s_ += a.b_ada[nn];
            const int part = nn >> 10, cc = nn & 1023;
            if (part == 1) s_ = a.g_norm[cc] * (1.f + s_);
            mod[b * 3072 + nn] = s_; }
        __syncthreads();
    }
    {
        float* scr = (float*)lds + wave * (64 * 33);
        const int gw = vcu * NWAVES + wave, NGW = G * NWAVES;
        constexpr int I_IN = (1024 / 64) * (INW / 32);
        constexpr int I_QK = 8 * (256 / 64) * (256 / 32);
        constexpr int I_OM = 16 * 32, I_OA = 8 * 32, I_O = 16 * 32;
        constexpr int NITEMS = I_IN + I_QK + I_OM + I_OA + I_O;
        for (int it = gw; it < NITEMS; it += NGW) {
            int r = it;
            if (r < I_IN) { const int nb = r % (INW / 32); const int off = (nb * 32 >= 4096) ? 8 : 0;
                transpose_item(a.w_in, 1024, INW_SRC, INW / 32, off, (bf16*)(ws + WS_WIN), 1024, 0, 1.f, scr, r, lane); continue; } r -= I_IN;
            if (r < I_QK) { const int mtx = r >> 5, rr = r & 31, h = mtx >> 1, isk = mtx & 1;
                const float* W = (isk ? a.w_k : a.w_q) + (size_t)h * 65536;
                transpose_item(W, 256, 256, 8, 0, (bf16*)(ws + WS_WQK) + (size_t)h * 512 * 256, 256, isk * 256, isk ? 0.0625f : 1.f, scr, rr, lane, true); continue; } r -= I_QK;
            if (r < I_OM) { transpose_item(a.w_om, 1024, 1024, 32, 0, (bf16*)(ws + WS_WOM), 1536, 0, 1.f, scr, r, lane); continue; } r -= I_OM;
            if (r < I_OA) { transpose_item(a.w_oa, 512, 1024, 32, 0, (bf16*)(ws + WS_WOM) + 1024, 1536, 0, 1.f, scr, r, lane); continue; } r -= I_OA;
            transpose_item(a.w_o, 1024, 1024, 32, 0, (bf16*)(ws + WS_WO), 1024, 0, 1.f, scr, r, lane);
        }
        float* wg = (float*)(ws + WS_WG);
        for (int i = (vcu * NTHR + tid); i < 8 * 1024; i += G * NTHR) { const int j = i >> 10, k = i & 1023; wg[i] = a.w_in[(size_t)k * INW_SRC + 4096 + j]; }
    }
}

__constant__ double c_inv_freq[16] = {1.0, 0.44036660267178046, 0.19392274474868576, 0.08539710028576561, 0.03760603093086393, 0.016560440080994446, 0.007292664737217109, 0.003211445994752591,
    0.001414213562373095, 0.000622772421914596, 0.0002742481756762073, 0.00012076973741146504, 5.318295896944988e-05, 2.341999896140934e-05, 1.031338537721246e-05, 4.5416704806078695e-06};

__device__ __forceinline__ void phase_h(const Args& a, unsigned char* lds, int vcu, int G) {
    const int tid = opaque_tid(), lane = tid & 63, wave = tid >> 6;
    unsigned char* ws = a.ws;
    float* wg = (float*)lds;
    { const float* src = (const float*)(ws + WS_WG); for (int i = tid; i < 8192; i += NTHR) wg[i] = src[i]; }
    __syncthreads();
    const float* mod = (const float*)(ws + WS_MOD);
    bf16* H = (bf16*)(ws + WS_H);
    float* IG = (float*)(ws + WS_IG); float* FG = (float*)(ws + WS_FG); float* ROPE = (float*)(ws + WS_ROPE);
    const int gw = vcu * NWAVES + wave, NGW = G * NWAVES;
    for (int row0 = 2 * gw; row0 < MALL; row0 += 2 * NGW) {
        f32x4 v[2][4]; float ss[2] = {0.f, 0.f};
#pragma unroll
        for (int rr = 0; rr < 2; ++rr) { const f32x4* xr = (const f32x4*)(a.x + (size_t)(row0 + rr) * DM) + lane;
#pragma unroll
            for (int j = 0; j < 4; ++j) v[rr][j] = xr[64 * j]; }
        { const int rr = lane >> 5, fi = lane & 15; const int pos = a.pos[row0 + rr];
            const double rev = (double)pos * c_inv_freq[fi] * 0.15915494309189535; const float fr_ = (float)(rev - rint(rev));
            ROPE[(size_t)row0 * 32 + lane] = (lane & 16) ? __builtin_amdgcn_sinf(fr_) : __builtin_amdgcn_cosf(fr_); }
#pragma unroll
        for (int rr = 0; rr < 2; ++rr) {
#pragma unroll
            for (int j = 0; j < 4; ++j) ss[rr] += (v[rr][j].x * v[rr][j].x + v[rr][j].y * v[rr][j].y) + (v[rr][j].z * v[rr][j].z + v[rr][j].w * v[rr][j].w);
        }
#pragma unroll
        for (int o = 1; o < 64; o <<= 1) { ss[0] += __shfl_xor(ss[0], o); ss[1] += __shfl_xor(ss[1], o); }
        const int b = row0 >> 12;
        float pg[2][8];
#pragma unroll
        for (int rr = 0; rr < 2; ++rr)
#pragma unroll
            for (int g = 0; g < 8; ++g) pg[rr][g] = 0.f;
        const float rinv[2] = {1.f / sqrtf(ss[0] * (1.f / DM) + EPS), 1.f / sqrtf(ss[1] * (1.f / DM) + EPS)};
#pragma unroll
        for (int j = 0; j < 4; ++j) {
            const int col = 4 * lane + 256 * j;
            const f32x4 sh = *(const f32x4*)(mod + b * 3072 + col), gs = *(const f32x4*)(mod + b * 3072 + 1024 + col);
            f32x4 h[2];
#pragma unroll
            for (int rr = 0; rr < 2; ++rr) { h[rr] = v[rr][j] * rinv[rr] * gs + sh;
                u32x2 o; o.x = pk2(h[rr].x, h[rr].y); o.y = pk2(h[rr].z, h[rr].w); *((u32x2*)(H + (size_t)(row0 + rr) * DM) + lane + 64 * j) = o; }
#pragma unroll
            for (int g = 0; g < 8; ++g) { const f32x4 w = *(const f32x4*)(wg + g * 1024 + col);
                pg[0][g] += (h[0].x * w.x + h[0].y * w.y) + (h[0].z * w.z + h[0].w * w.w); pg[1][g] += (h[1].x * w.x + h[1].y * w.y) + (h[1].z * w.z + h[1].w * w.w); }
            __builtin_amdgcn_sched_barrier(0);
        }
#pragma unroll
        for (int o = 1; o < 64; o <<= 1)
#pragma unroll
            for (int g = 0; g < 8; ++g) { pg[0][g] += __shfl_xor(pg[0][g], o); pg[1][g] += __shfl_xor(pg[1][g], o); }
        if (lane < 2) { const int rr = lane; const float* p = rr ? pg[1] : pg[0];
            f32x4 ig = {p[0] + a.b_ig[0], p[1] + a.b_ig[1], p[2] + a.b_ig[2], p[3] + a.b_ig[3]};
            f32x4 fg = {p[4] + a.b_fg[0], p[5] + a.b_fg[1], p[6] + a.b_fg[2], p[7] + a.b_fg[3]};
            *(f32x4*)(IG + (size_t)(row0 + rr) * 4) = ig; *(f32x4*)(FG + (size_t)(row0 + rr) * 4) = fg; }
    }
}

constexpr int GATE_COL = 4096;
struct EpiProj {
    static constexpr bool PERM = true; static constexpr int HOOK_T = -1;
    bf16* P; const float* rope; bf16* QKV;
    __device__ __forceinline__ void operator()(const f32x4 (&acc)[2][2][4][2], const pg8::Unit& u, int wr, int wc, int fr, int fq) const {
        const int row0 = u.pm * 256 + wr * 64 + fr, col0 = u.pn * 256 + wc * 64 + 8 * fq;
        const bool rot = (u.pn >= 16) && (u.pn < 28) && ((wc & 1) == 0);
        const bool att = (u.pn >= 16) && (u.pn < 34);
        const int hq = att ? (u.pn - 16) * 2 + (wc >> 1) : 0, lg = 2 * ((hq % 12) >> 2);
        const bool gat = u.pn >= 36;
        const int gq = gat ? (u.pm * 4 + ((u.pn - 36) & 3)) * 2 + ((u.pn - 36) >> 2) : 0;
#pragma unroll
        for (int ai = 0; ai < 2; ++ai)
#pragma unroll
            for (int m = 0; m < 4; ++m) { const int r = row0 + ai * 128 + m * 16; const int sq = r & (SEQ - 1);
                const int rq = (r & ~(SEQ - 1)) + ((sq & ((1 << lg) - 1)) << (12 - lg)) + (sq >> lg);
                bf16* rowp = att ? QKV + ((size_t)hq * MS + rq) * 128 + (wc & 1) * 64 + 8 * fq : P + (size_t)r * INW + col0;
                if (gat) rowp = P + (size_t)(gq * 16 + ai * 8 + m * 2) * INW + GATE_COL + (wr * 4 + wc) * 512 + (fq * 16 + fr) * 8;
#pragma unroll
                for (int bj = 0; bj < 2; ++bj) { f32x4 v0 = acc[ai][bj][m][0], v1 = acc[ai][bj][m][1];
                    if (bj == 0 && rot) {
                        const float* tp = rope + (size_t)r * 32 + 8 * (fq & 1);
                        const f32x4 c0 = *(const f32x4*)tp, c1 = *(const f32x4*)(tp + 4), s0 = *(const f32x4*)(tp + 16), s1 = *(const f32x4*)(tp + 20);
                        f32x4 p0, p1;
#pragma unroll
                        for (int e = 0; e < 4; ++e) { p0[e] = __shfl_xor(v0[e], 32); p1[e] = __shfl_xor(v1[e], 32); }
                        const float sg = (fq < 2) ? -1.f : 1.f;
                        v0 = v0 * c0 + p0 * s0 * sg; v1 = v1 * c1 + p1 * s1 * sg;
                    }
                    u32x4 w; w.x = pg8::cvt_pk_bf16(v0[0], v0[1]); w.y = pg8::cvt_pk_bf16(v0[2], v0[3]); w.z = pg8::cvt_pk_bf16(v1[0], v1[1]); w.w = pg8::cvt_pk_bf16(v1[2], v1[3]);
                    *(u32x4*)(rowp + (gat ? bj * INW : bj * 32)) = w; } }
    }
};
struct EpiQK {
    static constexpr bool PERM = true; static constexpr int HOOK_T = -1;
    bf16* QM; bf16* KM;
    __device__ __forceinline__ void operator()(const f32x4 (&acc)[2][2][4][2], const pg8::Unit& u, int wr, int wc, int fr, int fq) const {
        const int row0 = u.pm * 256 + wr * 64 + fr, col0 = u.g * 256 + wc * 64 + 8 * fq;
        bf16* base = u.pn ? KM : QM;
#pragma unroll
        for (int ai = 0; ai < 2; ++ai)
#pragma unroll
            for (int m = 0; m < 4; ++m) { bf16* rowp = base + (size_t)(row0 + ai * 128 + m * 16) * 1024 + col0;
#pragma unroll
                for (int bj = 0; bj < 2; ++bj) { const f32x4 v0 = acc[ai][bj][m][0], v1 = acc[ai][bj][m][1];
                    u32x4 w; w.x = pg8::cvt_pk_bf16(v0[0], v0[1]); w.y = pg8::cvt_pk_bf16(v0[2], v0[3]); w.z = pg8::cvt_pk_bf16(v1[0], v1[1]); w.w = pg8::cvt_pk_bf16(v1[2], v1[3]);
                    *(u32x4*)(rowp + bj * 32) = w; } }
    }
};
struct EpiMerge {
    static constexpr bool PERM = true; static constexpr int HOOK_T = 16;
    const bf16* P; bf16* MG;
    __device__ __forceinline__ void hook(f32x4 (&acc)[2][2][4][2], const pg8::Unit& u, int wr, int wc, int fr, int fq) const {
        int lo = (wr * 4 + wc) * 512 + (fq * 16 + fr) * 8; const int gq0 = (u.pm * 4 + u.pn) * 2;
        asm volatile("" : "+v"(lo));
#pragma unroll
        for (int ai = 0; ai < 2; ++ai)
#pragma unroll
            for (int m = 0; m < 4; ++m) {
#pragma unroll
                for (int bj = 0; bj < 2; ++bj) {
                    const bf16* gp = P + (size_t)(gq0 * 16 + ai * 8 + m * 2 + bj) * INW + GATE_COL + lo;
                    const u32x4 gaw = *(const u32x4*)gp, gbw = *(const u32x4*)(gp + 16 * INW);
                    float ga[8], gb[8]; unpack8(gaw, ga); unpack8(gbw, gb);
#pragma unroll
                    for (int e = 0; e < 4; ++e) {
                        acc[ai][bj][m][0][e] *= (1.f + __expf(-gb[e])) / (1.f + __expf(-ga[e]));
                        acc[ai][bj][m][1][e] *= (1.f + __expf(-gb[4 + e])) / (1.f + __expf(-ga[4 + e])); } }
                __builtin_amdgcn_sched_barrier(0); }
    }
    __device__ __forceinline__ void operator()(const f32x4 (&acc)[2][2][4][2], const pg8::Unit& u, int wr, int wc, int fr, int fq) const {
        const int row0 = u.pm * 256 + wr * 64 + fr, col0 = u.pn * 256 + wc * 64 + 8 * fq;
        const int lo = (wr * 4 + wc) * 512 + (fq * 16 + fr) * 8, gq0 = (u.pm * 4 + u.pn) * 2;
#pragma unroll
        for (int ai = 0; ai < 2; ++ai)
#pragma unroll
            for (int m = 0; m < 4; ++m) { const size_t r = (size_t)(row0 + ai * 128 + m * 16);
#pragma unroll
                for (int bj = 0; bj < 2; ++bj) { const int c = col0 + bj * 32;
                    const u32x4 gbw = *(const u32x4*)(P + (size_t)(gq0 * 16 + 16 + ai * 8 + m * 2 + bj) * INW + GATE_COL + lo); float gb[8]; unpack8(gbw, gb);
                    const f32x4 v0 = acc[ai][bj][m][0], v1 = acc[ai][bj][m][1];
                    float o[8];
#pragma unroll
                    for (int e = 0; e < 4; ++e) { o[e] = sigmoidf_(gb[e]) * v0[e]; o[4 + e] = sigmoidf_(gb[4 + e]) * v1[e]; }
                    u32x4 w; w.x = pg8::cvt_pk_bf16(o[0], o[1]); w.y = pg8::cvt_pk_bf16(o[2], o[3]); w.z = pg8::cvt_pk_bf16(o[4], o[5]); w.w = pg8::cvt_pk_bf16(o[6], o[7]);
                    *(u32x4*)(MG + r * 1024 + c) = w; } }
    }
};
struct EpiOut {
    static constexpr bool PERM = true; static constexpr int HOOK_T = -1;
    bf16* dl; const float* gate; int grow0;
    __device__ __forceinline__ void operator()(const f32x4 (&acc)[2][2][4][2], const pg8::Unit& u, int wr, int wc, int fr, int fq) const {
        const int row0 = grow0 + u.pm * 256 + wr * 64 + fr, col0 = u.pn * 256 + wc * 64 + 8 * fq;
        const int b = row0 >> 12;
#pragma unroll
        for (int ai = 0; ai < 2; ++ai)
#pragma unroll
            for (int m = 0; m < 4; ++m) { const int r = row0 + ai * 128 + m * 16;
#pragma unroll
                for (int bj = 0; bj < 2; ++bj) { const int c = col0 + bj * 32;
                    const float* gp = gate + b * 3072 + c; const f32x4 g0 = *(const f32x4*)gp, g1 = *(const f32x4*)(gp + 4);
                    const f32x4 o0 = g0 * acc[ai][bj][m][0], o1 = g1 * acc[ai][bj][m][1];
                    u32x4 w; w.x = pg8::cvt_pk_bf16(o0[0], o0[1]); w.y = pg8::cvt_pk_bf16(o0[2], o0[3]); w.z = pg8::cvt_pk_bf16(o1[0], o1[1]); w.w = pg8::cvt_pk_bf16(o1[2], o1[3]);
                    *(u32x4*)(dl + (size_t)r * 1024 + c) = w; } }
    }
};

struct ComboOrder {
    int nO, G, c;
    static constexpr int nV = (1024 / 256) * (MS / 256);
    __device__ void init(int G_, int c_, bool with_out2) { G = G_; c = c_; nO = with_out2 ? (MS / 256) * 4 : 0; }
    __device__ bool next(int i, pg8::Unit& u) const {
        const int L = i * G + c;
        pg8::StaticOrder o;
        if (L < nO) { o.init(MS, 1024, 1, 0); o.next(L, u); u.g = 0; return true; }
        if (L < nO + nV) { o.init(1024, MS, 1, 0); o.next(L - nO, u); u.g = 2; return true; }
        o.init(MS, INW - 1024, 1, 0);
        if (!o.next(L - nO - nV, u)) return false;
        if (u.pn >= 4) u.pn += 4;
        u.g = 1; return true;
    }
    __device__ __forceinline__ void a_ready(const pg8::Unit&) const {}
    __device__ __forceinline__ void done(const pg8::Unit&) const {}
};
struct GemmCombo {
    const char* ws; size_t hoff;
    static constexpr int lda = 1024, ldb = 1024, K = 1024;
    __device__ __forceinline__ const char* abase(const pg8::Unit& u) const {
        size_t off = WS_MG; if (u.g == 1) off = hoff; if (u.g == 2) off = WS_WIN + (size_t)C_VA * 2048;
        return ws + off + (size_t)u.pm * (size_t)(pg8::BM * 2 * 1024); }
    __device__ __forceinline__ const char* bbase(const pg8::Unit& u) const {
        size_t off = WS_WO; if (u.g == 1) off = WS_WIN; if (u.g == 2) off = hoff;
        return ws + off + (size_t)u.pn * (size_t)(pg8::BM * 2 * 1024); }
};
struct EpiVT {
    static constexpr bool PERM = true; static constexpr int HOOK_T = -1;
    bf16* VTG;
    __device__ __forceinline__ void operator()(const f32x4 (&acc)[2][2][4][2], const pg8::Unit& u, int wr, int wc, int fr, int fq) const {
        const int row0 = u.pm * 256 + wr * 64 + fr, col0 = u.pn * 256 + wc * 64 + 8 * fq;
#pragma unroll
        for (int ai = 0; ai < 2; ++ai)
#pragma unroll
            for (int m = 0; m < 4; ++m) { const int r = row0 + ai * 128 + m * 16, h = r >> 8, e = r & 255;
#pragma unroll
                for (int bj = 0; bj < 2; ++bj) { const int c = col0 + bj * 32, chunk = c >> 6, l = c & 63;
                    const f32x4 v0 = acc[ai][bj][m][0], v1 = acc[ai][bj][m][1];
                    u32x4 w; w.x = pg8::cvt_pk_bf16(v0[0], v0[1]); w.y = pg8::cvt_pk_bf16(v0[2], v0[3]); w.z = pg8::cvt_pk_bf16(v1[0], v1[1]); w.w = pg8::cvt_pk_bf16(v1[2], v1[3]);
                    *(u32x4*)(VTG + (size_t)(chunk * 4 + h) * 16384 + (((e >> 4) * 2 + (l >> 5)) * 64 + ((l >> 3) & 3) * 16 + (e & 15)) * 8) = w; } }
    }
};
struct EpiCombo {
    static constexpr bool PERM = true; static constexpr int HOOK_T = -1;
    EpiOut eo; EpiProj ep; EpiVT ev;
    __device__ __forceinline__ void operator()(const f32x4 (&acc)[2][2][4][2], const pg8::Unit& u, int wr, int wc, int fr, int fq) const {
        if (u.g == 1) ep(acc, u, wr, wc, fr, fq); else if (u.g == 2) ev(acc, u, wr, wc, fr, fq); else eo(acc, u, wr, wc, fr, fq);
    }
};

__device__ __forceinline__ void phase_gates(const Args& a, unsigned char* lds, int vcu, int G) {
    const int tid = opaque_tid(), lane = tid & 63, wave = tid >> 6;
    unsigned char* ws = a.ws;
    for (int gi = vcu; gi < NBATCH * 4; gi += G) {
        const int pass = gi >> 4, bl = (gi >> 2) & 3, h = gi & 3;
        const float* IG = (const float*)(ws + WS_IG); const float* FG = (const float*)(ws + WS_FG);
        float* gsc = (float*)(ws + WS_GSC + (size_t)pass * GSC_STRIDE);
        float* A1 = gsc, *B1 = gsc + MS * 4, *WI = gsc + 2 * MS * 4, *EF = gsc + 3 * MS * 4, *WK = gsc + 4 * MS * 4, *DEC = gsc + 5 * MS * 4;
        float* cg = (float*)lds; float* cp = cg + 64;
        __syncthreads();
        float f[8], ii[8];
#pragma unroll
        for (int q = 0; q < 8; ++q) { const size_t grow = (size_t)pass * MS + bl * SEQ + (wave * 8 + q) * 64 + lane; f[q] = FG[grow * 4 + h]; ii[q] = IG[grow * 4 + h]; }
        float acs[8], b1[8], pm[8];
#pragma unroll
        for (int q = 0; q < 8; ++q) {
            float x = fminf(f[q], 0.f) - log1pf(expf(-fabsf(f[q])));
#pragma unroll
            for (int o = 1; o < 64; o <<= 1) { const float t = __shfl_up(x, o); if (lane >= o) x += t; }
            acs[q] = x; b1[q] = ii[q] - x;
            float m = b1[q];
#pragma unroll
            for (int o = 1; o < 64; o <<= 1) { const float t = __shfl_up(m, o); if (lane >= o) m = fmaxf(m, t); }
            pm[q] = m;
            if (lane == 63) { cg[wave * 8 + q] = x; cp[wave * 8 + q] = m; }
        }
        __syncthreads();
        float m_prev = 0.f, mp[8], Ms8[8];
        for (int j = 0; j < 64; ++j) { const float Ms = fmaxf(m_prev, cp[j]);
#pragma unroll
            for (int q = 0; q < 8; ++q) if (j == wave * 8 + q) { mp[q] = m_prev; Ms8[q] = Ms; }
            m_prev = cg[j] + Ms; }
#pragma unroll
        for (int q = 0; q < 8; ++q) {
            const int j = wave * 8 + q, lrow = bl * SEQ + j * 64 + lane;
            const float mx = fmaxf(mp[q], pm[q]);
            A1[h * MS + lrow] = -mx; B1[h * MS + lrow] = b1[q]; WI[h * MS + lrow] = expf(mp[q] - mx); EF[h * MS + lrow] = expf(-(acs[q] + mx)); WK[h * MS + lrow] = expf(b1[q] - Ms8[q]);
            if (lane == 0) { DEC[h * (MS / 64) + bl * 64 + j] = expf(mp[q] - Ms8[q]); DEC[4 * (MS / 64) + h * (MS / 64) + bl * 64 + j] = Ms8[q]; }
        }
    }
}

__device__ __forceinline__ f32x4 mfma16(bf16x8 a, bf16x8 b, f32x4 c) { return __builtin_amdgcn_mfma_f32_16x16x32_bf16(a, b, c, 0, 0, 0); }

constexpr int TPS = 72;
constexpr int XCS = 264;
constexpr int L_QC_X = 0, L_QC_Q = 36864, L_QC_KT = L_QC_Q + 64 * XCS * 2, L_QC_ST = L_QC_KT + 256 * TPS * 2, L_QC_END = L_QC_ST + 64 * TPS * 2;
static_assert(64 * XCS * 2 <= 36864 && 256 * TPS * 2 <= 36864 && L_QC_END + 768 + 5120 <= 131072, "qkc lds");
#define CP_BAR() do { asm volatile("s_waitcnt lgkmcnt(0)" ::: "memory"); __builtin_amdgcn_s_barrier(); asm volatile("" ::: "memory"); } while (0)
__device__ __forceinline__ void cprep_fetch(const bf16* P, const float* gsc, int ci, int tid, u32x4 (&xr)[7], float& gw) {
    const int h = ci & 3, t0 = (ci >> 2) * 64, ch0 = h * 256 + 8 * (tid & 31);
    const bf16* p0 = P + ((ptrdiff_t)(t0 + 4 * (tid >> 5) - 3)) * INW + C_XA + ch0;
#pragma unroll
    for (int k = 0; k < 7; ++k) xr[k] = *(const u32x4*)(p0 + (ptrdiff_t)k * INW);
    const int wv = tid >> 6;
    gw = gsc[wv == 0 ? 4 * MS * 4 + h * MS + t0 + (tid & 63) : wv == 1 ? h * MS + t0 + (tid & 63) : 5 * MS * 4 + 4 * (MS / 64) + h * (MS / 64) + (ci >> 2)];
}
__device__ __forceinline__ void phase_cprep(const Args& a, unsigned char* lds, int vcu, int G, int pass) {
    const int tid = opaque_tid(), lane = tid & 63, wave = __builtin_amdgcn_readfirstlane(tid >> 6);
    const int fr = lane & 15, fq = lane >> 4;
    unsigned char* ws = a.ws;
    const bf16* P = (const bf16*)(ws + WS_P); bf16* XCW = (bf16*)(ws + WS_XC); bf16* QM = (bf16*)(ws + WS_QM);
    const bf16* WF = (const bf16*)(ws + WS_WQK);
    const float* gsc = (const float*)(ws + WS_GSC + (size_t)pass * GSC_STRIDE);
    bf16* SG = (bf16*)(ws + WS_SG); bf16* KTG = (bf16*)(ws + WS_KTG);
    bf16* XS = (bf16*)(lds + L_QC_X); bf16* QL = (bf16*)(lds + L_QC_Q); bf16* KT = (bf16*)(lds + L_QC_KT); bf16* ST = (bf16*)(lds + L_QC_ST);
    float* GL = (float*)(lds + L_QC_END);
    float* CWL = GL + 192;
    int hw = -1;
    bf16x8 wq0[8], wq1[8], wq2[8], wq3[8];
    const int ti = wave >> 1, tj0 = 2 * (wave & 1);
    constexpr int NITEMS = (MS / 64) * 4;
    u32x4 xr[7]; float gw = 0.f;
    cprep_fetch(P, gsc, vcu < NITEMS ? vcu : 0, tid, xr, gw);
    const int tid0 = tid;
    for (int ci = vcu; ci < NITEMS; ci += G) {
        int tid = tid0; asm volatile("" : "+v"(tid));
        const int lane = tid & 63, fr = lane & 15, fq = lane >> 4;
        const int h = ci & 3, t0 = (ci >> 2) * 64;
        const bool has_next = ci + G < NITEMS, seq0 = (t0 & (SEQ - 1)) == 0;
        if (h != hw) {
            CP_BAR();
            for (int idx = tid; idx < 1280; idx += NTHR) CWL[idx] = idx < 1024 ? a.w_conv[(idx >> 8) * 1024 + h * 256 + (idx & 255)] : a.b_conv[h * 256 + idx - 1024];
            CP_BAR();
            hw = h;
            const bf16* wf = WF + (size_t)h * 512 * 256;
#define CP_LOADW(dst, ct) do { _Pragma("unroll") for (int ks = 0; ks < 8; ++ks) dst[ks] = *(const bf16x8*)(wf + (size_t)(((4 * wave + (ct)) * 8 + ks) * 64 + lane) * 8); } while (0)
            CP_LOADW(wq0, 0); CP_LOADW(wq1, 1); CP_LOADW(wq2, 2); CP_LOADW(wq3, 3);
#undef CP_LOADW
        }
        CP_BAR();
        {
            const int cc = tid & 31, rg = tid >> 5, ch0 = h * 256 + 8 * cc;
            if (seq0 && rg == 0) { xr[0] = (u32x4){0u, 0u, 0u, 0u}; xr[1] = (u32x4){0u, 0u, 0u, 0u}; xr[2] = (u32x4){0u, 0u, 0u, 0u}; }
            float bc[8];
            { const f32x4 b0 = *(const f32x4*)(CWL + 1024 + 8 * cc), b1 = *(const f32x4*)(CWL + 1024 + 8 * cc + 4);
              bc[0] = b0[0]; bc[1] = b0[1]; bc[2] = b0[2]; bc[3] = b0[3]; bc[4] = b1[0]; bc[5] = b1[1]; bc[6] = b1[2]; bc[7] = b1[3]; }
            float y[4][8];
#pragma unroll
            for (int i = 0; i < 4; ++i)
#pragma unroll
                for (int e = 0; e < 8; ++e) y[i][e] = bc[e];
#pragma unroll
            for (int j = 0; j < 4; ++j) {
                float wc[8];
                { const f32x4 w0 = *(const f32x4*)(CWL + j * 256 + 8 * cc), w1 = *(const f32x4*)(CWL + j * 256 + 8 * cc + 4);
                  wc[0] = w0[0]; wc[1] = w0[1]; wc[2] = w0[2]; wc[3] = w0[3]; wc[4] = w1[0]; wc[5] = w1[1]; wc[6] = w1[2]; wc[7] = w1[3]; }
#pragma unroll
                for (int i = 0; i < 4; ++i) { float xv[8]; unpack8(xr[i + j], xv);
#pragma unroll
                    for (int e = 0; e < 8; ++e) y[i][e] += wc[e] * xv[e]; }
            }
#pragma unroll
            for (int i = 0; i < 4; ++i) {
                u32x4 o; o.x = pk2(siluf_(y[i][0]), siluf_(y[i][1])); o.y = pk2(siluf_(y[i][2]), siluf_(y[i][3])); o.z = pk2(siluf_(y[i][4]), siluf_(y[i][5])); o.w = pk2(siluf_(y[i][6]), siluf_(y[i][7]));
                *(u32x4*)(XCW + (size_t)(t0 + 4 * rg + i) * 1024 + ch0) = o;
                *(u32x4*)(XS + (4 * rg + i) * XCS + 8 * cc) = o; }
        }
        if (tid < 192) GL[tid] = gw;
        CP_BAR();
#define CP_PROJ(bq, ct) do { \
            _Pragma("unroll") for (int lt = 0; lt < 4; ++lt) { \
                f32x4 acc = {0.f, 0.f, 0.f, 0.f}; \
                _Pragma("unroll") for (int ks = 0; ks < 8; ++ks) { const bf16x8 af = *(const bf16x8*)(XS + (16 * lt + fr) * XCS + 32 * ks + 8 * fq); acc = mfma16(af, bq[ks], acc); } \
                if (wave < 4) { \
                    _Pragma("unroll") for (int i = 0; i < 4; ++i) QL[(16 * lt + 4 * fq + i) * XCS + 64 * wave + 16 * (ct) + fr] = (bf16)f2bf(acc[i]); \
                } else { \
                    const int d = 64 * (wave - 4) + 16 * (ct) + fr; const f32x4 wk4 = *(const f32x4*)(GL + 16 * lt + 4 * fq); \
                    u32x2 o; o.x = pk2(acc[0] * wk4[0], acc[1] * wk4[1]); o.y = pk2(acc[2] * wk4[2], acc[3] * wk4[3]); \
                    *(u32x2*)(KT + d * TPS + 16 * lt + 4 * fq) = o; \
                } } } while (0)
        __builtin_amdgcn_sched_barrier(0);
        cprep_fetch(P, gsc, has_next ? ci + G : ci, tid, xr, gw);
        __builtin_amdgcn_sched_barrier(0);
        CP_PROJ(wq0, 0); __builtin_amdgcn_sched_barrier(0); CP_PROJ(wq1, 1); __builtin_amdgcn_sched_barrier(0);
        CP_PROJ(wq2, 2); __builtin_amdgcn_sched_barrier(0); CP_PROJ(wq3, 3); __builtin_amdgcn_sched_barrier(0);
#undef CP_PROJ
        CP_BAR();
#pragma unroll
        for (int i = 0; i < 4; ++i) { const int c = tid + NTHR * i, row = c >> 5, cc = c & 31;
            *(u32x4*)(QM + (size_t)(t0 + row) * 1024 + h * 256 + 8 * cc) = *(const u32x4*)(QL + row * XCS + 8 * cc); }
        const f32x4 a1l = *(const f32x4*)(GL + 64 + 16 * ti + 4 * fq); const float msc = GL[128];
#pragma unroll
        for (int tt = 0; tt < 2; ++tt) {
            const int tj = tj0 + tt;
            f32x4 sacc = {0.f, 0.f, 0.f, 0.f};
            if (tj <= ti) {
#pragma unroll
                for (int ks = 0; ks < 8; ++ks) {
                    const bf16x8 qf = *(const bf16x8*)(QL + (16 * ti + fr) * XCS + 32 * ks + 8 * fq);
                    const bf16* kp = KT + (32 * ks + 8 * fq + (fr >> 2)) * TPS + 16 * tj + 4 * (fr & 3);
                    const s16x4 k0 = __builtin_amdgcn_ds_read_tr16_b64_v4i16((__attribute__((address_space(3))) s16x4*)(kp));
                    const s16x4 k1 = __builtin_amdgcn_ds_read_tr16_b64_v4i16((__attribute__((address_space(3))) s16x4*)(kp + 4 * TPS));
                    bf16x8 kb; kb[0] = k0[0]; kb[1] = k0[1]; kb[2] = k0[2]; kb[3] = k0[3]; kb[4] = k1[0]; kb[5] = k1[1]; kb[6] = k1[2]; kb[7] = k1[3];
                    sacc = mfma16(qf, kb, sacc); }
            }
            const int sidx = 16 * tj + fr;
#pragma unroll
            for (int i = 0; i < 4; ++i) { const int l = 16 * ti + 4 * fq + i;
                float v = 0.f;
                if (sidx <= l) v = sacc[i] * __expf(a1l[i] + msc);
                ST[l * TPS + sidx] = (bf16)f2bf(v); }
        }
        CP_BAR();
        { const int row = tid >> 3, ch = tid & 7; *(u32x4*)(SG + (size_t)ci * 4096 + row * 64 + 8 * ch) = *(const u32x4*)(ST + row * TPS + 8 * ch); }
#pragma unroll
        for (int i = 0; i < 4; ++i) { const int p = tid + NTHR * i, blk = p >> 6, ln = p & 63, row = (blk >> 1) * 16 + (ln & 15), ch = (blk & 1) * 4 + (ln >> 4);
            *(u32x4*)(KTG + (size_t)ci * 16384 + p * 8) = *(const u32x4*)(KT + row * TPS + 8 * ch); }
    }
    __syncthreads();
}

constexpr int SA_DEPTH = 5, SA_PATCH = 32 * 32 * 2 + 128;
struct ScanA { const bf16* KTG; const bf16* VTG; const float* gDEC; bf16* CS; float* NS; int bl, h, dblk, eblk, wave, fr, fq; unsigned koff, voff; bool do_den; };
struct ScanAOps { bf16x8 k[2][2], v[2][2]; float decay; };
__device__ __forceinline__ void scana_load(const ScanA& c, int j, ScanAOps& o) {
    const int ci = (c.bl * 64 + j) * 4 + c.h;
    const bf16* kb = c.KTG + (size_t)ci * 16384; const bf16* vb = c.VTG + (size_t)ci * 16384;
#pragma unroll
    for (int dt = 0; dt < 2; ++dt)
#pragma unroll
        for (int k2 = 0; k2 < 2; ++k2) o.k[dt][k2] = *(const bf16x8*)(kb + (c.koff + (unsigned)((dt * 2 + k2) * 512)));
#pragma unroll
    for (int et = 0; et < 2; ++et)
#pragma unroll
        for (int k2 = 0; k2 < 2; ++k2) o.v[et][k2] = *(const bf16x8*)(vb + (c.voff + (unsigned)((et * 2 + k2) * 512)));
    o.decay = c.gDEC[c.h * (MS / 64) + c.bl * 64 + j];
}
__device__ __forceinline__ void scana_step(const ScanA& c, unsigned char* lds, int j, f32x4 (&Cacc)[2][2], f32x4 (&Nacc)[2], const ScanAOps& o, const bf16x8 ones) {
    const int ci = (c.bl * 64 + j) * 4 + c.h;
    unsigned char* patch = lds + c.wave * SA_PATCH;
    const int lane = c.fq * 16 + c.fr;
    if ((j & 1) == 0) {
#pragma unroll
    for (int dt = 0; dt < 2; ++dt) {
#pragma unroll
        for (int et = 0; et < 2; ++et) { const f32x4 cc = Cacc[dt][et]; u32x2 w; w.x = pk2(cc[0], cc[1]); w.y = pk2(cc[2], cc[3]);
            *(u32x2*)(patch + (16 * et + c.fr) * 64 + (16 * dt + 4 * c.fq) * 2) = w; }
        if (c.do_den && c.fr == 0) *(f32x4*)(patch + 2048 + (16 * dt + 4 * c.fq) * 4) = Nacc[dt];
    }
    { bf16* cs = c.CS + (size_t)((c.bl * 32 + (j >> 1)) * 4 + c.h) * 65536 + (c.eblk * 8 + c.dblk) * 1024;
#pragma unroll
      for (int k = 0; k < 2; ++k) __builtin_nontemporal_store(*(const u32x4*)(patch + k * 1024 + lane * 16), (u32x4*)(cs + k * 512 + lane * 8));
      if (c.do_den && lane < 8) *(f32x4*)(c.NS + (size_t)ci * 256 + c.dblk * 32 + lane * 4) = *(const f32x4*)(patch + 2048 + lane * 16); }
    }
#pragma unroll
    for (int dt = 0; dt < 2; ++dt) {
#pragma unroll
        for (int et = 0; et < 2; ++et) {
            f32x4 cc = Cacc[dt][et] * o.decay;
#pragma unroll
            for (int k2 = 0; k2 < 2; ++k2) cc = mfma16(o.k[dt][k2], o.v[et][k2], cc);
            Cacc[dt][et] = cc;
        }
        if (c.do_den) {
            f32x4 cc = Nacc[dt] * o.decay;
#pragma unroll
            for (int k2 = 0; k2 < 2; ++k2) cc = mfma16(o.k[dt][k2], ones, cc);
            Nacc[dt] = cc;
        }
    }
}
__device__ __forceinline__ void scana_item(const Args& a, unsigned char* lds, int item, int pass) {
    const int tid = opaque_tid(), lane = tid & 63;
    unsigned char* ws = a.ws;
    ScanA c;
    c.wave = __builtin_amdgcn_readfirstlane(tid >> 6); c.fr = lane & 15; c.fq = lane >> 4;
    item = __builtin_amdgcn_readfirstlane(item);
    c.bl = item >> 5; c.h = (item >> 3) & 3; c.dblk = 2 * ((item >> 1) & 3) + (c.wave >> 2); c.eblk = 4 * (item & 1) + (c.wave & 3); c.do_den = (c.eblk == 0);
    c.koff = (unsigned)((4 * c.dblk) * 512 + lane * 8); c.voff = (unsigned)((4 * c.eblk) * 512 + lane * 8);
    c.KTG = (const bf16*)(ws + WS_KTG); c.VTG = (const bf16*)(ws + WS_VTG); c.gDEC = (const float*)(ws + WS_GSC + (size_t)pass * GSC_STRIDE) + 5 * MS * 4;
    c.CS = (bf16*)(ws + WS_CS); c.NS = (float*)(ws + WS_NS);
    f32x4 Cacc[2][2], Nacc[2];
#pragma unroll
    for (int x = 0; x < 2; ++x) { Nacc[x] = (f32x4){0.f, 0.f, 0.f, 0.f};
#pragma unroll
        for (int y = 0; y < 2; ++y) Cacc[x][y] = (f32x4){0.f, 0.f, 0.f, 0.f}; }
    bf16x8 ones;
    { const short ov = (c.fr == 0) ? (short)0x3F80 : (short)0;
#pragma unroll
      for (int e = 0; e < 8; ++e) ones[e] = ov; }
    ScanAOps o0, o1, o2, o3, o4;
    scana_load(c, 0, o0); scana_load(c, 1, o1); scana_load(c, 2, o2); scana_load(c, 3, o3); scana_load(c, 4, o4);
#define SA_STEP(jj, ob) do { scana_step(c, lds, (jj), Cacc, Nacc, ob, ones); __builtin_amdgcn_sched_barrier(0); scana_load(c, (jj) + SA_DEPTH < 64 ? (jj) + SA_DEPTH : 63, ob); __builtin_amdgcn_sched_barrier(0); } while (0)
#pragma nounroll
    for (int j = 0; j < 60; j += 5) { SA_STEP(j, o0); SA_STEP(j + 1, o1); SA_STEP(j + 2, o2); SA_STEP(j + 3, o3); SA_STEP(j + 4, o4); }
    SA_STEP(60, o0); SA_STEP(61, o1); SA_STEP(62, o2); SA_STEP(63, o3);
#undef SA_STEP
    asm volatile("s_waitcnt vmcnt(0)" ::: "memory");
}

constexpr int AKS = 136;
constexpr int L_AK = 0, L_AV = L_AK + 128 * AKS * 2, L_AP = L_AV + 128 * AKS * 2, L_ATT_END = L_AP + 8 * 16 * AKS * 2;
static_assert(L_ATT_END <= 131072, "attn lds");

__device__ __forceinline__ void attn_item(const Args& a, unsigned char* lds, int item) {
    const int tid = opaque_tid(), lane = tid & 63, wave = __builtin_amdgcn_readfirstlane(tid >> 6);
    const int fr = lane & 15, fq = lane >> 4;
    unsigned char* ws = a.ws;
    const int blk = item & 15, hh = (item >> 4) & 3, bl = (item >> 6) & 3, g = item >> 8;
    const int dil = g == 0 ? 1 : g == 1 ? 4 : 16, nb = 16 / dil;
    const int r = blk / nb, n2 = blk % nb;
    const int H = 4 * g + hh;
    const bf16* Qb = (const bf16*)(ws + WS_QKV) + ((size_t)H * MS + bl * SEQ + r * (SEQ / dil)) * 128;
    const bf16* Kb = Qb + (size_t)12 * MS * 128; const bf16* Vb = Qb + (size_t)24 * MS * 128;
    bf16* Ks = (bf16*)(lds + L_AK); bf16* VTs = (bf16*)(lds + L_AV); bf16* Pw = (bf16*)(lds + L_AP) + wave * 16 * AKS;
    const int rowbase = bl * SEQ + r;
    bf16* AO = (bf16*)(ws + WS_AO) + (size_t)g * MS * 512; float* LSE = (float*)(ws + WS_LSE) + (size_t)g * MS * 4;
    bf16x8 qf[4];
    f32x4 O[8];
    float mrow = -INFINITY, lrow = 0.f;
    const float scale = 0.08838834764831845f;
#define ATT_BAR() do { asm volatile("s_waitcnt lgkmcnt(0)" ::: "memory"); __builtin_amdgcn_s_barrier(); asm volatile("" ::: "memory"); } while (0)
    const int step0 = (n2 == 0 ? 1 : 0);
    u32x4 kreg[4], vreg[4];
#pragma unroll
    for (int i = 0; i < 4; ++i) { const int c = tid + NTHR * i, key = c >> 4, dc = c & 15;
        const int krow = 128 * (2 * n2 - 1 + step0) + key;
        kreg[i] = *(const u32x4*)(Kb + krow * 128 + 8 * dc); vreg[i] = *(const u32x4*)(Vb + krow * 128 + 8 * dc); }
#pragma nounroll
    for (int step = step0; step < 4; ++step) {
        const int half = step & 1, n = 2 * n2 + (step >> 1);
        if (step == step0 || step == 2) {
            const int qrow = 128 * n + 16 * wave + fr;
#pragma unroll
            for (int ks = 0; ks < 4; ++ks) qf[ks] = *(const bf16x8*)(Qb + qrow * 128 + 32 * ks + 8 * fq);
#pragma unroll
            for (int i = 0; i < 8; ++i) O[i] = (f32x4){0.f, 0.f, 0.f, 0.f};
            mrow = -INFINITY; lrow = 0.f;
        }
        if (step != 2) {
            ATT_BAR();
#pragma unroll
            for (int i = 0; i < 4; ++i) { const int c = tid + NTHR * i, key = c >> 4, dc = c & 15;
                *(u32x4*)(Ks + key * AKS + 8 * dc) = kreg[i]; *(u32x4*)(VTs + key * AKS + 8 * dc) = vreg[i]; }
            if (step < 3) {
#pragma unroll
                for (int i = 0; i < 4; ++i) { const int c = tid + NTHR * i, key = c >> 4, dc = c & 15;
                    const int krow = 128 * (2 * n2 + step) + key;
                    kreg[i] = *(const u32x4*)(Kb + krow * 128 + 8 * dc); vreg[i] = *(const u32x4*)(Vb + krow * 128 + 8 * dc); }
            }
            ATT_BAR();
        }
        f32x4 S[8];
        const int p = 16 * wave + fr;
        float mx = -INFINITY;
#pragma unroll
        for (int kt = 0; kt < 8; ++kt) {
            const bool act = half == 0 ? (kt >= wave) : (kt <= wave);
            f32x4 sacc = {0.f, 0.f, 0.f, 0.f};
            if (act) {
#pragma unroll
                for (int ks = 0; ks < 4; ++ks) { const bf16x8 kf = *(const bf16x8*)(Ks + (16 * kt + fr) * AKS + 32 * ks + 8 * fq); sacc = mfma16(kf, qf[ks], sacc); }
#pragma unroll
                for (int i = 0; i < 4; ++i) { const int kk = 16 * kt + 4 * fq + i; const bool ok = half == 0 ? (kk >= p) : (kk <= p);
                    const float v = ok ? sacc[i] * scale : -INFINITY; sacc[i] = v; mx = fmaxf(mx, v); }
            }
            S[kt] = sacc;
        }
        mx = fmaxf(mx, __shfl_xor(mx, 16)); mx = fmaxf(mx, __shfl_xor(mx, 32));
        const float mn = fmaxf(mrow, mx), alpha = __expf(mrow - mn); mrow = mn;
        float rs = 0.f;
        unsigned pk[8][2];
#pragma unroll
        for (int kt = 0; kt < 8; ++kt) {
            const bool act = half == 0 ? (kt >= wave) : (kt <= wave);
            if (act) { const float p0 = __expf(S[kt][0] - mn), p1 = __expf(S[kt][1] - mn), p2 = __expf(S[kt][2] - mn), p3 = __expf(S[kt][3] - mn);
                rs += (p0 + p1) + (p2 + p3); pk[kt][0] = pk2(p0, p1); pk[kt][1] = pk2(p2, p3); }
            else { pk[kt][0] = 0u; pk[kt][1] = 0u; }
        }
        rs += __shfl_xor(rs, 16); rs += __shfl_xor(rs, 32);
        lrow = lrow * alpha + rs;
        float al[4];
#pragma unroll
        for (int i = 0; i < 4; ++i) al[i] = __shfl(alpha, 4 * fq + i);
#pragma unroll
        for (int dtile = 0; dtile < 8; ++dtile)
#pragma unroll
            for (int i = 0; i < 4; ++i) O[dtile][i] *= al[i];
#pragma unroll
        for (int ks = 0; ks < 4; ++ks) {
            const bool act = half == 0 ? (2 * ks + 1 >= wave) : (2 * ks <= wave);
            if (act) {
                u32x4 pw; pw.x = pk[2 * ks][0]; pw.y = pk[2 * ks][1]; pw.z = pk[2 * ks + 1][0]; pw.w = pk[2 * ks + 1][1];
                const bf16x8 pa = __builtin_bit_cast(bf16x8, pw);
#pragma unroll
                for (int dtile = 0; dtile < 8; ++dtile) {
                    const bf16* vp = VTs + (32 * ks + 4 * fq + (fr >> 2)) * AKS + 16 * dtile + 4 * (fr & 3);
                    const s16x4 v0 = __builtin_amdgcn_ds_read_tr16_b64_v4i16((__attribute__((address_space(3))) s16x4*)(vp));
                    const s16x4 v1 = __builtin_amdgcn_ds_read_tr16_b64_v4i16((__attribute__((address_space(3))) s16x4*)(vp + 16 * AKS));
                    bf16x8 vb; vb[0] = v0[0]; vb[1] = v0[1]; vb[2] = v0[2]; vb[3] = v0[3]; vb[4] = v1[0]; vb[5] = v1[1]; vb[6] = v1[2]; vb[7] = v1[3];
                    O[dtile] = mfma16(pa, vb, O[dtile]); }
            }
        }
        if (half == 1)
        {
            const float inv_l = 1.f / lrow;
            float il[4];
    #pragma unroll
            for (int i = 0; i < 4; ++i) il[i] = __shfl(inv_l, 4 * fq + i);
    #pragma unroll
            for (int dtile = 0; dtile < 8; ++dtile)
    #pragma unroll
                for (int i = 0; i < 4; ++i) Pw[(4 * fq + i) * AKS + 16 * dtile + fr] = (bf16)f2bf(O[dtile][i] * il[i]);
            if (fq == 0) { const size_t row = (size_t)(rowbase + (128 * n + 16 * wave + fr) * dil); LSE[(size_t)hh * MS + row] = mrow + logf(lrow); }
    #pragma unroll
            for (int k = 0; k < 4; ++k) { const int c = lane + 64 * k, q = c >> 4, ch = c & 15;
                const size_t row = (size_t)(rowbase + (128 * n + 16 * wave + q) * dil);
                *(u32x4*)(AO + row * 512 + hh * 128 + 8 * ch) = *(const u32x4*)(Pw + q * AKS + 8 * ch); }
        }
    }
    __syncthreads();
}

constexpr int N_SCAN_ITEMS = NB_PASS * 32, N_ATT_ITEMS = 3 * NB_PASS * 4 * 16;
#ifndef PROBE_ATT_REP
#define PROBE_ATT_REP 1
#endif
struct XcdBarrier;
__device__ __forceinline__ void xcd_barrier(const XcdBarrier& b);
__device__ __forceinline__ void phase_mix(const Args& a, unsigned char* lds, int pass, const XcdBarrier* pbar) {
    volatile int* slot = (volatile int*)(lds + 131072 + 1024);
#ifdef PROBE_SPLIT
    for (int it = blockIdx.x; it < N_SCAN_ITEMS; it += gridDim.x) scana_item(a, lds, it, pass);
    xcd_barrier(*pbar);
    for (int rep = 0; rep < PROBE_ATT_REP; ++rep)
    for (int it = blockIdx.x; it < N_ATT_ITEMS; it += gridDim.x) attn_item(a, lds, it);
#else
    if ((int)blockIdx.x < N_SCAN_ITEMS && gridDim.x >= (unsigned)N_SCAN_ITEMS) {
        const int x = blockIdx.x & 7, k = blockIdx.x >> 3, g = x + 8 * (k >> 3), m = k & 7;
        scana_item(a, lds, g * 8 + m, pass);
    } else if (gridDim.x < (unsigned)N_SCAN_ITEMS) { for (int it = blockIdx.x; it < N_SCAN_ITEMS; it += gridDim.x) scana_item(a, lds, it, pass); }
    constexpr int QN = N_ATT_ITEMS / 8;
    for (int qo = 0; qo < 8; ++qo) {
        const int qx = (int)((blockIdx.x + qo) & 7);
        unsigned* qc = (unsigned*)(a.ws + WS_CTL) + CW_QCTR + (pass * 8 + qx) * 64;
        for (;;) {
            __syncthreads();
            if (opaque_tid() == 0) *slot = (int)atomicAdd(qc, 1u);
            __syncthreads();
            const int L = *slot;
            if (L >= QN) break;
            attn_item(a, lds, ((L >> 3) * 8 + qx) * 8 + (L & 7));
        }
    }
#endif
}

constexpr int QS_STRIDE = 264, SS_STRIDE = 72;
constexpr int L_QS = 0, L_SS = L_QS + 64 * QS_STRIDE * 2, L_DENL = L_SS + 64 * SS_STRIDE * 2, L_WIL = L_DENL + 256, L_NUM = L_WIL + 256, L_SB_END = L_NUM + 64 * QS_STRIDE * 2;
static_assert(L_SB_END <= 131072, "scan-B lds");
constexpr int L_KTL = L_SB_END, L_XS = L_KTL + 256 * TPS * 2, L_SB2_END = L_XS + 64 * TPS * 2;
static_assert(L_SB2_END <= 131072, "scan-B lds");
struct SBCtx { const bf16* P; const bf16* XC; const bf16* QM; const bf16* SG; const bf16* VTG; const bf16* KTG; const bf16* CS; const float* NS; const float* gWI; const float* gEF; const float* gDEC; bf16* UM; int tid, lane, wave, fr, fq; };

__device__ __forceinline__ void scanb_tail(const Args& a, const SBCtx& c, const bf16* NUMS, const float* DENL, int h, int t0) {
    const int lane = c.lane, wave = c.wave, col = h * 256 + 4 * lane;
    const f32x4 gh = *(const f32x4*)(a.g_head + col), sk = *(const f32x4*)(a.skip + col);
#pragma unroll
    for (int hb = 0; hb < 2; ++hb) {
        u32x2 ow[4], zw[4], xw[4];
#pragma unroll
        for (int q = 0; q < 4; ++q) { const size_t r = (size_t)(t0 + 8 * wave + 4 * hb + q);
            ow[q] = *(const u32x2*)(c.P + r * INW + C_OA + col); zw[q] = *(const u32x2*)(c.P + r * INW + C_ZA + col); xw[q] = *(const u32x2*)(c.XC + r * 1024 + col); }
#pragma unroll
        for (int q = 0; q < 4; ++q) {
            const int l = 8 * wave + 4 * hb + q; const size_t r = (size_t)(t0 + l);
            const u32x2 hw = *(const u32x2*)(NUMS + l * QS_STRIDE + 4 * lane);
            const float rd = DENL[l];
            float hm[4] = {sigmoidf_(bflo(ow[q].x)) * bflo(hw.x) * rd, sigmoidf_(bfhi(ow[q].x)) * bfhi(hw.x) * rd, sigmoidf_(bflo(ow[q].y)) * bflo(hw.y) * rd, sigmoidf_(bfhi(ow[q].y)) * bfhi(hw.y) * rd};
            float ss = (hm[0] * hm[0] + hm[1] * hm[1]) + (hm[2] * hm[2] + hm[3] * hm[3]);
            ss = wave_sum(ss);
            const float rinv = 1.f / sqrtf(ss * (1.f / 256.f) + EPS);
            const float xc[4] = {bflo(xw[q].x), bfhi(xw[q].x), bflo(xw[q].y), bfhi(xw[q].y)}, za[4] = {bflo(zw[q].x), bfhi(zw[q].x), bflo(zw[q].y), bfhi(zw[q].y)};
            float o[4];
#pragma unroll
            for (int e = 0; e < 4; ++e) o[e] = (hm[e] * rinv * gh[e] + sk[e] * xc[e]) * siluf_(za[e]);
            u32x2 ov; ov.x = pk2(o[0], o[1]); ov.y = pk2(o[2], o[3]);
            *(u32x2*)(c.UM + r * 1536 + col) = ov;
        }
        __builtin_amdgcn_sched_barrier(0);
    }
}

__device__ __forceinline__ int scanb_run(const Args& a, unsigned char* lds, int vcu, int G, int pass) {
    SBCtx c;
    c.tid = opaque_tid(); c.lane = c.tid & 63; c.wave = __builtin_amdgcn_readfirstlane(c.tid >> 6); c.fr = c.lane & 15; c.fq = c.lane >> 4;
    unsigned char* ws = a.ws;
    c.P = (const bf16*)(ws + WS_P); c.XC = (const bf16*)(ws + WS_XC); c.QM = (const bf16*)(ws + WS_QM); c.SG = (const bf16*)(ws + WS_SG); c.VTG = (const bf16*)(ws + WS_VTG); c.KTG = (const bf16*)(ws + WS_KTG);
    c.CS = (const bf16*)(ws + WS_CS); c.NS = (const float*)(ws + WS_NS); { const float* gsc = (const float*)(ws + WS_GSC + (size_t)pass * GSC_STRIDE); c.gWI = gsc + 2 * MS * 4; c.gEF = gsc + 3 * MS * 4; c.gDEC = gsc + 5 * MS * 4; }
    c.UM = (bf16*)(ws + WS_ACAT);
    const int wave = c.wave;
    bf16* QS = (bf16*)(lds + L_QS); bf16* SS = (bf16*)(lds + L_SS); float* DENL = (float*)(lds + L_DENL); float* WIL = (float*)(lds + L_WIL); bf16* NUMS = (bf16*)(lds + L_NUM);
    bf16* KTL = (bf16*)(lds + L_KTL); bf16* XS = (bf16*)(lds + L_XS);
    unsigned* qc = (unsigned*)(ws + WS_CTL) + CW_QCTR + 2048 + pass * 64;
    volatile int* slot = (volatile int*)(lds + 131072 + 1024);
    constexpr int NITEMS = (MS / 128) * 4;
    bf16x8 ones;
    { const short ov = (c.fr == 0) ? (short)0x3F80 : (short)0;
#pragma unroll
      for (int e = 0; e < 8; ++e) ones[e] = ov; }
    int it = vcu;
    while (it < NITEMS) {
        { int t_ = c.tid; asm volatile("" : "+v"(t_)); c.tid = t_; c.lane = t_ & 63; c.fr = c.lane & 15; c.fq = c.lane >> 4; }
        const int tid = c.tid, lane = c.lane, fr = c.fr, fq = c.fq;
        const int h = it & 3, pr = it >> 2, chA = (2 * pr) * 4 + h, chB = chA + 4, tA = (2 * pr) * 64, tB = tA + 64;
        bf16x8 cb[2][8], vtA[2][2], vtB[2][2];
#pragma unroll
        for (int t = 0; t < 2; ++t) {
#pragma unroll
            for (int ks = 0; ks < 8; ++ks) cb[t][ks] = *(const bf16x8*)(c.CS + (size_t)it * 65536 + (wave * 8 + ks) * 1024 + (16 * t + fr) * 32 + 8 * fq);
#pragma unroll
            for (int k2 = 0; k2 < 2; ++k2) vtA[t][k2] = *(const bf16x8*)(c.VTG + (size_t)chA * 16384 + (((2 * wave + t) * 2 + k2) * 64 + lane) * 8);
        }
        const float decA = c.gDEC[h * (MS / 64) + 2 * pr];
        if (tid == 0) *slot = (int)atomicAdd(qc, 1u);
        __syncthreads();
#pragma unroll
        for (int i = 0; i < 4; ++i) { const int q = tid + NTHR * i, row = q >> 5, cc = q & 31; *(u32x4*)(QS + row * QS_STRIDE + 8 * cc) = *(const u32x4*)(c.QM + (size_t)(tA + row) * 1024 + h * 256 + 8 * cc); }
        { const int row = tid >> 3, cc = tid & 7; *(u32x4*)(SS + row * SS_STRIDE + 8 * cc) = *(const u32x4*)(c.SG + (size_t)chA * 4096 + row * 64 + 8 * cc); }
        if (tid < 64) WIL[tid] = c.gWI[h * MS + tA + tid];
#pragma unroll
        for (int i = 0; i < 4; ++i) { const int p = tid + NTHR * i, blk = p >> 6, ln = p & 63, row = (blk >> 1) * 16 + (ln & 15), ch8 = (blk & 1) * 4 + (ln >> 4);
            *(u32x4*)(KTL + row * TPS + 8 * ch8) = *(const u32x4*)(c.KTG + (size_t)chA * 16384 + p * 8); }
        __syncthreads();
        const int nit = G + *slot;
#pragma unroll
        for (int lt = 0; lt < 4; ++lt) {
            bf16x8 qf[8], sf[2];
#pragma unroll
            for (int ks = 0; ks < 8; ++ks) qf[ks] = *(const bf16x8*)(QS + (16 * lt + fr) * QS_STRIDE + 32 * ks + 8 * fq);
#pragma unroll
            for (int k2 = 0; k2 < 2; ++k2) sf[k2] = *(const bf16x8*)(SS + (16 * lt + fr) * SS_STRIDE + 32 * k2 + 8 * fq);
#pragma unroll
            for (int t = 0; t < 2; ++t) {
                f32x4 a1 = {0.f, 0.f, 0.f, 0.f}, a2 = {0.f, 0.f, 0.f, 0.f}, a3 = {0.f, 0.f, 0.f, 0.f};
#pragma unroll
                for (int k2 = 0; k2 < 2; ++k2) a1 = mfma16(sf[k2], vtA[t][k2], a1);
#pragma unroll
                for (int ks = 0; ks < 8; ks += 2) { a2 = mfma16(qf[ks], cb[t][ks], a2); a3 = mfma16(qf[ks + 1], cb[t][ks + 1], a3); }
#pragma unroll
                for (int i = 0; i < 4; ++i) NUMS[(16 * lt + 4 * fq + i) * QS_STRIDE + 32 * wave + 16 * t + fr] = (bf16)f2bf(a1[i] + WIL[16 * lt + 4 * fq + i] * (a2[i] + a3[i]));
            }
        }
        if (wave == 0) {
            bf16x8 nb[8];
#pragma unroll
            for (int ks = 0; ks < 8; ++ks) { const f32x4 n0 = *(const f32x4*)(c.NS + (size_t)chA * 256 + 32 * ks + 8 * fq), n1 = *(const f32x4*)(c.NS + (size_t)chA * 256 + 32 * ks + 8 * fq + 4);
                u32x4 w; w.x = pk2(n0[0], n0[1]); w.y = pk2(n0[2], n0[3]); w.z = pk2(n1[0], n1[1]); w.w = pk2(n1[2], n1[3]);
                if (fr != 0) w = (u32x4){0u, 0u, 0u, 0u};
                nb[ks] = __builtin_bit_cast(bf16x8, w); }
#pragma unroll
            for (int lt = 0; lt < 4; ++lt) {
                f32x4 a1 = {0.f, 0.f, 0.f, 0.f}, a2 = {0.f, 0.f, 0.f, 0.f};
#pragma unroll
                for (int k2 = 0; k2 < 2; ++k2) { const bf16x8 sf = *(const bf16x8*)(SS + (16 * lt + fr) * SS_STRIDE + 32 * k2 + 8 * fq); a1 = mfma16(sf, ones, a1); }
#pragma unroll
                for (int ks = 0; ks < 8; ++ks) { const bf16x8 qf = *(const bf16x8*)(QS + (16 * lt + fr) * QS_STRIDE + 32 * ks + 8 * fq); a2 = mfma16(qf, nb[ks], a2); }
                if (fr == 0) {
#pragma unroll
                    for (int i = 0; i < 4; ++i) { const int l = 16 * lt + 4 * fq + i; const float den = a1[i] + WIL[l] * a2[i]; DENL[l] = 1.f / fmaxf(fabsf(den), c.gEF[h * MS + tA + l]); } }
            }
        }
        __syncthreads();
#pragma unroll
        for (int i = 0; i < 4; ++i) { const int q = tid + NTHR * i, row = q >> 5, cc = q & 31; *(u32x4*)(QS + row * QS_STRIDE + 8 * cc) = *(const u32x4*)(c.QM + (size_t)(tB + row) * 1024 + h * 256 + 8 * cc); }
        { const int row = tid >> 3, cc = tid & 7; *(u32x4*)(SS + row * SS_STRIDE + 8 * cc) = *(const u32x4*)(c.SG + (size_t)chB * 4096 + row * 64 + 8 * cc); }
        scanb_tail(a, c, NUMS, DENL, h, tA);
#pragma unroll
        for (int t = 0; t < 2; ++t)
#pragma unroll
            for (int k2 = 0; k2 < 2; ++k2) vtB[t][k2] = *(const bf16x8*)(c.VTG + (size_t)chB * 16384 + (((2 * wave + t) * 2 + k2) * 64 + lane) * 8);
        __syncthreads();
        if (tid < 64) WIL[tid] = c.gWI[h * MS + tB + tid];
        {
            const int ti = wave >> 1;
            bf16x8 qf[8];
#pragma unroll
            for (int ks = 0; ks < 8; ++ks) qf[ks] = *(const bf16x8*)(QS + (16 * ti + fr) * QS_STRIDE + 32 * ks + 8 * fq);
#pragma unroll
            for (int tt = 0; tt < 2; ++tt) { const int tj = 2 * (wave & 1) + tt;
                f32x4 xacc = {0.f, 0.f, 0.f, 0.f};
#pragma unroll
                for (int ks = 0; ks < 8; ++ks) {
                    const bf16* kp = KTL + (32 * ks + 8 * fq + (fr >> 2)) * TPS + 16 * tj + 4 * (fr & 3);
                    const s16x4 k0 = __builtin_amdgcn_ds_read_tr16_b64_v4i16((__attribute__((address_space(3))) s16x4*)(kp));
                    const s16x4 k1 = __builtin_amdgcn_ds_read_tr16_b64_v4i16((__attribute__((address_space(3))) s16x4*)(kp + 4 * TPS));
                    bf16x8 kb; kb[0] = k0[0]; kb[1] = k0[1]; kb[2] = k0[2]; kb[3] = k0[3]; kb[4] = k1[0]; kb[5] = k1[1]; kb[6] = k1[2]; kb[7] = k1[3];
                    xacc = mfma16(qf[ks], kb, xacc); }
#pragma unroll
                for (int i = 0; i < 4; ++i) XS[(16 * ti + 4 * fq + i) * TPS + 16 * tj + fr] = (bf16)f2bf(xacc[i]); }
        }
        __syncthreads();
#pragma unroll
        for (int lt = 0; lt < 4; ++lt) {
            bf16x8 qf[8], sf[2], xf[2];
#pragma unroll
            for (int ks = 0; ks < 8; ++ks) qf[ks] = *(const bf16x8*)(QS + (16 * lt + fr) * QS_STRIDE + 32 * ks + 8 * fq);
#pragma unroll
            for (int k2 = 0; k2 < 2; ++k2) { sf[k2] = *(const bf16x8*)(SS + (16 * lt + fr) * SS_STRIDE + 32 * k2 + 8 * fq); xf[k2] = *(const bf16x8*)(XS + (16 * lt + fr) * TPS + 32 * k2 + 8 * fq); }
#pragma unroll
            for (int t = 0; t < 2; ++t) {
                f32x4 a1 = {0.f, 0.f, 0.f, 0.f}, a2 = {0.f, 0.f, 0.f, 0.f}, a3 = {0.f, 0.f, 0.f, 0.f}, a4 = {0.f, 0.f, 0.f, 0.f};
#pragma unroll
                for (int k2 = 0; k2 < 2; ++k2) { a1 = mfma16(sf[k2], vtB[t][k2], a1); a4 = mfma16(xf[k2], vtA[t][k2], a4); }
#pragma unroll
                for (int ks = 0; ks < 8; ks += 2) { a2 = mfma16(qf[ks], cb[t][ks], a2); a3 = mfma16(qf[ks + 1], cb[t][ks + 1], a3); }
#pragma unroll
                for (int i = 0; i < 4; ++i) NUMS[(16 * lt + 4 * fq + i) * QS_STRIDE + 32 * wave + 16 * t + fr] = (bf16)f2bf(a1[i] + WIL[16 * lt + 4 * fq + i] * (decA * (a2[i] + a3[i]) + a4[i]));
            }
        }
        if (wave == 0) {
            bf16x8 nb[8];
#pragma unroll
            for (int ks = 0; ks < 8; ++ks) { const f32x4 n0 = *(const f32x4*)(c.NS + (size_t)chA * 256 + 32 * ks + 8 * fq), n1 = *(const f32x4*)(c.NS + (size_t)chA * 256 + 32 * ks + 8 * fq + 4);
                u32x4 w; w.x = pk2(n0[0], n0[1]); w.y = pk2(n0[2], n0[3]); w.z = pk2(n1[0], n1[1]); w.w = pk2(n1[2], n1[3]);
                if (fr != 0) w = (u32x4){0u, 0u, 0u, 0u};
                nb[ks] = __builtin_bit_cast(bf16x8, w); }
#pragma unroll
            for (int lt = 0; lt < 4; ++lt) {
                f32x4 a1 = {0.f, 0.f, 0.f, 0.f}, a2 = {0.f, 0.f, 0.f, 0.f}, a4 = {0.f, 0.f, 0.f, 0.f};
#pragma unroll
                for (int k2 = 0; k2 < 2; ++k2) { const bf16x8 sf = *(const bf16x8*)(SS + (16 * lt + fr) * SS_STRIDE + 32 * k2 + 8 * fq); a1 = mfma16(sf, ones, a1);
                                                 const bf16x8 xf = *(const bf16x8*)(XS + (16 * lt + fr) * TPS + 32 * k2 + 8 * fq); a4 = mfma16(xf, ones, a4); }
#pragma unroll
                for (int ks = 0; ks < 8; ++ks) { const bf16x8 qf = *(const bf16x8*)(QS + (16 * lt + fr) * QS_STRIDE + 32 * ks + 8 * fq); a2 = mfma16(qf, nb[ks], a2); }
                if (fr == 0) {
#pragma unroll
                    for (int i = 0; i < 4; ++i) { const int l = 16 * lt + 4 * fq + i; const float den = a1[i] + WIL[l] * (decA * a2[i] + a4[i]); DENL[l] = 1.f / fmaxf(fabsf(den), c.gEF[h * MS + tB + l]); } }
            }
        }
        __syncthreads();
        scanb_tail(a, c, NUMS, DENL, h, tB);
        it = nit;
    }
    __syncthreads();
    if (vcu >= NITEMS) { if (opaque_tid() == 0) *slot = (int)atomicAdd(qc, 1u); __syncthreads(); it = G + *slot; __syncthreads(); }
    return it;
}

__device__ __forceinline__ void phase_post(const Args& a, unsigned char* lds, int vcu, int G, int pass) {
    int qi = scanb_run(a, lds, vcu, G, pass);
    const int tid = opaque_tid(), lane = tid & 63, wave = tid >> 6;
    unsigned char* ws = a.ws;
    const bf16* P = (const bf16*)(ws + WS_P);
    const bf16* AO = (const bf16*)(ws + WS_AO); const float* LSE = (const float*)(ws + WS_LSE); bf16* UA = (bf16*)(ws + WS_ACAT) + 1024;
    const int hh = lane >> 4, c = hh * 128 + 8 * (lane & 15);
    unsigned* qc = (unsigned*)(ws + WS_CTL) + CW_QCTR + 2048 + pass * 64;
    volatile int* slot = (volatile int*)(lds + 131072 + 1024);
    constexpr int NSB = (MS / 128) * 4, NCOMB = MS / 32;
    for (;;) {
        const int ci = qi - NSB;
        if (ci >= NCOMB) break;
        if (tid == 0) *slot = (int)atomicAdd(qc, 1u);
#pragma unroll 1
    for (int r0 = ci * 32 + 2 * wave; r0 < ci * 32 + 32; r0 += 16) {
        u32x4 o0[2], o1[2], o2[2], zb[2]; float l0[2], l1[2], l2[2];
#pragma unroll
        for (int q = 0; q < 2; ++q) { const size_t r = (size_t)(r0 + q);
            o0[q] = *(const u32x4*)(AO + r * 512 + c); o1[q] = *(const u32x4*)(AO + ((size_t)MS + r) * 512 + c); o2[q] = *(const u32x4*)(AO + ((size_t)2 * MS + r) * 512 + c);
            zb[q] = *(const u32x4*)(P + r * INW + C_ZB + c);
            l0[q] = LSE[(size_t)hh * MS + r]; l1[q] = LSE[(size_t)(4 + hh) * MS + r]; l2[q] = LSE[(size_t)(8 + hh) * MS + r]; }
#pragma unroll
        for (int q = 0; q < 2; ++q) {
            const float mx = fmaxf(l0[q], fmaxf(l1[q], l2[q]));
            float w0 = __expf(l0[q] - mx), w1 = __expf(l1[q] - mx), w2 = __expf(l2[q] - mx); const float inv = 1.f / (w0 + w1 + w2); w0 *= inv; w1 *= inv; w2 *= inv;
            float f0[8], f1[8], f2[8], z[8], o[8]; unpack8(o0[q], f0); unpack8(o1[q], f1); unpack8(o2[q], f2); unpack8(zb[q], z);
#pragma unroll
            for (int e = 0; e < 8; ++e) o[e] = (w0 * f0[e] + w1 * f1[e] + w2 * f2[e]) * siluf_(z[e]);
            u32x4 ov; ov.x = pk2(o[0], o[1]); ov.y = pk2(o[2], o[3]); ov.z = pk2(o[4], o[5]); ov.w = pk2(o[6], o[7]);
            *(u32x4*)(UA + (size_t)(r0 + q) * 1536 + c) = ov;
        }
    }
        __syncthreads();
        qi = G + *slot;
        __syncthreads();
    }
}

__device__ __forceinline__ void phase_norm(const Args& a, int vcu, int G) {
    const int tid = opaque_tid(), lane = tid & 63, wave = tid >> 6;
    const bf16* dl = (const bf16*)(a.ws + WS_H);
    for (int r0 = 2 * (vcu * NWAVES + wave); r0 < MALL; r0 += 2 * G * NWAVES) {
        f32x4 v[2][4]; u32x2 d[2][4]; float ss[2] = {0.f, 0.f};
#pragma unroll
        for (int q = 0; q < 2; ++q) { const f32x4* xr = (const f32x4*)(a.x + (size_t)(r0 + q) * DM) + lane; const u32x2* dr = (const u32x2*)(dl + (size_t)(r0 + q) * DM) + lane;
#pragma unroll
            for (int j = 0; j < 4; ++j) { v[q][j] = xr[64 * j]; d[q][j] = dr[64 * j]; } }
#pragma unroll
        for (int q = 0; q < 2; ++q)
#pragma unroll
            for (int j = 0; j < 4; ++j) { v[q][j] += (f32x4){bflo(d[q][j].x), bfhi(d[q][j].x), bflo(d[q][j].y), bfhi(d[q][j].y)};
                ss[q] += (v[q][j].x * v[q][j].x + v[q][j].y * v[q][j].y) + (v[q][j].z * v[q][j].z + v[q][j].w * v[q][j].w); }
#pragma unroll
        for (int o = 1; o < 64; o <<= 1) { ss[0] += __shfl_xor(ss[0], o); ss[1] += __shfl_xor(ss[1], o); }
#pragma unroll
        for (int q = 0; q < 2; ++q) { const float rinv = 1.f / sqrtf(ss[q] * (1.f / DM) + EPS);
#pragma unroll
            for (int j = 0; j < 4; ++j) { const f32x4 gf = *((const f32x4*)a.g_final + lane + 64 * j); *((f32x4*)(a.out + (size_t)(r0 + q) * DM) + lane + 64 * j) = v[q][j] * rinv * gf; } }
    }
}


#define LAS __attribute__((address_space(3)))
#define XB_TMO      128
#define XB_XCNT(j)  (256  + 64 * (j))
#define XB_XSUB(j)  (1280 + 64 * (j))
#define XB_XGEN(j)  (2304 + 64 * (j))
#define XB_TOP      3328
#define XB_TOPGEN   3392
#define XCD_BAR_WORDS 3456
#define XB_SPIN_CAP (1u << 22)
constexpr int CW_BAR = 4096;
__device__ __forceinline__ unsigned xb_ld(unsigned* p)              { return __hip_atomic_load(p, __ATOMIC_RELAXED, __HIP_MEMORY_SCOPE_AGENT); }
__device__ __forceinline__ unsigned xb_add(unsigned* p, unsigned v) { return __hip_atomic_fetch_add(p, v, __ATOMIC_RELAXED, __HIP_MEMORY_SCOPE_AGENT); }
__device__ __forceinline__ unsigned xb_xcc_id() { return (unsigned)__builtin_amdgcn_s_getreg((3 << 11) | 20) & 0xFu; }
#define XB_SPIN(cond, bar) do { unsigned _sp = 0; while (cond) { __builtin_amdgcn_s_sleep(1); \
    if ((++_sp & 255u) == 0u) { if (xb_ld(&(bar)[XB_TMO])) break; if (_sp > XB_SPIN_CAP) { atomicAdd(&(bar)[XB_TMO], 1u); break; } } } } while (0)
struct XcdBarrier { unsigned* bar; unsigned x; volatile LAS unsigned* st; };
__device__ __forceinline__ XcdBarrier xcd_barrier_post(unsigned* bar, volatile LAS unsigned* st) {
    XcdBarrier b; b.bar = bar; b.x = xb_xcc_id(); b.st = st;
    if (threadIdx.x == 0) (void)xb_add(&bar[XB_XCNT(b.x)], 1u);
    return b;
}
__device__ __forceinline__ void xcd_barrier_complete(unsigned* bar, unsigned x, unsigned& nloc, unsigned& nx) {
    const unsigned G = gridDim.x * gridDim.y * gridDim.z;
    unsigned sum, cnt, mine, sp = 0u;
    for (;;) {
        sum = 0u; cnt = 0u; mine = 0u;
#pragma unroll
        for (unsigned j = 0; j < 16; ++j) { const unsigned c = xb_ld(&bar[XB_XCNT(j)]); sum += c; cnt += (c > 0u) ? 1u : 0u; mine = (j == x) ? c : mine; }
        if (sum == G) break;
        __builtin_amdgcn_s_sleep(1);
        if ((++sp & 255u) == 0u) { if (xb_ld(&bar[XB_TMO])) break; if (sp > XB_SPIN_CAP) { atomicAdd(&bar[XB_TMO], 1u); break; } }
    }
    nloc = mine > 0u ? mine : 1u; nx = cnt > 0u ? cnt : 1u;
}
__device__ __forceinline__ void xcd_barrier(const XcdBarrier& b) {
    asm volatile("s_waitcnt vmcnt(0)" ::: "memory");
    __syncthreads();
    if (threadIdx.x == 0) {
        unsigned* bar = b.bar;
        __builtin_amdgcn_s_waitcnt(0);
        unsigned nloc = b.st[0], nx = b.st[1];
        if (nloc == 0u) { xcd_barrier_complete(bar, b.x, nloc, nx); b.st[0] = nloc; b.st[1] = nx; }
        const unsigned old = xb_add(&bar[XB_XSUB(b.x)], 1u);
        const unsigned gen = old / nloc;
        if (old + 1u == (gen + 1u) * nloc) {
            __builtin_amdgcn_fence(__ATOMIC_RELEASE, "agent");
            asm volatile("s_waitcnt vmcnt(0)" ::: "memory");
            const unsigned og = xb_add(&bar[XB_TOP], 1u);
            const unsigned tg = og / nx;
            if (og + 1u == (tg + 1u) * nx) xb_add(&bar[XB_TOPGEN], 1u);
            else XB_SPIN(xb_ld(&bar[XB_TOPGEN]) == tg, bar);
            __builtin_amdgcn_fence(__ATOMIC_ACQUIRE, "agent");
            xb_add(&bar[XB_XGEN(b.x)], 1u);
            asm volatile("s_waitcnt vmcnt(0)" ::: "memory");
        } else {
            XB_SPIN(xb_ld(&bar[XB_XGEN(b.x)]) == gen, bar);
            __builtin_amdgcn_fence(__ATOMIC_ACQUIRE, "agent");
            asm volatile("s_waitcnt vmcnt(0)" ::: "memory");
        }
    }
    __syncthreads();
}

constexpr int PH_PER_PASS = 5, PH_TOTAL = 4 + PH_PER_PASS * NPASS + 1;
#define PROBE_KIND_OF(k) ((k) == 0 ? K_CPREP : (k) == 1 ? K_MIX : (k) == 2 ? K_POST : (k) == 3 ? K_OUT1 : K_OUT2)
enum { K_PROLOGUE = 0, K_H = 1, K_INPROJ = 2, K_PREP = 3, K_QK = 4, K_MIX = 5, K_POST = 6, K_OUT1 = 7, K_OUT2 = 8, K_NORM = 9, K_CPREP = 10, K_OUT2IN = 12 };

__device__ __forceinline__ Args fresh_args() {
    Args a{};
#if defined(__HIP_DEVICE_COMPILE__)
    typedef const __attribute__((address_space(4))) unsigned long long* KP;
    KP q = (KP)__builtin_amdgcn_kernarg_segment_ptr(); asm volatile("" : "+s"(q));
    static_assert(sizeof(Args) == 22 * 8, "Args layout");
    unsigned long long w[22];
#pragma unroll
    for (int i = 0; i < 22; ++i) w[i] = q[i];
    __builtin_memcpy(&a, w, sizeof(Args));
#endif
    return a;
}
template <int KIND>
__device__ __forceinline__ void run_phase(const Args& args, unsigned char* lds, int pass, const XcdBarrier* pbar = nullptr) {
    const int G = gridDim.x; const int bx = blockIdx.x;
    const int vcu = (G % 8 == 0) ? (bx % 8) * (G / 8) + bx / 8 : bx;
    unsigned char* ws = args.ws;
    PG8_LAS unsigned char* lds3 = (PG8_LAS unsigned char*)lds;
    if constexpr (KIND == K_PROLOGUE) phase_prologue(args, lds, vcu, G);
    else if constexpr (KIND == K_H) phase_h(args, lds, vcu, G);
    else if constexpr (KIND == K_NORM) phase_norm(args, vcu, G);
    else if constexpr (KIND == K_INPROJ) {
        GemmCombo g{(const char*)ws, WS_H + (size_t)pass * MS * 2048};
        ComboOrder S; S.init(G, bx, false);
        EpiCombo E{EpiOut{(bf16*)(ws + WS_H), (const float*)(ws + WS_MOD) + 2048, 0}, EpiProj{(bf16*)(ws + WS_P), (const float*)(ws + WS_ROPE) + (size_t)pass * MS * 32, (bf16*)(ws + WS_QKV)}, EpiVT{(bf16*)(ws + WS_VTG)}};
        pg8::gemm_phase<EpiCombo, ComboOrder, true, true>(lds3, g, S, E);
    } else if constexpr (KIND == K_PREP) phase_gates(args, lds, vcu, G);
    else if constexpr (KIND == K_QK) {
        pg8::Gemm<1024, 256, 256, 512, 512 * 256 * 2> g{(const bf16*)(ws + WS_XC), (const bf16*)(ws + WS_WQK)};
        pg8::GroupOrder S; S.init(MS, G, bx);
        EpiQK E{(bf16*)(ws + WS_QM), (bf16*)(ws + WS_KM)};
        pg8::gemm_phase<EpiQK, pg8::GroupOrder, true, true>(lds3, g, S, E);
    } else if constexpr (KIND == K_CPREP) phase_cprep(args, lds, vcu, G, pass);
    else if constexpr (KIND == K_MIX) phase_mix(args, lds, pass, pbar);
    else if constexpr (KIND == K_POST) phase_post(args, lds, vcu, G, pass);
    else if constexpr (KIND == K_OUT1) {
        pg8::Gemm<1536, 1536, 1536> g{(const bf16*)(ws + WS_ACAT), (const bf16*)(ws + WS_WOM)};
        pg8::StaticOrder S; S.init(MS, 1024, G, bx);
        EpiMerge E{(const bf16*)(ws + WS_P), (bf16*)(ws + WS_MG)};
        pg8::gemm_phase<EpiMerge, pg8::StaticOrder, true, true>(lds3, g, S, E);
    } else if constexpr (KIND == K_OUT2IN) {
        GemmCombo g{(const char*)ws, WS_H + (size_t)(pass + 1) * MS * 2048};
        ComboOrder S; S.init(G, bx, true);
        EpiCombo E{EpiOut{(bf16*)(ws + WS_H), (const float*)(ws + WS_MOD) + 2048, pass * MS}, EpiProj{(bf16*)(ws + WS_P), (const float*)(ws + WS_ROPE) + (size_t)(pass + 1) * MS * 32, (bf16*)(ws + WS_QKV)}, EpiVT{(bf16*)(ws + WS_VTG)}};
        pg8::gemm_phase<EpiCombo, ComboOrder, true, true>(lds3, g, S, E);
    } else if constexpr (KIND == K_OUT2) {
        pg8::Gemm<1024, 1024, 1024> g{(const bf16*)(ws + WS_MG), (const bf16*)(ws + WS_WO)};
        pg8::StaticOrder S; S.init(MS, 1024, G, bx);
        EpiOut E{(bf16*)(ws + WS_H), (const float*)(ws + WS_MOD) + 2048, pass * MS};
        pg8::gemm_phase<EpiOut, pg8::StaticOrder, true, true>(lds3, g, S, E);
    }
}

#if !MK_ONE_LAUNCH
template <int KIND>
__global__ void __launch_bounds__(NTHR, 2) k_phase(Args args) {
    extern __shared__ __attribute__((aligned(16))) unsigned char lds[];
    run_phase<KIND>(args, lds, args.ph_lo);
}
#else
__global__ void __launch_bounds__(NTHR, 2) mk_fwd(Args args) {
    extern __shared__ __attribute__((aligned(16))) unsigned char lds[];
    volatile LAS unsigned* misc = (volatile LAS unsigned*)((LAS unsigned char*)lds + 131072 + 2048);
    if (threadIdx.x < 16) misc[threadIdx.x] = 0u;
    __syncthreads();
    XcdBarrier bar = xcd_barrier_post((unsigned*)(args.ws + WS_CTL) + CW_BAR, misc + 8);
#ifdef PROBE_TMASK
    unsigned long long pr_acc = 0ull;
#endif
    for (int gp = args.ph_lo; gp < args.ph_hi; ++gp) {
#ifdef PROBE_TMASK
        const unsigned long long pr_t0 = __builtin_amdgcn_s_memrealtime();
        int pr_kind;
        if (gp == 0) pr_kind = K_PROLOGUE; else if (gp == 1) pr_kind = K_H; else if (gp == 2) pr_kind = K_PREP; else if (gp == 3) pr_kind = K_INPROJ; else if (gp == PH_TOTAL - 1) pr_kind = K_NORM;
        else { const int k = (gp - 4) % PH_PER_PASS; pr_kind = PROBE_KIND_OF(k); }
#endif
        if (gp == 0) run_phase<K_PROLOGUE>(args, lds, 0);
        else if (gp == 1) run_phase<K_H>(args, lds, 0);
        else if (gp == 2) run_phase<K_PREP>(args, lds, 0);
        else if (gp == 3) run_phase<K_INPROJ>(args, lds, 0);
        else if (gp == PH_TOTAL - 1) run_phase<K_NORM>(args, lds, 0);
        else {
            const int pass = (gp - 4) / PH_PER_PASS, k = (gp - 4) % PH_PER_PASS;
            if (k == 0) run_phase<K_CPREP>(args, lds, pass);
            else if (k == 1) run_phase<K_MIX>(args, lds, pass, &bar);
            else if (k == 2) run_phase<K_POST>(args, lds, pass);
            else if (k == 3) run_phase<K_OUT1>(args, lds, pass);
            else if (pass + 1 < NPASS) run_phase<K_OUT2IN>(args, lds, pass);
            else run_phase<K_OUT2>(args, lds, pass);
        }
#ifdef PROBE_TMASK
        const unsigned long long pr_tb = __builtin_amdgcn_s_memrealtime();
#endif
        if (gp + 1 < args.ph_hi) xcd_barrier(bar);
#ifdef PROBE_TMASK
        else __syncthreads();
        if ((PROBE_TMASK >> 11) & 1) pr_acc += __builtin_amdgcn_s_memrealtime() - pr_tb;
        if ((PROBE_TMASK >> pr_kind) & 1) pr_acc += __builtin_amdgcn_s_memrealtime() - pr_t0;
#endif
    }
#ifdef PROBE_TMASK
    if (blockIdx.x == 0) { const unsigned long long t1 = __builtin_amdgcn_s_memrealtime(); while (__builtin_amdgcn_s_memrealtime() - t1 < 4ull * pr_acc) __builtin_amdgcn_s_sleep(8); }
#endif
}
#endif

extern "C" void kernel_launch(void* const* d_in, const int* in_sizes, int n_in, void* d_out, int out_size, void* d_ws, size_t ws_size, hipStream_t stream) {
    static int grid = 0;
    if (grid == 0) {
        if (n_in != 19 || in_sizes[0] != MALL * DM || out_size != MALL * DM || ws_size < WS_END) { fprintf(stderr, "kernel_launch: unexpected shapes (n_in %d, ws %zu)\n", n_in, ws_size); grid = -1; return; }
        int dev = 0, cus = 0, per_cu = 0;
        (void)hipGetDevice(&dev); (void)hipDeviceGetAttribute(&cus, hipDeviceAttributeMultiprocessorCount, dev);
#if MK_ONE_LAUNCH
        (void)hipFuncSetAttribute((const void*)mk_fwd, hipFuncAttributeMaxDynamicSharedMemorySize, LDS_BYTES);
        (void)hipOccupancyMaxActiveBlocksPerMultiprocessor(&per_cu, (const void*)mk_fwd, NTHR, LDS_BYTES);
        if (per_cu < 1) { fprintf(stderr, "kernel_launch: occupancy query says %d\n", per_cu); per_cu = 1; }
#else
#define SETATTR(KIND) (void)hipFuncSetAttribute((const void*)k_phase<KIND>, hipFuncAttributeMaxDynamicSharedMemorySize, LDS_BYTES)
        SETATTR(K_PROLOGUE); SETATTR(K_H); SETATTR(K_INPROJ); SETATTR(K_PREP); SETATTR(K_QK); SETATTR(K_MIX); SETATTR(K_POST); SETATTR(K_OUT1); SETATTR(K_OUT2); SETATTR(K_NORM); SETATTR(K_CPREP); SETATTR(K_OUT2IN);
        (void)per_cu;
#endif
        (void)hipGetLastError();
        grid = cus;
    }
    if (grid < 0) return;
    (void)hipMemsetAsync((char*)d_ws + WS_CTL, 0, CTL_ZERO_BYTES, stream);
    Args a{};
    a.x = (const float*)d_in[0]; a.c = (const float*)d_in[1]; a.pos = (const int*)d_in[2]; a.w_ada = (const float*)d_in[3]; a.b_ada = (const float*)d_in[4];
    a.g_norm = (const float*)d_in[5]; a.w_in = (const float*)d_in[6]; a.b_ig = (const float*)d_in[7]; a.b_fg = (const float*)d_in[8]; a.w_conv = (const float*)d_in[9];
    a.b_conv = (const float*)d_in[10]; a.w_q = (const float*)d_in[11]; a.w_k = (const float*)d_in[12]; a.g_head = (const float*)d_in[13]; a.skip = (const float*)d_in[14];
    a.w_om = (const float*)d_in[15]; a.w_oa = (const float*)d_in[16]; a.w_o = (const float*)d_in[17]; a.g_final = (const float*)d_in[18];
    a.out = (float*)d_out; a.ws = (unsigned char*)d_ws;
#if MK_ONE_LAUNCH
    a.ph_lo = 0; a.ph_hi = PH_TOTAL;
    void* params[] = {&a};
    hipError_t e = hipLaunchCooperativeKernel((const void*)mk_fwd, dim3(grid), dim3(NTHR), params, LDS_BYTES, stream);
    if (e != hipSuccess) fprintf(stderr, "cooperative launch failed: %s\n", hipGetErrorString(e));
#else
#define LAUNCH(KIND, PASS) do { a.ph_lo = (PASS); a.ph_hi = 0; hipLaunchKernelGGL(k_phase<KIND>, dim3(grid), dim3(NTHR), LDS_BYTES, stream, a); } while (0)
    LAUNCH(K_PROLOGUE, 0); LAUNCH(K_H, 0);
    LAUNCH(K_PREP, 0); LAUNCH(K_INPROJ, 0);
    for (int p = 0; p < NPASS; ++p) { LAUNCH(K_CPREP, p); LAUNCH(K_MIX, p); LAUNCH(K_POST, p); LAUNCH(K_OUT1, p); if (p + 1 < NPASS) LAUNCH(K_OUT2IN, p); else LAUNCH(K_OUT2, p); }
    LAUNCH(K_NORM, 0);
#endif
}
```

```cpp
#include <hip/hip_runtime.h>
#include <hip/hip_cooperative_groups.h>
#include <cstdio>
#include <cstdint>
namespace cg = cooperative_groups;

#ifndef MK_ONE_LAUNCH
#define MK_ONE_LAUNCH 1
#endif

__device__ __forceinline__ int opaque_tid() { int t = threadIdx.x; asm volatile("" : "+v"(t)); return t; }
namespace pg8 {
#define PG8_LAS __attribute__((address_space(3)))
typedef unsigned short bf16_t;
typedef short bf16x8 __attribute__((ext_vector_type(8)));
typedef float f32x4 __attribute__((ext_vector_type(4)));
typedef unsigned u32x4 __attribute__((ext_vector_type(4)));
constexpr int BM = 256, BK = 64, HALF = 128, HTB = HALF * BK * 2, STAGE_BYTES = 8 * HTB, NXCD = 8, WGM = 8;

__host__ __device__ __forceinline__ int lds_byte(int r, int c) { const int st = (r >> 4) * 2 + (c >> 5), rr = r & 15, cc = c & 31, ob = rr * 64 + cc * 2; return st * 1024 + (ob ^ (((ob >> 9) & 1) << 5)); }
__host__ __device__ __forceinline__ void stage_rc(int b, int& R, int& C) { const int st = b / 1024, sb = b % 1024, swz = sb ^ (((sb >> 9) & 1) << 5); R = (st >> 1) * 16 + swz / 64; C = (st & 1) * 32 + (swz % 64) / 2; }
__host__ __device__ __forceinline__ int perm32(int rho) { const int n = rho >> 4, i = rho & 15; return 8 * (i >> 2) + 4 * n + (i & 3); }

struct Unit { int pm, pn, g; };
template <int LDA, int LDB, int KK, int AGS = 0, int BGS = 0> struct Gemm {
    const bf16_t* A; const bf16_t* Bt;
    static constexpr int lda = LDA, ldb = LDB, K = KK;
    __device__ __forceinline__ const char* abase(const Unit& u) const { return (const char*)A + (size_t)(u.g * AGS) + (size_t)u.pm * (size_t)(BM * 2 * LDA); }
    __device__ __forceinline__ const char* bbase(const Unit& u) const { return (const char*)Bt + (size_t)(u.g * BGS) + (size_t)u.pn * (size_t)(BM * 2 * LDB); }
};

struct StaticOrder {
    int nM, nN, nwg, G, c;
    __host__ __device__ void init(int M, int N, int G_, int c_) { nM = M / BM; nN = N / BM; nwg = nM * nN; G = G_; c = c_; }
    __host__ __device__ bool next(int i, Unit& u) const {
        const long L = (long)i * G + c; if (L >= nwg) return false;
        int wgid = (int)L; { const int q = nwg / NXCD, r = nwg % NXCD, xcd = wgid % NXCD, off = wgid / NXCD; wgid = (xcd < r ? xcd * (q + 1) : r * (q + 1) + (xcd - r) * q) + off; }
        const int nig = WGM * nN, gid = wgid / nig, fm = gid * WGM, gsz = (nM - fm) < WGM ? (nM - fm) : WGM;
        u.pm = fm + ((wgid % nig) % gsz); u.pn = (wgid % nig) / gsz; u.g = 0; return true;
    }
    __device__ __forceinline__ void a_ready(const Unit&) const {}
    __device__ __forceinline__ void done(const Unit&) const {}
};
struct GroupOrder {
    int nunits, G, c;
    __host__ __device__ void init(int M, int G_, int c_) { nunits = (M / BM) * 8; G = G_; c = c_; }
    __host__ __device__ bool next(int i, Unit& u) const {
        const long L = (long)i * G + c; if (L >= nunits) return false;
        u.pm = (int)(L >> 3); u.g = (int)((L & 7) >> 1); u.pn = (int)(L & 1); return true;
    }
    __device__ __forceinline__ void a_ready(const Unit&) const {}
    __device__ __forceinline__ void done(const Unit&) const {}
};

typedef __bf16 hwbf16x2_t __attribute__((ext_vector_type(2)));
__device__ __forceinline__ unsigned cvt_pk_bf16(float lo, float hi) { hwbf16x2_t v; v[0] = (__bf16)lo; v[1] = (__bf16)hi; return __builtin_bit_cast(unsigned, v); }

template <class Epi, class Sched, bool ALIGN_EPI, bool SP2, class GemmT>
__device__ __forceinline__ void gemm_phase(PG8_LAS unsigned char* lds, const GemmT g, const Sched& S, const Epi& E) {
    const int tid = opaque_tid(), wid = __builtin_amdgcn_readfirstlane(tid >> 6), lane = tid & 63, wr = wid >> 2, wc = wid & 3, fr = lane & 15, fq = lane >> 4;
    constexpr int K = GemmT::K, nt = K / BK;
    unsigned voffA[2], voffB[2];
#pragma unroll
    for (int i = 0; i < 2; ++i) { int R, C; stage_rc(tid * 16 + i * 8192, R, C); const int Rb = Epi::PERM ? (64 * (R >> 5) + perm32(R & 31)) : R;
        voffA[i] = (unsigned)(R * g.lda + C) * 2u; voffB[i] = (unsigned)(Rb * g.ldb + C) * 2u; }
    const size_t kstep = (size_t)(BK * 2);
    const size_t hstepA = (size_t)HALF * g.lda * 2, hstepB = (size_t)(Epi::PERM ? 32 : HALF) * g.ldb * 2;
    const unsigned ldsw = (unsigned)wid * 1024u;
    const int aoff = lds_byte(wr * 64 + fr, fq * 8), boff = lds_byte(wc * 32 + fr, fq * 8);
#define PG8_SA(b, h) (((b) * 2 + (h)) * HTB)
#define PG8_SB(b, h) ((4 + (b) * 2 + (h)) * HTB)
#define PG8_STAGE(bufoff, gbase, voff) do { _Pragma("unroll") for (int _i = 0; _i < 2; ++_i) \
        __builtin_amdgcn_global_load_lds((const unsigned*)((const char*)(gbase) + (voff)[_i]), (PG8_LAS unsigned*)(lds + (bufoff) + ldsw + _i * 8192), 16, 0, 0); } while (0)
#define PG8_LDA(dst, b, h) do { _Pragma("unroll") for (int m = 0; m < 4; ++m) _Pragma("unroll") for (int k = 0; k < 2; ++k) dst[m][k] = *(const PG8_LAS bf16x8*)(lds + PG8_SA(b, h) + aoff + m * 2048 + k * 1024); } while (0)
#define PG8_LDB(dst, b, h) do { _Pragma("unroll") for (int n = 0; n < 2; ++n) _Pragma("unroll") for (int k = 0; k < 2; ++k) dst[n][k] = *(const PG8_LAS bf16x8*)(lds + PG8_SB(b, h) + boff + n * 2048 + k * 1024); } while (0)
#define PG8_MMA(ai, bj, At, Bt) do { __builtin_amdgcn_s_setprio(1); _Pragma("unroll") for (int m = 0; m < 4; ++m) _Pragma("unroll") for (int n = 0; n < 2; ++n) _Pragma("unroll") for (int k = 0; k < 2; ++k) \
        acc[ai][bj][m][n] = __builtin_amdgcn_mfma_f32_16x16x32_bf16(Bt[n][k], At[m][k], acc[ai][bj][m][n], 0, 0, 0); __builtin_amdgcn_s_setprio(0); } while (0)
#define PG8_WAIT_V(n) asm volatile("s_waitcnt vmcnt(" #n ")" ::: "memory")
#define PG8_WAIT_L(n) asm volatile("s_waitcnt lgkmcnt(" #n ")" ::: "memory")
#define PG8_BAR __builtin_amdgcn_s_barrier()
#define PG8_SCHED __builtin_amdgcn_sched_barrier(0)
    Unit cur, nxt; int ui = 0;
    if (!S.next(0, cur)) return;
    f32x4 acc[2][2][4][2];
#pragma unroll
    for (int a = 0; a < 2; ++a)
#pragma unroll
        for (int b = 0; b < 2; ++b)
#pragma unroll
            for (int m = 0; m < 4; ++m)
#pragma unroll
                for (int n = 0; n < 2; ++n) acc[a][b][m][n] = (f32x4){0.f, 0.f, 0.f, 0.f};
    bf16x8 At[4][2], B0[2][2], B1[2][2];
    const char* cA = g.abase(cur); const char* cB = g.bbase(cur);
    S.a_ready(cur);
    if constexpr (SP2) {
        PG8_STAGE(PG8_SB(0, 0), cB, voffB); PG8_STAGE(PG8_SB(0, 1), cB + hstepB, voffB); PG8_STAGE(PG8_SA(0, 0), cA, voffA); PG8_STAGE(PG8_SA(0, 1), cA + hstepA, voffA);
        if (wr == 1) PG8_BAR;
        PG8_WAIT_V(2); PG8_BAR;
        PG8_STAGE(PG8_SB(1, 0), cB + kstep, voffB); PG8_STAGE(PG8_SA(1, 0), cA + kstep, voffA); PG8_STAGE(PG8_SB(1, 1), cB + hstepB + kstep, voffB);
        PG8_WAIT_V(6); PG8_BAR;
    } else {
        PG8_STAGE(PG8_SB(0, 0), cB, voffB); PG8_STAGE(PG8_SA(0, 0), cA, voffA); PG8_STAGE(PG8_SB(0, 1), cB + hstepB, voffB); PG8_STAGE(PG8_SA(0, 1), cA + hstepA, voffA);
        if (wr == 1) PG8_BAR;
        PG8_WAIT_V(4); PG8_BAR;
        PG8_STAGE(PG8_SB(1, 0), cB + kstep, voffB); PG8_STAGE(PG8_SA(1, 0), cA + kstep, voffA); PG8_STAGE(PG8_SB(1, 1), cB + hstepB + kstep, voffB);
        PG8_WAIT_V(6); PG8_BAR;
    }
    for (;;) {
        const bool has_next = S.next(ui + 1, nxt);
        const char* nA = has_next ? g.abase(nxt) : cA; const char* nB = has_next ? g.bbase(nxt) : cB;
#pragma nounroll
        for (int t = 0; t < nt; t += 2) {
            const bool last = (t == nt - 2);
            const char* a1 = cA + (size_t)(t + 1) * kstep;
            const char* a2 = last ? nA : cA + (size_t)(t + 2) * kstep; const char* b2 = last ? nB : cB + (size_t)(t + 2) * kstep;
            const char* a3 = a2 + kstep; const char* b3 = b2 + kstep;
            if (last && has_next) S.a_ready(nxt);
            if constexpr (Epi::HOOK_T >= 0) { if (t == Epi::HOOK_T) E.hook(acc, cur, wr, wc, fr, fq); }
            if constexpr (SP2) {
            PG8_LDB(B0, 0, 0); PG8_LDB(B1, 0, 1); PG8_SCHED; PG8_LDA(At, 0, 0); PG8_STAGE(PG8_SA(1, 1), a1 + hstepA, voffA);
            PG8_WAIT_V(8); PG8_WAIT_L(0); PG8_BAR; PG8_MMA(0, 0, At, B0); PG8_MMA(0, 1, At, B1); PG8_BAR; PG8_SCHED;
            PG8_LDA(At, 0, 1); PG8_STAGE(PG8_SB(0, 0), b2, voffB); PG8_STAGE(PG8_SB(0, 1), b2 + hstepB, voffB); PG8_STAGE(PG8_SA(0, 0), a2, voffA);
            PG8_WAIT_V(8); PG8_WAIT_L(0); PG8_BAR; PG8_MMA(1, 0, At, B0); PG8_MMA(1, 1, At, B1); PG8_BAR; PG8_SCHED;
            PG8_LDB(B0, 1, 0); PG8_LDB(B1, 1, 1); PG8_SCHED; PG8_LDA(At, 1, 0); PG8_STAGE(PG8_SA(0, 1), a2 + hstepA, voffA);
            PG8_WAIT_V(8); PG8_WAIT_L(0); PG8_BAR; PG8_MMA(0, 0, At, B0); PG8_MMA(0, 1, At, B1); PG8_BAR; PG8_SCHED;
            PG8_LDA(At, 1, 1); PG8_STAGE(PG8_SB(1, 0), b3, voffB); PG8_STAGE(PG8_SB(1, 1), b3 + hstepB, voffB); PG8_STAGE(PG8_SA(1, 0), a3, voffA);
            PG8_WAIT_V(8); PG8_WAIT_L(0); PG8_BAR; PG8_MMA(1, 0, At, B0); PG8_MMA(1, 1, At, B1); PG8_BAR; PG8_SCHED;
            } else {
            PG8_LDB(B0, 0, 0); PG8_SCHED; PG8_LDA(At, 0, 0); PG8_STAGE(PG8_SA(1, 1), a1 + hstepA, voffA);
            PG8_WAIT_L(8); PG8_BAR; PG8_WAIT_L(0); PG8_MMA(0, 0, At, B0); PG8_BAR; PG8_SCHED;
            PG8_LDB(B1, 0, 1); PG8_STAGE(PG8_SB(0, 0), b2, voffB);
            PG8_BAR; PG8_WAIT_L(0); PG8_MMA(0, 1, At, B1); PG8_BAR;
            PG8_LDA(At, 0, 1); PG8_STAGE(PG8_SA(0, 0), a2, voffA);
            PG8_BAR; PG8_WAIT_L(0); PG8_MMA(1, 0, At, B0); PG8_BAR; PG8_SCHED;
            PG8_STAGE(PG8_SB(0, 1), b2 + hstepB, voffB);
            PG8_WAIT_V(6); PG8_BAR; PG8_MMA(1, 1, At, B1); PG8_BAR;
            PG8_LDB(B0, 1, 0); PG8_SCHED; PG8_LDA(At, 1, 0); PG8_STAGE(PG8_SA(0, 1), a2 + hstepA, voffA);
            PG8_WAIT_L(8); PG8_BAR; PG8_WAIT_L(0); PG8_MMA(0, 0, At, B0); PG8_BAR; PG8_SCHED;
            PG8_LDB(B1, 1, 1); PG8_STAGE(PG8_SB(1, 0), b3, voffB);
            PG8_BAR; PG8_WAIT_L(0); PG8_MMA(0, 1, At, B1); PG8_BAR;
            PG8_LDA(At, 1, 1); PG8_STAGE(PG8_SA(1, 0), a3, voffA);
            PG8_BAR; PG8_WAIT_L(0); PG8_MMA(1, 0, At, B0); PG8_BAR; PG8_SCHED;
            PG8_STAGE(PG8_SB(1, 1), b3 + hstepB, voffB);
            PG8_WAIT_V(6); PG8_BAR; PG8_MMA(1, 1, At, B1); PG8_BAR;
            }
        }
        if constexpr (ALIGN_EPI) { if (wr == 0) PG8_BAR; }
        E(acc, cur, wr, wc, fr, fq); S.done(cur);
        if (!has_next) break;
#pragma unroll
        for (int a = 0; a < 2; ++a)
#pragma unroll
            for (int b = 0; b < 2; ++b)
#pragma unroll
                for (int m = 0; m < 4; ++m)
#pragma unroll
                    for (int n = 0; n < 2; ++n) acc[a][b][m][n] = (f32x4){0.f, 0.f, 0.f, 0.f};
        cur = nxt; cA = nA; cB = nB; ++ui;
        if constexpr (ALIGN_EPI) { if (wr == 1) PG8_BAR; }
    }
    PG8_WAIT_V(0);
    if constexpr (!ALIGN_EPI) { if (wr == 0) PG8_BAR; }
    PG8_BAR;
#undef PG8_SA
#undef PG8_SB
#undef PG8_STAGE
#undef PG8_LDA
#undef PG8_LDB
#undef PG8_MMA
#undef PG8_WAIT_V
#undef PG8_WAIT_L
#undef PG8_BAR
#undef PG8_SCHED
}
}

constexpr int NWAVES = 8, NTHR = 512;
constexpr int DM = 1024, NBATCH = 16, SEQ = 4096, MALL = NBATCH * SEQ;
constexpr int NB_PASS = 4, MS = NB_PASS * SEQ, NPASS = NBATCH / NB_PASS;
constexpr int INW_SRC = 11272, INW = 11264;
constexpr int C_XA = 0, C_VA = 1024, C_OA = 2048, C_ZA = 3072, C_QA = 4096, C_KA = 5632, C_VT = 7168, C_ZB = 8704, C_GA = 9216, C_GB = 10240;
constexpr float EPS = 1e-6f;

constexpr size_t MiB = 1u << 20;
constexpr size_t WS_CTL = 0, CTL_ZERO_BYTES = 1 * MiB;
constexpr size_t WS_MOD = 1 * MiB;
constexpr size_t WS_WG = 1 * MiB + 256 * 1024;
constexpr size_t WS_WIN = 2 * MiB;
constexpr size_t WS_WQK = 24 * MiB;
constexpr size_t WS_WOM = 25 * MiB, WS_WOA = 27 * MiB, WS_WO = 28 * MiB;
constexpr size_t WS_IG = 30 * MiB, WS_FG = 31 * MiB;
constexpr size_t WS_LSE = 34 * MiB;
constexpr size_t WS_DEN = 35 * MiB;
constexpr size_t WS_H = 36 * MiB;
constexpr size_t WS_P = 164 * MiB;
constexpr size_t WS_XC = 516 * MiB;
constexpr size_t WS_QM = 548 * MiB, WS_KM = WS_QM;
constexpr size_t WS_GSC = 580 * MiB, GSC_STRIDE = 2 * MiB;
constexpr size_t WS_AO = 588 * MiB;
constexpr size_t WS_ACAT = 636 * MiB;
constexpr size_t WS_MG = 684 * MiB;
constexpr size_t WS_SG = 716 * MiB;
constexpr size_t WS_KTG = 724 * MiB;
constexpr size_t WS_VTG = 756 * MiB;
constexpr size_t WS_CS = 788 * MiB;
constexpr size_t WS_NS = 852 * MiB;
constexpr size_t WS_ROPE = 853 * MiB;
constexpr size_t WS_QKV = 861 * MiB;
constexpr size_t WS_END = 1005 * MiB;
constexpr int CW_QCTR = 1024;
constexpr int CW_ROWSS = 65536;
static_assert((CW_ROWSS + MALL) * 4 <= (int)CTL_ZERO_BYTES, "ctl");

constexpr int LDS_BYTES = 147456;

typedef unsigned short bf16;
typedef float f32x4 __attribute__((ext_vector_type(4)));
typedef float f32x2 __attribute__((ext_vector_type(2)));
typedef short bf16x8 __attribute__((ext_vector_type(8)));
typedef unsigned u32x4 __attribute__((ext_vector_type(4)));
typedef unsigned u32x2 __attribute__((ext_vector_type(2)));
typedef short s16x4 __attribute__((ext_vector_type(4)));

typedef __bf16 hwbf16x2 __attribute__((ext_vector_type(2)));
__device__ __forceinline__ unsigned pk2(float lo, float hi) { hwbf16x2 v; v[0] = (__bf16)lo; v[1] = (__bf16)hi; return __builtin_bit_cast(unsigned, v); }
__device__ __forceinline__ unsigned f2bf(float f) { return (unsigned)__builtin_bit_cast(unsigned short, (__bf16)f); }
__device__ __forceinline__ float bflo(unsigned w) { return __builtin_bit_cast(float, w << 16); }
__device__ __forceinline__ float bfhi(unsigned w) { return __builtin_bit_cast(float, w & 0xffff0000u); }
__device__ __forceinline__ float bf1(bf16 v) { return __builtin_bit_cast(float, (unsigned)v << 16); }
__device__ __forceinline__ float sigmoidf_(float x) { return __builtin_amdgcn_rcpf(1.f + __expf(-x)); }
__device__ __forceinline__ float siluf_(float x) { return x * __builtin_amdgcn_rcpf(1.f + __expf(-x)); }
template <int CTRL> __device__ __forceinline__ float dpp_f(float v) { return __builtin_bit_cast(float, __builtin_amdgcn_update_dpp(0, __builtin_bit_cast(int, v), CTRL, 0xF, 0xF, false)); }
__device__ __forceinline__ float row16_sum(float v) { v += dpp_f<0xB1>(v); v += dpp_f<0x4E>(v); v += dpp_f<0x141>(v); v += dpp_f<0x140>(v); return v; }
__device__ __forceinline__ float xsum16(float v) { const unsigned u = __builtin_bit_cast(unsigned, v); const auto r = __builtin_amdgcn_permlane16_swap(u, u, false, false); return __builtin_bit_cast(float, (unsigned)r[0]) + __builtin_bit_cast(float, (unsigned)r[1]); }
__device__ __forceinline__ float xsum32(float v) { const unsigned u = __builtin_bit_cast(unsigned, v); const auto r = __builtin_amdgcn_permlane32_swap(u, u, false, false); return __builtin_bit_cast(float, (unsigned)r[0]) + __builtin_bit_cast(float, (unsigned)r[1]); }
__device__ __forceinline__ float xmax16(float v) { const unsigned u = __builtin_bit_cast(unsigned, v); const auto r = __builtin_amdgcn_permlane16_swap(u, u, false, false); return fmaxf(__builtin_bit_cast(float, (unsigned)r[0]), __builtin_bit_cast(float, (unsigned)r[1])); }
__device__ __forceinline__ float xmax32(float v) { const unsigned u = __builtin_bit_cast(unsigned, v); const auto r = __builtin_amdgcn_permlane32_swap(u, u, false, false); return fmaxf(__builtin_bit_cast(float, (unsigned)r[0]), __builtin_bit_cast(float, (unsigned)r[1])); }
__device__ __forceinline__ float wave_sum(float v) { return xsum32(xsum16(row16_sum(v))); }
__device__ __forceinline__ void unpack8(const u32x4 w, float* f) {
    f[0] = bflo(w.x); f[1] = bfhi(w.x); f[2] = bflo(w.y); f[3] = bfhi(w.y); f[4] = bflo(w.z); f[5] = bfhi(w.z); f[6] = bflo(w.w); f[7] = bfhi(w.w);
}

struct Args {
    const float* x; const float* c; const int* pos; const float* w_ada; const float* b_ada; const float* g_norm; const float* w_in;
    const float* b_ig; const float* b_fg; const float* w_conv; const float* b_conv; const float* w_q; const float* w_k; const float* g_head;
    const float* skip; const float* w_om; const float* w_oa; const float* w_o; const float* g_final;
    float* out; unsigned char* ws; int ph_lo, ph_hi;
};

__device__ __forceinline__ void transpose_item(const float* W, int K, int Nsrc, int nblk, int src_col_off, bf16* WT, int ldt, int row_off, float scale, float* scr, int item, int lane, bool frag = false) {
    const int kb = item / nblk, nb = item % nblk, k0 = 64 * kb, n0 = 32 * nb;
    { float tv[32];
#pragma unroll
      for (int i = 0; i < 32; ++i) tv[i] = W[(size_t)(k0 + 2 * i + (lane >> 5)) * Nsrc + src_col_off + n0 + (lane & 31)];
#pragma unroll
      for (int i = 0; i < 32; ++i) scr[(2 * i + (lane >> 5)) * 33 + (lane & 31)] = tv[i]; }
    __builtin_amdgcn_wave_barrier();
    asm volatile("s_waitcnt lgkmcnt(0)" ::: "memory");
    const int cc = lane & 7;
#pragma unroll
    for (int j = 0; j < 4; ++j) { const int n = (lane >> 3) + 8 * j; const float* s = scr + (8 * cc) * 33 + n;
        u32x4 o; o.x = pk2(s[0 * 33] * scale, s[1 * 33] * scale); o.y = pk2(s[2 * 33] * scale, s[3 * 33] * scale); o.z = pk2(s[4 * 33] * scale, s[5 * 33] * scale); o.w = pk2(s[6 * 33] * scale, s[7 * 33] * scale);
        if (frag) { const int nn = row_off + n0 + n, kc = (k0 >> 3) + cc; *(u32x4*)(WT + (size_t)((((nn >> 4) * (K >> 5) + (kc >> 2)) * 64 + (kc & 3) * 16 + (nn & 15)) * 8)) = o; }
        else *(u32x4*)(WT + (size_t)(row_off + n0 + n) * ldt + k0 + 8 * cc) = o; }
    asm volatile("s_waitcnt lgkmcnt(0)" ::: "memory");
    __builtin_amdgcn_wave_barrier();
}

__device__ __forceinline__ void phase_prologue(const Args& a, unsigned char* lds, int vcu, int G) {
    const int tid = opaque_tid(), lane = tid & 63, wave = tid >> 6;
    unsigned char* ws = a.ws;
    if (vcu < 192) {
        float* sc = (float*)lds;
        float* red = (float*)(lds + 65536);
        for (int i = tid; i < 16 * 1024; i += NTHR) sc[i] = siluf_(a.c[i]);
        __syncthreads();
        const int col = lane & 15, ksub = lane >> 4, n = vcu * 16 + col;
        float acc[16];
#pragma unroll
        for (int b = 0; b < 16; ++b) acc[b] = 0.f;
        const int k0 = wave * 128 + ksub * 32;
        const float* wp = a.w_ada + (size_t)k0 * 3072 + n;
#pragma unroll 1
        for (int kh = 0; kh < 4; ++kh) {
            const float* wq = wp + (size_t)(8 * kh) * 3072; const float* sq = sc + k0 + 8 * kh;
            float wv[8];
#pragma unroll
            for (int q = 0; q < 8; ++q) wv[q] = wq[q * 3072];
            __builtin_amdgcn_sched_barrier(0);
#pragma unroll
            for (int kq = 0; kq < 2; ++kq) {
#pragma unroll
                for (int b = 0; b < 16; ++b) { const f32x4 s4 = *(const f32x4*)(sq + b * 1024 + 4 * kq); acc[b] += (s4.x * wv[4 * kq] + s4.y * wv[4 * kq + 1]) + (s4.z * wv[4 * kq + 2] + s4.w * wv[4 * kq + 3]); }
                asm volatile("" ::: "memory"); __builtin_amdgcn_sched_barrier(0);
            }
        }
#pragma unroll
        for (int b = 0; b < 16; ++b) { float v = xsum32(xsum16(acc[b])); if (ksub == 0) red[(wave * 16 + b) * 16 + col] = v; }
        __syncthreads();
        float* mod = (float*)(ws + WS_MOD);
        if (tid < 256) { const int b = tid >> 4, l = tid & 15, nn = vcu * 16 + l; float s_ = 0.f;
#pragma unroll
            for (int w = 0; w < 8; ++w) s_ += red[(w * 16 + b) * 16 + l];
            s_ += a.b_ada[nn];
            const int part = nn >> 10, cc = nn & 1023;
            if (part == 1) s_ = a.g_norm[cc] * (1.f + s_);
            mod[b * 3072 + nn] = s_; }
        __syncthreads();
    }
    {
        float* scr = (float*)lds + wave * (64 * 33);
        const int gw = vcu * NWAVES + wave, NGW = G * NWAVES;
        constexpr int I_IN = (1024 / 64) * (INW / 32);
        constexpr int I_QK = 8 * (256 / 64) * (256 / 32);
        constexpr int I_OM = 16 * 32, I_OA = 8 * 32, I_O = 16 * 32;
        constexpr int NITEMS = I_IN + I_QK + I_OM + I_OA + I_O;
        for (int it = gw; it < NITEMS; it += NGW) {
            int r = it;
            if (r < I_IN) { const int nb = r % (INW / 32); const int off = (nb * 32 >= 4096) ? 8 : 0;
                transpose_item(a.w_in, 1024, INW_SRC, INW / 32, off, (bf16*)(ws + WS_WIN), 1024, 0, 1.f, scr, r, lane); continue; } r -= I_IN;
            if (r < I_QK) { const int mtx = r >> 5, rr = r & 31, h = mtx >> 1, isk = mtx & 1;
                const float* W = (isk ? a.w_k : a.w_q) + (size_t)h * 65536;
                transpose_item(W, 256, 256, 8, 0, (bf16*)(ws + WS_WQK) + (size_t)h * 512 * 256, 256, isk * 256, isk ? 0.0625f : 1.f, scr, rr, lane, true); continue; } r -= I_QK;
            if (r < I_OM) { transpose_item(a.w_om, 1024, 1024, 32, 0, (bf16*)(ws + WS_WOM), 1536, 0, 1.f, scr, r, lane); continue; } r -= I_OM;
            if (r < I_OA) { transpose_item(a.w_oa, 512, 1024, 32, 0, (bf16*)(ws + WS_WOM) + 1024, 1536, 0, 1.f, scr, r, lane); continue; } r -= I_OA;
            transpose_item(a.w_o, 1024, 1024, 32, 0, (bf16*)(ws + WS_WO), 1024, 0, 1.f, scr, r, lane);
        }
        float* wg = (float*)(ws + WS_WG);
        for (int i = (vcu * NTHR + tid); i < 8 * 1024; i += G * NTHR) { const int j = i >> 10, k = i & 1023; wg[i] = a.w_in[(size_t)k * INW_SRC + 4096 + j]; }
    }
}

__constant__ double c_inv_freq[16] = {1.0, 0.44036660267178046, 0.19392274474868576, 0.08539710028576561, 0.03760603093086393, 0.016560440080994446, 0.007292664737217109, 0.003211445994752591,
    0.001414213562373095, 0.000622772421914596, 0.0002742481756762073, 0.00012076973741146504, 5.318295896944988e-05, 2.341999896140934e-05, 1.031338537721246e-05, 4.5416704806078695e-06};

__device__ __forceinline__ void phase_h(const Args& a, unsigned char* lds, int vcu, int G) {
    const int tid = opaque_tid(), lane = tid & 63, wave = tid >> 6;
    unsigned char* ws = a.ws;
    float* wg = (float*)lds;
    { const float* src = (const float*)(ws + WS_WG); for (int i = tid; i < 8192; i += NTHR) wg[i] = src[i]; }
    __syncthreads();
    const float* mod = (const float*)(ws + WS_MOD);
    bf16* H = (bf16*)(ws + WS_H);
    float* IG = (float*)(ws + WS_IG); float* FG = (float*)(ws + WS_FG); float* ROPE = (float*)(ws + WS_ROPE);
    const int gw = vcu * NWAVES + wave, NGW = G * NWAVES;
    const f32x4 big = *(const f32x4*)a.b_ig, bfg = *(const f32x4*)a.b_fg;
    const double invf = c_inv_freq[lane & 15] * 0.15915494309189535;
    const int grr = lane & 1, ggt = ((lane >> 1) & 1) * 4 + ((lane >> 2) & 1) * 2 + ((lane >> 3) & 1);
    float* gdst = (ggt < 4 ? IG : FG) + grr * 4 + (ggt & 3);
    const float gbias = ggt < 4 ? big[ggt & 3] : bfg[ggt & 3];
    for (int blk = gw; blk < MALL / 32; blk += NGW) {
    const int rb = 32 * blk, b = rb >> 12;
    f32x4 shv[4], gsv[4];
#pragma unroll
    for (int j = 0; j < 4; ++j) { shv[j] = *(const f32x4*)(mod + b * 3072 + 4 * lane + 256 * j); gsv[j] = *(const f32x4*)(mod + b * 3072 + 1024 + 4 * lane + 256 * j); }
    f32x4 vn[2][4]; int posn;
#pragma unroll
    for (int rr = 0; rr < 2; ++rr) { const f32x4* xr = (const f32x4*)(a.x + (size_t)(rb + rr) * DM) + lane;
#pragma unroll
        for (int j = 0; j < 4; ++j) vn[rr][j] = xr[64 * j]; }
    posn = a.pos[rb + (lane >> 5)];
#pragma nounroll
    for (int t = 0; t < 16; ++t) {
        const int row0 = rb + 2 * t;
        f32x4 v[2][4]; float ss[2] = {0.f, 0.f};
#pragma unroll
        for (int rr = 0; rr < 2; ++rr)
#pragma unroll
            for (int j = 0; j < 4; ++j) v[rr][j] = vn[rr][j];
        const int pos = posn;
        __builtin_amdgcn_sched_barrier(0);
        { const int rown = t < 15 ? row0 + 2 : row0;
#pragma unroll
          for (int rr = 0; rr < 2; ++rr) { const f32x4* xr = (const f32x4*)(a.x + (size_t)(rown + rr) * DM) + lane;
#pragma unroll
              for (int j = 0; j < 4; ++j) vn[rr][j] = xr[64 * j]; }
          posn = a.pos[rown + (lane >> 5)]; }
        __builtin_amdgcn_sched_barrier(0);
        {
            const double rev = (double)pos * invf; const float fr_ = (float)(rev - rint(rev));
            ROPE[(size_t)row0 * 32 + lane] = (lane & 16) ? __builtin_amdgcn_sinf(fr_) : __builtin_amdgcn_cosf(fr_); }
#pragma unroll
        for (int rr = 0; rr < 2; ++rr) {
#pragma unroll
            for (int j = 0; j < 4; ++j) ss[rr] += (v[rr][j].x * v[rr][j].x + v[rr][j].y * v[rr][j].y) + (v[rr][j].z * v[rr][j].z + v[rr][j].w * v[rr][j].w);
        }
        ss[0] = wave_sum(ss[0]); ss[1] = wave_sum(ss[1]);
        float pg[2][8];
#pragma unroll
        for (int rr = 0; rr < 2; ++rr)
#pragma unroll
            for (int g = 0; g < 8; ++g) pg[rr][g] = 0.f;
        const float rinv[2] = {__builtin_amdgcn_rsqf(ss[0] * (1.f / DM) + EPS), __builtin_amdgcn_rsqf(ss[1] * (1.f / DM) + EPS)};
#pragma unroll
        for (int j = 0; j < 4; ++j) {
            const int col = 4 * lane + 256 * j;
            const f32x4 sh = shv[j], gs = gsv[j];
            f32x4 h[2];
#pragma unroll
            for (int rr = 0; rr < 2; ++rr) { h[rr] = v[rr][j] * rinv[rr] * gs + sh;
                u32x2 o; o.x = pk2(h[rr].x, h[rr].y); o.y = pk2(h[rr].z, h[rr].w); *((u32x2*)(H + (size_t)(row0 + rr) * DM) + lane + 64 * j) = o; }
#pragma unroll
            for (int g = 0; g < 8; ++g) { const f32x4 w = *(const f32x4*)(wg + g * 1024 + col);
                pg[0][g] += (h[0].x * w.x + h[0].y * w.y) + (h[0].z * w.z + h[0].w * w.w); pg[1][g] += (h[1].x * w.x + h[1].y * w.y) + (h[1].z * w.z + h[1].w * w.w); }
            __builtin_amdgcn_sched_barrier(0);
        }
        {
            float t8[8], t4[4], t2[2], t1;
            { const bool up = lane & 1;
#pragma unroll
              for (int i = 0; i < 8; ++i) { const float lo_ = pg[0][i], hi_ = pg[1][i]; const float keep = up ? hi_ : lo_, send = up ? lo_ : hi_; t8[i] = keep + dpp_f<0xB1>(send); } }
            { const bool up = lane & 2;
#pragma unroll
              for (int i = 0; i < 4; ++i) { const float keep = up ? t8[i + 4] : t8[i], send = up ? t8[i] : t8[i + 4]; t4[i] = keep + dpp_f<0x4E>(send); } }
            { const bool up = lane & 4;
#pragma unroll
              for (int i = 0; i < 2; ++i) { const float keep = up ? t4[i + 2] : t4[i], send = up ? t4[i] : t4[i + 2]; t2[i] = keep + __shfl_xor(send, 4); } }
            { const bool up = lane & 8; const float keep = up ? t2[1] : t2[0], send = up ? t2[0] : t2[1]; t1 = keep + __shfl_xor(send, 8); }
            t1 = xsum32(xsum16(t1));
            gdst[(size_t)row0 * 4] = t1 + gbias;
        }
    }
    }
}

constexpr int GATE_COL = 4096;
struct EpiProj {
    static constexpr bool PERM = true; static constexpr int HOOK_T = -1;
    bf16* P; const float* rope; bf16* QKV;
    template <bool ROT>
    __device__ __forceinline__ void run(const f32x4 (&acc)[2][2][4][2], const pg8::Unit& u, int wr, int wc, int fr, int fq) const {
        const int row0 = u.pm * 256 + wr * 64 + fr, col0 = u.pn * 256 + wc * 64 + 8 * fq;
        const bool att = (u.pn >= 16) && (u.pn < 34);
        const int hq = att ? (u.pn - 16) * 2 + (wc >> 1) : 0, lg = 2 * ((hq % 12) >> 2);
        const bool gat = u.pn >= 36;
        const int gq = gat ? (u.pm * 4 + ((u.pn - 36) & 3)) * 2 + ((u.pn - 36) >> 2) : 0;
        f32x4 rc0, rc1, rs0, rs1;
        if constexpr (ROT) { const float* tp = rope + (size_t)row0 * 32 + 8 * (fq & 1); rc0 = *(const f32x4*)tp; rc1 = *(const f32x4*)(tp + 4); rs0 = *(const f32x4*)(tp + 16); rs1 = *(const f32x4*)(tp + 20); }
#pragma unroll
        for (int it = 0; it < 8; ++it) { const int ai = it >> 2, m = it & 3;
                const int r = row0 + ai * 128 + m * 16; const int sq = r & (SEQ - 1);
                const int rq = (r & ~(SEQ - 1)) + ((sq & ((1 << lg) - 1)) << (12 - lg)) + (sq >> lg);
                bf16* rowp = att ? QKV + ((size_t)hq * MS + rq) * 128 + (wc & 1) * 64 + 8 * fq : P + (size_t)r * INW + col0;
                if (gat) rowp = P + (size_t)(gq * 16 + ai * 8 + m * 2) * INW + GATE_COL + (wr * 4 + wc) * 512 + (fq * 16 + fr) * 8;
                f32x4 nc0, nc1, ns0, ns1;
                if constexpr (ROT) { if (it < 7) { const int rn = row0 + ((it + 1) >> 2) * 128 + ((it + 1) & 3) * 16; const float* tp = rope + (size_t)rn * 32 + 8 * (fq & 1);
                    nc0 = *(const f32x4*)tp; nc1 = *(const f32x4*)(tp + 4); ns0 = *(const f32x4*)(tp + 16); ns1 = *(const f32x4*)(tp + 20); } }
#pragma unroll
                for (int bj = 0; bj < 2; ++bj) { f32x4 v0 = acc[ai][bj][m][0], v1 = acc[ai][bj][m][1];
                    if constexpr (ROT) { if (bj == 0) {
                        f32x4 p0, p1;
#pragma unroll
                        for (int e = 0; e < 4; ++e) { p0[e] = __shfl_xor(v0[e], 32); p1[e] = __shfl_xor(v1[e], 32); }
                        const float sg = (fq < 2) ? -1.f : 1.f;
                        v0 = v0 * rc0 + p0 * rs0 * sg; v1 = v1 * rc1 + p1 * rs1 * sg;
                    } }
                    u32x4 w; w.x = pg8::cvt_pk_bf16(v0[0], v0[1]); w.y = pg8::cvt_pk_bf16(v0[2], v0[3]); w.z = pg8::cvt_pk_bf16(v1[0], v1[1]); w.w = pg8::cvt_pk_bf16(v1[2], v1[3]);
                    *(u32x4*)(rowp + (gat ? bj * INW : bj * 32)) = w; }
                if constexpr (ROT) { if (it < 7) { rc0 = nc0; rc1 = nc1; rs0 = ns0; rs1 = ns1; } } }
    }
    __device__ __forceinline__ void operator()(const f32x4 (&acc)[2][2][4][2], const pg8::Unit& u, int wr, int wc, int fr, int fq) const {
        const bool rot = (u.pn >= 16) && (u.pn < 28) && ((wc & 1) == 0);
        if (rot) run<true>(acc, u, wr, wc, fr, fq); else run<false>(acc, u, wr, wc, fr, fq);
    }
};
struct EpiQK {
    static constexpr bool PERM = true; static constexpr int HOOK_T = -1;
    bf16* QM; bf16* KM;
    __device__ __forceinline__ void operator()(const f32x4 (&acc)[2][2][4][2], const pg8::Unit& u, int wr, int wc, int fr, int fq) const {
        const int row0 = u.pm * 256 + wr * 64 + fr, col0 = u.g * 256 + wc * 64 + 8 * fq;
        bf16* base = u.pn ? KM : QM;
#pragma unroll
        for (int ai = 0; ai < 2; ++ai)
#pragma unroll
            for (int m = 0; m < 4; ++m) { bf16* rowp = base + (size_t)(row0 + ai * 128 + m * 16) * 1024 + col0;
#pragma unroll
                for (int bj = 0; bj < 2; ++bj) { const f32x4 v0 = acc[ai][bj][m][0], v1 = acc[ai][bj][m][1];
                    u32x4 w; w.x = pg8::cvt_pk_bf16(v0[0], v0[1]); w.y = pg8::cvt_pk_bf16(v0[2], v0[3]); w.z = pg8::cvt_pk_bf16(v1[0], v1[1]); w.w = pg8::cvt_pk_bf16(v1[2], v1[3]);
                    *(u32x4*)(rowp + bj * 32) = w; } }
    }
};
struct EpiMerge {
    static constexpr bool PERM = true; static constexpr int HOOK_T = 16;
    const bf16* P; bf16* MG;
    __device__ __forceinline__ void hook(f32x4 (&acc)[2][2][4][2], const pg8::Unit& u, int wr, int wc, int fr, int fq) const {
        int lo = (wr * 4 + wc) * 512 + (fq * 16 + fr) * 8; const int gq0 = (u.pm * 4 + u.pn) * 2;
        asm volatile("" : "+v"(lo));
#pragma unroll
        for (int ai = 0; ai < 2; ++ai)
#pragma unroll
            for (int m = 0; m < 4; ++m) {
#pragma unroll
                for (int bj = 0; bj < 2; ++bj) {
                    const bf16* gp = P + (size_t)(gq0 * 16 + ai * 8 + m * 2 + bj) * INW + GATE_COL + lo;
                    const u32x4 gaw = *(const u32x4*)gp, gbw = *(const u32x4*)(gp + 16 * INW);
                    float ga[8], gb[8]; unpack8(gaw, ga); unpack8(gbw, gb);
#pragma unroll
                    for (int e = 0; e < 4; ++e) {
                        acc[ai][bj][m][0][e] *= (1.f + __expf(-gb[e])) * __builtin_amdgcn_rcpf(1.f + __expf(-ga[e]));
                        acc[ai][bj][m][1][e] *= (1.f + __expf(-gb[4 + e])) * __builtin_amdgcn_rcpf(1.f + __expf(-ga[4 + e])); } }
                __builtin_amdgcn_sched_barrier(0); }
    }
    __device__ __forceinline__ void operator()(const f32x4 (&acc)[2][2][4][2], const pg8::Unit& u, int wr, int wc, int fr, int fq) const {
        const int row0 = u.pm * 256 + wr * 64 + fr, col0 = u.pn * 256 + wc * 64 + 8 * fq;
        int lo = (wr * 4 + wc) * 512 + (fq * 16 + fr) * 8; const int gq0 = (u.pm * 4 + u.pn) * 2;
        asm volatile("" : "+v"(lo));
#pragma unroll
        for (int ai = 0; ai < 2; ++ai) {
            u32x4 gw[4][2];
#pragma unroll
            for (int m = 0; m < 4; ++m)
#pragma unroll
                for (int bj = 0; bj < 2; ++bj) gw[m][bj] = *(const u32x4*)(P + (size_t)(gq0 * 16 + 16 + ai * 8 + m * 2 + bj) * INW + GATE_COL + lo);
#pragma unroll
            for (int m = 0; m < 4; ++m) { const size_t r = (size_t)(row0 + ai * 128 + m * 16);
#pragma unroll
                for (int bj = 0; bj < 2; ++bj) { const int c = col0 + bj * 32;
                    float gb[8]; unpack8(gw[m][bj], gb);
                    const f32x4 v0 = acc[ai][bj][m][0], v1 = acc[ai][bj][m][1];
                    float o[8];
#pragma unroll
                    for (int e = 0; e < 4; ++e) { o[e] = sigmoidf_(gb[e]) * v0[e]; o[4 + e] = sigmoidf_(gb[4 + e]) * v1[e]; }
                    u32x4 w; w.x = pg8::cvt_pk_bf16(o[0], o[1]); w.y = pg8::cvt_pk_bf16(o[2], o[3]); w.z = pg8::cvt_pk_bf16(o[4], o[5]); w.w = pg8::cvt_pk_bf16(o[6], o[7]);
                    *(u32x4*)(MG + r * 1024 + c) = w; } }
        }
    }
};
struct EpiOut {
    static constexpr bool PERM = true; static constexpr int HOOK_T = -1;
    bf16* dl; const float* gate; int grow0;
    __device__ __forceinline__ void operator()(const f32x4 (&acc)[2][2][4][2], const pg8::Unit& u, int wr, int wc, int fr, int fq) const {
        int col0 = u.pn * 256 + wc * 64 + 8 * fq; const int row0 = grow0 + u.pm * 256 + wr * 64 + fr;
        asm volatile("" : "+v"(col0));
        const int b = row0 >> 12;
        f32x4 gv[2][2];
#pragma unroll
        for (int bj = 0; bj < 2; ++bj) { const float* gp = gate + b * 3072 + col0 + bj * 32; gv[bj][0] = *(const f32x4*)gp; gv[bj][1] = *(const f32x4*)(gp + 4); }
#pragma unroll
        for (int ai = 0; ai < 2; ++ai)
#pragma unroll
            for (int m = 0; m < 4; ++m) { const int r = row0 + ai * 128 + m * 16;
#pragma unroll
                for (int bj = 0; bj < 2; ++bj) { const int c = col0 + bj * 32;
                    const f32x4 g0 = gv[bj][0], g1 = gv[bj][1];
                    const f32x4 o0 = g0 * acc[ai][bj][m][0], o1 = g1 * acc[ai][bj][m][1];
                    u32x4 w; w.x = pg8::cvt_pk_bf16(o0[0], o0[1]); w.y = pg8::cvt_pk_bf16(o0[2], o0[3]); w.z = pg8::cvt_pk_bf16(o1[0], o1[1]); w.w = pg8::cvt_pk_bf16(o1[2], o1[3]);
                    *(u32x4*)(dl + (size_t)r * 1024 + c) = w; } }
    }
};

struct ComboOrder {
    int nO, G, c;
    static constexpr int nV = (1024 / 256) * (MS / 256);
    __device__ void init(int G_, int c_, bool with_out2) { G = G_; c = c_; nO = with_out2 ? (MS / 256) * 4 : 0; }
    __device__ bool next(int i, pg8::Unit& u) const {
        const int L = i * G + c;
        pg8::StaticOrder o;
        if (L < nO) { o.init(MS, 1024, 1, 0); o.next(L, u); u.g = 0; return true; }
        if (L < nO + nV) { o.init(1024, MS, 1, 0); o.next(L - nO, u); u.g = 2; return true; }
        o.init(MS, INW - 1024, 1, 0);
        if (!o.next(L - nO - nV, u)) return false;
        if (u.pn >= 4) u.pn += 4;
        u.g = 1; return true;
    }
    __device__ __forceinline__ void a_ready(const pg8::Unit&) const {}
    __device__ __forceinline__ void done(const pg8::Unit&) const {}
};
struct GemmCombo {
    const char* ws; size_t hoff;
    static constexpr int lda = 1024, ldb = 1024, K = 1024;
    __device__ __forceinline__ const char* abase(const pg8::Unit& u) const {
        size_t off = WS_MG; if (u.g == 1) off = hoff; if (u.g == 2) off = WS_WIN + (size_t)C_VA * 2048;
        return ws + off + (size_t)u.pm * (size_t)(pg8::BM * 2 * 1024); }
    __device__ __forceinline__ const char* bbase(const pg8::Unit& u) const {
        size_t off = WS_WO; if (u.g == 1) off = WS_WIN; if (u.g == 2) off = hoff;
        return ws + off + (size_t)u.pn * (size_t)(pg8::BM * 2 * 1024); }
};
struct EpiVT {
    static constexpr bool PERM = true; static constexpr int HOOK_T = -1;
    bf16* VTG;
    __device__ __forceinline__ void operator()(const f32x4 (&acc)[2][2][4][2], const pg8::Unit& u, int wr, int wc, int fr, int fq) const {
        const int row0 = u.pm * 256 + wr * 64 + fr, col0 = u.pn * 256 + wc * 64 + 8 * fq;
#pragma unroll
        for (int ai = 0; ai < 2; ++ai)
#pragma unroll
            for (int m = 0; m < 4; ++m) { const int r = row0 + ai * 128 + m * 16, h = r >> 8, e = r & 255;
#pragma unroll
                for (int bj = 0; bj < 2; ++bj) { const int c = col0 + bj * 32, chunk = c >> 6, l = c & 63;
                    const f32x4 v0 = acc[ai][bj][m][0], v1 = acc[ai][bj][m][1];
                    u32x4 w; w.x = pg8::cvt_pk_bf16(v0[0], v0[1]); w.y = pg8::cvt_pk_bf16(v0[2], v0[3]); w.z = pg8::cvt_pk_bf16(v1[0], v1[1]); w.w = pg8::cvt_pk_bf16(v1[2], v1[3]);
                    *(u32x4*)(VTG + (size_t)(chunk * 4 + h) * 16384 + (((e >> 4) * 2 + (l >> 5)) * 64 + ((l >> 3) & 3) * 16 + (e & 15)) * 8) = w; } }
    }
};
struct EpiCombo {
    static constexpr bool PERM = true; static constexpr int HOOK_T = -1;
    EpiOut eo; EpiProj ep; EpiVT ev;
    __device__ __forceinline__ void operator()(const f32x4 (&acc)[2][2][4][2], const pg8::Unit& u, int wr, int wc, int fr, int fq) const {
        if (u.g == 1) ep(acc, u, wr, wc, fr, fq); else if (u.g == 2) ev(acc, u, wr, wc, fr, fq); else eo(acc, u, wr, wc, fr, fq);
    }
};

__device__ __forceinline__ void phase_gates(const Args& a, unsigned char* lds, int vcu, int G) {
    const int tid = opaque_tid(), lane = tid & 63, wave = tid >> 6;
    unsigned char* ws = a.ws;
    for (int gi = vcu; gi < NBATCH * 4; gi += G) {
        const int pass = gi >> 4, bl = (gi >> 2) & 3, h = gi & 3;
        const float* IG = (const float*)(ws + WS_IG); const float* FG = (const float*)(ws + WS_FG);
        float* gsc = (float*)(ws + WS_GSC + (size_t)pass * GSC_STRIDE);
        float* A1 = gsc, *B1 = gsc + MS * 4, *WI = gsc + 2 * MS * 4, *EF = gsc + 3 * MS * 4, *WK = gsc + 4 * MS * 4, *DEC = gsc + 5 * MS * 4;
        float* cg = (float*)lds; float* cp = cg + 64;
        __syncthreads();
        float f[8], ii[8];
#pragma unroll
        for (int q = 0; q < 8; ++q) { const size_t grow = (size_t)pass * MS + bl * SEQ + (wave * 8 + q) * 64 + lane; f[q] = FG[grow * 4 + h]; ii[q] = IG[grow * 4 + h]; }
        float acs[8], b1[8], pm[8];
#pragma unroll
        for (int q = 0; q < 8; ++q) {
            float x = fminf(f[q], 0.f) - __logf(1.f + __expf(-fabsf(f[q])));
#pragma unroll
            for (int o = 1; o < 64; o <<= 1) { const float t = __shfl_up(x, o); if (lane >= o) x += t; }
            acs[q] = x; b1[q] = ii[q] - x;
            float m = b1[q];
#pragma unroll
            for (int o = 1; o < 64; o <<= 1) { const float t = __shfl_up(m, o); if (lane >= o) m = fmaxf(m, t); }
            pm[q] = m;
            if (lane == 63) { cg[wave * 8 + q] = x; cp[wave * 8 + q] = m; }
        }
        __syncthreads();
        float m_prev = 0.f, mp[8], Ms8[8];
        for (int j = 0; j < 64; ++j) { const float Ms = fmaxf(m_prev, cp[j]);
#pragma unroll
            for (int q = 0; q < 8; ++q) if (j == wave * 8 + q) { mp[q] = m_prev; Ms8[q] = Ms; }
            m_prev = cg[j] + Ms; }
#pragma unroll
        for (int q = 0; q < 8; ++q) {
            const int j = wave * 8 + q, lrow = bl * SEQ + j * 64 + lane;
            const float mx = fmaxf(mp[q], pm[q]);
            A1[h * MS + lrow] = -mx; B1[h * MS + lrow] = b1[q]; WI[h * MS + lrow] = __expf(mp[q] - mx); EF[h * MS + lrow] = __expf(-(acs[q] + mx)); WK[h * MS + lrow] = __expf(b1[q] - Ms8[q]);
            if (lane == 0) { DEC[h * (MS / 64) + bl * 64 + j] = expf(mp[q] - Ms8[q]); DEC[4 * (MS / 64) + h * (MS / 64) + bl * 64 + j] = Ms8[q]; }
        }
    }
}

__device__ __forceinline__ f32x4 mfma16(bf16x8 a, bf16x8 b, f32x4 c) { return __builtin_amdgcn_mfma_f32_16x16x32_bf16(a, b, c, 0, 0, 0); }

constexpr int TPS = 72;
constexpr int XCS = 264;
constexpr int L_QC_X = 0, L_QC_Q = 36864, L_QC_KT = L_QC_Q + 64 * XCS * 2, L_QC_ST = L_QC_KT + 256 * TPS * 2, L_QC_END = L_QC_ST + 64 * TPS * 2;
static_assert(64 * XCS * 2 <= 36864 && 256 * TPS * 2 <= 36864 && L_QC_END + 768 + 5120 <= 131072, "qkc lds");
#define CP_BAR() do { asm volatile("s_waitcnt lgkmcnt(0)" ::: "memory"); __builtin_amdgcn_s_barrier(); asm volatile("" ::: "memory"); } while (0)
__device__ __forceinline__ void cprep_fetch(const bf16* P, const float* gsc, int ci, int tid, u32x4 (&xr)[7], float& gw) {
    const int h = ci & 3, t0 = (ci >> 2) * 64, ch0 = h * 256 + 8 * (tid & 31);
    const bf16* p0 = P + ((ptrdiff_t)(t0 + 4 * (tid >> 5) - 3)) * INW + C_XA + ch0;
#pragma unroll
    for (int k = 0; k < 7; ++k) xr[k] = *(const u32x4*)(p0 + (ptrdiff_t)k * INW);
    const int wv = tid >> 6;
    gw = gsc[wv == 0 ? 4 * MS * 4 + h * MS + t0 + (tid & 63) : wv == 1 ? h * MS + t0 + (tid & 63) : 5 * MS * 4 + 4 * (MS / 64) + h * (MS / 64) + (ci >> 2)];
}
__device__ __forceinline__ void phase_cprep(const Args& a, unsigned char* lds, int vcu, int G, int pass) {
    const int tid = opaque_tid(), lane = tid & 63, wave = __builtin_amdgcn_readfirstlane(tid >> 6);
    const int fr = lane & 15, fq = lane >> 4;
    unsigned char* ws = a.ws;
    const bf16* P = (const bf16*)(ws + WS_P); bf16* XCW = (bf16*)(ws + WS_XC); bf16* QM = (bf16*)(ws + WS_QM);
    const bf16* WF = (const bf16*)(ws + WS_WQK);
    const float* gsc = (const float*)(ws + WS_GSC + (size_t)pass * GSC_STRIDE);
    bf16* SG = (bf16*)(ws + WS_SG); bf16* KTG = (bf16*)(ws + WS_KTG);
    bf16* XS = (bf16*)(lds + L_QC_X); bf16* QL = (bf16*)(lds + L_QC_Q); bf16* KT = (bf16*)(lds + L_QC_KT); bf16* ST = (bf16*)(lds + L_QC_ST);
    float* GL = (float*)(lds + L_QC_END);
    float* CWL = GL + 192;
    int hw = -1;
    bf16x8 wq0[8], wq1[8], wq2[8], wq3[8];
    const int ti = wave >> 1, tj0 = 2 * (wave & 1);
    constexpr int NITEMS = (MS / 64) * 4;
    u32x4 xr[7]; float gw = 0.f;
    cprep_fetch(P, gsc, vcu < NITEMS ? vcu : 0, tid, xr, gw);
    const int tid0 = tid;
    for (int ci = vcu; ci < NITEMS; ci += G) {
        int tid = tid0; asm volatile("" : "+v"(tid));
        const int lane = tid & 63, fr = lane & 15, fq = lane >> 4;
        const int h = ci & 3, t0 = (ci >> 2) * 64;
        const bool has_next = ci + G < NITEMS, seq0 = (t0 & (SEQ - 1)) == 0;
        if (h != hw) {
            CP_BAR();
            for (int idx = tid; idx < 1280; idx += NTHR) CWL[idx] = idx < 1024 ? a.w_conv[(idx >> 8) * 1024 + h * 256 + (idx & 255)] : a.b_conv[h * 256 + idx - 1024];
            CP_BAR();
            hw = h;
            const bf16* wf = WF + (size_t)h * 512 * 256;
#define CP_LOADW(dst, ct) do { _Pragma("unroll") for (int ks = 0; ks < 8; ++ks) dst[ks] = *(const bf16x8*)(wf + (size_t)(((4 * wave + (ct)) * 8 + ks) * 64 + lane) * 8); } while (0)
            CP_LOADW(wq0, 0); CP_LOADW(wq1, 1); CP_LOADW(wq2, 2); CP_LOADW(wq3, 3);
#undef CP_LOADW
        }
        CP_BAR();
        {
            const int cc = tid & 31, rg = tid >> 5, ch0 = h * 256 + 8 * cc;
            if (seq0 && rg == 0) { xr[0] = (u32x4){0u, 0u, 0u, 0u}; xr[1] = (u32x4){0u, 0u, 0u, 0u}; xr[2] = (u32x4){0u, 0u, 0u, 0u}; }
            float bc[8];
            { const f32x4 b0 = *(const f32x4*)(CWL + 1024 + 8 * cc), b1 = *(const f32x4*)(CWL + 1024 + 8 * cc + 4);
              bc[0] = b0[0]; bc[1] = b0[1]; bc[2] = b0[2]; bc[3] = b0[3]; bc[4] = b1[0]; bc[5] = b1[1]; bc[6] = b1[2]; bc[7] = b1[3]; }
            float y[4][8];
#pragma unroll
            for (int i = 0; i < 4; ++i)
#pragma unroll
                for (int e = 0; e < 8; ++e) y[i][e] = bc[e];
#pragma unroll
            for (int j = 0; j < 4; ++j) {
                float wc[8];
                { const f32x4 w0 = *(const f32x4*)(CWL + j * 256 + 8 * cc), w1 = *(const f32x4*)(CWL + j * 256 + 8 * cc + 4);
                  wc[0] = w0[0]; wc[1] = w0[1]; wc[2] = w0[2]; wc[3] = w0[3]; wc[4] = w1[0]; wc[5] = w1[1]; wc[6] = w1[2]; wc[7] = w1[3]; }
#pragma unroll
                for (int i = 0; i < 4; ++i) { float xv[8]; unpack8(xr[i + j], xv);
#pragma unroll
                    for (int e = 0; e < 8; ++e) y[i][e] += wc[e] * xv[e]; }
            }
#pragma unroll
            for (int i = 0; i < 4; ++i) {
                u32x4 o; o.x = pk2(siluf_(y[i][0]), siluf_(y[i][1])); o.y = pk2(siluf_(y[i][2]), siluf_(y[i][3])); o.z = pk2(siluf_(y[i][4]), siluf_(y[i][5])); o.w = pk2(siluf_(y[i][6]), siluf_(y[i][7]));
                *(u32x4*)(XCW + (size_t)(t0 + 4 * rg + i) * 1024 + ch0) = o;
                *(u32x4*)(XS + (4 * rg + i) * XCS + 8 * cc) = o; }
        }
        if (tid < 192) GL[tid] = gw;
        CP_BAR();
#define CP_EPI(acc, ct) do { \
                if (wave < 4) { \
                    _Pragma("unroll") for (int i = 0; i < 4; ++i) QL[(16 * lt + 4 * fq + i) * XCS + 64 * wave + 16 * (ct) + fr] = (bf16)f2bf(acc[i]); \
                } else { \
                    const int d = 64 * (wave - 4) + 16 * (ct) + fr; \
                    u32x2 o; o.x = pk2(acc[0] * wk4[0], acc[1] * wk4[1]); o.y = pk2(acc[2] * wk4[2], acc[3] * wk4[3]); \
                    *(u32x2*)(KT + d * TPS + 16 * lt + 4 * fq) = o; \
                } } while (0)
        __builtin_amdgcn_sched_barrier(0);
        cprep_fetch(P, gsc, has_next ? ci + G : ci, tid, xr, gw);
        __builtin_amdgcn_sched_barrier(0);
#pragma unroll
        for (int lt = 0; lt < 4; ++lt) {
            bf16x8 af[8];
#pragma unroll
            for (int ks = 0; ks < 8; ++ks) af[ks] = *(const bf16x8*)(XS + (16 * lt + fr) * XCS + 32 * ks + 8 * fq);
            const f32x4 wk4 = *(const f32x4*)(GL + 16 * lt + 4 * fq);
            f32x4 ac0 = {0.f, 0.f, 0.f, 0.f}, ac1 = ac0, ac2 = ac0, ac3 = ac0;
#pragma unroll
            for (int ks = 0; ks < 8; ++ks) { ac0 = mfma16(af[ks], wq0[ks], ac0); ac1 = mfma16(af[ks], wq1[ks], ac1); ac2 = mfma16(af[ks], wq2[ks], ac2); ac3 = mfma16(af[ks], wq3[ks], ac3); }
            CP_EPI(ac0, 0); CP_EPI(ac1, 1); CP_EPI(ac2, 2); CP_EPI(ac3, 3);
            __builtin_amdgcn_sched_barrier(0);
        }
#undef CP_EPI
        CP_BAR();
#pragma unroll
        for (int i = 0; i < 4; ++i) { const int c = tid + NTHR * i, row = c >> 5, cc = c & 31;
            *(u32x4*)(QM + (size_t)(t0 + row) * 1024 + h * 256 + 8 * cc) = *(const u32x4*)(QL + row * XCS + 8 * cc); }
        const f32x4 a1l = *(const f32x4*)(GL + 64 + 16 * ti + 4 * fq); const float msc = GL[128];
#pragma unroll
        for (int tt = 0; tt < 2; ++tt) {
            const int tj = tj0 + tt;
            f32x4 sacc = {0.f, 0.f, 0.f, 0.f};
            if (tj <= ti) {
#pragma unroll
                for (int ks = 0; ks < 8; ++ks) {
                    const bf16x8 qf = *(const bf16x8*)(QL + (16 * ti + fr) * XCS + 32 * ks + 8 * fq);
                    const bf16* kp = KT + (32 * ks + 8 * fq + (fr >> 2)) * TPS + 16 * tj + 4 * (fr & 3);
                    const s16x4 k0 = __builtin_amdgcn_ds_read_tr16_b64_v4i16((__attribute__((address_space(3))) s16x4*)(kp));
                    const s16x4 k1 = __builtin_amdgcn_ds_read_tr16_b64_v4i16((__attribute__((address_space(3))) s16x4*)(kp + 4 * TPS));
                    bf16x8 kb; kb[0] = k0[0]; kb[1] = k0[1]; kb[2] = k0[2]; kb[3] = k0[3]; kb[4] = k1[0]; kb[5] = k1[1]; kb[6] = k1[2]; kb[7] = k1[3];
                    sacc = mfma16(qf, kb, sacc); }
            }
            const int sidx = 16 * tj + fr;
#pragma unroll
            for (int i = 0; i < 4; ++i) { const int l = 16 * ti + 4 * fq + i;
                float v = 0.f;
                if (sidx <= l) v = sacc[i] * __expf(a1l[i] + msc);
                ST[l * TPS + sidx] = (bf16)f2bf(v); }
        }
        CP_BAR();
        { const int row = tid >> 3, ch = tid & 7; *(u32x4*)(SG + (size_t)ci * 4096 + row * 64 + 8 * ch) = *(const u32x4*)(ST + row * TPS + 8 * ch); }
#pragma unroll
        for (int i = 0; i < 4; ++i) { const int p = tid + NTHR * i, blk = p >> 6, ln = p & 63, row = (blk >> 1) * 16 + (ln & 15), ch = (blk & 1) * 4 + (ln >> 4);
            *(u32x4*)(KTG + (size_t)ci * 16384 + p * 8) = *(const u32x4*)(KT + row * TPS + 8 * ch); }
    }
    __syncthreads();
}

constexpr int SA_DEPTH = 5, SA_PATCH = 32 * 32 * 2 + 128;
struct ScanA { const bf16* KTG; const bf16* VTG; const float* gDEC; bf16* CS; float* NS; int bl, h, dblk, eblk, wave, fr, fq; unsigned koff, voff; bool do_den; };
struct ScanAOps { bf16x8 k[2][2], v[2][2]; float decay; };
__device__ __forceinline__ void scana_load(const ScanA& c, int j, ScanAOps& o) {
    const int ci = (c.bl * 64 + j) * 4 + c.h;
    const bf16* kb = c.KTG + (size_t)ci * 16384; const bf16* vb = c.VTG + (size_t)ci * 16384;
#pragma unroll
    for (int dt = 0; dt < 2; ++dt)
#pragma unroll
        for (int k2 = 0; k2 < 2; ++k2) o.k[dt][k2] = *(const bf16x8*)(kb + (c.koff + (unsigned)((dt * 2 + k2) * 512)));
#pragma unroll
    for (int et = 0; et < 2; ++et)
#pragma unroll
        for (int k2 = 0; k2 < 2; ++k2) o.v[et][k2] = *(const bf16x8*)(vb + (c.voff + (unsigned)((et * 2 + k2) * 512)));
    o.decay = c.gDEC[c.h * (MS / 64) + c.bl * 64 + j];
}
__device__ __forceinline__ void scana_step(const ScanA& c, unsigned char* lds, int j, f32x4 (&Cacc)[2][2], f32x4 (&Nacc)[2], const ScanAOps& o, const bf16x8 ones) {
    const int ci = (c.bl * 64 + j) * 4 + c.h;
    unsigned char* patch = lds + c.wave * SA_PATCH;
    const int lane = c.fq * 16 + c.fr;
    if ((j & 1) == 0) {
#pragma unroll
    for (int dt = 0; dt < 2; ++dt) {
#pragma unroll
        for (int et = 0; et < 2; ++et) { const f32x4 cc = Cacc[dt][et]; u32x2 w; w.x = pk2(cc[0], cc[1]); w.y = pk2(cc[2], cc[3]);
            *(u32x2*)(patch + (16 * et + c.fr) * 64 + (16 * dt + 4 * c.fq) * 2) = w; }
        if (c.do_den && c.fr == 0) *(f32x4*)(patch + 2048 + (16 * dt + 4 * c.fq) * 4) = Nacc[dt];
    }
    { bf16* cs = c.CS + (size_t)((c.bl * 32 + (j >> 1)) * 4 + c.h) * 65536 + (c.eblk * 8 + c.dblk) * 1024;
#pragma unroll
      for (int k = 0; k < 2; ++k) __builtin_nontemporal_store(*(const u32x4*)(patch + k * 1024 + lane * 16), (u32x4*)(cs + k * 512 + lane * 8));
      if (c.do_den && lane < 8) *(f32x4*)(c.NS + (size_t)ci * 256 + c.dblk * 32 + lane * 4) = *(const f32x4*)(patch + 2048 + lane * 16); }
    }
#pragma unroll
    for (int dt = 0; dt < 2; ++dt) {
#pragma unroll
        for (int et = 0; et < 2; ++et) {
            f32x4 cc = Cacc[dt][et] * o.decay;
#pragma unroll
            for (int k2 = 0; k2 < 2; ++k2) cc = mfma16(o.k[dt][k2], o.v[et][k2], cc);
            Cacc[dt][et] = cc;
        }
        if (c.do_den) {
            f32x4 cc = Nacc[dt] * o.decay;
#pragma unroll
            for (int k2 = 0; k2 < 2; ++k2) cc = mfma16(o.k[dt][k2], ones, cc);
            Nacc[dt] = cc;
        }
    }
}
__device__ __forceinline__ void scana_item(const Args& a, unsigned char* lds, int item, int pass) {
    const int tid = opaque_tid(), lane = tid & 63;
    unsigned char* ws = a.ws;
    ScanA c;
    c.wave = __builtin_amdgcn_readfirstlane(tid >> 6); c.fr = lane & 15; c.fq = lane >> 4;
    item = __builtin_amdgcn_readfirstlane(item);
    c.bl = item >> 5; c.h = (item >> 3) & 3; c.dblk = 2 * ((item >> 1) & 3) + (c.wave >> 2); c.eblk = 4 * (item & 1) + (c.wave & 3); c.do_den = (c.eblk == 0);
    c.koff = (unsigned)((4 * c.dblk) * 512 + lane * 8); c.voff = (unsigned)((4 * c.eblk) * 512 + lane * 8);
    c.KTG = (const bf16*)(ws + WS_KTG); c.VTG = (const bf16*)(ws + WS_VTG); c.gDEC = (const float*)(ws + WS_GSC + (size_t)pass * GSC_STRIDE) + 5 * MS * 4;
    c.CS = (bf16*)(ws + WS_CS); c.NS = (float*)(ws + WS_NS);
    f32x4 Cacc[2][2], Nacc[2];
#pragma unroll
    for (int x = 0; x < 2; ++x) { Nacc[x] = (f32x4){0.f, 0.f, 0.f, 0.f};
#pragma unroll
        for (int y = 0; y < 2; ++y) Cacc[x][y] = (f32x4){0.f, 0.f, 0.f, 0.f}; }
    bf16x8 ones;
    { const short ov = (c.fr == 0) ? (short)0x3F80 : (short)0;
#pragma unroll
      for (int e = 0; e < 8; ++e) ones[e] = ov; }
    ScanAOps o0, o1, o2, o3, o4;
    scana_load(c, 0, o0); scana_load(c, 1, o1); scana_load(c, 2, o2); scana_load(c, 3, o3); scana_load(c, 4, o4);
#define SA_STEP(jj, ob) do { scana_step(c, lds, (jj), Cacc, Nacc, ob, ones); __builtin_amdgcn_sched_barrier(0); scana_load(c, (jj) + SA_DEPTH < 64 ? (jj) + SA_DEPTH : 63, ob); __builtin_amdgcn_sched_barrier(0); } while (0)
#pragma nounroll
    for (int j = 0; j < 60; j += 5) { SA_STEP(j, o0); SA_STEP(j + 1, o1); SA_STEP(j + 2, o2); SA_STEP(j + 3, o3); SA_STEP(j + 4, o4); }
    SA_STEP(60, o0); SA_STEP(61, o1); SA_STEP(62, o2); SA_STEP(63, o3);
#undef SA_STEP
    asm volatile("s_waitcnt vmcnt(0)" ::: "memory");
}

constexpr int AKS = 136;
constexpr int L_AK = 0, L_AV = L_AK + 128 * AKS * 2, L_AP = L_AV + 128 * AKS * 2, L_ATT_END = L_AP + 8 * 16 * AKS * 2;
static_assert(L_ATT_END <= 131072, "attn lds");

__device__ __forceinline__ void attn_item(const Args& a, unsigned char* lds, int item) {
    const int tid = opaque_tid(), lane = tid & 63, wave = __builtin_amdgcn_readfirstlane(tid >> 6);
    const int fr = lane & 15, fq = lane >> 4;
    unsigned char* ws = a.ws;
    const int blk = item & 15, hh = (item >> 4) & 3, bl = (item >> 6) & 3, g = item >> 8;
    const int dil = g == 0 ? 1 : g == 1 ? 4 : 16, nb = 16 / dil;
    const int r = blk / nb, n2 = blk % nb;
    const int H = 4 * g + hh;
    const bf16* Qb = (const bf16*)(ws + WS_QKV) + ((size_t)H * MS + bl * SEQ + r * (SEQ / dil)) * 128;
    const bf16* Kb = Qb + (size_t)12 * MS * 128; const bf16* Vb = Qb + (size_t)24 * MS * 128;
    bf16* Ks = (bf16*)(lds + L_AK); bf16* VTs = (bf16*)(lds + L_AV); bf16* Pw = (bf16*)(lds + L_AP) + wave * 16 * AKS;
    const int rowbase = bl * SEQ + r;
    bf16* AO = (bf16*)(ws + WS_AO) + (size_t)g * MS * 512; float* LSE = (float*)(ws + WS_LSE) + (size_t)g * MS * 4;
    bf16x8 qf[4];
    f32x4 O[8];
    float mrow = -INFINITY, lrow = 0.f;
    const float scale = 0.08838834764831845f;
#define ATT_BAR() do { asm volatile("s_waitcnt lgkmcnt(0)" ::: "memory"); __builtin_amdgcn_s_barrier(); asm volatile("" ::: "memory"); } while (0)
    const int step0 = (n2 == 0 ? 1 : 0);
    u32x4 kreg[4], vreg[4];
#pragma unroll
    for (int i = 0; i < 4; ++i) { const int c = tid + NTHR * i, key = c >> 4, dc = c & 15;
        const int krow = 128 * (2 * n2 - 1 + step0) + key;
        kreg[i] = *(const u32x4*)(Kb + krow * 128 + 8 * dc); vreg[i] = *(const u32x4*)(Vb + krow * 128 + 8 * dc); }
#pragma nounroll
    for (int step = step0; step < 4; ++step) {
        const int half = step & 1, n = 2 * n2 + (step >> 1);
        if (step == step0 || step == 2) {
            const int qrow = 128 * n + 16 * wave + fr;
#pragma unroll
            for (int ks = 0; ks < 4; ++ks) qf[ks] = *(const bf16x8*)(Qb + qrow * 128 + 32 * ks + 8 * fq);
#pragma unroll
            for (int i = 0; i < 8; ++i) O[i] = (f32x4){0.f, 0.f, 0.f, 0.f};
            mrow = -INFINITY; lrow = 0.f;
        }
        if (step != 2) {
            ATT_BAR();
#pragma unroll
            for (int i = 0; i < 4; ++i) { const int c = tid + NTHR * i, key = c >> 4, dc = c & 15;
                *(u32x4*)(Ks + key * AKS + 8 * dc) = kreg[i]; *(u32x4*)(VTs + key * AKS + 8 * dc) = vreg[i]; }
            if (step < 3) {
#pragma unroll
                for (int i = 0; i < 4; ++i) { const int c = tid + NTHR * i, key = c >> 4, dc = c & 15;
                    const int krow = 128 * (2 * n2 + step) + key;
                    kreg[i] = *(const u32x4*)(Kb + krow * 128 + 8 * dc); vreg[i] = *(const u32x4*)(Vb + krow * 128 + 8 * dc); }
            }
            ATT_BAR();
        }
        f32x4 S[8];
        const int p = 16 * wave + fr;
        float mx = -INFINITY;
#pragma unroll
        for (int kt = 0; kt < 8; ++kt) {
            const bool act = half == 0 ? (kt >= wave) : (kt <= wave);
            f32x4 sacc = {0.f, 0.f, 0.f, 0.f};
            if (act) {
#pragma unroll
                for (int ks = 0; ks < 4; ++ks) { const bf16x8 kf = *(const bf16x8*)(Ks + (16 * kt + fr) * AKS + 32 * ks + 8 * fq); sacc = mfma16(kf, qf[ks], sacc); }
#pragma unroll
                for (int i = 0; i < 4; ++i) { const int kk = 16 * kt + 4 * fq + i; const bool ok = half == 0 ? (kk >= p) : (kk <= p);
                    const float v = ok ? sacc[i] * scale : -INFINITY; sacc[i] = v; mx = fmaxf(mx, v); }
            }
            S[kt] = sacc;
        }
        mx = xmax32(xmax16(mx));
        const float mn = fmaxf(mrow, mx), alpha = __expf(mrow - mn); mrow = mn;
        float rs = 0.f;
        unsigned pk[8][2];
#pragma unroll
        for (int kt = 0; kt < 8; ++kt) {
            const bool act = half == 0 ? (kt >= wave) : (kt <= wave);
            if (act) { const float p0 = __expf(S[kt][0] - mn), p1 = __expf(S[kt][1] - mn), p2 = __expf(S[kt][2] - mn), p3 = __expf(S[kt][3] - mn);
                rs += (p0 + p1) + (p2 + p3); pk[kt][0] = pk2(p0, p1); pk[kt][1] = pk2(p2, p3); }
            else { pk[kt][0] = 0u; pk[kt][1] = 0u; }
        }
        rs = xsum32(xsum16(rs));
        lrow = lrow * alpha + rs;
        float al[4];
#pragma unroll
        for (int i = 0; i < 4; ++i) al[i] = __shfl(alpha, 4 * fq + i);
#pragma unroll
        for (int dtile = 0; dtile < 8; ++dtile)
#pragma unroll
            for (int i = 0; i < 4; ++i) O[dtile][i] *= al[i];
#pragma unroll
        for (int ks = 0; ks < 4; ++ks) {
            const bool act = half == 0 ? (2 * ks + 1 >= wave) : (2 * ks <= wave);
            if (act) {
                u32x4 pw; pw.x = pk[2 * ks][0]; pw.y = pk[2 * ks][1]; pw.z = pk[2 * ks + 1][0]; pw.w = pk[2 * ks + 1][1];
                const bf16x8 pa = __builtin_bit_cast(bf16x8, pw);
#pragma unroll
                for (int dtile = 0; dtile < 8; ++dtile) {
                    const bf16* vp = VTs + (32 * ks + 4 * fq + (fr >> 2)) * AKS + 16 * dtile + 4 * (fr & 3);
                    const s16x4 v0 = __builtin_amdgcn_ds_read_tr16_b64_v4i16((__attribute__((address_space(3))) s16x4*)(vp));
                    const s16x4 v1 = __builtin_amdgcn_ds_read_tr16_b64_v4i16((__attribute__((address_space(3))) s16x4*)(vp + 16 * AKS));
                    bf16x8 vb; vb[0] = v0[0]; vb[1] = v0[1]; vb[2] = v0[2]; vb[3] = v0[3]; vb[4] = v1[0]; vb[5] = v1[1]; vb[6] = v1[2]; vb[7] = v1[3];
                    O[dtile] = mfma16(pa, vb, O[dtile]); }
            }
        }
        if (half == 1)
        {
            const float inv_l = 1.f / lrow;
            float il[4];
    #pragma unroll
            for (int i = 0; i < 4; ++i) il[i] = __shfl(inv_l, 4 * fq + i);
    #pragma unroll
            for (int dtile = 0; dtile < 8; ++dtile)
    #pragma unroll
                for (int i = 0; i < 4; ++i) Pw[(4 * fq + i) * AKS + 16 * dtile + fr] = (bf16)f2bf(O[dtile][i] * il[i]);
            if (fq == 0) { const size_t row = (size_t)(rowbase + (128 * n + 16 * wave + fr) * dil); LSE[(size_t)hh * MS + row] = mrow + __logf(lrow); }
    #pragma unroll
            for (int k = 0; k < 4; ++k) { const int c = lane + 64 * k, q = c >> 4, ch = c & 15;
                const size_t row = (size_t)(rowbase + (128 * n + 16 * wave + q) * dil);
                *(u32x4*)(AO + row * 512 + hh * 128 + 8 * ch) = *(const u32x4*)(Pw + q * AKS + 8 * ch); }
        }
    }
    __syncthreads();
}

constexpr int N_SCAN_ITEMS = NB_PASS * 32, N_ATT_ITEMS = 3 * NB_PASS * 4 * 16;
#ifndef PROBE_ATT_REP
#define PROBE_ATT_REP 1
#endif
struct XcdBarrier;
__device__ __forceinline__ void xcd_barrier(const XcdBarrier& b);
__device__ __forceinline__ void phase_mix(const Args& a, unsigned char* lds, int pass, const XcdBarrier* pbar) {
    volatile int* slot = (volatile int*)(lds + 131072 + 1024);
#ifdef PROBE_SPLIT
    for (int it = blockIdx.x; it < N_SCAN_ITEMS; it += gridDim.x) scana_item(a, lds, it, pass);
    xcd_barrier(*pbar);
    for (int rep = 0; rep < PROBE_ATT_REP; ++rep)
    for (int it = blockIdx.x; it < N_ATT_ITEMS; it += gridDim.x) attn_item(a, lds, it);
#else
    if ((int)blockIdx.x < N_SCAN_ITEMS && gridDim.x >= (unsigned)N_SCAN_ITEMS) {
        const int x = blockIdx.x & 7, k = blockIdx.x >> 3, g = x + 8 * (k >> 3), m = k & 7;
        scana_item(a, lds, g * 8 + m, pass);
    } else if (gridDim.x < (unsigned)N_SCAN_ITEMS) { for (int it = blockIdx.x; it < N_SCAN_ITEMS; it += gridDim.x) scana_item(a, lds, it, pass); }
    constexpr int QN = N_ATT_ITEMS / 8;
    for (int qo = 0; qo < 8; ++qo) {
        const int qx = (int)((blockIdx.x + qo) & 7);
        unsigned* qc = (unsigned*)(a.ws + WS_CTL) + CW_QCTR + (pass * 8 + qx) * 64;
        for (;;) {
            __syncthreads();
            if (opaque_tid() == 0) *slot = (int)atomicAdd(qc, 1u);
            __syncthreads();
            const int L = *slot;
            if (L >= QN) break;
            attn_item(a, lds, ((L >> 3) * 8 + qx) * 8 + (L & 7));
        }
    }
#endif
}

constexpr int QS_STRIDE = 264, SS_STRIDE = 72;
constexpr int L_QS = 0, L_SS = L_QS + 64 * QS_STRIDE * 2, L_DENL = L_SS + 64 * SS_STRIDE * 2, L_WIL = L_DENL + 256, L_NUM = L_WIL + 256, L_SB_END = L_NUM + 64 * QS_STRIDE * 2;
static_assert(L_SB_END <= 131072, "scan-B lds");
constexpr int L_KTL = L_SB_END, L_XS = L_KTL + 256 * TPS * 2, L_SB2_END = L_XS + 64 * TPS * 2;
static_assert(L_SB2_END + 1024 + 256 <= 131072, "scan-B lds");
struct SBCtx { const bf16* P; const bf16* XC; const bf16* QM; const bf16* SG; const bf16* VTG; const bf16* KTG; const bf16* CS; const float* NS; const float* gWI; const float* gEF; const float* gDEC; bf16* UM; int tid, lane, wave, fr, fq; };

__device__ __forceinline__ void scanb_tail(const Args& a, const SBCtx& c, const bf16* NUMS, const float* DENL, int h, int t0) {
    const int lane = c.lane, wave = c.wave, col = h * 256 + 4 * lane;
    const f32x4 gh = *(const f32x4*)(a.g_head + col), sk = *(const f32x4*)(a.skip + col);
#pragma unroll
    for (int hb = 0; hb < 2; ++hb) {
        u32x2 ow[4], zw[4], xw[4];
#pragma unroll
        for (int q = 0; q < 4; ++q) { const size_t r = (size_t)(t0 + 8 * wave + 4 * hb + q);
            ow[q] = *(const u32x2*)(c.P + r * INW + C_OA + col); zw[q] = *(const u32x2*)(c.P + r * INW + C_ZA + col); xw[q] = *(const u32x2*)(c.XC + r * 1024 + col); }
#pragma unroll
        for (int q = 0; q < 4; ++q) {
            const int l = 8 * wave + 4 * hb + q; const size_t r = (size_t)(t0 + l);
            const u32x2 hw = *(const u32x2*)(NUMS + l * QS_STRIDE + 4 * lane);
            const float rd = DENL[l];
            float hm[4] = {sigmoidf_(bflo(ow[q].x)) * bflo(hw.x) * rd, sigmoidf_(bfhi(ow[q].x)) * bfhi(hw.x) * rd, sigmoidf_(bflo(ow[q].y)) * bflo(hw.y) * rd, sigmoidf_(bfhi(ow[q].y)) * bfhi(hw.y) * rd};
            float ss = (hm[0] * hm[0] + hm[1] * hm[1]) + (hm[2] * hm[2] + hm[3] * hm[3]);
            ss = wave_sum(ss);
            const float rinv = __builtin_amdgcn_rsqf(ss * (1.f / 256.f) + EPS);
            const float xc[4] = {bflo(xw[q].x), bfhi(xw[q].x), bflo(xw[q].y), bfhi(xw[q].y)}, za[4] = {bflo(zw[q].x), bfhi(zw[q].x), bflo(zw[q].y), bfhi(zw[q].y)};
            float o[4];
#pragma unroll
            for (int e = 0; e < 4; ++e) o[e] = (hm[e] * rinv * gh[e] + sk[e] * xc[e]) * siluf_(za[e]);
            u32x2 ov; ov.x = pk2(o[0], o[1]); ov.y = pk2(o[2], o[3]);
            *(u32x2*)(c.UM + r * 1536 + col) = ov;
        }
        __builtin_amdgcn_sched_barrier(0);
    }
}

__device__ __forceinline__ int scanb_run(const Args& a, unsigned char* lds, int vcu, int G, int pass) {
    SBCtx c;
    c.tid = opaque_tid(); c.lane = c.tid & 63; c.wave = __builtin_amdgcn_readfirstlane(c.tid >> 6); c.fr = c.lane & 15; c.fq = c.lane >> 4;
    unsigned char* ws = a.ws;
    c.P = (const bf16*)(ws + WS_P); c.XC = (const bf16*)(ws + WS_XC); c.QM = (const bf16*)(ws + WS_QM); c.SG = (const bf16*)(ws + WS_SG); c.VTG = (const bf16*)(ws + WS_VTG); c.KTG = (const bf16*)(ws + WS_KTG);
    c.CS = (const bf16*)(ws + WS_CS); c.NS = (const float*)(ws + WS_NS); { const float* gsc = (const float*)(ws + WS_GSC + (size_t)pass * GSC_STRIDE); c.gWI = gsc + 2 * MS * 4; c.gEF = gsc + 3 * MS * 4; c.gDEC = gsc + 5 * MS * 4; }
    c.UM = (bf16*)(ws + WS_ACAT);
    const int wave = c.wave;
    bf16* QS = (bf16*)(lds + L_QS); bf16* SS = (bf16*)(lds + L_SS); float* DENL = (float*)(lds + L_DENL); float* WIL = (float*)(lds + L_WIL); bf16* NUMS = (bf16*)(lds + L_NUM);
    bf16* KTL = (bf16*)(lds + L_KTL); bf16* XS = (bf16*)(lds + L_XS);
    float* NSL = (float*)(lds + L_SB2_END); float* EFL = NSL + 256;
    unsigned* qc = (unsigned*)(ws + WS_CTL) + CW_QCTR + 2048 + pass * 64;
    volatile int* slot = (volatile int*)(lds + 131072 + 1024);
    constexpr int NITEMS = (MS / 128) * 4;
    bf16x8 ones;
    { const short ov = (c.fr == 0) ? (short)0x3F80 : (short)0;
#pragma unroll
      for (int e = 0; e < 8; ++e) ones[e] = ov; }
    int it = vcu;
    while (it < NITEMS) {
        { int t_ = c.tid; asm volatile("" : "+v"(t_)); c.tid = t_; c.lane = t_ & 63; c.fr = c.lane & 15; c.fq = c.lane >> 4; }
        const int tid = c.tid, lane = c.lane, fr = c.fr, fq = c.fq;
        const int h = it & 3, pr = it >> 2, chA = (2 * pr) * 4 + h, chB = chA + 4, tA = (2 * pr) * 64, tB = tA + 64;
        bf16x8 cb[2][8], vtA[2][2], vtB[2][2];
#pragma unroll
        for (int t = 0; t < 2; ++t) {
#pragma unroll
            for (int ks = 0; ks < 8; ++ks) cb[t][ks] = *(const bf16x8*)(c.CS + (size_t)it * 65536 + (wave * 8 + ks) * 1024 + (16 * t + fr) * 32 + 8 * fq);
#pragma unroll
            for (int k2 = 0; k2 < 2; ++k2) vtA[t][k2] = *(const bf16x8*)(c.VTG + (size_t)chA * 16384 + (((2 * wave + t) * 2 + k2) * 64 + lane) * 8);
        }
        const float decA = c.gDEC[h * (MS / 64) + 2 * pr];
        u32x4 sq[4], sss, skt[4]; float sg1 = 0.f; f32x4 sn4 = {0.f, 0.f, 0.f, 0.f}; int popv = 0;
#pragma unroll
        for (int i = 0; i < 4; ++i) { const int q = tid + NTHR * i, row = q >> 5, cc = q & 31; sq[i] = *(const u32x4*)(c.QM + (size_t)(tA + row) * 1024 + h * 256 + 8 * cc); }
        { const int row = tid >> 3, cc = tid & 7; sss = *(const u32x4*)(c.SG + (size_t)chA * 4096 + row * 64 + 8 * cc); }
#pragma unroll
        for (int i = 0; i < 4; ++i) { const int p = tid + NTHR * i; skt[i] = *(const u32x4*)(c.KTG + (size_t)chA * 16384 + p * 8); }
        sg1 = ((tid & 64) ? c.gEF : c.gWI)[h * MS + tA + (tid & 63)];
        sn4 = *(const f32x4*)(c.NS + (size_t)chA * 256 + 4 * (tid & 63));
        if (tid == 0) popv = (int)atomicAdd(qc, 1u);
        __syncthreads();
#pragma unroll
        for (int i = 0; i < 4; ++i) { const int q = tid + NTHR * i, row = q >> 5, cc = q & 31; *(u32x4*)(QS + row * QS_STRIDE + 8 * cc) = sq[i]; }
        { const int row = tid >> 3, cc = tid & 7; *(u32x4*)(SS + row * SS_STRIDE + 8 * cc) = sss; }
        if (tid < 64) WIL[tid] = sg1;
        else if (tid < 128) EFL[tid - 64] = sg1;
        else if (tid < 192) *(f32x4*)(NSL + 4 * (tid - 128)) = sn4;
#pragma unroll
        for (int i = 0; i < 4; ++i) { const int p = tid + NTHR * i, blk = p >> 6, ln = p & 63, row = (blk >> 1) * 16 + (ln & 15), ch8 = (blk & 1) * 4 + (ln >> 4);
            *(u32x4*)(KTL + row * TPS + 8 * ch8) = skt[i]; }
        if (tid == 0) *slot = popv;
        __syncthreads();
        const int nit = G + *slot;
#pragma unroll
        for (int lt = 0; lt < 4; ++lt) {
            bf16x8 qf[8], sf[2];
#pragma unroll
            for (int ks = 0; ks < 8; ++ks) qf[ks] = *(const bf16x8*)(QS + (16 * lt + fr) * QS_STRIDE + 32 * ks + 8 * fq);
#pragma unroll
            for (int k2 = 0; k2 < 2; ++k2) sf[k2] = *(const bf16x8*)(SS + (16 * lt + fr) * SS_STRIDE + 32 * k2 + 8 * fq);
#pragma unroll
            for (int t = 0; t < 2; ++t) {
                f32x4 a1 = {0.f, 0.f, 0.f, 0.f}, a2 = {0.f, 0.f, 0.f, 0.f}, a3 = {0.f, 0.f, 0.f, 0.f};
#pragma unroll
                for (int k2 = 0; k2 < 2; ++k2) a1 = mfma16(sf[k2], vtA[t][k2], a1);
#pragma unroll
                for (int ks = 0; ks < 8; ks += 2) { a2 = mfma16(qf[ks], cb[t][ks], a2); a3 = mfma16(qf[ks + 1], cb[t][ks + 1], a3); }
#pragma unroll
                for (int i = 0; i < 4; ++i) NUMS[(16 * lt + 4 * fq + i) * QS_STRIDE + 32 * wave + 16 * t + fr] = (bf16)f2bf(a1[i] + WIL[16 * lt + 4 * fq + i] * (a2[i] + a3[i]));
            }
        }
        if (wave < 4) {
            bf16x8 nb[8];
#pragma unroll
            for (int ks = 0; ks < 8; ++ks) { const f32x4 n0 = *(const f32x4*)(NSL + 32 * ks + 8 * fq), n1 = *(const f32x4*)(NSL + 32 * ks + 8 * fq + 4);
                u32x4 w; w.x = pk2(n0[0], n0[1]); w.y = pk2(n0[2], n0[3]); w.z = pk2(n1[0], n1[1]); w.w = pk2(n1[2], n1[3]);
                if (fr != 0) w = (u32x4){0u, 0u, 0u, 0u};
                nb[ks] = __builtin_bit_cast(bf16x8, w); }
            { const int lt = wave;
                f32x4 a1 = {0.f, 0.f, 0.f, 0.f}, a2 = {0.f, 0.f, 0.f, 0.f};
#pragma unroll
                for (int k2 = 0; k2 < 2; ++k2) { const bf16x8 sf = *(const bf16x8*)(SS + (16 * lt + fr) * SS_STRIDE + 32 * k2 + 8 * fq); a1 = mfma16(sf, ones, a1); }
#pragma unroll
                for (int ks = 0; ks < 8; ++ks) { const bf16x8 qf = *(const bf16x8*)(QS + (16 * lt + fr) * QS_STRIDE + 32 * ks + 8 * fq); a2 = mfma16(qf, nb[ks], a2); }
                if (fr == 0) {
#pragma unroll
                    for (int i = 0; i < 4; ++i) { const int l = 16 * lt + 4 * fq + i; const float den = a1[i] + WIL[l] * a2[i]; DENL[l] = 1.f / fmaxf(fabsf(den), EFL[l]); } }
            }
        }
        __syncthreads();
#pragma unroll
        for (int i = 0; i < 4; ++i) { const int q = tid + NTHR * i, row = q >> 5, cc = q & 31; sq[i] = *(const u32x4*)(c.QM + (size_t)(tB + row) * 1024 + h * 256 + 8 * cc); }
        { const int row = tid >> 3, cc = tid & 7; sss = *(const u32x4*)(c.SG + (size_t)chB * 4096 + row * 64 + 8 * cc); }
        sg1 = ((tid & 64) ? c.gEF : c.gWI)[h * MS + tB + (tid & 63)];
#pragma unroll
        for (int i = 0; i < 4; ++i) { const int q = tid + NTHR * i, row = q >> 5, cc = q & 31; *(u32x4*)(QS + row * QS_STRIDE + 8 * cc) = sq[i]; }
        { const int row = tid >> 3, cc = tid & 7; *(u32x4*)(SS + row * SS_STRIDE + 8 * cc) = sss; }
        scanb_tail(a, c, NUMS, DENL, h, tA);
#pragma unroll
        for (int t = 0; t < 2; ++t)
#pragma unroll
            for (int k2 = 0; k2 < 2; ++k2) vtB[t][k2] = *(const bf16x8*)(c.VTG + (size_t)chB * 16384 + (((2 * wave + t) * 2 + k2) * 64 + lane) * 8);
        __syncthreads();
        if (tid < 64) WIL[tid] = sg1;
        else if (tid < 128) EFL[tid - 64] = sg1;
        {
            const int ti = wave >> 1;
            bf16x8 qf[8];
#pragma unroll
            for (int ks = 0; ks < 8; ++ks) qf[ks] = *(const bf16x8*)(QS + (16 * ti + fr) * QS_STRIDE + 32 * ks + 8 * fq);
#pragma unroll
            for (int tt = 0; tt < 2; ++tt) { const int tj = 2 * (wave & 1) + tt;
                f32x4 xacc = {0.f, 0.f, 0.f, 0.f};
#pragma unroll
                for (int ks = 0; ks < 8; ++ks) {
                    const bf16* kp = KTL + (32 * ks + 8 * fq + (fr >> 2)) * TPS + 16 * tj + 4 * (fr & 3);
                    const s16x4 k0 = __builtin_amdgcn_ds_read_tr16_b64_v4i16((__attribute__((address_space(3))) s16x4*)(kp));
                    const s16x4 k1 = __builtin_amdgcn_ds_read_tr16_b64_v4i16((__attribute__((address_space(3))) s16x4*)(kp + 4 * TPS));
                    bf16x8 kb; kb[0] = k0[0]; kb[1] = k0[1]; kb[2] = k0[2]; kb[3] = k0[3]; kb[4] = k1[0]; kb[5] = k1[1]; kb[6] = k1[2]; kb[7] = k1[3];
                    xacc = mfma16(qf[ks], kb, xacc); }
#pragma unroll
                for (int i = 0; i < 4; ++i) XS[(16 * ti + 4 * fq + i) * TPS + 16 * tj + fr] = (bf16)f2bf(xacc[i]); }
        }
        __syncthreads();
#pragma unroll
        for (int lt = 0; lt < 4; ++lt) {
            bf16x8 qf[8], sf[2], xf[2];
#pragma unroll
            for (int ks = 0; ks < 8; ++ks) qf[ks] = *(const bf16x8*)(QS + (16 * lt + fr) * QS_STRIDE + 32 * ks + 8 * fq);
#pragma unroll
            for (int k2 = 0; k2 < 2; ++k2) { sf[k2] = *(const bf16x8*)(SS + (16 * lt + fr) * SS_STRIDE + 32 * k2 + 8 * fq); xf[k2] = *(const bf16x8*)(XS + (16 * lt + fr) * TPS + 32 * k2 + 8 * fq); }
#pragma unroll
            for (int t = 0; t < 2; ++t) {
                f32x4 a1 = {0.f, 0.f, 0.f, 0.f}, a2 = {0.f, 0.f, 0.f, 0.f}, a3 = {0.f, 0.f, 0.f, 0.f}, a4 = {0.f, 0.f, 0.f, 0.f};
#pragma unroll
                for (int k2 = 0; k2 < 2; ++k2) { a1 = mfma16(sf[k2], vtB[t][k2], a1); a4 = mfma16(xf[k2], vtA[t][k2], a4); }
#pragma unroll
                for (int ks = 0; ks < 8; ks += 2) { a2 = mfma16(qf[ks], cb[t][ks], a2); a3 = mfma16(qf[ks + 1], cb[t][ks + 1], a3); }
#pragma unroll
                for (int i = 0; i < 4; ++i) NUMS[(16 * lt + 4 * fq + i) * QS_STRIDE + 32 * wave + 16 * t + fr] = (bf16)f2bf(a1[i] + WIL[16 * lt + 4 * fq + i] * (decA * (a2[i] + a3[i]) + a4[i]));
            }
        }
        if (wave < 4) {
            bf16x8 nb[8];
#pragma unroll
            for (int ks = 0; ks < 8; ++ks) { const f32x4 n0 = *(const f32x4*)(NSL + 32 * ks + 8 * fq), n1 = *(const f32x4*)(NSL + 32 * ks + 8 * fq + 4);
                u32x4 w; w.x = pk2(n0[0], n0[1]); w.y = pk2(n0[2], n0[3]); w.z = pk2(n1[0], n1[1]); w.w = pk2(n1[2], n1[3]);
                if (fr != 0) w = (u32x4){0u, 0u, 0u, 0u};
                nb[ks] = __builtin_bit_cast(bf16x8, w); }
            { const int lt = wave;
                f32x4 a1 = {0.f, 0.f, 0.f, 0.f}, a2 = {0.f, 0.f, 0.f, 0.f}, a4 = {0.f, 0.f, 0.f, 0.f};
#pragma unroll
                for (int k2 = 0; k2 < 2; ++k2) { const bf16x8 sf = *(const bf16x8*)(SS + (16 * lt + fr) * SS_STRIDE + 32 * k2 + 8 * fq); a1 = mfma16(sf, ones, a1);
                                                 const bf16x8 xf = *(const bf16x8*)(XS + (16 * lt + fr) * TPS + 32 * k2 + 8 * fq); a4 = mfma16(xf, ones, a4); }
#pragma unroll
                for (int ks = 0; ks < 8; ++ks) { const bf16x8 qf = *(const bf16x8*)(QS + (16 * lt + fr) * QS_STRIDE + 32 * ks + 8 * fq); a2 = mfma16(qf, nb[ks], a2); }
                if (fr == 0) {
#pragma unroll
                    for (int i = 0; i < 4; ++i) { const int l = 16 * lt + 4 * fq + i; const float den = a1[i] + WIL[l] * (decA * a2[i] + a4[i]); DENL[l] = 1.f / fmaxf(fabsf(den), EFL[l]); } }
            }
        }
        __syncthreads();
        scanb_tail(a, c, NUMS, DENL, h, tB);
        it = nit;
    }
    __syncthreads();
    if (vcu >= NITEMS) { if (opaque_tid() == 0) *slot = (int)atomicAdd(qc, 1u); __syncthreads(); it = G + *slot; __syncthreads(); }
    return it;
}

__device__ __forceinline__ void phase_post(const Args& a, unsigned char* lds, int vcu, int G, int pass) {
    int qi = scanb_run(a, lds, vcu, G, pass);
    const int tid = opaque_tid(), lane = tid & 63, wave = tid >> 6;
    unsigned char* ws = a.ws;
    const bf16* P = (const bf16*)(ws + WS_P);
    const bf16* AO = (const bf16*)(ws + WS_AO); const float* LSE = (const float*)(ws + WS_LSE); bf16* UA = (bf16*)(ws + WS_ACAT) + 1024;
    const int hh = lane >> 4, c = hh * 128 + 8 * (lane & 15);
    unsigned* qc = (unsigned*)(ws + WS_CTL) + CW_QCTR + 2048 + pass * 64;
    volatile int* slot = (volatile int*)(lds + 131072 + 1024);
    constexpr int NSB = (MS / 128) * 4, NCOMB = MS / 32;
    for (;;) {
        const int ci = qi - NSB;
        if (ci >= NCOMB) break;
#pragma unroll 1
    for (int r0 = ci * 32 + 2 * wave; r0 < ci * 32 + 32; r0 += 16) {
        u32x4 o0[2], o1[2], o2[2], zb[2]; float l0[2], l1[2], l2[2];
#pragma unroll
        for (int q = 0; q < 2; ++q) { const size_t r = (size_t)(r0 + q);
            o0[q] = *(const u32x4*)(AO + r * 512 + c); o1[q] = *(const u32x4*)(AO + ((size_t)MS + r) * 512 + c); o2[q] = *(const u32x4*)(AO + ((size_t)2 * MS + r) * 512 + c);
            zb[q] = *(const u32x4*)(P + r * INW + C_ZB + c);
            l0[q] = LSE[(size_t)hh * MS + r]; l1[q] = LSE[(size_t)(4 + hh) * MS + r]; l2[q] = LSE[(size_t)(8 + hh) * MS + r]; }
        if (r0 < ci * 32 + 16) { if (tid == 0) *slot = (int)atomicAdd(qc, 1u); }
#pragma unroll
        for (int q = 0; q < 2; ++q) {
            const float mx = fmaxf(l0[q], fmaxf(l1[q], l2[q]));
            float w0 = __expf(l0[q] - mx), w1 = __expf(l1[q] - mx), w2 = __expf(l2[q] - mx); const float inv = 1.f / (w0 + w1 + w2); w0 *= inv; w1 *= inv; w2 *= inv;
            float f0[8], f1[8], f2[8], z[8], o[8]; unpack8(o0[q], f0); unpack8(o1[q], f1); unpack8(o2[q], f2); unpack8(zb[q], z);
#pragma unroll
            for (int e = 0; e < 8; ++e) o[e] = (w0 * f0[e] + w1 * f1[e] + w2 * f2[e]) * siluf_(z[e]);
            u32x4 ov; ov.x = pk2(o[0], o[1]); ov.y = pk2(o[2], o[3]); ov.z = pk2(o[4], o[5]); ov.w = pk2(o[6], o[7]);
            *(u32x4*)(UA + (size_t)(r0 + q) * 1536 + c) = ov;
        }
    }
        __syncthreads();
        qi = G + *slot;
        __syncthreads();
    }
}

__device__ __forceinline__ void phase_norm(const Args& a, int vcu, int G) {
    const int tid = opaque_tid(), lane = tid & 63, wave = tid >> 6;
    const bf16* dl = (const bf16*)(a.ws + WS_H);
    f32x4 gfv[4];
#pragma unroll
    for (int j = 0; j < 4; ++j) gfv[j] = *((const f32x4*)a.g_final + lane + 64 * j);
    const int stride = 2 * G * NWAVES;
    f32x4 vn[2][4]; u32x2 dn[2][4];
    { const int r0 = 2 * (vcu * NWAVES + wave) < MALL ? 2 * (vcu * NWAVES + wave) : 0;
#pragma unroll
      for (int q = 0; q < 2; ++q) { const f32x4* xr = (const f32x4*)(a.x + (size_t)(r0 + q) * DM) + lane; const u32x2* dr = (const u32x2*)(dl + (size_t)(r0 + q) * DM) + lane;
#pragma unroll
          for (int j = 0; j < 4; ++j) { vn[q][j] = xr[64 * j]; dn[q][j] = dr[64 * j]; } } }
    for (int r0 = 2 * (vcu * NWAVES + wave); r0 < MALL; r0 += stride) {
        f32x4 v[2][4]; u32x2 d[2][4]; float ss[2] = {0.f, 0.f};
#pragma unroll
        for (int q = 0; q < 2; ++q)
#pragma unroll
            for (int j = 0; j < 4; ++j) { v[q][j] = vn[q][j]; d[q][j] = dn[q][j]; }
        __builtin_amdgcn_sched_barrier(0);
        { const int rn = r0 + stride < MALL ? r0 + stride : r0;
#pragma unroll
          for (int q = 0; q < 2; ++q) { const f32x4* xr = (const f32x4*)(a.x + (size_t)(rn + q) * DM) + lane; const u32x2* dr = (const u32x2*)(dl + (size_t)(rn + q) * DM) + lane;
#pragma unroll
              for (int j = 0; j < 4; ++j) { vn[q][j] = xr[64 * j]; dn[q][j] = dr[64 * j]; } } }
        __builtin_amdgcn_sched_barrier(0);
#pragma unroll
        for (int q = 0; q < 2; ++q)
#pragma unroll
            for (int j = 0; j < 4; ++j) { v[q][j] += (f32x4){bflo(d[q][j].x), bfhi(d[q][j].x), bflo(d[q][j].y), bfhi(d[q][j].y)};
                ss[q] += (v[q][j].x * v[q][j].x + v[q][j].y * v[q][j].y) + (v[q][j].z * v[q][j].z + v[q][j].w * v[q][j].w); }
        ss[0] = wave_sum(ss[0]); ss[1] = wave_sum(ss[1]);
#pragma unroll
        for (int q = 0; q < 2; ++q) { const float rinv = __builtin_amdgcn_rsqf(ss[q] * (1.f / DM) + EPS);
#pragma unroll
            for (int j = 0; j < 4; ++j) *((f32x4*)(a.out + (size_t)(r0 + q) * DM) + lane + 64 * j) = v[q][j] * rinv * gfv[j]; }
    }
}


#define LAS __attribute__((address_space(3)))
#define XB_TMO      128
#define XB_XCNT(j)  (256  + 64 * (j))
#define XB_XSUB(j)  (1280 + 64 * (j))
#define XB_XGEN(j)  (2304 + 64 * (j))
#define XB_TOP      3328
#define XB_TOPGEN   3392
#define XCD_BAR_WORDS 3456
#define XB_SPIN_CAP (1u << 22)
constexpr int CW_BAR = 4096;
__device__ __forceinline__ unsigned xb_ld(unsigned* p)              { return __hip_atomic_load(p, __ATOMIC_RELAXED, __HIP_MEMORY_SCOPE_AGENT); }
__device__ __forceinline__ unsigned xb_add(unsigned* p, unsigned v) { return __hip_atomic_fetch_add(p, v, __ATOMIC_RELAXED, __HIP_MEMORY_SCOPE_AGENT); }
__device__ __forceinline__ unsigned xb_xcc_id() { return (unsigned)__builtin_amdgcn_s_getreg((3 << 11) | 20) & 0xFu; }
#define XB_SPIN(cond, bar) do { unsigned _sp = 0; while (cond) { __builtin_amdgcn_s_sleep(1); \
    if ((++_sp & 255u) == 0u) { if (xb_ld(&(bar)[XB_TMO])) break; if (_sp > XB_SPIN_CAP) { atomicAdd(&(bar)[XB_TMO], 1u); break; } } } } while (0)
struct XcdBarrier { unsigned* bar; unsigned x; volatile LAS unsigned* st; };
__device__ __forceinline__ XcdBarrier xcd_barrier_post(unsigned* bar, volatile LAS unsigned* st) {
    XcdBarrier b; b.bar = bar; b.x = xb_xcc_id(); b.st = st;
    if (threadIdx.x == 0) (void)xb_add(&bar[XB_XCNT(b.x)], 1u);
    return b;
}
__device__ __forceinline__ void xcd_barrier_complete(unsigned* bar, unsigned x, unsigned& nloc, unsigned& nx) {
    const unsigned G = gridDim.x * gridDim.y * gridDim.z;
    unsigned sum, cnt, mine, sp = 0u;
    for (;;) {
        sum = 0u; cnt = 0u; mine = 0u;
#pragma unroll
        for (unsigned j = 0; j < 16; ++j) { const unsigned c = xb_ld(&bar[XB_XCNT(j)]); sum += c; cnt += (c > 0u) ? 1u : 0u; mine = (j == x) ? c : mine; }
        if (sum == G) break;
        __builtin_amdgcn_s_sleep(1);
        if ((++sp & 255u) == 0u) { if (xb_ld(&bar[XB_TMO])) break; if (sp > XB_SPIN_CAP) { atomicAdd(&bar[XB_TMO], 1u); break; } }
    }
    nloc = mine > 0u ? mine : 1u; nx = cnt > 0u ? cnt : 1u;
}
__device__ __forceinline__ void xcd_barrier(const XcdBarrier& b) {
    asm volatile("s_waitcnt vmcnt(0)" ::: "memory");
    __syncthreads();
    if (threadIdx.x == 0) {
        unsigned* bar = b.bar;
        __builtin_amdgcn_s_waitcnt(0);
        unsigned nloc = b.st[0], nx = b.st[1];
        if (nloc == 0u) { xcd_barrier_complete(bar, b.x, nloc, nx); b.st[0] = nloc; b.st[1] = nx; }
        const unsigned old = xb_add(&bar[XB_XSUB(b.x)], 1u);
        const unsigned gen = old / nloc;
        if (old + 1u == (gen + 1u) * nloc) {
            __builtin_amdgcn_fence(__ATOMIC_RELEASE, "agent");
            asm volatile("s_waitcnt vmcnt(0)" ::: "memory");
            const unsigned og = xb_add(&bar[XB_TOP], 1u);
            const unsigned tg = og / nx;
            if (og + 1u == (tg + 1u) * nx) xb_add(&bar[XB_TOPGEN], 1u);
            else XB_SPIN(xb_ld(&bar[XB_TOPGEN]) == tg, bar);
            __builtin_amdgcn_fence(__ATOMIC_ACQUIRE, "agent");
            xb_add(&bar[XB_XGEN(b.x)], 1u);
            asm volatile("s_waitcnt vmcnt(0)" ::: "memory");
        } else {
            XB_SPIN(xb_ld(&bar[XB_XGEN(b.x)]) == gen, bar);
            __builtin_amdgcn_fence(__ATOMIC_ACQUIRE, "agent");
            asm volatile("s_waitcnt vmcnt(0)" ::: "memory");
        }
    }
    __syncthreads();
}

constexpr int PH_PER_PASS = 5, PH_TOTAL = 4 + PH_PER_PASS * NPASS + 1;
#define PROBE_KIND_OF(k) ((k) == 0 ? K_CPREP : (k) == 1 ? K_MIX : (k) == 2 ? K_POST : (k) == 3 ? K_OUT1 : K_OUT2)
enum { K_PROLOGUE = 0, K_H = 1, K_INPROJ = 2, K_PREP = 3, K_QK = 4, K_MIX = 5, K_POST = 6, K_OUT1 = 7, K_OUT2 = 8, K_NORM = 9, K_CPREP = 10, K_OUT2IN = 12 };

__device__ __forceinline__ Args fresh_args() {
    Args a{};
#if defined(__HIP_DEVICE_COMPILE__)
    typedef const __attribute__((address_space(4))) unsigned long long* KP;
    KP q = (KP)__builtin_amdgcn_kernarg_segment_ptr(); asm volatile("" : "+s"(q));
    static_assert(sizeof(Args) == 22 * 8, "Args layout");
    unsigned long long w[22];
#pragma unroll
    for (int i = 0; i < 22; ++i) w[i] = q[i];
    __builtin_memcpy(&a, w, sizeof(Args));
#endif
    return a;
}
template <int KIND>
__device__ __forceinline__ void run_phase(const Args& args, unsigned char* lds, int pass, const XcdBarrier* pbar = nullptr) {
    const int G = gridDim.x; const int bx = blockIdx.x;
    const int vcu = (G % 8 == 0) ? (bx % 8) * (G / 8) + bx / 8 : bx;
    unsigned char* ws = args.ws;
    PG8_LAS unsigned char* lds3 = (PG8_LAS unsigned char*)lds;
    if constexpr (KIND == K_PROLOGUE) phase_prologue(args, lds, vcu, G);
    else if constexpr (KIND == K_H) phase_h(args, lds, vcu, G);
    else if constexpr (KIND == K_NORM) phase_norm(args, vcu, G);
    else if constexpr (KIND == K_INPROJ) {
        GemmCombo g{(const char*)ws, WS_H + (size_t)pass * MS * 2048};
        ComboOrder S; S.init(G, bx, false);
        EpiCombo E{EpiOut{(bf16*)(ws + WS_H), (const float*)(ws + WS_MOD) + 2048, 0}, EpiProj{(bf16*)(ws + WS_P), (const float*)(ws + WS_ROPE) + (size_t)pass * MS * 32, (bf16*)(ws + WS_QKV)}, EpiVT{(bf16*)(ws + WS_VTG)}};
        pg8::gemm_phase<EpiCombo, ComboOrder, true, true>(lds3, g, S, E);
    } else if constexpr (KIND == K_PREP) phase_gates(args, lds, vcu, G);
    else if constexpr (KIND == K_QK) {
        pg8::Gemm<1024, 256, 256, 512, 512 * 256 * 2> g{(const bf16*)(ws + WS_XC), (const bf16*)(ws + WS_WQK)};
        pg8::GroupOrder S; S.init(MS, G, bx);
        EpiQK E{(bf16*)(ws + WS_QM), (bf16*)(ws + WS_KM)};
        pg8::gemm_phase<EpiQK, pg8::GroupOrder, true, true>(lds3, g, S, E);
    } else if constexpr (KIND == K_CPREP) phase_cprep(args, lds, vcu, G, pass);
    else if constexpr (KIND == K_MIX) phase_mix(args, lds, pass, pbar);
    else if constexpr (KIND == K_POST) phase_post(args, lds, vcu, G, pass);
    else if constexpr (KIND == K_OUT1) {
        pg8::Gemm<1536, 1536, 1536> g{(const bf16*)(ws + WS_ACAT), (const bf16*)(ws + WS_WOM)};
        pg8::StaticOrder S; S.init(MS, 1024, G, bx);
        EpiMerge E{(const bf16*)(ws + WS_P), (bf16*)(ws + WS_MG)};
        pg8::gemm_phase<EpiMerge, pg8::StaticOrder, true, true>(lds3, g, S, E);
    } else if constexpr (KIND == K_OUT2IN) {
        GemmCombo g{(const char*)ws, WS_H + (size_t)(pass + 1) * MS * 2048};
        ComboOrder S; S.init(G, bx, true);
        EpiCombo E{EpiOut{(bf16*)(ws + WS_H), (const float*)(ws + WS_MOD) + 2048, pass * MS}, EpiProj{(bf16*)(ws + WS_P), (const float*)(ws + WS_ROPE) + (size_t)(pass + 1) * MS * 32, (bf16*)(ws + WS_QKV)}, EpiVT{(bf16*)(ws + WS_VTG)}};
        pg8::gemm_phase<EpiCombo, ComboOrder, true, true>(lds3, g, S, E);
    } else if constexpr (KIND == K_OUT2) {
        pg8::Gemm<1024, 1024, 1024> g{(const bf16*)(ws + WS_MG), (const bf16*)(ws + WS_WO)};
        pg8::StaticOrder S; S.init(MS, 1024, G, bx);
        EpiOut E{(bf16*)(ws + WS_H), (const float*)(ws + WS_MOD) + 2048, pass * MS};
        pg8::gemm_phase<EpiOut, pg8::StaticOrder, true, true>(lds3, g, S, E);
    }
}

#if !MK_ONE_LAUNCH
template <int KIND>
__global__ void __launch_bounds__(NTHR, 2) k_phase(Args args) {
    extern __shared__ __attribute__((aligned(16))) unsigned char lds[];
    run_phase<KIND>(args, lds, args.ph_lo);
}
#else
__global__ void __launch_bounds__(NTHR, 2) mk_fwd(Args args) {
    extern __shared__ __attribute__((aligned(16))) unsigned char lds[];
    volatile LAS unsigned* misc = (volatile LAS unsigned*)((LAS unsigned char*)lds + 131072 + 2048);
    if (threadIdx.x < 16) misc[threadIdx.x] = 0u;
    __syncthreads();
    XcdBarrier bar = xcd_barrier_post((unsigned*)(args.ws + WS_CTL) + CW_BAR, misc + 8);
#ifdef PROBE_TMASK
    unsigned long long pr_acc = 0ull;
#endif
    for (int gp = args.ph_lo; gp < args.ph_hi; ++gp) {
#ifdef PROBE_TMASK
        const unsigned long long pr_t0 = __builtin_amdgcn_s_memrealtime();
        int pr_kind;
        if (gp == 0) pr_kind = K_PROLOGUE; else if (gp == 1) pr_kind = K_H; else if (gp == 2) pr_kind = K_PREP; else if (gp == 3) pr_kind = K_INPROJ; else if (gp == PH_TOTAL - 1) pr_kind = K_NORM;
        else { const int k = (gp - 4) % PH_PER_PASS; pr_kind = PROBE_KIND_OF(k); }
#endif
        if (gp == 0) run_phase<K_PROLOGUE>(args, lds, 0);
        else if (gp == 1) run_phase<K_H>(args, lds, 0);
        else if (gp == 2) run_phase<K_PREP>(args, lds, 0);
        else if (gp == 3) run_phase<K_INPROJ>(args, lds, 0);
        else if (gp == PH_TOTAL - 1) run_phase<K_NORM>(args, lds, 0);
        else {
            const int pass = (gp - 4) / PH_PER_PASS, k = (gp - 4) % PH_PER_PASS;
            if (k == 0) run_phase<K_CPREP>(args, lds, pass);
            else if (k == 1) run_phase<K_MIX>(args, lds, pass, &bar);
            else if (k == 2) run_phase<K_POST>(args, lds, pass);
            else if (k == 3) run_phase<K_OUT1>(args, lds, pass);
            else if (pass + 1 < NPASS) run_phase<K_OUT2IN>(args, lds, pass);
            else run_phase<K_OUT2>(args, lds, pass);
        }
#ifdef PROBE_TMASK
        const unsigned long long pr_tb = __builtin_amdgcn_s_memrealtime();
#endif
        if (gp + 1 < args.ph_hi) xcd_barrier(bar);
#ifdef PROBE_TMASK
        else __syncthreads();
        if ((PROBE_TMASK >> 11) & 1) pr_acc += __builtin_amdgcn_s_memrealtime() - pr_tb;
        if ((PROBE_TMASK >> pr_kind) & 1) pr_acc += __builtin_amdgcn_s_memrealtime() - pr_t0;
#endif
    }
#ifdef PROBE_TMASK
    if (blockIdx.x == 0) { const unsigned long long t1 = __builtin_amdgcn_s_memrealtime(); while (__builtin_amdgcn_s_memrealtime() - t1 < 4ull * pr_acc) __builtin_amdgcn_s_sleep(8); }
#endif
}
#endif

extern "C" void kernel_launch(void* const* d_in, const int* in_sizes, int n_in, void* d_out, int out_size, void* d_ws, size_t ws_size, hipStream_t stream) {
    static int grid = 0;
    if (grid == 0) {
        if (n_in != 19 || in_sizes[0] != MALL * DM || out_size != MALL * DM || ws_size < WS_END) { fprintf(stderr, "kernel_launch: unexpected shapes (n_in %d, ws %zu)\n", n_in, ws_size); grid = -1; return; }
        int dev = 0, cus = 0, per_cu = 0;
        (void)hipGetDevice(&dev); (void)hipDeviceGetAttribute(&cus, hipDeviceAttributeMultiprocessorCount, dev);
#if MK_ONE_LAUNCH
        (void)hipFuncSetAttribute((const void*)mk_fwd, hipFuncAttributeMaxDynamicSharedMemorySize, LDS_BYTES);
        (void)hipOccupancyMaxActiveBlocksPerMultiprocessor(&per_cu, (const void*)mk_fwd, NTHR, LDS_BYTES);
        if (per_cu < 1) { fprintf(stderr, "kernel_launch: occupancy query says %d\n", per_cu); per_cu = 1; }
#else
#define SETATTR(KIND) (void)hipFuncSetAttribute((const void*)k_phase<KIND>, hipFuncAttributeMaxDynamicSharedMemorySize, LDS_BYTES)
        SETATTR(K_PROLOGUE); SETATTR(K_H); SETATTR(K_INPROJ); SETATTR(K_PREP); SETATTR(K_QK); SETATTR(K_MIX); SETATTR(K_POST); SETATTR(K_OUT1); SETATTR(K_OUT2); SETATTR(K_NORM); SETATTR(K_CPREP); SETATTR(K_OUT2IN);
        (void)per_cu;
#endif
        (void)hipGetLastError();
        grid = cus;
    }
    if (grid < 0) return;
    (void)hipMemsetAsync((char*)d_ws + WS_CTL, 0, CTL_ZERO_BYTES, stream);
    Args a{};
    a.x = (const float*)d_in[0]; a.c = (const float*)d_in[1]; a.pos = (const int*)d_in[2]; a.w_ada = (const float*)d_in[3]; a.b_ada = (const float*)d_in[4];
    a.g_norm = (const float*)d_in[5]; a.w_in = (const float*)d_in[6]; a.b_ig = (const float*)d_in[7]; a.b_fg = (const float*)d_in[8]; a.w_conv = (const float*)d_in[9];
    a.b_conv = (const float*)d_in[10]; a.w_q = (const float*)d_in[11]; a.w_k = (const float*)d_in[12]; a.g_head = (const float*)d_in[13]; a.skip = (const float*)d_in[14];
    a.w_om = (const float*)d_in[15]; a.w_oa = (const float*)d_in[16]; a.w_o = (const float*)d_in[17]; a.g_final = (const float*)d_in[18];
    a.out = (float*)d_out; a.ws = (unsigned char*)d_ws;
#if MK_ONE_LAUNCH
    a.ph_lo = 0; a.ph_hi = PH_TOTAL;
    void* params[] = {&a};
    hipError_t e = hipLaunchCooperativeKernel((const void*)mk_fwd, dim3(grid), dim3(NTHR), params, LDS_BYTES, stream);
    if (e != hipSuccess) fprintf(stderr, "cooperative launch failed: %s\n", hipGetErrorString(e));
#else
#define LAUNCH(KIND, PASS) do { a.ph_lo = (PASS); a.ph_hi = 0; hipLaunchKernelGGL(k_phase<KIND>, dim3(grid), dim3(NTHR), LDS_BYTES, stream, a); } while (0)
    LAUNCH(K_PROLOGUE, 0); LAUNCH(K_H, 0);
    LAUNCH(K_PREP, 0); LAUNCH(K_INPROJ, 0);
    for (int p = 0; p < NPASS; ++p) { LAUNCH(K_CPREP, p); LAUNCH(K_MIX, p); LAUNCH(K_POST, p); LAUNCH(K_OUT1, p); if (p + 1 < NPASS) LAUNCH(K_OUT2IN, p); else LAUNCH(K_OUT2, p); }
    LAUNCH(K_NORM, 0);
#endif
}
```
